# Optimizing an MI355X kernel written in HIP

```python
import jax, jax.numpy as jnp
from jax import lax
import numpy as np

D_MODEL = 1024
BATCH = 8
SEQ = 2048
DEPTH = 1

PLE_DIM = 256
MIX_WIDTH = D_MODEL
GDN_WIDTH = D_MODEL // 2
GDN_HEAD_DIM = 128
GDN_HEADS = GDN_WIDTH // GDN_HEAD_DIM
FOX_WIDTH = MIX_WIDTH - GDN_WIDTH
FOX_HEAD_DIM = 64
FOX_HEADS = FOX_WIDTH // FOX_HEAD_DIM
CONV_WIDTH = 4
CHUNK = 64
Q_BLOCK = 128
D_FF = -(-8 * D_MODEL // (3 * 256)) * 256
EPS = 1e-6

IN_SIZES = [3 * GDN_WIDTH, GDN_WIDTH, GDN_HEADS, GDN_HEADS, 3 * FOX_WIDTH, FOX_HEADS]
D_IN = sum(IN_SIZES)
IN_SPLITS = [sum(IN_SIZES[:i + 1]) for i in range(len(IN_SIZES) - 1)]

kernel_name = 'hymba_style_gdn_fox_hybrid'


def rmsnorm(x, w):
    xf = x.astype(jnp.float32)
    y = xf * lax.rsqrt(jnp.mean(xf * xf, axis=-1, keepdims=True) + EPS)
    return (y * w.astype(jnp.float32)).astype(x.dtype)


def l2norm(x):
    return x * lax.rsqrt(jnp.sum(x * x, axis=-1, keepdims=True) + EPS)


def causal_depthwise_conv(x, w):
    c = x.shape[-1]
    return lax.conv_general_dilated(
        x, w.astype(x.dtype)[:, None, :], window_strides=(1,),
        padding=[(CONV_WIDTH - 1, 0)], dimension_numbers=('NWC', 'WIO', 'NWC'),
        feature_group_count=c)


def gated_delta_rule(q, k, v, g, beta):
    b, s, h, dk = q.shape
    dv = v.shape[-1]
    n = s // CHUNK

    def chunk(t):
        return jnp.moveaxis(t.reshape((b, n, CHUNK, h) + t.shape[3:]), 3, 2)

    q = chunk(q * (dk ** -0.5))
    k, v, g, beta = chunk(k), chunk(v), chunk(g), chunk(beta)
    gc = jnp.cumsum(g, axis=-1)
    lower = jnp.tril(jnp.ones((CHUNK, CHUNK), bool))
    strict = jnp.tril(jnp.ones((CHUNK, CHUNK), bool), -1)
    diff = gc[..., :, None] - gc[..., None, :]
    decay = jnp.where(lower, jnp.exp(jnp.where(lower, diff, 0.0)), 0.0)
    kb = k * beta[..., None]
    vb = v * beta[..., None]
    kk = jnp.einsum('bnhid,bnhjd->bnhij', kb, k) * decay
    a_mat = jnp.where(strict, kk, 0.0) + jnp.eye(CHUNK, dtype=kk.dtype)
    rhs = jnp.concatenate([vb, kb * jnp.exp(gc)[..., None]], axis=-1)
    sol = lax.linalg.triangular_solve(a_mat, rhs, left_side=True, lower=True, unit_diagonal=True)
    u, w = sol[..., :dv], sol[..., dv:]
    qk = jnp.where(lower, jnp.einsum('bnhid,bnhjd->bnhij', q, k) * decay, 0.0)

    def step(state, xs):
        q_c, k_c, u_c, w_c, gc_c, qk_c = xs
        v_new = u_c - jnp.einsum('bhcd,bhde->bhce', w_c, state)
        o = (jnp.einsum('bhcd,bhde->bhce', q_c * jnp.exp(gc_c)[..., None], state)
             + jnp.einsum('bhij,bhje->bhie', qk_c, v_new))
        g_last = gc_c[..., -1]
        k_dec = k_c * jnp.exp(g_last[..., None] - gc_c)[..., None]
        state = state * jnp.exp(g_last)[..., None, None] + jnp.einsum('bhcd,bhce->bhde', k_dec, v_new)
        return state, o

    xs = tuple(jnp.moveaxis(t, 1, 0) for t in (q, k, u, w, gc, qk))
    state0 = jnp.zeros((b, h, dk, dv), jnp.float32)
    _, o = lax.scan(step, state0, xs)
    o = jnp.moveaxis(jnp.moveaxis(o, 0, 1), 2, 3)
    return o.reshape(b, s, h, dv)


def forgetting_attention(q, k, v, log_f):
    b, s, h, d = q.shape
    scale = d ** -0.5
    c = jnp.cumsum(log_f.astype(jnp.float32), axis=1).transpose(0, 2, 1)
    q, k, v = (t.transpose(0, 2, 1, 3) for t in (q, k, v))
    outs = []
    for blk in range(s // Q_BLOCK):
        q0, q1 = blk * Q_BLOCK, (blk + 1) * Q_BLOCK
        logits = jnp.einsum('bhqd,bhkd->bhqk', q[:, :, q0:q1], k[:, :, :q1],
                            preferred_element_type=jnp.float32) * scale
        logits = logits + c[:, :, q0:q1, None] - c[:, :, None, :q1]
        causal = jnp.arange(q0, q1)[:, None] >= jnp.arange(q1)[None, :]
        logits = jnp.where(causal, logits, -jnp.inf)
        prob = jax.nn.softmax(logits, axis=-1)
        outs.append(jnp.einsum('bhqk,bhkd->bhqd', prob.astype(v.dtype), v[:, :, :q1]))
    o = jnp.concatenate(outs, axis=2)
    return o.transpose(0, 2, 1, 3)


def setup_inputs(seed: int = 0) -> dict:
    key = jax.random.key(seed)
    ks = jax.random.split(key, 20)
    f32 = jnp.float32
    nrm = lambda k, shape, s: jax.random.normal(k, shape, f32) * s
    gain = lambda k, shape: 1.0 + 0.1 * jax.random.normal(k, shape, f32)
    dt = jnp.exp(jax.random.uniform(ks[5], (DEPTH, GDN_HEADS), f32) * (np.log(0.1) - np.log(0.001)) + np.log(0.001))
    dt_bias = dt + jnp.log(-jnp.expm1(-dt))
    return {
        'x': nrm(ks[0], (BATCH, SEQ, D_MODEL), 1.0),
        'p': nrm(ks[1], (DEPTH, BATCH, SEQ, PLE_DIM), 1.0),
        'attn_norm_w': gain(ks[2], (DEPTH, D_MODEL)),
        'w_in': nrm(ks[3], (DEPTH, D_MODEL, D_IN), D_MODEL ** -0.5),
        'conv_w': nrm(ks[4], (DEPTH, CONV_WIDTH, 3 * GDN_WIDTH), CONV_WIDTH ** -0.5),
        'a_log': jnp.log(jax.random.uniform(ks[6], (DEPTH, GDN_HEADS), f32, 1.0, 16.0)),
        'dt_bias': dt_bias,
        'gdn_norm_w': gain(ks[7], (DEPTH, GDN_HEAD_DIM)),
        'fox_f_bias': 3.0 + 0.5 * jax.random.normal(ks[8], (DEPTH, FOX_HEADS), f32),
        'w_out': nrm(ks[9], (DEPTH, MIX_WIDTH, D_MODEL), MIX_WIDTH ** -0.5),
        'ffn_norm_w': gain(ks[10], (DEPTH, D_MODEL)),
        'w_gate_up': nrm(ks[11], (DEPTH, D_MODEL, 2 * D_FF), D_MODEL ** -0.5),
        'w_down': nrm(ks[12], (DEPTH, D_FF, D_MODEL), D_FF ** -0.5),
        'ple_norm_w': gain(ks[13], (DEPTH, D_MODEL)),
        'w_ple_gate': nrm(ks[14], (DEPTH, D_MODEL, D_MODEL), D_MODEL ** -0.5),
        'w_ple_proj': nrm(ks[15], (DEPTH, PLE_DIM, D_MODEL), PLE_DIM ** -0.5),
        'final_norm_w': gain(ks[16], (D_MODEL,)),
    }


def reference(x, p, attn_norm_w, w_in, conv_w, a_log, dt_bias, gdn_norm_w, fox_f_bias, w_out,
              ffn_norm_w, w_gate_up, w_down, ple_norm_w, w_ple_gate, w_ple_proj, final_norm_w):
    b, s, _ = x.shape
    f32 = jnp.float32
    h = x
    for i in range(DEPTH):
        xn = rmsnorm(h, attn_norm_w[i])
        proj = xn @ w_in[i]
        g_qkv, g_z, g_a, g_b, f_qkv, f_f = jnp.split(proj, IN_SPLITS, axis=-1)

        g_qkv = jax.nn.silu(causal_depthwise_conv(g_qkv, conv_w[i])).astype(f32)
        gq, gk, gv = jnp.split(g_qkv.reshape(b, s, 3 * GDN_HEADS, GDN_HEAD_DIM), 3, axis=2)
        gq, gk = l2norm(gq), l2norm(gk)
        beta = jax.nn.sigmoid(g_b.astype(f32))
        g_decay = -jnp.exp(a_log[i].astype(f32)) * jax.nn.softplus(g_a.astype(f32) + dt_bias[i].astype(f32))
        o_g = gated_delta_rule(gq, gk, gv, g_decay, beta)
        o_g = o_g * lax.rsqrt(jnp.mean(o_g * o_g, axis=-1, keepdims=True) + EPS) * gdn_norm_w[i].astype(f32)
        o_g = o_g * jax.nn.silu(g_z.astype(f32)).reshape(b, s, GDN_HEADS, GDN_HEAD_DIM)
        o_g = o_g.reshape(b, s, GDN_WIDTH).astype(h.dtype)

        fq, fk, fv = jnp.split(f_qkv.reshape(b, s, 3 * FOX_HEADS, FOX_HEAD_DIM), 3, axis=2)
        log_f = jax.nn.log_sigmoid(f_f.astype(f32) + fox_f_bias[i].astype(f32))
        o_f = forgetting_attention(fq, fk, fv, log_f).reshape(b, s, FOX_WIDTH).astype(h.dtype)

        h = h + jnp.concatenate([o_g, o_f], axis=-1) @ w_out[i]

        hn = rmsnorm(h, ffn_norm_w[i])
        gate, up = jnp.split(hn @ w_gate_up[i], 2, axis=-1)
        h = h + (jax.nn.silu(gate) * up) @ w_down[i]

        ple_gate = jax.nn.sigmoid(rmsnorm(h, ple_norm_w[i]) @ w_ple_gate[i])
        h = h + ple_gate * (p[i] @ w_ple_proj[i])
    return rmsnorm(h, final_norm_w)
```

```cpp
#include <hip/hip_runtime.h>
#include <hip/hip_cooperative_groups.h>
#include <cstdio>
#include <cstdint>
namespace cg = cooperative_groups;

typedef unsigned short u16;
typedef __attribute__((ext_vector_type(8))) short bf16x8;
typedef __attribute__((ext_vector_type(4))) float f32x4;

#define NTOK 16384
#define SEQ 2048
#define DM 1024
#define DFF 2816
#define PROJW 3072
#define NIN_PAD 3712
#define EPSV 1e-6f
#define NPHASE 11

struct P {
  const float *x, *p, *attn_norm_w, *w_in, *conv_w, *a_log, *dt_bias, *gdn_norm_w, *fox_f_bias, *w_out,
      *ffn_norm_w, *w_gate_up, *w_down, *ple_norm_w, *w_ple_gate, *w_ple_proj, *final_norm_w;
  float* h;
  u16 *wt_in, *wt_out, *wt_gu, *wt_down, *wt_pg, *wt_pp;
  u16 *actA;
  u16 *pb;
  u16 *proj;
  u16 *vt;
  float *gates;
  float *cf;
  u16 *gw, *gqg, *gkdT, *gqk;
  float *guT;
  float *gdl;
  unsigned *counters;
};

__device__ __forceinline__ u16 f2bf(float f) {
  unsigned u = __float_as_uint(f);
  u += 0x7fffu + ((u >> 16) & 1u);
  return (u16)(u >> 16);
}
__device__ __forceinline__ float bf2f(u16 h) { return __uint_as_float(((unsigned)h) << 16); }
__device__ __forceinline__ unsigned pack2(float a, float b) { return (unsigned)f2bf(a) | (((unsigned)f2bf(b)) << 16); }
__device__ __forceinline__ float siluf(float v) { return v / (1.f + __expf(-v)); }
__device__ __forceinline__ float sigmoidf_(float v) { return 1.f / (1.f + __expf(-v)); }
__device__ __forceinline__ f32x4 mfma16(bf16x8 a, bf16x8 b, f32x4 c) {
  return __builtin_amdgcn_mfma_f32_16x16x32_bf16(a, b, c, 0, 0, 0);
}
#define LDS_FENCE() asm volatile("s_waitcnt lgkmcnt(0)" ::: "memory")

__device__ __forceinline__ int colmap(int kind, int nn) {
  if (kind == 0) {
    if (nn < 2048) return nn;
    if (nn < 3584) return nn + 8;
    if (nn < 3588) return 2048 + (nn - 3584);
    if (nn < 3592) return 2052 + (nn - 3588);
    if (nn < 3600) return nn;
    return -1;
  } else if (kind == 2) {
    int i = nn >> 7, wc = (nn >> 6) & 1, u = (nn >> 5) & 1, j = nn & 31;
    return u * DFF + 64 * i + 32 * wc + j;
  }
  return nn;
}

__device__ void transpose_item(const float* __restrict__ src, int ldsrc, u16* __restrict__ dst, int K,
                               int kt, int nt, int kind, float* tile) {
  const int tid = threadIdx.x;
  const int c = tid & 63, r0 = tid >> 6;
  const int ncol = colmap(kind, nt * 64 + c);
#pragma unroll 4
  for (int i = 0; i < 16; i++) {
    int r = r0 + 4 * i;
    float v = (ncol >= 0) ? src[(size_t)(kt * 64 + r) * ldsrc + ncol] : 0.f;
    tile[r * 65 + c] = v;
  }
  __syncthreads();
#pragma unroll 4
  for (int i = 0; i < 16; i++) {
    int rn = r0 + 4 * i;
    dst[(size_t)(nt * 64 + rn) * K + kt * 64 + c] = f2bf(tile[c * 65 + rn]);
  }
  __syncthreads();
}

__device__ __forceinline__ void rmsnorm_row(const float* src, const float* __restrict__ w,
                                            u16* dstb, float* dstf, int row) {
  const int lane = threadIdx.x & 63;
  float4 v[4];
  float ss = 0.f;
#pragma unroll
  for (int i = 0; i < 4; i++) {
    v[i] = *(const float4*)&src[(size_t)row * DM + i * 256 + lane * 4];
    ss += v[i].x * v[i].x + v[i].y * v[i].y + v[i].z * v[i].z + v[i].w * v[i].w;
  }
#pragma unroll
  for (int off = 32; off >= 1; off >>= 1) ss += __shfl_xor(ss, off);
  const float r = rsqrtf(ss * (1.f / DM) + EPSV);
#pragma unroll
  for (int i = 0; i < 4; i++) {
    const int col = i * 256 + lane * 4;
    float4 wv = *(const float4*)&w[col];
    float y0 = v[i].x * r * wv.x, y1 = v[i].y * r * wv.y, y2 = v[i].z * r * wv.z, y3 = v[i].w * r * wv.w;
    if (dstb) {
      uint2 o; o.x = pack2(y0, y1); o.y = pack2(y2, y3);
      *(uint2*)&dstb[(size_t)row * DM + col] = o;
    } else {
      *(float4*)&dstf[(size_t)row * DM + col] = make_float4(y0, y1, y2, y3);
    }
  }
}

__device__ void phase_prep(const P& p, unsigned char* smem) {
  float* tile = (float*)smem;
  if (blockIdx.x == 0 && threadIdx.x < 16) p.counters[threadIdx.x] = 0u;
  const int n0 = 16 * 58, n1 = n0 + 16 * 16, n2 = n1 + 16 * 88, n3 = n2 + 44 * 16, n4 = n3 + 16 * 16, n5 = n4 + 4 * 16;
  for (int it = blockIdx.x; it < n5; it += gridDim.x) {
    if (it < n0) { int kt = it % 16, nt = it / 16; transpose_item(p.w_in, 3600, p.wt_in, 1024, kt, nt, 0, tile); }
    else if (it < n1) { int j = it - n0; transpose_item(p.w_out, 1024, p.wt_out, 1024, j % 16, j / 16, 1, tile); }
    else if (it < n2) { int j = it - n1; transpose_item(p.w_gate_up, 2 * DFF, p.wt_gu, 1024, j % 16, j / 16, 2, tile); }
    else if (it < n3) { int j = it - n2; transpose_item(p.w_down, 1024, p.wt_down, DFF, j % 44, j / 44, 1, tile); }
    else if (it < n4) { int j = it - n3; transpose_item(p.w_ple_gate, 1024, p.wt_pg, 1024, j % 16, j / 16, 1, tile); }
    else { int j = it - n4; transpose_item(p.w_ple_proj, 1024, p.wt_pp, 256, j % 4, j / 4, 1, tile); }
  }
  const int wave = threadIdx.x >> 6, lane = threadIdx.x & 63;
  for (int rb = blockIdx.x; rb < NTOK / 4; rb += gridDim.x) {
    const int row = rb * 4 + wave;
    rmsnorm_row(p.x, p.attn_norm_w, p.actA, nullptr, row);
    float4 pv = *(const float4*)&p.p[(size_t)row * 256 + lane * 4];
    uint2 o; o.x = pack2(pv.x, pv.y); o.y = pack2(pv.z, pv.w);
    *(uint2*)&p.pb[(size_t)row * 256 + lane * 4] = o;
  }
}

__device__ void phase_rmsnorm(const float* src, const float* w, u16* dstb, float* dstf) {
  const int wave = threadIdx.x >> 6;
  for (int rb = blockIdx.x; rb < NTOK / 4; rb += gridDim.x) rmsnorm_row(src, w, dstb, dstf, rb * 4 + wave);
}

#define GK 64
#define GLD 72
struct GemmSmem { u16 a[2][128 * GLD]; u16 b[2][128 * GLD]; };

__device__ __forceinline__ void gemm_tile(const u16* __restrict__ A, int lda, const u16* __restrict__ Bt, int ldb,
                                          int K, int m0, int n0, GemmSmem& s, f32x4 (&acc)[4][4]) {
  const int tid = threadIdx.x, lane = tid & 63, wave = tid >> 6;
  const int wr = wave >> 1, wc = wave & 1;
  const int l15 = lane & 15, g = lane >> 4;
  const int nk = K / GK;
  uint4 ra0, ra1, ra2, ra3, rb0, rb1, rb2, rb3;
  const int crow = tid >> 3, ccol = (tid & 7) * 8;
  const u16* Ap = A + (size_t)(m0 + crow) * lda + ccol;
  const u16* Bp = Bt + (size_t)(n0 + crow) * ldb + ccol;
  const size_t sa = (size_t)32 * lda, sb = (size_t)32 * ldb;
#define G_LOAD(koff) \
  ra0 = *(const uint4*)(Ap + (koff)); ra1 = *(const uint4*)(Ap + sa + (koff)); \
  ra2 = *(const uint4*)(Ap + 2 * sa + (koff)); ra3 = *(const uint4*)(Ap + 3 * sa + (koff)); \
  rb0 = *(const uint4*)(Bp + (koff)); rb1 = *(const uint4*)(Bp + sb + (koff)); \
  rb2 = *(const uint4*)(Bp + 2 * sb + (koff)); rb3 = *(const uint4*)(Bp + 3 * sb + (koff));
#define G_STORE(bufi) \
  *(uint4*)&s.a[bufi][(crow) * GLD + ccol] = ra0; *(uint4*)&s.a[bufi][(crow + 32) * GLD + ccol] = ra1; \
  *(uint4*)&s.a[bufi][(crow + 64) * GLD + ccol] = ra2; *(uint4*)&s.a[bufi][(crow + 96) * GLD + ccol] = ra3; \
  *(uint4*)&s.b[bufi][(crow) * GLD + ccol] = rb0; *(uint4*)&s.b[bufi][(crow + 32) * GLD + ccol] = rb1; \
  *(uint4*)&s.b[bufi][(crow + 64) * GLD + ccol] = rb2; *(uint4*)&s.b[bufi][(crow + 96) * GLD + ccol] = rb3;
  G_LOAD(0)
  __syncthreads();
  G_STORE(0)
  __syncthreads();
  for (int kt = 0; kt < nk; kt++) {
    const int buf = kt & 1;
    if (kt + 1 < nk) { G_LOAD((kt + 1) * GK) }
#pragma unroll
    for (int ks = 0; ks < 2; ks++) {
      bf16x8 af[4], bfr[4];
#pragma unroll
      for (int mi = 0; mi < 4; mi++) af[mi] = *(const bf16x8*)&s.a[buf][(wr * 64 + mi * 16 + l15) * GLD + ks * 32 + g * 8];
#pragma unroll
      for (int ni = 0; ni < 4; ni++) bfr[ni] = *(const bf16x8*)&s.b[buf][(wc * 64 + ni * 16 + l15) * GLD + ks * 32 + g * 8];
#pragma unroll
      for (int mi = 0; mi < 4; mi++)
#pragma unroll
        for (int ni = 0; ni < 4; ni++) acc[mi][ni] = mfma16(af[mi], bfr[ni], acc[mi][ni]);
    }
    if (kt + 1 < nk) {
      if (buf) { G_STORE(0) } else { G_STORE(1) }
    }
    __syncthreads();
  }
}

#define ZERO_ACC(acc) _Pragma("unroll") for (int _i = 0; _i < 4; _i++) _Pragma("unroll") for (int _j = 0; _j < 4; _j++) acc[_i][_j] = (f32x4){0.f, 0.f, 0.f, 0.f};

__device__ void phase_inproj(const P& p, unsigned char* smem) {
  GemmSmem& s = *(GemmSmem*)smem;
  const int lane = threadIdx.x & 63, wave = threadIdx.x >> 6, wr = wave >> 1, wc = wave & 1, l15 = lane & 15, g = lane >> 4;
  const int ntiles = 128 * 29;
  for (int tl = blockIdx.x; tl < ntiles; tl += gridDim.x) {
    const int mt = tl & 127, nt = tl >> 7;
    const int m0 = mt * 128, n0 = nt * 128;
    f32x4 acc[4][4];
    ZERO_ACC(acc);
    gemm_tile(p.actA, DM, p.wt_in, DM, DM, m0, n0, s, acc);
#pragma unroll
    for (int mi = 0; mi < 4; mi++)
#pragma unroll
      for (int ni = 0; ni < 4; ni++) {
        const int rowb = m0 + wr * 64 + mi * 16 + g * 4;
        const int col = n0 + wc * 64 + ni * 16 + l15;
        if (nt < 24) {
#pragma unroll
          for (int r = 0; r < 4; r++) p.proj[(size_t)(rowb + r) * PROJW + col] = f2bf(acc[mi][ni][r]);
        } else if (nt < 28) {
          const int cc = col - 3072, hh = cc >> 6, d = cc & 63;
          const int b = rowb >> 11, sq = rowb & 2047;
          uint2 o; o.x = pack2(acc[mi][ni][0], acc[mi][ni][1]); o.y = pack2(acc[mi][ni][2], acc[mi][ni][3]);
          *(uint2*)&p.vt[((size_t)((b * 8 + hh) * 64 + d)) * SEQ + sq] = o;
        } else {
          if (col < 3600) {
#pragma unroll
            for (int r = 0; r < 4; r++) p.gates[(size_t)(rowb + r) * 16 + (col - 3584)] = acc[mi][ni][r];
          }
        }
      }
  }
}

__device__ void phase_outproj(const P& p, unsigned char* smem) {
  GemmSmem& s = *(GemmSmem*)smem;
  const int lane = threadIdx.x & 63, wave = threadIdx.x >> 6, wr = wave >> 1, wc = wave & 1, l15 = lane & 15, g = lane >> 4;
  for (int tl = blockIdx.x; tl < 128 * 8; tl += gridDim.x) {
    const int mt = tl & 127, nt = tl >> 7;
    const int m0 = mt * 128, n0 = nt * 128;
    f32x4 acc[4][4];
    ZERO_ACC(acc);
    gemm_tile(p.actA, DM, p.wt_out, DM, DM, m0, n0, s, acc);
#pragma unroll
    for (int mi = 0; mi < 4; mi++)
#pragma unroll
      for (int ni = 0; ni < 4; ni++) {
        const int rowb = m0 + wr * 64 + mi * 16 + g * 4;
        const int col = n0 + wc * 64 + ni * 16 + l15;
#pragma unroll
        for (int r = 0; r < 4; r++) {
          size_t idx = (size_t)(rowb + r) * DM + col;
          p.h[idx] = p.x[idx] + acc[mi][ni][r];
        }
      }
  }
}

__device__ void phase_gateup(const P& p, unsigned char* smem) {
  GemmSmem& s = *(GemmSmem*)smem;
  u16* act = p.proj;
  const int lane = threadIdx.x & 63, wave = threadIdx.x >> 6, wr = wave >> 1, wc = wave & 1, l15 = lane & 15, g = lane >> 4;
  for (int tl = blockIdx.x; tl < 128 * 44; tl += gridDim.x) {
    const int mt = tl & 127, nt = tl >> 7;
    const int m0 = mt * 128, n0 = nt * 128;
    f32x4 acc[4][4];
    ZERO_ACC(acc);
    gemm_tile(p.actA, DM, p.wt_gu, DM, DM, m0, n0, s, acc);
#pragma unroll
    for (int mi = 0; mi < 4; mi++)
#pragma unroll
      for (int ni = 0; ni < 2; ni++) {
        const int rowb = m0 + wr * 64 + mi * 16 + g * 4;
        const int col = 64 * nt + 32 * wc + 16 * ni + l15;
#pragma unroll
        for (int r = 0; r < 4; r++) {
          float gt = acc[mi][ni][r], up = acc[mi][ni + 2][r];
          act[(size_t)(rowb + r) * DFF + col] = f2bf(siluf(gt) * up);
        }
      }
  }
}

__device__ void phase_down(const P& p, unsigned char* smem) {
  GemmSmem& s = *(GemmSmem*)smem;
  const u16* act = p.proj;
  const int lane = threadIdx.x & 63, wave = threadIdx.x >> 6, wr = wave >> 1, wc = wave & 1, l15 = lane & 15, g = lane >> 4;
  for (int tl = blockIdx.x; tl < 128 * 8; tl += gridDim.x) {
    const int mt = tl & 127, nt = tl >> 7;
    const int m0 = mt * 128, n0 = nt * 128;
    f32x4 acc[4][4];
    ZERO_ACC(acc);
    gemm_tile(act, DFF, p.wt_down, DFF, DFF, m0, n0, s, acc);
#pragma unroll
    for (int mi = 0; mi < 4; mi++)
#pragma unroll
      for (int ni = 0; ni < 4; ni++) {
        const int rowb = m0 + wr * 64 + mi * 16 + g * 4;
        const int col = n0 + wc * 64 + ni * 16 + l15;
#pragma unroll
        for (int r = 0; r < 4; r++) {
          size_t idx = (size_t)(rowb + r) * DM + col;
          p.h[idx] += acc[mi][ni][r];
        }
      }
  }
}

__device__ void phase_ple(const P& p, unsigned char* smem) {
  GemmSmem& s = *(GemmSmem*)smem;
  const int lane = threadIdx.x & 63, wave = threadIdx.x >> 6, wr = wave >> 1, wc = wave & 1, l15 = lane & 15, g = lane >> 4;
  for (int tl = blockIdx.x; tl < 128 * 8; tl += gridDim.x) {
    const int mt = tl & 127, nt = tl >> 7;
    const int m0 = mt * 128, n0 = nt * 128;
    f32x4 acc[4][4], acc2[4][4];
    ZERO_ACC(acc);
    gemm_tile(p.actA, DM, p.wt_pg, DM, DM, m0, n0, s, acc);
#pragma unroll
    for (int mi = 0; mi < 4; mi++)
#pragma unroll
      for (int ni = 0; ni < 4; ni++)
#pragma unroll
        for (int r = 0; r < 4; r++) acc[mi][ni][r] = sigmoidf_(acc[mi][ni][r]);
    ZERO_ACC(acc2);
    gemm_tile(p.pb, 256, p.wt_pp, 256, 256, m0, n0, s, acc2);
#pragma unroll
    for (int mi = 0; mi < 4; mi++)
#pragma unroll
      for (int ni = 0; ni < 4; ni++) {
        const int rowb = m0 + wr * 64 + mi * 16 + g * 4;
        const int col = n0 + wc * 64 + ni * 16 + l15;
#pragma unroll
        for (int r = 0; r < 4; r++) {
          size_t idx = (size_t)(rowb + r) * DM + col;
          p.h[idx] += acc[mi][ni][r] * acc2[mi][ni][r];
        }
      }
  }
}

#define QLD 136
struct GdnSmem {
  u16 qb[64 * QLD];
  u16 kn[64 * QLD];
  u16 vb[64 * QLD];
  float Am[64 * 64];
  float gc[64], beta[64], be[64];
  float part[64 * 2];
};

__device__ void gdn_unit(const P& p, int unit, GdnSmem& s) {
  const int tid = threadIdx.x, lane = tid & 63, wave = tid >> 6;
  const int bh = unit >> 5, n = unit & 31;
  const int b = bh >> 2, h = bh & 3;
  const int tb = b * SEQ;
  const int s0 = n * 64;
  __syncthreads();
  if (wave == 0) {
    const int t = tb + s0 + lane;
    const float ga = p.gates[(size_t)t * 16 + h], gb = p.gates[(size_t)t * 16 + 4 + h];
    const float xx = ga + p.dt_bias[h];
    const float sp = (xx > 20.f) ? xx : log1pf(__expf(xx));
    float gg = -__expf(p.a_log[h]) * sp;
#pragma unroll
    for (int off = 1; off < 64; off <<= 1) {
      float nb = __shfl_up(gg, off);
      if (lane >= off) gg += nb;
    }
    const float bt = sigmoidf_(gb);
    s.gc[lane] = gg;
    s.beta[lane] = bt;
    s.be[lane] = bt * __expf(gg);
  }
  {
    const int c = tid & 127, half = tid >> 7;
#pragma unroll 1
    for (int mat = 0; mat < 3; mat++) {
      const int col = mat * 512 + h * 128 + c;
      const float cw0 = p.conv_w[col], cw1 = p.conv_w[1536 + col], cw2 = p.conv_w[2 * 1536 + col], cw3 = p.conv_w[3 * 1536 + col];
      const int sfirst = s0 + half * 32;
      float x0 = 0.f, x1 = 0.f, x2 = 0.f;
      if (sfirst >= 3) {
        x0 = bf2f(p.proj[(size_t)(tb + sfirst - 3) * PROJW + col]);
        x1 = bf2f(p.proj[(size_t)(tb + sfirst - 2) * PROJW + col]);
        x2 = bf2f(p.proj[(size_t)(tb + sfirst - 1) * PROJW + col]);
      }
      float val[32];
#pragma unroll
      for (int i = 0; i < 32; i++) {
        const float x3 = bf2f(p.proj[(size_t)(tb + sfirst + i) * PROJW + col]);
        const float cv = cw0 * x0 + cw1 * x1 + cw2 * x2 + cw3 * x3;
        val[i] = siluf(cv);
        x0 = x1; x1 = x2; x2 = x3;
      }
      if (mat < 2) {
        __syncthreads();
#pragma unroll
        for (int i = 0; i < 32; i++) {
          float sq = val[i] * val[i];
#pragma unroll
          for (int off = 32; off >= 1; off >>= 1) sq += __shfl_xor(sq, off);
          if (lane == 0) s.part[(half * 32 + i) * 2 + (wave & 1)] = sq;
        }
        __syncthreads();
        u16* dst = (mat == 0) ? s.qb : s.kn;
        const float extra = (mat == 0) ? 0.08838834764831845f : 1.f;
#pragma unroll
        for (int i = 0; i < 32; i++) {
          const int r = half * 32 + i;
          const float rs = rsqrtf(s.part[r * 2] + s.part[r * 2 + 1] + EPSV) * extra;
          dst[r * QLD + c] = f2bf(val[i] * rs);
        }
      } else {
#pragma unroll
        for (int i = 0; i < 32; i++) s.vb[(half * 32 + i) * QLD + c] = f2bf(val[i]);
      }
    }
  }
  __syncthreads();
  {
    const int l15 = lane & 15, g = lane >> 4;
    bf16x8 aq[4], ak[4];
#pragma unroll
    for (int ks = 0; ks < 4; ks++) {
      aq[ks] = *(const bf16x8*)&s.qb[(wave * 16 + l15) * QLD + ks * 32 + g * 8];
      ak[ks] = *(const bf16x8*)&s.kn[(wave * 16 + l15) * QLD + ks * 32 + g * 8];
    }
    u16* qkout = p.gqk + (size_t)unit * 4096;
#pragma unroll
    for (int ni = 0; ni < 4; ni++) {
      f32x4 ckk = {0.f, 0.f, 0.f, 0.f}, cqk = {0.f, 0.f, 0.f, 0.f};
      if (ni <= wave) {
#pragma unroll
        for (int ks = 0; ks < 4; ks++) {
          bf16x8 bk = *(const bf16x8*)&s.kn[(ni * 16 + l15) * QLD + ks * 32 + g * 8];
          ckk = mfma16(ak[ks], bk, ckk);
          cqk = mfma16(aq[ks], bk, cqk);
        }
      }
      const int j = ni * 16 + l15;
      const float gcj = s.gc[j];
#pragma unroll
      for (int r = 0; r < 4; r++) {
        const int i = wave * 16 + g * 4 + r;
        const float dec = (i >= j) ? __expf(s.gc[i] - gcj) : 0.f;
        s.Am[i * 64 + j] = (i > j) ? ckk[r] * s.beta[i] * dec : 0.f;
        qkout[i * 64 + j] = f2bf((i >= j) ? cqk[r] * dec : 0.f);
      }
    }
  }
  __syncthreads();
  {
    const int c = tid;
    const u16* src = (c < 128) ? &s.vb[c] : &s.kn[c - 128];
    const float* sc = (c < 128) ? s.beta : s.be;
    float xs[64];
#pragma unroll
    for (int i = 0; i < 64; i++) {
      float a0 = bf2f(src[i * QLD]) * sc[i], a1 = 0.f, a2 = 0.f, a3 = 0.f;
#pragma unroll
      for (int j4 = 0; j4 < (i + 3) / 4; j4++) {
        const float4 av = *(const float4*)&s.Am[i * 64 + j4 * 4];
        if (j4 * 4 + 0 < i) a0 -= av.x * xs[j4 * 4 + 0];
        if (j4 * 4 + 1 < i) a1 -= av.y * xs[j4 * 4 + 1];
        if (j4 * 4 + 2 < i) a2 -= av.z * xs[j4 * 4 + 2];
        if (j4 * 4 + 3 < i) a3 -= av.w * xs[j4 * 4 + 3];
      }
      xs[i] = (a0 + a1) + (a2 + a3);
    }
    if (c < 128) {
      float* dst = p.guT + ((size_t)unit * 128 + c) * 64;
#pragma unroll
      for (int i = 0; i < 16; i++) *(float4*)&dst[i * 4] = make_float4(xs[i * 4], xs[i * 4 + 1], xs[i * 4 + 2], xs[i * 4 + 3]);
    } else {
      u16* dst = p.gw + (size_t)unit * 8192 + (c - 128);
#pragma unroll
      for (int i = 0; i < 64; i++) dst[i * 128] = f2bf(xs[i]);
    }
  }
  {
    u16* qg = p.gqg + (size_t)unit * 8192;
#pragma unroll
    for (int it = 0; it < 4; it++) {
      const int idx = tid + 256 * it;
      const int i = idx >> 4, d8 = (idx & 15) * 8;
      const float e = __expf(s.gc[i]);
      uint4 raw = *(const uint4*)&s.qb[i * QLD + d8];
      unsigned rw[4] = {raw.x, raw.y, raw.z, raw.w};
      unsigned ow[4];
#pragma unroll
      for (int q = 0; q < 4; q++) {
        float lo = bf2f((u16)(rw[q] & 0xffffu)) * e, hi = bf2f((u16)(rw[q] >> 16)) * e;
        ow[q] = pack2(lo, hi);
      }
      *(uint4*)&qg[i * 128 + d8] = make_uint4(ow[0], ow[1], ow[2], ow[3]);
    }
    const int d = tid & 127, half = tid >> 7;
    const float glast = s.gc[63];
    u16* kd = p.gkdT + (size_t)unit * 8192 + d * 64 + half * 32;
#pragma unroll
    for (int q = 0; q < 4; q++) {
      unsigned ow[4];
#pragma unroll
      for (int e2 = 0; e2 < 4; e2++) {
        const int c0 = half * 32 + q * 8 + e2 * 2;
        float v0 = bf2f(s.kn[c0 * QLD + d]) * __expf(glast - s.gc[c0]);
        float v1 = bf2f(s.kn[(c0 + 1) * QLD + d]) * __expf(glast - s.gc[c0 + 1]);
        ow[e2] = pack2(v0, v1);
      }
      *(uint4*)&kd[q * 8] = make_uint4(ow[0], ow[1], ow[2], ow[3]);
    }
    if (tid == 0) p.gdl[unit] = __expf(glast);
  }
}

__device__ void fox_cumsum_unit(const P& p, int bhf, float* red) {
  const int tid = threadIdx.x, lane = tid & 63, wave = tid >> 6;
  const int b = bhf >> 3, hf = bhf & 7;
  const float bias = p.fox_f_bias[hf];
  float v[8];
  float run = 0.f;
#pragma unroll
  for (int i = 0; i < 8; i++) {
    const int t = b * SEQ + tid * 8 + i;
    const float xx = p.gates[(size_t)t * 16 + 8 + hf] + bias;
    const float ls = fminf(xx, 0.f) - log1pf(__expf(-fabsf(xx)));
    run += ls;
    v[i] = run;
  }
  float tot = run;
#pragma unroll
  for (int off = 1; off < 64; off <<= 1) {
    float nb = __shfl_up(tot, off);
    if (lane >= off) tot += nb;
  }
  __syncthreads();
  if (lane == 63) red[wave] = tot;
  __syncthreads();
  float base = tot - run;
  for (int w = 0; w < wave; w++) base += red[w];
#pragma unroll
  for (int i = 0; i < 8; i++) p.cf[(size_t)bhf * SEQ + tid * 8 + i] = v[i] + base;
}

__device__ void phase_gdnprep(const P& p, unsigned char* smem) {
  GdnSmem& s = *(GdnSmem*)smem;
  for (int u = blockIdx.x; u < 1024 + 64; u += gridDim.x) {
    if (u < 1024) gdn_unit(p, u, s);
    else { __syncthreads(); fox_cumsum_unit(p, u - 1024, (float*)smem); }
  }
}

#define SLD 136
#define VLD 72
struct ScanSmem {
  u16 st[4][32 * SLD];
  u16 vn[4][32 * VLD];
  float ssq[2][4][64];
  u16 ob[64 * 136];
};
#define OLD 136

__device__ void scan_unit(const P& p, int bh, ScanSmem& s) {
  const int tid = threadIdx.x, lane = tid & 63, w = tid >> 6;
  const int l15 = lane & 15, g = lane >> 4;
  const int b = bh >> 2, h = bh & 3;
  u16* St = s.st[w];
  u16* Vn = s.vn[w];
  f32x4 st[8][2];
#pragma unroll
  for (int md = 0; md < 8; md++)
#pragma unroll
    for (int ne = 0; ne < 2; ne++) st[md][ne] = (f32x4){0.f, 0.f, 0.f, 0.f};
  float gnw[2];
#pragma unroll
  for (int ne = 0; ne < 2; ne++) gnw[ne] = p.gdn_norm_w[32 * w + 16 * ne + l15];

#pragma unroll 1
  for (int n = 0; n < 32; n++) {
    const int unit = bh * 32 + n;
    const u16* gw = p.gw + (size_t)unit * 8192;
    const u16* gqg = p.gqg + (size_t)unit * 8192;
    const u16* gkd = p.gkdT + (size_t)unit * 8192;
    const u16* gqk = p.gqk + (size_t)unit * 4096;
    const float* guT = p.guT + (size_t)unit * 8192;
    const float dl = p.gdl[unit];
    int la = l15 * 128 + g * 8, lb = l15 * 64 + g * 8, lu = (32 * w + l15) * 64 + 4 * g;
    asm volatile("" : "+v"(la), "+v"(lb), "+v"(lu));
    asm volatile("; MARK1" ::: "memory");
#pragma unroll
    for (int md = 0; md < 8; md++)
#pragma unroll
      for (int ne = 0; ne < 2; ne++) {
        uint2 o; o.x = pack2(st[md][ne][0], st[md][ne][1]); o.y = pack2(st[md][ne][2], st[md][ne][3]);
        *(uint2*)&St[(16 * ne + l15) * SLD + 16 * md + 4 * g] = o;
      }
    LDS_FENCE();
    asm volatile("; MARK2" ::: "memory");
#pragma unroll
    for (int mc = 0; mc < 4; mc++) {
      asm volatile("" ::: "memory");
      bf16x8 aw[4];
#pragma unroll
      for (int ks = 0; ks < 4; ks++) aw[ks] = *(const bf16x8*)&gw[la + (16 * mc) * 128 + ks * 32];
#pragma unroll
      for (int ne = 0; ne < 2; ne++) {
        f32x4 acc = {0.f, 0.f, 0.f, 0.f};
#pragma unroll
        for (int ks = 0; ks < 4; ks++) {
          bf16x8 bs = *(const bf16x8*)&St[(16 * ne + l15) * SLD + ks * 32 + g * 8];
          acc = mfma16(aw[ks], bs, acc);
        }
        const float4 u4 = *(const float4*)&guT[lu + (16 * ne) * 64 + 16 * mc];
        uint2 o; o.x = pack2(u4.x - acc[0], u4.y - acc[1]); o.y = pack2(u4.z - acc[2], u4.w - acc[3]);
        *(uint2*)&Vn[(16 * ne + l15) * VLD + 16 * mc + 4 * g] = o;
      }
    }
    LDS_FENCE();
    asm volatile("; MARK4" ::: "memory");
#pragma unroll
    for (int md = 0; md < 8; md++) {
      if ((md & 1) == 0) asm volatile("" ::: "memory");
      bf16x8 akd[2];
#pragma unroll
      for (int ks = 0; ks < 2; ks++) akd[ks] = *(const bf16x8*)&gkd[lb + (16 * md) * 64 + ks * 32];
#pragma unroll
      for (int ne = 0; ne < 2; ne++) {
        f32x4 acc = st[md][ne] * dl;
#pragma unroll
        for (int ks = 0; ks < 2; ks++) {
          bf16x8 bv = *(const bf16x8*)&Vn[(16 * ne + l15) * VLD + ks * 32 + g * 8];
          acc = mfma16(akd[ks], bv, acc);
        }
        st[md][ne] = acc;
      }
    }
    asm volatile("" ::: "memory");
    asm volatile("; MARK3" ::: "memory");
    f32x4 o[4][2];
    float ssr[4][4];
#pragma unroll
    for (int mc = 0; mc < 4; mc++) {
      asm volatile("" ::: "memory");
      bf16x8 aq[4], ak[2];
#pragma unroll
      for (int ks = 0; ks < 4; ks++) aq[ks] = *(const bf16x8*)&gqg[la + (16 * mc) * 128 + ks * 32];
#pragma unroll
      for (int ks = 0; ks < 2; ks++) ak[ks] = *(const bf16x8*)&gqk[lb + (16 * mc) * 64 + ks * 32];
#pragma unroll
      for (int ne = 0; ne < 2; ne++) {
        f32x4 acc = {0.f, 0.f, 0.f, 0.f};
#pragma unroll
        for (int ks = 0; ks < 4; ks++) {
          bf16x8 bs = *(const bf16x8*)&St[(16 * ne + l15) * SLD + ks * 32 + g * 8];
          acc = mfma16(aq[ks], bs, acc);
        }
#pragma unroll
        for (int ks = 0; ks < 2; ks++) {
          bf16x8 bv = *(const bf16x8*)&Vn[(16 * ne + l15) * VLD + ks * 32 + g * 8];
          acc = mfma16(ak[ks], bv, acc);
        }
        o[mc][ne] = acc;
      }
#pragma unroll
      for (int r = 0; r < 4; r++) {
        float sq = o[mc][0][r] * o[mc][0][r] + o[mc][1][r] * o[mc][1][r];
#pragma unroll
        for (int off = 1; off < 16; off <<= 1) sq += __shfl_xor(sq, off);
        ssr[mc][r] = sq;
      }
    }
    if (l15 == 0) {
#pragma unroll
      for (int mc = 0; mc < 4; mc++)
#pragma unroll
        for (int r = 0; r < 4; r++) s.ssq[n & 1][w][16 * mc + 4 * g + r] = ssr[mc][r];
    }
    __syncthreads();
#pragma unroll
    for (int mc = 0; mc < 4; mc++)
#pragma unroll
      for (int r = 0; r < 4; r++) {
        const int c = 16 * mc + 4 * g + r;
        const float tot = s.ssq[n & 1][0][c] + s.ssq[n & 1][1][c] + s.ssq[n & 1][2][c] + s.ssq[n & 1][3][c];
        const float rs = rsqrtf(tot * (1.f / 128.f) + EPSV);
#pragma unroll
        for (int ne = 0; ne < 2; ne++) s.ob[c * OLD + 32 * w + 16 * ne + l15] = f2bf(o[mc][ne][r] * rs * gnw[ne]);
      }
    __syncthreads();
    {
      const int t0 = b * SEQ + n * 64;
      const int c0 = tid >> 4, ch = tid & 15;
      const u16* zp = p.proj + (size_t)(t0 + c0) * PROJW + 1536 + h * 128 + ch * 8;
      u16* op = p.actA + (size_t)(t0 + c0) * DM + h * 128 + ch * 8;
#pragma unroll
      for (int i = 0; i < 4; i++) {
        const uint4 ov = *(const uint4*)&s.ob[(c0 + 16 * i) * OLD + ch * 8];
        const uint4 zv = *(const uint4*)(zp + (size_t)i * 16 * PROJW);
        const unsigned ow[4] = {ov.x, ov.y, ov.z, ov.w};
        const unsigned zw[4] = {zv.x, zv.y, zv.z, zv.w};
        unsigned rw[4];
#pragma unroll
        for (int q = 0; q < 4; q++) {
          const float lo = bf2f((u16)(ow[q] & 0xffffu)) * siluf(bf2f((u16)(zw[q] & 0xffffu)));
          const float hi = bf2f((u16)(ow[q] >> 16)) * siluf(bf2f((u16)(zw[q] >> 16)));
          rw[q] = pack2(lo, hi);
        }
        *(uint4*)(op + (size_t)i * 16 * DM) = make_uint4(rw[0], rw[1], rw[2], rw[3]);
      }
    }
  }
}

#define PLD 72
__device__ void attn_unit(const P& p, int item, u16* psm) {
  const int tid = threadIdx.x, lane = tid & 63, w = tid >> 6;
  const int l15 = lane & 15, g = lane >> 4;
  const int qb = 15 - (item >> 6), bhf = item & 63;
  const int b = bhf >> 3, hf = bhf & 7;
  const int q0 = qb * 128 + 32 * w;
  u16* Pw = psm + w * (32 * PLD);
  const u16* qbase = p.proj + (size_t)(b * SEQ) * PROJW + 2048 + hf * 64;
  const u16* kbase = p.proj + (size_t)(b * SEQ) * PROJW + 2560 + hf * 64;
  const u16* vbase = p.vt + (size_t)bhf * 64 * SEQ;
  const float* cfb = p.cf + (size_t)bhf * SEQ;
  bf16x8 qf[2][2];
#pragma unroll
  for (int mi = 0; mi < 2; mi++)
#pragma unroll
    for (int ks = 0; ks < 2; ks++) qf[mi][ks] = *(const bf16x8*)&qbase[(size_t)(q0 + 16 * mi + l15) * PROJW + ks * 32 + g * 8];
  float cq[2][4], m[2][4], lsum[2][4];
  f32x4 O[2][4];
#pragma unroll
  for (int mi = 0; mi < 2; mi++) {
#pragma unroll
    for (int r = 0; r < 4; r++) { cq[mi][r] = cfb[q0 + 16 * mi + 4 * g + r]; m[mi][r] = -1e30f; lsum[mi][r] = 0.f; }
#pragma unroll
    for (int nd = 0; nd < 4; nd++) O[mi][nd] = (f32x4){0.f, 0.f, 0.f, 0.f};
  }
  const int ntile = (q0 + 32 + 63) >> 6;
#pragma unroll 1
  for (int kt = 0; kt < ntile; kt++) {
    const int k0 = kt * 64;
    f32x4 S[2][4];
#pragma unroll
    for (int ni = 0; ni < 4; ni++) {
      bf16x8 kf0 = *(const bf16x8*)&kbase[(size_t)(k0 + 16 * ni + l15) * PROJW + g * 8];
      bf16x8 kf1 = *(const bf16x8*)&kbase[(size_t)(k0 + 16 * ni + l15) * PROJW + 32 + g * 8];
#pragma unroll
      for (int mi = 0; mi < 2; mi++) {
        f32x4 acc = {0.f, 0.f, 0.f, 0.f};
        acc = mfma16(qf[mi][0], kf0, acc);
        acc = mfma16(qf[mi][1], kf1, acc);
        S[mi][ni] = acc;
      }
    }
    float ck[4];
#pragma unroll
    for (int ni = 0; ni < 4; ni++) ck[ni] = cfb[k0 + 16 * ni + l15];
#pragma unroll
    for (int mi = 0; mi < 2; mi++)
#pragma unroll
      for (int r = 0; r < 4; r++) {
        const int qpos = q0 + 16 * mi + 4 * g + r;
        float mx = -1e30f;
#pragma unroll
        for (int ni = 0; ni < 4; ni++) {
          const int kpos = k0 + 16 * ni + l15;
          float lg = S[mi][ni][r] * 0.125f + cq[mi][r] - ck[ni];
          lg = (kpos <= qpos) ? lg : -1e30f;
          S[mi][ni][r] = lg;
          mx = fmaxf(mx, lg);
        }
#pragma unroll
        for (int off = 1; off < 16; off <<= 1) mx = fmaxf(mx, __shfl_xor(mx, off));
        const float mn = fmaxf(m[mi][r], mx);
        const float alpha = __expf(m[mi][r] - mn);
        m[mi][r] = mn;
        float ps = 0.f;
#pragma unroll
        for (int ni = 0; ni < 4; ni++) {
          const float pe = __expf(S[mi][ni][r] - mn);
          ps += pe;
          Pw[(16 * mi + 4 * g + r) * PLD + 16 * ni + l15] = f2bf(pe);
        }
        lsum[mi][r] = lsum[mi][r] * alpha + ps;
#pragma unroll
        for (int nd = 0; nd < 4; nd++) O[mi][nd][r] *= alpha;
      }
    LDS_FENCE();
    bf16x8 pf[2][2];
#pragma unroll
    for (int mi = 0; mi < 2; mi++)
#pragma unroll
      for (int ks = 0; ks < 2; ks++) pf[mi][ks] = *(const bf16x8*)&Pw[(16 * mi + l15) * PLD + ks * 32 + g * 8];
#pragma unroll
    for (int nd = 0; nd < 4; nd++) {
      bf16x8 vf0 = *(const bf16x8*)&vbase[(size_t)(16 * nd + l15) * SEQ + k0 + g * 8];
      bf16x8 vf1 = *(const bf16x8*)&vbase[(size_t)(16 * nd + l15) * SEQ + k0 + 32 + g * 8];
#pragma unroll
      for (int mi = 0; mi < 2; mi++) {
        O[mi][nd] = mfma16(pf[mi][0], vf0, O[mi][nd]);
        O[mi][nd] = mfma16(pf[mi][1], vf1, O[mi][nd]);
      }
    }
    LDS_FENCE();
  }
#pragma unroll
  for (int mi = 0; mi < 2; mi++)
#pragma unroll
    for (int r = 0; r < 4; r++) {
      float l = lsum[mi][r];
#pragma unroll
      for (int off = 1; off < 16; off <<= 1) l += __shfl_xor(l, off);
      const float inv = 1.f / l;
      const int t = b * SEQ + q0 + 16 * mi + 4 * g + r;
#pragma unroll
      for (int nd = 0; nd < 4; nd++) p.actA[(size_t)t * DM + 512 + hf * 64 + 16 * nd + l15] = f2bf(O[mi][nd][r] * inv);
    }
}

__device__ void phase_mixer(const P& p, unsigned char* smem) {
  __shared__ int s_item;
  for (;;) {
    __syncthreads();
    if (threadIdx.x == 0) s_item = (int)atomicAdd(&p.counters[0], 1u);
    __syncthreads();
    const int item = s_item;
    if (item >= 32 + 1024) break;
#ifndef NO_SCAN
    if (item < 32) scan_unit(p, item, *(ScanSmem*)smem);
#endif
#ifndef NO_ATTN
    if (item >= 32) attn_unit(p, item - 32, (u16*)smem);
#endif
  }
}

__global__ void __launch_bounds__(256, 2) mega(P p, int lo, int hi) {
  __shared__ __attribute__((aligned(16))) unsigned char smem[sizeof(GemmSmem)];
  cg::grid_group grid = cg::this_grid();
#if !defined(ONLY) || ONLY == 0
  if (lo <= 0 && 0 < hi) { phase_prep(p, smem); }
#endif
  if (lo <= 0 && 1 < hi) grid.sync();
#if !defined(ONLY) || ONLY == 1
  if (lo <= 1 && 1 < hi) { phase_inproj(p, smem); }
#endif
  if (lo <= 1 && 2 < hi) grid.sync();
#if !defined(ONLY) || ONLY == 2
  if (lo <= 2 && 2 < hi) { phase_gdnprep(p, smem); }
#endif
  if (lo <= 2 && 3 < hi) grid.sync();
#if !defined(ONLY) || ONLY == 3
  if (lo <= 3 && 3 < hi) { phase_mixer(p, smem); }
#endif
  if (lo <= 3 && 4 < hi) grid.sync();
#if !defined(ONLY) || ONLY == 4
  if (lo <= 4 && 4 < hi) { phase_outproj(p, smem); }
#endif
  if (lo <= 4 && 5 < hi) grid.sync();
#if !defined(ONLY) || ONLY == 5
  if (lo <= 5 && 5 < hi) { phase_rmsnorm(p.h, p.ffn_norm_w, p.actA, nullptr); }
#endif
  if (lo <= 5 && 6 < hi) grid.sync();
#if !defined(ONLY) || ONLY == 6
  if (lo <= 6 && 6 < hi) { phase_gateup(p, smem); }
#endif
  if (lo <= 6 && 7 < hi) grid.sync();
#if !defined(ONLY) || ONLY == 7
  if (lo <= 7 && 7 < hi) { phase_down(p, smem); }
#endif
  if (lo <= 7 && 8 < hi) grid.sync();
#if !defined(ONLY) || ONLY == 8
  if (lo <= 8 && 8 < hi) { phase_rmsnorm(p.h, p.ple_norm_w, p.actA, nullptr); }
#endif
  if (lo <= 8 && 9 < hi) grid.sync();
#if !defined(ONLY) || ONLY == 9
  if (lo <= 9 && 9 < hi) { phase_ple(p, smem); }
#endif
  if (lo <= 9 && 10 < hi) grid.sync();
#if !defined(ONLY) || ONLY == 10
  if (lo <= 10 && 10 < hi) { phase_rmsnorm(p.h, p.final_norm_w, nullptr, p.h); }
#endif
}

static_assert(sizeof(GdnSmem) <= sizeof(GemmSmem), "smem");
static_assert(sizeof(ScanSmem) <= sizeof(GemmSmem), "smem");

extern "C" void kernel_launch(void* const* d_in, const int* in_sizes, int n_in, void* d_out, int out_size,
                              void* d_ws, size_t ws_size, hipStream_t stream) {
  static int grid_blocks = 0;
  if (!grid_blocks) {
    int dev = 0, cus = 0, per_cu = 0;
    hipGetDevice(&dev);
    hipDeviceGetAttribute(&cus, hipDeviceAttributeMultiprocessorCount, dev);
    hipOccupancyMaxActiveBlocksPerMultiprocessor(&per_cu, mega, 256, 0);
    if (per_cu > 2) per_cu = 2;
    if (per_cu < 1) per_cu = 1;
    grid_blocks = cus * per_cu;
  }
  P p{};
  const float* const* in = (const float* const*)d_in;
  p.x = in[0]; p.p = in[1]; p.attn_norm_w = in[2]; p.w_in = in[3]; p.conv_w = in[4]; p.a_log = in[5];
  p.dt_bias = in[6]; p.gdn_norm_w = in[7]; p.fox_f_bias = in[8]; p.w_out = in[9]; p.ffn_norm_w = in[10];
  p.w_gate_up = in[11]; p.w_down = in[12]; p.ple_norm_w = in[13]; p.w_ple_gate = in[14]; p.w_ple_proj = in[15];
  p.final_norm_w = in[16];
  p.h = (float*)d_out;
  unsigned char* ws = (unsigned char*)d_ws;
  size_t off = 0;
  auto take = [&](size_t bytes) { unsigned char* r = ws + off; off += (bytes + 255) & ~(size_t)255; return r; };
  p.counters = (unsigned*)take(256);
  p.wt_in = (u16*)take((size_t)NIN_PAD * 1024 * 2);
  p.wt_out = (u16*)take((size_t)1024 * 1024 * 2);
  p.wt_gu = (u16*)take((size_t)2 * DFF * 1024 * 2);
  p.wt_down = (u16*)take((size_t)1024 * DFF * 2);
  p.wt_pg = (u16*)take((size_t)1024 * 1024 * 2);
  p.wt_pp = (u16*)take((size_t)1024 * 256 * 2);
  p.actA = (u16*)take((size_t)NTOK * 1024 * 2);
  p.pb = (u16*)take((size_t)NTOK * 256 * 2);
  p.proj = (u16*)take((size_t)NTOK * PROJW * 2);
  p.vt = (u16*)take((size_t)64 * 64 * SEQ * 2);
  p.gates = (float*)take((size_t)NTOK * 16 * 4);
  p.cf = (float*)take((size_t)64 * SEQ * 4);
  p.guT = (float*)take((size_t)1024 * 8192 * 4);
  p.gdl = (float*)take(1024 * 4);
  if (off > ws_size) fprintf(stderr, "workspace too small: need %zu have %zu\n", off, ws_size);
  u16* ob = (u16*)d_out;
  p.gw = ob;
  p.gqg = ob + (size_t)1024 * 8192;
  p.gkdT = ob + (size_t)2 * 1024 * 8192;
  p.gqk = ob + (size_t)3 * 1024 * 8192;
  int lo = 0, hi = NPHASE;
  void* args[] = {&p, &lo, &hi};
  hipError_t e = hipLaunchCooperativeKernel((void*)mega, dim3(grid_blocks), dim3(256), args, 0, stream);
  if (e != hipSuccess) fprintf(stderr, "cooperative launch failed: %s (grid %d)\n", hipGetErrorString(e), grid_blocks);
}
```

```cpp
#include <hip/hip_runtime.h>
#include <hip/hip_cooperative_groups.h>
#include <cstdio>
#include <cstdint>
namespace cg = cooperative_groups;

typedef unsigned short u16;
typedef __attribute__((ext_vector_type(8))) short bf16x8;
typedef __attribute__((ext_vector_type(4))) float f32x4;

#define NTOK 16384
#define SEQ 2048
#define DM 1024
#define DFF 2816
#define PROJW 3072
#define NIN_PAD 3712
#define EPSV 1e-6f
#define NPHASE 11

struct P {
  const float *x, *p, *attn_norm_w, *w_in, *conv_w, *a_log, *dt_bias, *gdn_norm_w, *fox_f_bias, *w_out,
      *ffn_norm_w, *w_gate_up, *w_down, *ple_norm_w, *w_ple_gate, *w_ple_proj, *final_norm_w;
  float* h;
  u16 *wt_in, *wt_out, *wt_gu, *wt_down, *wt_pg, *wt_pp;
  u16 *actA;
  u16 *pb;
  u16 *proj;
  u16 *vt;
  float *gates;
  float *cf;
  u16 *gw, *gqg, *gkdT, *gqk;
  float *guT;
  float *gdl;
  unsigned *counters;
  unsigned *bar;
};

__device__ __forceinline__ u16 f2bf(float f) {
  unsigned u = __float_as_uint(f);
  u += 0x7fffu + ((u >> 16) & 1u);
  return (u16)(u >> 16);
}
__device__ __forceinline__ float bf2f(u16 h) { return __uint_as_float(((unsigned)h) << 16); }
__device__ __forceinline__ unsigned pack2(float a, float b) { return (unsigned)f2bf(a) | (((unsigned)f2bf(b)) << 16); }
__device__ __forceinline__ float siluf(float v) { return v / (1.f + __expf(-v)); }
__device__ __forceinline__ float sigmoidf_(float v) { return 1.f / (1.f + __expf(-v)); }
__device__ __forceinline__ f32x4 mfma16(bf16x8 a, bf16x8 b, f32x4 c) {
  return __builtin_amdgcn_mfma_f32_16x16x32_bf16(a, b, c, 0, 0, 0);
}
#define LDS_FENCE() asm volatile("s_waitcnt lgkmcnt(0)" ::: "memory")

__device__ __forceinline__ int colmap(int kind, int nn) {
  if (kind == 0) {
    if (nn < 2048) return nn;
    if (nn < 3584) return nn + 8;
    if (nn < 3588) return 2048 + (nn - 3584);
    if (nn < 3592) return 2052 + (nn - 3588);
    if (nn < 3600) return nn;
    return -1;
  } else if (kind == 2) {
    int i = nn >> 7, wc = (nn >> 6) & 1, u = (nn >> 5) & 1, j = nn & 31;
    return u * DFF + 64 * i + 32 * wc + j;
  }
  return nn;
}

__device__ void transpose_item(const float* __restrict__ src, int ldsrc, u16* __restrict__ dst, int K,
                               int kt, int nt, int kind, float* tile) {
  const int tid = threadIdx.x;
  const int c = tid & 63, r0 = tid >> 6;
  const int ncol = colmap(kind, nt * 64 + c);
#pragma unroll 4
  for (int i = 0; i < 16; i++) {
    int r = r0 + 4 * i;
    float v = (ncol >= 0) ? src[(size_t)(kt * 64 + r) * ldsrc + ncol] : 0.f;
    tile[r * 65 + c] = v;
  }
  __syncthreads();
#pragma unroll 4
  for (int i = 0; i < 16; i++) {
    int rn = r0 + 4 * i;
    dst[(size_t)(nt * 64 + rn) * K + kt * 64 + c] = f2bf(tile[c * 65 + rn]);
  }
  __syncthreads();
}

__device__ __forceinline__ void rmsnorm_row(const float* src, const float* __restrict__ w,
                                            u16* dstb, float* dstf, int row) {
  const int lane = threadIdx.x & 63;
  float4 v[4];
  float ss = 0.f;
#pragma unroll
  for (int i = 0; i < 4; i++) {
    v[i] = *(const float4*)&src[(size_t)row * DM + i * 256 + lane * 4];
    ss += v[i].x * v[i].x + v[i].y * v[i].y + v[i].z * v[i].z + v[i].w * v[i].w;
  }
#pragma unroll
  for (int off = 32; off >= 1; off >>= 1) ss += __shfl_xor(ss, off);
  const float r = rsqrtf(ss * (1.f / DM) + EPSV);
#pragma unroll
  for (int i = 0; i < 4; i++) {
    const int col = i * 256 + lane * 4;
    float4 wv = *(const float4*)&w[col];
    float y0 = v[i].x * r * wv.x, y1 = v[i].y * r * wv.y, y2 = v[i].z * r * wv.z, y3 = v[i].w * r * wv.w;
    if (dstb) {
      uint2 o; o.x = pack2(y0, y1); o.y = pack2(y2, y3);
      *(uint2*)&dstb[(size_t)row * DM + col] = o;
    } else {
      *(float4*)&dstf[(size_t)row * DM + col] = make_float4(y0, y1, y2, y3);
    }
  }
}

__device__ void phase_prep(const P& p, unsigned char* smem) {
  float* tile = (float*)smem;
  if (blockIdx.x == 0 && threadIdx.x < 16) p.counters[threadIdx.x] = 0u;
  const int n0 = 16 * 58, n1 = n0 + 16 * 16, n2 = n1 + 16 * 88, n3 = n2 + 44 * 16, n4 = n3 + 16 * 16, n5 = n4 + 4 * 16;
  for (int it = blockIdx.x; it < n5; it += gridDim.x) {
    if (it < n0) { int kt = it % 16, nt = it / 16; transpose_item(p.w_in, 3600, p.wt_in, 1024, kt, nt, 0, tile); }
    else if (it < n1) { int j = it - n0; transpose_item(p.w_out, 1024, p.wt_out, 1024, j % 16, j / 16, 1, tile); }
    else if (it < n2) { int j = it - n1; transpose_item(p.w_gate_up, 2 * DFF, p.wt_gu, 1024, j % 16, j / 16, 2, tile); }
    else if (it < n3) { int j = it - n2; transpose_item(p.w_down, 1024, p.wt_down, DFF, j % 44, j / 44, 1, tile); }
    else if (it < n4) { int j = it - n3; transpose_item(p.w_ple_gate, 1024, p.wt_pg, 1024, j % 16, j / 16, 1, tile); }
    else { int j = it - n4; transpose_item(p.w_ple_proj, 1024, p.wt_pp, 256, j % 4, j / 4, 1, tile); }
  }
  const int wave = threadIdx.x >> 6, lane = threadIdx.x & 63;
  for (int rb = blockIdx.x; rb < NTOK / 4; rb += gridDim.x) {
    const int row = rb * 4 + wave;
    rmsnorm_row(p.x, p.attn_norm_w, p.actA, nullptr, row);
    float4 pv = *(const float4*)&p.p[(size_t)row * 256 + lane * 4];
    uint2 o; o.x = pack2(pv.x, pv.y); o.y = pack2(pv.z, pv.w);
    *(uint2*)&p.pb[(size_t)row * 256 + lane * 4] = o;
  }
}

__device__ void phase_rmsnorm(const float* src, const float* w, u16* dstb, float* dstf) {
  const int wave = threadIdx.x >> 6;
  for (int rb = blockIdx.x; rb < NTOK / 4; rb += gridDim.x) rmsnorm_row(src, w, dstb, dstf, rb * 4 + wave);
}

#define GK 64
#define GLD 72
struct GemmSmem { u16 a[2][128 * GLD]; u16 b[2][128 * GLD]; };

__device__ __forceinline__ void gemm_tile(const u16* __restrict__ A, int lda, const u16* __restrict__ Bt, int ldb,
                                          int K, int m0, int n0, GemmSmem& s, f32x4 (&acc)[4][4]) {
  const int tid = threadIdx.x, lane = tid & 63, wave = tid >> 6;
  const int wr = wave >> 1, wc = wave & 1;
  const int l15 = lane & 15, g = lane >> 4;
  const int nk = K / GK;
  uint4 ra0, ra1, ra2, ra3, rb0, rb1, rb2, rb3;
  const int crow = tid >> 3, ccol = (tid & 7) * 8;
  const u16* Ap = A + (size_t)(m0 + crow) * lda + ccol;
  const u16* Bp = Bt + (size_t)(n0 + crow) * ldb + ccol;
  const size_t sa = (size_t)32 * lda, sb = (size_t)32 * ldb;
#define G_LOAD(koff) \
  ra0 = *(const uint4*)(Ap + (koff)); ra1 = *(const uint4*)(Ap + sa + (koff)); \
  ra2 = *(const uint4*)(Ap + 2 * sa + (koff)); ra3 = *(const uint4*)(Ap + 3 * sa + (koff)); \
  rb0 = *(const uint4*)(Bp + (koff)); rb1 = *(const uint4*)(Bp + sb + (koff)); \
  rb2 = *(const uint4*)(Bp + 2 * sb + (koff)); rb3 = *(const uint4*)(Bp + 3 * sb + (koff));
#define G_STORE(bufi) \
  *(uint4*)&s.a[bufi][(crow) * GLD + ccol] = ra0; *(uint4*)&s.a[bufi][(crow + 32) * GLD + ccol] = ra1; \
  *(uint4*)&s.a[bufi][(crow + 64) * GLD + ccol] = ra2; *(uint4*)&s.a[bufi][(crow + 96) * GLD + ccol] = ra3; \
  *(uint4*)&s.b[bufi][(crow) * GLD + ccol] = rb0; *(uint4*)&s.b[bufi][(crow + 32) * GLD + ccol] = rb1; \
  *(uint4*)&s.b[bufi][(crow + 64) * GLD + ccol] = rb2; *(uint4*)&s.b[bufi][(crow + 96) * GLD + ccol] = rb3;
  G_LOAD(0)
  __syncthreads();
  G_STORE(0)
  __syncthreads();
  for (int kt = 0; kt < nk; kt++) {
    const int buf = kt & 1;
    if (kt + 1 < nk) { G_LOAD((kt + 1) * GK) }
#pragma unroll
    for (int ks = 0; ks < 2; ks++) {
      bf16x8 af[4], bfr[4];
#pragma unroll
      for (int mi = 0; mi < 4; mi++) af[mi] = *(const bf16x8*)&s.a[buf][(wr * 64 + mi * 16 + l15) * GLD + ks * 32 + g * 8];
#pragma unroll
      for (int ni = 0; ni < 4; ni++) bfr[ni] = *(const bf16x8*)&s.b[buf][(wc * 64 + ni * 16 + l15) * GLD + ks * 32 + g * 8];
#pragma unroll
      for (int mi = 0; mi < 4; mi++)
#pragma unroll
        for (int ni = 0; ni < 4; ni++) acc[mi][ni] = mfma16(af[mi], bfr[ni], acc[mi][ni]);
    }
    if (kt + 1 < nk) {
      if (buf) { G_STORE(0) } else { G_STORE(1) }
    }
    __syncthreads();
  }
}

#define ZERO_ACC(acc) _Pragma("unroll") for (int _i = 0; _i < 4; _i++) _Pragma("unroll") for (int _j = 0; _j < 4; _j++) acc[_i][_j] = (f32x4){0.f, 0.f, 0.f, 0.f};

__device__ void phase_inproj(const P& p, unsigned char* smem) {
  GemmSmem& s = *(GemmSmem*)smem;
  const int lane = threadIdx.x & 63, wave = threadIdx.x >> 6, wr = wave >> 1, wc = wave & 1, l15 = lane & 15, g = lane >> 4;
  const int ntiles = 128 * 29;
  for (int tl = blockIdx.x; tl < ntiles; tl += gridDim.x) {
    const int mt = tl & 127, nt = tl >> 7;
    const int m0 = mt * 128, n0 = nt * 128;
    f32x4 acc[4][4];
    ZERO_ACC(acc);
    gemm_tile(p.actA, DM, p.wt_in, DM, DM, m0, n0, s, acc);
#pragma unroll
    for (int mi = 0; mi < 4; mi++)
#pragma unroll
      for (int ni = 0; ni < 4; ni++) {
        const int rowb = m0 + wr * 64 + mi * 16 + g * 4;
        const int col = n0 + wc * 64 + ni * 16 + l15;
        if (nt < 24) {
#pragma unroll
          for (int r = 0; r < 4; r++) p.proj[(size_t)(rowb + r) * PROJW + col] = f2bf(acc[mi][ni][r]);
        } else if (nt < 28) {
          const int cc = col - 3072, hh = cc >> 6, d = cc & 63;
          const int b = rowb >> 11, sq = rowb & 2047;
          uint2 o; o.x = pack2(acc[mi][ni][0], acc[mi][ni][1]); o.y = pack2(acc[mi][ni][2], acc[mi][ni][3]);
          *(uint2*)&p.vt[((size_t)((b * 8 + hh) * 64 + d)) * SEQ + sq] = o;
        } else {
          if (col < 3600) {
#pragma unroll
            for (int r = 0; r < 4; r++) p.gates[(size_t)(rowb + r) * 16 + (col - 3584)] = acc[mi][ni][r];
          }
        }
      }
  }
}

__device__ void phase_outproj(const P& p, unsigned char* smem) {
  GemmSmem& s = *(GemmSmem*)smem;
  const int lane = threadIdx.x & 63, wave = threadIdx.x >> 6, wr = wave >> 1, wc = wave & 1, l15 = lane & 15, g = lane >> 4;
  for (int tl = blockIdx.x; tl < 128 * 8; tl += gridDim.x) {
    const int mt = tl & 127, nt = tl >> 7;
    const int m0 = mt * 128, n0 = nt * 128;
    f32x4 acc[4][4];
    ZERO_ACC(acc);
    gemm_tile(p.actA, DM, p.wt_out, DM, DM, m0, n0, s, acc);
#pragma unroll
    for (int mi = 0; mi < 4; mi++)
#pragma unroll
      for (int ni = 0; ni < 4; ni++) {
        const int rowb = m0 + wr * 64 + mi * 16 + g * 4;
        const int col = n0 + wc * 64 + ni * 16 + l15;
#pragma unroll
        for (int r = 0; r < 4; r++) {
          size_t idx = (size_t)(rowb + r) * DM + col;
          p.h[idx] = p.x[idx] + acc[mi][ni][r];
        }
      }
  }
}

__device__ void phase_gateup(const P& p, unsigned char* smem) {
  GemmSmem& s = *(GemmSmem*)smem;
  u16* act = p.proj;
  const int lane = threadIdx.x & 63, wave = threadIdx.x >> 6, wr = wave >> 1, wc = wave & 1, l15 = lane & 15, g = lane >> 4;
  for (int tl = blockIdx.x; tl < 128 * 44; tl += gridDim.x) {
    const int mt = tl & 127, nt = tl >> 7;
    const int m0 = mt * 128, n0 = nt * 128;
    f32x4 acc[4][4];
    ZERO_ACC(acc);
    gemm_tile(p.actA, DM, p.wt_gu, DM, DM, m0, n0, s, acc);
#pragma unroll
    for (int mi = 0; mi < 4; mi++)
#pragma unroll
      for (int ni = 0; ni < 2; ni++) {
        const int rowb = m0 + wr * 64 + mi * 16 + g * 4;
        const int col = 64 * nt + 32 * wc + 16 * ni + l15;
#pragma unroll
        for (int r = 0; r < 4; r++) {
          float gt = acc[mi][ni][r], up = acc[mi][ni + 2][r];
          act[(size_t)(rowb + r) * DFF + col] = f2bf(siluf(gt) * up);
        }
      }
  }
}

__device__ void phase_down(const P& p, unsigned char* smem) {
  GemmSmem& s = *(GemmSmem*)smem;
  const u16* act = p.proj;
  const int lane = threadIdx.x & 63, wave = threadIdx.x >> 6, wr = wave >> 1, wc = wave & 1, l15 = lane & 15, g = lane >> 4;
  for (int tl = blockIdx.x; tl < 128 * 8; tl += gridDim.x) {
    const int mt = tl & 127, nt = tl >> 7;
    const int m0 = mt * 128, n0 = nt * 128;
    f32x4 acc[4][4];
    ZERO_ACC(acc);
    gemm_tile(act, DFF, p.wt_down, DFF, DFF, m0, n0, s, acc);
#pragma unroll
    for (int mi = 0; mi < 4; mi++)
#pragma unroll
      for (int ni = 0; ni < 4; ni++) {
        const int rowb = m0 + wr * 64 + mi * 16 + g * 4;
        const int col = n0 + wc * 64 + ni * 16 + l15;
#pragma unroll
        for (int r = 0; r < 4; r++) {
          size_t idx = (size_t)(rowb + r) * DM + col;
          p.h[idx] += acc[mi][ni][r];
        }
      }
  }
}

__device__ void phase_ple(const P& p, unsigned char* smem) {
  GemmSmem& s = *(GemmSmem*)smem;
  const int lane = threadIdx.x & 63, wave = threadIdx.x >> 6, wr = wave >> 1, wc = wave & 1, l15 = lane & 15, g = lane >> 4;
  for (int tl = blockIdx.x; tl < 128 * 8; tl += gridDim.x) {
    const int mt = tl & 127, nt = tl >> 7;
    const int m0 = mt * 128, n0 = nt * 128;
    f32x4 acc[4][4], acc2[4][4];
    ZERO_ACC(acc);
    gemm_tile(p.actA, DM, p.wt_pg, DM, DM, m0, n0, s, acc);
#pragma unroll
    for (int mi = 0; mi < 4; mi++)
#pragma unroll
      for (int ni = 0; ni < 4; ni++)
#pragma unroll
        for (int r = 0; r < 4; r++) acc[mi][ni][r] = sigmoidf_(acc[mi][ni][r]);
    ZERO_ACC(acc2);
    gemm_tile(p.pb, 256, p.wt_pp, 256, 256, m0, n0, s, acc2);
#pragma unroll
    for (int mi = 0; mi < 4; mi++)
#pragma unroll
      for (int ni = 0; ni < 4; ni++) {
        const int rowb = m0 + wr * 64 + mi * 16 + g * 4;
        const int col = n0 + wc * 64 + ni * 16 + l15;
#pragma unroll
        for (int r = 0; r < 4; r++) {
          size_t idx = (size_t)(rowb + r) * DM + col;
          p.h[idx] += acc[mi][ni][r] * acc2[mi][ni][r];
        }
      }
  }
}

#define QLD 136
struct GdnSmem {
  u16 qb[64 * QLD];
  u16 kn[64 * QLD];
  u16 vb[64 * QLD];
  float Am[64 * 64];
  float gc[64], beta[64], be[64];
  float part[64 * 2];
};

__device__ void gdn_unit(const P& p, int unit, GdnSmem& s) {
  const int tid = threadIdx.x, lane = tid & 63, wave = tid >> 6;
  const int bh = unit >> 5, n = unit & 31;
  const int b = bh >> 2, h = bh & 3;
  const int tb = b * SEQ;
  const int s0 = n * 64;
  __syncthreads();
  if (wave == 0) {
    const int t = tb + s0 + lane;
    const float ga = p.gates[(size_t)t * 16 + h], gb = p.gates[(size_t)t * 16 + 4 + h];
    const float xx = ga + p.dt_bias[h];
    const float sp = (xx > 20.f) ? xx : log1pf(__expf(xx));
    float gg = -__expf(p.a_log[h]) * sp;
#pragma unroll
    for (int off = 1; off < 64; off <<= 1) {
      float nb = __shfl_up(gg, off);
      if (lane >= off) gg += nb;
    }
    const float bt = sigmoidf_(gb);
    s.gc[lane] = gg;
    s.beta[lane] = bt;
    s.be[lane] = bt * __expf(gg);
  }
  {
    const int c = tid & 127, half = tid >> 7;
#pragma unroll 1
    for (int mat = 0; mat < 3; mat++) {
      const int col = mat * 512 + h * 128 + c;
      const float cw0 = p.conv_w[col], cw1 = p.conv_w[1536 + col], cw2 = p.conv_w[2 * 1536 + col], cw3 = p.conv_w[3 * 1536 + col];
      const int sfirst = s0 + half * 32;
      float x0 = 0.f, x1 = 0.f, x2 = 0.f;
      if (sfirst >= 3) {
        x0 = bf2f(p.proj[(size_t)(tb + sfirst - 3) * PROJW + col]);
        x1 = bf2f(p.proj[(size_t)(tb + sfirst - 2) * PROJW + col]);
        x2 = bf2f(p.proj[(size_t)(tb + sfirst - 1) * PROJW + col]);
      }
      float val[32];
#pragma unroll
      for (int i = 0; i < 32; i++) {
        const float x3 = bf2f(p.proj[(size_t)(tb + sfirst + i) * PROJW + col]);
        const float cv = cw0 * x0 + cw1 * x1 + cw2 * x2 + cw3 * x3;
        val[i] = siluf(cv);
        x0 = x1; x1 = x2; x2 = x3;
      }
      if (mat < 2) {
        __syncthreads();
#pragma unroll
        for (int i = 0; i < 32; i++) {
          float sq = val[i] * val[i];
#pragma unroll
          for (int off = 32; off >= 1; off >>= 1) sq += __shfl_xor(sq, off);
          if (lane == 0) s.part[(half * 32 + i) * 2 + (wave & 1)] = sq;
        }
        __syncthreads();
        u16* dst = (mat == 0) ? s.qb : s.kn;
        const float extra = (mat == 0) ? 0.08838834764831845f : 1.f;
#pragma unroll
        for (int i = 0; i < 32; i++) {
          const int r = half * 32 + i;
          const float rs = rsqrtf(s.part[r * 2] + s.part[r * 2 + 1] + EPSV) * extra;
          dst[r * QLD + c] = f2bf(val[i] * rs);
        }
      } else {
#pragma unroll
        for (int i = 0; i < 32; i++) s.vb[(half * 32 + i) * QLD + c] = f2bf(val[i]);
      }
    }
  }
  __syncthreads();
  {
    const int l15 = lane & 15, g = lane >> 4;
    bf16x8 aq[4], ak[4];
#pragma unroll
    for (int ks = 0; ks < 4; ks++) {
      aq[ks] = *(const bf16x8*)&s.qb[(wave * 16 + l15) * QLD + ks * 32 + g * 8];
      ak[ks] = *(const bf16x8*)&s.kn[(wave * 16 + l15) * QLD + ks * 32 + g * 8];
    }
    u16* qkout = p.gqk + (size_t)unit * 4096;
#pragma unroll
    for (int ni = 0; ni < 4; ni++) {
      f32x4 ckk = {0.f, 0.f, 0.f, 0.f}, cqk = {0.f, 0.f, 0.f, 0.f};
      if (ni <= wave) {
#pragma unroll
        for (int ks = 0; ks < 4; ks++) {
          bf16x8 bk = *(const bf16x8*)&s.kn[(ni * 16 + l15) * QLD + ks * 32 + g * 8];
          ckk = mfma16(ak[ks], bk, ckk);
          cqk = mfma16(aq[ks], bk, cqk);
        }
      }
      const int j = ni * 16 + l15;
      const float gcj = s.gc[j];
#pragma unroll
      for (int r = 0; r < 4; r++) {
        const int i = wave * 16 + g * 4 + r;
        const float dec = (i >= j) ? __expf(s.gc[i] - gcj) : 0.f;
        s.Am[i * 64 + j] = (i > j) ? ckk[r] * s.beta[i] * dec : 0.f;
        qkout[i * 64 + j] = f2bf((i >= j) ? cqk[r] * dec : 0.f);
      }
    }
  }
  __syncthreads();
  {
    const int c = tid;
    const u16* src = (c < 128) ? &s.vb[c] : &s.kn[c - 128];
    const float* sc = (c < 128) ? s.beta : s.be;
    float xs[64];
#pragma unroll
    for (int i = 0; i < 64; i++) {
      float a0 = bf2f(src[i * QLD]) * sc[i], a1 = 0.f, a2 = 0.f, a3 = 0.f;
#pragma unroll
      for (int j4 = 0; j4 < (i + 3) / 4; j4++) {
        const float4 av = *(const float4*)&s.Am[i * 64 + j4 * 4];
        if (j4 * 4 + 0 < i) a0 -= av.x * xs[j4 * 4 + 0];
        if (j4 * 4 + 1 < i) a1 -= av.y * xs[j4 * 4 + 1];
        if (j4 * 4 + 2 < i) a2 -= av.z * xs[j4 * 4 + 2];
        if (j4 * 4 + 3 < i) a3 -= av.w * xs[j4 * 4 + 3];
      }
      xs[i] = (a0 + a1) + (a2 + a3);
    }
    if (c < 128) {
      float* dst = p.guT + ((size_t)unit * 128 + c) * 64;
#pragma unroll
      for (int i = 0; i < 16; i++) *(float4*)&dst[i * 4] = make_float4(xs[i * 4], xs[i * 4 + 1], xs[i * 4 + 2], xs[i * 4 + 3]);
    } else {
      u16* dst = p.gw + (size_t)unit * 8192 + (c - 128);
#pragma unroll
      for (int i = 0; i < 64; i++) dst[i * 128] = f2bf(xs[i]);
    }
  }
  {
    u16* qg = p.gqg + (size_t)unit * 8192;
#pragma unroll
    for (int it = 0; it < 4; it++) {
      const int idx = tid + 256 * it;
      const int i = idx >> 4, d8 = (idx & 15) * 8;
      const float e = __expf(s.gc[i]);
      uint4 raw = *(const uint4*)&s.qb[i * QLD + d8];
      unsigned rw[4] = {raw.x, raw.y, raw.z, raw.w};
      unsigned ow[4];
#pragma unroll
      for (int q = 0; q < 4; q++) {
        float lo = bf2f((u16)(rw[q] & 0xffffu)) * e, hi = bf2f((u16)(rw[q] >> 16)) * e;
        ow[q] = pack2(lo, hi);
      }
      *(uint4*)&qg[i * 128 + d8] = make_uint4(ow[0], ow[1], ow[2], ow[3]);
    }
    const int d = tid & 127, half = tid >> 7;
    const float glast = s.gc[63];
    u16* kd = p.gkdT + (size_t)unit * 8192 + d * 64 + half * 32;
#pragma unroll
    for (int q = 0; q < 4; q++) {
      unsigned ow[4];
#pragma unroll
      for (int e2 = 0; e2 < 4; e2++) {
        const int c0 = half * 32 + q * 8 + e2 * 2;
        float v0 = bf2f(s.kn[c0 * QLD + d]) * __expf(glast - s.gc[c0]);
        float v1 = bf2f(s.kn[(c0 + 1) * QLD + d]) * __expf(glast - s.gc[c0 + 1]);
        ow[e2] = pack2(v0, v1);
      }
      *(uint4*)&kd[q * 8] = make_uint4(ow[0], ow[1], ow[2], ow[3]);
    }
    if (tid == 0) p.gdl[unit] = __expf(glast);
  }
}

__device__ void fox_cumsum_unit(const P& p, int bhf, float* red) {
  const int tid = threadIdx.x, lane = tid & 63, wave = tid >> 6;
  const int b = bhf >> 3, hf = bhf & 7;
  const float bias = p.fox_f_bias[hf];
  float v[8];
  float run = 0.f;
#pragma unroll
  for (int i = 0; i < 8; i++) {
    const int t = b * SEQ + tid * 8 + i;
    const float xx = p.gates[(size_t)t * 16 + 8 + hf] + bias;
    const float ls = fminf(xx, 0.f) - log1pf(__expf(-fabsf(xx)));
    run += ls;
    v[i] = run;
  }
  float tot = run;
#pragma unroll
  for (int off = 1; off < 64; off <<= 1) {
    float nb = __shfl_up(tot, off);
    if (lane >= off) tot += nb;
  }
  __syncthreads();
  if (lane == 63) red[wave] = tot;
  __syncthreads();
  float base = tot - run;
  for (int w = 0; w < wave; w++) base += red[w];
#pragma unroll
  for (int i = 0; i < 8; i++) p.cf[(size_t)bhf * SEQ + tid * 8 + i] = v[i] + base;
}

__device__ void phase_gdnprep(const P& p, unsigned char* smem) {
  GdnSmem& s = *(GdnSmem*)smem;
  for (int u = blockIdx.x; u < 1024 + 64; u += gridDim.x) {
    if (u < 1024) gdn_unit(p, u, s);
    else { __syncthreads(); fox_cumsum_unit(p, u - 1024, (float*)smem); }
  }
}

#define SLD 136
#define VLD 72
struct ScanSmem {
  u16 st[4][32 * SLD];
  u16 vn[4][32 * VLD];
  float ssq[2][4][64];
  u16 ob[64 * 136];
};
#define OLD 136

__device__ void scan_unit(const P& p, int bh, ScanSmem& s) {
  const int tid = threadIdx.x, lane = tid & 63, w = tid >> 6;
  const int l15 = lane & 15, g = lane >> 4;
  const int b = bh >> 2, h = bh & 3;
  u16* St = s.st[w];
  u16* Vn = s.vn[w];
  f32x4 st[8][2];
#pragma unroll
  for (int md = 0; md < 8; md++)
#pragma unroll
    for (int ne = 0; ne < 2; ne++) st[md][ne] = (f32x4){0.f, 0.f, 0.f, 0.f};
  float gnw[2];
#pragma unroll
  for (int ne = 0; ne < 2; ne++) gnw[ne] = p.gdn_norm_w[32 * w + 16 * ne + l15];

#pragma unroll 1
  for (int n = 0; n < 32; n++) {
    const int unit = bh * 32 + n;
    const u16* gw = p.gw + (size_t)unit * 8192;
    const u16* gqg = p.gqg + (size_t)unit * 8192;
    const u16* gkd = p.gkdT + (size_t)unit * 8192;
    const u16* gqk = p.gqk + (size_t)unit * 4096;
    const float* guT = p.guT + (size_t)unit * 8192;
    const float dl = p.gdl[unit];
    int la = l15 * 128 + g * 8, lb = l15 * 64 + g * 8, lu = (32 * w + l15) * 64 + 4 * g;
    asm volatile("" : "+v"(la), "+v"(lb), "+v"(lu));
    asm volatile("; MARK1" ::: "memory");
#pragma unroll
    for (int md = 0; md < 8; md++)
#pragma unroll
      for (int ne = 0; ne < 2; ne++) {
        uint2 o; o.x = pack2(st[md][ne][0], st[md][ne][1]); o.y = pack2(st[md][ne][2], st[md][ne][3]);
        *(uint2*)&St[(16 * ne + l15) * SLD + 16 * md + 4 * g] = o;
      }
    LDS_FENCE();
    asm volatile("; MARK2" ::: "memory");
#pragma unroll
    for (int mc = 0; mc < 4; mc++) {
      asm volatile("" ::: "memory");
      bf16x8 aw[4];
#pragma unroll
      for (int ks = 0; ks < 4; ks++) aw[ks] = *(const bf16x8*)&gw[la + (16 * mc) * 128 + ks * 32];
#pragma unroll
      for (int ne = 0; ne < 2; ne++) {
        f32x4 acc = {0.f, 0.f, 0.f, 0.f};
#pragma unroll
        for (int ks = 0; ks < 4; ks++) {
          bf16x8 bs = *(const bf16x8*)&St[(16 * ne + l15) * SLD + ks * 32 + g * 8];
          acc = mfma16(aw[ks], bs, acc);
        }
        const float4 u4 = *(const float4*)&guT[lu + (16 * ne) * 64 + 16 * mc];
        uint2 o; o.x = pack2(u4.x - acc[0], u4.y - acc[1]); o.y = pack2(u4.z - acc[2], u4.w - acc[3]);
        *(uint2*)&Vn[(16 * ne + l15) * VLD + 16 * mc + 4 * g] = o;
      }
    }
    LDS_FENCE();
    asm volatile("; MARK4" ::: "memory");
#pragma unroll
    for (int md = 0; md < 8; md++) {
      if ((md & 1) == 0) asm volatile("" ::: "memory");
      bf16x8 akd[2];
#pragma unroll
      for (int ks = 0; ks < 2; ks++) akd[ks] = *(const bf16x8*)&gkd[lb + (16 * md) * 64 + ks * 32];
#pragma unroll
      for (int ne = 0; ne < 2; ne++) {
        f32x4 acc = st[md][ne] * dl;
#pragma unroll
        for (int ks = 0; ks < 2; ks++) {
          bf16x8 bv = *(const bf16x8*)&Vn[(16 * ne + l15) * VLD + ks * 32 + g * 8];
          acc = mfma16(akd[ks], bv, acc);
        }
        st[md][ne] = acc;
      }
    }
    asm volatile("" ::: "memory");
    asm volatile("; MARK3" ::: "memory");
    f32x4 o[4][2];
    float ssr[4][4];
#pragma unroll
    for (int mc = 0; mc < 4; mc++) {
      asm volatile("" ::: "memory");
      bf16x8 aq[4], ak[2];
#pragma unroll
      for (int ks = 0; ks < 4; ks++) aq[ks] = *(const bf16x8*)&gqg[la + (16 * mc) * 128 + ks * 32];
#pragma unroll
      for (int ks = 0; ks < 2; ks++) ak[ks] = *(const bf16x8*)&gqk[lb + (16 * mc) * 64 + ks * 32];
#pragma unroll
      for (int ne = 0; ne < 2; ne++) {
        f32x4 acc = {0.f, 0.f, 0.f, 0.f};
#pragma unroll
        for (int ks = 0; ks < 4; ks++) {
          bf16x8 bs = *(const bf16x8*)&St[(16 * ne + l15) * SLD + ks * 32 + g * 8];
          acc = mfma16(aq[ks], bs, acc);
        }
#pragma unroll
        for (int ks = 0; ks < 2; ks++) {
          bf16x8 bv = *(const bf16x8*)&Vn[(16 * ne + l15) * VLD + ks * 32 + g * 8];
          acc = mfma16(ak[ks], bv, acc);
        }
        o[mc][ne] = acc;
      }
#pragma unroll
      for (int r = 0; r < 4; r++) {
        float sq = o[mc][0][r] * o[mc][0][r] + o[mc][1][r] * o[mc][1][r];
#pragma unroll
        for (int off = 1; off < 16; off <<= 1) sq += __shfl_xor(sq, off);
        ssr[mc][r] = sq;
      }
    }
    if (l15 == 0) {
#pragma unroll
      for (int mc = 0; mc < 4; mc++)
#pragma unroll
        for (int r = 0; r < 4; r++) s.ssq[n & 1][w][16 * mc + 4 * g + r] = ssr[mc][r];
    }
    __syncthreads();
#pragma unroll
    for (int mc = 0; mc < 4; mc++)
#pragma unroll
      for (int r = 0; r < 4; r++) {
        const int c = 16 * mc + 4 * g + r;
        const float tot = s.ssq[n & 1][0][c] + s.ssq[n & 1][1][c] + s.ssq[n & 1][2][c] + s.ssq[n & 1][3][c];
        const float rs = rsqrtf(tot * (1.f / 128.f) + EPSV);
#pragma unroll
        for (int ne = 0; ne < 2; ne++) s.ob[c * OLD + 32 * w + 16 * ne + l15] = f2bf(o[mc][ne][r] * rs * gnw[ne]);
      }
    __syncthreads();
    {
      const int t0 = b * SEQ + n * 64;
      const int c0 = tid >> 4, ch = tid & 15;
      const u16* zp = p.proj + (size_t)(t0 + c0) * PROJW + 1536 + h * 128 + ch * 8;
      u16* op = p.actA + (size_t)(t0 + c0) * DM + h * 128 + ch * 8;
#pragma unroll
      for (int i = 0; i < 4; i++) {
        const uint4 ov = *(const uint4*)&s.ob[(c0 + 16 * i) * OLD + ch * 8];
        const uint4 zv = *(const uint4*)(zp + (size_t)i * 16 * PROJW);
        const unsigned ow[4] = {ov.x, ov.y, ov.z, ov.w};
        const unsigned zw[4] = {zv.x, zv.y, zv.z, zv.w};
        unsigned rw[4];
#pragma unroll
        for (int q = 0; q < 4; q++) {
          const float lo = bf2f((u16)(ow[q] & 0xffffu)) * siluf(bf2f((u16)(zw[q] & 0xffffu)));
          const float hi = bf2f((u16)(ow[q] >> 16)) * siluf(bf2f((u16)(zw[q] >> 16)));
          rw[q] = pack2(lo, hi);
        }
        *(uint4*)(op + (size_t)i * 16 * DM) = make_uint4(rw[0], rw[1], rw[2], rw[3]);
      }
    }
  }
}

#define PLD 72
__device__ void attn_unit(const P& p, int item, u16* psm) {
  const int tid = threadIdx.x, lane = tid & 63, w = tid >> 6;
  const int l15 = lane & 15, g = lane >> 4;
  const int qb = 15 - (item >> 6), bhf = item & 63;
  const int b = bhf >> 3, hf = bhf & 7;
  const int q0 = qb * 128 + 32 * w;
  u16* Pw = psm + w * (32 * PLD);
  const u16* qbase = p.proj + (size_t)(b * SEQ) * PROJW + 2048 + hf * 64;
  const u16* kbase = p.proj + (size_t)(b * SEQ) * PROJW + 2560 + hf * 64;
  const u16* vbase = p.vt + (size_t)bhf * 64 * SEQ;
  const float* cfb = p.cf + (size_t)bhf * SEQ;
  bf16x8 qf[2][2];
#pragma unroll
  for (int mi = 0; mi < 2; mi++)
#pragma unroll
    for (int ks = 0; ks < 2; ks++) qf[mi][ks] = *(const bf16x8*)&qbase[(size_t)(q0 + 16 * mi + l15) * PROJW + ks * 32 + g * 8];
  float cq[2][4], m[2][4], lsum[2][4];
  f32x4 O[2][4];
#pragma unroll
  for (int mi = 0; mi < 2; mi++) {
#pragma unroll
    for (int r = 0; r < 4; r++) { cq[mi][r] = cfb[q0 + 16 * mi + 4 * g + r]; m[mi][r] = -1e30f; lsum[mi][r] = 0.f; }
#pragma unroll
    for (int nd = 0; nd < 4; nd++) O[mi][nd] = (f32x4){0.f, 0.f, 0.f, 0.f};
  }
  const int ntile = (q0 + 32 + 63) >> 6;
#pragma unroll 1
  for (int kt = 0; kt < ntile; kt++) {
    const int k0 = kt * 64;
    f32x4 S[2][4];
#pragma unroll
    for (int ni = 0; ni < 4; ni++) {
      bf16x8 kf0 = *(const bf16x8*)&kbase[(size_t)(k0 + 16 * ni + l15) * PROJW + g * 8];
      bf16x8 kf1 = *(const bf16x8*)&kbase[(size_t)(k0 + 16 * ni + l15) * PROJW + 32 + g * 8];
#pragma unroll
      for (int mi = 0; mi < 2; mi++) {
        f32x4 acc = {0.f, 0.f, 0.f, 0.f};
        acc = mfma16(qf[mi][0], kf0, acc);
        acc = mfma16(qf[mi][1], kf1, acc);
        S[mi][ni] = acc;
      }
    }
    float ck[4];
#pragma unroll
    for (int ni = 0; ni < 4; ni++) ck[ni] = cfb[k0 + 16 * ni + l15];
#pragma unroll
    for (int mi = 0; mi < 2; mi++)
#pragma unroll
      for (int r = 0; r < 4; r++) {
        const int qpos = q0 + 16 * mi + 4 * g + r;
        float mx = -1e30f;
#pragma unroll
        for (int ni = 0; ni < 4; ni++) {
          const int kpos = k0 + 16 * ni + l15;
          float lg = S[mi][ni][r] * 0.125f + cq[mi][r] - ck[ni];
          lg = (kpos <= qpos) ? lg : -1e30f;
          S[mi][ni][r] = lg;
          mx = fmaxf(mx, lg);
        }
#pragma unroll
        for (int off = 1; off < 16; off <<= 1) mx = fmaxf(mx, __shfl_xor(mx, off));
        const float mn = fmaxf(m[mi][r], mx);
        const float alpha = __expf(m[mi][r] - mn);
        m[mi][r] = mn;
        float ps = 0.f;
#pragma unroll
        for (int ni = 0; ni < 4; ni++) {
          const float pe = __expf(S[mi][ni][r] - mn);
          ps += pe;
          Pw[(16 * mi + 4 * g + r) * PLD + 16 * ni + l15] = f2bf(pe);
        }
        lsum[mi][r] = lsum[mi][r] * alpha + ps;
#pragma unroll
        for (int nd = 0; nd < 4; nd++) O[mi][nd][r] *= alpha;
      }
    LDS_FENCE();
    bf16x8 pf[2][2];
#pragma unroll
    for (int mi = 0; mi < 2; mi++)
#pragma unroll
      for (int ks = 0; ks < 2; ks++) pf[mi][ks] = *(const bf16x8*)&Pw[(16 * mi + l15) * PLD + ks * 32 + g * 8];
#pragma unroll
    for (int nd = 0; nd < 4; nd++) {
      bf16x8 vf0 = *(const bf16x8*)&vbase[(size_t)(16 * nd + l15) * SEQ + k0 + g * 8];
      bf16x8 vf1 = *(const bf16x8*)&vbase[(size_t)(16 * nd + l15) * SEQ + k0 + 32 + g * 8];
#pragma unroll
      for (int mi = 0; mi < 2; mi++) {
        O[mi][nd] = mfma16(pf[mi][0], vf0, O[mi][nd]);
        O[mi][nd] = mfma16(pf[mi][1], vf1, O[mi][nd]);
      }
    }
    LDS_FENCE();
  }
#pragma unroll
  for (int mi = 0; mi < 2; mi++)
#pragma unroll
    for (int r = 0; r < 4; r++) {
      float l = lsum[mi][r];
#pragma unroll
      for (int off = 1; off < 16; off <<= 1) l += __shfl_xor(l, off);
      const float inv = 1.f / l;
      const int t = b * SEQ + q0 + 16 * mi + 4 * g + r;
#pragma unroll
      for (int nd = 0; nd < 4; nd++) p.actA[(size_t)t * DM + 512 + hf * 64 + 16 * nd + l15] = f2bf(O[mi][nd][r] * inv);
    }
}

__device__ void phase_mixer(const P& p, unsigned char* smem, int rr) {
  __shared__ int s_item;
  for (;;) {
    __syncthreads();
    if (threadIdx.x == 0) s_item = (int)atomicAdd(&p.counters[rr], 1u);
    __syncthreads();
    const int item = s_item;
    if (item >= 32 + 1024) break;
#ifndef NO_SCAN
    if (item < 32) scan_unit(p, item, *(ScanSmem*)smem);
#endif
#ifndef NO_ATTN
    if (item >= 32) attn_unit(p, item - 32, (u16*)smem);
#endif
  }
}


#define XB_TMO      128
#define XB_XCNT(j)  (256  + 64 * (j))
#define XB_XSUB(j)  (1280 + 64 * (j))
#define XB_XGEN(j)  (2304 + 64 * (j))
#define XB_TOP      3328
#define XB_TOPGEN   3392
#define XCD_BAR_WORDS 3456
#define XB_SPIN_CAP (1u << 20)
#define LAS __attribute__((address_space(3)))
__device__ __forceinline__ unsigned xb_ld(unsigned* p) { return __hip_atomic_load(p, __ATOMIC_RELAXED, __HIP_MEMORY_SCOPE_AGENT); }
__device__ __forceinline__ unsigned xb_add(unsigned* p, unsigned v) { return __hip_atomic_fetch_add(p, v, __ATOMIC_RELAXED, __HIP_MEMORY_SCOPE_AGENT); }
__device__ __forceinline__ unsigned xb_xcc_id() { return (unsigned)__builtin_amdgcn_s_getreg((3 << 11) | 20) & 0xFu; }
#define XB_SPIN(cond, bar) do { unsigned _sp = 0; while (cond) { __builtin_amdgcn_s_sleep(1); \
    if ((++_sp & 255u) == 0u) { if (xb_ld(&(bar)[XB_TMO])) break; if (_sp > XB_SPIN_CAP) { atomicAdd(&(bar)[XB_TMO], 1u); break; } } } } while (0)
struct XcdBarrier { unsigned* bar; unsigned x; volatile LAS unsigned* st; };
__device__ __forceinline__ XcdBarrier xcd_barrier_post(unsigned* bar, volatile LAS unsigned* st) {
  XcdBarrier b; b.bar = bar; b.x = xb_xcc_id(); b.st = st;
  if (threadIdx.x == 0) (void)xb_add(&bar[XB_XCNT(b.x)], 1u);
  return b;
}
__device__ __forceinline__ void xcd_barrier_complete(unsigned* bar, unsigned x, unsigned& nloc, unsigned& nx) {
  const unsigned G = gridDim.x * gridDim.y * gridDim.z;
  unsigned sum, cnt, mine, sp = 0u;
  for (;;) {
    sum = 0u; cnt = 0u; mine = 0u;
#pragma unroll
    for (unsigned j = 0; j < 16; ++j) { const unsigned c = xb_ld(&bar[XB_XCNT(j)]); sum += c; cnt += (c > 0u) ? 1u : 0u; mine = (j == x) ? c : mine; }
    if (sum == G) break;
    __builtin_amdgcn_s_sleep(1);
    if ((++sp & 255u) == 0u) { if (xb_ld(&bar[XB_TMO])) break; if (sp > XB_SPIN_CAP) { atomicAdd(&bar[XB_TMO], 1u); break; } }
  }
  nloc = mine > 0u ? mine : 1u; nx = cnt > 0u ? cnt : 1u;
}
__device__ __forceinline__ void xcd_barrier(const XcdBarrier& b) {
  asm volatile("s_waitcnt vmcnt(0)" ::: "memory");
  __syncthreads();
  if (threadIdx.x == 0) {
    unsigned* bar = b.bar;
    __builtin_amdgcn_s_waitcnt(0);
    unsigned nloc = b.st[0], nx = b.st[1];
    if (nloc == 0u) { xcd_barrier_complete(bar, b.x, nloc, nx); b.st[0] = nloc; b.st[1] = nx; }
    const unsigned old = xb_add(&bar[XB_XSUB(b.x)], 1u);
    const unsigned gen = old / nloc;
    if (old + 1u == (gen + 1u) * nloc) {
      __builtin_amdgcn_fence(__ATOMIC_RELEASE, "agent");
      asm volatile("s_waitcnt vmcnt(0)" ::: "memory");
      const unsigned og = xb_add(&bar[XB_TOP], 1u);
      const unsigned tg = og / nx;
      if (og + 1u == (tg + 1u) * nx) xb_add(&bar[XB_TOPGEN], 1u);
      else XB_SPIN(xb_ld(&bar[XB_TOPGEN]) == tg, bar);
      __builtin_amdgcn_fence(__ATOMIC_ACQUIRE, "agent");
      xb_add(&bar[XB_XGEN(b.x)], 1u);
      asm volatile("s_waitcnt vmcnt(0)" ::: "memory");
    } else {
      XB_SPIN(xb_ld(&bar[XB_XGEN(b.x)]) == gen, bar);
      __builtin_amdgcn_fence(__ATOMIC_ACQUIRE, "agent");
      asm volatile("s_waitcnt vmcnt(0)" ::: "memory");
    }
  }
  __syncthreads();
}

#define REP0 1
#define REP1 1
#define REP2 1
#define REP3 1
#define REP4 1
#define REP5 1
#define REP6 1

__global__ void __launch_bounds__(256, 2) mega(P p, int lo, int hi) {
  __shared__ __attribute__((aligned(16))) unsigned char smem[sizeof(GemmSmem)];
  __shared__ uint4 xb_words;
  cg::grid_group grid = cg::this_grid();
  if (threadIdx.x == 0) xb_words = make_uint4(0u, 0u, 0u, 0u);
  __syncthreads();
  XcdBarrier xb = xcd_barrier_post(p.bar, (volatile LAS unsigned*)&xb_words);
  if (hi < 0) grid.sync();
#define SEAM(k) if (lo <= k && k + 1 < hi) xcd_barrier(xb);
  if (lo <= 0 && 0 < hi) { for (int rr = 0; rr < REP0; rr++) { phase_prep(p, smem); if (rr + 1 < REP0) xcd_barrier(xb); } }
  SEAM(0)
  if (lo <= 1 && 1 < hi) { for (int rr = 0; rr < REP1; rr++) { phase_inproj(p, smem); if (rr + 1 < REP1) xcd_barrier(xb); } }
  SEAM(1)
  if (lo <= 2 && 2 < hi) { for (int rr = 0; rr < REP2; rr++) { phase_gdnprep(p, smem); if (rr + 1 < REP2) xcd_barrier(xb); } }
  SEAM(2)
  if (lo <= 3 && 3 < hi) { for (int rr = 0; rr < REP3; rr++) { phase_mixer(p, smem, rr); if (rr + 1 < REP3) xcd_barrier(xb); } }
  SEAM(3)
  if (lo <= 4 && 4 < hi) { for (int rr = 0; rr < REP4; rr++) { phase_outproj(p, smem); if (rr + 1 < REP4) xcd_barrier(xb); } }
  SEAM(4)
  if (lo <= 5 && 5 < hi) { for (int rr = 0; rr < REP5; rr++) { phase_rmsnorm(p.h, p.ffn_norm_w, p.actA, nullptr); if (rr + 1 < REP5) xcd_barrier(xb); } }
  SEAM(5)
  if (lo <= 6 && 6 < hi) { for (int rr = 0; rr < REP6; rr++) { phase_gateup(p, smem); if (rr + 1 < REP6) xcd_barrier(xb); } }
  SEAM(6)
  if (lo <= 7 && 7 < hi) { phase_down(p, smem); }
  SEAM(7)
  if (lo <= 8 && 8 < hi) { phase_rmsnorm(p.h, p.ple_norm_w, p.actA, nullptr); }
  SEAM(8)
  if (lo <= 9 && 9 < hi) { phase_ple(p, smem); }
  SEAM(9)
  if (lo <= 10 && 10 < hi) { phase_rmsnorm(p.h, p.final_norm_w, nullptr, p.h); }
}

static_assert(sizeof(GdnSmem) <= sizeof(GemmSmem), "smem");
static_assert(sizeof(ScanSmem) <= sizeof(GemmSmem), "smem");

extern "C" void kernel_launch(void* const* d_in, const int* in_sizes, int n_in, void* d_out, int out_size,
                              void* d_ws, size_t ws_size, hipStream_t stream) {
  static int grid_blocks = 0;
  if (!grid_blocks) {
    int dev = 0, cus = 0, per_cu = 0;
    hipGetDevice(&dev);
    hipDeviceGetAttribute(&cus, hipDeviceAttributeMultiprocessorCount, dev);
    hipOccupancyMaxActiveBlocksPerMultiprocessor(&per_cu, mega, 256, 0);
    if (per_cu > 2) per_cu = 2;
    if (per_cu < 1) per_cu = 1;
    grid_blocks = cus * per_cu;
  }
  P p{};
  const float* const* in = (const float* const*)d_in;
  p.x = in[0]; p.p = in[1]; p.attn_norm_w = in[2]; p.w_in = in[3]; p.conv_w = in[4]; p.a_log = in[5];
  p.dt_bias = in[6]; p.gdn_norm_w = in[7]; p.fox_f_bias = in[8]; p.w_out = in[9]; p.ffn_norm_w = in[10];
  p.w_gate_up = in[11]; p.w_down = in[12]; p.ple_norm_w = in[13]; p.w_ple_gate = in[14]; p.w_ple_proj = in[15];
  p.final_norm_w = in[16];
  p.h = (float*)d_out;
  unsigned char* ws = (unsigned char*)d_ws;
  size_t off = 0;
  auto take = [&](size_t bytes) { unsigned char* r = ws + off; off += (bytes + 255) & ~(size_t)255; return r; };
  p.counters = (unsigned*)take(256);
  p.bar = (unsigned*)take(XCD_BAR_WORDS * 4);
  p.wt_in = (u16*)take((size_t)NIN_PAD * 1024 * 2);
  p.wt_out = (u16*)take((size_t)1024 * 1024 * 2);
  p.wt_gu = (u16*)take((size_t)2 * DFF * 1024 * 2);
  p.wt_down = (u16*)take((size_t)1024 * DFF * 2);
  p.wt_pg = (u16*)take((size_t)1024 * 1024 * 2);
  p.wt_pp = (u16*)take((size_t)1024 * 256 * 2);
  p.actA = (u16*)take((size_t)NTOK * 1024 * 2);
  p.pb = (u16*)take((size_t)NTOK * 256 * 2);
  p.proj = (u16*)take((size_t)NTOK * PROJW * 2);
  p.vt = (u16*)take((size_t)64 * 64 * SEQ * 2);
  p.gates = (float*)take((size_t)NTOK * 16 * 4);
  p.cf = (float*)take((size_t)64 * SEQ * 4);
  p.guT = (float*)take((size_t)1024 * 8192 * 4);
  p.gdl = (float*)take(1024 * 4);
  if (off > ws_size) fprintf(stderr, "workspace too small: need %zu have %zu\n", off, ws_size);
  u16* ob = (u16*)d_out;
  p.gw = ob;
  p.gqg = ob + (size_t)1024 * 8192;
  p.gkdT = ob + (size_t)2 * 1024 * 8192;
  p.gqk = ob + (size_t)3 * 1024 * 8192;
  hipMemsetAsync(p.bar, 0, XCD_BAR_WORDS * 4, stream);
  int lo = 0, hi = NPHASE;
  void* args[] = {&p, &lo, &hi};
  hipError_t e = hipLaunchCooperativeKernel((void*)mega, dim3(grid_blocks), dim3(256), args, 0, stream);
  if (e != hipSuccess) fprintf(stderr, "cooperative launch failed: %s (grid %d)\n", hipGetErrorString(e), grid_blocks);
}
```

```cpp
#include <hip/hip_runtime.h>
#include <hip/hip_cooperative_groups.h>
#include <cstdio>
#include <cstdint>
namespace cg = cooperative_groups;

typedef unsigned short u16;
typedef __attribute__((ext_vector_type(8))) short bf16x8;
typedef __attribute__((ext_vector_type(4))) float f32x4;

#define NTOK 16384
#define SEQ 2048
#define DM 1024
#define DFF 2816
#define PROJW 3072
#define NIN_PAD 3712
#define EPSV 1e-6f
#define NPHASE 12

struct P {
  const float *x, *p, *attn_norm_w, *w_in, *conv_w, *a_log, *dt_bias, *gdn_norm_w, *fox_f_bias, *w_out,
      *ffn_norm_w, *w_gate_up, *w_down, *ple_norm_w, *w_ple_gate, *w_ple_proj, *final_norm_w;
  float* h;
  u16 *wt_in, *wt_out, *wt_gu, *wt_down, *wt_pg, *wt_pp;
  u16 *actA;
  u16 *pb;
  u16 *proj;
  u16 *vt;
  float *gates;
  float *cf;
  u16 *gM, *gC;
  u16 *gQ, *gO;
  u16 *gS;
  float *gdl;
  unsigned *counters;
  unsigned *bar;
};

__device__ __forceinline__ u16 f2bf(float f) {
  unsigned u = __float_as_uint(f);
  u += 0x7fffu + ((u >> 16) & 1u);
  return (u16)(u >> 16);
}
__device__ __forceinline__ float bf2f(u16 h) { return __uint_as_float(((unsigned)h) << 16); }
__device__ __forceinline__ unsigned pack2(float a, float b) { return (unsigned)f2bf(a) | (((unsigned)f2bf(b)) << 16); }
__device__ __forceinline__ float siluf(float v) { return v / (1.f + __expf(-v)); }
__device__ __forceinline__ float sigmoidf_(float v) { return 1.f / (1.f + __expf(-v)); }
__device__ __forceinline__ f32x4 mfma16(bf16x8 a, bf16x8 b, f32x4 c) {
  return __builtin_amdgcn_mfma_f32_16x16x32_bf16(a, b, c, 0, 0, 0);
}
#define LDS_FENCE() asm volatile("s_waitcnt lgkmcnt(0)" ::: "memory")

__device__ __forceinline__ int colmap(int kind, int nn) {
  if (kind == 0) {
    if (nn < 2048) return nn;
    if (nn < 3584) return nn + 8;
    if (nn < 3588) return 2048 + (nn - 3584);
    if (nn < 3592) return 2052 + (nn - 3588);
    if (nn < 3600) return nn;
    return -1;
  } else if (kind == 2) {
    int i = nn >> 7, wc = (nn >> 6) & 1, u = (nn >> 5) & 1, j = nn & 31;
    return u * DFF + 64 * i + 32 * wc + j;
  }
  return nn;
}

__device__ void transpose_item(const float* __restrict__ src, int ldsrc, u16* __restrict__ dst, int K,
                               int kt, int nt, int kind, float* tile) {
  int tid = threadIdx.x;
  asm volatile("" : "+v"(tid));
  const int c = tid & 63, r0 = tid >> 6;
  const int ncol = colmap(kind, nt * 64 + c);
#pragma unroll 4
  for (int i = 0; i < 16; i++) {
    int r = r0 + 4 * i;
    float v = (ncol >= 0) ? src[(size_t)(kt * 64 + r) * ldsrc + ncol] : 0.f;
    tile[r * 65 + c] = v;
  }
  __syncthreads();
#pragma unroll 4
  for (int i = 0; i < 16; i++) {
    int rn = r0 + 4 * i;
    dst[(size_t)(nt * 64 + rn) * K + kt * 64 + c] = f2bf(tile[c * 65 + rn]);
  }
  __syncthreads();
}

__device__ __forceinline__ void rmsnorm_row(const float* src, const float* __restrict__ w,
                                            u16* dstb, float* dstf, int row) {
  const int lane = threadIdx.x & 63;
  float4 v[4];
  float ss = 0.f;
#pragma unroll
  for (int i = 0; i < 4; i++) {
    v[i] = *(const float4*)&src[(size_t)row * DM + i * 256 + lane * 4];
    ss += v[i].x * v[i].x + v[i].y * v[i].y + v[i].z * v[i].z + v[i].w * v[i].w;
  }
#pragma unroll
  for (int off = 32; off >= 1; off >>= 1) ss += __shfl_xor(ss, off);
  const float r = rsqrtf(ss * (1.f / DM) + EPSV);
#pragma unroll
  for (int i = 0; i < 4; i++) {
    const int col = i * 256 + lane * 4;
    float4 wv = *(const float4*)&w[col];
    float y0 = v[i].x * r * wv.x, y1 = v[i].y * r * wv.y, y2 = v[i].z * r * wv.z, y3 = v[i].w * r * wv.w;
    if (dstb) {
      uint2 o; o.x = pack2(y0, y1); o.y = pack2(y2, y3);
      *(uint2*)&dstb[(size_t)row * DM + col] = o;
    } else {
      *(float4*)&dstf[(size_t)row * DM + col] = make_float4(y0, y1, y2, y3);
    }
  }
}

__device__ void phase_prep(const P& p, unsigned char* smem) {
  float* tile = (float*)smem;
  if (blockIdx.x == 0 && threadIdx.x < 16) p.counters[threadIdx.x] = 0u;
  for (int it = blockIdx.x; it < 16 * 58; it += gridDim.x) transpose_item(p.w_in, 3600, p.wt_in, 1024, it % 16, it / 16, 0, tile);
  const int wave = threadIdx.x >> 6, lane = threadIdx.x & 63;
  for (int rb = blockIdx.x; rb < NTOK / 4; rb += gridDim.x) {
    const int row = rb * 4 + wave;
    rmsnorm_row(p.x, p.attn_norm_w, p.actA, nullptr, row);
    float4 pv = *(const float4*)&p.p[(size_t)row * 256 + lane * 4];
    uint2 o; o.x = pack2(pv.x, pv.y); o.y = pack2(pv.z, pv.w);
    *(uint2*)&p.pb[(size_t)row * 256 + lane * 4] = o;
  }
}

__device__ void phase_rmsnorm(const float* src, const float* w, u16* dstb, float* dstf) {
  const int wave = threadIdx.x >> 6;
  for (int rb = blockIdx.x; rb < NTOK / 4; rb += gridDim.x) rmsnorm_row(src, w, dstb, dstf, rb * 4 + wave);
}

#define GK 64
#define GLD 72
struct GemmSmem { u16 a[2][128 * GLD]; u16 b[2][128 * GLD]; };

__device__ __forceinline__ void gemm_tile(const u16* __restrict__ A, int lda, const u16* __restrict__ Bt, int ldb,
                                          int K, int m0, int n0, GemmSmem& s, f32x4 (&acc)[4][4]) {
  const int tid = threadIdx.x, lane = tid & 63, wave = tid >> 6;
  const int wr = wave >> 1, wc = wave & 1;
  const int l15 = lane & 15, g = lane >> 4;
  const int nk = K / GK;
  uint4 ra0, ra1, ra2, ra3, rb0, rb1, rb2, rb3;
  const int crow = tid >> 3, ccol = (tid & 7) * 8;
  const u16* Ap = A + (size_t)(m0 + crow) * lda + ccol;
  const u16* Bp = Bt + (size_t)(n0 + crow) * ldb + ccol;
  const size_t sa = (size_t)32 * lda, sb = (size_t)32 * ldb;
#define G_LOAD(koff) \
  ra0 = *(const uint4*)(Ap + (koff)); ra1 = *(const uint4*)(Ap + sa + (koff)); \
  ra2 = *(const uint4*)(Ap + 2 * sa + (koff)); ra3 = *(const uint4*)(Ap + 3 * sa + (koff)); \
  rb0 = *(const uint4*)(Bp + (koff)); rb1 = *(const uint4*)(Bp + sb + (koff)); \
  rb2 = *(const uint4*)(Bp + 2 * sb + (koff)); rb3 = *(const uint4*)(Bp + 3 * sb + (koff));
#define G_STORE(bufi) \
  *(uint4*)&s.a[bufi][(crow) * GLD + ccol] = ra0; *(uint4*)&s.a[bufi][(crow + 32) * GLD + ccol] = ra1; \
  *(uint4*)&s.a[bufi][(crow + 64) * GLD + ccol] = ra2; *(uint4*)&s.a[bufi][(crow + 96) * GLD + ccol] = ra3; \
  *(uint4*)&s.b[bufi][(crow) * GLD + ccol] = rb0; *(uint4*)&s.b[bufi][(crow + 32) * GLD + ccol] = rb1; \
  *(uint4*)&s.b[bufi][(crow + 64) * GLD + ccol] = rb2; *(uint4*)&s.b[bufi][(crow + 96) * GLD + ccol] = rb3;
  G_LOAD(0)
  __syncthreads();
  G_STORE(0)
  __syncthreads();
  for (int kt = 0; kt < nk; kt++) {
    const int buf = kt & 1;
    if (kt + 1 < nk) { G_LOAD((kt + 1) * GK) }
#pragma unroll
    for (int ks = 0; ks < 2; ks++) {
      bf16x8 af[4], bfr[4];
#pragma unroll
      for (int mi = 0; mi < 4; mi++) af[mi] = *(const bf16x8*)&s.a[buf][(wr * 64 + mi * 16 + l15) * GLD + ks * 32 + g * 8];
#pragma unroll
      for (int ni = 0; ni < 4; ni++) bfr[ni] = *(const bf16x8*)&s.b[buf][(wc * 64 + ni * 16 + l15) * GLD + ks * 32 + g * 8];
#pragma unroll
      for (int mi = 0; mi < 4; mi++)
#pragma unroll
        for (int ni = 0; ni < 4; ni++) acc[mi][ni] = mfma16(af[mi], bfr[ni], acc[mi][ni]);
    }
    if (kt + 1 < nk) {
      if (buf) { G_STORE(0) } else { G_STORE(1) }
    }
    __syncthreads();
  }
}

#define ZERO_ACC(acc) _Pragma("unroll") for (int _i = 0; _i < 4; _i++) _Pragma("unroll") for (int _j = 0; _j < 4; _j++) acc[_i][_j] = (f32x4){0.f, 0.f, 0.f, 0.f};

__device__ void phase_inproj(const P& p, unsigned char* smem) {
  GemmSmem& s = *(GemmSmem*)smem;
  const int lane = threadIdx.x & 63, wave = threadIdx.x >> 6, wr = wave >> 1, wc = wave & 1, l15 = lane & 15, g = lane >> 4;
  const int ntiles = 128 * 29;
  for (int tl = blockIdx.x; tl < ntiles; tl += gridDim.x) {
    const int mt = tl & 127, nt = tl >> 7;
    const int m0 = mt * 128, n0 = nt * 128;
    f32x4 acc[4][4];
    ZERO_ACC(acc);
    gemm_tile(p.actA, DM, p.wt_in, DM, DM, m0, n0, s, acc);
#pragma unroll
    for (int mi = 0; mi < 4; mi++)
#pragma unroll
      for (int ni = 0; ni < 4; ni++) {
        const int rowb = m0 + wr * 64 + mi * 16 + g * 4;
        const int col = n0 + wc * 64 + ni * 16 + l15;
        if (nt < 24) {
#pragma unroll
          for (int r = 0; r < 4; r++) p.proj[(size_t)(rowb + r) * PROJW + col] = f2bf(acc[mi][ni][r]);
        } else if (nt < 28) {
          const int cc = col - 3072, hh = cc >> 6, d = cc & 63;
          const int b = rowb >> 11, sq = rowb & 2047;
          uint2 o; o.x = pack2(acc[mi][ni][0], acc[mi][ni][1]); o.y = pack2(acc[mi][ni][2], acc[mi][ni][3]);
          *(uint2*)&p.vt[((size_t)((b * 8 + hh) * 64 + d)) * SEQ + sq] = o;
        } else {
          if (col < 3600) {
#pragma unroll
            for (int r = 0; r < 4; r++) p.gates[(size_t)(rowb + r) * 16 + (col - 3584)] = acc[mi][ni][r];
          }
        }
      }
  }
}

__device__ void phase_outproj(const P& p, unsigned char* smem) {
  GemmSmem& s = *(GemmSmem*)smem;
  const int lane = threadIdx.x & 63, wave = threadIdx.x >> 6, wr = wave >> 1, wc = wave & 1, l15 = lane & 15, g = lane >> 4;
  for (int tl = blockIdx.x; tl < 128 * 8; tl += gridDim.x) {
    const int mt = tl & 127, nt = tl >> 7;
    const int m0 = mt * 128, n0 = nt * 128;
    f32x4 acc[4][4];
    ZERO_ACC(acc);
    gemm_tile(p.actA, DM, p.wt_out, DM, DM, m0, n0, s, acc);
#pragma unroll
    for (int mi = 0; mi < 4; mi++)
#pragma unroll
      for (int ni = 0; ni < 4; ni++) {
        const int rowb = m0 + wr * 64 + mi * 16 + g * 4;
        const int col = n0 + wc * 64 + ni * 16 + l15;
#pragma unroll
        for (int r = 0; r < 4; r++) {
          size_t idx = (size_t)(rowb + r) * DM + col;
          p.h[idx] = p.x[idx] + acc[mi][ni][r];
        }
      }
  }
}

__device__ void phase_gateup(const P& p, unsigned char* smem) {
  GemmSmem& s = *(GemmSmem*)smem;
  u16* act = p.proj;
  const int lane = threadIdx.x & 63, wave = threadIdx.x >> 6, wr = wave >> 1, wc = wave & 1, l15 = lane & 15, g = lane >> 4;
  for (int tl = blockIdx.x; tl < 128 * 44; tl += gridDim.x) {
    const int mt = tl & 127, nt = tl >> 7;
    const int m0 = mt * 128, n0 = nt * 128;
    f32x4 acc[4][4];
    ZERO_ACC(acc);
    gemm_tile(p.actA, DM, p.wt_gu, DM, DM, m0, n0, s, acc);
#pragma unroll
    for (int mi = 0; mi < 4; mi++)
#pragma unroll
      for (int ni = 0; ni < 2; ni++) {
        const int rowb = m0 + wr * 64 + mi * 16 + g * 4;
        const int col = 64 * nt + 32 * wc + 16 * ni + l15;
#pragma unroll
        for (int r = 0; r < 4; r++) {
          float gt = acc[mi][ni][r], up = acc[mi][ni + 2][r];
          act[(size_t)(rowb + r) * DFF + col] = f2bf(siluf(gt) * up);
        }
      }
  }
}

__device__ void phase_down(const P& p, unsigned char* smem) {
  GemmSmem& s = *(GemmSmem*)smem;
  const u16* act = p.proj;
  const int lane = threadIdx.x & 63, wave = threadIdx.x >> 6, wr = wave >> 1, wc = wave & 1, l15 = lane & 15, g = lane >> 4;
  for (int tl = blockIdx.x; tl < 128 * 8; tl += gridDim.x) {
    const int mt = tl & 127, nt = tl >> 7;
    const int m0 = mt * 128, n0 = nt * 128;
    f32x4 acc[4][4];
    ZERO_ACC(acc);
    gemm_tile(act, DFF, p.wt_down, DFF, DFF, m0, n0, s, acc);
#pragma unroll
    for (int mi = 0; mi < 4; mi++)
#pragma unroll
      for (int ni = 0; ni < 4; ni++) {
        const int rowb = m0 + wr * 64 + mi * 16 + g * 4;
        const int col = n0 + wc * 64 + ni * 16 + l15;
#pragma unroll
        for (int r = 0; r < 4; r++) {
          size_t idx = (size_t)(rowb + r) * DM + col;
          p.h[idx] += acc[mi][ni][r];
        }
      }
  }
}

__device__ void phase_ple(const P& p, unsigned char* smem) {
  GemmSmem& s = *(GemmSmem*)smem;
  const int lane = threadIdx.x & 63, wave = threadIdx.x >> 6, wr = wave >> 1, wc = wave & 1, l15 = lane & 15, g = lane >> 4;
  for (int tl = blockIdx.x; tl < 128 * 8; tl += gridDim.x) {
    const int mt = tl & 127, nt = tl >> 7;
    const int m0 = mt * 128, n0 = nt * 128;
    f32x4 acc[4][4], acc2[4][4];
    ZERO_ACC(acc);
    gemm_tile(p.actA, DM, p.wt_pg, DM, DM, m0, n0, s, acc);
#pragma unroll
    for (int mi = 0; mi < 4; mi++)
#pragma unroll
      for (int ni = 0; ni < 4; ni++)
#pragma unroll
        for (int r = 0; r < 4; r++) acc[mi][ni][r] = sigmoidf_(acc[mi][ni][r]);
    ZERO_ACC(acc2);
    gemm_tile(p.pb, 256, p.wt_pp, 256, 256, m0, n0, s, acc2);
#pragma unroll
    for (int mi = 0; mi < 4; mi++)
#pragma unroll
      for (int ni = 0; ni < 4; ni++) {
        const int rowb = m0 + wr * 64 + mi * 16 + g * 4;
        const int col = n0 + wc * 64 + ni * 16 + l15;
#pragma unroll
        for (int r = 0; r < 4; r++) {
          size_t idx = (size_t)(rowb + r) * DM + col;
          p.h[idx] += acc[mi][ni][r] * acc2[mi][ni][r];
        }
      }
  }
}

#define QLD 136
#define KLD 72
struct GdnSmem {
  u16 qb[64 * QLD];
  u16 kn[64 * QLD];
  u16 vb[64 * QLD];
  float Am[64 * 64];
  float gc[64], beta[64], be[64];
};
static_assert(offsetof(GdnSmem, kn) == 17408 && offsetof(GdnSmem, vb) == 34816 && offsetof(GdnSmem, Am) == 52224, "layout");

__device__ __forceinline__ void unpack8(const uint4& v, float (&f)[8]) {
  f[0] = bf2f((u16)(v.x & 0xffffu)); f[1] = bf2f((u16)(v.x >> 16));
  f[2] = bf2f((u16)(v.y & 0xffffu)); f[3] = bf2f((u16)(v.y >> 16));
  f[4] = bf2f((u16)(v.z & 0xffffu)); f[5] = bf2f((u16)(v.z >> 16));
  f[6] = bf2f((u16)(v.w & 0xffffu)); f[7] = bf2f((u16)(v.w >> 16));
}
__device__ __forceinline__ void unpack4(const uint2& v, float (&f)[4]) {
  f[0] = bf2f((u16)(v.x & 0xffffu)); f[1] = bf2f((u16)(v.x >> 16));
  f[2] = bf2f((u16)(v.y & 0xffffu)); f[3] = bf2f((u16)(v.y >> 16));
}

__device__ void gdn_unit(const P& p, int unit, GdnSmem& s) {
  int tid = threadIdx.x;
  asm volatile("" : "+v"(tid));
  int lane = tid & 63, wave = tid >> 6;
  int l15 = lane & 15, g = lane >> 4;
#define GDN_REFRESH() do { tid = threadIdx.x; asm volatile("" : "+v"(tid) :: "memory"); lane = tid & 63; wave = tid >> 6; l15 = lane & 15; g = lane >> 4; } while (0)
  const int bh = unit >> 5, n = unit & 31;
  const int b = bh >> 2, h = bh & 3;
  const int tb = b * SEQ;
  const int s0 = n * 64;
  u16* const qk_s = s.qb;
  u16* const WU = s.kn;
  u16* const kdT = (u16*)((unsigned char*)s.kn + 32768);
  __syncthreads();
  if (wave == 0) {
    const int t = tb + s0 + lane;
    const float ga = p.gates[(size_t)t * 16 + h], gb = p.gates[(size_t)t * 16 + 4 + h];
    const float xx = ga + p.dt_bias[h];
    const float sp = (xx > 20.f) ? xx : log1pf(__expf(xx));
    float gg = -__expf(p.a_log[h]) * sp;
#pragma unroll
    for (int off = 1; off < 64; off <<= 1) {
      float nb = __shfl_up(gg, off);
      if (lane >= off) gg += nb;
    }
    const float bt = sigmoidf_(gb);
    s.gc[lane] = gg;
    s.beta[lane] = bt;
    s.be[lane] = bt * __expf(gg);
  }
  {
    const int ch = tid & 15, rg = tid >> 4;
#pragma unroll 1
    for (int mat = 0; mat < 3; mat++) {
      const int col0 = mat * 512 + h * 128 + ch * 8;
      float cw[4][8];
#pragma unroll
      for (int k = 0; k < 4; k++) {
        const float4 w0 = *(const float4*)&p.conv_w[k * 1536 + col0];
        const float4 w1 = *(const float4*)&p.conv_w[k * 1536 + col0 + 4];
        cw[k][0] = w0.x; cw[k][1] = w0.y; cw[k][2] = w0.z; cw[k][3] = w0.w;
        cw[k][4] = w1.x; cw[k][5] = w1.y; cw[k][6] = w1.z; cw[k][7] = w1.w;
      }
      uint4 xr[7];
#pragma unroll
      for (int j = 0; j < 7; j++) {
        const int sp = s0 + 4 * rg + j - 3;
        xr[j] = (sp >= 0) ? *(const uint4*)&p.proj[(size_t)(tb + sp) * PROJW + col0] : make_uint4(0u, 0u, 0u, 0u);
      }
      float xf[7][8];
#pragma unroll
      for (int j = 0; j < 7; j++) unpack8(xr[j], xf[j]);
      u16* dst = (mat == 0) ? s.qb : ((mat == 1) ? s.kn : s.vb);
#pragma unroll
      for (int r = 0; r < 4; r++) {
        float val[8];
        float ss = 0.f;
#pragma unroll
        for (int c = 0; c < 8; c++) {
          const float cv = cw[0][c] * xf[r][c] + cw[1][c] * xf[r + 1][c] + cw[2][c] * xf[r + 2][c] + cw[3][c] * xf[r + 3][c];
          val[c] = siluf(cv);
          ss += val[c] * val[c];
        }
        float rs = 1.f;
        if (mat < 2) {
#pragma unroll
          for (int off = 1; off < 16; off <<= 1) ss += __shfl_xor(ss, off);
          rs = rsqrtf(ss + EPSV) * ((mat == 0) ? 0.08838834764831845f : 1.f);
        }
        uint4 o;
        o.x = pack2(val[0] * rs, val[1] * rs); o.y = pack2(val[2] * rs, val[3] * rs);
        o.z = pack2(val[4] * rs, val[5] * rs); o.w = pack2(val[6] * rs, val[7] * rs);
        *(uint4*)&dst[(4 * rg + r) * QLD + ch * 8] = o;
      }
    }
  }
  __syncthreads();
  GDN_REFRESH();
  u16* const gQ = p.gQ + (size_t)unit * 8192;
  {
#pragma unroll
    for (int it = 0; it < 4; it++) {
      const int idx = tid + 256 * it;
      const int i = idx >> 4, d8 = (idx & 15) * 8;
      const float e = __expf(s.gc[i]);
      float f[8];
      unpack8(*(const uint4*)&s.qb[i * QLD + d8], f);
      uint4 o;
      o.x = pack2(f[0] * e, f[1] * e); o.y = pack2(f[2] * e, f[3] * e);
      o.z = pack2(f[4] * e, f[5] * e); o.w = pack2(f[6] * e, f[7] * e);
      *(uint4*)&gQ[i * 128 + d8] = o;
    }
  }
  f32x4 cqk[4];
  {
    bf16x8 aq[4], ak[4];
#pragma unroll
    for (int ks = 0; ks < 4; ks++) {
      aq[ks] = *(const bf16x8*)&s.qb[(wave * 16 + l15) * QLD + ks * 32 + g * 8];
      ak[ks] = *(const bf16x8*)&s.kn[(wave * 16 + l15) * QLD + ks * 32 + g * 8];
    }
#pragma unroll
    for (int ni = 0; ni < 4; ni++) {
      f32x4 ckk = {0.f, 0.f, 0.f, 0.f};
      cqk[ni] = (f32x4){0.f, 0.f, 0.f, 0.f};
      if (ni <= wave) {
#pragma unroll
        for (int ks = 0; ks < 4; ks++) {
          bf16x8 bk = *(const bf16x8*)&s.kn[(ni * 16 + l15) * QLD + ks * 32 + g * 8];
          ckk = mfma16(ak[ks], bk, ckk);
          cqk[ni] = mfma16(aq[ks], bk, cqk[ni]);
        }
      }
      const int j = ni * 16 + l15;
      const float gcj = s.gc[j];
#pragma unroll
      for (int r = 0; r < 4; r++) {
        const int i = wave * 16 + g * 4 + r;
        const float dec = (i >= j) ? __expf(s.gc[i] - gcj) : 0.f;
        s.Am[i * 64 + j] = (i > j) ? ckk[r] * s.beta[i] * dec : 0.f;
        cqk[ni][r] = (i >= j) ? cqk[ni][r] * dec : 0.f;
      }
    }
  }
  __syncthreads();
  GDN_REFRESH();
#pragma unroll
  for (int ni = 0; ni < 4; ni++)
#pragma unroll
    for (int r = 0; r < 4; r++) qk_s[(wave * 16 + g * 4 + r) * KLD + ni * 16 + l15] = f2bf(cqk[ni][r]);
  float xs[64];
#ifdef NO_SOLVE
  for (int i = 0; i < 64; i++) xs[i] = s.Am[i*64+tid%64];
#else
  {
    const int c = tid;
    const u16* src = (c < 128) ? &s.vb[c] : &s.kn[c - 128];
    const float* sc = (c < 128) ? s.beta : s.be;
#pragma unroll
    for (int i = 0; i < 64; i++) {
      float a0 = bf2f(src[i * QLD]) * sc[i], a1 = 0.f, a2 = 0.f, a3 = 0.f;
#pragma unroll
      for (int j4 = 0; j4 < (i + 3) / 4; j4++) {
        const float4 av = *(const float4*)&s.Am[i * 64 + j4 * 4];
        if (j4 * 4 + 0 < i) a0 -= av.x * xs[j4 * 4 + 0];
        if (j4 * 4 + 1 < i) a1 -= av.y * xs[j4 * 4 + 1];
        if (j4 * 4 + 2 < i) a2 -= av.z * xs[j4 * 4 + 2];
        if (j4 * 4 + 3 < i) a3 -= av.w * xs[j4 * 4 + 3];
      }
      xs[i] = (a0 + a1) + (a2 + a3);
      asm volatile("" : "+v"(xs[i]) :: "memory");
    }
  }
#endif
  const float glast = s.gc[63];
  __syncthreads();
  GDN_REFRESH();
  {
    const int d = tid & 127, half = tid >> 7;
#pragma unroll
    for (int q = 0; q < 4; q++) {
      unsigned ow[4];
#pragma unroll
      for (int e2 = 0; e2 < 4; e2++) {
        const int c0 = half * 32 + q * 8 + e2 * 2;
        const float v0 = bf2f(s.kn[c0 * QLD + d]) * __expf(glast - s.gc[c0]);
        const float v1 = bf2f(s.kn[(c0 + 1) * QLD + d]) * __expf(glast - s.gc[c0 + 1]);
        ow[e2] = pack2(v0, v1);
      }
      *(uint4*)&kdT[d * KLD + half * 32 + q * 8] = make_uint4(ow[0], ow[1], ow[2], ow[3]);
    }
    if (tid == 0) p.gdl[unit] = __expf(glast);
  }
  __syncthreads();
  GDN_REFRESH();
  if (tid >= 128) {
#pragma unroll
    for (int q = 0; q < 8; q++)
      *(uint4*)&WU[(tid - 128) * KLD + q * 8] = make_uint4(pack2(xs[q * 8], xs[q * 8 + 1]), pack2(xs[q * 8 + 2], xs[q * 8 + 3]),
                                                            pack2(xs[q * 8 + 4], xs[q * 8 + 5]), pack2(xs[q * 8 + 6], xs[q * 8 + 7]));
  }
  __syncthreads();
  GDN_REFRESH();
  {
    u16* const gM = p.gM + (size_t)unit * 16384;
    bf16x8 aw[2][2];
#pragma unroll
    for (int mm = 0; mm < 2; mm++)
#pragma unroll
      for (int ks = 0; ks < 2; ks++) aw[mm][ks] = *(const bf16x8*)&WU[((2 * wave + mm) * 16 + l15) * KLD + ks * 32 + g * 8];
#pragma unroll
    for (int nn = 0; nn < 8; nn++) {
      const bf16x8 b0 = *(const bf16x8*)&kdT[(nn * 16 + l15) * KLD + g * 8];
      const bf16x8 b1 = *(const bf16x8*)&kdT[(nn * 16 + l15) * KLD + 32 + g * 8];
#pragma unroll
      for (int mm = 0; mm < 2; mm++) {
        f32x4 acc = {0.f, 0.f, 0.f, 0.f};
        acc = mfma16(aw[mm][0], b0, acc);
        acc = mfma16(aw[mm][1], b1, acc);
        uint2 o; o.x = pack2(-acc[0], -acc[1]); o.y = pack2(-acc[2], -acc[3]);
        *(uint2*)&gM[(nn * 16 + l15) * 128 + (2 * wave + mm) * 16 + 4 * g] = o;
      }
    }
#pragma unroll
    for (int nn = 0; nn < 4; nn++) {
      const bf16x8 b0 = *(const bf16x8*)&qk_s[(nn * 16 + l15) * KLD + g * 8];
      const bf16x8 b1 = *(const bf16x8*)&qk_s[(nn * 16 + l15) * KLD + 32 + g * 8];
#pragma unroll
      for (int mm = 0; mm < 2; mm++) {
        f32x4 acc = {0.f, 0.f, 0.f, 0.f};
        acc = mfma16(aw[mm][0], b0, acc);
        acc = mfma16(aw[mm][1], b1, acc);
        u16* qp = &gQ[(nn * 16 + l15) * 128 + (2 * wave + mm) * 16 + 4 * g];
        float qv[4];
        unpack4(*(const uint2*)qp, qv);
        uint2 o; o.x = pack2(qv[0] - acc[0], qv[1] - acc[1]); o.y = pack2(qv[2] - acc[2], qv[3] - acc[3]);
        *(uint2*)qp = o;
      }
    }
  }
  __syncthreads();
  GDN_REFRESH();
  if (tid < 128) {
#pragma unroll
    for (int q = 0; q < 8; q++)
      *(uint4*)&WU[tid * KLD + q * 8] = make_uint4(pack2(xs[q * 8], xs[q * 8 + 1]), pack2(xs[q * 8 + 2], xs[q * 8 + 3]),
                                                    pack2(xs[q * 8 + 4], xs[q * 8 + 5]), pack2(xs[q * 8 + 6], xs[q * 8 + 7]));
  }
  __syncthreads();
  GDN_REFRESH();
  {
    u16* const gC = p.gC + (size_t)unit * 16384;
    u16* const gO = p.gO + (size_t)unit * 8192;
    bf16x8 akd[2][2], aqk[2];
#pragma unroll
    for (int mm = 0; mm < 2; mm++)
#pragma unroll
      for (int ks = 0; ks < 2; ks++) akd[mm][ks] = *(const bf16x8*)&kdT[((2 * wave + mm) * 16 + l15) * KLD + ks * 32 + g * 8];
#pragma unroll
    for (int ks = 0; ks < 2; ks++) aqk[ks] = *(const bf16x8*)&qk_s[(wave * 16 + l15) * KLD + ks * 32 + g * 8];
#pragma unroll
    for (int nn = 0; nn < 8; nn++) {
      const bf16x8 b0 = *(const bf16x8*)&WU[(nn * 16 + l15) * KLD + g * 8];
      const bf16x8 b1 = *(const bf16x8*)&WU[(nn * 16 + l15) * KLD + 32 + g * 8];
#pragma unroll
      for (int mm = 0; mm < 2; mm++) {
        f32x4 acc = {0.f, 0.f, 0.f, 0.f};
        acc = mfma16(akd[mm][0], b0, acc);
        acc = mfma16(akd[mm][1], b1, acc);
        uint2 o; o.x = pack2(acc[0], acc[1]); o.y = pack2(acc[2], acc[3]);
        *(uint2*)&gC[(nn * 16 + l15) * 128 + (2 * wave + mm) * 16 + 4 * g] = o;
      }
      {
        f32x4 acc = {0.f, 0.f, 0.f, 0.f};
        acc = mfma16(aqk[0], b0, acc);
        acc = mfma16(aqk[1], b1, acc);
        uint2 o; o.x = pack2(acc[0], acc[1]); o.y = pack2(acc[2], acc[3]);
        *(uint2*)&gO[(nn * 16 + l15) * 64 + wave * 16 + 4 * g] = o;
      }
    }
  }
}

__device__ void fox_cumsum_unit(const P& p, int bhf, float* red) {
  const int tid = threadIdx.x, lane = tid & 63, wave = tid >> 6;
  const int b = bhf >> 3, hf = bhf & 7;
  const float bias = p.fox_f_bias[hf];
  float v[8];
  float run = 0.f;
#pragma unroll
  for (int i = 0; i < 8; i++) {
    const int t = b * SEQ + tid * 8 + i;
    const float xx = p.gates[(size_t)t * 16 + 8 + hf] + bias;
    const float ls = fminf(xx, 0.f) - log1pf(__expf(-fabsf(xx)));
    run += ls;
    v[i] = run;
  }
  float tot = run;
#pragma unroll
  for (int off = 1; off < 64; off <<= 1) {
    float nb = __shfl_up(tot, off);
    if (lane >= off) tot += nb;
  }
  __syncthreads();
  if (lane == 63) red[wave] = tot;
  __syncthreads();
  float base = tot - run;
  for (int w = 0; w < wave; w++) base += red[w];
#pragma unroll
  for (int i = 0; i < 8; i++) p.cf[(size_t)bhf * SEQ + tid * 8 + i] = v[i] + base;
}

__device__ void phase_gdnprep(const P& p, unsigned char* smem) {
  GdnSmem& s = *(GdnSmem*)smem;
  for (int u = blockIdx.x; u < 1024 + 64; u += gridDim.x) {
    if (u < 1024) gdn_unit(p, u, s);
    else { __syncthreads(); fox_cumsum_unit(p, u - 1024, (float*)smem); }
  }
}

#define SLD 136
struct ScanSmem { u16 st[2][128 * SLD]; };

__device__ __forceinline__ void scan_load_m(const P& p, int unit, int w, int l15, int g, bf16x8 (&mf)[2][4]) {
  int la = (32 * w + l15) * 128 + 8 * g;
  asm volatile("" : "+v"(la));
  const u16* gM = p.gM + (size_t)unit * 16384;
#pragma unroll
  for (int md = 0; md < 2; md++)
#pragma unroll
    for (int ks = 0; ks < 4; ks++) mf[md][ks] = *(const bf16x8*)&gM[la + md * 16 * 128 + ks * 32];
}
__device__ __forceinline__ void scan_load_c(const P& p, int unit, int w, int l15, int g, uint2 (&ci)[2][8], float& dl) {
  int lc = l15 * 128 + 32 * w + 4 * g;
  asm volatile("" : "+v"(lc));
  const u16* gC = p.gC + (size_t)unit * 16384;
#pragma unroll
  for (int md = 0; md < 2; md++)
#pragma unroll
    for (int ne = 0; ne < 8; ne++) ci[md][ne] = *(const uint2*)&gC[lc + ne * 16 * 128 + md * 16];
  dl = p.gdl[unit];
}

__device__ __forceinline__ void scan_step(const P& p, int unit, int n, int w, int l15, int g, ScanSmem& s,
                                          f32x4 (&st)[2][8], uint2 (&ci)[2][8], float& dl, const bf16x8 (&mf)[2][4]) {
  const u16* Sb = s.st[n & 1];
  u16* Sn = s.st[(n & 1) ^ 1];
#pragma unroll
  for (int md = 0; md < 2; md++)
#pragma unroll
    for (int ne = 0; ne < 8; ne++) {
      float c[4];
      unpack4(ci[md][ne], c);
      st[md][ne][0] = st[md][ne][0] * dl + c[0];
      st[md][ne][1] = st[md][ne][1] * dl + c[1];
      st[md][ne][2] = st[md][ne][2] * dl + c[2];
      st[md][ne][3] = st[md][ne][3] * dl + c[3];
    }
  if (n + 1 < 32) scan_load_c(p, unit + 1, w, l15, g, ci, dl);
  if (n > 0) {
    int lb = l15 * SLD + 8 * g;
    asm volatile("" : "+v"(lb));
#pragma unroll
    for (int ne = 0; ne < 8; ne++) {
#pragma unroll
      for (int ks = 0; ks < 4; ks++) {
        const bf16x8 bs = *(const bf16x8*)&Sb[lb + 16 * ne * SLD + ks * 32];
        st[0][ne] = mfma16(mf[0][ks], bs, st[0][ne]);
        st[1][ne] = mfma16(mf[1][ks], bs, st[1][ne]);
      }
    }
  }
  if (n + 1 < 32) {
    u16* gS = p.gS + (size_t)(unit + 1) * 16384;
    int lsl = l15 * SLD + 32 * w + 4 * g, lsg = l15 * 128 + 32 * w + 4 * g;
    asm volatile("" : "+v"(lsl), "+v"(lsg));
#pragma unroll
    for (int md = 0; md < 2; md++)
#pragma unroll
      for (int ne = 0; ne < 8; ne++) {
        uint2 o; o.x = pack2(st[md][ne][0], st[md][ne][1]); o.y = pack2(st[md][ne][2], st[md][ne][3]);
        *(uint2*)&Sn[lsl + 16 * ne * SLD + 16 * md] = o;
        *(uint2*)&gS[lsg + 16 * ne * 128 + 16 * md] = o;
      }
  }
  __syncthreads();
}

__device__ void scan_unit(const P& p, int bh, ScanSmem& s) {
  int tid = threadIdx.x;
  asm volatile("" : "+v"(tid));
  const int lane = tid & 63, w = tid >> 6;
  const int l15 = lane & 15, g = lane >> 4;
  f32x4 st[2][8];
#pragma unroll
  for (int md = 0; md < 2; md++)
#pragma unroll
    for (int ne = 0; ne < 8; ne++) st[md][ne] = (f32x4){0.f, 0.f, 0.f, 0.f};
  bf16x8 mfa[2][4], mfb[2][4];
  uint2 ci[2][8];
  float dl;
  scan_load_c(p, bh * 32, w, l15, g, ci, dl);
  scan_load_m(p, bh * 32, w, l15, g, mfa);
#pragma unroll 1
  for (int n = 0; n < 32; n += 2) {
    scan_load_m(p, bh * 32 + n + 1, w, l15, g, mfb);
    scan_step(p, bh * 32 + n, n, w, l15, g, s, st, ci, dl, mfa);
    if (n + 2 < 32) scan_load_m(p, bh * 32 + n + 2, w, l15, g, mfa);
    scan_step(p, bh * 32 + n + 1, n + 1, w, l15, g, s, st, ci, dl, mfb);
  }
}

#define OLD 136
struct GoutSmem { float ssq[4][64]; u16 ob[64 * OLD]; };

__device__ void gout_unit(const P& p, int unit, GoutSmem& s) {
  const int tid = threadIdx.x, lane = tid & 63, w = tid >> 6;
  const int l15 = lane & 15, g = lane >> 4;
  const int bh = unit >> 5, n = unit & 31;
  const int b = bh >> 2, h = bh & 3;
  const u16* gQ = p.gQ + (size_t)unit * 8192;
  const u16* gO = p.gO + (size_t)unit * 8192;
  const u16* gS = p.gS + (size_t)unit * 16384;
  f32x4 o[4][2];
#pragma unroll
  for (int mc = 0; mc < 4; mc++)
#pragma unroll
    for (int ne = 0; ne < 2; ne++) {
      float c[4];
      unpack4(*(const uint2*)&gO[(32 * w + 16 * ne + l15) * 64 + 16 * mc + 4 * g], c);
      o[mc][ne] = (f32x4){c[0], c[1], c[2], c[3]};
    }
  if (n > 0) {
    bf16x8 bs[2][4];
#pragma unroll
    for (int ne = 0; ne < 2; ne++)
#pragma unroll
      for (int ks = 0; ks < 4; ks++) bs[ne][ks] = *(const bf16x8*)&gS[(32 * w + 16 * ne + l15) * 128 + ks * 32 + 8 * g];
#pragma unroll
    for (int mc = 0; mc < 4; mc++) {
#pragma unroll
      for (int ks = 0; ks < 4; ks++) {
        const bf16x8 aq = *(const bf16x8*)&gQ[(16 * mc + l15) * 128 + ks * 32 + 8 * g];
        o[mc][0] = mfma16(aq, bs[0][ks], o[mc][0]);
        o[mc][1] = mfma16(aq, bs[1][ks], o[mc][1]);
      }
    }
  }
  const float gnw0 = p.gdn_norm_w[32 * w + l15], gnw1 = p.gdn_norm_w[32 * w + 16 + l15];
  __syncthreads();
#pragma unroll
  for (int mc = 0; mc < 4; mc++)
#pragma unroll
    for (int r = 0; r < 4; r++) {
      float sq = o[mc][0][r] * o[mc][0][r] + o[mc][1][r] * o[mc][1][r];
#pragma unroll
      for (int off = 1; off < 16; off <<= 1) sq += __shfl_xor(sq, off);
      if (l15 == 0) s.ssq[w][16 * mc + 4 * g + r] = sq;
    }
  __syncthreads();
#pragma unroll
  for (int mc = 0; mc < 4; mc++)
#pragma unroll
    for (int r = 0; r < 4; r++) {
      const int c = 16 * mc + 4 * g + r;
      const float tot = s.ssq[0][c] + s.ssq[1][c] + s.ssq[2][c] + s.ssq[3][c];
      const float rs = rsqrtf(tot * (1.f / 128.f) + EPSV);
      s.ob[c * OLD + 32 * w + l15] = f2bf(o[mc][0][r] * rs * gnw0);
      s.ob[c * OLD + 32 * w + 16 + l15] = f2bf(o[mc][1][r] * rs * gnw1);
    }
  __syncthreads();
  {
    const int t0 = b * SEQ + n * 64;
    const int c0 = tid >> 4, ch = tid & 15;
    const u16* zp = p.proj + (size_t)(t0 + c0) * PROJW + 1536 + h * 128 + ch * 8;
    u16* op = p.actA + (size_t)(t0 + c0) * DM + h * 128 + ch * 8;
#pragma unroll
    for (int i = 0; i < 4; i++) {
      float ov[8], zv[8];
      unpack8(*(const uint4*)&s.ob[(c0 + 16 * i) * OLD + ch * 8], ov);
      unpack8(*(const uint4*)(zp + (size_t)i * 16 * PROJW), zv);
      uint4 r;
      r.x = pack2(ov[0] * siluf(zv[0]), ov[1] * siluf(zv[1])); r.y = pack2(ov[2] * siluf(zv[2]), ov[3] * siluf(zv[3]));
      r.z = pack2(ov[4] * siluf(zv[4]), ov[5] * siluf(zv[5])); r.w = pack2(ov[6] * siluf(zv[6]), ov[7] * siluf(zv[7]));
      *(uint4*)(op + (size_t)i * 16 * DM) = r;
    }
  }
}

__device__ void phase_gout(const P& p, unsigned char* smem) {
  GoutSmem& s = *(GoutSmem*)smem;
  for (int u = blockIdx.x; u < 1024; u += gridDim.x) gout_unit(p, u, s);
}

#define PLD 72
__device__ void attn_unit(const P& p, int item, u16* psm) {
  int tid = threadIdx.x;
  asm volatile("" : "+v"(tid));
  const int lane = tid & 63, w = tid >> 6;
  const int l15 = lane & 15, g = lane >> 4;
  const int qb = 15 - (item >> 6), bhf = item & 63;
  const int b = bhf >> 3, hf = bhf & 7;
  const int q0 = qb * 128 + 32 * w;
  u16* Pw = psm + w * (32 * PLD);
  const u16* qbase = p.proj + (size_t)(b * SEQ) * PROJW + 2048 + hf * 64;
  const u16* kbase = p.proj + (size_t)(b * SEQ) * PROJW + 2560 + hf * 64;
  const u16* vbase = p.vt + (size_t)bhf * 64 * SEQ;
  const float* cfb = p.cf + (size_t)bhf * SEQ;
  bf16x8 qf[2][2];
#pragma unroll
  for (int mi = 0; mi < 2; mi++)
#pragma unroll
    for (int ks = 0; ks < 2; ks++) qf[mi][ks] = *(const bf16x8*)&qbase[(size_t)(q0 + 16 * mi + l15) * PROJW + ks * 32 + g * 8];
  float cq[2][4], m[2][4], lsum[2][4];
  f32x4 O[2][4];
#pragma unroll
  for (int mi = 0; mi < 2; mi++) {
#pragma unroll
    for (int r = 0; r < 4; r++) { cq[mi][r] = cfb[q0 + 16 * mi + 4 * g + r]; m[mi][r] = -1e30f; lsum[mi][r] = 0.f; }
#pragma unroll
    for (int nd = 0; nd < 4; nd++) O[mi][nd] = (f32x4){0.f, 0.f, 0.f, 0.f};
  }
  const int ntile = (q0 + 32 + 63) >> 6;
#pragma unroll 1
  for (int kt = 0; kt < ntile; kt++) {
    const int k0 = kt * 64;
    f32x4 S[2][4];
#pragma unroll
    for (int ni = 0; ni < 4; ni++) {
      bf16x8 kf0 = *(const bf16x8*)&kbase[(size_t)(k0 + 16 * ni + l15) * PROJW + g * 8];
      bf16x8 kf1 = *(const bf16x8*)&kbase[(size_t)(k0 + 16 * ni + l15) * PROJW + 32 + g * 8];
#pragma unroll
      for (int mi = 0; mi < 2; mi++) {
        f32x4 acc = {0.f, 0.f, 0.f, 0.f};
        acc = mfma16(qf[mi][0], kf0, acc);
        acc = mfma16(qf[mi][1], kf1, acc);
        S[mi][ni] = acc;
      }
    }
    float ck[4];
#pragma unroll
    for (int ni = 0; ni < 4; ni++) ck[ni] = cfb[k0 + 16 * ni + l15];
#pragma unroll
    for (int mi = 0; mi < 2; mi++)
#pragma unroll
      for (int r = 0; r < 4; r++) {
        const int qpos = q0 + 16 * mi + 4 * g + r;
        float mx = -1e30f;
#pragma unroll
        for (int ni = 0; ni < 4; ni++) {
          const int kpos = k0 + 16 * ni + l15;
          float lg = S[mi][ni][r] * 0.125f + cq[mi][r] - ck[ni];
          lg = (kpos <= qpos) ? lg : -1e30f;
          S[mi][ni][r] = lg;
          mx = fmaxf(mx, lg);
        }
#pragma unroll
        for (int off = 1; off < 16; off <<= 1) mx = fmaxf(mx, __shfl_xor(mx, off));
        const float mn = fmaxf(m[mi][r], mx);
        const float alpha = __expf(m[mi][r] - mn);
        m[mi][r] = mn;
        float ps = 0.f;
#pragma unroll
        for (int ni = 0; ni < 4; ni++) {
          const float pe = __expf(S[mi][ni][r] - mn);
          ps += pe;
          Pw[(16 * mi + 4 * g + r) * PLD + 16 * ni + l15] = f2bf(pe);
        }
        lsum[mi][r] = lsum[mi][r] * alpha + ps;
#pragma unroll
        for (int nd = 0; nd < 4; nd++) O[mi][nd][r] *= alpha;
      }
    LDS_FENCE();
    bf16x8 pf[2][2];
#pragma unroll
    for (int mi = 0; mi < 2; mi++)
#pragma unroll
      for (int ks = 0; ks < 2; ks++) pf[mi][ks] = *(const bf16x8*)&Pw[(16 * mi + l15) * PLD + ks * 32 + g * 8];
#pragma unroll
    for (int nd = 0; nd < 4; nd++) {
      bf16x8 vf0 = *(const bf16x8*)&vbase[(size_t)(16 * nd + l15) * SEQ + k0 + g * 8];
      bf16x8 vf1 = *(const bf16x8*)&vbase[(size_t)(16 * nd + l15) * SEQ + k0 + 32 + g * 8];
#pragma unroll
      for (int mi = 0; mi < 2; mi++) {
        O[mi][nd] = mfma16(pf[mi][0], vf0, O[mi][nd]);
        O[mi][nd] = mfma16(pf[mi][1], vf1, O[mi][nd]);
      }
    }
    LDS_FENCE();
  }
#pragma unroll
  for (int mi = 0; mi < 2; mi++)
#pragma unroll
    for (int r = 0; r < 4; r++) {
      float l = lsum[mi][r];
#pragma unroll
      for (int off = 1; off < 16; off <<= 1) l += __shfl_xor(l, off);
      const float inv = 1.f / l;
      const int t = b * SEQ + q0 + 16 * mi + 4 * g + r;
#pragma unroll
      for (int nd = 0; nd < 4; nd++) p.actA[(size_t)t * DM + 512 + hf * 64 + 16 * nd + l15] = f2bf(O[mi][nd][r] * inv);
    }
}

__device__ void deferred_transpose(const P& p, int it, float* tile) {
  const int n1 = 16 * 16, n2 = n1 + 16 * 88, n3 = n2 + 44 * 16, n4 = n3 + 16 * 16;
  if (it < n1) { transpose_item(p.w_out, 1024, p.wt_out, 1024, it % 16, it / 16, 1, tile); }
  else if (it < n2) { int j = it - n1; transpose_item(p.w_gate_up, 2 * DFF, p.wt_gu, 1024, j % 16, j / 16, 2, tile); }
  else if (it < n3) { int j = it - n2; transpose_item(p.w_down, 1024, p.wt_down, DFF, j % 44, j / 44, 1, tile); }
  else if (it < n4) { int j = it - n3; transpose_item(p.w_ple_gate, 1024, p.wt_pg, 1024, j % 16, j / 16, 1, tile); }
  else { int j = it - n4; transpose_item(p.w_ple_proj, 1024, p.wt_pp, 256, j % 4, j / 4, 1, tile); }
}
#define N_DEFER (16 * 16 + 16 * 88 + 44 * 16 + 16 * 16 + 4 * 16)

__device__ void phase_mixer(const P& p, unsigned char* smem) {
  __shared__ int s_item;
  for (;;) {
    __syncthreads();
    if (threadIdx.x == 0) s_item = (int)atomicAdd(&p.counters[0], 1u);
    __syncthreads();
    const int item = s_item;
    if (item >= 32 + 1024 + N_DEFER) break;
#ifndef NO_SCAN
    if (item < 32) scan_unit(p, item, *(ScanSmem*)smem);
#endif
#ifndef NO_ATTN
    if (item >= 32 && item < 32 + 1024) attn_unit(p, item - 32, (u16*)smem);
#endif
#ifndef NO_DEFER
    if (item >= 32 + 1024) deferred_transpose(p, item - 32 - 1024, (float*)smem);
#endif
  }
}

#define XB_TMO      128
#define XB_XCNT(j)  (256  + 64 * (j))
#define XB_XSUB(j)  (1280 + 64 * (j))
#define XB_XGEN(j)  (2304 + 64 * (j))
#define XB_TOP      3328
#define XB_TOPGEN   3392
#define XCD_BAR_WORDS 3456
#define XB_SPIN_CAP (1u << 20)
#define LAS __attribute__((address_space(3)))
__device__ __forceinline__ unsigned xb_ld(unsigned* p) { return __hip_atomic_load(p, __ATOMIC_RELAXED, __HIP_MEMORY_SCOPE_AGENT); }
__device__ __forceinline__ unsigned xb_add(unsigned* p, unsigned v) { return __hip_atomic_fetch_add(p, v, __ATOMIC_RELAXED, __HIP_MEMORY_SCOPE_AGENT); }
__device__ __forceinline__ unsigned xb_xcc_id() { return (unsigned)__builtin_amdgcn_s_getreg((3 << 11) | 20) & 0xFu; }
#define XB_SPIN(cond, bar) do { unsigned _sp = 0; while (cond) { __builtin_amdgcn_s_sleep(1); \
    if ((++_sp & 255u) == 0u) { if (xb_ld(&(bar)[XB_TMO])) break; if (_sp > XB_SPIN_CAP) { atomicAdd(&(bar)[XB_TMO], 1u); break; } } } } while (0)
struct XcdBarrier { unsigned* bar; unsigned x; volatile LAS unsigned* st; };
__device__ __forceinline__ XcdBarrier xcd_barrier_post(unsigned* bar, volatile LAS unsigned* st) {
  XcdBarrier b; b.bar = bar; b.x = xb_xcc_id(); b.st = st;
  if (threadIdx.x == 0) (void)xb_add(&bar[XB_XCNT(b.x)], 1u);
  return b;
}
__device__ __forceinline__ void xcd_barrier_complete(unsigned* bar, unsigned x, unsigned& nloc, unsigned& nx) {
  const unsigned G = gridDim.x * gridDim.y * gridDim.z;
  unsigned sum, cnt, mine, sp = 0u;
  for (;;) {
    sum = 0u; cnt = 0u; mine = 0u;
#pragma unroll
    for (unsigned j = 0; j < 16; ++j) { const unsigned c = xb_ld(&bar[XB_XCNT(j)]); sum += c; cnt += (c > 0u) ? 1u : 0u; mine = (j == x) ? c : mine; }
    if (sum == G) break;
    __builtin_amdgcn_s_sleep(1);
    if ((++sp & 255u) == 0u) { if (xb_ld(&bar[XB_TMO])) break; if (sp > XB_SPIN_CAP) { atomicAdd(&bar[XB_TMO], 1u); break; } }
  }
  nloc = mine > 0u ? mine : 1u; nx = cnt > 0u ? cnt : 1u;
}
__device__ __forceinline__ void xcd_barrier(const XcdBarrier& b) {
  asm volatile("s_waitcnt vmcnt(0)" ::: "memory");
  __syncthreads();
  if (threadIdx.x == 0) {
    unsigned* bar = b.bar;
    __builtin_amdgcn_s_waitcnt(0);
    unsigned nloc = b.st[0], nx = b.st[1];
    if (nloc == 0u) { xcd_barrier_complete(bar, b.x, nloc, nx); b.st[0] = nloc; b.st[1] = nx; }
    const unsigned old = xb_add(&bar[XB_XSUB(b.x)], 1u);
    const unsigned gen = old / nloc;
    if (old + 1u == (gen + 1u) * nloc) {
      __builtin_amdgcn_fence(__ATOMIC_RELEASE, "agent");
      asm volatile("s_waitcnt vmcnt(0)" ::: "memory");
      const unsigned og = xb_add(&bar[XB_TOP], 1u);
      const unsigned tg = og / nx;
      if (og + 1u == (tg + 1u) * nx) xb_add(&bar[XB_TOPGEN], 1u);
      else XB_SPIN(xb_ld(&bar[XB_TOPGEN]) == tg, bar);
      __builtin_amdgcn_fence(__ATOMIC_ACQUIRE, "agent");
      xb_add(&bar[XB_XGEN(b.x)], 1u);
      asm volatile("s_waitcnt vmcnt(0)" ::: "memory");
    } else {
      XB_SPIN(xb_ld(&bar[XB_XGEN(b.x)]) == gen, bar);
      __builtin_amdgcn_fence(__ATOMIC_ACQUIRE, "agent");
      asm volatile("s_waitcnt vmcnt(0)" ::: "memory");
    }
  }
  __syncthreads();
}

__global__ void __launch_bounds__(256, 2) mega(P p, int lo, int hi) {
  __shared__ __attribute__((aligned(16))) unsigned char smem[sizeof(GemmSmem)];
  __shared__ uint4 xb_words;
  cg::grid_group grid = cg::this_grid();
  if (threadIdx.x == 0) xb_words = make_uint4(0u, 0u, 0u, 0u);
  __syncthreads();
  XcdBarrier xb = xcd_barrier_post(p.bar, (volatile LAS unsigned*)&xb_words);
  if (hi < 0) grid.sync();
#define SEAM(k) if (lo <= k && k + 1 < hi) xcd_barrier(xb);
#if !defined(ONLY) || ONLY == 0
  if (lo <= 0 && 0 < hi) phase_prep(p, smem);
#endif
  SEAM(0)
#if !defined(ONLY) || ONLY == 1
  if (lo <= 1 && 1 < hi) phase_inproj(p, smem);
#endif
  SEAM(1)
#if !defined(ONLY) || ONLY == 2
  if (lo <= 2 && 2 < hi) phase_gdnprep(p, smem);
#endif
  SEAM(2)
#if !defined(ONLY) || ONLY == 3
  if (lo <= 3 && 3 < hi) phase_mixer(p, smem);
#endif
  SEAM(3)
#if !defined(ONLY) || ONLY == 4
  if (lo <= 4 && 4 < hi) phase_gout(p, smem);
#endif
  SEAM(4)
#if !defined(ONLY) || ONLY == 5
  if (lo <= 5 && 5 < hi) phase_outproj(p, smem);
#endif
  SEAM(5)
  if (lo <= 6 && 6 < hi) phase_rmsnorm(p.h, p.ffn_norm_w, p.actA, nullptr);
  SEAM(6)
#if !defined(ONLY) || ONLY == 7
  if (lo <= 7 && 7 < hi) phase_gateup(p, smem);
#endif
  SEAM(7)
#if !defined(ONLY) || ONLY == 8
  if (lo <= 8 && 8 < hi) phase_down(p, smem);
#endif
  SEAM(8)
  if (lo <= 9 && 9 < hi) phase_rmsnorm(p.h, p.ple_norm_w, p.actA, nullptr);
  SEAM(9)
#if !defined(ONLY) || ONLY == 10
  if (lo <= 10 && 10 < hi) phase_ple(p, smem);
#endif
  SEAM(10)
  if (lo <= 11 && 11 < hi) phase_rmsnorm(p.h, p.final_norm_w, nullptr, p.h);
}

static_assert(sizeof(GdnSmem) <= sizeof(GemmSmem), "smem");
static_assert(sizeof(ScanSmem) <= sizeof(GemmSmem), "smem");
static_assert(sizeof(GoutSmem) <= sizeof(GemmSmem), "smem");

extern "C" void kernel_launch(void* const* d_in, const int* in_sizes, int n_in, void* d_out, int out_size,
                              void* d_ws, size_t ws_size, hipStream_t stream) {
  static int grid_blocks = 0;
  if (!grid_blocks) {
    int dev = 0, cus = 0, per_cu = 0;
    hipGetDevice(&dev);
    hipDeviceGetAttribute(&cus, hipDeviceAttributeMultiprocessorCount, dev);
    hipOccupancyMaxActiveBlocksPerMultiprocessor(&per_cu, mega, 256, 0);
    if (per_cu > 2) per_cu = 2;
    if (per_cu < 1) per_cu = 1;
    grid_blocks = cus * per_cu;
  }
  P p{};
  const float* const* in = (const float* const*)d_in;
  p.x = in[0]; p.p = in[1]; p.attn_norm_w = in[2]; p.w_in = in[3]; p.conv_w = in[4]; p.a_log = in[5];
  p.dt_bias = in[6]; p.gdn_norm_w = in[7]; p.fox_f_bias = in[8]; p.w_out = in[9]; p.ffn_norm_w = in[10];
  p.w_gate_up = in[11]; p.w_down = in[12]; p.ple_norm_w = in[13]; p.w_ple_gate = in[14]; p.w_ple_proj = in[15];
  p.final_norm_w = in[16];
  p.h = (float*)d_out;
  unsigned char* ws = (unsigned char*)d_ws;
  size_t off = 0;
  auto take = [&](size_t bytes) { unsigned char* r = ws + off; off += (bytes + 255) & ~(size_t)255; return r; };
  p.counters = (unsigned*)take(256);
  p.bar = (unsigned*)take(XCD_BAR_WORDS * 4);
  p.wt_in = (u16*)take((size_t)NIN_PAD * 1024 * 2);
  p.wt_out = (u16*)take((size_t)1024 * 1024 * 2);
  p.wt_gu = (u16*)take((size_t)2 * DFF * 1024 * 2);
  p.wt_down = (u16*)take((size_t)1024 * DFF * 2);
  p.wt_pg = (u16*)take((size_t)1024 * 1024 * 2);
  p.wt_pp = (u16*)take((size_t)1024 * 256 * 2);
  p.actA = (u16*)take((size_t)NTOK * 1024 * 2);
  p.pb = (u16*)take((size_t)NTOK * 256 * 2);
  p.proj = (u16*)take((size_t)NTOK * PROJW * 2);
  p.vt = (u16*)take((size_t)64 * 64 * SEQ * 2);
  p.gates = (float*)take((size_t)NTOK * 16 * 4);
  p.cf = (float*)take((size_t)64 * SEQ * 4);
  p.gQ = (u16*)take((size_t)1024 * 8192 * 2);
  p.gO = (u16*)take((size_t)1024 * 8192 * 2);
  p.gS = (u16*)take((size_t)1024 * 16384 * 2);
  p.gdl = (float*)take(1024 * 4);
  if (off > ws_size) fprintf(stderr, "workspace too small: need %zu have %zu\n", off, ws_size);
  u16* ob = (u16*)d_out;
  p.gM = ob;
  p.gC = ob + (size_t)1024 * 16384;
  hipMemsetAsync(p.bar, 0, XCD_BAR_WORDS * 4, stream);
  int lo = 0, hi = NPHASE;
  void* args[] = {&p, &lo, &hi};
  hipError_t e = hipLaunchCooperativeKernel((void*)mega, dim3(grid_blocks), dim3(256), args, 0, stream);
  if (e != hipSuccess) fprintf(stderr, "cooperative launch failed: %s (grid %d)\n", hipGetErrorString(e), grid_blocks);
}
```

```cpp
#include <hip/hip_runtime.h>
#include <hip/hip_cooperative_groups.h>
#include <cstdio>
#include <cstdint>
namespace cg = cooperative_groups;

typedef unsigned short u16;
typedef __attribute__((ext_vector_type(8))) short bf16x8;
typedef __attribute__((ext_vector_type(4))) float f32x4;

#define NTOK 16384
#define SEQ 2048
#define DM 1024
#define DFF 2816
#define PROJW 3072
#define NIN_PAD 3712
#define EPSV 1e-6f
#define NPHASE 12

struct P {
  const float *x, *p, *attn_norm_w, *w_in, *conv_w, *a_log, *dt_bias, *gdn_norm_w, *fox_f_bias, *w_out,
      *ffn_norm_w, *w_gate_up, *w_down, *ple_norm_w, *w_ple_gate, *w_ple_proj, *final_norm_w;
  float* h;
  u16 *wt_in, *wt_out, *wt_gu, *wt_down, *wt_pg, *wt_pp;
  u16 *actA;
  u16 *pb;
  u16 *proj;
  u16 *vt;
  float *gates;
  float *cf;
  u16 *gM, *gC;
  u16 *gQ, *gO;
  u16 *gS;
  float *gdl;
  unsigned *counters;
  unsigned *bar;
};

typedef __attribute__((ext_vector_type(2))) float f32x2_t;
typedef __attribute__((ext_vector_type(2))) __bf16 bf16x2_t;
__device__ __forceinline__ u16 f2bf(float f) { return __builtin_bit_cast(u16, (__bf16)f); }
__device__ __forceinline__ float bf2f(u16 h) { return __uint_as_float(((unsigned)h) << 16); }
__device__ __forceinline__ unsigned pack2(float a, float b) {
  f32x2_t f = {a, b};
  return __builtin_bit_cast(unsigned, __builtin_convertvector(f, bf16x2_t));
}
__device__ __forceinline__ float siluf(float v) { return v / (1.f + __expf(-v)); }
__device__ __forceinline__ float sigmoidf_(float v) { return 1.f / (1.f + __expf(-v)); }
__device__ __forceinline__ f32x4 mfma16(bf16x8 a, bf16x8 b, f32x4 c) {
  return __builtin_amdgcn_mfma_f32_16x16x32_bf16(a, b, c, 0, 0, 0);
}
#define LDS_FENCE() asm volatile("s_waitcnt lgkmcnt(0)" ::: "memory")

__device__ __forceinline__ int colmap(int kind, int nn) {
  if (kind == 0) {
    if (nn < 2048) return nn;
    if (nn < 3584) return nn + 8;
    if (nn < 3588) return 2048 + (nn - 3584);
    if (nn < 3592) return 2052 + (nn - 3588);
    if (nn < 3600) return nn;
    return -1;
  } else if (kind == 2) {
    int i = nn >> 7, wc = (nn >> 6) & 1, u = (nn >> 5) & 1, j = nn & 31;
    return u * DFF + 64 * i + 32 * wc + j;
  }
  return nn;
}

__device__ void transpose_item(const float* __restrict__ src, int ldsrc, u16* __restrict__ dst, int K,
                               int kt, int nt, int kind, float* tile) {
  int tid = threadIdx.x;
  asm volatile("" : "+v"(tid));
  const int c = tid & 63, r0 = tid >> 6;
  const int ncol = colmap(kind, nt * 64 + c);
#pragma unroll 4
  for (int i = 0; i < 16; i++) {
    int r = r0 + 4 * i;
    float v = (ncol >= 0) ? src[(size_t)(kt * 64 + r) * ldsrc + ncol] : 0.f;
    tile[r * 65 + c] = v;
  }
  __syncthreads();
#pragma unroll 4
  for (int i = 0; i < 16; i++) {
    int rn = r0 + 4 * i;
    dst[(size_t)(nt * 64 + rn) * K + kt * 64 + c] = f2bf(tile[c * 65 + rn]);
  }
  __syncthreads();
}

__device__ __forceinline__ void rmsnorm_row(const float* src, const float* __restrict__ w,
                                            u16* dstb, float* dstf, int row) {
  const int lane = threadIdx.x & 63;
  float4 v[4];
  float ss = 0.f;
#pragma unroll
  for (int i = 0; i < 4; i++) {
    v[i] = *(const float4*)&src[(size_t)row * DM + i * 256 + lane * 4];
    ss += v[i].x * v[i].x + v[i].y * v[i].y + v[i].z * v[i].z + v[i].w * v[i].w;
  }
#pragma unroll
  for (int off = 32; off >= 1; off >>= 1) ss += __shfl_xor(ss, off);
  const float r = rsqrtf(ss * (1.f / DM) + EPSV);
#pragma unroll
  for (int i = 0; i < 4; i++) {
    const int col = i * 256 + lane * 4;
    float4 wv = *(const float4*)&w[col];
    float y0 = v[i].x * r * wv.x, y1 = v[i].y * r * wv.y, y2 = v[i].z * r * wv.z, y3 = v[i].w * r * wv.w;
    if (dstb) {
      uint2 o; o.x = pack2(y0, y1); o.y = pack2(y2, y3);
      *(uint2*)&dstb[(size_t)row * DM + col] = o;
    } else {
      *(float4*)&dstf[(size_t)row * DM + col] = make_float4(y0, y1, y2, y3);
    }
  }
}

__device__ void phase_prep(const P& p, unsigned char* smem) {
  float* tile = (float*)smem;
  if (blockIdx.x == 0 && threadIdx.x < 16) p.counters[threadIdx.x] = 0u;
  for (int it = blockIdx.x; it < 16 * 58; it += gridDim.x) transpose_item(p.w_in, 3600, p.wt_in, 1024, it % 16, it / 16, 0, tile);
  const int wave = threadIdx.x >> 6, lane = threadIdx.x & 63;
  for (int rb = blockIdx.x; rb < NTOK / 4; rb += gridDim.x) {
    const int row = rb * 4 + wave;
    rmsnorm_row(p.x, p.attn_norm_w, p.actA, nullptr, row);
    float4 pv = *(const float4*)&p.p[(size_t)row * 256 + lane * 4];
    uint2 o; o.x = pack2(pv.x, pv.y); o.y = pack2(pv.z, pv.w);
    *(uint2*)&p.pb[(size_t)row * 256 + lane * 4] = o;
  }
}

__device__ void phase_rmsnorm(const float* src, const float* w, u16* dstb, float* dstf) {
  const int wave = threadIdx.x >> 6;
  for (int rb = blockIdx.x; rb < NTOK / 4; rb += gridDim.x) rmsnorm_row(src, w, dstb, dstf, rb * 4 + wave);
}

#define GK 64
#define GLD 72
struct GemmSmem { u16 a[2][128 * GLD]; u16 b[2][128 * GLD]; };

__device__ __forceinline__ void gemm_tile(const u16* __restrict__ A, int lda, const u16* __restrict__ Bt, int ldb,
                                          int K, int m0, int n0, GemmSmem& s, f32x4 (&acc)[4][4]) {
  const int tid = threadIdx.x, lane = tid & 63, wave = tid >> 6;
  const int wr = wave >> 1, wc = wave & 1;
  const int l15 = lane & 15, g = lane >> 4;
  const int nk = K / GK;
  uint4 ra0, ra1, ra2, ra3, rb0, rb1, rb2, rb3;
  const int crow = tid >> 3, ccol = (tid & 7) * 8;
  const u16* Ap = A + (size_t)(m0 + crow) * lda + ccol;
  const u16* Bp = Bt + (size_t)(n0 + crow) * ldb + ccol;
  const size_t sa = (size_t)32 * lda, sb = (size_t)32 * ldb;
#define G_LOAD(koff) \
  ra0 = *(const uint4*)(Ap + (koff)); ra1 = *(const uint4*)(Ap + sa + (koff)); \
  ra2 = *(const uint4*)(Ap + 2 * sa + (koff)); ra3 = *(const uint4*)(Ap + 3 * sa + (koff)); \
  rb0 = *(const uint4*)(Bp + (koff)); rb1 = *(const uint4*)(Bp + sb + (koff)); \
  rb2 = *(const uint4*)(Bp + 2 * sb + (koff)); rb3 = *(const uint4*)(Bp + 3 * sb + (koff));
#define G_STORE(bufi) \
  *(uint4*)&s.a[bufi][(crow) * GLD + ccol] = ra0; *(uint4*)&s.a[bufi][(crow + 32) * GLD + ccol] = ra1; \
  *(uint4*)&s.a[bufi][(crow + 64) * GLD + ccol] = ra2; *(uint4*)&s.a[bufi][(crow + 96) * GLD + ccol] = ra3; \
  *(uint4*)&s.b[bufi][(crow) * GLD + ccol] = rb0; *(uint4*)&s.b[bufi][(crow + 32) * GLD + ccol] = rb1; \
  *(uint4*)&s.b[bufi][(crow + 64) * GLD + ccol] = rb2; *(uint4*)&s.b[bufi][(crow + 96) * GLD + ccol] = rb3;
  G_LOAD(0)
  __syncthreads();
  G_STORE(0)
  __syncthreads();
  for (int kt = 0; kt < nk; kt++) {
    const int buf = kt & 1;
    if (kt + 1 < nk) { G_LOAD((kt + 1) * GK) }
#pragma unroll
    for (int ks = 0; ks < 2; ks++) {
      bf16x8 af[4], bfr[4];
#pragma unroll
      for (int mi = 0; mi < 4; mi++) af[mi] = *(const bf16x8*)&s.a[buf][(wr * 64 + mi * 16 + l15) * GLD + ks * 32 + g * 8];
#pragma unroll
      for (int ni = 0; ni < 4; ni++) bfr[ni] = *(const bf16x8*)&s.b[buf][(wc * 64 + ni * 16 + l15) * GLD + ks * 32 + g * 8];
#pragma unroll
      for (int mi = 0; mi < 4; mi++)
#pragma unroll
        for (int ni = 0; ni < 4; ni++) acc[mi][ni] = mfma16(af[mi], bfr[ni], acc[mi][ni]);
    }
    if (kt + 1 < nk) {
      if (buf) { G_STORE(0) } else { G_STORE(1) }
    }
    __syncthreads();
  }
}

#define ZERO_ACC(acc) _Pragma("unroll") for (int _i = 0; _i < 4; _i++) _Pragma("unroll") for (int _j = 0; _j < 4; _j++) acc[_i][_j] = (f32x4){0.f, 0.f, 0.f, 0.f};

__device__ void phase_inproj(const P& p, unsigned char* smem) {
  GemmSmem& s = *(GemmSmem*)smem;
  const int lane = threadIdx.x & 63, wave = threadIdx.x >> 6, wr = wave >> 1, wc = wave & 1, l15 = lane & 15, g = lane >> 4;
  const int ntiles = 128 * 29;
  for (int tl = blockIdx.x; tl < ntiles; tl += gridDim.x) {
    const int mt = tl & 127, nt = tl >> 7;
    const int m0 = mt * 128, n0 = nt * 128;
    f32x4 acc[4][4];
    ZERO_ACC(acc);
    gemm_tile(p.actA, DM, p.wt_in, DM, DM, m0, n0, s, acc);
#pragma unroll
    for (int mi = 0; mi < 4; mi++)
#pragma unroll
      for (int ni = 0; ni < 4; ni++) {
        const int rowb = m0 + wr * 64 + mi * 16 + g * 4;
        const int col = n0 + wc * 64 + ni * 16 + l15;
        if (nt < 24) {
#pragma unroll
          for (int r = 0; r < 4; r++) p.proj[(size_t)(rowb + r) * PROJW + col] = f2bf(acc[mi][ni][r]);
        } else if (nt < 28) {
          const int cc = col - 3072, hh = cc >> 6, d = cc & 63;
          const int b = rowb >> 11, sq = rowb & 2047;
          uint2 o; o.x = pack2(acc[mi][ni][0], acc[mi][ni][1]); o.y = pack2(acc[mi][ni][2], acc[mi][ni][3]);
          *(uint2*)&p.vt[((size_t)((b * 8 + hh) * 64 + d)) * SEQ + sq] = o;
        } else {
          if (col < 3600) {
#pragma unroll
            for (int r = 0; r < 4; r++) p.gates[(size_t)(rowb + r) * 16 + (col - 3584)] = acc[mi][ni][r];
          }
        }
      }
  }
}

__device__ void phase_outproj(const P& p, unsigned char* smem) {
  GemmSmem& s = *(GemmSmem*)smem;
  const int lane = threadIdx.x & 63, wave = threadIdx.x >> 6, wr = wave >> 1, wc = wave & 1, l15 = lane & 15, g = lane >> 4;
  for (int tl = blockIdx.x; tl < 128 * 8; tl += gridDim.x) {
    const int mt = tl & 127, nt = tl >> 7;
    const int m0 = mt * 128, n0 = nt * 128;
    f32x4 acc[4][4];
    ZERO_ACC(acc);
    gemm_tile(p.actA, DM, p.wt_out, DM, DM, m0, n0, s, acc);
#pragma unroll
    for (int mi = 0; mi < 4; mi++)
#pragma unroll
      for (int ni = 0; ni < 4; ni++) {
        const int rowb = m0 + wr * 64 + mi * 16 + g * 4;
        const int col = n0 + wc * 64 + ni * 16 + l15;
#pragma unroll
        for (int r = 0; r < 4; r++) {
          size_t idx = (size_t)(rowb + r) * DM + col;
          p.h[idx] = p.x[idx] + acc[mi][ni][r];
        }
      }
  }
}

__device__ void phase_gateup(const P& p, unsigned char* smem) {
  GemmSmem& s = *(GemmSmem*)smem;
  u16* act = p.proj;
  const int lane = threadIdx.x & 63, wave = threadIdx.x >> 6, wr = wave >> 1, wc = wave & 1, l15 = lane & 15, g = lane >> 4;
  for (int tl = blockIdx.x; tl < 128 * 44; tl += gridDim.x) {
    const int mt = tl & 127, nt = tl >> 7;
    const int m0 = mt * 128, n0 = nt * 128;
    f32x4 acc[4][4];
    ZERO_ACC(acc);
    gemm_tile(p.actA, DM, p.wt_gu, DM, DM, m0, n0, s, acc);
#pragma unroll
    for (int mi = 0; mi < 4; mi++)
#pragma unroll
      for (int ni = 0; ni < 2; ni++) {
        const int rowb = m0 + wr * 64 + mi * 16 + g * 4;
        const int col = 64 * nt + 32 * wc + 16 * ni + l15;
#pragma unroll
        for (int r = 0; r < 4; r++) {
          float gt = acc[mi][ni][r], up = acc[mi][ni + 2][r];
          act[(size_t)(rowb + r) * DFF + col] = f2bf(siluf(gt) * up);
        }
      }
  }
}

__device__ void phase_down(const P& p, unsigned char* smem) {
  GemmSmem& s = *(GemmSmem*)smem;
  const u16* act = p.proj;
  const int lane = threadIdx.x & 63, wave = threadIdx.x >> 6, wr = wave >> 1, wc = wave & 1, l15 = lane & 15, g = lane >> 4;
  for (int tl = blockIdx.x; tl < 128 * 8; tl += gridDim.x) {
    const int mt = tl & 127, nt = tl >> 7;
    const int m0 = mt * 128, n0 = nt * 128;
    f32x4 acc[4][4];
    ZERO_ACC(acc);
    gemm_tile(act, DFF, p.wt_down, DFF, DFF, m0, n0, s, acc);
#pragma unroll
    for (int mi = 0; mi < 4; mi++)
#pragma unroll
      for (int ni = 0; ni < 4; ni++) {
        const int rowb = m0 + wr * 64 + mi * 16 + g * 4;
        const int col = n0 + wc * 64 + ni * 16 + l15;
#pragma unroll
        for (int r = 0; r < 4; r++) {
          size_t idx = (size_t)(rowb + r) * DM + col;
          p.h[idx] += acc[mi][ni][r];
        }
      }
  }
}

__device__ void phase_ple(const P& p, unsigned char* smem) {
  GemmSmem& s = *(GemmSmem*)smem;
  const int lane = threadIdx.x & 63, wave = threadIdx.x >> 6, wr = wave >> 1, wc = wave & 1, l15 = lane & 15, g = lane >> 4;
  for (int tl = blockIdx.x; tl < 128 * 8; tl += gridDim.x) {
    const int mt = tl & 127, nt = tl >> 7;
    const int m0 = mt * 128, n0 = nt * 128;
    f32x4 acc[4][4], acc2[4][4];
    ZERO_ACC(acc);
    gemm_tile(p.actA, DM, p.wt_pg, DM, DM, m0, n0, s, acc);
#pragma unroll
    for (int mi = 0; mi < 4; mi++)
#pragma unroll
      for (int ni = 0; ni < 4; ni++)
#pragma unroll
        for (int r = 0; r < 4; r++) acc[mi][ni][r] = sigmoidf_(acc[mi][ni][r]);
    ZERO_ACC(acc2);
    gemm_tile(p.pb, 256, p.wt_pp, 256, 256, m0, n0, s, acc2);
#pragma unroll
    for (int mi = 0; mi < 4; mi++)
#pragma unroll
      for (int ni = 0; ni < 4; ni++) {
        const int rowb = m0 + wr * 64 + mi * 16 + g * 4;
        const int col = n0 + wc * 64 + ni * 16 + l15;
#pragma unroll
        for (int r = 0; r < 4; r++) {
          size_t idx = (size_t)(rowb + r) * DM + col;
          p.h[idx] += acc[mi][ni][r] * acc2[mi][ni][r];
        }
      }
  }
}

#define QLD 136
#define KLD 72
struct GdnSmem {
  u16 qb[64 * QLD];
  u16 kn[64 * QLD];
  u16 vb[64 * QLD];
  float Am[64 * 64];
  float gc[64], beta[64], be[64];
};
static_assert(offsetof(GdnSmem, kn) == 17408 && offsetof(GdnSmem, vb) == 34816 && offsetof(GdnSmem, Am) == 52224, "layout");

__device__ __forceinline__ void unpack8(const uint4& v, float (&f)[8]) {
  f[0] = bf2f((u16)(v.x & 0xffffu)); f[1] = bf2f((u16)(v.x >> 16));
  f[2] = bf2f((u16)(v.y & 0xffffu)); f[3] = bf2f((u16)(v.y >> 16));
  f[4] = bf2f((u16)(v.z & 0xffffu)); f[5] = bf2f((u16)(v.z >> 16));
  f[6] = bf2f((u16)(v.w & 0xffffu)); f[7] = bf2f((u16)(v.w >> 16));
}
__device__ __forceinline__ void unpack4(const uint2& v, float (&f)[4]) {
  f[0] = bf2f((u16)(v.x & 0xffffu)); f[1] = bf2f((u16)(v.x >> 16));
  f[2] = bf2f((u16)(v.y & 0xffffu)); f[3] = bf2f((u16)(v.y >> 16));
}

__device__ void gdn_unit(const P& p, int unit, GdnSmem& s) {
  int tid = threadIdx.x;
  asm volatile("" : "+v"(tid));
  int lane = tid & 63, wave = tid >> 6;
  int l15 = lane & 15, g = lane >> 4;
#define GDN_REFRESH() do { tid = threadIdx.x; asm volatile("" : "+v"(tid) :: "memory"); lane = tid & 63; wave = tid >> 6; l15 = lane & 15; g = lane >> 4; } while (0)
  const int bh = unit >> 5, n = unit & 31;
  const int b = bh >> 2, h = bh & 3;
  const int tb = b * SEQ;
  const int s0 = n * 64;
  u16* const qk_s = s.qb;
  u16* const WU = s.kn;
  u16* const kdT = (u16*)((unsigned char*)s.kn + 32768);
  __syncthreads();
  if (wave == 0) {
    const int t = tb + s0 + lane;
    const float ga = p.gates[(size_t)t * 16 + h], gb = p.gates[(size_t)t * 16 + 4 + h];
    const float xx = ga + p.dt_bias[h];
    const float sp = (xx > 20.f) ? xx : log1pf(__expf(xx));
    float gg = -__expf(p.a_log[h]) * sp;
#pragma unroll
    for (int off = 1; off < 64; off <<= 1) {
      float nb = __shfl_up(gg, off);
      if (lane >= off) gg += nb;
    }
    const float bt = sigmoidf_(gb);
    s.gc[lane] = gg;
    s.beta[lane] = bt;
    s.be[lane] = bt * __expf(gg);
  }
  {
    const int ch = tid & 15, rg = tid >> 4;
#pragma unroll 1
    for (int mat = 0; mat < 3; mat++) {
      const int col0 = mat * 512 + h * 128 + ch * 8;
      float cw[4][8];
#pragma unroll
      for (int k = 0; k < 4; k++) {
        const float4 w0 = *(const float4*)&p.conv_w[k * 1536 + col0];
        const float4 w1 = *(const float4*)&p.conv_w[k * 1536 + col0 + 4];
        cw[k][0] = w0.x; cw[k][1] = w0.y; cw[k][2] = w0.z; cw[k][3] = w0.w;
        cw[k][4] = w1.x; cw[k][5] = w1.y; cw[k][6] = w1.z; cw[k][7] = w1.w;
      }
      uint4 xr[7];
#pragma unroll
      for (int j = 0; j < 7; j++) {
        const int sp = s0 + 4 * rg + j - 3;
        xr[j] = (sp >= 0) ? *(const uint4*)&p.proj[(size_t)(tb + sp) * PROJW + col0] : make_uint4(0u, 0u, 0u, 0u);
      }
      float xf[7][8];
#pragma unroll
      for (int j = 0; j < 7; j++) unpack8(xr[j], xf[j]);
      u16* dst = (mat == 0) ? s.qb : ((mat == 1) ? s.kn : s.vb);
#pragma unroll
      for (int r = 0; r < 4; r++) {
        float val[8];
        float ss = 0.f;
#pragma unroll
        for (int c = 0; c < 8; c++) {
          const float cv = cw[0][c] * xf[r][c] + cw[1][c] * xf[r + 1][c] + cw[2][c] * xf[r + 2][c] + cw[3][c] * xf[r + 3][c];
          val[c] = siluf(cv);
          ss += val[c] * val[c];
        }
        float rs = 1.f;
        if (mat < 2) {
#pragma unroll
          for (int off = 1; off < 16; off <<= 1) ss += __shfl_xor(ss, off);
          rs = rsqrtf(ss + EPSV) * ((mat == 0) ? 0.08838834764831845f : 1.f);
        }
        uint4 o;
        o.x = pack2(val[0] * rs, val[1] * rs); o.y = pack2(val[2] * rs, val[3] * rs);
        o.z = pack2(val[4] * rs, val[5] * rs); o.w = pack2(val[6] * rs, val[7] * rs);
        *(uint4*)&dst[(4 * rg + r) * QLD + ch * 8] = o;
      }
    }
  }
  __syncthreads();
  GDN_REFRESH();
  u16* const gQ = p.gQ + (size_t)unit * 8192;
  {
#pragma unroll
    for (int it = 0; it < 4; it++) {
      const int idx = tid + 256 * it;
      const int i = idx >> 4, d8 = (idx & 15) * 8;
      const float e = __expf(s.gc[i]);
      float f[8];
      unpack8(*(const uint4*)&s.qb[i * QLD + d8], f);
      uint4 o;
      o.x = pack2(f[0] * e, f[1] * e); o.y = pack2(f[2] * e, f[3] * e);
      o.z = pack2(f[4] * e, f[5] * e); o.w = pack2(f[6] * e, f[7] * e);
      *(uint4*)&gQ[i * 128 + d8] = o;
    }
  }
  f32x4 cqk[4];
  {
    bf16x8 aq[4], ak[4];
#pragma unroll
    for (int ks = 0; ks < 4; ks++) {
      aq[ks] = *(const bf16x8*)&s.qb[(wave * 16 + l15) * QLD + ks * 32 + g * 8];
      ak[ks] = *(const bf16x8*)&s.kn[(wave * 16 + l15) * QLD + ks * 32 + g * 8];
    }
#pragma unroll
    for (int ni = 0; ni < 4; ni++) {
      f32x4 ckk = {0.f, 0.f, 0.f, 0.f};
      cqk[ni] = (f32x4){0.f, 0.f, 0.f, 0.f};
      if (ni <= wave) {
#pragma unroll
        for (int ks = 0; ks < 4; ks++) {
          bf16x8 bk = *(const bf16x8*)&s.kn[(ni * 16 + l15) * QLD + ks * 32 + g * 8];
          ckk = mfma16(ak[ks], bk, ckk);
          cqk[ni] = mfma16(aq[ks], bk, cqk[ni]);
        }
      }
      const int j = ni * 16 + l15;
      const float gcj = s.gc[j];
#pragma unroll
      for (int r = 0; r < 4; r++) {
        const int i = wave * 16 + g * 4 + r;
        const float dec = (i >= j) ? __expf(s.gc[i] - gcj) : 0.f;
        s.Am[i * 64 + j] = (i > j) ? ckk[r] * s.beta[i] * dec : 0.f;
        cqk[ni][r] = (i >= j) ? cqk[ni][r] * dec : 0.f;
      }
    }
  }
  __syncthreads();
  GDN_REFRESH();
#pragma unroll
  for (int ni = 0; ni < 4; ni++)
#pragma unroll
    for (int r = 0; r < 4; r++) qk_s[(wave * 16 + g * 4 + r) * KLD + ni * 16 + l15] = f2bf(cqk[ni][r]);
  float xs[64];
#ifdef NO_SOLVE
  for (int i = 0; i < 64; i++) xs[i] = s.Am[i*64+tid%64];
#else
  {
    const int c = tid;
    const u16* src = (c < 128) ? &s.vb[c] : &s.kn[c - 128];
    const float* sc = (c < 128) ? s.beta : s.be;
#pragma unroll
    for (int i = 0; i < 64; i++) {
      float a0 = bf2f(src[i * QLD]) * sc[i], a1 = 0.f, a2 = 0.f, a3 = 0.f;
#pragma unroll
      for (int j4 = 0; j4 < (i + 3) / 4; j4++) {
        const float4 av = *(const float4*)&s.Am[i * 64 + j4 * 4];
        if (j4 * 4 + 0 < i) a0 -= av.x * xs[j4 * 4 + 0];
        if (j4 * 4 + 1 < i) a1 -= av.y * xs[j4 * 4 + 1];
        if (j4 * 4 + 2 < i) a2 -= av.z * xs[j4 * 4 + 2];
        if (j4 * 4 + 3 < i) a3 -= av.w * xs[j4 * 4 + 3];
      }
      xs[i] = (a0 + a1) + (a2 + a3);
      asm volatile("" : "+v"(xs[i]) :: "memory");
    }
  }
#endif
  const float glast = s.gc[63];
  __syncthreads();
  GDN_REFRESH();
  {
    const int d = tid & 127, half = tid >> 7;
#pragma unroll
    for (int q = 0; q < 4; q++) {
      unsigned ow[4];
#pragma unroll
      for (int e2 = 0; e2 < 4; e2++) {
        const int c0 = half * 32 + q * 8 + e2 * 2;
        const float v0 = bf2f(s.kn[c0 * QLD + d]) * __expf(glast - s.gc[c0]);
        const float v1 = bf2f(s.kn[(c0 + 1) * QLD + d]) * __expf(glast - s.gc[c0 + 1]);
        ow[e2] = pack2(v0, v1);
      }
      *(uint4*)&kdT[d * KLD + half * 32 + q * 8] = make_uint4(ow[0], ow[1], ow[2], ow[3]);
    }
    if (tid == 0) p.gdl[unit] = __expf(glast);
  }
  __syncthreads();
  GDN_REFRESH();
  if (tid >= 128) {
#pragma unroll
    for (int q = 0; q < 8; q++)
      *(uint4*)&WU[(tid - 128) * KLD + q * 8] = make_uint4(pack2(xs[q * 8], xs[q * 8 + 1]), pack2(xs[q * 8 + 2], xs[q * 8 + 3]),
                                                            pack2(xs[q * 8 + 4], xs[q * 8 + 5]), pack2(xs[q * 8 + 6], xs[q * 8 + 7]));
  }
  __syncthreads();
  GDN_REFRESH();
  {
    u16* const gM = p.gM + (size_t)unit * 16384;
    bf16x8 aw[2][2];
#pragma unroll
    for (int mm = 0; mm < 2; mm++)
#pragma unroll
      for (int ks = 0; ks < 2; ks++) aw[mm][ks] = *(const bf16x8*)&WU[((2 * wave + mm) * 16 + l15) * KLD + ks * 32 + g * 8];
#pragma unroll
    for (int nn = 0; nn < 8; nn++) {
      const bf16x8 b0 = *(const bf16x8*)&kdT[(nn * 16 + l15) * KLD + g * 8];
      const bf16x8 b1 = *(const bf16x8*)&kdT[(nn * 16 + l15) * KLD + 32 + g * 8];
#pragma unroll
      for (int mm = 0; mm < 2; mm++) {
        f32x4 acc = {0.f, 0.f, 0.f, 0.f};
        acc = mfma16(aw[mm][0], b0, acc);
        acc = mfma16(aw[mm][1], b1, acc);
        uint2 o; o.x = pack2(-acc[0], -acc[1]); o.y = pack2(-acc[2], -acc[3]);
        *(uint2*)&gM[(nn * 16 + l15) * 128 + (2 * wave + mm) * 16 + 4 * g] = o;
      }
    }
#pragma unroll
    for (int nn = 0; nn < 4; nn++) {
      const bf16x8 b0 = *(const bf16x8*)&qk_s[(nn * 16 + l15) * KLD + g * 8];
      const bf16x8 b1 = *(const bf16x8*)&qk_s[(nn * 16 + l15) * KLD + 32 + g * 8];
#pragma unroll
      for (int mm = 0; mm < 2; mm++) {
        f32x4 acc = {0.f, 0.f, 0.f, 0.f};
        acc = mfma16(aw[mm][0], b0, acc);
        acc = mfma16(aw[mm][1], b1, acc);
        u16* qp = &gQ[(nn * 16 + l15) * 128 + (2 * wave + mm) * 16 + 4 * g];
        float qv[4];
        unpack4(*(const uint2*)qp, qv);
        uint2 o; o.x = pack2(qv[0] - acc[0], qv[1] - acc[1]); o.y = pack2(qv[2] - acc[2], qv[3] - acc[3]);
        *(uint2*)qp = o;
      }
    }
  }
  __syncthreads();
  GDN_REFRESH();
  if (tid < 128) {
#pragma unroll
    for (int q = 0; q < 8; q++)
      *(uint4*)&WU[tid * KLD + q * 8] = make_uint4(pack2(xs[q * 8], xs[q * 8 + 1]), pack2(xs[q * 8 + 2], xs[q * 8 + 3]),
                                                    pack2(xs[q * 8 + 4], xs[q * 8 + 5]), pack2(xs[q * 8 + 6], xs[q * 8 + 7]));
  }
  __syncthreads();
  GDN_REFRESH();
  {
    u16* const gC = p.gC + (size_t)unit * 16384;
    u16* const gO = p.gO + (size_t)unit * 8192;
    bf16x8 akd[2][2], aqk[2];
#pragma unroll
    for (int mm = 0; mm < 2; mm++)
#pragma unroll
      for (int ks = 0; ks < 2; ks++) akd[mm][ks] = *(const bf16x8*)&kdT[((2 * wave + mm) * 16 + l15) * KLD + ks * 32 + g * 8];
#pragma unroll
    for (int ks = 0; ks < 2; ks++) aqk[ks] = *(const bf16x8*)&qk_s[(wave * 16 + l15) * KLD + ks * 32 + g * 8];
#pragma unroll
    for (int nn = 0; nn < 8; nn++) {
      const bf16x8 b0 = *(const bf16x8*)&WU[(nn * 16 + l15) * KLD + g * 8];
      const bf16x8 b1 = *(const bf16x8*)&WU[(nn * 16 + l15) * KLD + 32 + g * 8];
#pragma unroll
      for (int mm = 0; mm < 2; mm++) {
        f32x4 acc = {0.f, 0.f, 0.f, 0.f};
        acc = mfma16(akd[mm][0], b0, acc);
        acc = mfma16(akd[mm][1], b1, acc);
        uint2 o; o.x = pack2(acc[0], acc[1]); o.y = pack2(acc[2], acc[3]);
        *(uint2*)&gC[(nn * 16 + l15) * 128 + (2 * wave + mm) * 16 + 4 * g] = o;
      }
      {
        f32x4 acc = {0.f, 0.f, 0.f, 0.f};
        acc = mfma16(aqk[0], b0, acc);
        acc = mfma16(aqk[1], b1, acc);
        uint2 o; o.x = pack2(acc[0], acc[1]); o.y = pack2(acc[2], acc[3]);
        *(uint2*)&gO[(nn * 16 + l15) * 64 + wave * 16 + 4 * g] = o;
      }
    }
  }
}

__device__ void fox_cumsum_unit(const P& p, int bhf, float* red) {
  const int tid = threadIdx.x, lane = tid & 63, wave = tid >> 6;
  const int b = bhf >> 3, hf = bhf & 7;
  const float bias = p.fox_f_bias[hf];
  float v[8];
  float run = 0.f;
#pragma unroll
  for (int i = 0; i < 8; i++) {
    const int t = b * SEQ + tid * 8 + i;
    const float xx = p.gates[(size_t)t * 16 + 8 + hf] + bias;
    const float ls = fminf(xx, 0.f) - log1pf(__expf(-fabsf(xx)));
    run += ls;
    v[i] = run;
  }
  float tot = run;
#pragma unroll
  for (int off = 1; off < 64; off <<= 1) {
    float nb = __shfl_up(tot, off);
    if (lane >= off) tot += nb;
  }
  __syncthreads();
  if (lane == 63) red[wave] = tot;
  __syncthreads();
  float base = tot - run;
  for (int w = 0; w < wave; w++) base += red[w];
#pragma unroll
  for (int i = 0; i < 8; i++) p.cf[(size_t)bhf * SEQ + tid * 8 + i] = v[i] + base;
}

__device__ void phase_gdnprep(const P& p, unsigned char* smem) {
  GdnSmem& s = *(GdnSmem*)smem;
  for (int u = blockIdx.x; u < 1024 + 64; u += gridDim.x) {
    if (u < 1024) gdn_unit(p, u, s);
    else { __syncthreads(); fox_cumsum_unit(p, u - 1024, (float*)smem); }
  }
}

#define SLD 136
#define NSCAN 128
struct ScanSmem { u16 st[2][32 * SLD]; };
struct ScanSet { bf16x8 mf[2][4]; uint2 ci[2][2]; float dl; };

__device__ __forceinline__ void scan_load(const P& p, int unit, int eq, int w, int l15, int g, ScanSet& z) {
  int la = (32 * w + l15) * 128 + 8 * g, lc = (32 * eq + l15) * 128 + 32 * w + 4 * g;
  asm volatile("" : "+v"(la), "+v"(lc));
  const u16* gM = p.gM + (size_t)unit * 16384;
  const u16* gC = p.gC + (size_t)unit * 16384;
#pragma unroll
  for (int md = 0; md < 2; md++)
#pragma unroll
    for (int ks = 0; ks < 4; ks++) z.mf[md][ks] = *(const bf16x8*)&gM[la + md * 16 * 128 + ks * 32];
#pragma unroll
  for (int md = 0; md < 2; md++)
#pragma unroll
    for (int ne = 0; ne < 2; ne++) z.ci[md][ne] = *(const uint2*)&gC[lc + ne * 16 * 128 + md * 16];
  z.dl = p.gdl[unit];
}

__device__ __forceinline__ void scan_step(const P& p, int unit, int n, int eq, int w, int l15, int g, ScanSmem& s,
                                          f32x4 (&st)[2][2], const ScanSet& z) {
  const u16* Sb = s.st[n & 1];
  u16* Sn = s.st[(n & 1) ^ 1];
#pragma unroll
  for (int md = 0; md < 2; md++)
#pragma unroll
    for (int ne = 0; ne < 2; ne++) {
      float c[4];
      unpack4(z.ci[md][ne], c);
      st[md][ne][0] = st[md][ne][0] * z.dl + c[0];
      st[md][ne][1] = st[md][ne][1] * z.dl + c[1];
      st[md][ne][2] = st[md][ne][2] * z.dl + c[2];
      st[md][ne][3] = st[md][ne][3] * z.dl + c[3];
    }
  if (n > 0) {
    int lb = l15 * SLD + 8 * g;
    asm volatile("" : "+v"(lb));
#pragma unroll
    for (int ne = 0; ne < 2; ne++) {
#pragma unroll
      for (int ks = 0; ks < 4; ks++) {
        const bf16x8 bs = *(const bf16x8*)&Sb[lb + 16 * ne * SLD + ks * 32];
        st[0][ne] = mfma16(z.mf[0][ks], bs, st[0][ne]);
        st[1][ne] = mfma16(z.mf[1][ks], bs, st[1][ne]);
      }
    }
  }
  if (n + 1 < 32) {
    u16* gS = p.gS + (size_t)(unit + 1) * 16384;
    int lsl = l15 * SLD + 32 * w + 4 * g, lsg = (32 * eq + l15) * 128 + 32 * w + 4 * g;
    asm volatile("" : "+v"(lsl), "+v"(lsg));
#pragma unroll
    for (int md = 0; md < 2; md++)
#pragma unroll
      for (int ne = 0; ne < 2; ne++) {
        uint2 o; o.x = pack2(st[md][ne][0], st[md][ne][1]); o.y = pack2(st[md][ne][2], st[md][ne][3]);
        *(uint2*)&Sn[lsl + 16 * ne * SLD + 16 * md] = o;
        *(uint2*)&gS[lsg + 16 * ne * 128 + 16 * md] = o;
      }
  }
  asm volatile("s_waitcnt lgkmcnt(0)" ::: "memory");
  __builtin_amdgcn_s_barrier();
  asm volatile("" ::: "memory");
}

__device__ void scan_unit(const P& p, int item, ScanSmem& s) {
  int tid = threadIdx.x;
  asm volatile("" : "+v"(tid));
  const int lane = tid & 63, w = tid >> 6;
  const int l15 = lane & 15, g = lane >> 4;
  const int bh = item >> 2, eq = item & 3;
  const int u0 = bh * 32;
  f32x4 st[2][2];
#pragma unroll
  for (int md = 0; md < 2; md++)
#pragma unroll
    for (int ne = 0; ne < 2; ne++) st[md][ne] = (f32x4){0.f, 0.f, 0.f, 0.f};
  ScanSet z0, z1, z2, z3;
  scan_load(p, u0 + 0, eq, w, l15, g, z0);
  scan_load(p, u0 + 1, eq, w, l15, g, z1);
  scan_load(p, u0 + 2, eq, w, l15, g, z2);
#pragma unroll 1
  for (int n = 0; n < 32; n += 4) {
    scan_load(p, u0 + n + 3, eq, w, l15, g, z3);
    scan_step(p, u0 + n, n, eq, w, l15, g, s, st, z0);
    if (n + 4 < 32) scan_load(p, u0 + n + 4, eq, w, l15, g, z0);
    scan_step(p, u0 + n + 1, n + 1, eq, w, l15, g, s, st, z1);
    if (n + 4 < 32) scan_load(p, u0 + n + 5, eq, w, l15, g, z1);
    scan_step(p, u0 + n + 2, n + 2, eq, w, l15, g, s, st, z2);
    if (n + 4 < 32) scan_load(p, u0 + n + 6, eq, w, l15, g, z2);
    scan_step(p, u0 + n + 3, n + 3, eq, w, l15, g, s, st, z3);
  }
}

#define OLD 136
struct GoutSmem { float ssq[4][64]; u16 ob[64 * OLD]; };

__device__ void gout_unit(const P& p, int unit, GoutSmem& s) {
  const int tid = threadIdx.x, lane = tid & 63, w = tid >> 6;
  const int l15 = lane & 15, g = lane >> 4;
  const int bh = unit >> 5, n = unit & 31;
  const int b = bh >> 2, h = bh & 3;
  const u16* gQ = p.gQ + (size_t)unit * 8192;
  const u16* gO = p.gO + (size_t)unit * 8192;
  const u16* gS = p.gS + (size_t)unit * 16384;
  f32x4 o[4][2];
#pragma unroll
  for (int mc = 0; mc < 4; mc++)
#pragma unroll
    for (int ne = 0; ne < 2; ne++) {
      float c[4];
      unpack4(*(const uint2*)&gO[(32 * w + 16 * ne + l15) * 64 + 16 * mc + 4 * g], c);
      o[mc][ne] = (f32x4){c[0], c[1], c[2], c[3]};
    }
  if (n > 0) {
    bf16x8 bs[2][4];
#pragma unroll
    for (int ne = 0; ne < 2; ne++)
#pragma unroll
      for (int ks = 0; ks < 4; ks++) bs[ne][ks] = *(const bf16x8*)&gS[(32 * w + 16 * ne + l15) * 128 + ks * 32 + 8 * g];
#pragma unroll
    for (int mc = 0; mc < 4; mc++) {
#pragma unroll
      for (int ks = 0; ks < 4; ks++) {
        const bf16x8 aq = *(const bf16x8*)&gQ[(16 * mc + l15) * 128 + ks * 32 + 8 * g];
        o[mc][0] = mfma16(aq, bs[0][ks], o[mc][0]);
        o[mc][1] = mfma16(aq, bs[1][ks], o[mc][1]);
      }
    }
  }
  const float gnw0 = p.gdn_norm_w[32 * w + l15], gnw1 = p.gdn_norm_w[32 * w + 16 + l15];
  __syncthreads();
#pragma unroll
  for (int mc = 0; mc < 4; mc++)
#pragma unroll
    for (int r = 0; r < 4; r++) {
      float sq = o[mc][0][r] * o[mc][0][r] + o[mc][1][r] * o[mc][1][r];
#pragma unroll
      for (int off = 1; off < 16; off <<= 1) sq += __shfl_xor(sq, off);
      if (l15 == 0) s.ssq[w][16 * mc + 4 * g + r] = sq;
    }
  __syncthreads();
#pragma unroll
  for (int mc = 0; mc < 4; mc++)
#pragma unroll
    for (int r = 0; r < 4; r++) {
      const int c = 16 * mc + 4 * g + r;
      const float tot = s.ssq[0][c] + s.ssq[1][c] + s.ssq[2][c] + s.ssq[3][c];
      const float rs = rsqrtf(tot * (1.f / 128.f) + EPSV);
      s.ob[c * OLD + 32 * w + l15] = f2bf(o[mc][0][r] * rs * gnw0);
      s.ob[c * OLD + 32 * w + 16 + l15] = f2bf(o[mc][1][r] * rs * gnw1);
    }
  __syncthreads();
  {
    const int t0 = b * SEQ + n * 64;
    const int c0 = tid >> 4, ch = tid & 15;
    const u16* zp = p.proj + (size_t)(t0 + c0) * PROJW + 1536 + h * 128 + ch * 8;
    u16* op = p.actA + (size_t)(t0 + c0) * DM + h * 128 + ch * 8;
#pragma unroll
    for (int i = 0; i < 4; i++) {
      float ov[8], zv[8];
      unpack8(*(const uint4*)&s.ob[(c0 + 16 * i) * OLD + ch * 8], ov);
      unpack8(*(const uint4*)(zp + (size_t)i * 16 * PROJW), zv);
      uint4 r;
      r.x = pack2(ov[0] * siluf(zv[0]), ov[1] * siluf(zv[1])); r.y = pack2(ov[2] * siluf(zv[2]), ov[3] * siluf(zv[3]));
      r.z = pack2(ov[4] * siluf(zv[4]), ov[5] * siluf(zv[5])); r.w = pack2(ov[6] * siluf(zv[6]), ov[7] * siluf(zv[7]));
      *(uint4*)(op + (size_t)i * 16 * DM) = r;
    }
  }
}

__device__ void phase_gout(const P& p, unsigned char* smem) {
  GoutSmem& s = *(GoutSmem*)smem;
  for (int u = blockIdx.x; u < 1024; u += gridDim.x) gout_unit(p, u, s);
}

#define LOG2E 1.4426950408889634f
#define ALD 72
struct AttnSmem { u16 k[2][64 * ALD]; u16 v[2][64 * ALD]; float ck[2][64]; };

__device__ void attn_unit(const P& p, int item, AttnSmem& s) {
  int tid = threadIdx.x;
  asm volatile("" : "+v"(tid));
  const int lane = tid & 63, w = tid >> 6;
  const int l15 = lane & 15, g = lane >> 4;
  const int qb = 15 - (item >> 6), bhf = item & 63;
  const int b = bhf >> 3, hf = bhf & 7;
  const int q0 = qb * 128 + 32 * w;
  const u16* qbase = p.proj + (size_t)(b * SEQ) * PROJW + 2048 + hf * 64;
  const u16* kbase = p.proj + (size_t)(b * SEQ) * PROJW + 2560 + hf * 64;
  const u16* vbase = p.vt + (size_t)bhf * 64 * SEQ;
  const float* cfb = p.cf + (size_t)bhf * SEQ;
  bf16x8 qf[2][2];
#pragma unroll
  for (int mi = 0; mi < 2; mi++)
#pragma unroll
    for (int ks = 0; ks < 2; ks++) qf[mi][ks] = *(const bf16x8*)&qbase[(size_t)(q0 + 16 * mi + l15) * PROJW + ks * 32 + g * 8];
  float cq[2], m[2], lsum[2];
  f32x4 O[2][4];
#pragma unroll
  for (int mi = 0; mi < 2; mi++) {
    cq[mi] = cfb[q0 + 16 * mi + l15] * LOG2E; m[mi] = -1e30f; lsum[mi] = 0.f;
#pragma unroll
    for (int nd = 0; nd < 4; nd++) O[mi][nd] = (f32x4){0.f, 0.f, 0.f, 0.f};
  }
  const int ntile = (q0 + 32 + 63) >> 6;
  const int ntile_blk = 2 * qb + 2;
  const int srow = tid >> 3, scol = (tid & 7) * 8;
  const u16* kg = kbase + (size_t)srow * PROJW + scol;
  const u16* vg = vbase + (size_t)srow * SEQ + scol;
  uint4 rk0, rk1, rv0, rv1;
  float rck = 0.f;
  rk0 = *(const uint4*)(kg); rk1 = *(const uint4*)(kg + (size_t)32 * PROJW);
  rv0 = *(const uint4*)(vg); rv1 = *(const uint4*)(vg + (size_t)32 * SEQ);
  if (tid < 64) rck = cfb[tid] * LOG2E;
  *(uint4*)&s.k[0][srow * ALD + scol] = rk0; *(uint4*)&s.k[0][(srow + 32) * ALD + scol] = rk1;
  *(uint4*)&s.v[0][srow * ALD + scol] = rv0; *(uint4*)&s.v[0][(srow + 32) * ALD + scol] = rv1;
  if (tid < 64) s.ck[0][tid] = rck;
  __syncthreads();
#pragma unroll 1
  for (int kt = 0; kt < ntile_blk; kt++) {
    const int k0 = kt * 64, buf = kt & 1;
    if (kt + 1 < ntile_blk) {
      rk0 = *(const uint4*)(kg + (size_t)(k0 + 64) * PROJW); rk1 = *(const uint4*)(kg + (size_t)(k0 + 96) * PROJW);
      rv0 = *(const uint4*)(vg + k0 + 64); rv1 = *(const uint4*)(vg + (size_t)32 * SEQ + k0 + 64);
      if (tid < 64) rck = cfb[k0 + 64 + tid] * LOG2E;
    }
    if (kt < ntile) {
      const u16* Ks = s.k[buf];
      const u16* Vs = s.v[buf];
      f32x4 ST[2][4];
#pragma unroll
      for (int t = 0; t < 4; t++) {
        const bf16x8 kf0 = *(const bf16x8*)&Ks[(16 * t + l15) * ALD + g * 8];
        const bf16x8 kf1 = *(const bf16x8*)&Ks[(16 * t + l15) * ALD + 32 + g * 8];
#pragma unroll
        for (int mi = 0; mi < 2; mi++) {
          f32x4 acc = {0.f, 0.f, 0.f, 0.f};
          acc = mfma16(kf0, qf[mi][0], acc);
          acc = mfma16(kf1, qf[mi][1], acc);
          ST[mi][t] = acc;
        }
      }
      float4 ck[4];
#pragma unroll
      for (int t = 0; t < 4; t++) ck[t] = *(const float4*)&s.ck[buf][16 * t + 4 * g];
      const bool diag = (kt == ntile - 1);
      bf16x8 pf[2][2];
#pragma unroll
      for (int mi = 0; mi < 2; mi++) {
        const int qpos = q0 + 16 * mi + l15;
        float mx = -1e30f;
#pragma unroll
        for (int t = 0; t < 4; t++) {
          const float ckv[4] = {ck[t].x, ck[t].y, ck[t].z, ck[t].w};
#pragma unroll
          for (int r = 0; r < 4; r++) {
            float lg = ST[mi][t][r] * (0.125f * LOG2E) + (cq[mi] - ckv[r]);
            if (diag && (k0 + 16 * t + 4 * g + r > qpos)) lg = -1e30f;
            ST[mi][t][r] = lg;
            mx = fmaxf(mx, lg);
          }
        }
        mx = fmaxf(mx, __shfl_xor(mx, 16));
        mx = fmaxf(mx, __shfl_xor(mx, 32));
        const float mn = fmaxf(m[mi], mx);
        const float alpha = __builtin_amdgcn_exp2f(m[mi] - mn);
        m[mi] = mn;
        float ps = 0.f;
#pragma unroll
        for (int t = 0; t < 4; t++)
#pragma unroll
          for (int r = 0; r < 4; r++) {
            const float pe = __builtin_amdgcn_exp2f(ST[mi][t][r] - mn);
            ST[mi][t][r] = pe;
            ps += pe;
          }
        lsum[mi] = lsum[mi] * alpha + ps;
#pragma unroll
        for (int kk = 0; kk < 2; kk++) {
          uint4 pk;
          pk.x = pack2(ST[mi][2 * kk][0], ST[mi][2 * kk][1]); pk.y = pack2(ST[mi][2 * kk][2], ST[mi][2 * kk][3]);
          pk.z = pack2(ST[mi][2 * kk + 1][0], ST[mi][2 * kk + 1][1]); pk.w = pack2(ST[mi][2 * kk + 1][2], ST[mi][2 * kk + 1][3]);
          pf[mi][kk] = __builtin_bit_cast(bf16x8, pk);
        }
#pragma unroll
        for (int r = 0; r < 4; r++) {
          const float ar = __shfl(alpha, 4 * g + r);
#pragma unroll
          for (int nd = 0; nd < 4; nd++) O[mi][nd][r] *= ar;
        }
      }
#pragma unroll
      for (int nd = 0; nd < 4; nd++)
#pragma unroll
        for (int kk = 0; kk < 2; kk++) {
          const uint2 vlo = *(const uint2*)&Vs[(16 * nd + l15) * ALD + 32 * kk + 4 * g];
          const uint2 vhi = *(const uint2*)&Vs[(16 * nd + l15) * ALD + 32 * kk + 16 + 4 * g];
          const bf16x8 vf = __builtin_bit_cast(bf16x8, make_uint4(vlo.x, vlo.y, vhi.x, vhi.y));
          O[0][nd] = mfma16(pf[0][kk], vf, O[0][nd]);
          O[1][nd] = mfma16(pf[1][kk], vf, O[1][nd]);
        }
    }
    if (kt + 1 < ntile_blk) {
      const int nb = buf ^ 1;
      *(uint4*)&s.k[nb][srow * ALD + scol] = rk0; *(uint4*)&s.k[nb][(srow + 32) * ALD + scol] = rk1;
      *(uint4*)&s.v[nb][srow * ALD + scol] = rv0; *(uint4*)&s.v[nb][(srow + 32) * ALD + scol] = rv1;
      if (tid < 64) s.ck[nb][tid] = rck;
    }
    __syncthreads();
  }
#pragma unroll
  for (int mi = 0; mi < 2; mi++) {
    float l = lsum[mi];
    l += __shfl_xor(l, 16);
    l += __shfl_xor(l, 32);
    const float inv = 1.f / l;
#pragma unroll
    for (int r = 0; r < 4; r++) {
      const float ir = __shfl(inv, 4 * g + r);
      const int t = b * SEQ + q0 + 16 * mi + 4 * g + r;
#pragma unroll
      for (int nd = 0; nd < 4; nd++) p.actA[(size_t)t * DM + 512 + hf * 64 + 16 * nd + l15] = f2bf(O[mi][nd][r] * ir);
    }
  }
}

__device__ void deferred_transpose(const P& p, int it, float* tile) {
  const int n1 = 16 * 16, n2 = n1 + 16 * 88, n3 = n2 + 44 * 16, n4 = n3 + 16 * 16;
  if (it < n1) { transpose_item(p.w_out, 1024, p.wt_out, 1024, it % 16, it / 16, 1, tile); }
  else if (it < n2) { int j = it - n1; transpose_item(p.w_gate_up, 2 * DFF, p.wt_gu, 1024, j % 16, j / 16, 2, tile); }
  else if (it < n3) { int j = it - n2; transpose_item(p.w_down, 1024, p.wt_down, DFF, j % 44, j / 44, 1, tile); }
  else if (it < n4) { int j = it - n3; transpose_item(p.w_ple_gate, 1024, p.wt_pg, 1024, j % 16, j / 16, 1, tile); }
  else { int j = it - n4; transpose_item(p.w_ple_proj, 1024, p.wt_pp, 256, j % 4, j / 4, 1, tile); }
}
#define N_DEFER (16 * 16 + 16 * 88 + 44 * 16 + 16 * 16 + 4 * 16)

__device__ void phase_mixer(const P& p, unsigned char* smem, int rr) {
  __shared__ int s_item;
  for (;;) {
    __syncthreads();
    if (threadIdx.x == 0) s_item = (int)atomicAdd(&p.counters[rr], 1u);
    __syncthreads();
    const int item = s_item;
    if (item >= NSCAN + 1024 + N_DEFER) break;
    if (item < NSCAN) { scan_unit(p, item, *(ScanSmem*)smem); }
    else if (item < NSCAN + 1024) { attn_unit(p, item - NSCAN, *(AttnSmem*)smem); }
    else { deferred_transpose(p, item - NSCAN - 1024, (float*)smem); }
  }
}

#define XB_TMO      128
#define XB_XCNT(j)  (256  + 64 * (j))
#define XB_XSUB(j)  (1280 + 64 * (j))
#define XB_XGEN(j)  (2304 + 64 * (j))
#define XB_TOP      3328
#define XB_TOPGEN   3392
#define XCD_BAR_WORDS 3456
#define XB_SPIN_CAP (1u << 20)
#define LAS __attribute__((address_space(3)))
__device__ __forceinline__ unsigned xb_ld(unsigned* p) { return __hip_atomic_load(p, __ATOMIC_RELAXED, __HIP_MEMORY_SCOPE_AGENT); }
__device__ __forceinline__ unsigned xb_add(unsigned* p, unsigned v) { return __hip_atomic_fetch_add(p, v, __ATOMIC_RELAXED, __HIP_MEMORY_SCOPE_AGENT); }
__device__ __forceinline__ unsigned xb_xcc_id() { return (unsigned)__builtin_amdgcn_s_getreg((3 << 11) | 20) & 0xFu; }
#define XB_SPIN(cond, bar) do { unsigned _sp = 0; while (cond) { __builtin_amdgcn_s_sleep(1); \
    if ((++_sp & 255u) == 0u) { if (xb_ld(&(bar)[XB_TMO])) break; if (_sp > XB_SPIN_CAP) { atomicAdd(&(bar)[XB_TMO], 1u); break; } } } } while (0)
struct XcdBarrier { unsigned* bar; unsigned x; volatile LAS unsigned* st; };
__device__ __forceinline__ XcdBarrier xcd_barrier_post(unsigned* bar, volatile LAS unsigned* st) {
  XcdBarrier b; b.bar = bar; b.x = xb_xcc_id(); b.st = st;
  if (threadIdx.x == 0) (void)xb_add(&bar[XB_XCNT(b.x)], 1u);
  return b;
}
__device__ __forceinline__ void xcd_barrier_complete(unsigned* bar, unsigned x, unsigned& nloc, unsigned& nx) {
  const unsigned G = gridDim.x * gridDim.y * gridDim.z;
  unsigned sum, cnt, mine, sp = 0u;
  for (;;) {
    sum = 0u; cnt = 0u; mine = 0u;
#pragma unroll
    for (unsigned j = 0; j < 16; ++j) { const unsigned c = xb_ld(&bar[XB_XCNT(j)]); sum += c; cnt += (c > 0u) ? 1u : 0u; mine = (j == x) ? c : mine; }
    if (sum == G) break;
    __builtin_amdgcn_s_sleep(1);
    if ((++sp & 255u) == 0u) { if (xb_ld(&bar[XB_TMO])) break; if (sp > XB_SPIN_CAP) { atomicAdd(&bar[XB_TMO], 1u); break; } }
  }
  nloc = mine > 0u ? mine : 1u; nx = cnt > 0u ? cnt : 1u;
}
__device__ __forceinline__ void xcd_barrier(const XcdBarrier& b) {
  asm volatile("s_waitcnt vmcnt(0)" ::: "memory");
  __syncthreads();
  if (threadIdx.x == 0) {
    unsigned* bar = b.bar;
    __builtin_amdgcn_s_waitcnt(0);
    unsigned nloc = b.st[0], nx = b.st[1];
    if (nloc == 0u) { xcd_barrier_complete(bar, b.x, nloc, nx); b.st[0] = nloc; b.st[1] = nx; }
    const unsigned old = xb_add(&bar[XB_XSUB(b.x)], 1u);
    const unsigned gen = old / nloc;
    if (old + 1u == (gen + 1u) * nloc) {
      __builtin_amdgcn_fence(__ATOMIC_RELEASE, "agent");
      asm volatile("s_waitcnt vmcnt(0)" ::: "memory");
      const unsigned og = xb_add(&bar[XB_TOP], 1u);
      const unsigned tg = og / nx;
      if (og + 1u == (tg + 1u) * nx) xb_add(&bar[XB_TOPGEN], 1u);
      else XB_SPIN(xb_ld(&bar[XB_TOPGEN]) == tg, bar);
      __builtin_amdgcn_fence(__ATOMIC_ACQUIRE, "agent");
      xb_add(&bar[XB_XGEN(b.x)], 1u);
      asm volatile("s_waitcnt vmcnt(0)" ::: "memory");
    } else {
      XB_SPIN(xb_ld(&bar[XB_XGEN(b.x)]) == gen, bar);
      __builtin_amdgcn_fence(__ATOMIC_ACQUIRE, "agent");
      asm volatile("s_waitcnt vmcnt(0)" ::: "memory");
    }
  }
  __syncthreads();
}

__global__ void __launch_bounds__(256, 2) mega(P p, int lo, int hi) {
  __shared__ __attribute__((aligned(16))) unsigned char smem[sizeof(GemmSmem)];
  __shared__ uint4 xb_words;
  cg::grid_group grid = cg::this_grid();
  if (threadIdx.x == 0) xb_words = make_uint4(0u, 0u, 0u, 0u);
  __syncthreads();
  XcdBarrier xb = xcd_barrier_post(p.bar, (volatile LAS unsigned*)&xb_words);
  if (hi < 0) grid.sync();
#define REP0 1
#define REP2 1
#define REP3 1
#define REP4 1
#define SEAM(k) if (lo <= k && k + 1 < hi) xcd_barrier(xb);
#if !defined(ONLY) || ONLY == 0
  if (lo <= 0 && 0 < hi) { for (int rr = 0; rr < REP0; rr++) { phase_prep(p, smem); if (rr + 1 < REP0) xcd_barrier(xb); } }
#endif
  SEAM(0)
#if !defined(ONLY) || ONLY == 1
  if (lo <= 1 && 1 < hi) phase_inproj(p, smem);
#endif
  SEAM(1)
#if !defined(ONLY) || ONLY == 2
  if (lo <= 2 && 2 < hi) { for (int rr = 0; rr < REP2; rr++) { phase_gdnprep(p, smem); if (rr + 1 < REP2) xcd_barrier(xb); } }
#endif
  SEAM(2)
#if !defined(ONLY) || ONLY == 3
  if (lo <= 3 && 3 < hi) { for (int rr = 0; rr < REP3; rr++) { phase_mixer(p, smem, rr); if (rr + 1 < REP3) xcd_barrier(xb); } }
#endif
  SEAM(3)
#if !defined(ONLY) || ONLY == 4
  if (lo <= 4 && 4 < hi) { for (int rr = 0; rr < REP4; rr++) { phase_gout(p, smem); if (rr + 1 < REP4) xcd_barrier(xb); } }
#endif
  SEAM(4)
#if !defined(ONLY) || ONLY == 5
  if (lo <= 5 && 5 < hi) phase_outproj(p, smem);
#endif
  SEAM(5)
  if (lo <= 6 && 6 < hi) phase_rmsnorm(p.h, p.ffn_norm_w, p.actA, nullptr);
  SEAM(6)
#if !defined(ONLY) || ONLY == 7
  if (lo <= 7 && 7 < hi) phase_gateup(p, smem);
#endif
  SEAM(7)
#if !defined(ONLY) || ONLY == 8
  if (lo <= 8 && 8 < hi) phase_down(p, smem);
#endif
  SEAM(8)
  if (lo <= 9 && 9 < hi) phase_rmsnorm(p.h, p.ple_norm_w, p.actA, nullptr);
  SEAM(9)
#if !defined(ONLY) || ONLY == 10
  if (lo <= 10 && 10 < hi) phase_ple(p, smem);
#endif
  SEAM(10)
  if (lo <= 11 && 11 < hi) phase_rmsnorm(p.h, p.final_norm_w, nullptr, p.h);
}

static_assert(sizeof(GdnSmem) <= sizeof(GemmSmem), "smem");
static_assert(sizeof(ScanSmem) <= sizeof(GemmSmem), "smem");
static_assert(sizeof(GoutSmem) <= sizeof(GemmSmem), "smem");

extern "C" void kernel_launch(void* const* d_in, const int* in_sizes, int n_in, void* d_out, int out_size,
                              void* d_ws, size_t ws_size, hipStream_t stream) {
  static int grid_blocks = 0;
  if (!grid_blocks) {
    int dev = 0, cus = 0, per_cu = 0;
    hipGetDevice(&dev);
    hipDeviceGetAttribute(&cus, hipDeviceAttributeMultiprocessorCount, dev);
    hipOccupancyMaxActiveBlocksPerMultiprocessor(&per_cu, mega, 256, 0);
    if (per_cu > 2) per_cu = 2;
    if (per_cu < 1) per_cu = 1;
    grid_blocks = cus * per_cu;
  }
  P p{};
  const float* const* in = (const float* const*)d_in;
  p.x = in[0]; p.p = in[1]; p.attn_norm_w = in[2]; p.w_in = in[3]; p.conv_w = in[4]; p.a_log = in[5];
  p.dt_bias = in[6]; p.gdn_norm_w = in[7]; p.fox_f_bias = in[8]; p.w_out = in[9]; p.ffn_norm_w = in[10];
  p.w_gate_up = in[11]; p.w_down = in[12]; p.ple_norm_w = in[13]; p.w_ple_gate = in[14]; p.w_ple_proj = in[15];
  p.final_norm_w = in[16];
  p.h = (float*)d_out;
  unsigned char* ws = (unsigned char*)d_ws;
  size_t off = 0;
  auto take = [&](size_t bytes) { unsigned char* r = ws + off; off += (bytes + 255) & ~(size_t)255; return r; };
  p.counters = (unsigned*)take(256);
  p.bar = (unsigned*)take(XCD_BAR_WORDS * 4);
  p.wt_in = (u16*)take((size_t)NIN_PAD * 1024 * 2);
  p.wt_out = (u16*)take((size_t)1024 * 1024 * 2);
  p.wt_gu = (u16*)take((size_t)2 * DFF * 1024 * 2);
  p.wt_down = (u16*)take((size_t)1024 * DFF * 2);
  p.wt_pg = (u16*)take((size_t)1024 * 1024 * 2);
  p.wt_pp = (u16*)take((size_t)1024 * 256 * 2);
  p.actA = (u16*)take((size_t)NTOK * 1024 * 2);
  p.pb = (u16*)take((size_t)NTOK * 256 * 2);
  p.proj = (u16*)take((size_t)NTOK * PROJW * 2);
  p.vt = (u16*)take((size_t)64 * 64 * SEQ * 2);
  p.gates = (float*)take((size_t)NTOK * 16 * 4);
  p.cf = (float*)take((size_t)64 * SEQ * 4);
  p.gM = (u16*)take((size_t)1024 * 16384 * 2);
  p.gC = (u16*)take((size_t)1024 * 16384 * 2);
  p.gdl = (float*)take(1024 * 4);
  if (off > ws_size) fprintf(stderr, "workspace too small: need %zu have %zu\n", off, ws_size);
  u16* ob = (u16*)d_out;
  p.gS = ob;
  p.gQ = ob + (size_t)1024 * 16384;
  p.gO = ob + (size_t)1024 * 16384 + (size_t)1024 * 8192;
  hipMemsetAsync(p.bar, 0, XCD_BAR_WORDS * 4, stream);
  int lo = 0, hi = NPHASE;
  void* args[] = {&p, &lo, &hi};
  hipError_t e = hipLaunchCooperativeKernel((void*)mega, dim3(grid_blocks), dim3(256), args, 0, stream);
  if (e != hipSuccess) fprintf(stderr, "cooperative launch failed: %s (grid %d)\n", hipGetErrorString(e), grid_blocks);
}
```

```cpp
#include <hip/hip_runtime.h>
#include <hip/hip_cooperative_groups.h>
#include <cstdio>
#include <cstdint>
namespace cg = cooperative_groups;

typedef unsigned short u16;
typedef __attribute__((ext_vector_type(8))) short bf16x8;
typedef __attribute__((ext_vector_type(4))) float f32x4;

#define NTOK 16384
#define SEQ 2048
#define DM 1024
#define DFF 2816
#define PROJW 3072
#define NIN_PAD 3712
#define EPSV 1e-6f
#define NPHASE 12
#define SMEM_MAIN 71680

struct P {
  const float *x, *p, *attn_norm_w, *w_in, *conv_w, *a_log, *dt_bias, *gdn_norm_w, *fox_f_bias, *w_out,
      *ffn_norm_w, *w_gate_up, *w_down, *ple_norm_w, *w_ple_gate, *w_ple_proj, *final_norm_w;
  float* h;
  u16 *wt_in, *wt_out, *wt_gu, *wt_down, *wt_pg, *wt_pp;
  u16 *actA;
  u16 *pb;
  u16 *proj;
  u16 *vt;
  float *gates;
  float *cf;
  u16 *gM, *gC;
  u16 *gQ, *gO;
  u16 *gS;
  float *gdl;
  unsigned *counters;
  unsigned *bar;
};

typedef __attribute__((ext_vector_type(2))) float f32x2_t;
typedef __attribute__((ext_vector_type(2))) __bf16 bf16x2_t;
__device__ __forceinline__ u16 f2bf(float f) { return __builtin_bit_cast(u16, (__bf16)f); }
__device__ __forceinline__ float bf2f(u16 h) { return __uint_as_float(((unsigned)h) << 16); }
__device__ __forceinline__ unsigned pack2(float a, float b) {
  f32x2_t f = {a, b};
  return __builtin_bit_cast(unsigned, __builtin_convertvector(f, bf16x2_t));
}
__device__ __forceinline__ float siluf(float v) { return v / (1.f + __expf(-v)); }
__device__ __forceinline__ float sigmoidf_(float v) { return 1.f / (1.f + __expf(-v)); }
__device__ __forceinline__ f32x4 mfma16(bf16x8 a, bf16x8 b, f32x4 c) {
  return __builtin_amdgcn_mfma_f32_16x16x32_bf16(a, b, c, 0, 0, 0);
}
#define LDS_FENCE() asm volatile("s_waitcnt lgkmcnt(0)" ::: "memory")

__device__ __forceinline__ int colmap(int kind, int nn) {
  if (kind == 0) {
    if (nn < 2048) return nn;
    if (nn < 3584) return nn + 8;
    if (nn < 3588) return 2048 + (nn - 3584);
    if (nn < 3592) return 2052 + (nn - 3588);
    if (nn < 3600) return nn;
    return -1;
  } else if (kind == 2) {
    int i = nn >> 7, wc = (nn >> 6) & 1, u = (nn >> 5) & 1, j = nn & 31;
    return u * DFF + 64 * i + 32 * wc + j;
  }
  return nn;
}

__device__ void transpose_item(const float* __restrict__ src, int ldsrc, u16* __restrict__ dst, int K,
                               int kt, int nt, int kind, float* tile) {
  int tid = threadIdx.x;
  asm volatile("" : "+v"(tid));
  const int c = tid & 63, r0 = tid >> 6;
  const int ncol = colmap(kind, nt * 64 + c);
#pragma unroll 4
  for (int i = 0; i < 16; i++) {
    int r = r0 + 4 * i;
    float v = (ncol >= 0) ? src[(size_t)(kt * 64 + r) * ldsrc + ncol] : 0.f;
    tile[r * 65 + c] = v;
  }
  __syncthreads();
#pragma unroll 4
  for (int i = 0; i < 16; i++) {
    int rn = r0 + 4 * i;
    dst[(size_t)(nt * 64 + rn) * K + kt * 64 + c] = f2bf(tile[c * 65 + rn]);
  }
  __syncthreads();
}

__device__ __forceinline__ void rmsnorm_row(const float* src, const float* __restrict__ w,
                                            u16* dstb, float* dstf, int row) {
  const int lane = threadIdx.x & 63;
  float4 v[4];
  float ss = 0.f;
#pragma unroll
  for (int i = 0; i < 4; i++) {
    v[i] = *(const float4*)&src[(size_t)row * DM + i * 256 + lane * 4];
    ss += v[i].x * v[i].x + v[i].y * v[i].y + v[i].z * v[i].z + v[i].w * v[i].w;
  }
#pragma unroll
  for (int off = 32; off >= 1; off >>= 1) ss += __shfl_xor(ss, off);
  const float r = rsqrtf(ss * (1.f / DM) + EPSV);
#pragma unroll
  for (int i = 0; i < 4; i++) {
    const int col = i * 256 + lane * 4;
    float4 wv = *(const float4*)&w[col];
    float y0 = v[i].x * r * wv.x, y1 = v[i].y * r * wv.y, y2 = v[i].z * r * wv.z, y3 = v[i].w * r * wv.w;
    if (dstb) {
      uint2 o; o.x = pack2(y0, y1); o.y = pack2(y2, y3);
      *(uint2*)&dstb[(size_t)row * DM + col] = o;
    } else {
      *(float4*)&dstf[(size_t)row * DM + col] = make_float4(y0, y1, y2, y3);
    }
  }
}

__device__ void phase_prep(const P& p, unsigned char* smem) {
  float* tile = (float*)smem;
  if (blockIdx.x == 0 && threadIdx.x < 16) p.counters[threadIdx.x] = 0u;
  for (int it = blockIdx.x; it < 16 * 58; it += gridDim.x) transpose_item(p.w_in, 3600, p.wt_in, 1024, it % 16, it / 16, 0, tile);
  const int wave = threadIdx.x >> 6, lane = threadIdx.x & 63;
  for (int rb = blockIdx.x; rb < NTOK / 4; rb += gridDim.x) {
    const int row = rb * 4 + wave;
    rmsnorm_row(p.x, p.attn_norm_w, p.actA, nullptr, row);
    float4 pv = *(const float4*)&p.p[(size_t)row * 256 + lane * 4];
    uint2 o; o.x = pack2(pv.x, pv.y); o.y = pack2(pv.z, pv.w);
    *(uint2*)&p.pb[(size_t)row * 256 + lane * 4] = o;
  }
}

__device__ void phase_rmsnorm(const float* src, const float* w, u16* dstb, float* dstf) {
  const int wave = threadIdx.x >> 6;
  for (int rb = blockIdx.x; rb < NTOK / 4; rb += gridDim.x) rmsnorm_row(src, w, dstb, dstf, rb * 4 + wave);
}

#define GK 64
struct GemmSmem { u16 a[2][128 * GK]; u16 b[2][128 * GK]; };

__device__ __forceinline__ void gemm_tile(const u16* __restrict__ A, int lda, const u16* __restrict__ Bt, int ldb,
                                          int K, int m0, int n0, GemmSmem& s, f32x4 (&acc)[4][4]) {
  const int tid = threadIdx.x, lane = tid & 63, wave = tid >> 6;
  const int wr = wave >> 1, wc = wave & 1;
  const int l15 = lane & 15, g = lane >> 4;
  const int nk = K / GK;
  const int drow = 8 * wave + (lane >> 3);
  const int dchunk = (lane & 7) ^ ((4 * (wave & 1) + (lane >> 4)) & 7);
  const u16* Ap = A + (size_t)(m0 + drow) * lda + dchunk * 8;
  const u16* Bp = Bt + (size_t)(n0 + drow) * ldb + dchunk * 8;
  const size_t sa = (size_t)32 * lda, sb = (size_t)32 * ldb;
#define G_DMA(bufi, koff) do { \
    _Pragma("unroll") for (int _i = 0; _i < 4; _i++) { \
      __builtin_amdgcn_global_load_lds((const unsigned*)(Ap + _i * sa + (koff)), (unsigned*)&s.a[bufi][(32 * _i + 8 * wave) * GK], 16, 0, 0); \
      __builtin_amdgcn_global_load_lds((const unsigned*)(Bp + _i * sb + (koff)), (unsigned*)&s.b[bufi][(32 * _i + 8 * wave) * GK], 16, 0, 0); \
    } } while (0)
  const int fo0 = l15 * GK + ((g ^ (l15 >> 1)) * 8);
  const int fo1 = l15 * GK + (((4 + g) ^ (l15 >> 1)) * 8);
  G_DMA(0, 0);
  asm volatile("s_waitcnt vmcnt(0)" ::: "memory");
  __builtin_amdgcn_s_barrier();
  asm volatile("" ::: "memory");
  for (int kt = 0; kt < nk; kt++) {
    const int buf = kt & 1;
    if (kt + 1 < nk) { if (buf) G_DMA(0, (kt + 1) * GK); else G_DMA(1, (kt + 1) * GK); }
    const u16* sa_ = &s.a[buf][(wr * 64) * GK];
    const u16* sb_ = &s.b[buf][(wc * 64) * GK];
#pragma unroll
    for (int ks = 0; ks < 2; ks++) {
      const int fo = ks ? fo1 : fo0;
      bf16x8 af[4], bfr[4];
#pragma unroll
      for (int mi = 0; mi < 4; mi++) af[mi] = *(const bf16x8*)&sa_[mi * 16 * GK + fo];
#pragma unroll
      for (int ni = 0; ni < 4; ni++) bfr[ni] = *(const bf16x8*)&sb_[ni * 16 * GK + fo];
#pragma unroll
      for (int mi = 0; mi < 4; mi++)
#pragma unroll
        for (int ni = 0; ni < 4; ni++) acc[mi][ni] = mfma16(af[mi], bfr[ni], acc[mi][ni]);
    }
    asm volatile("s_waitcnt vmcnt(0) lgkmcnt(0)" ::: "memory");
    __builtin_amdgcn_s_barrier();
    asm volatile("" ::: "memory");
  }
}

#define ZERO_ACC(acc) _Pragma("unroll") for (int _i = 0; _i < 4; _i++) _Pragma("unroll") for (int _j = 0; _j < 4; _j++) acc[_i][_j] = (f32x4){0.f, 0.f, 0.f, 0.f};

__device__ void phase_inproj(const P& p, unsigned char* smem) {
  GemmSmem& s = *(GemmSmem*)smem;
  const int lane = threadIdx.x & 63, wave = threadIdx.x >> 6, wr = wave >> 1, wc = wave & 1, l15 = lane & 15, g = lane >> 4;
  const int ntiles = 128 * 29;
  for (int tl = blockIdx.x; tl < ntiles; tl += gridDim.x) {
    const int mt = tl & 127, nt = tl >> 7;
    const int m0 = mt * 128, n0 = nt * 128;
    f32x4 acc[4][4];
    ZERO_ACC(acc);
    gemm_tile(p.actA, DM, p.wt_in, DM, DM, m0, n0, s, acc);
#pragma unroll
    for (int mi = 0; mi < 4; mi++)
#pragma unroll
      for (int ni = 0; ni < 4; ni++) {
        const int rowb = m0 + wr * 64 + mi * 16 + g * 4;
        const int col = n0 + wc * 64 + ni * 16 + l15;
        if (nt < 24) {
#pragma unroll
          for (int r = 0; r < 4; r++) p.proj[(size_t)(rowb + r) * PROJW + col] = f2bf(acc[mi][ni][r]);
        } else if (nt < 28) {
          const int cc = col - 3072, hh = cc >> 6, d = cc & 63;
          const int b = rowb >> 11, sq = rowb & 2047;
          uint2 o; o.x = pack2(acc[mi][ni][0], acc[mi][ni][1]); o.y = pack2(acc[mi][ni][2], acc[mi][ni][3]);
          *(uint2*)&p.vt[((size_t)((b * 8 + hh) * 64 + d)) * SEQ + sq] = o;
        } else {
          if (col < 3600) {
#pragma unroll
            for (int r = 0; r < 4; r++) p.gates[(size_t)(rowb + r) * 16 + (col - 3584)] = acc[mi][ni][r];
          }
        }
      }
  }
}

__device__ void phase_outproj(const P& p, unsigned char* smem) {
  GemmSmem& s = *(GemmSmem*)smem;
  const int lane = threadIdx.x & 63, wave = threadIdx.x >> 6, wr = wave >> 1, wc = wave & 1, l15 = lane & 15, g = lane >> 4;
  for (int tl = blockIdx.x; tl < 128 * 8; tl += gridDim.x) {
    const int mt = tl & 127, nt = tl >> 7;
    const int m0 = mt * 128, n0 = nt * 128;
    f32x4 acc[4][4];
    ZERO_ACC(acc);
    gemm_tile(p.actA, DM, p.wt_out, DM, DM, m0, n0, s, acc);
#pragma unroll
    for (int mi = 0; mi < 4; mi++)
#pragma unroll
      for (int ni = 0; ni < 4; ni++) {
        const int rowb = m0 + wr * 64 + mi * 16 + g * 4;
        const int col = n0 + wc * 64 + ni * 16 + l15;
#pragma unroll
        for (int r = 0; r < 4; r++) {
          size_t idx = (size_t)(rowb + r) * DM + col;
          p.h[idx] = p.x[idx] + acc[mi][ni][r];
        }
      }
  }
}

__device__ void phase_gateup(const P& p, unsigned char* smem) {
  GemmSmem& s = *(GemmSmem*)smem;
  u16* act = p.proj;
  const int lane = threadIdx.x & 63, wave = threadIdx.x >> 6, wr = wave >> 1, wc = wave & 1, l15 = lane & 15, g = lane >> 4;
  for (int tl = blockIdx.x; tl < 128 * 44; tl += gridDim.x) {
    const int mt = tl & 127, nt = tl >> 7;
    const int m0 = mt * 128, n0 = nt * 128;
    f32x4 acc[4][4];
    ZERO_ACC(acc);
    gemm_tile(p.actA, DM, p.wt_gu, DM, DM, m0, n0, s, acc);
#pragma unroll
    for (int mi = 0; mi < 4; mi++)
#pragma unroll
      for (int ni = 0; ni < 2; ni++) {
        const int rowb = m0 + wr * 64 + mi * 16 + g * 4;
        const int col = 64 * nt + 32 * wc + 16 * ni + l15;
#pragma unroll
        for (int r = 0; r < 4; r++) {
          float gt = acc[mi][ni][r], up = acc[mi][ni + 2][r];
          act[(size_t)(rowb + r) * DFF + col] = f2bf(siluf(gt) * up);
        }
      }
  }
}

__device__ void phase_down(const P& p, unsigned char* smem) {
  GemmSmem& s = *(GemmSmem*)smem;
  const u16* act = p.proj;
  const int lane = threadIdx.x & 63, wave = threadIdx.x >> 6, wr = wave >> 1, wc = wave & 1, l15 = lane & 15, g = lane >> 4;
  for (int tl = blockIdx.x; tl < 128 * 8; tl += gridDim.x) {
    const int mt = tl & 127, nt = tl >> 7;
    const int m0 = mt * 128, n0 = nt * 128;
    f32x4 acc[4][4];
    ZERO_ACC(acc);
    gemm_tile(act, DFF, p.wt_down, DFF, DFF, m0, n0, s, acc);
#pragma unroll
    for (int mi = 0; mi < 4; mi++)
#pragma unroll
      for (int ni = 0; ni < 4; ni++) {
        const int rowb = m0 + wr * 64 + mi * 16 + g * 4;
        const int col = n0 + wc * 64 + ni * 16 + l15;
#pragma unroll
        for (int r = 0; r < 4; r++) {
          size_t idx = (size_t)(rowb + r) * DM + col;
          p.h[idx] += acc[mi][ni][r];
        }
      }
  }
}

__device__ void phase_ple(const P& p, unsigned char* smem) {
  GemmSmem& s = *(GemmSmem*)smem;
  const int lane = threadIdx.x & 63, wave = threadIdx.x >> 6, wr = wave >> 1, wc = wave & 1, l15 = lane & 15, g = lane >> 4;
  for (int tl = blockIdx.x; tl < 128 * 8; tl += gridDim.x) {
    const int mt = tl & 127, nt = tl >> 7;
    const int m0 = mt * 128, n0 = nt * 128;
    f32x4 acc[4][4], acc2[4][4];
    ZERO_ACC(acc);
    gemm_tile(p.actA, DM, p.wt_pg, DM, DM, m0, n0, s, acc);
#pragma unroll
    for (int mi = 0; mi < 4; mi++)
#pragma unroll
      for (int ni = 0; ni < 4; ni++)
#pragma unroll
        for (int r = 0; r < 4; r++) acc[mi][ni][r] = sigmoidf_(acc[mi][ni][r]);
    ZERO_ACC(acc2);
    gemm_tile(p.pb, 256, p.wt_pp, 256, 256, m0, n0, s, acc2);
#pragma unroll
    for (int mi = 0; mi < 4; mi++)
#pragma unroll
      for (int ni = 0; ni < 4; ni++) {
        const int rowb = m0 + wr * 64 + mi * 16 + g * 4;
        const int col = n0 + wc * 64 + ni * 16 + l15;
#pragma unroll
        for (int r = 0; r < 4; r++) {
          size_t idx = (size_t)(rowb + r) * DM + col;
          p.h[idx] += acc[mi][ni][r] * acc2[mi][ni][r];
        }
      }
  }
}

#define QLD 136
#define KLD 72
struct GdnSmem {
  u16 qb[64 * QLD];
  u16 kn[64 * QLD];
  u16 vb[64 * QLD];
  float Am[64 * 64];
  float gc[64], beta[64], be[64];
};
static_assert(offsetof(GdnSmem, kn) == 17408 && offsetof(GdnSmem, vb) == 34816 && offsetof(GdnSmem, Am) == 52224, "layout");

__device__ __forceinline__ void unpack8(const uint4& v, float (&f)[8]) {
  f[0] = bf2f((u16)(v.x & 0xffffu)); f[1] = bf2f((u16)(v.x >> 16));
  f[2] = bf2f((u16)(v.y & 0xffffu)); f[3] = bf2f((u16)(v.y >> 16));
  f[4] = bf2f((u16)(v.z & 0xffffu)); f[5] = bf2f((u16)(v.z >> 16));
  f[6] = bf2f((u16)(v.w & 0xffffu)); f[7] = bf2f((u16)(v.w >> 16));
}
__device__ __forceinline__ void unpack4(const uint2& v, float (&f)[4]) {
  f[0] = bf2f((u16)(v.x & 0xffffu)); f[1] = bf2f((u16)(v.x >> 16));
  f[2] = bf2f((u16)(v.y & 0xffffu)); f[3] = bf2f((u16)(v.y >> 16));
}

__device__ void gdn_unit(const P& p, int unit, GdnSmem& s) {
  int tid = threadIdx.x;
  asm volatile("" : "+v"(tid));
  int lane = tid & 63, wave = tid >> 6;
  int l15 = lane & 15, g = lane >> 4;
#define GDN_REFRESH() do { tid = threadIdx.x; asm volatile("" : "+v"(tid) :: "memory"); lane = tid & 63; wave = tid >> 6; l15 = lane & 15; g = lane >> 4; } while (0)
  const int bh = unit >> 5, n = unit & 31;
  const int b = bh >> 2, h = bh & 3;
  const int tb = b * SEQ;
  const int s0 = n * 64;
  u16* const qk_s = s.qb;
  u16* const WU = s.kn;
  u16* const kdT = (u16*)((unsigned char*)s.kn + 32768);
  __syncthreads();
  if (wave == 0) {
    const int t = tb + s0 + lane;
    const float ga = p.gates[(size_t)t * 16 + h], gb = p.gates[(size_t)t * 16 + 4 + h];
    const float xx = ga + p.dt_bias[h];
    const float sp = (xx > 20.f) ? xx : log1pf(__expf(xx));
    float gg = -__expf(p.a_log[h]) * sp;
#pragma unroll
    for (int off = 1; off < 64; off <<= 1) {
      float nb = __shfl_up(gg, off);
      if (lane >= off) gg += nb;
    }
    const float bt = sigmoidf_(gb);
    s.gc[lane] = gg;
    s.beta[lane] = bt;
    s.be[lane] = bt * __expf(gg);
  }
  {
    const int ch = tid & 15, rg = tid >> 4;
#pragma unroll 1
    for (int mat = 0; mat < 3; mat++) {
      const int col0 = mat * 512 + h * 128 + ch * 8;
      float cw[4][8];
#pragma unroll
      for (int k = 0; k < 4; k++) {
        const float4 w0 = *(const float4*)&p.conv_w[k * 1536 + col0];
        const float4 w1 = *(const float4*)&p.conv_w[k * 1536 + col0 + 4];
        cw[k][0] = w0.x; cw[k][1] = w0.y; cw[k][2] = w0.z; cw[k][3] = w0.w;
        cw[k][4] = w1.x; cw[k][5] = w1.y; cw[k][6] = w1.z; cw[k][7] = w1.w;
      }
      uint4 xr[7];
#pragma unroll
      for (int j = 0; j < 7; j++) {
        const int sp = s0 + 4 * rg + j - 3;
        xr[j] = (sp >= 0) ? *(const uint4*)&p.proj[(size_t)(tb + sp) * PROJW + col0] : make_uint4(0u, 0u, 0u, 0u);
      }
      float xf[7][8];
#pragma unroll
      for (int j = 0; j < 7; j++) unpack8(xr[j], xf[j]);
      u16* dst = (mat == 0) ? s.qb : ((mat == 1) ? s.kn : s.vb);
#pragma unroll
      for (int r = 0; r < 4; r++) {
        float val[8];
        float ss = 0.f;
#pragma unroll
        for (int c = 0; c < 8; c++) {
          const float cv = cw[0][c] * xf[r][c] + cw[1][c] * xf[r + 1][c] + cw[2][c] * xf[r + 2][c] + cw[3][c] * xf[r + 3][c];
          val[c] = siluf(cv);
          ss += val[c] * val[c];
        }
        float rs = 1.f;
        if (mat < 2) {
#pragma unroll
          for (int off = 1; off < 16; off <<= 1) ss += __shfl_xor(ss, off);
          rs = rsqrtf(ss + EPSV) * ((mat == 0) ? 0.08838834764831845f : 1.f);
        }
        uint4 o;
        o.x = pack2(val[0] * rs, val[1] * rs); o.y = pack2(val[2] * rs, val[3] * rs);
        o.z = pack2(val[4] * rs, val[5] * rs); o.w = pack2(val[6] * rs, val[7] * rs);
        *(uint4*)&dst[(4 * rg + r) * QLD + ch * 8] = o;
      }
    }
  }
  __syncthreads();
  GDN_REFRESH();
  u16* const gQ = p.gQ + (size_t)unit * 8192;
  {
#pragma unroll
    for (int it = 0; it < 4; it++) {
      const int idx = tid + 256 * it;
      const int i = idx >> 4, d8 = (idx & 15) * 8;
      const float e = __expf(s.gc[i]);
      float f[8];
      unpack8(*(const uint4*)&s.qb[i * QLD + d8], f);
      uint4 o;
      o.x = pack2(f[0] * e, f[1] * e); o.y = pack2(f[2] * e, f[3] * e);
      o.z = pack2(f[4] * e, f[5] * e); o.w = pack2(f[6] * e, f[7] * e);
      *(uint4*)&gQ[i * 128 + d8] = o;
    }
  }
  f32x4 cqk[4];
  {
    bf16x8 aq[4], ak[4];
#pragma unroll
    for (int ks = 0; ks < 4; ks++) {
      aq[ks] = *(const bf16x8*)&s.qb[(wave * 16 + l15) * QLD + ks * 32 + g * 8];
      ak[ks] = *(const bf16x8*)&s.kn[(wave * 16 + l15) * QLD + ks * 32 + g * 8];
    }
#pragma unroll
    for (int ni = 0; ni < 4; ni++) {
      f32x4 ckk = {0.f, 0.f, 0.f, 0.f};
      cqk[ni] = (f32x4){0.f, 0.f, 0.f, 0.f};
      if (ni <= wave) {
#pragma unroll
        for (int ks = 0; ks < 4; ks++) {
          bf16x8 bk = *(const bf16x8*)&s.kn[(ni * 16 + l15) * QLD + ks * 32 + g * 8];
          ckk = mfma16(ak[ks], bk, ckk);
          cqk[ni] = mfma16(aq[ks], bk, cqk[ni]);
        }
      }
      const int j = ni * 16 + l15;
      const float gcj = s.gc[j];
#pragma unroll
      for (int r = 0; r < 4; r++) {
        const int i = wave * 16 + g * 4 + r;
        const float dec = (i >= j) ? __expf(s.gc[i] - gcj) : 0.f;
        s.Am[i * 64 + j] = (i > j) ? ckk[r] * s.beta[i] * dec : 0.f;
        cqk[ni][r] = (i >= j) ? cqk[ni][r] * dec : 0.f;
      }
    }
  }
  __syncthreads();
  GDN_REFRESH();
#pragma unroll
  for (int ni = 0; ni < 4; ni++)
#pragma unroll
    for (int r = 0; r < 4; r++) qk_s[(wave * 16 + g * 4 + r) * KLD + ni * 16 + l15] = f2bf(cqk[ni][r]);
  float xs[64];
#ifdef NO_SOLVE
  for (int i = 0; i < 64; i++) xs[i] = s.Am[i*64+tid%64];
#else
  {
    const int c = tid;
    const u16* src = (c < 128) ? &s.vb[c] : &s.kn[c - 128];
    const float* sc = (c < 128) ? s.beta : s.be;
#pragma unroll
    for (int i = 0; i < 64; i++) {
      float a0 = bf2f(src[i * QLD]) * sc[i], a1 = 0.f, a2 = 0.f, a3 = 0.f;
#pragma unroll
      for (int j4 = 0; j4 < (i + 3) / 4; j4++) {
        const float4 av = *(const float4*)&s.Am[i * 64 + j4 * 4];
        if (j4 * 4 + 0 < i) a0 -= av.x * xs[j4 * 4 + 0];
        if (j4 * 4 + 1 < i) a1 -= av.y * xs[j4 * 4 + 1];
        if (j4 * 4 + 2 < i) a2 -= av.z * xs[j4 * 4 + 2];
        if (j4 * 4 + 3 < i) a3 -= av.w * xs[j4 * 4 + 3];
      }
      xs[i] = (a0 + a1) + (a2 + a3);
      asm volatile("" : "+v"(xs[i]) :: "memory");
    }
  }
#endif
  const float glast = s.gc[63];
  __syncthreads();
  GDN_REFRESH();
  {
    const int d = tid & 127, half = tid >> 7;
#pragma unroll
    for (int q = 0; q < 4; q++) {
      unsigned ow[4];
#pragma unroll
      for (int e2 = 0; e2 < 4; e2++) {
        const int c0 = half * 32 + q * 8 + e2 * 2;
        const float v0 = bf2f(s.kn[c0 * QLD + d]) * __expf(glast - s.gc[c0]);
        const float v1 = bf2f(s.kn[(c0 + 1) * QLD + d]) * __expf(glast - s.gc[c0 + 1]);
        ow[e2] = pack2(v0, v1);
      }
      *(uint4*)&kdT[d * KLD + half * 32 + q * 8] = make_uint4(ow[0], ow[1], ow[2], ow[3]);
    }
    if (tid == 0) p.gdl[unit] = __expf(glast);
  }
  __syncthreads();
  GDN_REFRESH();
  if (tid >= 128) {
#pragma unroll
    for (int q = 0; q < 8; q++)
      *(uint4*)&WU[(tid - 128) * KLD + q * 8] = make_uint4(pack2(xs[q * 8], xs[q * 8 + 1]), pack2(xs[q * 8 + 2], xs[q * 8 + 3]),
                                                            pack2(xs[q * 8 + 4], xs[q * 8 + 5]), pack2(xs[q * 8 + 6], xs[q * 8 + 7]));
  }
  __syncthreads();
  GDN_REFRESH();
  {
    u16* const gM = p.gM + (size_t)unit * 16384;
    bf16x8 aw[2][2];
#pragma unroll
    for (int mm = 0; mm < 2; mm++)
#pragma unroll
      for (int ks = 0; ks < 2; ks++) aw[mm][ks] = *(const bf16x8*)&WU[((2 * wave + mm) * 16 + l15) * KLD + ks * 32 + g * 8];
#pragma unroll
    for (int nn = 0; nn < 8; nn++) {
      const bf16x8 b0 = *(const bf16x8*)&kdT[(nn * 16 + l15) * KLD + g * 8];
      const bf16x8 b1 = *(const bf16x8*)&kdT[(nn * 16 + l15) * KLD + 32 + g * 8];
#pragma unroll
      for (int mm = 0; mm < 2; mm++) {
        f32x4 acc = {0.f, 0.f, 0.f, 0.f};
        acc = mfma16(aw[mm][0], b0, acc);
        acc = mfma16(aw[mm][1], b1, acc);
        uint2 o; o.x = pack2(-acc[0], -acc[1]); o.y = pack2(-acc[2], -acc[3]);
        *(uint2*)&gM[(nn * 16 + l15) * 128 + (2 * wave + mm) * 16 + 4 * g] = o;
      }
    }
#pragma unroll
    for (int nn = 0; nn < 4; nn++) {
      const bf16x8 b0 = *(const bf16x8*)&qk_s[(nn * 16 + l15) * KLD + g * 8];
      const bf16x8 b1 = *(const bf16x8*)&qk_s[(nn * 16 + l15) * KLD + 32 + g * 8];
#pragma unroll
      for (int mm = 0; mm < 2; mm++) {
        f32x4 acc = {0.f, 0.f, 0.f, 0.f};
        acc = mfma16(aw[mm][0], b0, acc);
        acc = mfma16(aw[mm][1], b1, acc);
        u16* qp = &gQ[(nn * 16 + l15) * 128 + (2 * wave + mm) * 16 + 4 * g];
        float qv[4];
        unpack4(*(const uint2*)qp, qv);
        uint2 o; o.x = pack2(qv[0] - acc[0], qv[1] - acc[1]); o.y = pack2(qv[2] - acc[2], qv[3] - acc[3]);
        *(uint2*)qp = o;
      }
    }
  }
  __syncthreads();
  GDN_REFRESH();
  if (tid < 128) {
#pragma unroll
    for (int q = 0; q < 8; q++)
      *(uint4*)&WU[tid * KLD + q * 8] = make_uint4(pack2(xs[q * 8], xs[q * 8 + 1]), pack2(xs[q * 8 + 2], xs[q * 8 + 3]),
                                                    pack2(xs[q * 8 + 4], xs[q * 8 + 5]), pack2(xs[q * 8 + 6], xs[q * 8 + 7]));
  }
  __syncthreads();
  GDN_REFRESH();
  {
    u16* const gC = p.gC + (size_t)unit * 16384;
    u16* const gO = p.gO + (size_t)unit * 8192;
    bf16x8 akd[2][2], aqk[2];
#pragma unroll
    for (int mm = 0; mm < 2; mm++)
#pragma unroll
      for (int ks = 0; ks < 2; ks++) akd[mm][ks] = *(const bf16x8*)&kdT[((2 * wave + mm) * 16 + l15) * KLD + ks * 32 + g * 8];
#pragma unroll
    for (int ks = 0; ks < 2; ks++) aqk[ks] = *(const bf16x8*)&qk_s[(wave * 16 + l15) * KLD + ks * 32 + g * 8];
#pragma unroll
    for (int nn = 0; nn < 8; nn++) {
      const bf16x8 b0 = *(const bf16x8*)&WU[(nn * 16 + l15) * KLD + g * 8];
      const bf16x8 b1 = *(const bf16x8*)&WU[(nn * 16 + l15) * KLD + 32 + g * 8];
#pragma unroll
      for (int mm = 0; mm < 2; mm++) {
        f32x4 acc = {0.f, 0.f, 0.f, 0.f};
        acc = mfma16(akd[mm][0], b0, acc);
        acc = mfma16(akd[mm][1], b1, acc);
        uint2 o; o.x = pack2(acc[0], acc[1]); o.y = pack2(acc[2], acc[3]);
        *(uint2*)&gC[(nn * 16 + l15) * 128 + (2 * wave + mm) * 16 + 4 * g] = o;
      }
      {
        f32x4 acc = {0.f, 0.f, 0.f, 0.f};
        acc = mfma16(aqk[0], b0, acc);
        acc = mfma16(aqk[1], b1, acc);
        uint2 o; o.x = pack2(acc[0], acc[1]); o.y = pack2(acc[2], acc[3]);
        *(uint2*)&gO[(nn * 16 + l15) * 64 + wave * 16 + 4 * g] = o;
      }
    }
  }
}

__device__ void fox_cumsum_unit(const P& p, int bhf, float* red) {
  const int tid = threadIdx.x, lane = tid & 63, wave = tid >> 6;
  const int b = bhf >> 3, hf = bhf & 7;
  const float bias = p.fox_f_bias[hf];
  float v[8];
  float run = 0.f;
#pragma unroll
  for (int i = 0; i < 8; i++) {
    const int t = b * SEQ + tid * 8 + i;
    const float xx = p.gates[(size_t)t * 16 + 8 + hf] + bias;
    const float ls = fminf(xx, 0.f) - log1pf(__expf(-fabsf(xx)));
    run += ls;
    v[i] = run;
  }
  float tot = run;
#pragma unroll
  for (int off = 1; off < 64; off <<= 1) {
    float nb = __shfl_up(tot, off);
    if (lane >= off) tot += nb;
  }
  __syncthreads();
  if (lane == 63) red[wave] = tot;
  __syncthreads();
  float base = tot - run;
  for (int w = 0; w < wave; w++) base += red[w];
#pragma unroll
  for (int i = 0; i < 8; i++) p.cf[(size_t)bhf * SEQ + tid * 8 + i] = v[i] + base;
}

__device__ void phase_gdnprep(const P& p, unsigned char* smem) {
  GdnSmem& s = *(GdnSmem*)smem;
  for (int u = blockIdx.x; u < 1024 + 64; u += gridDim.x) {
    if (u < 1024) gdn_unit(p, u, s);
    else { __syncthreads(); fox_cumsum_unit(p, u - 1024, (float*)smem); }
  }
}

#define SLD 136
#define NSCAN 128
struct ScanSmem { u16 st[2][32 * SLD]; };
struct ScanSet { bf16x8 mf[2][4]; uint2 ci[2][2]; float dl; };

__device__ __forceinline__ void scan_load(const P& p, int unit, int eq, int w, int l15, int g, ScanSet& z) {
  int la = (32 * w + l15) * 128 + 8 * g, lc = (32 * eq + l15) * 128 + 32 * w + 4 * g;
  asm volatile("" : "+v"(la), "+v"(lc));
  const u16* gM = p.gM + (size_t)unit * 16384;
  const u16* gC = p.gC + (size_t)unit * 16384;
#pragma unroll
  for (int md = 0; md < 2; md++)
#pragma unroll
    for (int ks = 0; ks < 4; ks++) z.mf[md][ks] = *(const bf16x8*)&gM[la + md * 16 * 128 + ks * 32];
#pragma unroll
  for (int md = 0; md < 2; md++)
#pragma unroll
    for (int ne = 0; ne < 2; ne++) z.ci[md][ne] = *(const uint2*)&gC[lc + ne * 16 * 128 + md * 16];
  z.dl = p.gdl[unit];
}

__device__ __forceinline__ void scan_step(const P& p, int unit, int n, int eq, int w, int l15, int g, ScanSmem& s,
                                          f32x4 (&st)[2][2], const ScanSet& z) {
  const u16* Sb = s.st[n & 1];
  u16* Sn = s.st[(n & 1) ^ 1];
#pragma unroll
  for (int md = 0; md < 2; md++)
#pragma unroll
    for (int ne = 0; ne < 2; ne++) {
      float c[4];
      unpack4(z.ci[md][ne], c);
      st[md][ne][0] = st[md][ne][0] * z.dl + c[0];
      st[md][ne][1] = st[md][ne][1] * z.dl + c[1];
      st[md][ne][2] = st[md][ne][2] * z.dl + c[2];
      st[md][ne][3] = st[md][ne][3] * z.dl + c[3];
    }
  if (n > 0) {
    int lb = l15 * SLD + 8 * g;
    asm volatile("" : "+v"(lb));
#pragma unroll
    for (int ne = 0; ne < 2; ne++) {
#pragma unroll
      for (int ks = 0; ks < 4; ks++) {
        const bf16x8 bs = *(const bf16x8*)&Sb[lb + 16 * ne * SLD + ks * 32];
        st[0][ne] = mfma16(z.mf[0][ks], bs, st[0][ne]);
        st[1][ne] = mfma16(z.mf[1][ks], bs, st[1][ne]);
      }
    }
  }
  if (n + 1 < 32) {
    u16* gS = p.gS + (size_t)(unit + 1) * 16384;
    int lsl = l15 * SLD + 32 * w + 4 * g, lsg = (32 * eq + l15) * 128 + 32 * w + 4 * g;
    asm volatile("" : "+v"(lsl), "+v"(lsg));
#pragma unroll
    for (int md = 0; md < 2; md++)
#pragma unroll
      for (int ne = 0; ne < 2; ne++) {
        uint2 o; o.x = pack2(st[md][ne][0], st[md][ne][1]); o.y = pack2(st[md][ne][2], st[md][ne][3]);
        *(uint2*)&Sn[lsl + 16 * ne * SLD + 16 * md] = o;
        *(uint2*)&gS[lsg + 16 * ne * 128 + 16 * md] = o;
      }
  }
  asm volatile("s_waitcnt lgkmcnt(0)" ::: "memory");
  __builtin_amdgcn_s_barrier();
  asm volatile("" ::: "memory");
}

__device__ void scan_unit(const P& p, int item, ScanSmem& s) {
  int tid = threadIdx.x;
  asm volatile("" : "+v"(tid));
  const int lane = tid & 63, w = tid >> 6;
  const int l15 = lane & 15, g = lane >> 4;
  const int bh = item >> 2, eq = item & 3;
  const int u0 = bh * 32;
  f32x4 st[2][2];
#pragma unroll
  for (int md = 0; md < 2; md++)
#pragma unroll
    for (int ne = 0; ne < 2; ne++) st[md][ne] = (f32x4){0.f, 0.f, 0.f, 0.f};
  ScanSet z0, z1, z2, z3;
  scan_load(p, u0 + 0, eq, w, l15, g, z0);
  scan_load(p, u0 + 1, eq, w, l15, g, z1);
  scan_load(p, u0 + 2, eq, w, l15, g, z2);
#pragma unroll 1
  for (int n = 0; n < 32; n += 4) {
    scan_load(p, u0 + n + 3, eq, w, l15, g, z3);
    scan_step(p, u0 + n, n, eq, w, l15, g, s, st, z0);
    if (n + 4 < 32) scan_load(p, u0 + n + 4, eq, w, l15, g, z0);
    scan_step(p, u0 + n + 1, n + 1, eq, w, l15, g, s, st, z1);
    if (n + 4 < 32) scan_load(p, u0 + n + 5, eq, w, l15, g, z1);
    scan_step(p, u0 + n + 2, n + 2, eq, w, l15, g, s, st, z2);
    if (n + 4 < 32) scan_load(p, u0 + n + 6, eq, w, l15, g, z2);
    scan_step(p, u0 + n + 3, n + 3, eq, w, l15, g, s, st, z3);
  }
}

#define OLD 136
struct GoutSmem { float ssq[4][64]; u16 ob[64 * OLD]; };

__device__ void gout_unit(const P& p, int unit, GoutSmem& s) {
  const int tid = threadIdx.x, lane = tid & 63, w = tid >> 6;
  const int l15 = lane & 15, g = lane >> 4;
  const int bh = unit >> 5, n = unit & 31;
  const int b = bh >> 2, h = bh & 3;
  const u16* gQ = p.gQ + (size_t)unit * 8192;
  const u16* gO = p.gO + (size_t)unit * 8192;
  const u16* gS = p.gS + (size_t)unit * 16384;
  f32x4 o[4][2];
#pragma unroll
  for (int mc = 0; mc < 4; mc++)
#pragma unroll
    for (int ne = 0; ne < 2; ne++) {
      float c[4];
      unpack4(*(const uint2*)&gO[(32 * w + 16 * ne + l15) * 64 + 16 * mc + 4 * g], c);
      o[mc][ne] = (f32x4){c[0], c[1], c[2], c[3]};
    }
  if (n > 0) {
    bf16x8 bs[2][4];
#pragma unroll
    for (int ne = 0; ne < 2; ne++)
#pragma unroll
      for (int ks = 0; ks < 4; ks++) bs[ne][ks] = *(const bf16x8*)&gS[(32 * w + 16 * ne + l15) * 128 + ks * 32 + 8 * g];
#pragma unroll
    for (int mc = 0; mc < 4; mc++) {
#pragma unroll
      for (int ks = 0; ks < 4; ks++) {
        const bf16x8 aq = *(const bf16x8*)&gQ[(16 * mc + l15) * 128 + ks * 32 + 8 * g];
        o[mc][0] = mfma16(aq, bs[0][ks], o[mc][0]);
        o[mc][1] = mfma16(aq, bs[1][ks], o[mc][1]);
      }
    }
  }
  const float gnw0 = p.gdn_norm_w[32 * w + l15], gnw1 = p.gdn_norm_w[32 * w + 16 + l15];
  __syncthreads();
#pragma unroll
  for (int mc = 0; mc < 4; mc++)
#pragma unroll
    for (int r = 0; r < 4; r++) {
      float sq = o[mc][0][r] * o[mc][0][r] + o[mc][1][r] * o[mc][1][r];
#pragma unroll
      for (int off = 1; off < 16; off <<= 1) sq += __shfl_xor(sq, off);
      if (l15 == 0) s.ssq[w][16 * mc + 4 * g + r] = sq;
    }
  __syncthreads();
#pragma unroll
  for (int mc = 0; mc < 4; mc++)
#pragma unroll
    for (int r = 0; r < 4; r++) {
      const int c = 16 * mc + 4 * g + r;
      const float tot = s.ssq[0][c] + s.ssq[1][c] + s.ssq[2][c] + s.ssq[3][c];
      const float rs = rsqrtf(tot * (1.f / 128.f) + EPSV);
      s.ob[c * OLD + 32 * w + l15] = f2bf(o[mc][0][r] * rs * gnw0);
      s.ob[c * OLD + 32 * w + 16 + l15] = f2bf(o[mc][1][r] * rs * gnw1);
    }
  __syncthreads();
  {
    const int t0 = b * SEQ + n * 64;
    const int c0 = tid >> 4, ch = tid & 15;
    const u16* zp = p.proj + (size_t)(t0 + c0) * PROJW + 1536 + h * 128 + ch * 8;
    u16* op = p.actA + (size_t)(t0 + c0) * DM + h * 128 + ch * 8;
#pragma unroll
    for (int i = 0; i < 4; i++) {
      float ov[8], zv[8];
      unpack8(*(const uint4*)&s.ob[(c0 + 16 * i) * OLD + ch * 8], ov);
      unpack8(*(const uint4*)(zp + (size_t)i * 16 * PROJW), zv);
      uint4 r;
      r.x = pack2(ov[0] * siluf(zv[0]), ov[1] * siluf(zv[1])); r.y = pack2(ov[2] * siluf(zv[2]), ov[3] * siluf(zv[3]));
      r.z = pack2(ov[4] * siluf(zv[4]), ov[5] * siluf(zv[5])); r.w = pack2(ov[6] * siluf(zv[6]), ov[7] * siluf(zv[7]));
      *(uint4*)(op + (size_t)i * 16 * DM) = r;
    }
  }
}

__device__ void phase_gout(const P& p, unsigned char* smem) {
  GoutSmem& s = *(GoutSmem*)smem;
  for (int u = blockIdx.x; u < 1024; u += gridDim.x) gout_unit(p, u, s);
}

#define LOG2E 1.4426950408889634f
#define ALD 72
struct AttnSmem { u16 k[2][64 * ALD]; u16 v[2][64 * ALD]; float ck[2][64]; };

__device__ void attn_unit(const P& p, int item, AttnSmem& s) {
  int tid = threadIdx.x;
  asm volatile("" : "+v"(tid));
  const int lane = tid & 63, w = tid >> 6;
  const int l15 = lane & 15, g = lane >> 4;
  const int qb = 15 - (item >> 6), bhf = item & 63;
  const int b = bhf >> 3, hf = bhf & 7;
  const int q0 = qb * 128 + 32 * w;
  const u16* qbase = p.proj + (size_t)(b * SEQ) * PROJW + 2048 + hf * 64;
  const u16* kbase = p.proj + (size_t)(b * SEQ) * PROJW + 2560 + hf * 64;
  const u16* vbase = p.vt + (size_t)bhf * 64 * SEQ;
  const float* cfb = p.cf + (size_t)bhf * SEQ;
  bf16x8 qf[2][2];
#pragma unroll
  for (int mi = 0; mi < 2; mi++)
#pragma unroll
    for (int ks = 0; ks < 2; ks++) qf[mi][ks] = *(const bf16x8*)&qbase[(size_t)(q0 + 16 * mi + l15) * PROJW + ks * 32 + g * 8];
  float cq[2], m[2], lsum[2];
  f32x4 O[2][4];
#pragma unroll
  for (int mi = 0; mi < 2; mi++) {
    cq[mi] = cfb[q0 + 16 * mi + l15] * LOG2E; m[mi] = -1e30f; lsum[mi] = 0.f;
#pragma unroll
    for (int nd = 0; nd < 4; nd++) O[mi][nd] = (f32x4){0.f, 0.f, 0.f, 0.f};
  }
  const int ntile = (q0 + 32 + 63) >> 6;
  const int ntile_blk = 2 * qb + 2;
  const int srow = tid >> 3, scol = (tid & 7) * 8;
  const u16* kg = kbase + (size_t)srow * PROJW + scol;
  const u16* vg = vbase + (size_t)srow * SEQ + scol;
  uint4 rk0, rk1, rv0, rv1;
  float rck = 0.f;
  rk0 = *(const uint4*)(kg); rk1 = *(const uint4*)(kg + (size_t)32 * PROJW);
  rv0 = *(const uint4*)(vg); rv1 = *(const uint4*)(vg + (size_t)32 * SEQ);
  if (tid < 64) rck = cfb[tid] * LOG2E;
  *(uint4*)&s.k[0][srow * ALD + scol] = rk0; *(uint4*)&s.k[0][(srow + 32) * ALD + scol] = rk1;
  *(uint4*)&s.v[0][srow * ALD + scol] = rv0; *(uint4*)&s.v[0][(srow + 32) * ALD + scol] = rv1;
  if (tid < 64) s.ck[0][tid] = rck;
  __syncthreads();
#pragma unroll 1
  for (int kt = 0; kt < ntile_blk; kt++) {
    const int k0 = kt * 64, buf = kt & 1;
    if (kt + 1 < ntile_blk) {
      rk0 = *(const uint4*)(kg + (size_t)(k0 + 64) * PROJW); rk1 = *(const uint4*)(kg + (size_t)(k0 + 96) * PROJW);
      rv0 = *(const uint4*)(vg + k0 + 64); rv1 = *(const uint4*)(vg + (size_t)32 * SEQ + k0 + 64);
      if (tid < 64) rck = cfb[k0 + 64 + tid] * LOG2E;
    }
    if (kt < ntile) {
      const u16* Ks = s.k[buf];
      const u16* Vs = s.v[buf];
      f32x4 ST[2][4];
#pragma unroll
      for (int t = 0; t < 4; t++) {
        const bf16x8 kf0 = *(const bf16x8*)&Ks[(16 * t + l15) * ALD + g * 8];
        const bf16x8 kf1 = *(const bf16x8*)&Ks[(16 * t + l15) * ALD + 32 + g * 8];
#pragma unroll
        for (int mi = 0; mi < 2; mi++) {
          f32x4 acc = {0.f, 0.f, 0.f, 0.f};
          acc = mfma16(kf0, qf[mi][0], acc);
          acc = mfma16(kf1, qf[mi][1], acc);
          ST[mi][t] = acc;
        }
      }
      float4 ck[4];
#pragma unroll
      for (int t = 0; t < 4; t++) ck[t] = *(const float4*)&s.ck[buf][16 * t + 4 * g];
      const bool diag = (kt == ntile - 1);
      bf16x8 pf[2][2];
#pragma unroll
      for (int mi = 0; mi < 2; mi++) {
        const int qpos = q0 + 16 * mi + l15;
        float mx = -1e30f;
#pragma unroll
        for (int t = 0; t < 4; t++) {
          const float ckv[4] = {ck[t].x, ck[t].y, ck[t].z, ck[t].w};
#pragma unroll
          for (int r = 0; r < 4; r++) {
            float lg = ST[mi][t][r] * (0.125f * LOG2E) + (cq[mi] - ckv[r]);
            if (diag && (k0 + 16 * t + 4 * g + r > qpos)) lg = -1e30f;
            ST[mi][t][r] = lg;
            mx = fmaxf(mx, lg);
          }
        }
        mx = fmaxf(mx, __shfl_xor(mx, 16));
        mx = fmaxf(mx, __shfl_xor(mx, 32));
        const float mn = fmaxf(m[mi], mx);
        const float alpha = __builtin_amdgcn_exp2f(m[mi] - mn);
        m[mi] = mn;
        float ps = 0.f;
#pragma unroll
        for (int t = 0; t < 4; t++)
#pragma unroll
          for (int r = 0; r < 4; r++) {
            const float pe = __builtin_amdgcn_exp2f(ST[mi][t][r] - mn);
            ST[mi][t][r] = pe;
            ps += pe;
          }
        lsum[mi] = lsum[mi] * alpha + ps;
#pragma unroll
        for (int kk = 0; kk < 2; kk++) {
          uint4 pk;
          pk.x = pack2(ST[mi][2 * kk][0], ST[mi][2 * kk][1]); pk.y = pack2(ST[mi][2 * kk][2], ST[mi][2 * kk][3]);
          pk.z = pack2(ST[mi][2 * kk + 1][0], ST[mi][2 * kk + 1][1]); pk.w = pack2(ST[mi][2 * kk + 1][2], ST[mi][2 * kk + 1][3]);
          pf[mi][kk] = __builtin_bit_cast(bf16x8, pk);
        }
#pragma unroll
        for (int r = 0; r < 4; r++) {
          const float ar = __shfl(alpha, 4 * g + r);
#pragma unroll
          for (int nd = 0; nd < 4; nd++) O[mi][nd][r] *= ar;
        }
      }
#pragma unroll
      for (int nd = 0; nd < 4; nd++)
#pragma unroll
        for (int kk = 0; kk < 2; kk++) {
          const uint2 vlo = *(const uint2*)&Vs[(16 * nd + l15) * ALD + 32 * kk + 4 * g];
          const uint2 vhi = *(const uint2*)&Vs[(16 * nd + l15) * ALD + 32 * kk + 16 + 4 * g];
          const bf16x8 vf = __builtin_bit_cast(bf16x8, make_uint4(vlo.x, vlo.y, vhi.x, vhi.y));
          O[0][nd] = mfma16(pf[0][kk], vf, O[0][nd]);
          O[1][nd] = mfma16(pf[1][kk], vf, O[1][nd]);
        }
    }
    if (kt + 1 < ntile_blk) {
      const int nb = buf ^ 1;
      *(uint4*)&s.k[nb][srow * ALD + scol] = rk0; *(uint4*)&s.k[nb][(srow + 32) * ALD + scol] = rk1;
      *(uint4*)&s.v[nb][srow * ALD + scol] = rv0; *(uint4*)&s.v[nb][(srow + 32) * ALD + scol] = rv1;
      if (tid < 64) s.ck[nb][tid] = rck;
    }
    __syncthreads();
  }
#pragma unroll
  for (int mi = 0; mi < 2; mi++) {
    float l = lsum[mi];
    l += __shfl_xor(l, 16);
    l += __shfl_xor(l, 32);
    const float inv = 1.f / l;
#pragma unroll
    for (int r = 0; r < 4; r++) {
      const float ir = __shfl(inv, 4 * g + r);
      const int t = b * SEQ + q0 + 16 * mi + 4 * g + r;
#pragma unroll
      for (int nd = 0; nd < 4; nd++) p.actA[(size_t)t * DM + 512 + hf * 64 + 16 * nd + l15] = f2bf(O[mi][nd][r] * ir);
    }
  }
}

__device__ void deferred_transpose(const P& p, int it, float* tile) {
  const int n1 = 16 * 16, n2 = n1 + 16 * 88, n3 = n2 + 44 * 16, n4 = n3 + 16 * 16;
  if (it < n1) { transpose_item(p.w_out, 1024, p.wt_out, 1024, it % 16, it / 16, 1, tile); }
  else if (it < n2) { int j = it - n1; transpose_item(p.w_gate_up, 2 * DFF, p.wt_gu, 1024, j % 16, j / 16, 2, tile); }
  else if (it < n3) { int j = it - n2; transpose_item(p.w_down, 1024, p.wt_down, DFF, j % 44, j / 44, 1, tile); }
  else if (it < n4) { int j = it - n3; transpose_item(p.w_ple_gate, 1024, p.wt_pg, 1024, j % 16, j / 16, 1, tile); }
  else { int j = it - n4; transpose_item(p.w_ple_proj, 1024, p.wt_pp, 256, j % 4, j / 4, 1, tile); }
}
#define N_DEFER (16 * 16 + 16 * 88 + 44 * 16 + 16 * 16 + 4 * 16)

__device__ void phase_mixer(const P& p, unsigned char* smem, int rr) {
  volatile int* s_item_p = (volatile int*)(smem + SMEM_MAIN + 16);
  for (;;) {
    __syncthreads();
    if (threadIdx.x == 0) *s_item_p = (int)atomicAdd(&p.counters[rr], 1u);
    __syncthreads();
    const int item = *s_item_p;
    if (item >= NSCAN + 1024 + N_DEFER) break;
    if (item < NSCAN) { scan_unit(p, item, *(ScanSmem*)smem); }
    else if (item < NSCAN + 1024) { attn_unit(p, item - NSCAN, *(AttnSmem*)smem); }
    else { deferred_transpose(p, item - NSCAN - 1024, (float*)smem); }
  }
}

#define XB_TMO      128
#define XB_XCNT(j)  (256  + 64 * (j))
#define XB_XSUB(j)  (1280 + 64 * (j))
#define XB_XGEN(j)  (2304 + 64 * (j))
#define XB_TOP      3328
#define XB_TOPGEN   3392
#define XCD_BAR_WORDS 3456
#define XB_SPIN_CAP (1u << 20)
#define LAS __attribute__((address_space(3)))
__device__ __forceinline__ unsigned xb_ld(unsigned* p) { return __hip_atomic_load(p, __ATOMIC_RELAXED, __HIP_MEMORY_SCOPE_AGENT); }
__device__ __forceinline__ unsigned xb_add(unsigned* p, unsigned v) { return __hip_atomic_fetch_add(p, v, __ATOMIC_RELAXED, __HIP_MEMORY_SCOPE_AGENT); }
__device__ __forceinline__ unsigned xb_xcc_id() { return (unsigned)__builtin_amdgcn_s_getreg((3 << 11) | 20) & 0xFu; }
#define XB_SPIN(cond, bar) do { unsigned _sp = 0; while (cond) { __builtin_amdgcn_s_sleep(1); \
    if ((++_sp & 255u) == 0u) { if (xb_ld(&(bar)[XB_TMO])) break; if (_sp > XB_SPIN_CAP) { atomicAdd(&(bar)[XB_TMO], 1u); break; } } } } while (0)
struct XcdBarrier { unsigned* bar; unsigned x; volatile LAS unsigned* st; };
__device__ __forceinline__ XcdBarrier xcd_barrier_post(unsigned* bar, volatile LAS unsigned* st) {
  XcdBarrier b; b.bar = bar; b.x = xb_xcc_id(); b.st = st;
  if (threadIdx.x == 0) (void)xb_add(&bar[XB_XCNT(b.x)], 1u);
  return b;
}
__device__ __forceinline__ void xcd_barrier_complete(unsigned* bar, unsigned x, unsigned& nloc, unsigned& nx) {
  const unsigned G = gridDim.x * gridDim.y * gridDim.z;
  unsigned sum, cnt, mine, sp = 0u;
  for (;;) {
    sum = 0u; cnt = 0u; mine = 0u;
#pragma unroll
    for (unsigned j = 0; j < 16; ++j) { const unsigned c = xb_ld(&bar[XB_XCNT(j)]); sum += c; cnt += (c > 0u) ? 1u : 0u; mine = (j == x) ? c : mine; }
    if (sum == G) break;
    __builtin_amdgcn_s_sleep(1);
    if ((++sp & 255u) == 0u) { if (xb_ld(&bar[XB_TMO])) break; if (sp > XB_SPIN_CAP) { atomicAdd(&bar[XB_TMO], 1u); break; } }
  }
  nloc = mine > 0u ? mine : 1u; nx = cnt > 0u ? cnt : 1u;
}
__device__ __forceinline__ void xcd_barrier(const XcdBarrier& b) {
  asm volatile("s_waitcnt vmcnt(0)" ::: "memory");
  __syncthreads();
  if (threadIdx.x == 0) {
    unsigned* bar = b.bar;
    __builtin_amdgcn_s_waitcnt(0);
    unsigned nloc = b.st[0], nx = b.st[1];
    if (nloc == 0u) { xcd_barrier_complete(bar, b.x, nloc, nx); b.st[0] = nloc; b.st[1] = nx; }
    const unsigned old = xb_add(&bar[XB_XSUB(b.x)], 1u);
    const unsigned gen = old / nloc;
    if (old + 1u == (gen + 1u) * nloc) {
      __builtin_amdgcn_fence(__ATOMIC_RELEASE, "agent");
      asm volatile("s_waitcnt vmcnt(0)" ::: "memory");
      const unsigned og = xb_add(&bar[XB_TOP], 1u);
      const unsigned tg = og / nx;
      if (og + 1u == (tg + 1u) * nx) xb_add(&bar[XB_TOPGEN], 1u);
      else XB_SPIN(xb_ld(&bar[XB_TOPGEN]) == tg, bar);
      __builtin_amdgcn_fence(__ATOMIC_ACQUIRE, "agent");
      xb_add(&bar[XB_XGEN(b.x)], 1u);
      asm volatile("s_waitcnt vmcnt(0)" ::: "memory");
    } else {
      XB_SPIN(xb_ld(&bar[XB_XGEN(b.x)]) == gen, bar);
      __builtin_amdgcn_fence(__ATOMIC_ACQUIRE, "agent");
      asm volatile("s_waitcnt vmcnt(0)" ::: "memory");
    }
  }
  __syncthreads();
}

__global__ void __launch_bounds__(256, 2) mega(P p, int lo, int hi) {
  __shared__ __attribute__((aligned(16))) unsigned char smem[SMEM_MAIN + 32];
  cg::grid_group grid = cg::this_grid();
  uint4* xbw = (uint4*)(smem + SMEM_MAIN);
  if (threadIdx.x == 0) *xbw = make_uint4(0u, 0u, 0u, 0u);
  __syncthreads();
  XcdBarrier xb = xcd_barrier_post(p.bar, (volatile LAS unsigned*)xbw);
  if (hi < 0) grid.sync();
#define REP0 1
#define REP2 1
#define REP3 1
#define REP4 1
#define SEAM(k) if (lo <= k && k + 1 < hi) xcd_barrier(xb);
#if !defined(ONLY) || ONLY == 0
  if (lo <= 0 && 0 < hi) { for (int rr = 0; rr < REP0; rr++) { phase_prep(p, smem); if (rr + 1 < REP0) xcd_barrier(xb); } }
#endif
  SEAM(0)
#if !defined(ONLY) || ONLY == 1
  if (lo <= 1 && 1 < hi) phase_inproj(p, smem);
#endif
  SEAM(1)
#if !defined(ONLY) || ONLY == 2
  if (lo <= 2 && 2 < hi) { for (int rr = 0; rr < REP2; rr++) { phase_gdnprep(p, smem); if (rr + 1 < REP2) xcd_barrier(xb); } }
#endif
  SEAM(2)
#if !defined(ONLY) || ONLY == 3
  if (lo <= 3 && 3 < hi) { for (int rr = 0; rr < REP3; rr++) { phase_mixer(p, smem, rr); if (rr + 1 < REP3) xcd_barrier(xb); } }
#endif
  SEAM(3)
#if !defined(ONLY) || ONLY == 4
  if (lo <= 4 && 4 < hi) { for (int rr = 0; rr < REP4; rr++) { phase_gout(p, smem); if (rr + 1 < REP4) xcd_barrier(xb); } }
#endif
  SEAM(4)
#if !defined(ONLY) || ONLY == 5
  if (lo <= 5 && 5 < hi) phase_outproj(p, smem);
#endif
  SEAM(5)
  if (lo <= 6 && 6 < hi) phase_rmsnorm(p.h, p.ffn_norm_w, p.actA, nullptr);
  SEAM(6)
#if !defined(ONLY) || ONLY == 7
  if (lo <= 7 && 7 < hi) phase_gateup(p, smem);
#endif
  SEAM(7)
#if !defined(ONLY) || ONLY == 8
  if (lo <= 8 && 8 < hi) phase_down(p, smem);
#endif
  SEAM(8)
  if (lo <= 9 && 9 < hi) phase_rmsnorm(p.h, p.ple_norm_w, p.actA, nullptr);
  SEAM(9)
#if !defined(ONLY) || ONLY == 10
  if (lo <= 10 && 10 < hi) phase_ple(p, smem);
#endif
  SEAM(10)
  if (lo <= 11 && 11 < hi) phase_rmsnorm(p.h, p.final_norm_w, nullptr, p.h);
}

static_assert(sizeof(GemmSmem) <= SMEM_MAIN && sizeof(GdnSmem) <= SMEM_MAIN && sizeof(ScanSmem) <= SMEM_MAIN &&
              sizeof(GoutSmem) <= SMEM_MAIN && sizeof(AttnSmem) <= SMEM_MAIN && 64 * 65 * 4 <= SMEM_MAIN, "smem");

extern "C" void kernel_launch(void* const* d_in, const int* in_sizes, int n_in, void* d_out, int out_size,
                              void* d_ws, size_t ws_size, hipStream_t stream) {
  static int grid_blocks = 0;
  if (!grid_blocks) {
    int dev = 0, cus = 0, per_cu = 0;
    hipGetDevice(&dev);
    hipDeviceGetAttribute(&cus, hipDeviceAttributeMultiprocessorCount, dev);
    hipOccupancyMaxActiveBlocksPerMultiprocessor(&per_cu, mega, 256, 0);
    if (per_cu > 2) per_cu = 2;
    if (per_cu < 1) per_cu = 1;
    grid_blocks = cus * per_cu;
  }
  P p{};
  const float* const* in = (const float* const*)d_in;
  p.x = in[0]; p.p = in[1]; p.attn_norm_w = in[2]; p.w_in = in[3]; p.conv_w = in[4]; p.a_log = in[5];
  p.dt_bias = in[6]; p.gdn_norm_w = in[7]; p.fox_f_bias = in[8]; p.w_out = in[9]; p.ffn_norm_w = in[10];
  p.w_gate_up = in[11]; p.w_down = in[12]; p.ple_norm_w = in[13]; p.w_ple_gate = in[14]; p.w_ple_proj = in[15];
  p.final_norm_w = in[16];
  p.h = (float*)d_out;
  unsigned char* ws = (unsigned char*)d_ws;
  size_t off = 0;
  auto take = [&](size_t bytes) { unsigned char* r = ws + off; off += (bytes + 255) & ~(size_t)255; return r; };
  p.counters = (unsigned*)take(256);
  p.bar = (unsigned*)take(XCD_BAR_WORDS * 4);
  p.wt_in = (u16*)take((size_t)NIN_PAD * 1024 * 2);
  p.wt_out = (u16*)take((size_t)1024 * 1024 * 2);
  p.wt_gu = (u16*)take((size_t)2 * DFF * 1024 * 2);
  p.wt_down = (u16*)take((size_t)1024 * DFF * 2);
  p.wt_pg = (u16*)take((size_t)1024 * 1024 * 2);
  p.wt_pp = (u16*)take((size_t)1024 * 256 * 2);
  p.actA = (u16*)take((size_t)NTOK * 1024 * 2);
  p.pb = (u16*)take((size_t)NTOK * 256 * 2);
  p.proj = (u16*)take((size_t)NTOK * PROJW * 2);
  p.vt = (u16*)take((size_t)64 * 64 * SEQ * 2);
  p.gates = (float*)take((size_t)NTOK * 16 * 4);
  p.cf = (float*)take((size_t)64 * SEQ * 4);
  p.gM = (u16*)take((size_t)1024 * 16384 * 2);
  p.gC = (u16*)take((size_t)1024 * 16384 * 2);
  p.gdl = (float*)take(1024 * 4);
  if (off > ws_size) fprintf(stderr, "workspace too small: need %zu have %zu\n", off, ws_size);
  u16* ob = (u16*)d_out;
  p.gS = ob;
  p.gQ = ob + (size_t)1024 * 16384;
  p.gO = ob + (size_t)1024 * 16384 + (size_t)1024 * 8192;
  hipMemsetAsync(p.bar, 0, XCD_BAR_WORDS * 4, stream);
  int lo = 0, hi = NPHASE;
  void* args[] = {&p, &lo, &hi};
  hipError_t e = hipLaunchCooperativeKernel((void*)mega, dim3(grid_blocks), dim3(256), args, 0, stream);
  if (e != hipSuccess) fprintf(stderr, "cooperative launch failed: %s (grid %d)\n", hipGetErrorString(e), grid_blocks);
}
```

```cpp
#include <hip/hip_runtime.h>
#include <hip/hip_cooperative_groups.h>
#include <cstdio>
#include <cstdint>
namespace cg = cooperative_groups;

typedef unsigned short u16;
typedef __attribute__((ext_vector_type(8))) short bf16x8;
typedef __attribute__((ext_vector_type(4))) float f32x4;

#define NTOK 16384
#define SEQ 2048
#define DM 1024
#define DFF 2816
#define PROJW 3072
#define NIN_PAD 3712
#define EPSV 1e-6f
#define NPHASE 10
#define SMEM_MAIN 71680

struct P {
  const float *x, *p, *attn_norm_w, *w_in, *conv_w, *a_log, *dt_bias, *gdn_norm_w, *fox_f_bias, *w_out,
      *ffn_norm_w, *w_gate_up, *w_down, *ple_norm_w, *w_ple_gate, *w_ple_proj, *final_norm_w;
  float* h;
  u16 *wt_in, *wt_out, *wt_gu, *wt_down, *wt_pg, *wt_pp;
  u16 *actA;
  u16 *pb;
  u16 *proj;
  u16 *vt;
  float *gates;
  float *cf;
  u16 *gM, *gC;
  u16 *gQ, *gO;
  u16 *gS;
  float *gdl;
  unsigned *counters;
  unsigned *bar;
  u16 *hb;
  float *rss;
};

typedef __attribute__((ext_vector_type(2))) float f32x2_t;
typedef __attribute__((ext_vector_type(2))) __bf16 bf16x2_t;
__device__ __forceinline__ u16 f2bf(float f) { return __builtin_bit_cast(u16, (__bf16)f); }
__device__ __forceinline__ float bf2f(u16 h) { return __uint_as_float(((unsigned)h) << 16); }
__device__ __forceinline__ unsigned pack2(float a, float b) {
  f32x2_t f = {a, b};
  return __builtin_bit_cast(unsigned, __builtin_convertvector(f, bf16x2_t));
}
__device__ __forceinline__ float siluf(float v) { return v / (1.f + __expf(-v)); }
__device__ __forceinline__ float sigmoidf_(float v) { return 1.f / (1.f + __expf(-v)); }
__device__ __forceinline__ f32x4 mfma16(bf16x8 a, bf16x8 b, f32x4 c) {
  return __builtin_amdgcn_mfma_f32_16x16x32_bf16(a, b, c, 0, 0, 0);
}
#define LDS_FENCE() asm volatile("s_waitcnt lgkmcnt(0)" ::: "memory")

__device__ __forceinline__ int colmap(int kind, int nn) {
  if (kind == 0) {
    if (nn < 2048) return nn;
    if (nn < 3584) return nn + 8;
    if (nn < 3588) return 2048 + (nn - 3584);
    if (nn < 3592) return 2052 + (nn - 3588);
    if (nn < 3600) return nn;
    return -1;
  } else if (kind == 2) {
    int i = nn >> 7, wc = (nn >> 6) & 1, u = (nn >> 5) & 1, j = nn & 31;
    return u * DFF + 64 * i + 32 * wc + j;
  }
  return nn;
}

__device__ void transpose_item(const float* __restrict__ src, int ldsrc, u16* __restrict__ dst, int K,
                               int kt, int nt, int kind, float* tile, const float* __restrict__ kscale = nullptr) {
  int tid = threadIdx.x;
  asm volatile("" : "+v"(tid));
  const int c = tid & 63, r0 = tid >> 6;
  const int ncol = colmap(kind, nt * 64 + c);
#pragma unroll 4
  for (int i = 0; i < 16; i++) {
    int r = r0 + 4 * i;
    float v = (ncol >= 0) ? src[(size_t)(kt * 64 + r) * ldsrc + ncol] : 0.f;
    if (kscale) v *= kscale[kt * 64 + r];
    tile[r * 65 + c] = v;
  }
  __syncthreads();
#pragma unroll 4
  for (int i = 0; i < 16; i++) {
    int rn = r0 + 4 * i;
    dst[(size_t)(nt * 64 + rn) * K + kt * 64 + c] = f2bf(tile[c * 65 + rn]);
  }
  __syncthreads();
}

__device__ __forceinline__ void rmsnorm_row(const float* src, const float* __restrict__ w,
                                            u16* dstb, float* dstf, int row) {
  const int lane = threadIdx.x & 63;
  float4 v[4];
  float ss = 0.f;
#pragma unroll
  for (int i = 0; i < 4; i++) {
    v[i] = *(const float4*)&src[(size_t)row * DM + i * 256 + lane * 4];
    ss += v[i].x * v[i].x + v[i].y * v[i].y + v[i].z * v[i].z + v[i].w * v[i].w;
  }
#pragma unroll
  for (int off = 32; off >= 1; off >>= 1) ss += __shfl_xor(ss, off);
  const float r = rsqrtf(ss * (1.f / DM) + EPSV);
#pragma unroll
  for (int i = 0; i < 4; i++) {
    const int col = i * 256 + lane * 4;
    float4 wv = *(const float4*)&w[col];
    float y0 = v[i].x * r * wv.x, y1 = v[i].y * r * wv.y, y2 = v[i].z * r * wv.z, y3 = v[i].w * r * wv.w;
    if (dstb) {
      uint2 o; o.x = pack2(y0, y1); o.y = pack2(y2, y3);
      *(uint2*)&dstb[(size_t)row * DM + col] = o;
    } else {
      *(float4*)&dstf[(size_t)row * DM + col] = make_float4(y0, y1, y2, y3);
    }
  }
}

__device__ void phase_prep(const P& p, unsigned char* smem) {
  float* tile = (float*)smem;
  if (blockIdx.x == 0 && threadIdx.x < 16) p.counters[threadIdx.x] = 0u;
  for (int i = blockIdx.x * 256 + threadIdx.x; i < 3 * NTOK; i += gridDim.x * 256) p.rss[i] = 0.f;
  for (int it = blockIdx.x; it < 16 * 58; it += gridDim.x) transpose_item(p.w_in, 3600, p.wt_in, 1024, it % 16, it / 16, 0, tile);
  const int wave = threadIdx.x >> 6, lane = threadIdx.x & 63;
  for (int rb = blockIdx.x; rb < NTOK / 4; rb += gridDim.x) {
    const int row = rb * 4 + wave;
    rmsnorm_row(p.x, p.attn_norm_w, p.actA, nullptr, row);
    float4 pv = *(const float4*)&p.p[(size_t)row * 256 + lane * 4];
    uint2 o; o.x = pack2(pv.x, pv.y); o.y = pack2(pv.z, pv.w);
    *(uint2*)&p.pb[(size_t)row * 256 + lane * 4] = o;
  }
}

__device__ void phase_rmsnorm(const float* src, const float* w, u16* dstb, float* dstf) {
  const int wave = threadIdx.x >> 6;
  for (int rb = blockIdx.x; rb < NTOK / 4; rb += gridDim.x) rmsnorm_row(src, w, dstb, dstf, rb * 4 + wave);
}

__device__ void phase_final(const P& p) {
  const int wave = threadIdx.x >> 6, lane = threadIdx.x & 63;
  for (int rb = blockIdx.x; rb < NTOK / 4; rb += gridDim.x) {
    const int row = rb * 4 + wave;
    const float r = rsqrtf(p.rss[2 * NTOK + row] * (1.f / DM) + EPSV);
#pragma unroll
    for (int i = 0; i < 4; i++) {
      const int col = i * 256 + lane * 4;
      float4 v = *(const float4*)&p.h[(size_t)row * DM + col];
      const float4 wv = *(const float4*)&p.final_norm_w[col];
      v.x *= r * wv.x; v.y *= r * wv.y; v.z *= r * wv.z; v.w *= r * wv.w;
      *(float4*)&p.h[(size_t)row * DM + col] = v;
    }
  }
}

#define GK 64
struct GemmSmem { u16 a[2][128 * GK]; u16 b[2][128 * GK]; };

template <bool SWAP>
__device__ __forceinline__ void gemm_tile(const u16* __restrict__ A, int lda, const u16* __restrict__ Bt, int ldb,
                                          int K, int m0, int n0, GemmSmem& s, f32x4 (&acc)[4][4]) {
  int tid = threadIdx.x;
  asm volatile("" : "+v"(tid));
  const int lane = tid & 63, wave = tid >> 6;
  const int wr = wave >> 1, wc = wave & 1;
  const int l15 = lane & 15, g = lane >> 4;
  const int nk = K / GK;
  const int drow = 8 * wave + (lane >> 3);
  const int dchunk = (lane & 7) ^ ((4 * (wave & 1) + (lane >> 4)) & 7);
  const u16* Ap = A + (size_t)(m0 + drow) * lda + dchunk * 8;
  const u16* Bp = Bt + (size_t)(n0 + drow) * ldb + dchunk * 8;
  const size_t sa = (size_t)32 * lda, sb = (size_t)32 * ldb;
#define G_DMA(bufi, koff) do { \
    _Pragma("unroll") for (int _i = 0; _i < 4; _i++) { \
      __builtin_amdgcn_global_load_lds((const unsigned*)(Ap + _i * sa + (koff)), (unsigned*)&s.a[bufi][(32 * _i + 8 * wave) * GK], 16, 0, 0); \
      __builtin_amdgcn_global_load_lds((const unsigned*)(Bp + _i * sb + (koff)), (unsigned*)&s.b[bufi][(32 * _i + 8 * wave) * GK], 16, 0, 0); \
    } } while (0)
  const int fo0 = l15 * GK + ((g ^ (l15 >> 1)) * 8);
  const int fo1 = l15 * GK + (((4 + g) ^ (l15 >> 1)) * 8);
  G_DMA(0, 0);
  asm volatile("s_waitcnt vmcnt(0)" ::: "memory");
  __builtin_amdgcn_s_barrier();
  asm volatile("" ::: "memory");
  for (int kt = 0; kt < nk; kt++) {
    const int buf = kt & 1;
    if (kt + 1 < nk) { if (buf) G_DMA(0, (kt + 1) * GK); else G_DMA(1, (kt + 1) * GK); }
    const u16* sa_ = &s.a[buf][(wr * 64) * GK];
    const u16* sb_ = &s.b[buf][(wc * 64) * GK];
#pragma unroll
    for (int ks = 0; ks < 2; ks++) {
      const int fo = ks ? fo1 : fo0;
      bf16x8 af[4], bfr[4];
#pragma unroll
      for (int mi = 0; mi < 4; mi++) af[mi] = *(const bf16x8*)&sa_[mi * 16 * GK + fo];
#pragma unroll
      for (int ni = 0; ni < 4; ni++) bfr[ni] = *(const bf16x8*)&sb_[ni * 16 * GK + fo];
#pragma unroll
      for (int mi = 0; mi < 4; mi++)
#pragma unroll
        for (int ni = 0; ni < 4; ni++) acc[mi][ni] = SWAP ? mfma16(bfr[ni], af[mi], acc[mi][ni]) : mfma16(af[mi], bfr[ni], acc[mi][ni]);
    }
    asm volatile("s_waitcnt vmcnt(0) lgkmcnt(0)" ::: "memory");
    __builtin_amdgcn_s_barrier();
    asm volatile("" ::: "memory");
  }
}

#define ZERO_ACC(acc) _Pragma("unroll") for (int _i = 0; _i < 4; _i++) _Pragma("unroll") for (int _j = 0; _j < 4; _j++) acc[_i][_j] = (f32x4){0.f, 0.f, 0.f, 0.f};

__device__ __forceinline__ void row_sumsq_add(f32x4 (&sq)[4][4], float* rss, int row0, int l15, int g) {
#pragma unroll
  for (int mi = 0; mi < 4; mi++) {
    float v = 0.f;
#pragma unroll
    for (int ni = 0; ni < 4; ni++) v += (sq[mi][ni][0] + sq[mi][ni][1]) + (sq[mi][ni][2] + sq[mi][ni][3]);
    v += __shfl_xor(v, 16);
    v += __shfl_xor(v, 32);
    if (g == 0) atomicAdd(&rss[row0 + mi * 16 + l15], v);
  }
}

__device__ void phase_inproj(const P& p, unsigned char* smem) {
  GemmSmem& s = *(GemmSmem*)smem;
  const int lane = threadIdx.x & 63, wave = threadIdx.x >> 6, wr = wave >> 1, wc = wave & 1, l15 = lane & 15, g = lane >> 4;
  const int ntiles = 128 * 29;
  for (int tl = blockIdx.x; tl < ntiles; tl += gridDim.x) {
    const int mt = tl & 127, nt = tl >> 7;
    const int m0 = mt * 128, n0 = nt * 128;
    f32x4 acc[4][4];
    ZERO_ACC(acc);
    if (nt >= 24 && nt < 28) {
      gemm_tile<false>(p.actA, DM, p.wt_in, DM, DM, m0, n0, s, acc);
#pragma unroll
      for (int mi = 0; mi < 4; mi++)
#pragma unroll
        for (int ni = 0; ni < 4; ni++) {
          const int rowb = m0 + wr * 64 + mi * 16 + g * 4;
          const int col = n0 + wc * 64 + ni * 16 + l15;
          const int cc = col - 3072, hh = cc >> 6, d = cc & 63;
          const int b = rowb >> 11, sq = rowb & 2047;
          uint2 o; o.x = pack2(acc[mi][ni][0], acc[mi][ni][1]); o.y = pack2(acc[mi][ni][2], acc[mi][ni][3]);
          *(uint2*)&p.vt[((size_t)((b * 8 + hh) * 64 + d)) * SEQ + sq] = o;
        }
    } else {
      gemm_tile<true>(p.actA, DM, p.wt_in, DM, DM, m0, n0, s, acc);
#pragma unroll
      for (int mi = 0; mi < 4; mi++)
#pragma unroll
        for (int ni = 0; ni < 4; ni++) {
          const int row = m0 + wr * 64 + mi * 16 + l15;
          const int col = n0 + wc * 64 + ni * 16 + g * 4;
          if (nt < 24) {
            uint2 o; o.x = pack2(acc[mi][ni][0], acc[mi][ni][1]); o.y = pack2(acc[mi][ni][2], acc[mi][ni][3]);
            *(uint2*)&p.proj[(size_t)row * PROJW + col] = o;
          } else if (col < 3600) {
            *(float4*)&p.gates[(size_t)row * 16 + (col - 3584)] = make_float4(acc[mi][ni][0], acc[mi][ni][1], acc[mi][ni][2], acc[mi][ni][3]);
          }
        }
    }
  }
}

__device__ void phase_outproj(const P& p, unsigned char* smem) {
  GemmSmem& s = *(GemmSmem*)smem;
  const int lane = threadIdx.x & 63, wave = threadIdx.x >> 6, wr = wave >> 1, wc = wave & 1, l15 = lane & 15, g = lane >> 4;
  for (int tl = blockIdx.x; tl < 128 * 8; tl += gridDim.x) {
    const int mt = tl & 127, nt = tl >> 7;
    const int m0 = mt * 128, n0 = nt * 128;
    f32x4 acc[4][4];
    ZERO_ACC(acc);
    gemm_tile<true>(p.actA, DM, p.wt_out, DM, DM, m0, n0, s, acc);
#pragma unroll
    for (int mi = 0; mi < 4; mi++)
#pragma unroll
      for (int ni = 0; ni < 4; ni++) {
        const size_t idx = (size_t)(m0 + wr * 64 + mi * 16 + l15) * DM + n0 + wc * 64 + ni * 16 + g * 4;
        const float4 xv = *(const float4*)&p.x[idx];
        const float h0 = xv.x + acc[mi][ni][0], h1 = xv.y + acc[mi][ni][1], h2 = xv.z + acc[mi][ni][2], h3 = xv.w + acc[mi][ni][3];
        *(float4*)&p.h[idx] = make_float4(h0, h1, h2, h3);
        uint2 o; o.x = pack2(h0, h1); o.y = pack2(h2, h3);
        *(uint2*)&p.hb[idx] = o;
        acc[mi][ni] = (f32x4){h0 * h0, h1 * h1, h2 * h2, h3 * h3};
      }
    row_sumsq_add(acc, p.rss, m0 + wr * 64, l15, g);
  }
}

__device__ void phase_gateup(const P& p, unsigned char* smem) {
  GemmSmem& s = *(GemmSmem*)smem;
  u16* act = p.proj;
  const int lane = threadIdx.x & 63, wave = threadIdx.x >> 6, wr = wave >> 1, wc = wave & 1, l15 = lane & 15, g = lane >> 4;
  for (int tl = blockIdx.x; tl < 128 * 44; tl += gridDim.x) {
    const int mt = tl & 127, nt = tl >> 7;
    const int m0 = mt * 128, n0 = nt * 128;
    f32x4 acc[4][4];
    ZERO_ACC(acc);
    gemm_tile<true>(p.hb, DM, p.wt_gu, DM, DM, m0, n0, s, acc);
#pragma unroll
    for (int mi = 0; mi < 4; mi++) {
      const int row = m0 + wr * 64 + mi * 16 + l15;
      const float rs = rsqrtf(p.rss[row] * (1.f / DM) + EPSV);
#pragma unroll
      for (int ni = 0; ni < 2; ni++) {
        const int col = 64 * nt + 32 * wc + 16 * ni + g * 4;
        float v[4];
#pragma unroll
        for (int r = 0; r < 4; r++) v[r] = siluf(acc[mi][ni][r] * rs) * (acc[mi][ni + 2][r] * rs);
        uint2 o; o.x = pack2(v[0], v[1]); o.y = pack2(v[2], v[3]);
        *(uint2*)&act[(size_t)row * DFF + col] = o;
      }
    }
  }
}

__device__ void phase_down(const P& p, unsigned char* smem) {
  GemmSmem& s = *(GemmSmem*)smem;
  const u16* act = p.proj;
  const int lane = threadIdx.x & 63, wave = threadIdx.x >> 6, wr = wave >> 1, wc = wave & 1, l15 = lane & 15, g = lane >> 4;
  for (int tl = blockIdx.x; tl < 128 * 8; tl += gridDim.x) {
    const int mt = tl & 127, nt = tl >> 7;
    const int m0 = mt * 128, n0 = nt * 128;
    f32x4 acc[4][4];
    ZERO_ACC(acc);
    gemm_tile<true>(act, DFF, p.wt_down, DFF, DFF, m0, n0, s, acc);
#pragma unroll
    for (int mi = 0; mi < 4; mi++)
#pragma unroll
      for (int ni = 0; ni < 4; ni++) {
        const size_t idx = (size_t)(m0 + wr * 64 + mi * 16 + l15) * DM + n0 + wc * 64 + ni * 16 + g * 4;
        const float4 hv = *(const float4*)&p.h[idx];
        const float h0 = hv.x + acc[mi][ni][0], h1 = hv.y + acc[mi][ni][1], h2 = hv.z + acc[mi][ni][2], h3 = hv.w + acc[mi][ni][3];
        *(float4*)&p.h[idx] = make_float4(h0, h1, h2, h3);
        uint2 o; o.x = pack2(h0, h1); o.y = pack2(h2, h3);
        *(uint2*)&p.actA[idx] = o;
        acc[mi][ni] = (f32x4){h0 * h0, h1 * h1, h2 * h2, h3 * h3};
      }
    row_sumsq_add(acc, p.rss + NTOK, m0 + wr * 64, l15, g);
  }
}

__device__ void phase_ple(const P& p, unsigned char* smem) {
  GemmSmem& s = *(GemmSmem*)smem;
  const int lane = threadIdx.x & 63, wave = threadIdx.x >> 6, wr = wave >> 1, wc = wave & 1, l15 = lane & 15, g = lane >> 4;
  for (int tl = blockIdx.x; tl < 128 * 8; tl += gridDim.x) {
    const int mt = tl & 127, nt = tl >> 7;
    const int m0 = mt * 128, n0 = nt * 128;
    f32x4 acc[4][4], acc2[4][4];
    ZERO_ACC(acc);
    gemm_tile<true>(p.actA, DM, p.wt_pg, DM, DM, m0, n0, s, acc);
#pragma unroll
    for (int mi = 0; mi < 4; mi++) {
      const float rs = rsqrtf(p.rss[NTOK + m0 + wr * 64 + mi * 16 + l15] * (1.f / DM) + EPSV);
#pragma unroll
      for (int ni = 0; ni < 4; ni++)
#pragma unroll
        for (int r = 0; r < 4; r++) acc[mi][ni][r] = sigmoidf_(acc[mi][ni][r] * rs);
    }
    ZERO_ACC(acc2);
    gemm_tile<true>(p.pb, 256, p.wt_pp, 256, 256, m0, n0, s, acc2);
#pragma unroll
    for (int mi = 0; mi < 4; mi++)
#pragma unroll
      for (int ni = 0; ni < 4; ni++) {
        const size_t idx = (size_t)(m0 + wr * 64 + mi * 16 + l15) * DM + n0 + wc * 64 + ni * 16 + g * 4;
        const float4 hv = *(const float4*)&p.h[idx];
        const float h0 = hv.x + acc[mi][ni][0] * acc2[mi][ni][0], h1 = hv.y + acc[mi][ni][1] * acc2[mi][ni][1];
        const float h2 = hv.z + acc[mi][ni][2] * acc2[mi][ni][2], h3 = hv.w + acc[mi][ni][3] * acc2[mi][ni][3];
        *(float4*)&p.h[idx] = make_float4(h0, h1, h2, h3);
        acc2[mi][ni] = (f32x4){h0 * h0, h1 * h1, h2 * h2, h3 * h3};
      }
    row_sumsq_add(acc2, p.rss + 2 * NTOK, m0 + wr * 64, l15, g);
  }
}

#define QLD 136
#define KLD 72
struct GdnSmem {
  u16 qb[64 * QLD];
  u16 kn[64 * QLD];
  u16 vb[64 * QLD];
  float Am[64 * 64];
  float gc[64], beta[64], be[64];
};
static_assert(offsetof(GdnSmem, kn) == 17408 && offsetof(GdnSmem, vb) == 34816 && offsetof(GdnSmem, Am) == 52224, "layout");

__device__ __forceinline__ void unpack8(const uint4& v, float (&f)[8]) {
  f[0] = bf2f((u16)(v.x & 0xffffu)); f[1] = bf2f((u16)(v.x >> 16));
  f[2] = bf2f((u16)(v.y & 0xffffu)); f[3] = bf2f((u16)(v.y >> 16));
  f[4] = bf2f((u16)(v.z & 0xffffu)); f[5] = bf2f((u16)(v.z >> 16));
  f[6] = bf2f((u16)(v.w & 0xffffu)); f[7] = bf2f((u16)(v.w >> 16));
}
__device__ __forceinline__ void unpack4(const uint2& v, float (&f)[4]) {
  f[0] = bf2f((u16)(v.x & 0xffffu)); f[1] = bf2f((u16)(v.x >> 16));
  f[2] = bf2f((u16)(v.y & 0xffffu)); f[3] = bf2f((u16)(v.y >> 16));
}

__device__ void gdn_unit(const P& p, int unit, GdnSmem& s) {
  int tid = threadIdx.x;
  asm volatile("" : "+v"(tid));
  int lane = tid & 63, wave = tid >> 6;
  int l15 = lane & 15, g = lane >> 4;
#define GDN_REFRESH() do { tid = threadIdx.x; asm volatile("" : "+v"(tid) :: "memory"); lane = tid & 63; wave = tid >> 6; l15 = lane & 15; g = lane >> 4; } while (0)
  const int bh = unit >> 5, n = unit & 31;
  const int b = bh >> 2, h = bh & 3;
  const int tb = b * SEQ;
  const int s0 = n * 64;
  u16* const qk_s = s.qb;
  u16* const WU = s.kn;
  u16* const kdT = (u16*)((unsigned char*)s.kn + 32768);
  __syncthreads();
  if (wave == 0) {
    const int t = tb + s0 + lane;
    const float ga = p.gates[(size_t)t * 16 + h], gb = p.gates[(size_t)t * 16 + 4 + h];
    const float xx = ga + p.dt_bias[h];
    const float sp = (xx > 20.f) ? xx : log1pf(__expf(xx));
    float gg = -__expf(p.a_log[h]) * sp;
#pragma unroll
    for (int off = 1; off < 64; off <<= 1) {
      float nb = __shfl_up(gg, off);
      if (lane >= off) gg += nb;
    }
    const float bt = sigmoidf_(gb);
    s.gc[lane] = gg;
    s.beta[lane] = bt;
    s.be[lane] = bt * __expf(gg);
  }
  {
    const int ch = tid & 15, rg = tid >> 4;
#pragma unroll 1
    for (int mat = 0; mat < 3; mat++) {
      const int col0 = mat * 512 + h * 128 + ch * 8;
      float cw[4][8];
#pragma unroll
      for (int k = 0; k < 4; k++) {
        const float4 w0 = *(const float4*)&p.conv_w[k * 1536 + col0];
        const float4 w1 = *(const float4*)&p.conv_w[k * 1536 + col0 + 4];
        cw[k][0] = w0.x; cw[k][1] = w0.y; cw[k][2] = w0.z; cw[k][3] = w0.w;
        cw[k][4] = w1.x; cw[k][5] = w1.y; cw[k][6] = w1.z; cw[k][7] = w1.w;
      }
      uint4 xr[7];
#pragma unroll
      for (int j = 0; j < 7; j++) {
        const int sp = s0 + 4 * rg + j - 3;
        xr[j] = (sp >= 0) ? *(const uint4*)&p.proj[(size_t)(tb + sp) * PROJW + col0] : make_uint4(0u, 0u, 0u, 0u);
      }
      float xf[7][8];
#pragma unroll
      for (int j = 0; j < 7; j++) unpack8(xr[j], xf[j]);
      u16* dst = (mat == 0) ? s.qb : ((mat == 1) ? s.kn : s.vb);
#pragma unroll
      for (int r = 0; r < 4; r++) {
        float val[8];
        float ss = 0.f;
#pragma unroll
        for (int c = 0; c < 8; c++) {
          const float cv = cw[0][c] * xf[r][c] + cw[1][c] * xf[r + 1][c] + cw[2][c] * xf[r + 2][c] + cw[3][c] * xf[r + 3][c];
          val[c] = siluf(cv);
          ss += val[c] * val[c];
        }
        float rs = 1.f;
        if (mat < 2) {
#pragma unroll
          for (int off = 1; off < 16; off <<= 1) ss += __shfl_xor(ss, off);
          rs = rsqrtf(ss + EPSV) * ((mat == 0) ? 0.08838834764831845f : 1.f);
        }
        uint4 o;
        o.x = pack2(val[0] * rs, val[1] * rs); o.y = pack2(val[2] * rs, val[3] * rs);
        o.z = pack2(val[4] * rs, val[5] * rs); o.w = pack2(val[6] * rs, val[7] * rs);
        *(uint4*)&dst[(4 * rg + r) * QLD + ch * 8] = o;
      }
    }
  }
  __syncthreads();
  GDN_REFRESH();
  u16* const gQ = p.gQ + (size_t)unit * 8192;
  {
#pragma unroll
    for (int it = 0; it < 4; it++) {
      const int idx = tid + 256 * it;
      const int i = idx >> 4, d8 = (idx & 15) * 8;
      const float e = __expf(s.gc[i]);
      float f[8];
      unpack8(*(const uint4*)&s.qb[i * QLD + d8], f);
      uint4 o;
      o.x = pack2(f[0] * e, f[1] * e); o.y = pack2(f[2] * e, f[3] * e);
      o.z = pack2(f[4] * e, f[5] * e); o.w = pack2(f[6] * e, f[7] * e);
      *(uint4*)&gQ[i * 128 + d8] = o;
    }
  }
  f32x4 cqk[4];
  {
    bf16x8 aq[4], ak[4];
#pragma unroll
    for (int ks = 0; ks < 4; ks++) {
      aq[ks] = *(const bf16x8*)&s.qb[(wave * 16 + l15) * QLD + ks * 32 + g * 8];
      ak[ks] = *(const bf16x8*)&s.kn[(wave * 16 + l15) * QLD + ks * 32 + g * 8];
    }
#pragma unroll
    for (int ni = 0; ni < 4; ni++) {
      f32x4 ckk = {0.f, 0.f, 0.f, 0.f};
      cqk[ni] = (f32x4){0.f, 0.f, 0.f, 0.f};
      if (ni <= wave) {
#pragma unroll
        for (int ks = 0; ks < 4; ks++) {
          bf16x8 bk = *(const bf16x8*)&s.kn[(ni * 16 + l15) * QLD + ks * 32 + g * 8];
          ckk = mfma16(ak[ks], bk, ckk);
          cqk[ni] = mfma16(aq[ks], bk, cqk[ni]);
        }
      }
      const int j = ni * 16 + l15;
      const float gcj = s.gc[j];
#pragma unroll
      for (int r = 0; r < 4; r++) {
        const int i = wave * 16 + g * 4 + r;
        const float dec = (i >= j) ? __expf(s.gc[i] - gcj) : 0.f;
        s.Am[i * 64 + j] = (i > j) ? ckk[r] * s.beta[i] * dec : 0.f;
        cqk[ni][r] = (i >= j) ? cqk[ni][r] * dec : 0.f;
      }
    }
  }
  __syncthreads();
  GDN_REFRESH();
#pragma unroll
  for (int ni = 0; ni < 4; ni++)
#pragma unroll
    for (int r = 0; r < 4; r++) qk_s[(wave * 16 + g * 4 + r) * KLD + ni * 16 + l15] = f2bf(cqk[ni][r]);
  float xs[64];
#ifdef NO_SOLVE
  for (int i = 0; i < 64; i++) xs[i] = s.Am[i*64+tid%64];
#else
  {
    const int c = tid;
    const u16* src = (c < 128) ? &s.vb[c] : &s.kn[c - 128];
    const float* sc = (c < 128) ? s.beta : s.be;
#pragma unroll
    for (int i = 0; i < 64; i++) {
      float a0 = bf2f(src[i * QLD]) * sc[i], a1 = 0.f, a2 = 0.f, a3 = 0.f;
#pragma unroll
      for (int j4 = 0; j4 < (i + 3) / 4; j4++) {
        const float4 av = *(const float4*)&s.Am[i * 64 + j4 * 4];
        if (j4 * 4 + 0 < i) a0 -= av.x * xs[j4 * 4 + 0];
        if (j4 * 4 + 1 < i) a1 -= av.y * xs[j4 * 4 + 1];
        if (j4 * 4 + 2 < i) a2 -= av.z * xs[j4 * 4 + 2];
        if (j4 * 4 + 3 < i) a3 -= av.w * xs[j4 * 4 + 3];
      }
      xs[i] = (a0 + a1) + (a2 + a3);
      asm volatile("" : "+v"(xs[i]) :: "memory");
    }
  }
#endif
  const float glast = s.gc[63];
  __syncthreads();
  GDN_REFRESH();
  {
    const int d = tid & 127, half = tid >> 7;
#pragma unroll
    for (int q = 0; q < 4; q++) {
      unsigned ow[4];
#pragma unroll
      for (int e2 = 0; e2 < 4; e2++) {
        const int c0 = half * 32 + q * 8 + e2 * 2;
        const float v0 = bf2f(s.kn[c0 * QLD + d]) * __expf(glast - s.gc[c0]);
        const float v1 = bf2f(s.kn[(c0 + 1) * QLD + d]) * __expf(glast - s.gc[c0 + 1]);
        ow[e2] = pack2(v0, v1);
      }
      *(uint4*)&kdT[d * KLD + half * 32 + q * 8] = make_uint4(ow[0], ow[1], ow[2], ow[3]);
    }
    if (tid == 0) p.gdl[unit] = __expf(glast);
  }
  __syncthreads();
  GDN_REFRESH();
  if (tid >= 128) {
#pragma unroll
    for (int q = 0; q < 8; q++)
      *(uint4*)&WU[(tid - 128) * KLD + q * 8] = make_uint4(pack2(xs[q * 8], xs[q * 8 + 1]), pack2(xs[q * 8 + 2], xs[q * 8 + 3]),
                                                            pack2(xs[q * 8 + 4], xs[q * 8 + 5]), pack2(xs[q * 8 + 6], xs[q * 8 + 7]));
  }
  __syncthreads();
  GDN_REFRESH();
  {
    u16* const gM = p.gM + (size_t)unit * 16384;
    bf16x8 aw[2][2];
#pragma unroll
    for (int mm = 0; mm < 2; mm++)
#pragma unroll
      for (int ks = 0; ks < 2; ks++) aw[mm][ks] = *(const bf16x8*)&WU[((2 * wave + mm) * 16 + l15) * KLD + ks * 32 + g * 8];
#pragma unroll
    for (int nn = 0; nn < 8; nn++) {
      const bf16x8 b0 = *(const bf16x8*)&kdT[(nn * 16 + l15) * KLD + g * 8];
      const bf16x8 b1 = *(const bf16x8*)&kdT[(nn * 16 + l15) * KLD + 32 + g * 8];
#pragma unroll
      for (int mm = 0; mm < 2; mm++) {
        f32x4 acc = {0.f, 0.f, 0.f, 0.f};
        acc = mfma16(aw[mm][0], b0, acc);
        acc = mfma16(aw[mm][1], b1, acc);
        uint2 o; o.x = pack2(-acc[0], -acc[1]); o.y = pack2(-acc[2], -acc[3]);
        *(uint2*)&gM[(nn * 16 + l15) * 128 + (2 * wave + mm) * 16 + 4 * g] = o;
      }
    }
#pragma unroll
    for (int nn = 0; nn < 4; nn++) {
      const bf16x8 b0 = *(const bf16x8*)&qk_s[(nn * 16 + l15) * KLD + g * 8];
      const bf16x8 b1 = *(const bf16x8*)&qk_s[(nn * 16 + l15) * KLD + 32 + g * 8];
#pragma unroll
      for (int mm = 0; mm < 2; mm++) {
        f32x4 acc = {0.f, 0.f, 0.f, 0.f};
        acc = mfma16(aw[mm][0], b0, acc);
        acc = mfma16(aw[mm][1], b1, acc);
        u16* qp = &gQ[(nn * 16 + l15) * 128 + (2 * wave + mm) * 16 + 4 * g];
        float qv[4];
        unpack4(*(const uint2*)qp, qv);
        uint2 o; o.x = pack2(qv[0] - acc[0], qv[1] - acc[1]); o.y = pack2(qv[2] - acc[2], qv[3] - acc[3]);
        *(uint2*)qp = o;
      }
    }
  }
  __syncthreads();
  GDN_REFRESH();
  if (tid < 128) {
#pragma unroll
    for (int q = 0; q < 8; q++)
      *(uint4*)&WU[tid * KLD + q * 8] = make_uint4(pack2(xs[q * 8], xs[q * 8 + 1]), pack2(xs[q * 8 + 2], xs[q * 8 + 3]),
                                                    pack2(xs[q * 8 + 4], xs[q * 8 + 5]), pack2(xs[q * 8 + 6], xs[q * 8 + 7]));
  }
  __syncthreads();
  GDN_REFRESH();
  {
    u16* const gC = p.gC + (size_t)unit * 16384;
    u16* const gO = p.gO + (size_t)unit * 8192;
    bf16x8 akd[2][2], aqk[2];
#pragma unroll
    for (int mm = 0; mm < 2; mm++)
#pragma unroll
      for (int ks = 0; ks < 2; ks++) akd[mm][ks] = *(const bf16x8*)&kdT[((2 * wave + mm) * 16 + l15) * KLD + ks * 32 + g * 8];
#pragma unroll
    for (int ks = 0; ks < 2; ks++) aqk[ks] = *(const bf16x8*)&qk_s[(wave * 16 + l15) * KLD + ks * 32 + g * 8];
#pragma unroll
    for (int nn = 0; nn < 8; nn++) {
      const bf16x8 b0 = *(const bf16x8*)&WU[(nn * 16 + l15) * KLD + g * 8];
      const bf16x8 b1 = *(const bf16x8*)&WU[(nn * 16 + l15) * KLD + 32 + g * 8];
#pragma unroll
      for (int mm = 0; mm < 2; mm++) {
        f32x4 acc = {0.f, 0.f, 0.f, 0.f};
        acc = mfma16(akd[mm][0], b0, acc);
        acc = mfma16(akd[mm][1], b1, acc);
        uint2 o; o.x = pack2(acc[0], acc[1]); o.y = pack2(acc[2], acc[3]);
        *(uint2*)&gC[(nn * 16 + l15) * 128 + (2 * wave + mm) * 16 + 4 * g] = o;
      }
      {
        f32x4 acc = {0.f, 0.f, 0.f, 0.f};
        acc = mfma16(aqk[0], b0, acc);
        acc = mfma16(aqk[1], b1, acc);
        uint2 o; o.x = pack2(acc[0], acc[1]); o.y = pack2(acc[2], acc[3]);
        *(uint2*)&gO[(nn * 16 + l15) * 64 + wave * 16 + 4 * g] = o;
      }
    }
  }
}

__device__ void fox_cumsum_unit(const P& p, int bhf, float* red) {
  const int tid = threadIdx.x, lane = tid & 63, wave = tid >> 6;
  const int b = bhf >> 3, hf = bhf & 7;
  const float bias = p.fox_f_bias[hf];
  float v[8];
  float run = 0.f;
#pragma unroll
  for (int i = 0; i < 8; i++) {
    const int t = b * SEQ + tid * 8 + i;
    const float xx = p.gates[(size_t)t * 16 + 8 + hf] + bias;
    const float ls = fminf(xx, 0.f) - log1pf(__expf(-fabsf(xx)));
    run += ls;
    v[i] = run;
  }
  float tot = run;
#pragma unroll
  for (int off = 1; off < 64; off <<= 1) {
    float nb = __shfl_up(tot, off);
    if (lane >= off) tot += nb;
  }
  __syncthreads();
  if (lane == 63) red[wave] = tot;
  __syncthreads();
  float base = tot - run;
  for (int w = 0; w < wave; w++) base += red[w];
#pragma unroll
  for (int i = 0; i < 8; i++) p.cf[(size_t)bhf * SEQ + tid * 8 + i] = v[i] + base;
}

__device__ void phase_gdnprep(const P& p, unsigned char* smem) {
  GdnSmem& s = *(GdnSmem*)smem;
  for (int u = blockIdx.x; u < 1024 + 64; u += gridDim.x) {
    if (u < 1024) gdn_unit(p, u, s);
    else { __syncthreads(); fox_cumsum_unit(p, u - 1024, (float*)smem); }
  }
}

#define SLD 136
#define NSCAN 128
struct ScanSmem { u16 st[2][32 * SLD]; };
struct ScanSet { bf16x8 mf[2][4]; uint2 ci[2][2]; float dl; };

__device__ __forceinline__ void scan_load(const P& p, int unit, int eq, int w, int l15, int g, ScanSet& z) {
  int la = (32 * w + l15) * 128 + 8 * g, lc = (32 * eq + l15) * 128 + 32 * w + 4 * g;
  asm volatile("" : "+v"(la), "+v"(lc));
  const u16* gM = p.gM + (size_t)unit * 16384;
  const u16* gC = p.gC + (size_t)unit * 16384;
#pragma unroll
  for (int md = 0; md < 2; md++)
#pragma unroll
    for (int ks = 0; ks < 4; ks++) z.mf[md][ks] = *(const bf16x8*)&gM[la + md * 16 * 128 + ks * 32];
#pragma unroll
  for (int md = 0; md < 2; md++)
#pragma unroll
    for (int ne = 0; ne < 2; ne++) z.ci[md][ne] = *(const uint2*)&gC[lc + ne * 16 * 128 + md * 16];
  z.dl = p.gdl[unit];
}

__device__ __forceinline__ void scan_step(const P& p, int unit, int n, int eq, int w, int l15, int g, ScanSmem& s,
                                          f32x4 (&st)[2][2], const ScanSet& z) {
  const u16* Sb = s.st[n & 1];
  u16* Sn = s.st[(n & 1) ^ 1];
#pragma unroll
  for (int md = 0; md < 2; md++)
#pragma unroll
    for (int ne = 0; ne < 2; ne++) {
      float c[4];
      unpack4(z.ci[md][ne], c);
      st[md][ne][0] = st[md][ne][0] * z.dl + c[0];
      st[md][ne][1] = st[md][ne][1] * z.dl + c[1];
      st[md][ne][2] = st[md][ne][2] * z.dl + c[2];
      st[md][ne][3] = st[md][ne][3] * z.dl + c[3];
    }
  if (n > 0) {
    int lb = l15 * SLD + 8 * g;
    asm volatile("" : "+v"(lb));
#pragma unroll
    for (int ne = 0; ne < 2; ne++) {
#pragma unroll
      for (int ks = 0; ks < 4; ks++) {
        const bf16x8 bs = *(const bf16x8*)&Sb[lb + 16 * ne * SLD + ks * 32];
        st[0][ne] = mfma16(z.mf[0][ks], bs, st[0][ne]);
        st[1][ne] = mfma16(z.mf[1][ks], bs, st[1][ne]);
      }
    }
  }
  if (n + 1 < 32) {
    u16* gS = p.gS + (size_t)(unit + 1) * 16384;
    int lsl = l15 * SLD + 32 * w + 4 * g, lsg = (32 * eq + l15) * 128 + 32 * w + 4 * g;
    asm volatile("" : "+v"(lsl), "+v"(lsg));
#pragma unroll
    for (int md = 0; md < 2; md++)
#pragma unroll
      for (int ne = 0; ne < 2; ne++) {
        uint2 o; o.x = pack2(st[md][ne][0], st[md][ne][1]); o.y = pack2(st[md][ne][2], st[md][ne][3]);
        *(uint2*)&Sn[lsl + 16 * ne * SLD + 16 * md] = o;
        *(uint2*)&gS[lsg + 16 * ne * 128 + 16 * md] = o;
      }
  }
  asm volatile("s_waitcnt lgkmcnt(0)" ::: "memory");
  __builtin_amdgcn_s_barrier();
  asm volatile("" ::: "memory");
}

__device__ void scan_unit(const P& p, int item, ScanSmem& s) {
  int tid = threadIdx.x;
  asm volatile("" : "+v"(tid));
  const int lane = tid & 63, w = tid >> 6;
  const int l15 = lane & 15, g = lane >> 4;
  const int bh = item >> 2, eq = item & 3;
  const int u0 = bh * 32;
  f32x4 st[2][2];
#pragma unroll
  for (int md = 0; md < 2; md++)
#pragma unroll
    for (int ne = 0; ne < 2; ne++) st[md][ne] = (f32x4){0.f, 0.f, 0.f, 0.f};
  ScanSet z0, z1, z2, z3;
  scan_load(p, u0 + 0, eq, w, l15, g, z0);
  scan_load(p, u0 + 1, eq, w, l15, g, z1);
  scan_load(p, u0 + 2, eq, w, l15, g, z2);
#pragma unroll 1
  for (int n = 0; n < 32; n += 4) {
    scan_load(p, u0 + n + 3, eq, w, l15, g, z3);
    scan_step(p, u0 + n, n, eq, w, l15, g, s, st, z0);
    if (n + 4 < 32) scan_load(p, u0 + n + 4, eq, w, l15, g, z0);
    scan_step(p, u0 + n + 1, n + 1, eq, w, l15, g, s, st, z1);
    if (n + 4 < 32) scan_load(p, u0 + n + 5, eq, w, l15, g, z1);
    scan_step(p, u0 + n + 2, n + 2, eq, w, l15, g, s, st, z2);
    if (n + 4 < 32) scan_load(p, u0 + n + 6, eq, w, l15, g, z2);
    scan_step(p, u0 + n + 3, n + 3, eq, w, l15, g, s, st, z3);
  }
}

#define OLD 136
struct GoutSmem { float ssq[4][64]; u16 ob[64 * OLD]; };

__device__ void gout_unit(const P& p, int unit, GoutSmem& s) {
  const int tid = threadIdx.x, lane = tid & 63, w = tid >> 6;
  const int l15 = lane & 15, g = lane >> 4;
  const int bh = unit >> 5, n = unit & 31;
  const int b = bh >> 2, h = bh & 3;
  const u16* gQ = p.gQ + (size_t)unit * 8192;
  const u16* gO = p.gO + (size_t)unit * 8192;
  const u16* gS = p.gS + (size_t)unit * 16384;
  f32x4 o[4][2];
#pragma unroll
  for (int mc = 0; mc < 4; mc++)
#pragma unroll
    for (int ne = 0; ne < 2; ne++) {
      float c[4];
      unpack4(*(const uint2*)&gO[(32 * w + 16 * ne + l15) * 64 + 16 * mc + 4 * g], c);
      o[mc][ne] = (f32x4){c[0], c[1], c[2], c[3]};
    }
  if (n > 0) {
    bf16x8 bs[2][4];
#pragma unroll
    for (int ne = 0; ne < 2; ne++)
#pragma unroll
      for (int ks = 0; ks < 4; ks++) bs[ne][ks] = *(const bf16x8*)&gS[(32 * w + 16 * ne + l15) * 128 + ks * 32 + 8 * g];
#pragma unroll
    for (int mc = 0; mc < 4; mc++) {
#pragma unroll
      for (int ks = 0; ks < 4; ks++) {
        const bf16x8 aq = *(const bf16x8*)&gQ[(16 * mc + l15) * 128 + ks * 32 + 8 * g];
        o[mc][0] = mfma16(aq, bs[0][ks], o[mc][0]);
        o[mc][1] = mfma16(aq, bs[1][ks], o[mc][1]);
      }
    }
  }
  const float gnw0 = p.gdn_norm_w[32 * w + l15], gnw1 = p.gdn_norm_w[32 * w + 16 + l15];
  __syncthreads();
#pragma unroll
  for (int mc = 0; mc < 4; mc++)
#pragma unroll
    for (int r = 0; r < 4; r++) {
      float sq = o[mc][0][r] * o[mc][0][r] + o[mc][1][r] * o[mc][1][r];
#pragma unroll
      for (int off = 1; off < 16; off <<= 1) sq += __shfl_xor(sq, off);
      if (l15 == 0) s.ssq[w][16 * mc + 4 * g + r] = sq;
    }
  __syncthreads();
#pragma unroll
  for (int mc = 0; mc < 4; mc++)
#pragma unroll
    for (int r = 0; r < 4; r++) {
      const int c = 16 * mc + 4 * g + r;
      const float tot = s.ssq[0][c] + s.ssq[1][c] + s.ssq[2][c] + s.ssq[3][c];
      const float rs = rsqrtf(tot * (1.f / 128.f) + EPSV);
      s.ob[c * OLD + 32 * w + l15] = f2bf(o[mc][0][r] * rs * gnw0);
      s.ob[c * OLD + 32 * w + 16 + l15] = f2bf(o[mc][1][r] * rs * gnw1);
    }
  __syncthreads();
  {
    const int t0 = b * SEQ + n * 64;
    const int c0 = tid >> 4, ch = tid & 15;
    const u16* zp = p.proj + (size_t)(t0 + c0) * PROJW + 1536 + h * 128 + ch * 8;
    u16* op = p.actA + (size_t)(t0 + c0) * DM + h * 128 + ch * 8;
#pragma unroll
    for (int i = 0; i < 4; i++) {
      float ov[8], zv[8];
      unpack8(*(const uint4*)&s.ob[(c0 + 16 * i) * OLD + ch * 8], ov);
      unpack8(*(const uint4*)(zp + (size_t)i * 16 * PROJW), zv);
      uint4 r;
      r.x = pack2(ov[0] * siluf(zv[0]), ov[1] * siluf(zv[1])); r.y = pack2(ov[2] * siluf(zv[2]), ov[3] * siluf(zv[3]));
      r.z = pack2(ov[4] * siluf(zv[4]), ov[5] * siluf(zv[5])); r.w = pack2(ov[6] * siluf(zv[6]), ov[7] * siluf(zv[7]));
      *(uint4*)(op + (size_t)i * 16 * DM) = r;
    }
  }
}

__device__ void phase_gout(const P& p, unsigned char* smem) {
  GoutSmem& s = *(GoutSmem*)smem;
  for (int u = blockIdx.x; u < 1024; u += gridDim.x) gout_unit(p, u, s);
}

#define LOG2E 1.4426950408889634f
#define ALD 72
struct AttnSmem { u16 k[2][64 * ALD]; u16 v[2][64 * ALD]; float ck[2][64]; };

__device__ void attn_unit(const P& p, int item, AttnSmem& s) {
  int tid = threadIdx.x;
  asm volatile("" : "+v"(tid));
  const int lane = tid & 63, w = tid >> 6;
  const int l15 = lane & 15, g = lane >> 4;
  const int qb = 15 - (item >> 6), bhf = item & 63;
  const int b = bhf >> 3, hf = bhf & 7;
  const int q0 = qb * 128 + 32 * w;
  const u16* qbase = p.proj + (size_t)(b * SEQ) * PROJW + 2048 + hf * 64;
  const u16* kbase = p.proj + (size_t)(b * SEQ) * PROJW + 2560 + hf * 64;
  const u16* vbase = p.vt + (size_t)bhf * 64 * SEQ;
  const float* cfb = p.cf + (size_t)bhf * SEQ;
  bf16x8 qf[2][2];
#pragma unroll
  for (int mi = 0; mi < 2; mi++)
#pragma unroll
    for (int ks = 0; ks < 2; ks++) qf[mi][ks] = *(const bf16x8*)&qbase[(size_t)(q0 + 16 * mi + l15) * PROJW + ks * 32 + g * 8];
  float cq[2], m[2], lsum[2];
  f32x4 O[2][4];
#pragma unroll
  for (int mi = 0; mi < 2; mi++) {
    cq[mi] = cfb[q0 + 16 * mi + l15] * LOG2E; m[mi] = -1e30f; lsum[mi] = 0.f;
#pragma unroll
    for (int nd = 0; nd < 4; nd++) O[mi][nd] = (f32x4){0.f, 0.f, 0.f, 0.f};
  }
  const int ntile = (q0 + 32 + 63) >> 6;
  const int ntile_blk = 2 * qb + 2;
  const int srow = tid >> 3, scol = (tid & 7) * 8;
  const u16* kg = kbase + (size_t)srow * PROJW + scol;
  const u16* vg = vbase + (size_t)srow * SEQ + scol;
  uint4 rk0, rk1, rv0, rv1;
  float rck = 0.f;
  rk0 = *(const uint4*)(kg); rk1 = *(const uint4*)(kg + (size_t)32 * PROJW);
  rv0 = *(const uint4*)(vg); rv1 = *(const uint4*)(vg + (size_t)32 * SEQ);
  if (tid < 64) rck = cfb[tid] * LOG2E;
  *(uint4*)&s.k[0][srow * ALD + scol] = rk0; *(uint4*)&s.k[0][(srow + 32) * ALD + scol] = rk1;
  *(uint4*)&s.v[0][srow * ALD + scol] = rv0; *(uint4*)&s.v[0][(srow + 32) * ALD + scol] = rv1;
  if (tid < 64) s.ck[0][tid] = rck;
  __syncthreads();
#pragma unroll 1
  for (int kt = 0; kt < ntile_blk; kt++) {
    const int k0 = kt * 64, buf = kt & 1;
    if (kt + 1 < ntile_blk) {
      rk0 = *(const uint4*)(kg + (size_t)(k0 + 64) * PROJW); rk1 = *(const uint4*)(kg + (size_t)(k0 + 96) * PROJW);
      rv0 = *(const uint4*)(vg + k0 + 64); rv1 = *(const uint4*)(vg + (size_t)32 * SEQ + k0 + 64);
      if (tid < 64) rck = cfb[k0 + 64 + tid] * LOG2E;
    }
    if (kt < ntile) {
      const u16* Ks = s.k[buf];
      const u16* Vs = s.v[buf];
      f32x4 ST[2][4];
#pragma unroll
      for (int t = 0; t < 4; t++) {
        const bf16x8 kf0 = *(const bf16x8*)&Ks[(16 * t + l15) * ALD + g * 8];
        const bf16x8 kf1 = *(const bf16x8*)&Ks[(16 * t + l15) * ALD + 32 + g * 8];
#pragma unroll
        for (int mi = 0; mi < 2; mi++) {
          f32x4 acc = {0.f, 0.f, 0.f, 0.f};
          acc = mfma16(kf0, qf[mi][0], acc);
          acc = mfma16(kf1, qf[mi][1], acc);
          ST[mi][t] = acc;
        }
      }
      float4 ck[4];
#pragma unroll
      for (int t = 0; t < 4; t++) ck[t] = *(const float4*)&s.ck[buf][16 * t + 4 * g];
      const bool diag = (kt == ntile - 1);
      bf16x8 pf[2][2];
#pragma unroll
      for (int mi = 0; mi < 2; mi++) {
        const int qpos = q0 + 16 * mi + l15;
        float mx = -1e30f;
#pragma unroll
        for (int t = 0; t < 4; t++) {
          const float ckv[4] = {ck[t].x, ck[t].y, ck[t].z, ck[t].w};
#pragma unroll
          for (int r = 0; r < 4; r++) {
            float lg = ST[mi][t][r] * (0.125f * LOG2E) + (cq[mi] - ckv[r]);
            if (diag && (k0 + 16 * t + 4 * g + r > qpos)) lg = -1e30f;
            ST[mi][t][r] = lg;
            mx = fmaxf(mx, lg);
          }
        }
        mx = fmaxf(mx, __shfl_xor(mx, 16));
        mx = fmaxf(mx, __shfl_xor(mx, 32));
        const float mn = fmaxf(m[mi], mx);
        const float alpha = __builtin_amdgcn_exp2f(m[mi] - mn);
        m[mi] = mn;
        float ps = 0.f;
#pragma unroll
        for (int t = 0; t < 4; t++)
#pragma unroll
          for (int r = 0; r < 4; r++) {
            const float pe = __builtin_amdgcn_exp2f(ST[mi][t][r] - mn);
            ST[mi][t][r] = pe;
            ps += pe;
          }
        lsum[mi] = lsum[mi] * alpha + ps;
#pragma unroll
        for (int kk = 0; kk < 2; kk++) {
          uint4 pk;
          pk.x = pack2(ST[mi][2 * kk][0], ST[mi][2 * kk][1]); pk.y = pack2(ST[mi][2 * kk][2], ST[mi][2 * kk][3]);
          pk.z = pack2(ST[mi][2 * kk + 1][0], ST[mi][2 * kk + 1][1]); pk.w = pack2(ST[mi][2 * kk + 1][2], ST[mi][2 * kk + 1][3]);
          pf[mi][kk] = __builtin_bit_cast(bf16x8, pk);
        }
#pragma unroll
        for (int r = 0; r < 4; r++) {
          const float ar = __shfl(alpha, 4 * g + r);
#pragma unroll
          for (int nd = 0; nd < 4; nd++) O[mi][nd][r] *= ar;
        }
      }
#pragma unroll
      for (int nd = 0; nd < 4; nd++)
#pragma unroll
        for (int kk = 0; kk < 2; kk++) {
          const uint2 vlo = *(const uint2*)&Vs[(16 * nd + l15) * ALD + 32 * kk + 4 * g];
          const uint2 vhi = *(const uint2*)&Vs[(16 * nd + l15) * ALD + 32 * kk + 16 + 4 * g];
          const bf16x8 vf = __builtin_bit_cast(bf16x8, make_uint4(vlo.x, vlo.y, vhi.x, vhi.y));
          O[0][nd] = mfma16(pf[0][kk], vf, O[0][nd]);
          O[1][nd] = mfma16(pf[1][kk], vf, O[1][nd]);
        }
    }
    if (kt + 1 < ntile_blk) {
      const int nb = buf ^ 1;
      *(uint4*)&s.k[nb][srow * ALD + scol] = rk0; *(uint4*)&s.k[nb][(srow + 32) * ALD + scol] = rk1;
      *(uint4*)&s.v[nb][srow * ALD + scol] = rv0; *(uint4*)&s.v[nb][(srow + 32) * ALD + scol] = rv1;
      if (tid < 64) s.ck[nb][tid] = rck;
    }
    __syncthreads();
  }
#pragma unroll
  for (int mi = 0; mi < 2; mi++) {
    float l = lsum[mi];
    l += __shfl_xor(l, 16);
    l += __shfl_xor(l, 32);
    const float inv = 1.f / l;
#pragma unroll
    for (int r = 0; r < 4; r++) {
      const float ir = __shfl(inv, 4 * g + r);
      const int t = b * SEQ + q0 + 16 * mi + 4 * g + r;
#pragma unroll
      for (int nd = 0; nd < 4; nd++) p.actA[(size_t)t * DM + 512 + hf * 64 + 16 * nd + l15] = f2bf(O[mi][nd][r] * ir);
    }
  }
}

__device__ void deferred_transpose(const P& p, int it, float* tile) {
  const int n1 = 16 * 16, n2 = n1 + 16 * 88, n3 = n2 + 44 * 16, n4 = n3 + 16 * 16;
  if (it < n1) { transpose_item(p.w_out, 1024, p.wt_out, 1024, it % 16, it / 16, 1, tile); }
  else if (it < n2) { int j = it - n1; transpose_item(p.w_gate_up, 2 * DFF, p.wt_gu, 1024, j % 16, j / 16, 2, tile, p.ffn_norm_w); }
  else if (it < n3) { int j = it - n2; transpose_item(p.w_down, 1024, p.wt_down, DFF, j % 44, j / 44, 1, tile); }
  else if (it < n4) { int j = it - n3; transpose_item(p.w_ple_gate, 1024, p.wt_pg, 1024, j % 16, j / 16, 1, tile, p.ple_norm_w); }
  else { int j = it - n4; transpose_item(p.w_ple_proj, 1024, p.wt_pp, 256, j % 4, j / 4, 1, tile); }
}
#define N_DEFER (16 * 16 + 16 * 88 + 44 * 16 + 16 * 16 + 4 * 16)

__device__ void phase_mixer(const P& p, unsigned char* smem, int rr) {
  volatile int* s_item_p = (volatile int*)(smem + SMEM_MAIN + 16);
  for (;;) {
    __syncthreads();
    if (threadIdx.x == 0) *s_item_p = (int)atomicAdd(&p.counters[rr], 1u);
    __syncthreads();
    const int item = *s_item_p;
    if (item >= NSCAN + 1024 + N_DEFER) break;
    if (item < NSCAN) { scan_unit(p, item, *(ScanSmem*)smem); }
    else if (item < NSCAN + 1024) { attn_unit(p, item - NSCAN, *(AttnSmem*)smem); }
    else { deferred_transpose(p, item - NSCAN - 1024, (float*)smem); }
  }
}

#define XB_TMO      128
#define XB_XCNT(j)  (256  + 64 * (j))
#define XB_XSUB(j)  (1280 + 64 * (j))
#define XB_XGEN(j)  (2304 + 64 * (j))
#define XB_TOP      3328
#define XB_TOPGEN   3392
#define XCD_BAR_WORDS 3456
#define XB_SPIN_CAP (1u << 20)
#define LAS __attribute__((address_space(3)))
__device__ __forceinline__ unsigned xb_ld(unsigned* p) { return __hip_atomic_load(p, __ATOMIC_RELAXED, __HIP_MEMORY_SCOPE_AGENT); }
__device__ __forceinline__ unsigned xb_add(unsigned* p, unsigned v) { return __hip_atomic_fetch_add(p, v, __ATOMIC_RELAXED, __HIP_MEMORY_SCOPE_AGENT); }
__device__ __forceinline__ unsigned xb_xcc_id() { return (unsigned)__builtin_amdgcn_s_getreg((3 << 11) | 20) & 0xFu; }
#define XB_SPIN(cond, bar) do { unsigned _sp = 0; while (cond) { __builtin_amdgcn_s_sleep(1); \
    if ((++_sp & 255u) == 0u) { if (xb_ld(&(bar)[XB_TMO])) break; if (_sp > XB_SPIN_CAP) { atomicAdd(&(bar)[XB_TMO], 1u); break; } } } } while (0)
struct XcdBarrier { unsigned* bar; unsigned x; volatile LAS unsigned* st; };
__device__ __forceinline__ XcdBarrier xcd_barrier_post(unsigned* bar, volatile LAS unsigned* st) {
  XcdBarrier b; b.bar = bar; b.x = xb_xcc_id(); b.st = st;
  if (threadIdx.x == 0) (void)xb_add(&bar[XB_XCNT(b.x)], 1u);
  return b;
}
__device__ __forceinline__ void xcd_barrier_complete(unsigned* bar, unsigned x, unsigned& nloc, unsigned& nx) {
  const unsigned G = gridDim.x * gridDim.y * gridDim.z;
  unsigned sum, cnt, mine, sp = 0u;
  for (;;) {
    sum = 0u; cnt = 0u; mine = 0u;
#pragma unroll
    for (unsigned j = 0; j < 16; ++j) { const unsigned c = xb_ld(&bar[XB_XCNT(j)]); sum += c; cnt += (c > 0u) ? 1u : 0u; mine = (j == x) ? c : mine; }
    if (sum == G) break;
    __builtin_amdgcn_s_sleep(1);
    if ((++sp & 255u) == 0u) { if (xb_ld(&bar[XB_TMO])) break; if (sp > XB_SPIN_CAP) { atomicAdd(&bar[XB_TMO], 1u); break; } }
  }
  nloc = mine > 0u ? mine : 1u; nx = cnt > 0u ? cnt : 1u;
}
__device__ __forceinline__ void xcd_barrier(const XcdBarrier& b) {
  asm volatile("s_waitcnt vmcnt(0)" ::: "memory");
  __syncthreads();
  if (threadIdx.x == 0) {
    unsigned* bar = b.bar;
    __builtin_amdgcn_s_waitcnt(0);
    unsigned nloc = b.st[0], nx = b.st[1];
    if (nloc == 0u) { xcd_barrier_complete(bar, b.x, nloc, nx); b.st[0] = nloc; b.st[1] = nx; }
    const unsigned old = xb_add(&bar[XB_XSUB(b.x)], 1u);
    const unsigned gen = old / nloc;
    if (old + 1u == (gen + 1u) * nloc) {
      __builtin_amdgcn_fence(__ATOMIC_RELEASE, "agent");
      asm volatile("s_waitcnt vmcnt(0)" ::: "memory");
      const unsigned og = xb_add(&bar[XB_TOP], 1u);
      const unsigned tg = og / nx;
      if (og + 1u == (tg + 1u) * nx) xb_add(&bar[XB_TOPGEN], 1u);
      else XB_SPIN(xb_ld(&bar[XB_TOPGEN]) == tg, bar);
      __builtin_amdgcn_fence(__ATOMIC_ACQUIRE, "agent");
      xb_add(&bar[XB_XGEN(b.x)], 1u);
      asm volatile("s_waitcnt vmcnt(0)" ::: "memory");
    } else {
      XB_SPIN(xb_ld(&bar[XB_XGEN(b.x)]) == gen, bar);
      __builtin_amdgcn_fence(__ATOMIC_ACQUIRE, "agent");
      asm volatile("s_waitcnt vmcnt(0)" ::: "memory");
    }
  }
  __syncthreads();
}

__global__ void __launch_bounds__(256, 2) mega(P p, int lo, int hi) {
  __shared__ __attribute__((aligned(16))) unsigned char smem[SMEM_MAIN + 32];
  cg::grid_group grid = cg::this_grid();
  uint4* xbw = (uint4*)(smem + SMEM_MAIN);
  if (threadIdx.x == 0) *xbw = make_uint4(0u, 0u, 0u, 0u);
  __syncthreads();
  XcdBarrier xb = xcd_barrier_post(p.bar, (volatile LAS unsigned*)xbw);
  if (hi < 0) grid.sync();
#define SEAM(k) if (lo <= k && k + 1 < hi) xcd_barrier(xb);
#if !defined(ONLY) || ONLY == 0
  if (lo <= 0 && 0 < hi) phase_prep(p, smem);
#endif
  SEAM(0)
#if !defined(ONLY) || ONLY == 1
  if (lo <= 1 && 1 < hi) phase_inproj(p, smem);
#endif
  SEAM(1)
#if !defined(ONLY) || ONLY == 2
  if (lo <= 2 && 2 < hi) phase_gdnprep(p, smem);
#endif
  SEAM(2)
#if !defined(ONLY) || ONLY == 3
  if (lo <= 3 && 3 < hi) phase_mixer(p, smem, 0);
#endif
  SEAM(3)
#if !defined(ONLY) || ONLY == 4
  if (lo <= 4 && 4 < hi) phase_gout(p, smem);
#endif
  SEAM(4)
#if !defined(ONLY) || ONLY == 5
  if (lo <= 5 && 5 < hi) phase_outproj(p, smem);
#endif
  SEAM(5)
#if !defined(ONLY) || ONLY == 6
  if (lo <= 6 && 6 < hi) phase_gateup(p, smem);
#endif
  SEAM(6)
#if !defined(ONLY) || ONLY == 7
  if (lo <= 7 && 7 < hi) phase_down(p, smem);
#endif
  SEAM(7)
#if !defined(ONLY) || ONLY == 8
  if (lo <= 8 && 8 < hi) phase_ple(p, smem);
#endif
  SEAM(8)
  if (lo <= 9 && 9 < hi) phase_final(p);
}

static_assert(sizeof(GemmSmem) <= SMEM_MAIN && sizeof(GdnSmem) <= SMEM_MAIN && sizeof(ScanSmem) <= SMEM_MAIN &&
              sizeof(GoutSmem) <= SMEM_MAIN && sizeof(AttnSmem) <= SMEM_MAIN && 64 * 65 * 4 <= SMEM_MAIN, "smem");

extern "C" void kernel_launch(void* const* d_in, const int* in_sizes, int n_in, void* d_out, int out_size,
                              void* d_ws, size_t ws_size, hipStream_t stream) {
  static int grid_blocks = 0;
  if (!grid_blocks) {
    int dev = 0, cus = 0, per_cu = 0;
    hipGetDevice(&dev);
    hipDeviceGetAttribute(&cus, hipDeviceAttributeMultiprocessorCount, dev);
    hipOccupancyMaxActiveBlocksPerMultiprocessor(&per_cu, mega, 256, 0);
    if (per_cu > 2) per_cu = 2;
    if (per_cu < 1) per_cu = 1;
    grid_blocks = cus * per_cu;
  }
  P p{};
  const float* const* in = (const float* const*)d_in;
  p.x = in[0]; p.p = in[1]; p.attn_norm_w = in[2]; p.w_in = in[3]; p.conv_w = in[4]; p.a_log = in[5];
  p.dt_bias = in[6]; p.gdn_norm_w = in[7]; p.fox_f_bias = in[8]; p.w_out = in[9]; p.ffn_norm_w = in[10];
  p.w_gate_up = in[11]; p.w_down = in[12]; p.ple_norm_w = in[13]; p.w_ple_gate = in[14]; p.w_ple_proj = in[15];
  p.final_norm_w = in[16];
  p.h = (float*)d_out;
  unsigned char* ws = (unsigned char*)d_ws;
  size_t off = 0;
  auto take = [&](size_t bytes) { unsigned char* r = ws + off; off += (bytes + 255) & ~(size_t)255; return r; };
  p.counters = (unsigned*)take(256);
  p.bar = (unsigned*)take(XCD_BAR_WORDS * 4);
  p.wt_in = (u16*)take((size_t)NIN_PAD * 1024 * 2);
  p.wt_out = (u16*)take((size_t)1024 * 1024 * 2);
  p.wt_gu = (u16*)take((size_t)2 * DFF * 1024 * 2);
  p.wt_down = (u16*)take((size_t)1024 * DFF * 2);
  p.wt_pg = (u16*)take((size_t)1024 * 1024 * 2);
  p.wt_pp = (u16*)take((size_t)1024 * 256 * 2);
  p.actA = (u16*)take((size_t)NTOK * 1024 * 2);
  p.pb = (u16*)take((size_t)NTOK * 256 * 2);
  p.proj = (u16*)take((size_t)NTOK * PROJW * 2);
  p.vt = (u16*)take((size_t)64 * 64 * SEQ * 2);
  p.gates = (float*)take((size_t)NTOK * 16 * 4);
  p.cf = (float*)take((size_t)64 * SEQ * 4);
  p.gM = (u16*)take((size_t)1024 * 16384 * 2);
  p.gC = (u16*)take((size_t)1024 * 16384 * 2);
  p.gdl = (float*)take(1024 * 4);
  p.rss = (float*)take((size_t)3 * NTOK * 4);
  p.hb = p.gM;
  if (off > ws_size) fprintf(stderr, "workspace too small: need %zu have %zu\n", off, ws_size);
  u16* ob = (u16*)d_out;
  p.gS = ob;
  p.gQ = ob + (size_t)1024 * 16384;
  p.gO = ob + (size_t)1024 * 16384 + (size_t)1024 * 8192;
  hipMemsetAsync(p.bar, 0, XCD_BAR_WORDS * 4, stream);
  int lo = 0, hi = NPHASE;
  void* args[] = {&p, &lo, &hi};
  hipError_t e = hipLaunchCooperativeKernel((void*)mega, dim3(grid_blocks), dim3(256), args, 0, stream);
  if (e != hipSuccess) fprintf(stderr, "cooperative launch failed: %s (grid %d)\n", hipGetErrorString(e), grid_blocks);
}
```

```cpp
#include <hip/hip_runtime.h>
#include <hip/hip_cooperative_groups.h>
#include <cstdio>
#include <cstdint>
namespace cg = cooperative_groups;

typedef unsigned short u16;
typedef __attribute__((ext_vector_type(8))) short bf16x8;
typedef __attribute__((ext_vector_type(4))) float f32x4;

#define NTOK 16384
#define SEQ 2048
#define DM 1024
#define DFF 2816
#define PROJW 3072
#define NIN_PAD 3712
#define EPSV 1e-6f
#define NPHASE 10
#define SMEM_MAIN 73728

struct P {
  const float *x, *p, *attn_norm_w, *w_in, *conv_w, *a_log, *dt_bias, *gdn_norm_w, *fox_f_bias, *w_out,
      *ffn_norm_w, *w_gate_up, *w_down, *ple_norm_w, *w_ple_gate, *w_ple_proj, *final_norm_w;
  float* h;
  u16 *wt_in, *wt_out, *wt_gu, *wt_down, *wt_pg, *wt_pp;
  u16 *actA;
  u16 *pb;
  u16 *proj;
  u16 *vt;
  float *gates;
  float *cf;
  u16 *gM, *gC;
  u16 *gQ, *gO;
  u16 *gS;
  float *gdl;
  unsigned *counters;
  unsigned *bar;
  u16 *hb;
  float *rss;
};

typedef __attribute__((ext_vector_type(2))) float f32x2_t;
typedef __attribute__((ext_vector_type(2))) __bf16 bf16x2_t;
__device__ __forceinline__ u16 f2bf(float f) { return __builtin_bit_cast(u16, (__bf16)f); }
__device__ __forceinline__ float bf2f(u16 h) { return __uint_as_float(((unsigned)h) << 16); }
__device__ __forceinline__ unsigned pack2(float a, float b) {
  f32x2_t f = {a, b};
  return __builtin_bit_cast(unsigned, __builtin_convertvector(f, bf16x2_t));
}
__device__ __forceinline__ float siluf(float v) { return v / (1.f + __expf(-v)); }
__device__ __forceinline__ float sigmoidf_(float v) { return 1.f / (1.f + __expf(-v)); }
__device__ __forceinline__ f32x4 mfma16(bf16x8 a, bf16x8 b, f32x4 c) {
  return __builtin_amdgcn_mfma_f32_16x16x32_bf16(a, b, c, 0, 0, 0);
}
#define LDS_FENCE() asm volatile("s_waitcnt lgkmcnt(0)" ::: "memory")

__device__ __forceinline__ int colmap(int kind, int nn) {
  if (kind == 0) {
    if (nn < 2048) return nn;
    if (nn < 3584) return nn + 8;
    if (nn < 3588) return 2048 + (nn - 3584);
    if (nn < 3592) return 2052 + (nn - 3588);
    if (nn < 3600) return nn;
    return -1;
  } else if (kind == 2) {
    int i = nn >> 7, wc = (nn >> 6) & 1, u = (nn >> 5) & 1, j = nn & 31;
    return u * DFF + 64 * i + 32 * wc + j;
  }
  return nn;
}

__device__ void transpose_item(const float* __restrict__ src, int ldsrc, u16* __restrict__ dst, int K,
                               int kt, int nt, int kind, float* tile, const float* __restrict__ kscale = nullptr) {
  int tid = threadIdx.x;
  asm volatile("" : "+v"(tid));
  const int c = tid & 63, r0 = tid >> 6;
  const int ncol = colmap(kind, nt * 64 + c);
  float tv[16];
#pragma unroll
  for (int i = 0; i < 16; i++) {
    int r = r0 + 4 * i;
    tv[i] = (ncol >= 0) ? src[(size_t)(kt * 64 + r) * ldsrc + ncol] : 0.f;
  }
  if (kscale) {
#pragma unroll
    for (int i = 0; i < 16; i++) tv[i] *= kscale[kt * 64 + r0 + 4 * i];
  }
#pragma unroll
  for (int i = 0; i < 16; i++) tile[(r0 + 4 * i) * 65 + c] = tv[i];
  __syncthreads();
#pragma unroll 8
  for (int i = 0; i < 16; i++) {
    int rn = r0 + 4 * i;
    dst[(size_t)(nt * 64 + rn) * K + kt * 64 + c] = f2bf(tile[c * 65 + rn]);
  }
  __syncthreads();
}

__device__ __forceinline__ void rmsnorm_row(const float* src, const float* __restrict__ w,
                                            u16* dstb, float* dstf, int row) {
  const int lane = threadIdx.x & 63;
  float4 v[4];
  float ss = 0.f;
#pragma unroll
  for (int i = 0; i < 4; i++) {
    v[i] = *(const float4*)&src[(size_t)row * DM + i * 256 + lane * 4];
    ss += v[i].x * v[i].x + v[i].y * v[i].y + v[i].z * v[i].z + v[i].w * v[i].w;
  }
#pragma unroll
  for (int off = 32; off >= 1; off >>= 1) ss += __shfl_xor(ss, off);
  const float r = rsqrtf(ss * (1.f / DM) + EPSV);
#pragma unroll
  for (int i = 0; i < 4; i++) {
    const int col = i * 256 + lane * 4;
    float4 wv = *(const float4*)&w[col];
    float y0 = v[i].x * r * wv.x, y1 = v[i].y * r * wv.y, y2 = v[i].z * r * wv.z, y3 = v[i].w * r * wv.w;
    if (dstb) {
      uint2 o; o.x = pack2(y0, y1); o.y = pack2(y2, y3);
      *(uint2*)&dstb[(size_t)row * DM + col] = o;
    } else {
      *(float4*)&dstf[(size_t)row * DM + col] = make_float4(y0, y1, y2, y3);
    }
  }
}

__device__ void phase_prep(const P& p, unsigned char* smem) {
  float* tile = (float*)smem;
  if (blockIdx.x == 0 && threadIdx.x < 16) p.counters[threadIdx.x] = 0u;
  for (int i = blockIdx.x * 256 + threadIdx.x; i < 3 * NTOK; i += gridDim.x * 256) p.rss[i] = 0.f;
  for (int it = blockIdx.x; it < 16 * 58; it += gridDim.x) transpose_item(p.w_in, 3600, p.wt_in, 1024, it % 16, it / 16, 0, tile);
  const int wave = threadIdx.x >> 6, lane = threadIdx.x & 63;
  for (int rb = blockIdx.x; rb < NTOK / 8; rb += gridDim.x) {
    const int row = rb * 8 + wave * 2;
    float4 v0[4], v1[4];
#pragma unroll
    for (int i = 0; i < 4; i++) {
      v0[i] = *(const float4*)&p.x[(size_t)row * DM + i * 256 + lane * 4];
      v1[i] = *(const float4*)&p.x[(size_t)(row + 1) * DM + i * 256 + lane * 4];
    }
    const float4 pv0 = *(const float4*)&p.p[(size_t)row * 256 + lane * 4];
    const float4 pv1 = *(const float4*)&p.p[(size_t)(row + 1) * 256 + lane * 4];
    float s0 = 0.f, s1 = 0.f;
#pragma unroll
    for (int i = 0; i < 4; i++) {
      s0 += v0[i].x * v0[i].x + v0[i].y * v0[i].y + v0[i].z * v0[i].z + v0[i].w * v0[i].w;
      s1 += v1[i].x * v1[i].x + v1[i].y * v1[i].y + v1[i].z * v1[i].z + v1[i].w * v1[i].w;
    }
#pragma unroll
    for (int off = 32; off >= 1; off >>= 1) { s0 += __shfl_xor(s0, off); s1 += __shfl_xor(s1, off); }
    const float r0 = rsqrtf(s0 * (1.f / DM) + EPSV), r1 = rsqrtf(s1 * (1.f / DM) + EPSV);
#pragma unroll
    for (int i = 0; i < 4; i++) {
      const int col = i * 256 + lane * 4;
      const float4 wv = *(const float4*)&p.attn_norm_w[col];
      uint2 o;
      o.x = pack2(v0[i].x * r0 * wv.x, v0[i].y * r0 * wv.y); o.y = pack2(v0[i].z * r0 * wv.z, v0[i].w * r0 * wv.w);
      *(uint2*)&p.actA[(size_t)row * DM + col] = o;
      o.x = pack2(v1[i].x * r1 * wv.x, v1[i].y * r1 * wv.y); o.y = pack2(v1[i].z * r1 * wv.z, v1[i].w * r1 * wv.w);
      *(uint2*)&p.actA[(size_t)(row + 1) * DM + col] = o;
    }
    uint2 o; o.x = pack2(pv0.x, pv0.y); o.y = pack2(pv0.z, pv0.w);
    *(uint2*)&p.pb[(size_t)row * 256 + lane * 4] = o;
    o.x = pack2(pv1.x, pv1.y); o.y = pack2(pv1.z, pv1.w);
    *(uint2*)&p.pb[(size_t)(row + 1) * 256 + lane * 4] = o;
  }
}

__device__ void phase_rmsnorm(const float* src, const float* w, u16* dstb, float* dstf) {
  const int wave = threadIdx.x >> 6;
  for (int rb = blockIdx.x; rb < NTOK / 4; rb += gridDim.x) rmsnorm_row(src, w, dstb, dstf, rb * 4 + wave);
}

__device__ void phase_final(const P& p) {
  const int wave = threadIdx.x >> 6, lane = threadIdx.x & 63;
  for (int rb = blockIdx.x; rb < NTOK / 4; rb += gridDim.x) {
    const int row = rb * 4 + wave;
    const float r = rsqrtf(p.rss[2 * NTOK + row] * (1.f / DM) + EPSV);
#pragma unroll
    for (int i = 0; i < 4; i++) {
      const int col = i * 256 + lane * 4;
      float4 v = *(const float4*)&p.h[(size_t)row * DM + col];
      const float4 wv = *(const float4*)&p.final_norm_w[col];
      v.x *= r * wv.x; v.y *= r * wv.y; v.z *= r * wv.z; v.w *= r * wv.w;
      *(float4*)&p.h[(size_t)row * DM + col] = v;
    }
  }
}

#define GK 64
struct GemmSmem { u16 a[2][128 * GK]; u16 b[2][128 * GK]; };

template <bool SWAP>
__device__ __forceinline__ void gemm_tile(const u16* __restrict__ A, int lda, const u16* __restrict__ Bt, int ldb,
                                          int K, int m0, int n0, GemmSmem& s, f32x4 (&acc)[4][4]) {
  int tid = threadIdx.x;
  asm volatile("" : "+v"(tid));
  const int lane = tid & 63, wave = tid >> 6;
  const int wr = wave >> 1, wc = wave & 1;
  const int l15 = lane & 15, g = lane >> 4;
  const int nk = K / GK;
  const int drow = 8 * wave + (lane >> 3);
  const int dchunk = (lane & 7) ^ ((4 * (wave & 1) + (lane >> 4)) & 7);
  const u16* Ap = A + (size_t)(m0 + drow) * lda + dchunk * 8;
  const u16* Bp = Bt + (size_t)(n0 + drow) * ldb + dchunk * 8;
  const size_t sa = (size_t)32 * lda, sb = (size_t)32 * ldb;
#define G_DMA(bufi, koff) do { \
    _Pragma("unroll") for (int _i = 0; _i < 4; _i++) { \
      __builtin_amdgcn_global_load_lds((const unsigned*)(Ap + _i * sa + (koff)), (unsigned*)&s.a[bufi][(32 * _i + 8 * wave) * GK], 16, 0, 0); \
      __builtin_amdgcn_global_load_lds((const unsigned*)(Bp + _i * sb + (koff)), (unsigned*)&s.b[bufi][(32 * _i + 8 * wave) * GK], 16, 0, 0); \
    } } while (0)
  const int fo0 = l15 * GK + ((g ^ (l15 >> 1)) * 8);
  const int fo1 = l15 * GK + (((4 + g) ^ (l15 >> 1)) * 8);
  G_DMA(0, 0);
  asm volatile("s_waitcnt vmcnt(0)" ::: "memory");
  __builtin_amdgcn_s_barrier();
  asm volatile("" ::: "memory");
  for (int kt = 0; kt < nk; kt++) {
    const int buf = kt & 1;
    if (kt + 1 < nk) { if (buf) G_DMA(0, (kt + 1) * GK); else G_DMA(1, (kt + 1) * GK); }
    const u16* sa_ = &s.a[buf][(wr * 64) * GK];
    const u16* sb_ = &s.b[buf][(wc * 64) * GK];
#pragma unroll
    for (int ks = 0; ks < 2; ks++) {
      const int fo = ks ? fo1 : fo0;
      bf16x8 af[4], bfr[4];
#pragma unroll
      for (int mi = 0; mi < 4; mi++) af[mi] = *(const bf16x8*)&sa_[mi * 16 * GK + fo];
#pragma unroll
      for (int ni = 0; ni < 4; ni++) bfr[ni] = *(const bf16x8*)&sb_[ni * 16 * GK + fo];
#pragma unroll
      for (int mi = 0; mi < 4; mi++)
#pragma unroll
        for (int ni = 0; ni < 4; ni++) acc[mi][ni] = SWAP ? mfma16(bfr[ni], af[mi], acc[mi][ni]) : mfma16(af[mi], bfr[ni], acc[mi][ni]);
    }
    asm volatile("s_waitcnt vmcnt(0) lgkmcnt(0)" ::: "memory");
    __builtin_amdgcn_s_barrier();
    asm volatile("" ::: "memory");
  }
}


#define G2K 32
struct Gemm2Smem { u16 a[3][256 * G2K]; u16 b[3][128 * G2K]; };

template <bool SWAP>
__device__ __forceinline__ void gemm256(const u16* __restrict__ A, int lda, const u16* __restrict__ Bt, int ldb,
                                        int K, int m0, int n0, Gemm2Smem& s, f32x4 (&acc)[8][4]) {
  int tid = threadIdx.x;
  asm volatile("" : "+v"(tid));
  const int lane = tid & 63, wave = tid >> 6;
  const int wr = wave >> 1, wc = wave & 1;
  const int l15 = lane & 15, g = lane >> 4;
  const int nk = K / G2K;
  const int drow = 16 * wave + (lane >> 2);
  const int dchunk = (lane & 3) ^ g;
  const u16* Ap = A + (size_t)(m0 + drow) * lda + dchunk * 8;
  const u16* Bp = Bt + (size_t)(n0 + drow) * ldb + dchunk * 8;
  const size_t sa = (size_t)64 * lda, sb = (size_t)64 * ldb;
#define G2_DMA(st, koff) do { \
    _Pragma("unroll") for (int _i = 0; _i < 4; _i++) \
      __builtin_amdgcn_global_load_lds((const unsigned*)(Ap + _i * sa + (koff)), (unsigned*)&s.a[st][(64 * _i + 16 * wave) * G2K], 16, 0, 0); \
    _Pragma("unroll") for (int _i = 0; _i < 2; _i++) \
      __builtin_amdgcn_global_load_lds((const unsigned*)(Bp + _i * sb + (koff)), (unsigned*)&s.b[st][(64 * _i + 16 * wave) * G2K], 16, 0, 0); \
  } while (0)
  const int fo = l15 * G2K + ((g ^ ((l15 >> 2) & 3)) * 8);
  asm volatile("s_waitcnt lgkmcnt(0)" ::: "memory");
  __builtin_amdgcn_s_barrier();
  asm volatile("" ::: "memory");
  G2_DMA(0, 0);
  if (nk > 1) G2_DMA(1, G2K);
  int st = 0;
  for (int kt = 0; kt < nk; kt++) {
    if (kt + 1 < nk) asm volatile("s_waitcnt vmcnt(6)" ::: "memory");
    else asm volatile("s_waitcnt vmcnt(0)" ::: "memory");
    __builtin_amdgcn_s_barrier();
    asm volatile("" ::: "memory");
    if (kt + 2 < nk) {
      const int st2 = (st >= 1) ? st - 1 : 2;
      if (st2 == 0) G2_DMA(0, (kt + 2) * G2K); else if (st2 == 1) G2_DMA(1, (kt + 2) * G2K); else G2_DMA(2, (kt + 2) * G2K);
    }
    const u16* sa_ = &s.a[0][0] + st * (256 * G2K) + (wr * 128) * G2K + fo;
    const u16* sb_ = &s.b[0][0] + st * (128 * G2K) + (wc * 64) * G2K + fo;
    bf16x8 af[8], bfr[4];
#pragma unroll
    for (int mi = 0; mi < 8; mi++) af[mi] = *(const bf16x8*)&sa_[mi * 16 * G2K];
#pragma unroll
    for (int ni = 0; ni < 4; ni++) bfr[ni] = *(const bf16x8*)&sb_[ni * 16 * G2K];
#pragma unroll
    for (int mi = 0; mi < 8; mi++)
#pragma unroll
      for (int ni = 0; ni < 4; ni++) acc[mi][ni] = SWAP ? mfma16(bfr[ni], af[mi], acc[mi][ni]) : mfma16(af[mi], bfr[ni], acc[mi][ni]);
    st = (st == 2) ? 0 : st + 1;
  }
}
#define ZERO_ACC8(acc) _Pragma("unroll") for (int _i = 0; _i < 8; _i++) _Pragma("unroll") for (int _j = 0; _j < 4; _j++) acc[_i][_j] = (f32x4){0.f, 0.f, 0.f, 0.f};

#define ZERO_ACC(acc) _Pragma("unroll") for (int _i = 0; _i < 4; _i++) _Pragma("unroll") for (int _j = 0; _j < 4; _j++) acc[_i][_j] = (f32x4){0.f, 0.f, 0.f, 0.f};

template <int NMI>
__device__ __forceinline__ void row_sumsq_add(f32x4 (&sq)[NMI][4], float* rss, int row0, int l15, int g) {
#pragma unroll
  for (int mi = 0; mi < NMI; mi++) {
    float v = 0.f;
#pragma unroll
    for (int ni = 0; ni < 4; ni++) v += (sq[mi][ni][0] + sq[mi][ni][1]) + (sq[mi][ni][2] + sq[mi][ni][3]);
    v += __shfl_xor(v, 16);
    v += __shfl_xor(v, 32);
    if (g == 0) atomicAdd(&rss[row0 + mi * 16 + l15], v);
  }
}

__device__ void phase_inproj(const P& p, unsigned char* smem) {
  Gemm2Smem& s = *(Gemm2Smem*)smem;
  const int lane = threadIdx.x & 63, wave = threadIdx.x >> 6, wr = wave >> 1, wc = wave & 1, l15 = lane & 15, g = lane >> 4;
  const int ntiles = 64 * 29;
  for (int tl = blockIdx.x; tl < ntiles; tl += gridDim.x) {
    const int mt = tl & 63, nt = tl >> 6;
    const int m0 = mt * 256, n0 = nt * 128;
    f32x4 acc[8][4];
    ZERO_ACC8(acc);
    if (nt >= 24 && nt < 28) {
      gemm256<false>(p.actA, DM, p.wt_in, DM, DM, m0, n0, s, acc);
#pragma unroll
      for (int mi = 0; mi < 8; mi++)
#pragma unroll
        for (int ni = 0; ni < 4; ni++) {
          const int rowb = m0 + wr * 128 + mi * 16 + g * 4;
          const int col = n0 + wc * 64 + ni * 16 + l15;
          const int cc = col - 3072, hh = cc >> 6, d = cc & 63;
          const int b = rowb >> 11, sq = rowb & 2047;
          uint2 o; o.x = pack2(acc[mi][ni][0], acc[mi][ni][1]); o.y = pack2(acc[mi][ni][2], acc[mi][ni][3]);
          *(uint2*)&p.vt[((size_t)((b * 8 + hh) * 64 + d)) * SEQ + sq] = o;
        }
    } else {
      gemm256<true>(p.actA, DM, p.wt_in, DM, DM, m0, n0, s, acc);
#pragma unroll
      for (int mi = 0; mi < 8; mi++)
#pragma unroll
        for (int ni = 0; ni < 4; ni++) {
          const int row = m0 + wr * 128 + mi * 16 + l15;
          const int col = n0 + wc * 64 + ni * 16 + g * 4;
          if (nt < 24) {
            uint2 o; o.x = pack2(acc[mi][ni][0], acc[mi][ni][1]); o.y = pack2(acc[mi][ni][2], acc[mi][ni][3]);
            *(uint2*)&p.proj[(size_t)row * PROJW + col] = o;
          } else if (col < 3600) {
            *(float4*)&p.gates[(size_t)row * 16 + (col - 3584)] = make_float4(acc[mi][ni][0], acc[mi][ni][1], acc[mi][ni][2], acc[mi][ni][3]);
          }
        }
    }
  }
}

__device__ void phase_outproj(const P& p, unsigned char* smem) {
  Gemm2Smem& s = *(Gemm2Smem*)smem;
  const int lane = threadIdx.x & 63, wave = threadIdx.x >> 6, wr = wave >> 1, wc = wave & 1, l15 = lane & 15, g = lane >> 4;
  for (int tl = blockIdx.x; tl < 64 * 8; tl += gridDim.x) {
    const int mt = tl & 63, nt = tl >> 6;
    const int m0 = mt * 256, n0 = nt * 128;
    f32x4 acc[8][4];
    ZERO_ACC8(acc);
    gemm256<true>(p.actA, DM, p.wt_out, DM, DM, m0, n0, s, acc);
#pragma unroll
    for (int mi = 0; mi < 8; mi++)
#pragma unroll
      for (int ni = 0; ni < 4; ni++) {
        const size_t idx = (size_t)(m0 + wr * 128 + mi * 16 + l15) * DM + n0 + wc * 64 + ni * 16 + g * 4;
        const float4 xv = *(const float4*)&p.x[idx];
        const float h0 = xv.x + acc[mi][ni][0], h1 = xv.y + acc[mi][ni][1], h2 = xv.z + acc[mi][ni][2], h3 = xv.w + acc[mi][ni][3];
        *(float4*)&p.h[idx] = make_float4(h0, h1, h2, h3);
        uint2 o; o.x = pack2(h0, h1); o.y = pack2(h2, h3);
        *(uint2*)&p.hb[idx] = o;
        acc[mi][ni] = (f32x4){h0 * h0, h1 * h1, h2 * h2, h3 * h3};
      }
    row_sumsq_add(acc, p.rss, m0 + wr * 128, l15, g);
  }
}

__device__ void phase_gateup(const P& p, unsigned char* smem) {
  Gemm2Smem& s = *(Gemm2Smem*)smem;
  u16* act = p.proj;
  const int lane = threadIdx.x & 63, wave = threadIdx.x >> 6, wr = wave >> 1, wc = wave & 1, l15 = lane & 15, g = lane >> 4;
  for (int tl = blockIdx.x; tl < 64 * 44; tl += gridDim.x) {
    const int mt = tl & 63, nt = tl >> 6;
    const int m0 = mt * 256, n0 = nt * 128;
    f32x4 acc[8][4];
    ZERO_ACC8(acc);
    gemm256<true>(p.hb, DM, p.wt_gu, DM, DM, m0, n0, s, acc);
#pragma unroll
    for (int mi = 0; mi < 8; mi++) {
      const int row = m0 + wr * 128 + mi * 16 + l15;
      const float rs = rsqrtf(p.rss[row] * (1.f / DM) + EPSV);
#pragma unroll
      for (int ni = 0; ni < 2; ni++) {
        const int col = 64 * nt + 32 * wc + 16 * ni + g * 4;
        float v[4];
#pragma unroll
        for (int r = 0; r < 4; r++) v[r] = siluf(acc[mi][ni][r] * rs) * (acc[mi][ni + 2][r] * rs);
        uint2 o; o.x = pack2(v[0], v[1]); o.y = pack2(v[2], v[3]);
        *(uint2*)&act[(size_t)row * DFF + col] = o;
      }
    }
  }
}

__device__ void phase_down(const P& p, unsigned char* smem) {
  Gemm2Smem& s = *(Gemm2Smem*)smem;
  const u16* act = p.proj;
  const int lane = threadIdx.x & 63, wave = threadIdx.x >> 6, wr = wave >> 1, wc = wave & 1, l15 = lane & 15, g = lane >> 4;
  for (int tl = blockIdx.x; tl < 64 * 8; tl += gridDim.x) {
    const int mt = tl & 63, nt = tl >> 6;
    const int m0 = mt * 256, n0 = nt * 128;
    f32x4 acc[8][4];
    ZERO_ACC8(acc);
    gemm256<true>(act, DFF, p.wt_down, DFF, DFF, m0, n0, s, acc);
#pragma unroll
    for (int mi = 0; mi < 8; mi++)
#pragma unroll
      for (int ni = 0; ni < 4; ni++) {
        const size_t idx = (size_t)(m0 + wr * 128 + mi * 16 + l15) * DM + n0 + wc * 64 + ni * 16 + g * 4;
        const float4 hv = *(const float4*)&p.h[idx];
        const float h0 = hv.x + acc[mi][ni][0], h1 = hv.y + acc[mi][ni][1], h2 = hv.z + acc[mi][ni][2], h3 = hv.w + acc[mi][ni][3];
        *(float4*)&p.h[idx] = make_float4(h0, h1, h2, h3);
        uint2 o; o.x = pack2(h0, h1); o.y = pack2(h2, h3);
        *(uint2*)&p.actA[idx] = o;
        acc[mi][ni] = (f32x4){h0 * h0, h1 * h1, h2 * h2, h3 * h3};
      }
    row_sumsq_add(acc, p.rss + NTOK, m0 + wr * 128, l15, g);
  }
}

__device__ void phase_ple(const P& p, unsigned char* smem) {
  GemmSmem& s = *(GemmSmem*)smem;
  const int lane = threadIdx.x & 63, wave = threadIdx.x >> 6, wr = wave >> 1, wc = wave & 1, l15 = lane & 15, g = lane >> 4;
  for (int tl = blockIdx.x; tl < 128 * 8; tl += gridDim.x) {
    const int mt = tl & 127, nt = tl >> 7;
    const int m0 = mt * 128, n0 = nt * 128;
    f32x4 acc[4][4], acc2[4][4];
    ZERO_ACC(acc);
    gemm_tile<true>(p.actA, DM, p.wt_pg, DM, DM, m0, n0, s, acc);
#pragma unroll
    for (int mi = 0; mi < 4; mi++) {
      const float rs = rsqrtf(p.rss[NTOK + m0 + wr * 64 + mi * 16 + l15] * (1.f / DM) + EPSV);
#pragma unroll
      for (int ni = 0; ni < 4; ni++)
#pragma unroll
        for (int r = 0; r < 4; r++) acc[mi][ni][r] = sigmoidf_(acc[mi][ni][r] * rs);
    }
    ZERO_ACC(acc2);
    gemm_tile<true>(p.pb, 256, p.wt_pp, 256, 256, m0, n0, s, acc2);
#pragma unroll
    for (int mi = 0; mi < 4; mi++)
#pragma unroll
      for (int ni = 0; ni < 4; ni++) {
        const size_t idx = (size_t)(m0 + wr * 64 + mi * 16 + l15) * DM + n0 + wc * 64 + ni * 16 + g * 4;
        const float4 hv = *(const float4*)&p.h[idx];
        const float h0 = hv.x + acc[mi][ni][0] * acc2[mi][ni][0], h1 = hv.y + acc[mi][ni][1] * acc2[mi][ni][1];
        const float h2 = hv.z + acc[mi][ni][2] * acc2[mi][ni][2], h3 = hv.w + acc[mi][ni][3] * acc2[mi][ni][3];
        *(float4*)&p.h[idx] = make_float4(h0, h1, h2, h3);
        acc2[mi][ni] = (f32x4){h0 * h0, h1 * h1, h2 * h2, h3 * h3};
      }
    row_sumsq_add(acc2, p.rss + 2 * NTOK, m0 + wr * 64, l15, g);
  }
}

#define QLD 136
#define KLD 72
struct GdnSmem {
  u16 qb[64 * QLD];
  u16 kn[64 * QLD];
  u16 vb[64 * QLD];
  float Am[64 * 64];
  float gc[64], beta[64], be[64];
};
static_assert(offsetof(GdnSmem, kn) == 17408 && offsetof(GdnSmem, vb) == 34816 && offsetof(GdnSmem, Am) == 52224, "layout");

__device__ __forceinline__ void unpack8(const uint4& v, float (&f)[8]) {
  f[0] = bf2f((u16)(v.x & 0xffffu)); f[1] = bf2f((u16)(v.x >> 16));
  f[2] = bf2f((u16)(v.y & 0xffffu)); f[3] = bf2f((u16)(v.y >> 16));
  f[4] = bf2f((u16)(v.z & 0xffffu)); f[5] = bf2f((u16)(v.z >> 16));
  f[6] = bf2f((u16)(v.w & 0xffffu)); f[7] = bf2f((u16)(v.w >> 16));
}
__device__ __forceinline__ void unpack4(const uint2& v, float (&f)[4]) {
  f[0] = bf2f((u16)(v.x & 0xffffu)); f[1] = bf2f((u16)(v.x >> 16));
  f[2] = bf2f((u16)(v.y & 0xffffu)); f[3] = bf2f((u16)(v.y >> 16));
}

__device__ void gdn_unit(const P& p, int unit, GdnSmem& s) {
  int tid = threadIdx.x;
  asm volatile("" : "+v"(tid));
  int lane = tid & 63, wave = tid >> 6;
  int l15 = lane & 15, g = lane >> 4;
#define GDN_REFRESH() do { tid = threadIdx.x; asm volatile("" : "+v"(tid) :: "memory"); lane = tid & 63; wave = tid >> 6; l15 = lane & 15; g = lane >> 4; } while (0)
  const int bh = unit >> 5, n = unit & 31;
  const int b = bh >> 2, h = bh & 3;
  const int tb = b * SEQ;
  const int s0 = n * 64;
  u16* const qk_s = s.qb;
  u16* const WU = s.kn;
  u16* const kdT = (u16*)((unsigned char*)s.kn + 32768);
  __syncthreads();
  if (wave == 0) {
    const int t = tb + s0 + lane;
    const float ga = p.gates[(size_t)t * 16 + h], gb = p.gates[(size_t)t * 16 + 4 + h];
    const float xx = ga + p.dt_bias[h];
    const float sp = (xx > 20.f) ? xx : log1pf(__expf(xx));
    float gg = -__expf(p.a_log[h]) * sp;
#pragma unroll
    for (int off = 1; off < 64; off <<= 1) {
      float nb = __shfl_up(gg, off);
      if (lane >= off) gg += nb;
    }
    const float bt = sigmoidf_(gb);
    s.gc[lane] = gg;
    s.beta[lane] = bt;
    s.be[lane] = bt * __expf(gg);
  }
  {
    const int ch = tid & 15, rg = tid >> 4;
#pragma unroll 1
    for (int mat = 0; mat < 3; mat++) {
      const int col0 = mat * 512 + h * 128 + ch * 8;
      float cw[4][8];
#pragma unroll
      for (int k = 0; k < 4; k++) {
        const float4 w0 = *(const float4*)&p.conv_w[k * 1536 + col0];
        const float4 w1 = *(const float4*)&p.conv_w[k * 1536 + col0 + 4];
        cw[k][0] = w0.x; cw[k][1] = w0.y; cw[k][2] = w0.z; cw[k][3] = w0.w;
        cw[k][4] = w1.x; cw[k][5] = w1.y; cw[k][6] = w1.z; cw[k][7] = w1.w;
      }
      uint4 xr[7];
#pragma unroll
      for (int j = 0; j < 7; j++) {
        const int sp = s0 + 4 * rg + j - 3;
        xr[j] = (sp >= 0) ? *(const uint4*)&p.proj[(size_t)(tb + sp) * PROJW + col0] : make_uint4(0u, 0u, 0u, 0u);
      }
      float xf[7][8];
#pragma unroll
      for (int j = 0; j < 7; j++) unpack8(xr[j], xf[j]);
      u16* dst = (mat == 0) ? s.qb : ((mat == 1) ? s.kn : s.vb);
#pragma unroll
      for (int r = 0; r < 4; r++) {
        float val[8];
        float ss = 0.f;
#pragma unroll
        for (int c = 0; c < 8; c++) {
          const float cv = cw[0][c] * xf[r][c] + cw[1][c] * xf[r + 1][c] + cw[2][c] * xf[r + 2][c] + cw[3][c] * xf[r + 3][c];
          val[c] = siluf(cv);
          ss += val[c] * val[c];
        }
        float rs = 1.f;
        if (mat < 2) {
#pragma unroll
          for (int off = 1; off < 16; off <<= 1) ss += __shfl_xor(ss, off);
          rs = rsqrtf(ss + EPSV) * ((mat == 0) ? 0.08838834764831845f : 1.f);
        }
        uint4 o;
        o.x = pack2(val[0] * rs, val[1] * rs); o.y = pack2(val[2] * rs, val[3] * rs);
        o.z = pack2(val[4] * rs, val[5] * rs); o.w = pack2(val[6] * rs, val[7] * rs);
        *(uint4*)&dst[(4 * rg + r) * QLD + ch * 8] = o;
      }
    }
  }
  __syncthreads();
  GDN_REFRESH();
  u16* const gQ = p.gQ + (size_t)unit * 8192;
  {
#pragma unroll
    for (int it = 0; it < 4; it++) {
      const int idx = tid + 256 * it;
      const int i = idx >> 4, d8 = (idx & 15) * 8;
      const float e = __expf(s.gc[i]);
      float f[8];
      unpack8(*(const uint4*)&s.qb[i * QLD + d8], f);
      uint4 o;
      o.x = pack2(f[0] * e, f[1] * e); o.y = pack2(f[2] * e, f[3] * e);
      o.z = pack2(f[4] * e, f[5] * e); o.w = pack2(f[6] * e, f[7] * e);
      *(uint4*)&gQ[i * 128 + d8] = o;
    }
  }
  f32x4 cqk[4];
  {
    bf16x8 aq[4], ak[4];
#pragma unroll
    for (int ks = 0; ks < 4; ks++) {
      aq[ks] = *(const bf16x8*)&s.qb[(wave * 16 + l15) * QLD + ks * 32 + g * 8];
      ak[ks] = *(const bf16x8*)&s.kn[(wave * 16 + l15) * QLD + ks * 32 + g * 8];
    }
#pragma unroll
    for (int ni = 0; ni < 4; ni++) {
      f32x4 ckk = {0.f, 0.f, 0.f, 0.f};
      cqk[ni] = (f32x4){0.f, 0.f, 0.f, 0.f};
      if (ni <= wave) {
#pragma unroll
        for (int ks = 0; ks < 4; ks++) {
          bf16x8 bk = *(const bf16x8*)&s.kn[(ni * 16 + l15) * QLD + ks * 32 + g * 8];
          ckk = mfma16(ak[ks], bk, ckk);
          cqk[ni] = mfma16(aq[ks], bk, cqk[ni]);
        }
      }
      const int j = ni * 16 + l15;
      const float gcj = s.gc[j];
#pragma unroll
      for (int r = 0; r < 4; r++) {
        const int i = wave * 16 + g * 4 + r;
        const float dec = (i >= j) ? __expf(s.gc[i] - gcj) : 0.f;
        s.Am[i * 64 + j] = (i > j) ? ckk[r] * s.beta[i] * dec : 0.f;
        cqk[ni][r] = (i >= j) ? cqk[ni][r] * dec : 0.f;
      }
    }
  }
  __syncthreads();
  GDN_REFRESH();
#pragma unroll
  for (int ni = 0; ni < 4; ni++)
#pragma unroll
    for (int r = 0; r < 4; r++) qk_s[(wave * 16 + g * 4 + r) * KLD + ni * 16 + l15] = f2bf(cqk[ni][r]);
  float xs[64];
#ifdef NO_SOLVE
  for (int i = 0; i < 64; i++) xs[i] = s.Am[i*64+tid%64];
#else
  {
    const int c = tid;
    const u16* src = (c < 128) ? &s.vb[c] : &s.kn[c - 128];
    const float* sc = (c < 128) ? s.beta : s.be;
#pragma unroll
    for (int i = 0; i < 64; i++) {
      float a0 = bf2f(src[i * QLD]) * sc[i], a1 = 0.f, a2 = 0.f, a3 = 0.f;
#pragma unroll
      for (int j4 = 0; j4 < (i + 3) / 4; j4++) {
        const float4 av = *(const float4*)&s.Am[i * 64 + j4 * 4];
        if (j4 * 4 + 0 < i) a0 -= av.x * xs[j4 * 4 + 0];
        if (j4 * 4 + 1 < i) a1 -= av.y * xs[j4 * 4 + 1];
        if (j4 * 4 + 2 < i) a2 -= av.z * xs[j4 * 4 + 2];
        if (j4 * 4 + 3 < i) a3 -= av.w * xs[j4 * 4 + 3];
      }
      xs[i] = (a0 + a1) + (a2 + a3);
      asm volatile("" : "+v"(xs[i]) :: "memory");
    }
  }
#endif
  const float glast = s.gc[63];
  __syncthreads();
  GDN_REFRESH();
  {
    const int d = tid & 127, half = tid >> 7;
#pragma unroll
    for (int q = 0; q < 4; q++) {
      unsigned ow[4];
#pragma unroll
      for (int e2 = 0; e2 < 4; e2++) {
        const int c0 = half * 32 + q * 8 + e2 * 2;
        const float v0 = bf2f(s.kn[c0 * QLD + d]) * __expf(glast - s.gc[c0]);
        const float v1 = bf2f(s.kn[(c0 + 1) * QLD + d]) * __expf(glast - s.gc[c0 + 1]);
        ow[e2] = pack2(v0, v1);
      }
      *(uint4*)&kdT[d * KLD + half * 32 + q * 8] = make_uint4(ow[0], ow[1], ow[2], ow[3]);
    }
    if (tid == 0) p.gdl[unit] = __expf(glast);
  }
  __syncthreads();
  GDN_REFRESH();
  if (tid >= 128) {
#pragma unroll
    for (int q = 0; q < 8; q++)
      *(uint4*)&WU[(tid - 128) * KLD + q * 8] = make_uint4(pack2(xs[q * 8], xs[q * 8 + 1]), pack2(xs[q * 8 + 2], xs[q * 8 + 3]),
                                                            pack2(xs[q * 8 + 4], xs[q * 8 + 5]), pack2(xs[q * 8 + 6], xs[q * 8 + 7]));
  }
  __syncthreads();
  GDN_REFRESH();
  {
    u16* const gM = p.gM + (size_t)unit * 16384;
    bf16x8 aw[2][2];
#pragma unroll
    for (int mm = 0; mm < 2; mm++)
#pragma unroll
      for (int ks = 0; ks < 2; ks++) aw[mm][ks] = *(const bf16x8*)&WU[((2 * wave + mm) * 16 + l15) * KLD + ks * 32 + g * 8];
#pragma unroll
    for (int nn = 0; nn < 8; nn++) {
      const bf16x8 b0 = *(const bf16x8*)&kdT[(nn * 16 + l15) * KLD + g * 8];
      const bf16x8 b1 = *(const bf16x8*)&kdT[(nn * 16 + l15) * KLD + 32 + g * 8];
#pragma unroll
      for (int mm = 0; mm < 2; mm++) {
        f32x4 acc = {0.f, 0.f, 0.f, 0.f};
        acc = mfma16(aw[mm][0], b0, acc);
        acc = mfma16(aw[mm][1], b1, acc);
        uint2 o; o.x = pack2(-acc[0], -acc[1]); o.y = pack2(-acc[2], -acc[3]);
        *(uint2*)&gM[(nn * 16 + l15) * 128 + (2 * wave + mm) * 16 + 4 * g] = o;
      }
    }
#pragma unroll
    for (int nn = 0; nn < 4; nn++) {
      const bf16x8 b0 = *(const bf16x8*)&qk_s[(nn * 16 + l15) * KLD + g * 8];
      const bf16x8 b1 = *(const bf16x8*)&qk_s[(nn * 16 + l15) * KLD + 32 + g * 8];
#pragma unroll
      for (int mm = 0; mm < 2; mm++) {
        f32x4 acc = {0.f, 0.f, 0.f, 0.f};
        acc = mfma16(aw[mm][0], b0, acc);
        acc = mfma16(aw[mm][1], b1, acc);
        u16* qp = &gQ[(nn * 16 + l15) * 128 + (2 * wave + mm) * 16 + 4 * g];
        float qv[4];
        unpack4(*(const uint2*)qp, qv);
        uint2 o; o.x = pack2(qv[0] - acc[0], qv[1] - acc[1]); o.y = pack2(qv[2] - acc[2], qv[3] - acc[3]);
        *(uint2*)qp = o;
      }
    }
  }
  __syncthreads();
  GDN_REFRESH();
  if (tid < 128) {
#pragma unroll
    for (int q = 0; q < 8; q++)
      *(uint4*)&WU[tid * KLD + q * 8] = make_uint4(pack2(xs[q * 8], xs[q * 8 + 1]), pack2(xs[q * 8 + 2], xs[q * 8 + 3]),
                                                    pack2(xs[q * 8 + 4], xs[q * 8 + 5]), pack2(xs[q * 8 + 6], xs[q * 8 + 7]));
  }
  __syncthreads();
  GDN_REFRESH();
  {
    u16* const gC = p.gC + (size_t)unit * 16384;
    u16* const gO = p.gO + (size_t)unit * 8192;
    bf16x8 akd[2][2], aqk[2];
#pragma unroll
    for (int mm = 0; mm < 2; mm++)
#pragma unroll
      for (int ks = 0; ks < 2; ks++) akd[mm][ks] = *(const bf16x8*)&kdT[((2 * wave + mm) * 16 + l15) * KLD + ks * 32 + g * 8];
#pragma unroll
    for (int ks = 0; ks < 2; ks++) aqk[ks] = *(const bf16x8*)&qk_s[(wave * 16 + l15) * KLD + ks * 32 + g * 8];
#pragma unroll
    for (int nn = 0; nn < 8; nn++) {
      const bf16x8 b0 = *(const bf16x8*)&WU[(nn * 16 + l15) * KLD + g * 8];
      const bf16x8 b1 = *(const bf16x8*)&WU[(nn * 16 + l15) * KLD + 32 + g * 8];
#pragma unroll
      for (int mm = 0; mm < 2; mm++) {
        f32x4 acc = {0.f, 0.f, 0.f, 0.f};
        acc = mfma16(akd[mm][0], b0, acc);
        acc = mfma16(akd[mm][1], b1, acc);
        uint2 o; o.x = pack2(acc[0], acc[1]); o.y = pack2(acc[2], acc[3]);
        *(uint2*)&gC[(nn * 16 + l15) * 128 + (2 * wave + mm) * 16 + 4 * g] = o;
      }
      {
        f32x4 acc = {0.f, 0.f, 0.f, 0.f};
        acc = mfma16(aqk[0], b0, acc);
        acc = mfma16(aqk[1], b1, acc);
        uint2 o; o.x = pack2(acc[0], acc[1]); o.y = pack2(acc[2], acc[3]);
        *(uint2*)&gO[(nn * 16 + l15) * 64 + wave * 16 + 4 * g] = o;
      }
    }
  }
}

__device__ void fox_cumsum_unit(const P& p, int bhf, float* red) {
  const int tid = threadIdx.x, lane = tid & 63, wave = tid >> 6;
  const int b = bhf >> 3, hf = bhf & 7;
  const float bias = p.fox_f_bias[hf];
  float v[8];
  float run = 0.f;
#pragma unroll
  for (int i = 0; i < 8; i++) {
    const int t = b * SEQ + tid * 8 + i;
    const float xx = p.gates[(size_t)t * 16 + 8 + hf] + bias;
    const float ls = fminf(xx, 0.f) - log1pf(__expf(-fabsf(xx)));
    run += ls;
    v[i] = run;
  }
  float tot = run;
#pragma unroll
  for (int off = 1; off < 64; off <<= 1) {
    float nb = __shfl_up(tot, off);
    if (lane >= off) tot += nb;
  }
  __syncthreads();
  if (lane == 63) red[wave] = tot;
  __syncthreads();
  float base = tot - run;
  for (int w = 0; w < wave; w++) base += red[w];
#pragma unroll
  for (int i = 0; i < 8; i++) p.cf[(size_t)bhf * SEQ + tid * 8 + i] = v[i] + base;
}

__device__ void phase_gdnprep(const P& p, unsigned char* smem) {
  GdnSmem& s = *(GdnSmem*)smem;
  for (int u = blockIdx.x; u < 1024 + 64; u += gridDim.x) {
    if (u < 1024) gdn_unit(p, u, s);
    else { __syncthreads(); fox_cumsum_unit(p, u - 1024, (float*)smem); }
  }
}

#define SLD 136
#define NSCAN 128
struct ScanSmem { u16 st[2][32 * SLD]; };
struct ScanSet { bf16x8 mf[2][4]; uint2 ci[2][2]; float dl; };

__device__ __forceinline__ void scan_load(const P& p, int unit, int eq, int w, int l15, int g, ScanSet& z) {
  int la = (32 * w + l15) * 128 + 8 * g, lc = (32 * eq + l15) * 128 + 32 * w + 4 * g;
  asm volatile("" : "+v"(la), "+v"(lc));
  const u16* gM = p.gM + (size_t)unit * 16384;
  const u16* gC = p.gC + (size_t)unit * 16384;
#pragma unroll
  for (int md = 0; md < 2; md++)
#pragma unroll
    for (int ks = 0; ks < 4; ks++) z.mf[md][ks] = *(const bf16x8*)&gM[la + md * 16 * 128 + ks * 32];
#pragma unroll
  for (int md = 0; md < 2; md++)
#pragma unroll
    for (int ne = 0; ne < 2; ne++) z.ci[md][ne] = *(const uint2*)&gC[lc + ne * 16 * 128 + md * 16];
  z.dl = p.gdl[unit];
}

__device__ __forceinline__ unsigned scan_touch(const P& p, int unit, int lane) {
  unsigned v = 0u;
  if (lane < 16) {
    const u16* base = (lane < 8) ? (p.gM + (size_t)unit * 16384) : (p.gC + (size_t)unit * 16384);
    v = *(const unsigned*)(base + (lane & 7) * 2048);
  }
  return v;
}

__device__ __forceinline__ void scan_step(const P& p, int unit, int n, int eq, int w, int l15, int g, ScanSmem& s,
                                          f32x4 (&st)[2][2], const ScanSet& z) {
  const u16* Sb = s.st[n & 1];
  u16* Sn = s.st[(n & 1) ^ 1];
#pragma unroll
  for (int md = 0; md < 2; md++)
#pragma unroll
    for (int ne = 0; ne < 2; ne++) {
      float c[4];
      unpack4(z.ci[md][ne], c);
      st[md][ne][0] = st[md][ne][0] * z.dl + c[0];
      st[md][ne][1] = st[md][ne][1] * z.dl + c[1];
      st[md][ne][2] = st[md][ne][2] * z.dl + c[2];
      st[md][ne][3] = st[md][ne][3] * z.dl + c[3];
    }
  if (n > 0) {
    int lb = l15 * SLD + 8 * g;
    asm volatile("" : "+v"(lb));
#pragma unroll
    for (int ne = 0; ne < 2; ne++) {
#pragma unroll
      for (int ks = 0; ks < 4; ks++) {
        const bf16x8 bs = *(const bf16x8*)&Sb[lb + 16 * ne * SLD + ks * 32];
        st[0][ne] = mfma16(z.mf[0][ks], bs, st[0][ne]);
        st[1][ne] = mfma16(z.mf[1][ks], bs, st[1][ne]);
      }
    }
  }
  if (n + 1 < 32) {
    u16* gS = p.gS + (size_t)(unit + 1) * 16384;
    int lsl = l15 * SLD + 32 * w + 4 * g, lsg = (32 * eq + l15) * 128 + 32 * w + 4 * g;
    asm volatile("" : "+v"(lsl), "+v"(lsg));
#pragma unroll
    for (int md = 0; md < 2; md++)
#pragma unroll
      for (int ne = 0; ne < 2; ne++) {
        uint2 o; o.x = pack2(st[md][ne][0], st[md][ne][1]); o.y = pack2(st[md][ne][2], st[md][ne][3]);
        *(uint2*)&Sn[lsl + 16 * ne * SLD + 16 * md] = o;
        *(uint2*)&gS[lsg + 16 * ne * 128 + 16 * md] = o;
      }
  }
  asm volatile("s_waitcnt lgkmcnt(0)" ::: "memory");
  __builtin_amdgcn_s_barrier();
  asm volatile("" ::: "memory");
}

__device__ void scan_unit(const P& p, int item, ScanSmem& s) {
  int tid = threadIdx.x;
  asm volatile("" : "+v"(tid));
  const int lane = tid & 63, w = tid >> 6;
  const int l15 = lane & 15, g = lane >> 4;
  const int bh = item >> 2, eq = item & 3;
  const int u0 = bh * 32;
  f32x4 st[2][2];
#pragma unroll
  for (int md = 0; md < 2; md++)
#pragma unroll
    for (int ne = 0; ne < 2; ne++) st[md][ne] = (f32x4){0.f, 0.f, 0.f, 0.f};
  ScanSet z0, z1, z2, z3;
  scan_load(p, u0 + 0, eq, w, l15, g, z0);
  scan_load(p, u0 + 1, eq, w, l15, g, z1);
  scan_load(p, u0 + 2, eq, w, l15, g, z2);
  unsigned tacc = 0u, tprev = 0u;
  __builtin_amdgcn_s_setprio(3);
#pragma unroll 1
  for (int n = 0; n < 32; n += 4) {
    tacc += tprev;
    tprev = 0u;
    if (n + 8 < 32) {
      tprev = scan_touch(p, u0 + n + 8, lane) + scan_touch(p, u0 + n + 9, lane) + scan_touch(p, u0 + n + 10, lane) +
              scan_touch(p, u0 + n + 11, lane);
    }
    scan_load(p, u0 + n + 3, eq, w, l15, g, z3);
    scan_step(p, u0 + n, n, eq, w, l15, g, s, st, z0);
    if (n + 4 < 32) scan_load(p, u0 + n + 4, eq, w, l15, g, z0);
    scan_step(p, u0 + n + 1, n + 1, eq, w, l15, g, s, st, z1);
    if (n + 4 < 32) scan_load(p, u0 + n + 5, eq, w, l15, g, z1);
    scan_step(p, u0 + n + 2, n + 2, eq, w, l15, g, s, st, z2);
    if (n + 4 < 32) scan_load(p, u0 + n + 6, eq, w, l15, g, z2);
    scan_step(p, u0 + n + 3, n + 3, eq, w, l15, g, s, st, z3);
  }
  __builtin_amdgcn_s_setprio(0);
  asm volatile("" :: "v"(tacc));
}

#define OLD 136
struct GoutSmem { float ssq[4][64]; u16 ob[64 * OLD]; };

__device__ void gout_unit(const P& p, int unit, GoutSmem& s) {
  const int tid = threadIdx.x, lane = tid & 63, w = tid >> 6;
  const int l15 = lane & 15, g = lane >> 4;
  const int bh = unit >> 5, n = unit & 31;
  const int b = bh >> 2, h = bh & 3;
  const u16* gQ = p.gQ + (size_t)unit * 8192;
  const u16* gO = p.gO + (size_t)unit * 8192;
  const u16* gS = p.gS + (size_t)unit * 16384;
  f32x4 o[4][2];
#pragma unroll
  for (int mc = 0; mc < 4; mc++)
#pragma unroll
    for (int ne = 0; ne < 2; ne++) {
      float c[4];
      unpack4(*(const uint2*)&gO[(32 * w + 16 * ne + l15) * 64 + 16 * mc + 4 * g], c);
      o[mc][ne] = (f32x4){c[0], c[1], c[2], c[3]};
    }
  if (n > 0) {
    bf16x8 bs[2][4];
#pragma unroll
    for (int ne = 0; ne < 2; ne++)
#pragma unroll
      for (int ks = 0; ks < 4; ks++) bs[ne][ks] = *(const bf16x8*)&gS[(32 * w + 16 * ne + l15) * 128 + ks * 32 + 8 * g];
#pragma unroll
    for (int mc = 0; mc < 4; mc++) {
#pragma unroll
      for (int ks = 0; ks < 4; ks++) {
        const bf16x8 aq = *(const bf16x8*)&gQ[(16 * mc + l15) * 128 + ks * 32 + 8 * g];
        o[mc][0] = mfma16(aq, bs[0][ks], o[mc][0]);
        o[mc][1] = mfma16(aq, bs[1][ks], o[mc][1]);
      }
    }
  }
  const float gnw0 = p.gdn_norm_w[32 * w + l15], gnw1 = p.gdn_norm_w[32 * w + 16 + l15];
  __syncthreads();
#pragma unroll
  for (int mc = 0; mc < 4; mc++)
#pragma unroll
    for (int r = 0; r < 4; r++) {
      float sq = o[mc][0][r] * o[mc][0][r] + o[mc][1][r] * o[mc][1][r];
#pragma unroll
      for (int off = 1; off < 16; off <<= 1) sq += __shfl_xor(sq, off);
      if (l15 == 0) s.ssq[w][16 * mc + 4 * g + r] = sq;
    }
  __syncthreads();
#pragma unroll
  for (int mc = 0; mc < 4; mc++)
#pragma unroll
    for (int r = 0; r < 4; r++) {
      const int c = 16 * mc + 4 * g + r;
      const float tot = s.ssq[0][c] + s.ssq[1][c] + s.ssq[2][c] + s.ssq[3][c];
      const float rs = rsqrtf(tot * (1.f / 128.f) + EPSV);
      s.ob[c * OLD + 32 * w + l15] = f2bf(o[mc][0][r] * rs * gnw0);
      s.ob[c * OLD + 32 * w + 16 + l15] = f2bf(o[mc][1][r] * rs * gnw1);
    }
  __syncthreads();
  {
    const int t0 = b * SEQ + n * 64;
    const int c0 = tid >> 4, ch = tid & 15;
    const u16* zp = p.proj + (size_t)(t0 + c0) * PROJW + 1536 + h * 128 + ch * 8;
    u16* op = p.actA + (size_t)(t0 + c0) * DM + h * 128 + ch * 8;
#pragma unroll
    for (int i = 0; i < 4; i++) {
      float ov[8], zv[8];
      unpack8(*(const uint4*)&s.ob[(c0 + 16 * i) * OLD + ch * 8], ov);
      unpack8(*(const uint4*)(zp + (size_t)i * 16 * PROJW), zv);
      uint4 r;
      r.x = pack2(ov[0] * siluf(zv[0]), ov[1] * siluf(zv[1])); r.y = pack2(ov[2] * siluf(zv[2]), ov[3] * siluf(zv[3]));
      r.z = pack2(ov[4] * siluf(zv[4]), ov[5] * siluf(zv[5])); r.w = pack2(ov[6] * siluf(zv[6]), ov[7] * siluf(zv[7]));
      *(uint4*)(op + (size_t)i * 16 * DM) = r;
    }
  }
}

__device__ void phase_gout(const P& p, unsigned char* smem) {
  GoutSmem& s = *(GoutSmem*)smem;
  for (int u = blockIdx.x; u < 1024; u += gridDim.x) gout_unit(p, u, s);
}

#define LOG2E 1.4426950408889634f
#define ALD 72
struct AttnSmem { u16 k[2][64 * ALD]; u16 v[2][64 * ALD]; float ck[2][64]; };

__device__ void attn_unit(const P& p, int item, AttnSmem& s) {
  int tid = threadIdx.x;
  asm volatile("" : "+v"(tid));
  const int lane = tid & 63, w = tid >> 6;
  const int l15 = lane & 15, g = lane >> 4;
  const int qb = 15 - (item >> 6), bhf = item & 63;
  const int b = bhf >> 3, hf = bhf & 7;
  const int q0 = qb * 128 + 32 * w;
  const u16* qbase = p.proj + (size_t)(b * SEQ) * PROJW + 2048 + hf * 64;
  const u16* kbase = p.proj + (size_t)(b * SEQ) * PROJW + 2560 + hf * 64;
  const u16* vbase = p.vt + (size_t)bhf * 64 * SEQ;
  const float* cfb = p.cf + (size_t)bhf * SEQ;
  bf16x8 qf[2][2];
#pragma unroll
  for (int mi = 0; mi < 2; mi++)
#pragma unroll
    for (int ks = 0; ks < 2; ks++) qf[mi][ks] = *(const bf16x8*)&qbase[(size_t)(q0 + 16 * mi + l15) * PROJW + ks * 32 + g * 8];
  float cq[2], m[2], lsum[2];
  f32x4 O[2][4];
#pragma unroll
  for (int mi = 0; mi < 2; mi++) {
    cq[mi] = cfb[q0 + 16 * mi + l15] * LOG2E; m[mi] = -1e30f; lsum[mi] = 0.f;
#pragma unroll
    for (int nd = 0; nd < 4; nd++) O[mi][nd] = (f32x4){0.f, 0.f, 0.f, 0.f};
  }
  const int ntile = (q0 + 32 + 63) >> 6;
  const int ntile_blk = 2 * qb + 2;
  const int srow = tid >> 3, scol = (tid & 7) * 8;
  const u16* kg = kbase + (size_t)srow * PROJW + scol;
  const u16* vg = vbase + (size_t)srow * SEQ + scol;
  uint4 rk0, rk1, rv0, rv1;
  float rck = 0.f;
  rk0 = *(const uint4*)(kg); rk1 = *(const uint4*)(kg + (size_t)32 * PROJW);
  rv0 = *(const uint4*)(vg); rv1 = *(const uint4*)(vg + (size_t)32 * SEQ);
  if (tid < 64) rck = cfb[tid] * LOG2E;
  *(uint4*)&s.k[0][srow * ALD + scol] = rk0; *(uint4*)&s.k[0][(srow + 32) * ALD + scol] = rk1;
  *(uint4*)&s.v[0][srow * ALD + scol] = rv0; *(uint4*)&s.v[0][(srow + 32) * ALD + scol] = rv1;
  if (tid < 64) s.ck[0][tid] = rck;
  __syncthreads();
#pragma unroll 1
  for (int kt = 0; kt < ntile_blk; kt++) {
    const int k0 = kt * 64, buf = kt & 1;
    if (kt + 1 < ntile_blk) {
      rk0 = *(const uint4*)(kg + (size_t)(k0 + 64) * PROJW); rk1 = *(const uint4*)(kg + (size_t)(k0 + 96) * PROJW);
      rv0 = *(const uint4*)(vg + k0 + 64); rv1 = *(const uint4*)(vg + (size_t)32 * SEQ + k0 + 64);
      if (tid < 64) rck = cfb[k0 + 64 + tid] * LOG2E;
    }
    if (kt < ntile) {
      const u16* Ks = s.k[buf];
      const u16* Vs = s.v[buf];
      f32x4 ST[2][4];
#pragma unroll
      for (int t = 0; t < 4; t++) {
        const bf16x8 kf0 = *(const bf16x8*)&Ks[(16 * t + l15) * ALD + g * 8];
        const bf16x8 kf1 = *(const bf16x8*)&Ks[(16 * t + l15) * ALD + 32 + g * 8];
#pragma unroll
        for (int mi = 0; mi < 2; mi++) {
          f32x4 acc = {0.f, 0.f, 0.f, 0.f};
          acc = mfma16(kf0, qf[mi][0], acc);
          acc = mfma16(kf1, qf[mi][1], acc);
          ST[mi][t] = acc;
        }
      }
      float4 ck[4];
#pragma unroll
      for (int t = 0; t < 4; t++) ck[t] = *(const float4*)&s.ck[buf][16 * t + 4 * g];
      const bool diag = (kt == ntile - 1);
      bf16x8 pf[2][2];
#pragma unroll
      for (int mi = 0; mi < 2; mi++) {
        const int qpos = q0 + 16 * mi + l15;
        float mx = -1e30f;
#pragma unroll
        for (int t = 0; t < 4; t++) {
          const float ckv[4] = {ck[t].x, ck[t].y, ck[t].z, ck[t].w};
#pragma unroll
          for (int r = 0; r < 4; r++) {
            float lg = ST[mi][t][r] * (0.125f * LOG2E) + (cq[mi] - ckv[r]);
            if (diag && (k0 + 16 * t + 4 * g + r > qpos)) lg = -1e30f;
            ST[mi][t][r] = lg;
            mx = fmaxf(mx, lg);
          }
        }
        mx = fmaxf(mx, __shfl_xor(mx, 16));
        mx = fmaxf(mx, __shfl_xor(mx, 32));
        const float mn = fmaxf(m[mi], mx);
        const float alpha = __builtin_amdgcn_exp2f(m[mi] - mn);
        m[mi] = mn;
        float ps = 0.f;
#pragma unroll
        for (int t = 0; t < 4; t++)
#pragma unroll
          for (int r = 0; r < 4; r++) {
            const float pe = __builtin_amdgcn_exp2f(ST[mi][t][r] - mn);
            ST[mi][t][r] = pe;
            ps += pe;
          }
        lsum[mi] = lsum[mi] * alpha + ps;
#pragma unroll
        for (int kk = 0; kk < 2; kk++) {
          uint4 pk;
          pk.x = pack2(ST[mi][2 * kk][0], ST[mi][2 * kk][1]); pk.y = pack2(ST[mi][2 * kk][2], ST[mi][2 * kk][3]);
          pk.z = pack2(ST[mi][2 * kk + 1][0], ST[mi][2 * kk + 1][1]); pk.w = pack2(ST[mi][2 * kk + 1][2], ST[mi][2 * kk + 1][3]);
          pf[mi][kk] = __builtin_bit_cast(bf16x8, pk);
        }
#pragma unroll
        for (int r = 0; r < 4; r++) {
          const float ar = __shfl(alpha, 4 * g + r);
#pragma unroll
          for (int nd = 0; nd < 4; nd++) O[mi][nd][r] *= ar;
        }
      }
#pragma unroll
      for (int nd = 0; nd < 4; nd++)
#pragma unroll
        for (int kk = 0; kk < 2; kk++) {
          const uint2 vlo = *(const uint2*)&Vs[(16 * nd + l15) * ALD + 32 * kk + 4 * g];
          const uint2 vhi = *(const uint2*)&Vs[(16 * nd + l15) * ALD + 32 * kk + 16 + 4 * g];
          const bf16x8 vf = __builtin_bit_cast(bf16x8, make_uint4(vlo.x, vlo.y, vhi.x, vhi.y));
          O[0][nd] = mfma16(pf[0][kk], vf, O[0][nd]);
          O[1][nd] = mfma16(pf[1][kk], vf, O[1][nd]);
        }
    }
    if (kt + 1 < ntile_blk) {
      const int nb = buf ^ 1;
      *(uint4*)&s.k[nb][srow * ALD + scol] = rk0; *(uint4*)&s.k[nb][(srow + 32) * ALD + scol] = rk1;
      *(uint4*)&s.v[nb][srow * ALD + scol] = rv0; *(uint4*)&s.v[nb][(srow + 32) * ALD + scol] = rv1;
      if (tid < 64) s.ck[nb][tid] = rck;
    }
    __syncthreads();
  }
#pragma unroll
  for (int mi = 0; mi < 2; mi++) {
    float l = lsum[mi];
    l += __shfl_xor(l, 16);
    l += __shfl_xor(l, 32);
    const float inv = 1.f / l;
#pragma unroll
    for (int r = 0; r < 4; r++) {
      const float ir = __shfl(inv, 4 * g + r);
      const int t = b * SEQ + q0 + 16 * mi + 4 * g + r;
#pragma unroll
      for (int nd = 0; nd < 4; nd++) p.actA[(size_t)t * DM + 512 + hf * 64 + 16 * nd + l15] = f2bf(O[mi][nd][r] * ir);
    }
  }
}

__device__ void deferred_transpose(const P& p, int it, float* tile) {
  const int n1 = 16 * 16, n2 = n1 + 16 * 88, n3 = n2 + 44 * 16, n4 = n3 + 16 * 16;
  if (it < n1) { transpose_item(p.w_out, 1024, p.wt_out, 1024, it % 16, it / 16, 1, tile); }
  else if (it < n2) { int j = it - n1; transpose_item(p.w_gate_up, 2 * DFF, p.wt_gu, 1024, j % 16, j / 16, 2, tile, p.ffn_norm_w); }
  else if (it < n3) { int j = it - n2; transpose_item(p.w_down, 1024, p.wt_down, DFF, j % 44, j / 44, 1, tile); }
  else if (it < n4) { int j = it - n3; transpose_item(p.w_ple_gate, 1024, p.wt_pg, 1024, j % 16, j / 16, 1, tile, p.ple_norm_w); }
  else { int j = it - n4; transpose_item(p.w_ple_proj, 1024, p.wt_pp, 256, j % 4, j / 4, 1, tile); }
}
#define N_DEFER (16 * 16 + 16 * 88 + 44 * 16 + 16 * 16 + 4 * 16)

__device__ void phase_mixer(const P& p, unsigned char* smem, int rr) {
  volatile int* s_item_p = (volatile int*)(smem + SMEM_MAIN + 16);
  for (;;) {
    __syncthreads();
    if (threadIdx.x == 0) *s_item_p = (int)atomicAdd(&p.counters[rr], 1u);
    __syncthreads();
    const int item = *s_item_p;
    if (item >= NSCAN + 1024 + N_DEFER) break;
    if (item < NSCAN) { scan_unit(p, item, *(ScanSmem*)smem); }
    else if (item < NSCAN + 1024) { attn_unit(p, item - NSCAN, *(AttnSmem*)smem); }
    else { deferred_transpose(p, item - NSCAN - 1024, (float*)smem); }
  }
}

#define XB_TMO      128
#define XB_XCNT(j)  (256  + 64 * (j))
#define XB_XSUB(j)  (1280 + 64 * (j))
#define XB_XGEN(j)  (2304 + 64 * (j))
#define XB_TOP      3328
#define XB_TOPGEN   3392
#define XCD_BAR_WORDS 3456
#define XB_SPIN_CAP (1u << 20)
#define LAS __attribute__((address_space(3)))
__device__ __forceinline__ unsigned xb_ld(unsigned* p) { return __hip_atomic_load(p, __ATOMIC_RELAXED, __HIP_MEMORY_SCOPE_AGENT); }
__device__ __forceinline__ unsigned xb_add(unsigned* p, unsigned v) { return __hip_atomic_fetch_add(p, v, __ATOMIC_RELAXED, __HIP_MEMORY_SCOPE_AGENT); }
__device__ __forceinline__ unsigned xb_xcc_id() { return (unsigned)__builtin_amdgcn_s_getreg((3 << 11) | 20) & 0xFu; }
#define XB_SPIN(cond, bar) do { unsigned _sp = 0; while (cond) { __builtin_amdgcn_s_sleep(1); \
    if ((++_sp & 255u) == 0u) { if (xb_ld(&(bar)[XB_TMO])) break; if (_sp > XB_SPIN_CAP) { atomicAdd(&(bar)[XB_TMO], 1u); break; } } } } while (0)
struct XcdBarrier { unsigned* bar; unsigned x; volatile LAS unsigned* st; };
__device__ __forceinline__ XcdBarrier xcd_barrier_post(unsigned* bar, volatile LAS unsigned* st) {
  XcdBarrier b; b.bar = bar; b.x = xb_xcc_id(); b.st = st;
  if (threadIdx.x == 0) (void)xb_add(&bar[XB_XCNT(b.x)], 1u);
  return b;
}
__device__ __forceinline__ void xcd_barrier_complete(unsigned* bar, unsigned x, unsigned& nloc, unsigned& nx) {
  const unsigned G = gridDim.x * gridDim.y * gridDim.z;
  unsigned sum, cnt, mine, sp = 0u;
  for (;;) {
    sum = 0u; cnt = 0u; mine = 0u;
#pragma unroll
    for (unsigned j = 0; j < 16; ++j) { const unsigned c = xb_ld(&bar[XB_XCNT(j)]); sum += c; cnt += (c > 0u) ? 1u : 0u; mine = (j == x) ? c : mine; }
    if (sum == G) break;
    __builtin_amdgcn_s_sleep(1);
    if ((++sp & 255u) == 0u) { if (xb_ld(&bar[XB_TMO])) break; if (sp > XB_SPIN_CAP) { atomicAdd(&bar[XB_TMO], 1u); break; } }
  }
  nloc = mine > 0u ? mine : 1u; nx = cnt > 0u ? cnt : 1u;
}
__device__ __forceinline__ void xcd_barrier(const XcdBarrier& b) {
  asm volatile("s_waitcnt vmcnt(0)" ::: "memory");
  __syncthreads();
  if (threadIdx.x == 0) {
    unsigned* bar = b.bar;
    __builtin_amdgcn_s_waitcnt(0);
    unsigned nloc = b.st[0], nx = b.st[1];
    if (nloc == 0u) { xcd_barrier_complete(bar, b.x, nloc, nx); b.st[0] = nloc; b.st[1] = nx; }
    const unsigned old = xb_add(&bar[XB_XSUB(b.x)], 1u);
    const unsigned gen = old / nloc;
    if (old + 1u == (gen + 1u) * nloc) {
      __builtin_amdgcn_fence(__ATOMIC_RELEASE, "agent");
      asm volatile("s_waitcnt vmcnt(0)" ::: "memory");
      const unsigned og = xb_add(&bar[XB_TOP], 1u);
      const unsigned tg = og / nx;
      if (og + 1u == (tg + 1u) * nx) xb_add(&bar[XB_TOPGEN], 1u);
      else XB_SPIN(xb_ld(&bar[XB_TOPGEN]) == tg, bar);
      __builtin_amdgcn_fence(__ATOMIC_ACQUIRE, "agent");
      xb_add(&bar[XB_XGEN(b.x)], 1u);
      asm volatile("s_waitcnt vmcnt(0)" ::: "memory");
    } else {
      XB_SPIN(xb_ld(&bar[XB_XGEN(b.x)]) == gen, bar);
      __builtin_amdgcn_fence(__ATOMIC_ACQUIRE, "agent");
      asm volatile("s_waitcnt vmcnt(0)" ::: "memory");
    }
  }
  __syncthreads();
}

__global__ void __launch_bounds__(256, 2) mega(P p, int lo, int hi) {
  __shared__ __attribute__((aligned(16))) unsigned char smem[SMEM_MAIN + 32];
  cg::grid_group grid = cg::this_grid();
  uint4* xbw = (uint4*)(smem + SMEM_MAIN);
  if (threadIdx.x == 0) *xbw = make_uint4(0u, 0u, 0u, 0u);
  __syncthreads();
  XcdBarrier xb = xcd_barrier_post(p.bar, (volatile LAS unsigned*)xbw);
  if (hi < 0) grid.sync();
#define SEAM(k) if (lo <= k && k + 1 < hi) xcd_barrier(xb);
#if !defined(ONLY) || ONLY == 0
  if (lo <= 0 && 0 < hi) phase_prep(p, smem);
#endif
  SEAM(0)
#if !defined(ONLY) || ONLY == 1
  if (lo <= 1 && 1 < hi) phase_inproj(p, smem);
#endif
  SEAM(1)
#if !defined(ONLY) || ONLY == 2
  if (lo <= 2 && 2 < hi) phase_gdnprep(p, smem);
#endif
  SEAM(2)
#if !defined(ONLY) || ONLY == 3
  if (lo <= 3 && 3 < hi) phase_mixer(p, smem, 0);
#endif
  SEAM(3)
#if !defined(ONLY) || ONLY == 4
  if (lo <= 4 && 4 < hi) phase_gout(p, smem);
#endif
  SEAM(4)
#if !defined(ONLY) || ONLY == 5
  if (lo <= 5 && 5 < hi) phase_outproj(p, smem);
#endif
  SEAM(5)
#if !defined(ONLY) || ONLY == 6
  if (lo <= 6 && 6 < hi) phase_gateup(p, smem);
#endif
  SEAM(6)
#if !defined(ONLY) || ONLY == 7
  if (lo <= 7 && 7 < hi) phase_down(p, smem);
#endif
  SEAM(7)
#if !defined(ONLY) || ONLY == 8
  if (lo <= 8 && 8 < hi) phase_ple(p, smem);
#endif
  SEAM(8)
  if (lo <= 9 && 9 < hi) phase_final(p);
}

static_assert(sizeof(GemmSmem) <= SMEM_MAIN && sizeof(Gemm2Smem) <= SMEM_MAIN && sizeof(GdnSmem) <= SMEM_MAIN && sizeof(ScanSmem) <= SMEM_MAIN &&
              sizeof(GoutSmem) <= SMEM_MAIN && sizeof(AttnSmem) <= SMEM_MAIN && 64 * 65 * 4 <= SMEM_MAIN, "smem");

extern "C" void kernel_launch(void* const* d_in, const int* in_sizes, int n_in, void* d_out, int out_size,
                              void* d_ws, size_t ws_size, hipStream_t stream) {
  static int grid_blocks = 0;
  if (!grid_blocks) {
    int dev = 0, cus = 0, per_cu = 0;
    hipGetDevice(&dev);
    hipDeviceGetAttribute(&cus, hipDeviceAttributeMultiprocessorCount, dev);
    hipOccupancyMaxActiveBlocksPerMultiprocessor(&per_cu, mega, 256, 0);
    if (per_cu > 2) per_cu = 2;
    if (per_cu < 1) per_cu = 1;
    grid_blocks = cus * per_cu;
  }
  P p{};
  const float* const* in = (const float* const*)d_in;
  p.x = in[0]; p.p = in[1]; p.attn_norm_w = in[2]; p.w_in = in[3]; p.conv_w = in[4]; p.a_log = in[5];
  p.dt_bias = in[6]; p.gdn_norm_w = in[7]; p.fox_f_bias = in[8]; p.w_out = in[9]; p.ffn_norm_w = in[10];
  p.w_gate_up = in[11]; p.w_down = in[12]; p.ple_norm_w = in[13]; p.w_ple_gate = in[14]; p.w_ple_proj = in[15];
  p.final_norm_w = in[16];
  p.h = (float*)d_out;
  unsigned char* ws = (unsigned char*)d_ws;
  size_t off = 0;
  auto take = [&](size_t bytes) { unsigned char* r = ws + off; off += (bytes + 255) & ~(size_t)255; return r; };
  p.counters = (unsigned*)take(256);
  p.bar = (unsigned*)take(XCD_BAR_WORDS * 4);
  p.wt_in = (u16*)take((size_t)NIN_PAD * 1024 * 2);
  p.wt_out = (u16*)take((size_t)1024 * 1024 * 2);
  p.wt_gu = (u16*)take((size_t)2 * DFF * 1024 * 2);
  p.wt_down = (u16*)take((size_t)1024 * DFF * 2);
  p.wt_pg = (u16*)take((size_t)1024 * 1024 * 2);
  p.wt_pp = (u16*)take((size_t)1024 * 256 * 2);
  p.actA = (u16*)take((size_t)NTOK * 1024 * 2);
  p.pb = (u16*)take((size_t)NTOK * 256 * 2);
  p.proj = (u16*)take((size_t)NTOK * PROJW * 2);
  p.vt = (u16*)take((size_t)64 * 64 * SEQ * 2);
  p.gates = (float*)take((size_t)NTOK * 16 * 4);
  p.cf = (float*)take((size_t)64 * SEQ * 4);
  p.gM = (u16*)take((size_t)1024 * 16384 * 2);
  p.gC = (u16*)take((size_t)1024 * 16384 * 2);
  p.gdl = (float*)take(1024 * 4);
  p.rss = (float*)take((size_t)3 * NTOK * 4);
  p.hb = p.gM;
  if (off > ws_size) fprintf(stderr, "workspace too small: need %zu have %zu\n", off, ws_size);
  u16* ob = (u16*)d_out;
  p.gS = ob;
  p.gQ = ob + (size_t)1024 * 16384;
  p.gO = ob + (size_t)1024 * 16384 + (size_t)1024 * 8192;
  hipMemsetAsync(p.bar, 0, XCD_BAR_WORDS * 4, stream);
  int lo = 0, hi = NPHASE;
  void* args[] = {&p, &lo, &hi};
  hipError_t e = hipLaunchCooperativeKernel((void*)mega, dim3(grid_blocks), dim3(256), args, 0, stream);
  if (e != hipSuccess) fprintf(stderr, "cooperative launch failed: %s (grid %d)\n", hipGetErrorString(e), grid_blocks);
}
```

```cpp
#include <hip/hip_runtime.h>
#include <hip/hip_cooperative_groups.h>
#include <cstdio>
#include <cstdint>
namespace cg = cooperative_groups;

typedef unsigned short u16;
typedef __attribute__((ext_vector_type(8))) short bf16x8;
typedef __attribute__((ext_vector_type(4))) float f32x4;

#define NTOK 16384
#define SEQ 2048
#define DM 1024
#define DFF 2816
#define PROJW 3072
#define NIN_PAD 3712
#define EPSV 1e-6f
#define NPHASE 10
#define SMEM_MAIN 73728

struct P {
  const float *x, *p, *attn_norm_w, *w_in, *conv_w, *a_log, *dt_bias, *gdn_norm_w, *fox_f_bias, *w_out,
      *ffn_norm_w, *w_gate_up, *w_down, *ple_norm_w, *w_ple_gate, *w_ple_proj, *final_norm_w;
  float* h;
  u16 *wt_in, *wt_out, *wt_gu, *wt_down, *wt_pg, *wt_pp;
  u16 *actA;
  u16 *pb;
  u16 *proj;
  u16 *vt;
  float *gates;
  float *cf;
  u16 *gM, *gC;
  u16 *gQ, *gO;
  u16 *gS;
  float *gdl;
  unsigned *counters;
  unsigned *bar;
  u16 *hb;
  float *rss;
};

typedef __attribute__((ext_vector_type(2))) float f32x2_t;
typedef __attribute__((ext_vector_type(2))) __bf16 bf16x2_t;
__device__ __forceinline__ u16 f2bf(float f) { return __builtin_bit_cast(u16, (__bf16)f); }
__device__ __forceinline__ float bf2f(u16 h) { return __uint_as_float(((unsigned)h) << 16); }
__device__ __forceinline__ unsigned pack2(float a, float b) {
  f32x2_t f = {a, b};
  return __builtin_bit_cast(unsigned, __builtin_convertvector(f, bf16x2_t));
}
__device__ __forceinline__ float siluf(float v) { return v / (1.f + __expf(-v)); }
__device__ __forceinline__ float sigmoidf_(float v) { return 1.f / (1.f + __expf(-v)); }
__device__ __forceinline__ f32x4 mfma16(bf16x8 a, bf16x8 b, f32x4 c) {
  return __builtin_amdgcn_mfma_f32_16x16x32_bf16(a, b, c, 0, 0, 0);
}
#define LDS_FENCE() asm volatile("s_waitcnt lgkmcnt(0)" ::: "memory")

__device__ __forceinline__ int colmap(int kind, int nn) {
  if (kind == 0) {
    if (nn < 2048) return nn;
    if (nn < 3584) return nn + 8;
    if (nn < 3588) return 2048 + (nn - 3584);
    if (nn < 3592) return 2052 + (nn - 3588);
    if (nn < 3600) return nn;
    return -1;
  } else if (kind == 2) {
    int i = nn >> 7, wc = (nn >> 6) & 1, u = (nn >> 5) & 1, j = nn & 31;
    return u * DFF + 64 * i + 32 * wc + j;
  }
  return nn;
}

__device__ void transpose_item(const float* __restrict__ src, int ldsrc, u16* __restrict__ dst, int K,
                               int kt, int nt, int kind, float* tile, const float* __restrict__ kscale = nullptr) {
  int tid = threadIdx.x;
  asm volatile("" : "+v"(tid));
  const int c = tid & 63, r0 = tid >> 6;
  const int ncol = colmap(kind, nt * 64 + c);
  float tv[16];
#pragma unroll
  for (int i = 0; i < 16; i++) {
    int r = r0 + 4 * i;
    tv[i] = (ncol >= 0) ? src[(size_t)(kt * 64 + r) * ldsrc + ncol] : 0.f;
  }
  if (kscale) {
#pragma unroll
    for (int i = 0; i < 16; i++) tv[i] *= kscale[kt * 64 + r0 + 4 * i];
  }
#pragma unroll
  for (int i = 0; i < 16; i++) tile[(r0 + 4 * i) * 65 + c] = tv[i];
  __syncthreads();
#pragma unroll 8
  for (int i = 0; i < 16; i++) {
    int rn = r0 + 4 * i;
    dst[(size_t)(nt * 64 + rn) * K + kt * 64 + c] = f2bf(tile[c * 65 + rn]);
  }
  __syncthreads();
}

__device__ __forceinline__ void rmsnorm_row(const float* src, const float* __restrict__ w,
                                            u16* dstb, float* dstf, int row) {
  const int lane = threadIdx.x & 63;
  float4 v[4];
  float ss = 0.f;
#pragma unroll
  for (int i = 0; i < 4; i++) {
    v[i] = *(const float4*)&src[(size_t)row * DM + i * 256 + lane * 4];
    ss += v[i].x * v[i].x + v[i].y * v[i].y + v[i].z * v[i].z + v[i].w * v[i].w;
  }
#pragma unroll
  for (int off = 32; off >= 1; off >>= 1) ss += __shfl_xor(ss, off);
  const float r = rsqrtf(ss * (1.f / DM) + EPSV);
#pragma unroll
  for (int i = 0; i < 4; i++) {
    const int col = i * 256 + lane * 4;
    float4 wv = *(const float4*)&w[col];
    float y0 = v[i].x * r * wv.x, y1 = v[i].y * r * wv.y, y2 = v[i].z * r * wv.z, y3 = v[i].w * r * wv.w;
    if (dstb) {
      uint2 o; o.x = pack2(y0, y1); o.y = pack2(y2, y3);
      *(uint2*)&dstb[(size_t)row * DM + col] = o;
    } else {
      *(float4*)&dstf[(size_t)row * DM + col] = make_float4(y0, y1, y2, y3);
    }
  }
}

__device__ void phase_prep(const P& p, unsigned char* smem) {
  float* tile = (float*)smem;
  if (blockIdx.x == 0 && threadIdx.x < 16) p.counters[threadIdx.x] = 0u;
  for (int i = blockIdx.x * 256 + threadIdx.x; i < 3 * NTOK; i += gridDim.x * 256) p.rss[i] = 0.f;
  for (int it = blockIdx.x; it < 16 * 58; it += gridDim.x) transpose_item(p.w_in, 3600, p.wt_in, 1024, it % 16, it / 16, 0, tile);
  const int wave = threadIdx.x >> 6, lane = threadIdx.x & 63;
  for (int rb = blockIdx.x; rb < NTOK / 8; rb += gridDim.x) {
    const int row = rb * 8 + wave * 2;
    float4 v0[4], v1[4];
#pragma unroll
    for (int i = 0; i < 4; i++) {
      v0[i] = *(const float4*)&p.x[(size_t)row * DM + i * 256 + lane * 4];
      v1[i] = *(const float4*)&p.x[(size_t)(row + 1) * DM + i * 256 + lane * 4];
    }
    const float4 pv0 = *(const float4*)&p.p[(size_t)row * 256 + lane * 4];
    const float4 pv1 = *(const float4*)&p.p[(size_t)(row + 1) * 256 + lane * 4];
    float s0 = 0.f, s1 = 0.f;
#pragma unroll
    for (int i = 0; i < 4; i++) {
      s0 += v0[i].x * v0[i].x + v0[i].y * v0[i].y + v0[i].z * v0[i].z + v0[i].w * v0[i].w;
      s1 += v1[i].x * v1[i].x + v1[i].y * v1[i].y + v1[i].z * v1[i].z + v1[i].w * v1[i].w;
    }
#pragma unroll
    for (int off = 32; off >= 1; off >>= 1) { s0 += __shfl_xor(s0, off); s1 += __shfl_xor(s1, off); }
    const float r0 = rsqrtf(s0 * (1.f / DM) + EPSV), r1 = rsqrtf(s1 * (1.f / DM) + EPSV);
#pragma unroll
    for (int i = 0; i < 4; i++) {
      const int col = i * 256 + lane * 4;
      const float4 wv = *(const float4*)&p.attn_norm_w[col];
      uint2 o;
      o.x = pack2(v0[i].x * r0 * wv.x, v0[i].y * r0 * wv.y); o.y = pack2(v0[i].z * r0 * wv.z, v0[i].w * r0 * wv.w);
      *(uint2*)&p.actA[(size_t)row * DM + col] = o;
      o.x = pack2(v1[i].x * r1 * wv.x, v1[i].y * r1 * wv.y); o.y = pack2(v1[i].z * r1 * wv.z, v1[i].w * r1 * wv.w);
      *(uint2*)&p.actA[(size_t)(row + 1) * DM + col] = o;
    }
    uint2 o; o.x = pack2(pv0.x, pv0.y); o.y = pack2(pv0.z, pv0.w);
    *(uint2*)&p.pb[(size_t)row * 256 + lane * 4] = o;
    o.x = pack2(pv1.x, pv1.y); o.y = pack2(pv1.z, pv1.w);
    *(uint2*)&p.pb[(size_t)(row + 1) * 256 + lane * 4] = o;
  }
}

__device__ void phase_rmsnorm(const float* src, const float* w, u16* dstb, float* dstf) {
  const int wave = threadIdx.x >> 6;
  for (int rb = blockIdx.x; rb < NTOK / 4; rb += gridDim.x) rmsnorm_row(src, w, dstb, dstf, rb * 4 + wave);
}

__device__ void phase_final(const P& p) {
  const int wave = threadIdx.x >> 6, lane = threadIdx.x & 63;
  for (int rb = blockIdx.x; rb < NTOK / 4; rb += gridDim.x) {
    const int row = rb * 4 + wave;
    const float r = rsqrtf(p.rss[2 * NTOK + row] * (1.f / DM) + EPSV);
#pragma unroll
    for (int i = 0; i < 4; i++) {
      const int col = i * 256 + lane * 4;
      float4 v = *(const float4*)&p.h[(size_t)row * DM + col];
      const float4 wv = *(const float4*)&p.final_norm_w[col];
      v.x *= r * wv.x; v.y *= r * wv.y; v.z *= r * wv.z; v.w *= r * wv.w;
      *(float4*)&p.h[(size_t)row * DM + col] = v;
    }
  }
}

#define GK 64
struct GemmSmem { u16 a[2][128 * GK]; u16 b[2][128 * GK]; };

template <bool SWAP>
__device__ __forceinline__ void gemm_tile(const u16* __restrict__ A, int lda, const u16* __restrict__ Bt, int ldb,
                                          int K, int m0, int n0, GemmSmem& s, f32x4 (&acc)[4][4]) {
  int tid = threadIdx.x;
  asm volatile("" : "+v"(tid));
  const int lane = tid & 63, wave = tid >> 6;
  const int wr = wave >> 1, wc = wave & 1;
  const int l15 = lane & 15, g = lane >> 4;
  const int nk = K / GK;
  const int drow = 8 * wave + (lane >> 3);
  const int dchunk = (lane & 7) ^ ((4 * (wave & 1) + (lane >> 4)) & 7);
  const u16* Ap = A + (size_t)(m0 + drow) * lda + dchunk * 8;
  const u16* Bp = Bt + (size_t)(n0 + drow) * ldb + dchunk * 8;
  const size_t sa = (size_t)32 * lda, sb = (size_t)32 * ldb;
#define G_DMA(bufi, koff) do { \
    _Pragma("unroll") for (int _i = 0; _i < 4; _i++) { \
      __builtin_amdgcn_global_load_lds((const unsigned*)(Ap + _i * sa + (koff)), (unsigned*)&s.a[bufi][(32 * _i + 8 * wave) * GK], 16, 0, 0); \
      __builtin_amdgcn_global_load_lds((const unsigned*)(Bp + _i * sb + (koff)), (unsigned*)&s.b[bufi][(32 * _i + 8 * wave) * GK], 16, 0, 0); \
    } } while (0)
  const int fo0 = l15 * GK + ((g ^ (l15 >> 1)) * 8);
  const int fo1 = l15 * GK + (((4 + g) ^ (l15 >> 1)) * 8);
  G_DMA(0, 0);
  asm volatile("s_waitcnt vmcnt(0)" ::: "memory");
  __builtin_amdgcn_s_barrier();
  asm volatile("" ::: "memory");
  for (int kt = 0; kt < nk; kt++) {
    const int buf = kt & 1;
    if (kt + 1 < nk) { if (buf) G_DMA(0, (kt + 1) * GK); else G_DMA(1, (kt + 1) * GK); }
    const u16* sa_ = &s.a[buf][(wr * 64) * GK];
    const u16* sb_ = &s.b[buf][(wc * 64) * GK];
#pragma unroll
    for (int ks = 0; ks < 2; ks++) {
      const int fo = ks ? fo1 : fo0;
      bf16x8 af[4], bfr[4];
#pragma unroll
      for (int mi = 0; mi < 4; mi++) af[mi] = *(const bf16x8*)&sa_[mi * 16 * GK + fo];
#pragma unroll
      for (int ni = 0; ni < 4; ni++) bfr[ni] = *(const bf16x8*)&sb_[ni * 16 * GK + fo];
#pragma unroll
      for (int mi = 0; mi < 4; mi++)
#pragma unroll
        for (int ni = 0; ni < 4; ni++) acc[mi][ni] = SWAP ? mfma16(bfr[ni], af[mi], acc[mi][ni]) : mfma16(af[mi], bfr[ni], acc[mi][ni]);
    }
    asm volatile("s_waitcnt vmcnt(0) lgkmcnt(0)" ::: "memory");
    __builtin_amdgcn_s_barrier();
    asm volatile("" ::: "memory");
  }
}


#define G2K 32
struct Gemm2Smem { u16 a[3][256 * G2K]; u16 b[3][128 * G2K]; };

template <bool SWAP>
__device__ __forceinline__ void gemm256(const u16* __restrict__ A, int lda, const u16* __restrict__ Bt, int ldb,
                                        int K, int m0, int n0, Gemm2Smem& s, f32x4 (&acc)[8][4]) {
  int tid = threadIdx.x;
  asm volatile("" : "+v"(tid));
  const int lane = tid & 63, wave = tid >> 6;
  const int wr = wave >> 1, wc = wave & 1;
  const int l15 = lane & 15, g = lane >> 4;
  const int nk = K / G2K;
  const int drow = 16 * wave + (lane >> 2);
  const int dchunk = (lane & 3) ^ g;
  const u16* Ap = A + (size_t)(m0 + drow) * lda + dchunk * 8;
  const u16* Bp = Bt + (size_t)(n0 + drow) * ldb + dchunk * 8;
  const size_t sa = (size_t)64 * lda, sb = (size_t)64 * ldb;
  u16* const sa0 = &s.a[0][0] + (16 * wave) * G2K;
  u16* const sb0 = &s.b[0][0] + (16 * wave) * G2K;
#define G2_DMA(st, koff) do { \
    u16* _da = sa0 + (st) * (256 * G2K); u16* _db = sb0 + (st) * (128 * G2K); \
    _Pragma("unroll") for (int _i = 0; _i < 4; _i++) \
      __builtin_amdgcn_global_load_lds((const unsigned*)(Ap + _i * sa + (koff)), (unsigned*)(_da + 64 * _i * G2K), 16, 0, 0); \
    _Pragma("unroll") for (int _i = 0; _i < 2; _i++) \
      __builtin_amdgcn_global_load_lds((const unsigned*)(Bp + _i * sb + (koff)), (unsigned*)(_db + 64 * _i * G2K), 16, 0, 0); \
  } while (0)
  const int fo = l15 * G2K + ((g ^ ((l15 >> 2) & 3)) * 8);
  asm volatile("s_waitcnt lgkmcnt(0)" ::: "memory");
  __builtin_amdgcn_s_barrier();
  asm volatile("" ::: "memory");
#pragma unroll 1
  for (int j = 0; j < 2; j++) G2_DMA(j, j * G2K);
  int st = 0;
  for (int kt = 0; kt < nk; kt++) {
    if (kt + 1 < nk) asm volatile("s_waitcnt vmcnt(6)" ::: "memory");
    else asm volatile("s_waitcnt vmcnt(0)" ::: "memory");
    __builtin_amdgcn_s_barrier();
    asm volatile("" ::: "memory");
    if (kt + 2 < nk) {
      const int st2 = (st >= 1) ? st - 1 : 2;
      G2_DMA(st2, (kt + 2) * G2K);
    }
    const u16* sa_ = &s.a[0][0] + st * (256 * G2K) + (wr * 128) * G2K + fo;
    const u16* sb_ = &s.b[0][0] + st * (128 * G2K) + (wc * 64) * G2K + fo;
    bf16x8 af[8], bfr[4];
#pragma unroll
    for (int mi = 0; mi < 8; mi++) af[mi] = *(const bf16x8*)&sa_[mi * 16 * G2K];
#pragma unroll
    for (int ni = 0; ni < 4; ni++) bfr[ni] = *(const bf16x8*)&sb_[ni * 16 * G2K];
#pragma unroll
    for (int mi = 0; mi < 8; mi++)
#pragma unroll
      for (int ni = 0; ni < 4; ni++) acc[mi][ni] = SWAP ? mfma16(bfr[ni], af[mi], acc[mi][ni]) : mfma16(af[mi], bfr[ni], acc[mi][ni]);
    st = (st == 2) ? 0 : st + 1;
  }
}
#define ZERO_ACC8(acc) _Pragma("unroll") for (int _i = 0; _i < 8; _i++) _Pragma("unroll") for (int _j = 0; _j < 4; _j++) acc[_i][_j] = (f32x4){0.f, 0.f, 0.f, 0.f};

#define ZERO_ACC(acc) _Pragma("unroll") for (int _i = 0; _i < 4; _i++) _Pragma("unroll") for (int _j = 0; _j < 4; _j++) acc[_i][_j] = (f32x4){0.f, 0.f, 0.f, 0.f};

template <int NMI>
__device__ __forceinline__ void row_sumsq_add(f32x4 (&sq)[NMI][4], float* rss, int row0, int l15, int g) {
#pragma unroll
  for (int mi = 0; mi < NMI; mi++) {
    float v = 0.f;
#pragma unroll
    for (int ni = 0; ni < 4; ni++) v += (sq[mi][ni][0] + sq[mi][ni][1]) + (sq[mi][ni][2] + sq[mi][ni][3]);
    v += __shfl_xor(v, 16);
    v += __shfl_xor(v, 32);
    if (g == 0) atomicAdd(&rss[row0 + mi * 16 + l15], v);
  }
}

__device__ void phase_inproj(const P& p, unsigned char* smem) {
  Gemm2Smem& s = *(Gemm2Smem*)smem;
  const int lane = threadIdx.x & 63, wave = threadIdx.x >> 6, wr = wave >> 1, wc = wave & 1, l15 = lane & 15, g = lane >> 4;
  const int ntiles = 64 * 29;
  for (int tl = blockIdx.x; tl < ntiles; tl += gridDim.x) {
    const int mt = tl & 63, nt = tl >> 6;
    const int m0 = mt * 256, n0 = nt * 128;
    f32x4 acc[8][4];
    ZERO_ACC8(acc);
    if (nt >= 24 && nt < 28) {
      gemm256<false>(p.actA, DM, p.wt_in, DM, DM, m0, n0, s, acc);
#pragma unroll
      for (int mi = 0; mi < 8; mi++)
#pragma unroll
        for (int ni = 0; ni < 4; ni++) {
          const int rowb = m0 + wr * 128 + mi * 16 + g * 4;
          const int col = n0 + wc * 64 + ni * 16 + l15;
          const int cc = col - 3072, hh = cc >> 6, d = cc & 63;
          const int b = rowb >> 11, sq = rowb & 2047;
          uint2 o; o.x = pack2(acc[mi][ni][0], acc[mi][ni][1]); o.y = pack2(acc[mi][ni][2], acc[mi][ni][3]);
          *(uint2*)&p.vt[((size_t)((b * 8 + hh) * 64 + d)) * SEQ + sq] = o;
        }
    } else {
      gemm256<true>(p.actA, DM, p.wt_in, DM, DM, m0, n0, s, acc);
#pragma unroll
      for (int mi = 0; mi < 8; mi++)
#pragma unroll
        for (int ni = 0; ni < 4; ni++) {
          const int row = m0 + wr * 128 + mi * 16 + l15;
          const int col = n0 + wc * 64 + ni * 16 + g * 4;
          if (nt < 24) {
            uint2 o; o.x = pack2(acc[mi][ni][0], acc[mi][ni][1]); o.y = pack2(acc[mi][ni][2], acc[mi][ni][3]);
            *(uint2*)&p.proj[(size_t)row * PROJW + col] = o;
          } else if (col < 3600) {
            *(float4*)&p.gates[(size_t)row * 16 + (col - 3584)] = make_float4(acc[mi][ni][0], acc[mi][ni][1], acc[mi][ni][2], acc[mi][ni][3]);
          }
        }
    }
  }
}

__device__ void phase_outproj(const P& p, unsigned char* smem) {
  Gemm2Smem& s = *(Gemm2Smem*)smem;
  const int lane = threadIdx.x & 63, wave = threadIdx.x >> 6, wr = wave >> 1, wc = wave & 1, l15 = lane & 15, g = lane >> 4;
  for (int tl = blockIdx.x; tl < 64 * 8; tl += gridDim.x) {
    const int mt = tl & 63, nt = tl >> 6;
    const int m0 = mt * 256, n0 = nt * 128;
    f32x4 acc[8][4];
    ZERO_ACC8(acc);
    gemm256<true>(p.actA, DM, p.wt_out, DM, DM, m0, n0, s, acc);
#pragma unroll
    for (int mi = 0; mi < 8; mi++)
#pragma unroll
      for (int ni = 0; ni < 4; ni++) {
        const size_t idx = (size_t)(m0 + wr * 128 + mi * 16 + l15) * DM + n0 + wc * 64 + ni * 16 + g * 4;
        const float4 xv = *(const float4*)&p.x[idx];
        const float h0 = xv.x + acc[mi][ni][0], h1 = xv.y + acc[mi][ni][1], h2 = xv.z + acc[mi][ni][2], h3 = xv.w + acc[mi][ni][3];
        *(float4*)&p.h[idx] = make_float4(h0, h1, h2, h3);
        uint2 o; o.x = pack2(h0, h1); o.y = pack2(h2, h3);
        *(uint2*)&p.hb[idx] = o;
        acc[mi][ni] = (f32x4){h0 * h0, h1 * h1, h2 * h2, h3 * h3};
      }
    row_sumsq_add(acc, p.rss, m0 + wr * 128, l15, g);
  }
}

__device__ void phase_gateup(const P& p, unsigned char* smem) {
  Gemm2Smem& s = *(Gemm2Smem*)smem;
  u16* act = p.proj;
  const int lane = threadIdx.x & 63, wave = threadIdx.x >> 6, wr = wave >> 1, wc = wave & 1, l15 = lane & 15, g = lane >> 4;
  for (int tl = blockIdx.x; tl < 64 * 44; tl += gridDim.x) {
    const int mt = tl & 63, nt = tl >> 6;
    const int m0 = mt * 256, n0 = nt * 128;
    f32x4 acc[8][4];
    ZERO_ACC8(acc);
    gemm256<true>(p.hb, DM, p.wt_gu, DM, DM, m0, n0, s, acc);
#pragma unroll
    for (int mi = 0; mi < 8; mi++) {
      const int row = m0 + wr * 128 + mi * 16 + l15;
      const float rs = rsqrtf(p.rss[row] * (1.f / DM) + EPSV);
#pragma unroll
      for (int ni = 0; ni < 2; ni++) {
        const int col = 64 * nt + 32 * wc + 16 * ni + g * 4;
        float v[4];
#pragma unroll
        for (int r = 0; r < 4; r++) v[r] = siluf(acc[mi][ni][r] * rs) * (acc[mi][ni + 2][r] * rs);
        uint2 o; o.x = pack2(v[0], v[1]); o.y = pack2(v[2], v[3]);
        *(uint2*)&act[(size_t)row * DFF + col] = o;
      }
    }
  }
}

__device__ void phase_down(const P& p, unsigned char* smem) {
  Gemm2Smem& s = *(Gemm2Smem*)smem;
  const u16* act = p.proj;
  const int lane = threadIdx.x & 63, wave = threadIdx.x >> 6, wr = wave >> 1, wc = wave & 1, l15 = lane & 15, g = lane >> 4;
  for (int tl = blockIdx.x; tl < 64 * 8; tl += gridDim.x) {
    const int mt = tl & 63, nt = tl >> 6;
    const int m0 = mt * 256, n0 = nt * 128;
    f32x4 acc[8][4];
    ZERO_ACC8(acc);
    gemm256<true>(act, DFF, p.wt_down, DFF, DFF, m0, n0, s, acc);
#pragma unroll
    for (int mi = 0; mi < 8; mi++)
#pragma unroll
      for (int ni = 0; ni < 4; ni++) {
        const size_t idx = (size_t)(m0 + wr * 128 + mi * 16 + l15) * DM + n0 + wc * 64 + ni * 16 + g * 4;
        const float4 hv = *(const float4*)&p.h[idx];
        const float h0 = hv.x + acc[mi][ni][0], h1 = hv.y + acc[mi][ni][1], h2 = hv.z + acc[mi][ni][2], h3 = hv.w + acc[mi][ni][3];
        *(float4*)&p.h[idx] = make_float4(h0, h1, h2, h3);
        uint2 o; o.x = pack2(h0, h1); o.y = pack2(h2, h3);
        *(uint2*)&p.actA[idx] = o;
        acc[mi][ni] = (f32x4){h0 * h0, h1 * h1, h2 * h2, h3 * h3};
      }
    row_sumsq_add(acc, p.rss + NTOK, m0 + wr * 128, l15, g);
  }
}

__device__ void phase_ple(const P& p, unsigned char* smem) {
  GemmSmem& s = *(GemmSmem*)smem;
  const int lane = threadIdx.x & 63, wave = threadIdx.x >> 6, wr = wave >> 1, wc = wave & 1, l15 = lane & 15, g = lane >> 4;
  for (int tl = blockIdx.x; tl < 128 * 8; tl += gridDim.x) {
    const int mt = tl & 127, nt = tl >> 7;
    const int m0 = mt * 128, n0 = nt * 128;
    f32x4 acc[4][4], acc2[4][4];
    ZERO_ACC(acc);
    gemm_tile<true>(p.actA, DM, p.wt_pg, DM, DM, m0, n0, s, acc);
#pragma unroll
    for (int mi = 0; mi < 4; mi++) {
      const float rs = rsqrtf(p.rss[NTOK + m0 + wr * 64 + mi * 16 + l15] * (1.f / DM) + EPSV);
#pragma unroll
      for (int ni = 0; ni < 4; ni++)
#pragma unroll
        for (int r = 0; r < 4; r++) acc[mi][ni][r] = sigmoidf_(acc[mi][ni][r] * rs);
    }
    ZERO_ACC(acc2);
    gemm_tile<true>(p.pb, 256, p.wt_pp, 256, 256, m0, n0, s, acc2);
#pragma unroll
    for (int mi = 0; mi < 4; mi++)
#pragma unroll
      for (int ni = 0; ni < 4; ni++) {
        const size_t idx = (size_t)(m0 + wr * 64 + mi * 16 + l15) * DM + n0 + wc * 64 + ni * 16 + g * 4;
        const float4 hv = *(const float4*)&p.h[idx];
        const float h0 = hv.x + acc[mi][ni][0] * acc2[mi][ni][0], h1 = hv.y + acc[mi][ni][1] * acc2[mi][ni][1];
        const float h2 = hv.z + acc[mi][ni][2] * acc2[mi][ni][2], h3 = hv.w + acc[mi][ni][3] * acc2[mi][ni][3];
        *(float4*)&p.h[idx] = make_float4(h0, h1, h2, h3);
        acc2[mi][ni] = (f32x4){h0 * h0, h1 * h1, h2 * h2, h3 * h3};
      }
    row_sumsq_add(acc2, p.rss + 2 * NTOK, m0 + wr * 64, l15, g);
  }
}

#define QLD 136
#define KLD 72
struct GdnSmem {
  u16 qb[64 * QLD];
  u16 kn[64 * QLD];
  u16 vb[64 * QLD];
  float Am[64 * 64];
  float gc[64], beta[64], be[64];
};
static_assert(offsetof(GdnSmem, kn) == 17408 && offsetof(GdnSmem, vb) == 34816 && offsetof(GdnSmem, Am) == 52224, "layout");

__device__ __forceinline__ void unpack8(const uint4& v, float (&f)[8]) {
  f[0] = bf2f((u16)(v.x & 0xffffu)); f[1] = bf2f((u16)(v.x >> 16));
  f[2] = bf2f((u16)(v.y & 0xffffu)); f[3] = bf2f((u16)(v.y >> 16));
  f[4] = bf2f((u16)(v.z & 0xffffu)); f[5] = bf2f((u16)(v.z >> 16));
  f[6] = bf2f((u16)(v.w & 0xffffu)); f[7] = bf2f((u16)(v.w >> 16));
}
__device__ __forceinline__ void unpack4(const uint2& v, float (&f)[4]) {
  f[0] = bf2f((u16)(v.x & 0xffffu)); f[1] = bf2f((u16)(v.x >> 16));
  f[2] = bf2f((u16)(v.y & 0xffffu)); f[3] = bf2f((u16)(v.y >> 16));
}

__device__ void gdn_unit(const P& p, int unit, GdnSmem& s) {
  int tid = threadIdx.x;
  asm volatile("" : "+v"(tid));
  int lane = tid & 63, wave = tid >> 6;
  int l15 = lane & 15, g = lane >> 4;
#define GDN_REFRESH() do { tid = threadIdx.x; asm volatile("" : "+v"(tid) :: "memory"); lane = tid & 63; wave = tid >> 6; l15 = lane & 15; g = lane >> 4; } while (0)
  const int bh = unit >> 5, n = unit & 31;
  const int b = bh >> 2, h = bh & 3;
  const int tb = b * SEQ;
  const int s0 = n * 64;
  u16* const qk_s = s.qb;
  u16* const WU = s.kn;
  u16* const kdT = (u16*)((unsigned char*)s.kn + 32768);
  __syncthreads();
  if (wave == 0) {
    const int t = tb + s0 + lane;
    const float ga = p.gates[(size_t)t * 16 + h], gb = p.gates[(size_t)t * 16 + 4 + h];
    const float xx = ga + p.dt_bias[h];
    const float sp = (xx > 20.f) ? xx : log1pf(__expf(xx));
    float gg = -__expf(p.a_log[h]) * sp;
#pragma unroll
    for (int off = 1; off < 64; off <<= 1) {
      float nb = __shfl_up(gg, off);
      if (lane >= off) gg += nb;
    }
    const float bt = sigmoidf_(gb);
    s.gc[lane] = gg;
    s.beta[lane] = bt;
    s.be[lane] = bt * __expf(gg);
  }
  {
    const int ch = tid & 15, rg = tid >> 4;
#pragma unroll 1
    for (int mat = 0; mat < 3; mat++) {
      const int col0 = mat * 512 + h * 128 + ch * 8;
      float cw[4][8];
#pragma unroll
      for (int k = 0; k < 4; k++) {
        const float4 w0 = *(const float4*)&p.conv_w[k * 1536 + col0];
        const float4 w1 = *(const float4*)&p.conv_w[k * 1536 + col0 + 4];
        cw[k][0] = w0.x; cw[k][1] = w0.y; cw[k][2] = w0.z; cw[k][3] = w0.w;
        cw[k][4] = w1.x; cw[k][5] = w1.y; cw[k][6] = w1.z; cw[k][7] = w1.w;
      }
      uint4 xr[7];
#pragma unroll
      for (int j = 0; j < 7; j++) {
        const int sp = s0 + 4 * rg + j - 3;
        xr[j] = (sp >= 0) ? *(const uint4*)&p.proj[(size_t)(tb + sp) * PROJW + col0] : make_uint4(0u, 0u, 0u, 0u);
      }
      float xf[7][8];
#pragma unroll
      for (int j = 0; j < 7; j++) unpack8(xr[j], xf[j]);
      u16* dst = (mat == 0) ? s.qb : ((mat == 1) ? s.kn : s.vb);
#pragma unroll
      for (int r = 0; r < 4; r++) {
        float val[8];
        float ss = 0.f;
#pragma unroll
        for (int c = 0; c < 8; c++) {
          const float cv = cw[0][c] * xf[r][c] + cw[1][c] * xf[r + 1][c] + cw[2][c] * xf[r + 2][c] + cw[3][c] * xf[r + 3][c];
          val[c] = siluf(cv);
          ss += val[c] * val[c];
        }
        float rs = 1.f;
        if (mat < 2) {
#pragma unroll
          for (int off = 1; off < 16; off <<= 1) ss += __shfl_xor(ss, off);
          rs = rsqrtf(ss + EPSV) * ((mat == 0) ? 0.08838834764831845f : 1.f);
        }
        uint4 o;
        o.x = pack2(val[0] * rs, val[1] * rs); o.y = pack2(val[2] * rs, val[3] * rs);
        o.z = pack2(val[4] * rs, val[5] * rs); o.w = pack2(val[6] * rs, val[7] * rs);
        *(uint4*)&dst[(4 * rg + r) * QLD + ch * 8] = o;
      }
    }
  }
  __syncthreads();
  GDN_REFRESH();
  u16* const gQ = p.gQ + (size_t)unit * 8192;
  {
#pragma unroll
    for (int it = 0; it < 4; it++) {
      const int idx = tid + 256 * it;
      const int i = idx >> 4, d8 = (idx & 15) * 8;
      const float e = __expf(s.gc[i]);
      float f[8];
      unpack8(*(const uint4*)&s.qb[i * QLD + d8], f);
      uint4 o;
      o.x = pack2(f[0] * e, f[1] * e); o.y = pack2(f[2] * e, f[3] * e);
      o.z = pack2(f[4] * e, f[5] * e); o.w = pack2(f[6] * e, f[7] * e);
      *(uint4*)&gQ[i * 128 + d8] = o;
    }
  }
  f32x4 cqk[4];
  {
    bf16x8 aq[4], ak[4];
#pragma unroll
    for (int ks = 0; ks < 4; ks++) {
      aq[ks] = *(const bf16x8*)&s.qb[(wave * 16 + l15) * QLD + ks * 32 + g * 8];
      ak[ks] = *(const bf16x8*)&s.kn[(wave * 16 + l15) * QLD + ks * 32 + g * 8];
    }
#pragma unroll
    for (int ni = 0; ni < 4; ni++) {
      f32x4 ckk = {0.f, 0.f, 0.f, 0.f};
      cqk[ni] = (f32x4){0.f, 0.f, 0.f, 0.f};
      if (ni <= wave) {
#pragma unroll
        for (int ks = 0; ks < 4; ks++) {
          bf16x8 bk = *(const bf16x8*)&s.kn[(ni * 16 + l15) * QLD + ks * 32 + g * 8];
          ckk = mfma16(ak[ks], bk, ckk);
          cqk[ni] = mfma16(aq[ks], bk, cqk[ni]);
        }
      }
      const int j = ni * 16 + l15;
      const float gcj = s.gc[j];
#pragma unroll
      for (int r = 0; r < 4; r++) {
        const int i = wave * 16 + g * 4 + r;
        const float dec = (i >= j) ? __expf(s.gc[i] - gcj) : 0.f;
        s.Am[i * 64 + j] = (i > j) ? ckk[r] * s.beta[i] * dec : 0.f;
        cqk[ni][r] = (i >= j) ? cqk[ni][r] * dec : 0.f;
      }
    }
  }
  __syncthreads();
  GDN_REFRESH();
#pragma unroll
  for (int ni = 0; ni < 4; ni++)
#pragma unroll
    for (int r = 0; r < 4; r++) qk_s[(wave * 16 + g * 4 + r) * KLD + ni * 16 + l15] = f2bf(cqk[ni][r]);
  float xs[64];
#ifdef NO_SOLVE
  for (int i = 0; i < 64; i++) xs[i] = s.Am[i*64+tid%64];
#else
  {
    const int c = tid;
    const u16* src = (c < 128) ? &s.vb[c] : &s.kn[c - 128];
    const float* sc = (c < 128) ? s.beta : s.be;
#pragma unroll
    for (int i = 0; i < 64; i++) {
      float a0 = bf2f(src[i * QLD]) * sc[i], a1 = 0.f, a2 = 0.f, a3 = 0.f;
#pragma unroll
      for (int j4 = 0; j4 < (i + 3) / 4; j4++) {
        const float4 av = *(const float4*)&s.Am[i * 64 + j4 * 4];
        if (j4 * 4 + 0 < i) a0 -= av.x * xs[j4 * 4 + 0];
        if (j4 * 4 + 1 < i) a1 -= av.y * xs[j4 * 4 + 1];
        if (j4 * 4 + 2 < i) a2 -= av.z * xs[j4 * 4 + 2];
        if (j4 * 4 + 3 < i) a3 -= av.w * xs[j4 * 4 + 3];
      }
      xs[i] = (a0 + a1) + (a2 + a3);
      asm volatile("" : "+v"(xs[i]) :: "memory");
    }
  }
#endif
  const float glast = s.gc[63];
  __syncthreads();
  GDN_REFRESH();
  {
    const int d = tid & 127, half = tid >> 7;
#pragma unroll
    for (int q = 0; q < 4; q++) {
      unsigned ow[4];
#pragma unroll
      for (int e2 = 0; e2 < 4; e2++) {
        const int c0 = half * 32 + q * 8 + e2 * 2;
        const float v0 = bf2f(s.kn[c0 * QLD + d]) * __expf(glast - s.gc[c0]);
        const float v1 = bf2f(s.kn[(c0 + 1) * QLD + d]) * __expf(glast - s.gc[c0 + 1]);
        ow[e2] = pack2(v0, v1);
      }
      *(uint4*)&kdT[d * KLD + half * 32 + q * 8] = make_uint4(ow[0], ow[1], ow[2], ow[3]);
    }
    if (tid == 0) p.gdl[unit] = __expf(glast);
  }
  __syncthreads();
  GDN_REFRESH();
  if (tid >= 128) {
#pragma unroll
    for (int q = 0; q < 8; q++)
      *(uint4*)&WU[(tid - 128) * KLD + q * 8] = make_uint4(pack2(xs[q * 8], xs[q * 8 + 1]), pack2(xs[q * 8 + 2], xs[q * 8 + 3]),
                                                            pack2(xs[q * 8 + 4], xs[q * 8 + 5]), pack2(xs[q * 8 + 6], xs[q * 8 + 7]));
  }
  __syncthreads();
  GDN_REFRESH();
  {
    u16* const gM = p.gM + (size_t)unit * 16384;
    bf16x8 aw[2][2];
#pragma unroll
    for (int mm = 0; mm < 2; mm++)
#pragma unroll
      for (int ks = 0; ks < 2; ks++) aw[mm][ks] = *(const bf16x8*)&WU[((2 * wave + mm) * 16 + l15) * KLD + ks * 32 + g * 8];
#pragma unroll
    for (int nn = 0; nn < 8; nn++) {
      const bf16x8 b0 = *(const bf16x8*)&kdT[(nn * 16 + l15) * KLD + g * 8];
      const bf16x8 b1 = *(const bf16x8*)&kdT[(nn * 16 + l15) * KLD + 32 + g * 8];
#pragma unroll
      for (int mm = 0; mm < 2; mm++) {
        f32x4 acc = {0.f, 0.f, 0.f, 0.f};
        acc = mfma16(aw[mm][0], b0, acc);
        acc = mfma16(aw[mm][1], b1, acc);
        uint2 o; o.x = pack2(-acc[0], -acc[1]); o.y = pack2(-acc[2], -acc[3]);
        *(uint2*)&gM[(nn * 16 + l15) * 128 + (2 * wave + mm) * 16 + 4 * g] = o;
      }
    }
#pragma unroll
    for (int nn = 0; nn < 4; nn++) {
      const bf16x8 b0 = *(const bf16x8*)&qk_s[(nn * 16 + l15) * KLD + g * 8];
      const bf16x8 b1 = *(const bf16x8*)&qk_s[(nn * 16 + l15) * KLD + 32 + g * 8];
#pragma unroll
      for (int mm = 0; mm < 2; mm++) {
        f32x4 acc = {0.f, 0.f, 0.f, 0.f};
        acc = mfma16(aw[mm][0], b0, acc);
        acc = mfma16(aw[mm][1], b1, acc);
        u16* qp = &gQ[(nn * 16 + l15) * 128 + (2 * wave + mm) * 16 + 4 * g];
        float qv[4];
        unpack4(*(const uint2*)qp, qv);
        uint2 o; o.x = pack2(qv[0] - acc[0], qv[1] - acc[1]); o.y = pack2(qv[2] - acc[2], qv[3] - acc[3]);
        *(uint2*)qp = o;
      }
    }
  }
  __syncthreads();
  GDN_REFRESH();
  if (tid < 128) {
#pragma unroll
    for (int q = 0; q < 8; q++)
      *(uint4*)&WU[tid * KLD + q * 8] = make_uint4(pack2(xs[q * 8], xs[q * 8 + 1]), pack2(xs[q * 8 + 2], xs[q * 8 + 3]),
                                                    pack2(xs[q * 8 + 4], xs[q * 8 + 5]), pack2(xs[q * 8 + 6], xs[q * 8 + 7]));
  }
  __syncthreads();
  GDN_REFRESH();
  {
    u16* const gC = p.gC + (size_t)unit * 16384;
    u16* const gO = p.gO + (size_t)unit * 8192;
    bf16x8 akd[2][2], aqk[2];
#pragma unroll
    for (int mm = 0; mm < 2; mm++)
#pragma unroll
      for (int ks = 0; ks < 2; ks++) akd[mm][ks] = *(const bf16x8*)&kdT[((2 * wave + mm) * 16 + l15) * KLD + ks * 32 + g * 8];
#pragma unroll
    for (int ks = 0; ks < 2; ks++) aqk[ks] = *(const bf16x8*)&qk_s[(wave * 16 + l15) * KLD + ks * 32 + g * 8];
#pragma unroll
    for (int nn = 0; nn < 8; nn++) {
      const bf16x8 b0 = *(const bf16x8*)&WU[(nn * 16 + l15) * KLD + g * 8];
      const bf16x8 b1 = *(const bf16x8*)&WU[(nn * 16 + l15) * KLD + 32 + g * 8];
#pragma unroll
      for (int mm = 0; mm < 2; mm++) {
        f32x4 acc = {0.f, 0.f, 0.f, 0.f};
        acc = mfma16(akd[mm][0], b0, acc);
        acc = mfma16(akd[mm][1], b1, acc);
        uint2 o; o.x = pack2(acc[0], acc[1]); o.y = pack2(acc[2], acc[3]);
        *(uint2*)&gC[(nn * 16 + l15) * 128 + (2 * wave + mm) * 16 + 4 * g] = o;
      }
      {
        f32x4 acc = {0.f, 0.f, 0.f, 0.f};
        acc = mfma16(aqk[0], b0, acc);
        acc = mfma16(aqk[1], b1, acc);
        uint2 o; o.x = pack2(acc[0], acc[1]); o.y = pack2(acc[2], acc[3]);
        *(uint2*)&gO[(nn * 16 + l15) * 64 + wave * 16 + 4 * g] = o;
      }
    }
  }
}

__device__ void fox_cumsum_unit(const P& p, int bhf, float* red) {
  const int tid = threadIdx.x, lane = tid & 63, wave = tid >> 6;
  const int b = bhf >> 3, hf = bhf & 7;
  const float bias = p.fox_f_bias[hf];
  float v[8];
  float run = 0.f;
#pragma unroll
  for (int i = 0; i < 8; i++) {
    const int t = b * SEQ + tid * 8 + i;
    const float xx = p.gates[(size_t)t * 16 + 8 + hf] + bias;
    const float ls = fminf(xx, 0.f) - log1pf(__expf(-fabsf(xx)));
    run += ls;
    v[i] = run;
  }
  float tot = run;
#pragma unroll
  for (int off = 1; off < 64; off <<= 1) {
    float nb = __shfl_up(tot, off);
    if (lane >= off) tot += nb;
  }
  __syncthreads();
  if (lane == 63) red[wave] = tot;
  __syncthreads();
  float base = tot - run;
  for (int w = 0; w < wave; w++) base += red[w];
#pragma unroll
  for (int i = 0; i < 8; i++) p.cf[(size_t)bhf * SEQ + tid * 8 + i] = v[i] + base;
}

__device__ void phase_gdnprep(const P& p, unsigned char* smem) {
  GdnSmem& s = *(GdnSmem*)smem;
  for (int u = blockIdx.x; u < 1024 + 64; u += gridDim.x) {
    if (u < 1024) gdn_unit(p, u, s);
    else { __syncthreads(); fox_cumsum_unit(p, u - 1024, (float*)smem); }
  }
}

#define SLD 136
#define NSCAN 128
struct ScanSmem { u16 st[2][32 * SLD]; };
struct ScanSet { bf16x8 mf[2][4]; uint2 ci[2][2]; float dl; };

__device__ __forceinline__ void scan_load(const P& p, int unit, int eq, int w, int l15, int g, ScanSet& z) {
  int la = (32 * w + l15) * 128 + 8 * g, lc = (32 * eq + l15) * 128 + 32 * w + 4 * g;
  asm volatile("" : "+v"(la), "+v"(lc));
  const u16* gM = p.gM + (size_t)unit * 16384;
  const u16* gC = p.gC + (size_t)unit * 16384;
#pragma unroll
  for (int md = 0; md < 2; md++)
#pragma unroll
    for (int ks = 0; ks < 4; ks++) z.mf[md][ks] = *(const bf16x8*)&gM[la + md * 16 * 128 + ks * 32];
#pragma unroll
  for (int md = 0; md < 2; md++)
#pragma unroll
    for (int ne = 0; ne < 2; ne++) z.ci[md][ne] = *(const uint2*)&gC[lc + ne * 16 * 128 + md * 16];
  z.dl = p.gdl[unit];
}

__device__ __forceinline__ unsigned scan_touch(const P& p, int unit, int lane) {
  unsigned v = 0u;
  if (lane < 16) {
    const u16* base = (lane < 8) ? (p.gM + (size_t)unit * 16384) : (p.gC + (size_t)unit * 16384);
    v = *(const unsigned*)(base + (lane & 7) * 2048);
  }
  return v;
}

__device__ __forceinline__ void scan_step(const P& p, int unit, int n, int eq, int w, int l15, int g, ScanSmem& s,
                                          f32x4 (&st)[2][2], const ScanSet& z) {
  const u16* Sb = s.st[n & 1];
  u16* Sn = s.st[(n & 1) ^ 1];
#pragma unroll
  for (int md = 0; md < 2; md++)
#pragma unroll
    for (int ne = 0; ne < 2; ne++) {
      float c[4];
      unpack4(z.ci[md][ne], c);
      st[md][ne][0] = st[md][ne][0] * z.dl + c[0];
      st[md][ne][1] = st[md][ne][1] * z.dl + c[1];
      st[md][ne][2] = st[md][ne][2] * z.dl + c[2];
      st[md][ne][3] = st[md][ne][3] * z.dl + c[3];
    }
  if (n > 0) {
    int lb = l15 * SLD + 8 * g;
    asm volatile("" : "+v"(lb));
#pragma unroll
    for (int ne = 0; ne < 2; ne++) {
#pragma unroll
      for (int ks = 0; ks < 4; ks++) {
        const bf16x8 bs = *(const bf16x8*)&Sb[lb + 16 * ne * SLD + ks * 32];
        st[0][ne] = mfma16(z.mf[0][ks], bs, st[0][ne]);
        st[1][ne] = mfma16(z.mf[1][ks], bs, st[1][ne]);
      }
    }
  }
  if (n + 1 < 32) {
    u16* gS = p.gS + (size_t)(unit + 1) * 16384;
    int lsl = l15 * SLD + 32 * w + 4 * g, lsg = (32 * eq + l15) * 128 + 32 * w + 4 * g;
    asm volatile("" : "+v"(lsl), "+v"(lsg));
#pragma unroll
    for (int md = 0; md < 2; md++)
#pragma unroll
      for (int ne = 0; ne < 2; ne++) {
        uint2 o; o.x = pack2(st[md][ne][0], st[md][ne][1]); o.y = pack2(st[md][ne][2], st[md][ne][3]);
        *(uint2*)&Sn[lsl + 16 * ne * SLD + 16 * md] = o;
        *(uint2*)&gS[lsg + 16 * ne * 128 + 16 * md] = o;
      }
  }
  asm volatile("s_waitcnt lgkmcnt(0)" ::: "memory");
  __builtin_amdgcn_s_barrier();
  asm volatile("" ::: "memory");
}

__device__ void scan_unit(const P& p, int item, ScanSmem& s) {
  int tid = threadIdx.x;
  asm volatile("" : "+v"(tid));
  const int lane = tid & 63, w = tid >> 6;
  const int l15 = lane & 15, g = lane >> 4;
  const int bh = item >> 2, eq = item & 3;
  const int u0 = bh * 32;
  f32x4 st[2][2];
#pragma unroll
  for (int md = 0; md < 2; md++)
#pragma unroll
    for (int ne = 0; ne < 2; ne++) st[md][ne] = (f32x4){0.f, 0.f, 0.f, 0.f};
  ScanSet z0, z1, z2, z3;
  scan_load(p, u0 + 0, eq, w, l15, g, z0);
  scan_load(p, u0 + 1, eq, w, l15, g, z1);
  scan_load(p, u0 + 2, eq, w, l15, g, z2);
  unsigned tacc = 0u, tprev = 0u;
  __builtin_amdgcn_s_setprio(3);
#pragma unroll 1
  for (int n = 0; n < 32; n += 4) {
    tacc += tprev;
    tprev = 0u;
    if (n + 8 < 32) {
      tprev = scan_touch(p, u0 + n + 8, lane) + scan_touch(p, u0 + n + 9, lane) + scan_touch(p, u0 + n + 10, lane) +
              scan_touch(p, u0 + n + 11, lane);
    }
    scan_load(p, u0 + n + 3, eq, w, l15, g, z3);
    scan_step(p, u0 + n, n, eq, w, l15, g, s, st, z0);
    if (n + 4 < 32) scan_load(p, u0 + n + 4, eq, w, l15, g, z0);
    scan_step(p, u0 + n + 1, n + 1, eq, w, l15, g, s, st, z1);
    if (n + 4 < 32) scan_load(p, u0 + n + 5, eq, w, l15, g, z1);
    scan_step(p, u0 + n + 2, n + 2, eq, w, l15, g, s, st, z2);
    if (n + 4 < 32) scan_load(p, u0 + n + 6, eq, w, l15, g, z2);
    scan_step(p, u0 + n + 3, n + 3, eq, w, l15, g, s, st, z3);
  }
  __builtin_amdgcn_s_setprio(0);
  asm volatile("" :: "v"(tacc));
}

#define OLD 136
struct GoutSmem { float ssq[4][64]; u16 ob[64 * OLD]; };

__device__ void gout_unit(const P& p, int unit, GoutSmem& s) {
  const int tid = threadIdx.x, lane = tid & 63, w = tid >> 6;
  const int l15 = lane & 15, g = lane >> 4;
  const int bh = unit >> 5, n = unit & 31;
  const int b = bh >> 2, h = bh & 3;
  const u16* gQ = p.gQ + (size_t)unit * 8192;
  const u16* gO = p.gO + (size_t)unit * 8192;
  const u16* gS = p.gS + (size_t)unit * 16384;
  f32x4 o[4][2];
#pragma unroll
  for (int mc = 0; mc < 4; mc++)
#pragma unroll
    for (int ne = 0; ne < 2; ne++) {
      float c[4];
      unpack4(*(const uint2*)&gO[(32 * w + 16 * ne + l15) * 64 + 16 * mc + 4 * g], c);
      o[mc][ne] = (f32x4){c[0], c[1], c[2], c[3]};
    }
  if (n > 0) {
    bf16x8 bs[2][4];
#pragma unroll
    for (int ne = 0; ne < 2; ne++)
#pragma unroll
      for (int ks = 0; ks < 4; ks++) bs[ne][ks] = *(const bf16x8*)&gS[(32 * w + 16 * ne + l15) * 128 + ks * 32 + 8 * g];
#pragma unroll
    for (int mc = 0; mc < 4; mc++) {
#pragma unroll
      for (int ks = 0; ks < 4; ks++) {
        const bf16x8 aq = *(const bf16x8*)&gQ[(16 * mc + l15) * 128 + ks * 32 + 8 * g];
        o[mc][0] = mfma16(aq, bs[0][ks], o[mc][0]);
        o[mc][1] = mfma16(aq, bs[1][ks], o[mc][1]);
      }
    }
  }
  const float gnw0 = p.gdn_norm_w[32 * w + l15], gnw1 = p.gdn_norm_w[32 * w + 16 + l15];
  __syncthreads();
#pragma unroll
  for (int mc = 0; mc < 4; mc++)
#pragma unroll
    for (int r = 0; r < 4; r++) {
      float sq = o[mc][0][r] * o[mc][0][r] + o[mc][1][r] * o[mc][1][r];
#pragma unroll
      for (int off = 1; off < 16; off <<= 1) sq += __shfl_xor(sq, off);
      if (l15 == 0) s.ssq[w][16 * mc + 4 * g + r] = sq;
    }
  __syncthreads();
#pragma unroll
  for (int mc = 0; mc < 4; mc++)
#pragma unroll
    for (int r = 0; r < 4; r++) {
      const int c = 16 * mc + 4 * g + r;
      const float tot = s.ssq[0][c] + s.ssq[1][c] + s.ssq[2][c] + s.ssq[3][c];
      const float rs = rsqrtf(tot * (1.f / 128.f) + EPSV);
      s.ob[c * OLD + 32 * w + l15] = f2bf(o[mc][0][r] * rs * gnw0);
      s.ob[c * OLD + 32 * w + 16 + l15] = f2bf(o[mc][1][r] * rs * gnw1);
    }
  __syncthreads();
  {
    const int t0 = b * SEQ + n * 64;
    const int c0 = tid >> 4, ch = tid & 15;
    const u16* zp = p.proj + (size_t)(t0 + c0) * PROJW + 1536 + h * 128 + ch * 8;
    u16* op = p.actA + (size_t)(t0 + c0) * DM + h * 128 + ch * 8;
#pragma unroll
    for (int i = 0; i < 4; i++) {
      float ov[8], zv[8];
      unpack8(*(const uint4*)&s.ob[(c0 + 16 * i) * OLD + ch * 8], ov);
      unpack8(*(const uint4*)(zp + (size_t)i * 16 * PROJW), zv);
      uint4 r;
      r.x = pack2(ov[0] * siluf(zv[0]), ov[1] * siluf(zv[1])); r.y = pack2(ov[2] * siluf(zv[2]), ov[3] * siluf(zv[3]));
      r.z = pack2(ov[4] * siluf(zv[4]), ov[5] * siluf(zv[5])); r.w = pack2(ov[6] * siluf(zv[6]), ov[7] * siluf(zv[7]));
      *(uint4*)(op + (size_t)i * 16 * DM) = r;
    }
  }
}

__device__ void phase_gout(const P& p, unsigned char* smem) {
  GoutSmem& s = *(GoutSmem*)smem;
  for (int u = blockIdx.x; u < 1024; u += gridDim.x) gout_unit(p, u, s);
}

#define LOG2E 1.4426950408889634f
#define ANST 4
struct AttnSmem { u16 k[ANST][64 * 64 + 128]; u16 v[ANST][64 * 64]; };

__device__ void attn_unit(const P& p, int item, AttnSmem& s) {
  int tid = threadIdx.x;
  asm volatile("" : "+v"(tid));
  const int lane = tid & 63, w = tid >> 6;
  const int l15 = lane & 15, g = lane >> 4;
  const int qb = 15 - (item >> 6), bhf = item & 63;
  const int b = bhf >> 3, hf = bhf & 7;
  const int q0 = qb * 128 + 32 * w;
  const u16* qbase = p.proj + (size_t)(b * SEQ) * PROJW + 2048 + hf * 64;
  const u16* kbase = p.proj + (size_t)(b * SEQ) * PROJW + 2560 + hf * 64;
  const u16* vbase = p.vt + (size_t)bhf * 64 * SEQ;
  const float* cfb = p.cf + (size_t)bhf * SEQ;
  bf16x8 qf[2][2];
#pragma unroll
  for (int mi = 0; mi < 2; mi++)
#pragma unroll
    for (int ks = 0; ks < 2; ks++) qf[mi][ks] = *(const bf16x8*)&qbase[(size_t)(q0 + 16 * mi + l15) * PROJW + ks * 32 + g * 8];
  float cq[2], m[2], lsum[2];
  f32x4 O[2][4];
#pragma unroll
  for (int mi = 0; mi < 2; mi++) {
    cq[mi] = cfb[q0 + 16 * mi + l15]; m[mi] = -1e30f; lsum[mi] = 0.f;
#pragma unroll
    for (int nd = 0; nd < 4; nd++) O[mi][nd] = (f32x4){0.f, 0.f, 0.f, 0.f};
  }
  asm volatile("" :: "v"(cq[0]), "v"(cq[1]), "v"(qf[0][0]), "v"(qf[0][1]), "v"(qf[1][0]), "v"(qf[1][1]));
  const int ntile = (q0 + 32 + 63) >> 6;
  const int ntile_blk = 2 * qb + 2;
  const int drow = 8 * w + (lane >> 3);
  const int dchunk = (lane & 7) ^ ((4 * (w & 1) + (lane >> 4)) & 7);
  const u16* kg = kbase + (size_t)drow * PROJW + dchunk * 8;
  const u16* vg = vbase + (size_t)drow * SEQ + dchunk * 8;
  const float* cg_ = cfb + lane;
  u16* const skw = &s.k[0][0] + (8 * w) * 64;
  u16* const svw = &s.v[0][0] + (8 * w) * 64;
#define A_DMA(st, kk0) do { \
    u16* _dk = skw + (st) * (64 * 64 + 128); u16* _dv = svw + (st) * (64 * 64); \
    __builtin_amdgcn_global_load_lds((const unsigned*)(kg + (size_t)(kk0) * PROJW), (unsigned*)(_dk), 16, 0, 0); \
    __builtin_amdgcn_global_load_lds((const unsigned*)(kg + (size_t)((kk0) + 32) * PROJW), (unsigned*)(_dk + 32 * 64), 16, 0, 0); \
    __builtin_amdgcn_global_load_lds((const unsigned*)(vg + (kk0)), (unsigned*)(_dv), 16, 0, 0); \
    __builtin_amdgcn_global_load_lds((const unsigned*)(vg + (size_t)32 * SEQ + (kk0)), (unsigned*)(_dv + 32 * 64), 16, 0, 0); \
    __builtin_amdgcn_global_load_lds((const unsigned*)(cg_ + (kk0)), (unsigned*)(&s.k[0][0] + (st) * (64 * 64 + 128) + 64 * 64), 4, 0, 0); \
  } while (0)
  {
    const int npro = (ntile_blk > 2) ? 3 : 2;
#pragma unroll 1
    for (int j = 0; j < npro; j++) A_DMA(j, j * 64);
  }
  int ko[4][2];
#pragma unroll
  for (int t = 0; t < 4; t++) {
    const int row = 32 * (t >> 1) + 8 * (l15 >> 2) + 4 * (t & 1) + (l15 & 3);
    const int sw = (row >> 1) & 7;
    ko[t][0] = row * 64 + ((g ^ sw) * 8);
    ko[t][1] = row * 64 + (((4 + g) ^ sw) * 8);
  }
  const int swz = l15 >> 1;
  int vo[2];
  vo[0] = l15 * 64 + ((g ^ swz) * 8);
  vo[1] = l15 * 64 + (((4 + g) ^ swz) * 8);
#pragma unroll 1
  for (int kt = 0; kt < ntile_blk; kt++) {
    const int k0 = kt * 64, st = kt & 3;
    const int rem = ntile_blk - 1 - kt;
    if (rem >= 2) asm volatile("s_waitcnt vmcnt(10)" ::: "memory");
    else if (rem == 1) asm volatile("s_waitcnt vmcnt(5)" ::: "memory");
    else asm volatile("s_waitcnt vmcnt(0)" ::: "memory");
    asm volatile("s_waitcnt lgkmcnt(0)" ::: "memory");
    __builtin_amdgcn_s_barrier();
    asm volatile("" ::: "memory");
    if (kt + 3 < ntile_blk) { const int st3 = (kt + 3) & 3; A_DMA(st3, k0 + 192); }
    if (kt < ntile) {
      const u16* Ks = s.k[st];
      const u16* Vs = s.v[st];
      f32x4 ST[2][4];
#pragma unroll
      for (int t = 0; t < 4; t++) {
        const bf16x8 kf0 = *(const bf16x8*)&Ks[ko[t][0]];
        const bf16x8 kf1 = *(const bf16x8*)&Ks[ko[t][1]];
#pragma unroll
        for (int mi = 0; mi < 2; mi++) {
          f32x4 acc = {0.f, 0.f, 0.f, 0.f};
          acc = mfma16(kf0, qf[mi][0], acc);
          acc = mfma16(kf1, qf[mi][1], acc);
          ST[mi][t] = acc;
        }
      }
      f32x4 ck[4];
      {
        const unsigned cka = (unsigned)(size_t)(&Ks[64 * 64]) + 32u * g;
        asm volatile("ds_read_b128 %0, %4\n\tds_read_b128 %1, %4 offset:16\n\tds_read_b128 %2, %4 offset:128\n\t"
                     "ds_read_b128 %3, %4 offset:144\n\ts_waitcnt lgkmcnt(0)"
                     : "=&v"(ck[0]), "=&v"(ck[1]), "=&v"(ck[2]), "=&v"(ck[3]) : "v"(cka) : "memory");
      }
      const bool diag = (kt == ntile - 1);
      bf16x8 pf[2][2];
#pragma unroll
      for (int mi = 0; mi < 2; mi++) {
        const int qpos = q0 + 16 * mi + l15;
        float mx = -1e30f;
#pragma unroll
        for (int t = 0; t < 4; t++) {
          const float ckv[4] = {ck[t][0], ck[t][1], ck[t][2], ck[t][3]};
#pragma unroll
          for (int r = 0; r < 4; r++) {
            float lg = ST[mi][t][r] * (0.125f * LOG2E) + (cq[mi] - ckv[r]) * LOG2E;
            if (diag && (k0 + 32 * (t >> 1) + 8 * g + 4 * (t & 1) + r > qpos)) lg = -1e30f;
            ST[mi][t][r] = lg;
            mx = fmaxf(mx, lg);
          }
        }
        mx = fmaxf(mx, __shfl_xor(mx, 16));
        mx = fmaxf(mx, __shfl_xor(mx, 32));
        const float mn = fmaxf(m[mi], mx);
        const float alpha = __builtin_amdgcn_exp2f(m[mi] - mn);
        m[mi] = mn;
        float ps = 0.f;
#pragma unroll
        for (int t = 0; t < 4; t++)
#pragma unroll
          for (int r = 0; r < 4; r++) {
            const float pe = __builtin_amdgcn_exp2f(ST[mi][t][r] - mn);
            ST[mi][t][r] = pe;
            ps += pe;
          }
        lsum[mi] = lsum[mi] * alpha + ps;
#pragma unroll
        for (int kk = 0; kk < 2; kk++) {
          uint4 pk;
          pk.x = pack2(ST[mi][2 * kk][0], ST[mi][2 * kk][1]); pk.y = pack2(ST[mi][2 * kk][2], ST[mi][2 * kk][3]);
          pk.z = pack2(ST[mi][2 * kk + 1][0], ST[mi][2 * kk + 1][1]); pk.w = pack2(ST[mi][2 * kk + 1][2], ST[mi][2 * kk + 1][3]);
          pf[mi][kk] = __builtin_bit_cast(bf16x8, pk);
        }
#pragma unroll
        for (int r = 0; r < 4; r++) {
          const float ar = __shfl(alpha, 4 * g + r);
#pragma unroll
          for (int nd = 0; nd < 4; nd++) O[mi][nd][r] *= ar;
        }
      }
#pragma unroll
      for (int nd = 0; nd < 4; nd++)
#pragma unroll
        for (int kk = 0; kk < 2; kk++) {
          const bf16x8 vf = *(const bf16x8*)&Vs[16 * nd * 64 + vo[kk]];
          O[0][nd] = mfma16(pf[0][kk], vf, O[0][nd]);
          O[1][nd] = mfma16(pf[1][kk], vf, O[1][nd]);
        }
    }
  }
#pragma unroll
  for (int mi = 0; mi < 2; mi++) {
    float l = lsum[mi];
    l += __shfl_xor(l, 16);
    l += __shfl_xor(l, 32);
    const float inv = 1.f / l;
#pragma unroll
    for (int r = 0; r < 4; r++) {
      const float ir = __shfl(inv, 4 * g + r);
      const int t = b * SEQ + q0 + 16 * mi + 4 * g + r;
#pragma unroll
      for (int nd = 0; nd < 4; nd++) p.actA[(size_t)t * DM + 512 + hf * 64 + 16 * nd + l15] = f2bf(O[mi][nd][r] * ir);
    }
  }
}

__device__ void deferred_transpose(const P& p, int it, float* tile) {
  const int n1 = 16 * 16, n2 = n1 + 16 * 88, n3 = n2 + 44 * 16, n4 = n3 + 16 * 16;
  if (it < n1) { transpose_item(p.w_out, 1024, p.wt_out, 1024, it % 16, it / 16, 1, tile); }
  else if (it < n2) { int j = it - n1; transpose_item(p.w_gate_up, 2 * DFF, p.wt_gu, 1024, j % 16, j / 16, 2, tile, p.ffn_norm_w); }
  else if (it < n3) { int j = it - n2; transpose_item(p.w_down, 1024, p.wt_down, DFF, j % 44, j / 44, 1, tile); }
  else if (it < n4) { int j = it - n3; transpose_item(p.w_ple_gate, 1024, p.wt_pg, 1024, j % 16, j / 16, 1, tile, p.ple_norm_w); }
  else { int j = it - n4; transpose_item(p.w_ple_proj, 1024, p.wt_pp, 256, j % 4, j / 4, 1, tile); }
}
#define N_DEFER (16 * 16 + 16 * 88 + 44 * 16 + 16 * 16 + 4 * 16)

__device__ void phase_mixer(const P& p, unsigned char* smem, int rr) {
  volatile int* s_item_p = (volatile int*)(smem + SMEM_MAIN + 16);
  for (;;) {
    __syncthreads();
    if (threadIdx.x == 0) *s_item_p = (int)atomicAdd(&p.counters[rr], 1u);
    __syncthreads();
    const int item = *s_item_p;
    if (item >= NSCAN + 1024 + N_DEFER) break;
    if (item < NSCAN) { scan_unit(p, item, *(ScanSmem*)smem); }
    else if (item < NSCAN + 1024) { attn_unit(p, item - NSCAN, *(AttnSmem*)smem); }
    else { deferred_transpose(p, item - NSCAN - 1024, (float*)smem); }
  }
}

#define XB_TMO      128
#define XB_XCNT(j)  (256  + 64 * (j))
#define XB_XSUB(j)  (1280 + 64 * (j))
#define XB_XGEN(j)  (2304 + 64 * (j))
#define XB_TOP      3328
#define XB_TOPGEN   3392
#define XCD_BAR_WORDS 3456
#define XB_SPIN_CAP (1u << 20)
#define LAS __attribute__((address_space(3)))
__device__ __forceinline__ unsigned xb_ld(unsigned* p) { return __hip_atomic_load(p, __ATOMIC_RELAXED, __HIP_MEMORY_SCOPE_AGENT); }
__device__ __forceinline__ unsigned xb_add(unsigned* p, unsigned v) { return __hip_atomic_fetch_add(p, v, __ATOMIC_RELAXED, __HIP_MEMORY_SCOPE_AGENT); }
__device__ __forceinline__ unsigned xb_xcc_id() { return (unsigned)__builtin_amdgcn_s_getreg((3 << 11) | 20) & 0xFu; }
#define XB_SPIN(cond, bar) do { unsigned _sp = 0; while (cond) { __builtin_amdgcn_s_sleep(1); \
    if ((++_sp & 255u) == 0u) { if (xb_ld(&(bar)[XB_TMO])) break; if (_sp > XB_SPIN_CAP) { atomicAdd(&(bar)[XB_TMO], 1u); break; } } } } while (0)
struct XcdBarrier { unsigned* bar; unsigned x; volatile LAS unsigned* st; };
__device__ __forceinline__ XcdBarrier xcd_barrier_post(unsigned* bar, volatile LAS unsigned* st) {
  XcdBarrier b; b.bar = bar; b.x = xb_xcc_id(); b.st = st;
  if (threadIdx.x == 0) (void)xb_add(&bar[XB_XCNT(b.x)], 1u);
  return b;
}
__device__ __forceinline__ void xcd_barrier_complete(unsigned* bar, unsigned x, unsigned& nloc, unsigned& nx) {
  const unsigned G = gridDim.x * gridDim.y * gridDim.z;
  unsigned sum, cnt, mine, sp = 0u;
  for (;;) {
    sum = 0u; cnt = 0u; mine = 0u;
#pragma unroll
    for (unsigned j = 0; j < 16; ++j) { const unsigned c = xb_ld(&bar[XB_XCNT(j)]); sum += c; cnt += (c > 0u) ? 1u : 0u; mine = (j == x) ? c : mine; }
    if (sum == G) break;
    __builtin_amdgcn_s_sleep(1);
    if ((++sp & 255u) == 0u) { if (xb_ld(&bar[XB_TMO])) break; if (sp > XB_SPIN_CAP) { atomicAdd(&bar[XB_TMO], 1u); break; } }
  }
  nloc = mine > 0u ? mine : 1u; nx = cnt > 0u ? cnt : 1u;
}
__device__ __forceinline__ void xcd_barrier(const XcdBarrier& b) {
  asm volatile("s_waitcnt vmcnt(0)" ::: "memory");
  __syncthreads();
  if (threadIdx.x == 0) {
    unsigned* bar = b.bar;
    __builtin_amdgcn_s_waitcnt(0);
    unsigned nloc = b.st[0], nx = b.st[1];
    if (nloc == 0u) { xcd_barrier_complete(bar, b.x, nloc, nx); b.st[0] = nloc; b.st[1] = nx; }
    const unsigned old = xb_add(&bar[XB_XSUB(b.x)], 1u);
    const unsigned gen = old / nloc;
    if (old + 1u == (gen + 1u) * nloc) {
      __builtin_amdgcn_fence(__ATOMIC_RELEASE, "agent");
      asm volatile("s_waitcnt vmcnt(0)" ::: "memory");
      const unsigned og = xb_add(&bar[XB_TOP], 1u);
      const unsigned tg = og / nx;
      if (og + 1u == (tg + 1u) * nx) xb_add(&bar[XB_TOPGEN], 1u);
      else XB_SPIN(xb_ld(&bar[XB_TOPGEN]) == tg, bar);
      __builtin_amdgcn_fence(__ATOMIC_ACQUIRE, "agent");
      xb_add(&bar[XB_XGEN(b.x)], 1u);
      asm volatile("s_waitcnt vmcnt(0)" ::: "memory");
    } else {
      XB_SPIN(xb_ld(&bar[XB_XGEN(b.x)]) == gen, bar);
      __builtin_amdgcn_fence(__ATOMIC_ACQUIRE, "agent");
      asm volatile("s_waitcnt vmcnt(0)" ::: "memory");
    }
  }
  __syncthreads();
}

__global__ void __launch_bounds__(256, 2) mega(P p, int lo, int hi) {
  __shared__ __attribute__((aligned(16))) unsigned char smem[SMEM_MAIN + 32];
  cg::grid_group grid = cg::this_grid();
  uint4* xbw = (uint4*)(smem + SMEM_MAIN);
  if (threadIdx.x == 0) *xbw = make_uint4(0u, 0u, 0u, 0u);
  __syncthreads();
  XcdBarrier xb = xcd_barrier_post(p.bar, (volatile LAS unsigned*)xbw);
  if (hi < 0) grid.sync();
#define SEAM(k) if (lo <= k && k + 1 < hi) xcd_barrier(xb);
#if !defined(ONLY) || ONLY == 0
  if (lo <= 0 && 0 < hi) phase_prep(p, smem);
#endif
  SEAM(0)
#if !defined(ONLY) || ONLY == 1
  if (lo <= 1 && 1 < hi) phase_inproj(p, smem);
#endif
  SEAM(1)
#if !defined(ONLY) || ONLY == 2
  if (lo <= 2 && 2 < hi) phase_gdnprep(p, smem);
#endif
  SEAM(2)
#if !defined(ONLY) || ONLY == 3
  if (lo <= 3 && 3 < hi) phase_mixer(p, smem, 0);
#endif
  SEAM(3)
#if !defined(ONLY) || ONLY == 4
  if (lo <= 4 && 4 < hi) phase_gout(p, smem);
#endif
  SEAM(4)
#if !defined(ONLY) || ONLY == 5
  if (lo <= 5 && 5 < hi) phase_outproj(p, smem);
#endif
  SEAM(5)
#if !defined(ONLY) || ONLY == 6
  if (lo <= 6 && 6 < hi) phase_gateup(p, smem);
#endif
  SEAM(6)
#if !defined(ONLY) || ONLY == 7
  if (lo <= 7 && 7 < hi) phase_down(p, smem);
#endif
  SEAM(7)
#if !defined(ONLY) || ONLY == 8
  if (lo <= 8 && 8 < hi) phase_ple(p, smem);
#endif
  SEAM(8)
  if (lo <= 9 && 9 < hi) phase_final(p);
}

static_assert(sizeof(GemmSmem) <= SMEM_MAIN && sizeof(Gemm2Smem) <= SMEM_MAIN && sizeof(GdnSmem) <= SMEM_MAIN && sizeof(ScanSmem) <= SMEM_MAIN &&
              sizeof(GoutSmem) <= SMEM_MAIN && sizeof(AttnSmem) <= SMEM_MAIN && 64 * 65 * 4 <= SMEM_MAIN, "smem");

extern "C" void kernel_launch(void* const* d_in, const int* in_sizes, int n_in, void* d_out, int out_size,
                              void* d_ws, size_t ws_size, hipStream_t stream) {
  static int grid_blocks = 0;
  if (!grid_blocks) {
    int dev = 0, cus = 0, per_cu = 0;
    hipGetDevice(&dev);
    hipDeviceGetAttribute(&cus, hipDeviceAttributeMultiprocessorCount, dev);
    hipOccupancyMaxActiveBlocksPerMultiprocessor(&per_cu, mega, 256, 0);
    if (per_cu > 2) per_cu = 2;
    if (per_cu < 1) per_cu = 1;
    grid_blocks = cus * per_cu;
  }
  P p{};
  const float* const* in = (const float* const*)d_in;
  p.x = in[0]; p.p = in[1]; p.attn_norm_w = in[2]; p.w_in = in[3]; p.conv_w = in[4]; p.a_log = in[5];
  p.dt_bias = in[6]; p.gdn_norm_w = in[7]; p.fox_f_bias = in[8]; p.w_out = in[9]; p.ffn_norm_w = in[10];
  p.w_gate_up = in[11]; p.w_down = in[12]; p.ple_norm_w = in[13]; p.w_ple_gate = in[14]; p.w_ple_proj = in[15];
  p.final_norm_w = in[16];
  p.h = (float*)d_out;
  unsigned char* ws = (unsigned char*)d_ws;
  size_t off = 0;
  auto take = [&](size_t bytes) { unsigned char* r = ws + off; off += (bytes + 255) & ~(size_t)255; return r; };
  p.counters = (unsigned*)take(256);
  p.bar = (unsigned*)take(XCD_BAR_WORDS * 4);
  p.wt_in = (u16*)take((size_t)NIN_PAD * 1024 * 2);
  p.wt_out = (u16*)take((size_t)1024 * 1024 * 2);
  p.wt_gu = (u16*)take((size_t)2 * DFF * 1024 * 2);
  p.wt_down = (u16*)take((size_t)1024 * DFF * 2);
  p.wt_pg = (u16*)take((size_t)1024 * 1024 * 2);
  p.wt_pp = (u16*)take((size_t)1024 * 256 * 2);
  p.actA = (u16*)take((size_t)NTOK * 1024 * 2);
  p.pb = (u16*)take((size_t)NTOK * 256 * 2);
  p.proj = (u16*)take((size_t)NTOK * PROJW * 2);
  p.vt = (u16*)take((size_t)64 * 64 * SEQ * 2);
  p.gates = (float*)take((size_t)NTOK * 16 * 4);
  p.cf = (float*)take((size_t)64 * SEQ * 4);
  p.gM = (u16*)take((size_t)1024 * 16384 * 2);
  p.gC = (u16*)take((size_t)1024 * 16384 * 2);
  p.gdl = (float*)take(1024 * 4);
  p.rss = (float*)take((size_t)3 * NTOK * 4);
  p.hb = p.gM;
  if (off > ws_size) fprintf(stderr, "workspace too small: need %zu have %zu\n", off, ws_size);
  u16* ob = (u16*)d_out;
  p.gS = ob;
  p.gQ = ob + (size_t)1024 * 16384;
  p.gO = ob + (size_t)1024 * 16384 + (size_t)1024 * 8192;
  hipMemsetAsync(p.bar, 0, XCD_BAR_WORDS * 4, stream);
  int lo = 0, hi = NPHASE;
  void* args[] = {&p, &lo, &hi};
  hipError_t e = hipLaunchCooperativeKernel((void*)mega, dim3(grid_blocks), dim3(256), args, 0, stream);
  if (e != hipSuccess) fprintf(stderr, "cooperative launch failed: %s (grid %d)\n", hipGetErrorString(e), grid_blocks);
}
```

```cpp
#include <hip/hip_runtime.h>
#include <hip/hip_cooperative_groups.h>
#include <cstdio>
#include <cstdint>
namespace cg = cooperative_groups;

typedef unsigned short u16;
typedef __attribute__((ext_vector_type(8))) short bf16x8;
typedef __attribute__((ext_vector_type(4))) float f32x4;

#define NTOK 16384
#define SEQ 2048
#define DM 1024
#define DFF 2816
#define PROJW 3072
#define NIN_PAD 3712
#define EPSV 1e-6f
#define NPHASE 10
#define SMEM_MAIN 73728

struct P {
  const float *x, *p, *attn_norm_w, *w_in, *conv_w, *a_log, *dt_bias, *gdn_norm_w, *fox_f_bias, *w_out,
      *ffn_norm_w, *w_gate_up, *w_down, *ple_norm_w, *w_ple_gate, *w_ple_proj, *final_norm_w;
  float* h;
  u16 *wt_in, *wt_out, *wt_gu, *wt_down, *wt_pg, *wt_pp;
  u16 *actA;
  u16 *pb;
  u16 *proj;
  u16 *vt;
  float *gates;
  float *cf;
  u16 *gM, *gC;
  u16 *gQ, *gO;
  u16 *gS;
  float *gdl;
  unsigned *counters;
  unsigned *bar;
  u16 *hb;
  float *rss;
};

typedef __attribute__((ext_vector_type(2))) float f32x2_t;
typedef __attribute__((ext_vector_type(2))) __bf16 bf16x2_t;
__device__ __forceinline__ u16 f2bf(float f) { return __builtin_bit_cast(u16, (__bf16)f); }
__device__ __forceinline__ float bf2f(u16 h) { return __uint_as_float(((unsigned)h) << 16); }
__device__ __forceinline__ unsigned pack2(float a, float b) {
  f32x2_t f = {a, b};
  return __builtin_bit_cast(unsigned, __builtin_convertvector(f, bf16x2_t));
}
__device__ __forceinline__ float siluf(float v) { return v / (1.f + __expf(-v)); }
__device__ __forceinline__ float sigmoidf_(float v) { return 1.f / (1.f + __expf(-v)); }
__device__ __forceinline__ f32x4 mfma16(bf16x8 a, bf16x8 b, f32x4 c) {
  return __builtin_amdgcn_mfma_f32_16x16x32_bf16(a, b, c, 0, 0, 0);
}
#define LDS_FENCE() asm volatile("s_waitcnt lgkmcnt(0)" ::: "memory")

__device__ __forceinline__ void unpack8(const uint4& v, float (&f)[8]) {
  f[0] = bf2f((u16)(v.x & 0xffffu)); f[1] = bf2f((u16)(v.x >> 16));
  f[2] = bf2f((u16)(v.y & 0xffffu)); f[3] = bf2f((u16)(v.y >> 16));
  f[4] = bf2f((u16)(v.z & 0xffffu)); f[5] = bf2f((u16)(v.z >> 16));
  f[6] = bf2f((u16)(v.w & 0xffffu)); f[7] = bf2f((u16)(v.w >> 16));
}
__device__ __forceinline__ void unpack4(const uint2& v, float (&f)[4]) {
  f[0] = bf2f((u16)(v.x & 0xffffu)); f[1] = bf2f((u16)(v.x >> 16));
  f[2] = bf2f((u16)(v.y & 0xffffu)); f[3] = bf2f((u16)(v.y >> 16));
}


__device__ __forceinline__ int colmap(int kind, int nn) {
  if (kind == 0) {
    if (nn < 2048) return nn;
    if (nn < 3584) return nn + 8;
    if (nn < 3588) return 2048 + (nn - 3584);
    if (nn < 3592) return 2052 + (nn - 3588);
    if (nn < 3600) return nn;
    return -1;
  } else if (kind == 2) {
    int i = nn >> 7, wc = (nn >> 6) & 1, u = (nn >> 5) & 1, j = nn & 31;
    return u * DFF + 64 * i + 32 * wc + j;
  }
  return nn;
}

__device__ void transpose_item(const float* __restrict__ src, int ldsrc, u16* __restrict__ dst, int K,
                               int kt, int nt, int kind, float* tile, const float* __restrict__ kscale = nullptr) {
  int tid = threadIdx.x;
  asm volatile("" : "+v"(tid));
  const int c = tid & 63, r0 = tid >> 6;
  const int ncol = colmap(kind, nt * 64 + c);
  float tv[16];
#pragma unroll
  for (int i = 0; i < 16; i++) {
    int r = r0 + 4 * i;
    tv[i] = (ncol >= 0) ? src[(size_t)(kt * 64 + r) * ldsrc + ncol] : 0.f;
  }
  if (kscale) {
#pragma unroll
    for (int i = 0; i < 16; i++) tv[i] *= kscale[kt * 64 + r0 + 4 * i];
  }
#pragma unroll
  for (int i = 0; i < 16; i++) tile[(r0 + 4 * i) * 65 + c] = tv[i];
  __syncthreads();
#pragma unroll 8
  for (int i = 0; i < 16; i++) {
    int rn = r0 + 4 * i;
    dst[(size_t)(nt * 64 + rn) * K + kt * 64 + c] = f2bf(tile[c * 65 + rn]);
  }
  __syncthreads();
}

__device__ __forceinline__ void rmsnorm_row(const float* src, const float* __restrict__ w,
                                            u16* dstb, float* dstf, int row) {
  const int lane = threadIdx.x & 63;
  float4 v[4];
  float ss = 0.f;
#pragma unroll
  for (int i = 0; i < 4; i++) {
    v[i] = *(const float4*)&src[(size_t)row * DM + i * 256 + lane * 4];
    ss += v[i].x * v[i].x + v[i].y * v[i].y + v[i].z * v[i].z + v[i].w * v[i].w;
  }
#pragma unroll
  for (int off = 32; off >= 1; off >>= 1) ss += __shfl_xor(ss, off);
  const float r = rsqrtf(ss * (1.f / DM) + EPSV);
#pragma unroll
  for (int i = 0; i < 4; i++) {
    const int col = i * 256 + lane * 4;
    float4 wv = *(const float4*)&w[col];
    float y0 = v[i].x * r * wv.x, y1 = v[i].y * r * wv.y, y2 = v[i].z * r * wv.z, y3 = v[i].w * r * wv.w;
    if (dstb) {
      uint2 o; o.x = pack2(y0, y1); o.y = pack2(y2, y3);
      *(uint2*)&dstb[(size_t)row * DM + col] = o;
    } else {
      *(float4*)&dstf[(size_t)row * DM + col] = make_float4(y0, y1, y2, y3);
    }
  }
}

__device__ void phase_prep(const P& p, unsigned char* smem) {
  float* tile = (float*)smem;
  if (blockIdx.x == 0 && threadIdx.x < 16) p.counters[threadIdx.x] = 0u;
  for (int i = blockIdx.x * 256 + threadIdx.x; i < 3 * NTOK; i += gridDim.x * 256) p.rss[i] = 0.f;
  for (int it = blockIdx.x; it < 16 * 58; it += gridDim.x) transpose_item(p.w_in, 3600, p.wt_in, 1024, it % 16, it / 16, 0, tile);
  const int wave = threadIdx.x >> 6, lane = threadIdx.x & 63;
  for (int rb = blockIdx.x; rb < NTOK / 8; rb += gridDim.x) {
    const int row = rb * 8 + wave * 2;
    float4 v0[4], v1[4];
#pragma unroll
    for (int i = 0; i < 4; i++) {
      v0[i] = *(const float4*)&p.x[(size_t)row * DM + i * 256 + lane * 4];
      v1[i] = *(const float4*)&p.x[(size_t)(row + 1) * DM + i * 256 + lane * 4];
    }
    const float4 pv0 = *(const float4*)&p.p[(size_t)row * 256 + lane * 4];
    const float4 pv1 = *(const float4*)&p.p[(size_t)(row + 1) * 256 + lane * 4];
    float s0 = 0.f, s1 = 0.f;
#pragma unroll
    for (int i = 0; i < 4; i++) {
      s0 += v0[i].x * v0[i].x + v0[i].y * v0[i].y + v0[i].z * v0[i].z + v0[i].w * v0[i].w;
      s1 += v1[i].x * v1[i].x + v1[i].y * v1[i].y + v1[i].z * v1[i].z + v1[i].w * v1[i].w;
    }
#pragma unroll
    for (int off = 32; off >= 1; off >>= 1) { s0 += __shfl_xor(s0, off); s1 += __shfl_xor(s1, off); }
    const float r0 = rsqrtf(s0 * (1.f / DM) + EPSV), r1 = rsqrtf(s1 * (1.f / DM) + EPSV);
#pragma unroll
    for (int i = 0; i < 4; i++) {
      const int col = i * 256 + lane * 4;
      const float4 wv = *(const float4*)&p.attn_norm_w[col];
      uint2 o;
      o.x = pack2(v0[i].x * r0 * wv.x, v0[i].y * r0 * wv.y); o.y = pack2(v0[i].z * r0 * wv.z, v0[i].w * r0 * wv.w);
      *(uint2*)&p.actA[(size_t)row * DM + col] = o;
      o.x = pack2(v1[i].x * r1 * wv.x, v1[i].y * r1 * wv.y); o.y = pack2(v1[i].z * r1 * wv.z, v1[i].w * r1 * wv.w);
      *(uint2*)&p.actA[(size_t)(row + 1) * DM + col] = o;
    }
    uint2 o; o.x = pack2(pv0.x, pv0.y); o.y = pack2(pv0.z, pv0.w);
    *(uint2*)&p.pb[(size_t)row * 256 + lane * 4] = o;
    o.x = pack2(pv1.x, pv1.y); o.y = pack2(pv1.z, pv1.w);
    *(uint2*)&p.pb[(size_t)(row + 1) * 256 + lane * 4] = o;
  }
}

__device__ void phase_rmsnorm(const float* src, const float* w, u16* dstb, float* dstf) {
  const int wave = threadIdx.x >> 6;
  for (int rb = blockIdx.x; rb < NTOK / 4; rb += gridDim.x) rmsnorm_row(src, w, dstb, dstf, rb * 4 + wave);
}

__device__ void phase_final(const P& p) {
  const int wave = threadIdx.x >> 6, lane = threadIdx.x & 63;
  for (int rb = blockIdx.x; rb < NTOK / 4; rb += gridDim.x) {
    const int row = rb * 4 + wave;
    const float r = rsqrtf(p.rss[2 * NTOK + row] * (1.f / DM) + EPSV);
#pragma unroll
    for (int i = 0; i < 4; i++) {
      const int col = i * 256 + lane * 4;
      float4 v = *(const float4*)&p.h[(size_t)row * DM + col];
      const float4 wv = *(const float4*)&p.final_norm_w[col];
      v.x *= r * wv.x; v.y *= r * wv.y; v.z *= r * wv.z; v.w *= r * wv.w;
      *(float4*)&p.h[(size_t)row * DM + col] = v;
    }
  }
}

#define GK 64
struct GemmSmem { u16 a[2][128 * GK]; u16 b[2][128 * GK]; };

template <bool SWAP>
__device__ __forceinline__ void gemm_tile(const u16* __restrict__ A, int lda, const u16* __restrict__ Bt, int ldb,
                                          int K, int m0, int n0, GemmSmem& s, f32x4 (&acc)[4][4]) {
  int tid = threadIdx.x;
  asm volatile("" : "+v"(tid));
  const int lane = tid & 63, wave = tid >> 6;
  const int wr = wave >> 1, wc = wave & 1;
  const int l15 = lane & 15, g = lane >> 4;
  const int nk = K / GK;
  const int drow = 8 * wave + (lane >> 3);
  const int dchunk = (lane & 7) ^ ((4 * (wave & 1) + (lane >> 4)) & 7);
  const u16* Ap = A + (size_t)(m0 + drow) * lda + dchunk * 8;
  const u16* Bp = Bt + (size_t)(n0 + drow) * ldb + dchunk * 8;
  const size_t sa = (size_t)32 * lda, sb = (size_t)32 * ldb;
#define G_DMA(bufi, koff) do { \
    _Pragma("unroll") for (int _i = 0; _i < 4; _i++) { \
      __builtin_amdgcn_global_load_lds((const unsigned*)(Ap + _i * sa + (koff)), (unsigned*)&s.a[bufi][(32 * _i + 8 * wave) * GK], 16, 0, 0); \
      __builtin_amdgcn_global_load_lds((const unsigned*)(Bp + _i * sb + (koff)), (unsigned*)&s.b[bufi][(32 * _i + 8 * wave) * GK], 16, 0, 0); \
    } } while (0)
  const int fo0 = l15 * GK + ((g ^ (l15 >> 1)) * 8);
  const int fo1 = l15 * GK + (((4 + g) ^ (l15 >> 1)) * 8);
  G_DMA(0, 0);
  asm volatile("s_waitcnt vmcnt(0)" ::: "memory");
  __builtin_amdgcn_s_barrier();
  asm volatile("" ::: "memory");
  for (int kt = 0; kt < nk; kt++) {
    const int buf = kt & 1;
    if (kt + 1 < nk) { if (buf) G_DMA(0, (kt + 1) * GK); else G_DMA(1, (kt + 1) * GK); }
    const u16* sa_ = &s.a[buf][(wr * 64) * GK];
    const u16* sb_ = &s.b[buf][(wc * 64) * GK];
#pragma unroll
    for (int ks = 0; ks < 2; ks++) {
      const int fo = ks ? fo1 : fo0;
      bf16x8 af[4], bfr[4];
#pragma unroll
      for (int mi = 0; mi < 4; mi++) af[mi] = *(const bf16x8*)&sa_[mi * 16 * GK + fo];
#pragma unroll
      for (int ni = 0; ni < 4; ni++) bfr[ni] = *(const bf16x8*)&sb_[ni * 16 * GK + fo];
#pragma unroll
      for (int mi = 0; mi < 4; mi++)
#pragma unroll
        for (int ni = 0; ni < 4; ni++) acc[mi][ni] = SWAP ? mfma16(bfr[ni], af[mi], acc[mi][ni]) : mfma16(af[mi], bfr[ni], acc[mi][ni]);
    }
    asm volatile("s_waitcnt vmcnt(0) lgkmcnt(0)" ::: "memory");
    __builtin_amdgcn_s_barrier();
    asm volatile("" ::: "memory");
  }
}


#define G2K 32
struct Gemm2Smem { u16 a[3][256 * G2K]; u16 b[3][128 * G2K]; };

template <bool SWAP>
__device__ __forceinline__ void gemm256(const u16* __restrict__ A, int lda, const u16* __restrict__ Bt, int ldb,
                                        int K, int m0, int n0, Gemm2Smem& s, f32x4 (&acc)[8][4]) {
  int tid = threadIdx.x;
  asm volatile("" : "+v"(tid));
  const int lane = tid & 63, wave = tid >> 6;
  const int wr = wave >> 1, wc = wave & 1;
  const int l15 = lane & 15, g = lane >> 4;
  const int nk = K / G2K;
  const int drow = 16 * wave + (lane >> 2);
  const int dchunk = (lane & 3) ^ g;
  const u16* Ap = A + (size_t)(m0 + drow) * lda + dchunk * 8;
  const u16* Bp = Bt + (size_t)(n0 + drow) * ldb + dchunk * 8;
  const size_t sa = (size_t)64 * lda, sb = (size_t)64 * ldb;
  u16* const sa0 = &s.a[0][0] + (16 * wave) * G2K;
  u16* const sb0 = &s.b[0][0] + (16 * wave) * G2K;
#define G2_DMA(st, koff) do { \
    u16* _da = sa0 + (st) * (256 * G2K); u16* _db = sb0 + (st) * (128 * G2K); \
    _Pragma("unroll") for (int _i = 0; _i < 4; _i++) \
      __builtin_amdgcn_global_load_lds((const unsigned*)(Ap + _i * sa + (koff)), (unsigned*)(_da + 64 * _i * G2K), 16, 0, 0); \
    _Pragma("unroll") for (int _i = 0; _i < 2; _i++) \
      __builtin_amdgcn_global_load_lds((const unsigned*)(Bp + _i * sb + (koff)), (unsigned*)(_db + 64 * _i * G2K), 16, 0, 0); \
  } while (0)
  const int fo = l15 * G2K + ((g ^ ((l15 >> 2) & 3)) * 8);
  asm volatile("s_waitcnt lgkmcnt(0)" ::: "memory");
  __builtin_amdgcn_s_barrier();
  asm volatile("" ::: "memory");
#pragma unroll 1
  for (int j = 0; j < 2; j++) G2_DMA(j, j * G2K);
  int st = 0;
  for (int kt = 0; kt < nk; kt++) {
    if (kt + 1 < nk) asm volatile("s_waitcnt vmcnt(6)" ::: "memory");
    else asm volatile("s_waitcnt vmcnt(0)" ::: "memory");
    __builtin_amdgcn_s_barrier();
    asm volatile("" ::: "memory");
    if (kt + 2 < nk) {
      const int st2 = (st >= 1) ? st - 1 : 2;
      G2_DMA(st2, (kt + 2) * G2K);
    }
    const u16* sa_ = &s.a[0][0] + st * (256 * G2K) + (wr * 128) * G2K + fo;
    const u16* sb_ = &s.b[0][0] + st * (128 * G2K) + (wc * 64) * G2K + fo;
    bf16x8 af[8], bfr[4];
#pragma unroll
    for (int mi = 0; mi < 8; mi++) af[mi] = *(const bf16x8*)&sa_[mi * 16 * G2K];
#pragma unroll
    for (int ni = 0; ni < 4; ni++) bfr[ni] = *(const bf16x8*)&sb_[ni * 16 * G2K];
#pragma unroll
    for (int mi = 0; mi < 8; mi++)
#pragma unroll
      for (int ni = 0; ni < 4; ni++) acc[mi][ni] = SWAP ? mfma16(bfr[ni], af[mi], acc[mi][ni]) : mfma16(af[mi], bfr[ni], acc[mi][ni]);
    st = (st == 2) ? 0 : st + 1;
  }
}
#define ZERO_ACC8(acc) _Pragma("unroll") for (int _i = 0; _i < 8; _i++) _Pragma("unroll") for (int _j = 0; _j < 4; _j++) acc[_i][_j] = (f32x4){0.f, 0.f, 0.f, 0.f};

#define ZERO_ACC(acc) _Pragma("unroll") for (int _i = 0; _i < 4; _i++) _Pragma("unroll") for (int _j = 0; _j < 4; _j++) acc[_i][_j] = (f32x4){0.f, 0.f, 0.f, 0.f};

template <int NMI>
__device__ __forceinline__ void row_sumsq_add(f32x4 (&sq)[NMI][4], float* rss, int row0, int l15, int g) {
#pragma unroll
  for (int mi = 0; mi < NMI; mi++) {
    float v = 0.f;
#pragma unroll
    for (int ni = 0; ni < 4; ni++) v += (sq[mi][ni][0] + sq[mi][ni][1]) + (sq[mi][ni][2] + sq[mi][ni][3]);
    v += __shfl_xor(v, 16);
    v += __shfl_xor(v, 32);
    if (g == 0) atomicAdd(&rss[row0 + mi * 16 + l15], v);
  }
}

__device__ void phase_inproj(const P& p, unsigned char* smem) {
  Gemm2Smem& s = *(Gemm2Smem*)smem;
  const int lane = threadIdx.x & 63, wave = threadIdx.x >> 6, wr = wave >> 1, wc = wave & 1, l15 = lane & 15, g = lane >> 4;
  const int ntiles = 64 * 29;
  for (int tl = blockIdx.x; tl < ntiles; tl += gridDim.x) {
    const int mt = tl & 63, nt = tl >> 6;
    const int m0 = mt * 256, n0 = nt * 128;
    f32x4 acc[8][4];
    ZERO_ACC8(acc);
    if (nt >= 24 && nt < 28) {
      gemm256<false>(p.actA, DM, p.wt_in, DM, DM, m0, n0, s, acc);
#pragma unroll
      for (int mi = 0; mi < 8; mi++)
#pragma unroll
        for (int ni = 0; ni < 4; ni++) {
          const int rowb = m0 + wr * 128 + mi * 16 + g * 4;
          const int col = n0 + wc * 64 + ni * 16 + l15;
          const int cc = col - 3072, hh = cc >> 6, d = cc & 63;
          const int b = rowb >> 11, sq = rowb & 2047;
          uint2 o; o.x = pack2(acc[mi][ni][0], acc[mi][ni][1]); o.y = pack2(acc[mi][ni][2], acc[mi][ni][3]);
          *(uint2*)&p.vt[((size_t)((b * 8 + hh) * 64 + d)) * SEQ + sq] = o;
        }
    } else {
      gemm256<true>(p.actA, DM, p.wt_in, DM, DM, m0, n0, s, acc);
#pragma unroll
      for (int mi = 0; mi < 8; mi++)
#pragma unroll
        for (int ni = 0; ni < 4; ni++) {
          const int row = m0 + wr * 128 + mi * 16 + l15;
          const int col = n0 + wc * 64 + ni * 16 + g * 4;
          if (nt < 24) {
            uint2 o; o.x = pack2(acc[mi][ni][0], acc[mi][ni][1]); o.y = pack2(acc[mi][ni][2], acc[mi][ni][3]);
            *(uint2*)&p.proj[(size_t)row * PROJW + col] = o;
          } else if (col < 3600) {
            *(float4*)&p.gates[(size_t)row * 16 + (col - 3584)] = make_float4(acc[mi][ni][0], acc[mi][ni][1], acc[mi][ni][2], acc[mi][ni][3]);
          }
        }
    }
  }
}

__device__ void phase_outproj(const P& p, unsigned char* smem) {
  Gemm2Smem& s = *(Gemm2Smem*)smem;
  const int lane = threadIdx.x & 63, wave = threadIdx.x >> 6, wr = wave >> 1, wc = wave & 1, l15 = lane & 15, g = lane >> 4;
  for (int tl = blockIdx.x; tl < 64 * 8; tl += gridDim.x) {
    const int mt = tl & 63, nt = tl >> 6;
    const int m0 = mt * 256, n0 = nt * 128;
    f32x4 acc[8][4];
    ZERO_ACC8(acc);
    gemm256<true>(p.actA, DM, p.wt_out, DM, DM, m0, n0, s, acc);
#pragma unroll
    for (int mi = 0; mi < 8; mi++)
#pragma unroll
      for (int ni = 0; ni < 4; ni++) {
        const size_t idx = (size_t)(m0 + wr * 128 + mi * 16 + l15) * DM + n0 + wc * 64 + ni * 16 + g * 4;
        const float4 xv = *(const float4*)&p.x[idx];
        const float h0 = xv.x + acc[mi][ni][0], h1 = xv.y + acc[mi][ni][1], h2 = xv.z + acc[mi][ni][2], h3 = xv.w + acc[mi][ni][3];
        uint2 o; o.x = pack2(h0, h1); o.y = pack2(h2, h3);
        *(uint2*)&p.hb[idx] = o;
        acc[mi][ni] = (f32x4){h0 * h0, h1 * h1, h2 * h2, h3 * h3};
      }
    row_sumsq_add(acc, p.rss, m0 + wr * 128, l15, g);
  }
}

__device__ void phase_gateup(const P& p, unsigned char* smem) {
  Gemm2Smem& s = *(Gemm2Smem*)smem;
  u16* act = p.proj;
  const int lane = threadIdx.x & 63, wave = threadIdx.x >> 6, wr = wave >> 1, wc = wave & 1, l15 = lane & 15, g = lane >> 4;
  for (int tl = blockIdx.x; tl < 64 * 44; tl += gridDim.x) {
    const int mt = tl & 63, nt = tl >> 6;
    const int m0 = mt * 256, n0 = nt * 128;
    f32x4 acc[8][4];
    ZERO_ACC8(acc);
    gemm256<true>(p.hb, DM, p.wt_gu, DM, DM, m0, n0, s, acc);
#pragma unroll
    for (int mi = 0; mi < 8; mi++) {
      const int row = m0 + wr * 128 + mi * 16 + l15;
      const float rs = rsqrtf(p.rss[row] * (1.f / DM) + EPSV);
#pragma unroll
      for (int ni = 0; ni < 2; ni++) {
        const int col = 64 * nt + 32 * wc + 16 * ni + g * 4;
        float v[4];
#pragma unroll
        for (int r = 0; r < 4; r++) v[r] = siluf(acc[mi][ni][r] * rs) * (acc[mi][ni + 2][r] * rs);
        uint2 o; o.x = pack2(v[0], v[1]); o.y = pack2(v[2], v[3]);
        *(uint2*)&act[(size_t)row * DFF + col] = o;
      }
    }
  }
}

__device__ void phase_down(const P& p, unsigned char* smem) {
  Gemm2Smem& s = *(Gemm2Smem*)smem;
  const u16* act = p.proj;
  const int lane = threadIdx.x & 63, wave = threadIdx.x >> 6, wr = wave >> 1, wc = wave & 1, l15 = lane & 15, g = lane >> 4;
  for (int tl = blockIdx.x; tl < 64 * 8; tl += gridDim.x) {
    const int mt = tl & 63, nt = tl >> 6;
    const int m0 = mt * 256, n0 = nt * 128;
    f32x4 acc[8][4];
    ZERO_ACC8(acc);
    gemm256<true>(act, DFF, p.wt_down, DFF, DFF, m0, n0, s, acc);
#pragma unroll
    for (int mi = 0; mi < 8; mi++)
#pragma unroll
      for (int ni = 0; ni < 4; ni++) {
        const size_t idx = (size_t)(m0 + wr * 128 + mi * 16 + l15) * DM + n0 + wc * 64 + ni * 16 + g * 4;
        float hp[4];
        unpack4(*(const uint2*)&p.hb[idx], hp);
        const float h0 = hp[0] + acc[mi][ni][0], h1 = hp[1] + acc[mi][ni][1], h2 = hp[2] + acc[mi][ni][2], h3 = hp[3] + acc[mi][ni][3];
        uint2 o; o.x = pack2(h0, h1); o.y = pack2(h2, h3);
        *(uint2*)&p.actA[idx] = o;
        acc[mi][ni] = (f32x4){h0 * h0, h1 * h1, h2 * h2, h3 * h3};
      }
    row_sumsq_add(acc, p.rss + NTOK, m0 + wr * 128, l15, g);
  }
}

__device__ void phase_ple(const P& p, unsigned char* smem) {
  GemmSmem& s = *(GemmSmem*)smem;
  const int lane = threadIdx.x & 63, wave = threadIdx.x >> 6, wr = wave >> 1, wc = wave & 1, l15 = lane & 15, g = lane >> 4;
  for (int tl = blockIdx.x; tl < 128 * 8; tl += gridDim.x) {
    const int mt = tl & 127, nt = tl >> 7;
    const int m0 = mt * 128, n0 = nt * 128;
    f32x4 acc[4][4], acc2[4][4];
    ZERO_ACC(acc);
    gemm_tile<true>(p.actA, DM, p.wt_pg, DM, DM, m0, n0, s, acc);
#pragma unroll
    for (int mi = 0; mi < 4; mi++) {
      const float rs = rsqrtf(p.rss[NTOK + m0 + wr * 64 + mi * 16 + l15] * (1.f / DM) + EPSV);
#pragma unroll
      for (int ni = 0; ni < 4; ni++)
#pragma unroll
        for (int r = 0; r < 4; r++) acc[mi][ni][r] = sigmoidf_(acc[mi][ni][r] * rs);
    }
    ZERO_ACC(acc2);
    gemm_tile<true>(p.pb, 256, p.wt_pp, 256, 256, m0, n0, s, acc2);
#pragma unroll
    for (int mi = 0; mi < 4; mi++)
#pragma unroll
      for (int ni = 0; ni < 4; ni++) {
        const size_t idx = (size_t)(m0 + wr * 64 + mi * 16 + l15) * DM + n0 + wc * 64 + ni * 16 + g * 4;
        float hp[4];
        unpack4(*(const uint2*)&p.actA[idx], hp);
        const float h0 = hp[0] + acc[mi][ni][0] * acc2[mi][ni][0], h1 = hp[1] + acc[mi][ni][1] * acc2[mi][ni][1];
        const float h2 = hp[2] + acc[mi][ni][2] * acc2[mi][ni][2], h3 = hp[3] + acc[mi][ni][3] * acc2[mi][ni][3];
        *(float4*)&p.h[idx] = make_float4(h0, h1, h2, h3);
        acc2[mi][ni] = (f32x4){h0 * h0, h1 * h1, h2 * h2, h3 * h3};
      }
    row_sumsq_add(acc2, p.rss + 2 * NTOK, m0 + wr * 64, l15, g);
  }
}

#define QLD 136
#define KLD 72
struct GdnSmem {
  u16 qb[64 * QLD];
  u16 kn[64 * QLD];
  u16 vb[64 * QLD];
  float Am[64 * 64];
  float gc[64], beta[64], be[64];
};
static_assert(offsetof(GdnSmem, kn) == 17408 && offsetof(GdnSmem, vb) == 34816 && offsetof(GdnSmem, Am) == 52224, "layout");


__device__ void gdn_unit(const P& p, int unit, GdnSmem& s) {
  int tid = threadIdx.x;
  asm volatile("" : "+v"(tid));
  int lane = tid & 63, wave = tid >> 6;
  int l15 = lane & 15, g = lane >> 4;
#define GDN_REFRESH() do { tid = threadIdx.x; asm volatile("" : "+v"(tid) :: "memory"); lane = tid & 63; wave = tid >> 6; l15 = lane & 15; g = lane >> 4; } while (0)
  const int bh = unit >> 5, n = unit & 31;
  const int b = bh >> 2, h = bh & 3;
  const int tb = b * SEQ;
  const int s0 = n * 64;
  u16* const qk_s = s.qb;
  u16* const WU = s.kn;
  u16* const kdT = (u16*)((unsigned char*)s.kn + 32768);
  __syncthreads();
  if (wave == 0) {
    const int t = tb + s0 + lane;
    const float ga = p.gates[(size_t)t * 16 + h], gb = p.gates[(size_t)t * 16 + 4 + h];
    const float xx = ga + p.dt_bias[h];
    const float sp = (xx > 20.f) ? xx : log1pf(__expf(xx));
    float gg = -__expf(p.a_log[h]) * sp;
#pragma unroll
    for (int off = 1; off < 64; off <<= 1) {
      float nb = __shfl_up(gg, off);
      if (lane >= off) gg += nb;
    }
    const float bt = sigmoidf_(gb);
    s.gc[lane] = gg;
    s.beta[lane] = bt;
    s.be[lane] = bt * __expf(gg);
  }
  {
    const int ch = tid & 15, rg = tid >> 4;
#pragma unroll 1
    for (int mat = 0; mat < 3; mat++) {
      const int col0 = mat * 512 + h * 128 + ch * 8;
      float cw[4][8];
#pragma unroll
      for (int k = 0; k < 4; k++) {
        const float4 w0 = *(const float4*)&p.conv_w[k * 1536 + col0];
        const float4 w1 = *(const float4*)&p.conv_w[k * 1536 + col0 + 4];
        cw[k][0] = w0.x; cw[k][1] = w0.y; cw[k][2] = w0.z; cw[k][3] = w0.w;
        cw[k][4] = w1.x; cw[k][5] = w1.y; cw[k][6] = w1.z; cw[k][7] = w1.w;
      }
      uint4 xr[7];
#pragma unroll
      for (int j = 0; j < 7; j++) {
        const int sp = s0 + 4 * rg + j - 3;
        xr[j] = (sp >= 0) ? *(const uint4*)&p.proj[(size_t)(tb + sp) * PROJW + col0] : make_uint4(0u, 0u, 0u, 0u);
      }
      float xf[7][8];
#pragma unroll
      for (int j = 0; j < 7; j++) unpack8(xr[j], xf[j]);
      u16* dst = (mat == 0) ? s.qb : ((mat == 1) ? s.kn : s.vb);
#pragma unroll
      for (int r = 0; r < 4; r++) {
        float val[8];
        float ss = 0.f;
#pragma unroll
        for (int c = 0; c < 8; c++) {
          const float cv = cw[0][c] * xf[r][c] + cw[1][c] * xf[r + 1][c] + cw[2][c] * xf[r + 2][c] + cw[3][c] * xf[r + 3][c];
          val[c] = siluf(cv);
          ss += val[c] * val[c];
        }
        float rs = 1.f;
        if (mat < 2) {
#pragma unroll
          for (int off = 1; off < 16; off <<= 1) ss += __shfl_xor(ss, off);
          rs = rsqrtf(ss + EPSV) * ((mat == 0) ? 0.08838834764831845f : 1.f);
        }
        uint4 o;
        o.x = pack2(val[0] * rs, val[1] * rs); o.y = pack2(val[2] * rs, val[3] * rs);
        o.z = pack2(val[4] * rs, val[5] * rs); o.w = pack2(val[6] * rs, val[7] * rs);
        *(uint4*)&dst[(4 * rg + r) * QLD + ch * 8] = o;
      }
    }
  }
  __syncthreads();
  GDN_REFRESH();
  u16* const gQ = p.gQ + (size_t)unit * 8192;
  {
#pragma unroll
    for (int it = 0; it < 4; it++) {
      const int idx = tid + 256 * it;
      const int i = idx >> 4, d8 = (idx & 15) * 8;
      const float e = __expf(s.gc[i]);
      float f[8];
      unpack8(*(const uint4*)&s.qb[i * QLD + d8], f);
      uint4 o;
      o.x = pack2(f[0] * e, f[1] * e); o.y = pack2(f[2] * e, f[3] * e);
      o.z = pack2(f[4] * e, f[5] * e); o.w = pack2(f[6] * e, f[7] * e);
      *(uint4*)&gQ[i * 128 + d8] = o;
    }
  }
  f32x4 cqk[4];
  {
    bf16x8 aq[4], ak[4];
#pragma unroll
    for (int ks = 0; ks < 4; ks++) {
      aq[ks] = *(const bf16x8*)&s.qb[(wave * 16 + l15) * QLD + ks * 32 + g * 8];
      ak[ks] = *(const bf16x8*)&s.kn[(wave * 16 + l15) * QLD + ks * 32 + g * 8];
    }
#pragma unroll
    for (int ni = 0; ni < 4; ni++) {
      f32x4 ckk = {0.f, 0.f, 0.f, 0.f};
      cqk[ni] = (f32x4){0.f, 0.f, 0.f, 0.f};
      if (ni <= wave) {
#pragma unroll
        for (int ks = 0; ks < 4; ks++) {
          bf16x8 bk = *(const bf16x8*)&s.kn[(ni * 16 + l15) * QLD + ks * 32 + g * 8];
          ckk = mfma16(ak[ks], bk, ckk);
          cqk[ni] = mfma16(aq[ks], bk, cqk[ni]);
        }
      }
      const int j = ni * 16 + l15;
      const float gcj = s.gc[j];
#pragma unroll
      for (int r = 0; r < 4; r++) {
        const int i = wave * 16 + g * 4 + r;
        const float dec = (i >= j) ? __expf(s.gc[i] - gcj) : 0.f;
        s.Am[i * 64 + j] = (i > j) ? ckk[r] * s.beta[i] * dec : 0.f;
        cqk[ni][r] = (i >= j) ? cqk[ni][r] * dec : 0.f;
      }
    }
  }
  __syncthreads();
  GDN_REFRESH();
#pragma unroll
  for (int ni = 0; ni < 4; ni++)
#pragma unroll
    for (int r = 0; r < 4; r++) qk_s[(wave * 16 + g * 4 + r) * KLD + ni * 16 + l15] = f2bf(cqk[ni][r]);
  float xs[64];
#ifdef NO_SOLVE
  for (int i = 0; i < 64; i++) xs[i] = s.Am[i*64+tid%64];
#else
  {
    const int c = tid;
    const u16* src = (c < 128) ? &s.vb[c] : &s.kn[c - 128];
    const float* sc = (c < 128) ? s.beta : s.be;
#pragma unroll
    for (int i = 0; i < 64; i++) {
      float a0 = bf2f(src[i * QLD]) * sc[i], a1 = 0.f, a2 = 0.f, a3 = 0.f;
#pragma unroll
      for (int j4 = 0; j4 < (i + 3) / 4; j4++) {
        const float4 av = *(const float4*)&s.Am[i * 64 + j4 * 4];
        if (j4 * 4 + 0 < i) a0 -= av.x * xs[j4 * 4 + 0];
        if (j4 * 4 + 1 < i) a1 -= av.y * xs[j4 * 4 + 1];
        if (j4 * 4 + 2 < i) a2 -= av.z * xs[j4 * 4 + 2];
        if (j4 * 4 + 3 < i) a3 -= av.w * xs[j4 * 4 + 3];
      }
      xs[i] = (a0 + a1) + (a2 + a3);
      asm volatile("" : "+v"(xs[i]) :: "memory");
    }
  }
#endif
  const float glast = s.gc[63];
  __syncthreads();
  GDN_REFRESH();
  {
    const int d = tid & 127, half = tid >> 7;
#pragma unroll
    for (int q = 0; q < 4; q++) {
      unsigned ow[4];
#pragma unroll
      for (int e2 = 0; e2 < 4; e2++) {
        const int c0 = half * 32 + q * 8 + e2 * 2;
        const float v0 = bf2f(s.kn[c0 * QLD + d]) * __expf(glast - s.gc[c0]);
        const float v1 = bf2f(s.kn[(c0 + 1) * QLD + d]) * __expf(glast - s.gc[c0 + 1]);
        ow[e2] = pack2(v0, v1);
      }
      *(uint4*)&kdT[d * KLD + half * 32 + q * 8] = make_uint4(ow[0], ow[1], ow[2], ow[3]);
    }
    if (tid == 0) p.gdl[unit] = __expf(glast);
  }
  __syncthreads();
  GDN_REFRESH();
  if (tid >= 128) {
#pragma unroll
    for (int q = 0; q < 8; q++)
      *(uint4*)&WU[(tid - 128) * KLD + q * 8] = make_uint4(pack2(xs[q * 8], xs[q * 8 + 1]), pack2(xs[q * 8 + 2], xs[q * 8 + 3]),
                                                            pack2(xs[q * 8 + 4], xs[q * 8 + 5]), pack2(xs[q * 8 + 6], xs[q * 8 + 7]));
  }
  __syncthreads();
  GDN_REFRESH();
  {
    u16* const gM = p.gM + (size_t)unit * 16384;
    bf16x8 aw[2][2];
#pragma unroll
    for (int mm = 0; mm < 2; mm++)
#pragma unroll
      for (int ks = 0; ks < 2; ks++) aw[mm][ks] = *(const bf16x8*)&WU[((2 * wave + mm) * 16 + l15) * KLD + ks * 32 + g * 8];
#pragma unroll
    for (int nn = 0; nn < 8; nn++) {
      const bf16x8 b0 = *(const bf16x8*)&kdT[(nn * 16 + l15) * KLD + g * 8];
      const bf16x8 b1 = *(const bf16x8*)&kdT[(nn * 16 + l15) * KLD + 32 + g * 8];
#pragma unroll
      for (int mm = 0; mm < 2; mm++) {
        f32x4 acc = {0.f, 0.f, 0.f, 0.f};
        acc = mfma16(aw[mm][0], b0, acc);
        acc = mfma16(aw[mm][1], b1, acc);
        uint2 o; o.x = pack2(-acc[0], -acc[1]); o.y = pack2(-acc[2], -acc[3]);
        *(uint2*)&gM[(nn * 16 + l15) * 128 + (2 * wave + mm) * 16 + 4 * g] = o;
      }
    }
#pragma unroll
    for (int nn = 0; nn < 4; nn++) {
      const bf16x8 b0 = *(const bf16x8*)&qk_s[(nn * 16 + l15) * KLD + g * 8];
      const bf16x8 b1 = *(const bf16x8*)&qk_s[(nn * 16 + l15) * KLD + 32 + g * 8];
#pragma unroll
      for (int mm = 0; mm < 2; mm++) {
        f32x4 acc = {0.f, 0.f, 0.f, 0.f};
        acc = mfma16(aw[mm][0], b0, acc);
        acc = mfma16(aw[mm][1], b1, acc);
        u16* qp = &gQ[(nn * 16 + l15) * 128 + (2 * wave + mm) * 16 + 4 * g];
        float qv[4];
        unpack4(*(const uint2*)qp, qv);
        uint2 o; o.x = pack2(qv[0] - acc[0], qv[1] - acc[1]); o.y = pack2(qv[2] - acc[2], qv[3] - acc[3]);
        *(uint2*)qp = o;
      }
    }
  }
  __syncthreads();
  GDN_REFRESH();
  if (tid < 128) {
#pragma unroll
    for (int q = 0; q < 8; q++)
      *(uint4*)&WU[tid * KLD + q * 8] = make_uint4(pack2(xs[q * 8], xs[q * 8 + 1]), pack2(xs[q * 8 + 2], xs[q * 8 + 3]),
                                                    pack2(xs[q * 8 + 4], xs[q * 8 + 5]), pack2(xs[q * 8 + 6], xs[q * 8 + 7]));
  }
  __syncthreads();
  GDN_REFRESH();
  {
    u16* const gC = p.gC + (size_t)unit * 16384;
    u16* const gO = p.gO + (size_t)unit * 8192;
    bf16x8 akd[2][2], aqk[2];
#pragma unroll
    for (int mm = 0; mm < 2; mm++)
#pragma unroll
      for (int ks = 0; ks < 2; ks++) akd[mm][ks] = *(const bf16x8*)&kdT[((2 * wave + mm) * 16 + l15) * KLD + ks * 32 + g * 8];
#pragma unroll
    for (int ks = 0; ks < 2; ks++) aqk[ks] = *(const bf16x8*)&qk_s[(wave * 16 + l15) * KLD + ks * 32 + g * 8];
#pragma unroll
    for (int nn = 0; nn < 8; nn++) {
      const bf16x8 b0 = *(const bf16x8*)&WU[(nn * 16 + l15) * KLD + g * 8];
      const bf16x8 b1 = *(const bf16x8*)&WU[(nn * 16 + l15) * KLD + 32 + g * 8];
#pragma unroll
      for (int mm = 0; mm < 2; mm++) {
        f32x4 acc = {0.f, 0.f, 0.f, 0.f};
        acc = mfma16(akd[mm][0], b0, acc);
        acc = mfma16(akd[mm][1], b1, acc);
        uint2 o; o.x = pack2(acc[0], acc[1]); o.y = pack2(acc[2], acc[3]);
        *(uint2*)&gC[(nn * 16 + l15) * 128 + (2 * wave + mm) * 16 + 4 * g] = o;
      }
      {
        f32x4 acc = {0.f, 0.f, 0.f, 0.f};
        acc = mfma16(aqk[0], b0, acc);
        acc = mfma16(aqk[1], b1, acc);
        uint2 o; o.x = pack2(acc[0], acc[1]); o.y = pack2(acc[2], acc[3]);
        *(uint2*)&gO[(nn * 16 + l15) * 64 + wave * 16 + 4 * g] = o;
      }
    }
  }
}

__device__ void fox_cumsum_unit(const P& p, int bhf, float* red) {
  const int tid = threadIdx.x, lane = tid & 63, wave = tid >> 6;
  const int b = bhf >> 3, hf = bhf & 7;
  const float bias = p.fox_f_bias[hf];
  float v[8];
  float run = 0.f;
#pragma unroll
  for (int i = 0; i < 8; i++) {
    const int t = b * SEQ + tid * 8 + i;
    const float xx = p.gates[(size_t)t * 16 + 8 + hf] + bias;
    const float ls = fminf(xx, 0.f) - log1pf(__expf(-fabsf(xx)));
    run += ls;
    v[i] = run;
  }
  float tot = run;
#pragma unroll
  for (int off = 1; off < 64; off <<= 1) {
    float nb = __shfl_up(tot, off);
    if (lane >= off) tot += nb;
  }
  __syncthreads();
  if (lane == 63) red[wave] = tot;
  __syncthreads();
  float base = tot - run;
  for (int w = 0; w < wave; w++) base += red[w];
#pragma unroll
  for (int i = 0; i < 8; i++) p.cf[(size_t)bhf * SEQ + tid * 8 + i] = v[i] + base;
}

__device__ void phase_gdnprep(const P& p, unsigned char* smem) {
  GdnSmem& s = *(GdnSmem*)smem;
  for (int u = blockIdx.x; u < 1024 + 64; u += gridDim.x) {
    if (u < 1024) gdn_unit(p, u, s);
    else { __syncthreads(); fox_cumsum_unit(p, u - 1024, (float*)smem); }
  }
}

#define SLD 136
#define NSCAN 128
struct ScanSmem { u16 st[2][32 * SLD]; };
struct ScanSet { bf16x8 mf[2][4]; uint2 ci[2][2]; float dl; };

__device__ __forceinline__ void scan_load(const P& p, int unit, int eq, int w, int l15, int g, ScanSet& z) {
  int la = (32 * w + l15) * 128 + 8 * g, lc = (32 * eq + l15) * 128 + 32 * w + 4 * g;
  asm volatile("" : "+v"(la), "+v"(lc));
  const u16* gM = p.gM + (size_t)unit * 16384;
  const u16* gC = p.gC + (size_t)unit * 16384;
#pragma unroll
  for (int md = 0; md < 2; md++)
#pragma unroll
    for (int ks = 0; ks < 4; ks++) z.mf[md][ks] = *(const bf16x8*)&gM[la + md * 16 * 128 + ks * 32];
#pragma unroll
  for (int md = 0; md < 2; md++)
#pragma unroll
    for (int ne = 0; ne < 2; ne++) z.ci[md][ne] = *(const uint2*)&gC[lc + ne * 16 * 128 + md * 16];
  z.dl = p.gdl[unit];
}

__device__ __forceinline__ unsigned scan_touch(const P& p, int unit, int lane) {
  unsigned v = 0u;
  if (lane < 16) {
    const u16* base = (lane < 8) ? (p.gM + (size_t)unit * 16384) : (p.gC + (size_t)unit * 16384);
    v = *(const unsigned*)(base + (lane & 7) * 2048);
  }
  return v;
}

__device__ __forceinline__ void scan_step(const P& p, int unit, int n, int eq, int w, int l15, int g, ScanSmem& s,
                                          f32x4 (&st)[2][2], const ScanSet& z) {
  const u16* Sb = s.st[n & 1];
  u16* Sn = s.st[(n & 1) ^ 1];
#pragma unroll
  for (int md = 0; md < 2; md++)
#pragma unroll
    for (int ne = 0; ne < 2; ne++) {
      float c[4];
      unpack4(z.ci[md][ne], c);
      st[md][ne][0] = st[md][ne][0] * z.dl + c[0];
      st[md][ne][1] = st[md][ne][1] * z.dl + c[1];
      st[md][ne][2] = st[md][ne][2] * z.dl + c[2];
      st[md][ne][3] = st[md][ne][3] * z.dl + c[3];
    }
  if (n > 0) {
    int lb = l15 * SLD + 8 * g;
    asm volatile("" : "+v"(lb));
#pragma unroll
    for (int ne = 0; ne < 2; ne++) {
#pragma unroll
      for (int ks = 0; ks < 4; ks++) {
        const bf16x8 bs = *(const bf16x8*)&Sb[lb + 16 * ne * SLD + ks * 32];
        st[0][ne] = mfma16(z.mf[0][ks], bs, st[0][ne]);
        st[1][ne] = mfma16(z.mf[1][ks], bs, st[1][ne]);
      }
    }
  }
  if (n + 1 < 32) {
    u16* gS = p.gS + (size_t)(unit + 1) * 16384;
    int lsl = l15 * SLD + 32 * w + 4 * g, lsg = (32 * eq + l15) * 128 + 32 * w + 4 * g;
    asm volatile("" : "+v"(lsl), "+v"(lsg));
#pragma unroll
    for (int md = 0; md < 2; md++)
#pragma unroll
      for (int ne = 0; ne < 2; ne++) {
        uint2 o; o.x = pack2(st[md][ne][0], st[md][ne][1]); o.y = pack2(st[md][ne][2], st[md][ne][3]);
        *(uint2*)&Sn[lsl + 16 * ne * SLD + 16 * md] = o;
        *(uint2*)&gS[lsg + 16 * ne * 128 + 16 * md] = o;
      }
  }
  asm volatile("s_waitcnt lgkmcnt(0)" ::: "memory");
  __builtin_amdgcn_s_barrier();
  asm volatile("" ::: "memory");
}

__device__ void scan_unit(const P& p, int item, ScanSmem& s) {
  int tid = threadIdx.x;
  asm volatile("" : "+v"(tid));
  const int lane = tid & 63, w = tid >> 6;
  const int l15 = lane & 15, g = lane >> 4;
  const int bh = item >> 2, eq = item & 3;
  const int u0 = bh * 32;
  f32x4 st[2][2];
#pragma unroll
  for (int md = 0; md < 2; md++)
#pragma unroll
    for (int ne = 0; ne < 2; ne++) st[md][ne] = (f32x4){0.f, 0.f, 0.f, 0.f};
  ScanSet z0, z1, z2, z3;
  scan_load(p, u0 + 0, eq, w, l15, g, z0);
  scan_load(p, u0 + 1, eq, w, l15, g, z1);
  scan_load(p, u0 + 2, eq, w, l15, g, z2);
  unsigned tacc = 0u, tprev = 0u;
  __builtin_amdgcn_s_setprio(3);
#pragma unroll 1
  for (int n = 0; n < 32; n += 4) {
    tacc += tprev;
    tprev = 0u;
    if (n + 8 < 32) {
      tprev = scan_touch(p, u0 + n + 8, lane) + scan_touch(p, u0 + n + 9, lane) + scan_touch(p, u0 + n + 10, lane) +
              scan_touch(p, u0 + n + 11, lane);
    }
    scan_load(p, u0 + n + 3, eq, w, l15, g, z3);
    scan_step(p, u0 + n, n, eq, w, l15, g, s, st, z0);
    if (n + 4 < 32) scan_load(p, u0 + n + 4, eq, w, l15, g, z0);
    scan_step(p, u0 + n + 1, n + 1, eq, w, l15, g, s, st, z1);
    if (n + 4 < 32) scan_load(p, u0 + n + 5, eq, w, l15, g, z1);
    scan_step(p, u0 + n + 2, n + 2, eq, w, l15, g, s, st, z2);
    if (n + 4 < 32) scan_load(p, u0 + n + 6, eq, w, l15, g, z2);
    scan_step(p, u0 + n + 3, n + 3, eq, w, l15, g, s, st, z3);
  }
  __builtin_amdgcn_s_setprio(0);
  asm volatile("" :: "v"(tacc));
}

#define OLD 136
struct GoutSmem { float ssq[4][64]; u16 ob[64 * OLD]; };

__device__ void gout_unit(const P& p, int unit, GoutSmem& s) {
  const int tid = threadIdx.x, lane = tid & 63, w = tid >> 6;
  const int l15 = lane & 15, g = lane >> 4;
  const int bh = unit >> 5, n = unit & 31;
  const int b = bh >> 2, h = bh & 3;
  const u16* gQ = p.gQ + (size_t)unit * 8192;
  const u16* gO = p.gO + (size_t)unit * 8192;
  const u16* gS = p.gS + (size_t)unit * 16384;
  f32x4 o[4][2];
#pragma unroll
  for (int mc = 0; mc < 4; mc++)
#pragma unroll
    for (int ne = 0; ne < 2; ne++) {
      float c[4];
      unpack4(*(const uint2*)&gO[(32 * w + 16 * ne + l15) * 64 + 16 * mc + 4 * g], c);
      o[mc][ne] = (f32x4){c[0], c[1], c[2], c[3]};
    }
  if (n > 0) {
    bf16x8 bs[2][4];
#pragma unroll
    for (int ne = 0; ne < 2; ne++)
#pragma unroll
      for (int ks = 0; ks < 4; ks++) bs[ne][ks] = *(const bf16x8*)&gS[(32 * w + 16 * ne + l15) * 128 + ks * 32 + 8 * g];
#pragma unroll
    for (int mc = 0; mc < 4; mc++) {
#pragma unroll
      for (int ks = 0; ks < 4; ks++) {
        const bf16x8 aq = *(const bf16x8*)&gQ[(16 * mc + l15) * 128 + ks * 32 + 8 * g];
        o[mc][0] = mfma16(aq, bs[0][ks], o[mc][0]);
        o[mc][1] = mfma16(aq, bs[1][ks], o[mc][1]);
      }
    }
  }
  const float gnw0 = p.gdn_norm_w[32 * w + l15], gnw1 = p.gdn_norm_w[32 * w + 16 + l15];
  __syncthreads();
#pragma unroll
  for (int mc = 0; mc < 4; mc++)
#pragma unroll
    for (int r = 0; r < 4; r++) {
      float sq = o[mc][0][r] * o[mc][0][r] + o[mc][1][r] * o[mc][1][r];
#pragma unroll
      for (int off = 1; off < 16; off <<= 1) sq += __shfl_xor(sq, off);
      if (l15 == 0) s.ssq[w][16 * mc + 4 * g + r] = sq;
    }
  __syncthreads();
#pragma unroll
  for (int mc = 0; mc < 4; mc++)
#pragma unroll
    for (int r = 0; r < 4; r++) {
      const int c = 16 * mc + 4 * g + r;
      const float tot = s.ssq[0][c] + s.ssq[1][c] + s.ssq[2][c] + s.ssq[3][c];
      const float rs = rsqrtf(tot * (1.f / 128.f) + EPSV);
      s.ob[c * OLD + 32 * w + l15] = f2bf(o[mc][0][r] * rs * gnw0);
      s.ob[c * OLD + 32 * w + 16 + l15] = f2bf(o[mc][1][r] * rs * gnw1);
    }
  __syncthreads();
  {
    const int t0 = b * SEQ + n * 64;
    const int c0 = tid >> 4, ch = tid & 15;
    const u16* zp = p.proj + (size_t)(t0 + c0) * PROJW + 1536 + h * 128 + ch * 8;
    u16* op = p.actA + (size_t)(t0 + c0) * DM + h * 128 + ch * 8;
#pragma unroll
    for (int i = 0; i < 4; i++) {
      float ov[8], zv[8];
      unpack8(*(const uint4*)&s.ob[(c0 + 16 * i) * OLD + ch * 8], ov);
      unpack8(*(const uint4*)(zp + (size_t)i * 16 * PROJW), zv);
      uint4 r;
      r.x = pack2(ov[0] * siluf(zv[0]), ov[1] * siluf(zv[1])); r.y = pack2(ov[2] * siluf(zv[2]), ov[3] * siluf(zv[3]));
      r.z = pack2(ov[4] * siluf(zv[4]), ov[5] * siluf(zv[5])); r.w = pack2(ov[6] * siluf(zv[6]), ov[7] * siluf(zv[7]));
      *(uint4*)(op + (size_t)i * 16 * DM) = r;
    }
  }
}

__device__ void phase_gout(const P& p, unsigned char* smem) {
  GoutSmem& s = *(GoutSmem*)smem;
  for (int u = blockIdx.x; u < 1024; u += gridDim.x) gout_unit(p, u, s);
}

#define LOG2E 1.4426950408889634f
#define ANST 4
struct AttnSmem { u16 k[ANST][64 * 64 + 128]; u16 v[ANST][64 * 64]; };

__device__ void attn_unit(const P& p, int item, AttnSmem& s) {
  int tid = threadIdx.x;
  asm volatile("" : "+v"(tid));
  const int lane = tid & 63, w = tid >> 6;
  const int l15 = lane & 15, g = lane >> 4;
  const int qb = 15 - (item >> 6), bhf = item & 63;
  const int b = bhf >> 3, hf = bhf & 7;
  const int q0 = qb * 128 + 32 * w;
  const u16* qbase = p.proj + (size_t)(b * SEQ) * PROJW + 2048 + hf * 64;
  const u16* kbase = p.proj + (size_t)(b * SEQ) * PROJW + 2560 + hf * 64;
  const u16* vbase = p.vt + (size_t)bhf * 64 * SEQ;
  const float* cfb = p.cf + (size_t)bhf * SEQ;
  bf16x8 qf[2][2];
#pragma unroll
  for (int mi = 0; mi < 2; mi++)
#pragma unroll
    for (int ks = 0; ks < 2; ks++) qf[mi][ks] = *(const bf16x8*)&qbase[(size_t)(q0 + 16 * mi + l15) * PROJW + ks * 32 + g * 8];
  float cq[2], m[2], lsum[2];
  f32x4 O[2][4];
#pragma unroll
  for (int mi = 0; mi < 2; mi++) {
    cq[mi] = cfb[q0 + 16 * mi + l15]; m[mi] = -1e30f; lsum[mi] = 0.f;
#pragma unroll
    for (int nd = 0; nd < 4; nd++) O[mi][nd] = (f32x4){0.f, 0.f, 0.f, 0.f};
  }
  asm volatile("" :: "v"(cq[0]), "v"(cq[1]), "v"(qf[0][0]), "v"(qf[0][1]), "v"(qf[1][0]), "v"(qf[1][1]));
  const int ntile = (q0 + 32 + 63) >> 6;
  const int ntile_blk = 2 * qb + 2;
  const int drow = 8 * w + (lane >> 3);
  const int dchunk = (lane & 7) ^ ((4 * (w & 1) + (lane >> 4)) & 7);
  const u16* kg = kbase + (size_t)drow * PROJW + dchunk * 8;
  const u16* vg = vbase + (size_t)drow * SEQ + dchunk * 8;
  const float* cg_ = cfb + lane;
  u16* const skw = &s.k[0][0] + (8 * w) * 64;
  u16* const svw = &s.v[0][0] + (8 * w) * 64;
#define A_DMA(st, kk0) do { \
    u16* _dk = skw + (st) * (64 * 64 + 128); u16* _dv = svw + (st) * (64 * 64); \
    __builtin_amdgcn_global_load_lds((const unsigned*)(kg + (size_t)(kk0) * PROJW), (unsigned*)(_dk), 16, 0, 0); \
    __builtin_amdgcn_global_load_lds((const unsigned*)(kg + (size_t)((kk0) + 32) * PROJW), (unsigned*)(_dk + 32 * 64), 16, 0, 0); \
    __builtin_amdgcn_global_load_lds((const unsigned*)(vg + (kk0)), (unsigned*)(_dv), 16, 0, 0); \
    __builtin_amdgcn_global_load_lds((const unsigned*)(vg + (size_t)32 * SEQ + (kk0)), (unsigned*)(_dv + 32 * 64), 16, 0, 0); \
    __builtin_amdgcn_global_load_lds((const unsigned*)(cg_ + (kk0)), (unsigned*)(&s.k[0][0] + (st) * (64 * 64 + 128) + 64 * 64), 4, 0, 0); \
  } while (0)
  {
    const int npro = (ntile_blk > 2) ? 3 : 2;
#pragma unroll 1
    for (int j = 0; j < npro; j++) A_DMA(j, j * 64);
  }
  int ko[4][2];
#pragma unroll
  for (int t = 0; t < 4; t++) {
    const int row = 32 * (t >> 1) + 8 * (l15 >> 2) + 4 * (t & 1) + (l15 & 3);
    const int sw = (row >> 1) & 7;
    ko[t][0] = row * 64 + ((g ^ sw) * 8);
    ko[t][1] = row * 64 + (((4 + g) ^ sw) * 8);
  }
  const int swz = l15 >> 1;
  int vo[2];
  vo[0] = l15 * 64 + ((g ^ swz) * 8);
  vo[1] = l15 * 64 + (((4 + g) ^ swz) * 8);
#pragma unroll 1
  for (int kt = 0; kt < ntile_blk; kt++) {
    const int k0 = kt * 64, st = kt & 3;
    const int rem = ntile_blk - 1 - kt;
    if (rem >= 2) asm volatile("s_waitcnt vmcnt(10)" ::: "memory");
    else if (rem == 1) asm volatile("s_waitcnt vmcnt(5)" ::: "memory");
    else asm volatile("s_waitcnt vmcnt(0)" ::: "memory");
    asm volatile("s_waitcnt lgkmcnt(0)" ::: "memory");
    __builtin_amdgcn_s_barrier();
    asm volatile("" ::: "memory");
    if (kt + 3 < ntile_blk) { const int st3 = (kt + 3) & 3; A_DMA(st3, k0 + 192); }
    if (kt < ntile) {
      const u16* Ks = s.k[st];
      const u16* Vs = s.v[st];
      f32x4 ST[2][4];
#pragma unroll
      for (int t = 0; t < 4; t++) {
        const bf16x8 kf0 = *(const bf16x8*)&Ks[ko[t][0]];
        const bf16x8 kf1 = *(const bf16x8*)&Ks[ko[t][1]];
#pragma unroll
        for (int mi = 0; mi < 2; mi++) {
          f32x4 acc = {0.f, 0.f, 0.f, 0.f};
          acc = mfma16(kf0, qf[mi][0], acc);
          acc = mfma16(kf1, qf[mi][1], acc);
          ST[mi][t] = acc;
        }
      }
      f32x4 ck[4];
      {
        const unsigned cka = (unsigned)(size_t)(&Ks[64 * 64]) + 32u * g;
        asm volatile("ds_read_b128 %0, %4\n\tds_read_b128 %1, %4 offset:16\n\tds_read_b128 %2, %4 offset:128\n\t"
                     "ds_read_b128 %3, %4 offset:144\n\ts_waitcnt lgkmcnt(0)"
                     : "=&v"(ck[0]), "=&v"(ck[1]), "=&v"(ck[2]), "=&v"(ck[3]) : "v"(cka) : "memory");
      }
      const bool diag = (kt == ntile - 1);
      bf16x8 pf[2][2];
#pragma unroll
      for (int mi = 0; mi < 2; mi++) {
        const int qpos = q0 + 16 * mi + l15;
        float mx = -1e30f;
#pragma unroll
        for (int t = 0; t < 4; t++) {
          const float ckv[4] = {ck[t][0], ck[t][1], ck[t][2], ck[t][3]};
#pragma unroll
          for (int r = 0; r < 4; r++) {
            float lg = ST[mi][t][r] * (0.125f * LOG2E) + (cq[mi] - ckv[r]) * LOG2E;
            if (diag && (k0 + 32 * (t >> 1) + 8 * g + 4 * (t & 1) + r > qpos)) lg = -1e30f;
            ST[mi][t][r] = lg;
            mx = fmaxf(mx, lg);
          }
        }
        mx = fmaxf(mx, __shfl_xor(mx, 16));
        mx = fmaxf(mx, __shfl_xor(mx, 32));
        const float mn = fmaxf(m[mi], mx);
        const float alpha = __builtin_amdgcn_exp2f(m[mi] - mn);
        m[mi] = mn;
        float ps = 0.f;
#pragma unroll
        for (int t = 0; t < 4; t++)
#pragma unroll
          for (int r = 0; r < 4; r++) {
            const float pe = __builtin_amdgcn_exp2f(ST[mi][t][r] - mn);
            ST[mi][t][r] = pe;
            ps += pe;
          }
        lsum[mi] = lsum[mi] * alpha + ps;
#pragma unroll
        for (int kk = 0; kk < 2; kk++) {
          uint4 pk;
          pk.x = pack2(ST[mi][2 * kk][0], ST[mi][2 * kk][1]); pk.y = pack2(ST[mi][2 * kk][2], ST[mi][2 * kk][3]);
          pk.z = pack2(ST[mi][2 * kk + 1][0], ST[mi][2 * kk + 1][1]); pk.w = pack2(ST[mi][2 * kk + 1][2], ST[mi][2 * kk + 1][3]);
          pf[mi][kk] = __builtin_bit_cast(bf16x8, pk);
        }
#pragma unroll
        for (int r = 0; r < 4; r++) {
          const float ar = __shfl(alpha, 4 * g + r);
#pragma unroll
          for (int nd = 0; nd < 4; nd++) O[mi][nd][r] *= ar;
        }
      }
#pragma unroll
      for (int nd = 0; nd < 4; nd++)
#pragma unroll
        for (int kk = 0; kk < 2; kk++) {
          const bf16x8 vf = *(const bf16x8*)&Vs[16 * nd * 64 + vo[kk]];
          O[0][nd] = mfma16(pf[0][kk], vf, O[0][nd]);
          O[1][nd] = mfma16(pf[1][kk], vf, O[1][nd]);
        }
    }
  }
#pragma unroll
  for (int mi = 0; mi < 2; mi++) {
    float l = lsum[mi];
    l += __shfl_xor(l, 16);
    l += __shfl_xor(l, 32);
    const float inv = 1.f / l;
#pragma unroll
    for (int r = 0; r < 4; r++) {
      const float ir = __shfl(inv, 4 * g + r);
      const int t = b * SEQ + q0 + 16 * mi + 4 * g + r;
#pragma unroll
      for (int nd = 0; nd < 4; nd++) p.actA[(size_t)t * DM + 512 + hf * 64 + 16 * nd + l15] = f2bf(O[mi][nd][r] * ir);
    }
  }
}

__device__ void deferred_transpose(const P& p, int it, float* tile) {
  const int n1 = 16 * 16, n2 = n1 + 16 * 88, n3 = n2 + 44 * 16, n4 = n3 + 16 * 16;
  if (it < n1) { transpose_item(p.w_out, 1024, p.wt_out, 1024, it % 16, it / 16, 1, tile); }
  else if (it < n2) { int j = it - n1; transpose_item(p.w_gate_up, 2 * DFF, p.wt_gu, 1024, j % 16, j / 16, 2, tile, p.ffn_norm_w); }
  else if (it < n3) { int j = it - n2; transpose_item(p.w_down, 1024, p.wt_down, DFF, j % 44, j / 44, 1, tile); }
  else if (it < n4) { int j = it - n3; transpose_item(p.w_ple_gate, 1024, p.wt_pg, 1024, j % 16, j / 16, 1, tile, p.ple_norm_w); }
  else { int j = it - n4; transpose_item(p.w_ple_proj, 1024, p.wt_pp, 256, j % 4, j / 4, 1, tile); }
}
#define N_DEFER (16 * 16 + 16 * 88 + 44 * 16 + 16 * 16 + 4 * 16)

__device__ void phase_mixer(const P& p, unsigned char* smem, int rr) {
  volatile int* s_item_p = (volatile int*)(smem + SMEM_MAIN + 16);
  for (;;) {
    __syncthreads();
    if (threadIdx.x == 0) *s_item_p = (int)atomicAdd(&p.counters[rr], 1u);
    __syncthreads();
    const int item = *s_item_p;
    if (item >= NSCAN + 1024 + N_DEFER) break;
    if (item < NSCAN) { scan_unit(p, item, *(ScanSmem*)smem); }
    else if (item < NSCAN + 1024) { attn_unit(p, item - NSCAN, *(AttnSmem*)smem); }
    else { deferred_transpose(p, item - NSCAN - 1024, (float*)smem); }
  }
}

#define XB_TMO      128
#define XB_XCNT(j)  (256  + 64 * (j))
#define XB_XSUB(j)  (1280 + 64 * (j))
#define XB_XGEN(j)  (2304 + 64 * (j))
#define XB_TOP      3328
#define XB_TOPGEN   3392
#define XCD_BAR_WORDS 3456
#define XB_SPIN_CAP (1u << 20)
#define LAS __attribute__((address_space(3)))
__device__ __forceinline__ unsigned xb_ld(unsigned* p) { return __hip_atomic_load(p, __ATOMIC_RELAXED, __HIP_MEMORY_SCOPE_AGENT); }
__device__ __forceinline__ unsigned xb_add(unsigned* p, unsigned v) { return __hip_atomic_fetch_add(p, v, __ATOMIC_RELAXED, __HIP_MEMORY_SCOPE_AGENT); }
__device__ __forceinline__ unsigned xb_xcc_id() { return (unsigned)__builtin_amdgcn_s_getreg((3 << 11) | 20) & 0xFu; }
#define XB_SPIN(cond, bar) do { unsigned _sp = 0; while (cond) { __builtin_amdgcn_s_sleep(1); \
    if ((++_sp & 255u) == 0u) { if (xb_ld(&(bar)[XB_TMO])) break; if (_sp > XB_SPIN_CAP) { atomicAdd(&(bar)[XB_TMO], 1u); break; } } } } while (0)
struct XcdBarrier { unsigned* bar; unsigned x; volatile LAS unsigned* st; };
__device__ __forceinline__ XcdBarrier xcd_barrier_post(unsigned* bar, volatile LAS unsigned* st) {
  XcdBarrier b; b.bar = bar; b.x = xb_xcc_id(); b.st = st;
  if (threadIdx.x == 0) (void)xb_add(&bar[XB_XCNT(b.x)], 1u);
  return b;
}
__device__ __forceinline__ void xcd_barrier_complete(unsigned* bar, unsigned x, unsigned& nloc, unsigned& nx) {
  const unsigned G = gridDim.x * gridDim.y * gridDim.z;
  unsigned sum, cnt, mine, sp = 0u;
  for (;;) {
    sum = 0u; cnt = 0u; mine = 0u;
#pragma unroll
    for (unsigned j = 0; j < 16; ++j) { const unsigned c = xb_ld(&bar[XB_XCNT(j)]); sum += c; cnt += (c > 0u) ? 1u : 0u; mine = (j == x) ? c : mine; }
    if (sum == G) break;
    __builtin_amdgcn_s_sleep(1);
    if ((++sp & 255u) == 0u) { if (xb_ld(&bar[XB_TMO])) break; if (sp > XB_SPIN_CAP) { atomicAdd(&bar[XB_TMO], 1u); break; } }
  }
  nloc = mine > 0u ? mine : 1u; nx = cnt > 0u ? cnt : 1u;
}
__device__ __forceinline__ void xcd_barrier(const XcdBarrier& b) {
  asm volatile("s_waitcnt vmcnt(0)" ::: "memory");
  __syncthreads();
  if (threadIdx.x == 0) {
    unsigned* bar = b.bar;
    __builtin_amdgcn_s_waitcnt(0);
    unsigned nloc = b.st[0], nx = b.st[1];
    if (nloc == 0u) { xcd_barrier_complete(bar, b.x, nloc, nx); b.st[0] = nloc; b.st[1] = nx; }
    const unsigned old = xb_add(&bar[XB_XSUB(b.x)], 1u);
    const unsigned gen = old / nloc;
    if (old + 1u == (gen + 1u) * nloc) {
      __builtin_amdgcn_fence(__ATOMIC_RELEASE, "agent");
      asm volatile("s_waitcnt vmcnt(0)" ::: "memory");
      const unsigned og = xb_add(&bar[XB_TOP], 1u);
      const unsigned tg = og / nx;
      if (og + 1u == (tg + 1u) * nx) xb_add(&bar[XB_TOPGEN], 1u);
      else XB_SPIN(xb_ld(&bar[XB_TOPGEN]) == tg, bar);
      __builtin_amdgcn_fence(__ATOMIC_ACQUIRE, "agent");
      xb_add(&bar[XB_XGEN(b.x)], 1u);
      asm volatile("s_waitcnt vmcnt(0)" ::: "memory");
    } else {
      XB_SPIN(xb_ld(&bar[XB_XGEN(b.x)]) == gen, bar);
      __builtin_amdgcn_fence(__ATOMIC_ACQUIRE, "agent");
      asm volatile("s_waitcnt vmcnt(0)" ::: "memory");
    }
  }
  __syncthreads();
}

__global__ void __launch_bounds__(256, 2) mega(P p, int lo, int hi) {
  __shared__ __attribute__((aligned(16))) unsigned char smem[SMEM_MAIN + 32];
  cg::grid_group grid = cg::this_grid();
  uint4* xbw = (uint4*)(smem + SMEM_MAIN);
  if (threadIdx.x == 0) *xbw = make_uint4(0u, 0u, 0u, 0u);
  __syncthreads();
  XcdBarrier xb = xcd_barrier_post(p.bar, (volatile LAS unsigned*)xbw);
  if (hi < 0) grid.sync();
#define SEAM(k) if (lo <= k && k + 1 < hi) xcd_barrier(xb);
#if !defined(ONLY) || ONLY == 0
  if (lo <= 0 && 0 < hi) phase_prep(p, smem);
#endif
  SEAM(0)
#if !defined(ONLY) || ONLY == 1
  if (lo <= 1 && 1 < hi) phase_inproj(p, smem);
#endif
  SEAM(1)
#if !defined(ONLY) || ONLY == 2
  if (lo <= 2 && 2 < hi) phase_gdnprep(p, smem);
#endif
  SEAM(2)
#if !defined(ONLY) || ONLY == 3
  if (lo <= 3 && 3 < hi) phase_mixer(p, smem, 0);
#endif
  SEAM(3)
#if !defined(ONLY) || ONLY == 4
  if (lo <= 4 && 4 < hi) phase_gout(p, smem);
#endif
  SEAM(4)
#if !defined(ONLY) || ONLY == 5
  if (lo <= 5 && 5 < hi) phase_outproj(p, smem);
#endif
  SEAM(5)
#if !defined(ONLY) || ONLY == 6
  if (lo <= 6 && 6 < hi) phase_gateup(p, smem);
#endif
  SEAM(6)
#if !defined(ONLY) || ONLY == 7
  if (lo <= 7 && 7 < hi) phase_down(p, smem);
#endif
  SEAM(7)
#if !defined(ONLY) || ONLY == 8
  if (lo <= 8 && 8 < hi) phase_ple(p, smem);
#endif
  SEAM(8)
  if (lo <= 9 && 9 < hi) phase_final(p);
}

static_assert(sizeof(GemmSmem) <= SMEM_MAIN && sizeof(Gemm2Smem) <= SMEM_MAIN && sizeof(GdnSmem) <= SMEM_MAIN && sizeof(ScanSmem) <= SMEM_MAIN &&
              sizeof(GoutSmem) <= SMEM_MAIN && sizeof(AttnSmem) <= SMEM_MAIN && 64 * 65 * 4 <= SMEM_MAIN, "smem");

extern "C" void kernel_launch(void* const* d_in, const int* in_sizes, int n_in, void* d_out, int out_size,
                              void* d_ws, size_t ws_size, hipStream_t stream) {
  static int grid_blocks = 0;
  if (!grid_blocks) {
    int dev = 0, cus = 0, per_cu = 0;
    hipGetDevice(&dev);
    hipDeviceGetAttribute(&cus, hipDeviceAttributeMultiprocessorCount, dev);
    hipOccupancyMaxActiveBlocksPerMultiprocessor(&per_cu, mega, 256, 0);
    if (per_cu > 2) per_cu = 2;
    if (per_cu < 1) per_cu = 1;
    grid_blocks = cus * per_cu;
  }
  P p{};
  const float* const* in = (const float* const*)d_in;
  p.x = in[0]; p.p = in[1]; p.attn_norm_w = in[2]; p.w_in = in[3]; p.conv_w = in[4]; p.a_log = in[5];
  p.dt_bias = in[6]; p.gdn_norm_w = in[7]; p.fox_f_bias = in[8]; p.w_out = in[9]; p.ffn_norm_w = in[10];
  p.w_gate_up = in[11]; p.w_down = in[12]; p.ple_norm_w = in[13]; p.w_ple_gate = in[14]; p.w_ple_proj = in[15];
  p.final_norm_w = in[16];
  p.h = (float*)d_out;
  unsigned char* ws = (unsigned char*)d_ws;
  size_t off = 0;
  auto take = [&](size_t bytes) { unsigned char* r = ws + off; off += (bytes + 255) & ~(size_t)255; return r; };
  p.counters = (unsigned*)take(256);
  p.bar = (unsigned*)take(XCD_BAR_WORDS * 4);
  p.wt_in = (u16*)take((size_t)NIN_PAD * 1024 * 2);
  p.wt_out = (u16*)take((size_t)1024 * 1024 * 2);
  p.wt_gu = (u16*)take((size_t)2 * DFF * 1024 * 2);
  p.wt_down = (u16*)take((size_t)1024 * DFF * 2);
  p.wt_pg = (u16*)take((size_t)1024 * 1024 * 2);
  p.wt_pp = (u16*)take((size_t)1024 * 256 * 2);
  p.actA = (u16*)take((size_t)NTOK * 1024 * 2);
  p.pb = (u16*)take((size_t)NTOK * 256 * 2);
  p.proj = (u16*)take((size_t)NTOK * PROJW * 2);
  p.vt = (u16*)take((size_t)64 * 64 * SEQ * 2);
  p.gates = (float*)take((size_t)NTOK * 16 * 4);
  p.cf = (float*)take((size_t)64 * SEQ * 4);
  p.gM = (u16*)take((size_t)1024 * 16384 * 2);
  p.gC = (u16*)take((size_t)1024 * 16384 * 2);
  p.gdl = (float*)take(1024 * 4);
  p.rss = (float*)take((size_t)3 * NTOK * 4);
  p.hb = p.gM;
  if (off > ws_size) fprintf(stderr, "workspace too small: need %zu have %zu\n", off, ws_size);
  u16* ob = (u16*)d_out;
  p.gS = ob;
  p.gQ = ob + (size_t)1024 * 16384;
  p.gO = ob + (size_t)1024 * 16384 + (size_t)1024 * 8192;
  hipMemsetAsync(p.bar, 0, XCD_BAR_WORDS * 4, stream);
  int lo = 0, hi = NPHASE;
  void* args[] = {&p, &lo, &hi};
  hipError_t e = hipLaunchCooperativeKernel((void*)mega, dim3(grid_blocks), dim3(256), args, 0, stream);
  if (e != hipSuccess) fprintf(stderr, "cooperative launch failed: %s (grid %d)\n", hipGetErrorString(e), grid_blocks);
}
```

```cpp
#include <hip/hip_runtime.h>
#include <hip/hip_cooperative_groups.h>
#include <cstdio>
#include <cstdint>
namespace cg = cooperative_groups;

typedef unsigned short u16;
typedef __attribute__((ext_vector_type(8))) short bf16x8;
typedef __attribute__((ext_vector_type(4))) float f32x4;

#define NTOK 16384
#define SEQ 2048
#define DM 1024
#define DFF 2816
#define PROJW 3072
#define NIN_PAD 3712
#define EPSV 1e-6f
#define NPHASE 10
#define SMEM_MAIN 73728

struct P {
  const float *x, *p, *attn_norm_w, *w_in, *conv_w, *a_log, *dt_bias, *gdn_norm_w, *fox_f_bias, *w_out,
      *ffn_norm_w, *w_gate_up, *w_down, *ple_norm_w, *w_ple_gate, *w_ple_proj, *final_norm_w;
  float* h;
  u16 *wt_in, *wt_out, *wt_gu, *wt_down, *wt_pg, *wt_pp;
  u16 *actA;
  u16 *pb;
  u16 *proj;
  u16 *vt;
  float *gates;
  float *cf;
  u16 *gM, *gC;
  u16 *gQ, *gO;
  u16 *gS;
  float *gdl;
  unsigned *counters;
  unsigned *bar;
  u16 *hb;
  float *rss;
};

typedef __attribute__((ext_vector_type(2))) float f32x2_t;
typedef __attribute__((ext_vector_type(2))) __bf16 bf16x2_t;
__device__ __forceinline__ u16 f2bf(float f) { return __builtin_bit_cast(u16, (__bf16)f); }
__device__ __forceinline__ float bf2f(u16 h) { return __uint_as_float(((unsigned)h) << 16); }
__device__ __forceinline__ unsigned pack2(float a, float b) {
  f32x2_t f = {a, b};
  return __builtin_bit_cast(unsigned, __builtin_convertvector(f, bf16x2_t));
}
__device__ __forceinline__ float siluf(float v) { return v / (1.f + __expf(-v)); }
__device__ __forceinline__ float sigmoidf_(float v) { return 1.f / (1.f + __expf(-v)); }
__device__ __forceinline__ f32x4 mfma16(bf16x8 a, bf16x8 b, f32x4 c) {
  return __builtin_amdgcn_mfma_f32_16x16x32_bf16(a, b, c, 0, 0, 0);
}
#define LDS_FENCE() asm volatile("s_waitcnt lgkmcnt(0)" ::: "memory")

__device__ __forceinline__ void unpack8(const uint4& v, float (&f)[8]) {
  f[0] = bf2f((u16)(v.x & 0xffffu)); f[1] = bf2f((u16)(v.x >> 16));
  f[2] = bf2f((u16)(v.y & 0xffffu)); f[3] = bf2f((u16)(v.y >> 16));
  f[4] = bf2f((u16)(v.z & 0xffffu)); f[5] = bf2f((u16)(v.z >> 16));
  f[6] = bf2f((u16)(v.w & 0xffffu)); f[7] = bf2f((u16)(v.w >> 16));
}
__device__ __forceinline__ void unpack4(const uint2& v, float (&f)[4]) {
  f[0] = bf2f((u16)(v.x & 0xffffu)); f[1] = bf2f((u16)(v.x >> 16));
  f[2] = bf2f((u16)(v.y & 0xffffu)); f[3] = bf2f((u16)(v.y >> 16));
}


__device__ __forceinline__ int colmap(int kind, int nn) {
  if (kind == 0) {
    if (nn < 2048) return nn;
    if (nn < 3584) return nn + 8;
    if (nn < 3588) return 2048 + (nn - 3584);
    if (nn < 3592) return 2052 + (nn - 3588);
    if (nn < 3600) return nn;
    return -1;
  } else if (kind == 2) {
    int i = nn >> 7, wc = (nn >> 6) & 1, u = (nn >> 5) & 1, j = nn & 31;
    return u * DFF + 64 * i + 32 * wc + j;
  }
  return nn;
}

__device__ void transpose_item(const float* __restrict__ src, int ldsrc, u16* __restrict__ dst, int K,
                               int kt, int nt, int kind, float* tile, const float* __restrict__ kscale = nullptr) {
  int tid = threadIdx.x;
  asm volatile("" : "+v"(tid));
  const int c = tid & 63, r0 = tid >> 6;
  const int ncol = colmap(kind, nt * 64 + c);
  float tv[16];
#pragma unroll
  for (int i = 0; i < 16; i++) {
    int r = r0 + 4 * i;
    tv[i] = (ncol >= 0) ? src[(size_t)(kt * 64 + r) * ldsrc + ncol] : 0.f;
  }
  if (kscale) {
#pragma unroll
    for (int i = 0; i < 16; i++) tv[i] *= kscale[kt * 64 + r0 + 4 * i];
  }
#pragma unroll
  for (int i = 0; i < 16; i++) tile[(r0 + 4 * i) * 65 + c] = tv[i];
  __syncthreads();
#pragma unroll 8
  for (int i = 0; i < 16; i++) {
    int rn = r0 + 4 * i;
    dst[(size_t)(nt * 64 + rn) * K + kt * 64 + c] = f2bf(tile[c * 65 + rn]);
  }
  __syncthreads();
}

__device__ __forceinline__ void rmsnorm_row(const float* src, const float* __restrict__ w,
                                            u16* dstb, float* dstf, int row) {
  const int lane = threadIdx.x & 63;
  float4 v[4];
  float ss = 0.f;
#pragma unroll
  for (int i = 0; i < 4; i++) {
    v[i] = *(const float4*)&src[(size_t)row * DM + i * 256 + lane * 4];
    ss += v[i].x * v[i].x + v[i].y * v[i].y + v[i].z * v[i].z + v[i].w * v[i].w;
  }
#pragma unroll
  for (int off = 32; off >= 1; off >>= 1) ss += __shfl_xor(ss, off);
  const float r = rsqrtf(ss * (1.f / DM) + EPSV);
#pragma unroll
  for (int i = 0; i < 4; i++) {
    const int col = i * 256 + lane * 4;
    float4 wv = *(const float4*)&w[col];
    float y0 = v[i].x * r * wv.x, y1 = v[i].y * r * wv.y, y2 = v[i].z * r * wv.z, y3 = v[i].w * r * wv.w;
    if (dstb) {
      uint2 o; o.x = pack2(y0, y1); o.y = pack2(y2, y3);
      *(uint2*)&dstb[(size_t)row * DM + col] = o;
    } else {
      *(float4*)&dstf[(size_t)row * DM + col] = make_float4(y0, y1, y2, y3);
    }
  }
}

__device__ void phase_prep(const P& p, unsigned char* smem) {
  float* tile = (float*)smem;
  if (blockIdx.x == 0 && threadIdx.x < 16) p.counters[threadIdx.x] = 0u;
  for (int i = blockIdx.x * 256 + threadIdx.x; i < 3 * NTOK; i += gridDim.x * 256) p.rss[i] = 0.f;
  for (int it = blockIdx.x; it < 16 * 58; it += gridDim.x) transpose_item(p.w_in, 3600, p.wt_in, 1024, it % 16, it / 16, 0, tile);
  const int wave = threadIdx.x >> 6, lane = threadIdx.x & 63;
  for (int rb = blockIdx.x; rb < NTOK / 8; rb += gridDim.x) {
    const int row = rb * 8 + wave * 2;
    float4 v0[4], v1[4];
#pragma unroll
    for (int i = 0; i < 4; i++) {
      v0[i] = *(const float4*)&p.x[(size_t)row * DM + i * 256 + lane * 4];
      v1[i] = *(const float4*)&p.x[(size_t)(row + 1) * DM + i * 256 + lane * 4];
    }
    const float4 pv0 = *(const float4*)&p.p[(size_t)row * 256 + lane * 4];
    const float4 pv1 = *(const float4*)&p.p[(size_t)(row + 1) * 256 + lane * 4];
    float s0 = 0.f, s1 = 0.f;
#pragma unroll
    for (int i = 0; i < 4; i++) {
      s0 += v0[i].x * v0[i].x + v0[i].y * v0[i].y + v0[i].z * v0[i].z + v0[i].w * v0[i].w;
      s1 += v1[i].x * v1[i].x + v1[i].y * v1[i].y + v1[i].z * v1[i].z + v1[i].w * v1[i].w;
    }
#pragma unroll
    for (int off = 32; off >= 1; off >>= 1) { s0 += __shfl_xor(s0, off); s1 += __shfl_xor(s1, off); }
    const float r0 = rsqrtf(s0 * (1.f / DM) + EPSV), r1 = rsqrtf(s1 * (1.f / DM) + EPSV);
#pragma unroll
    for (int i = 0; i < 4; i++) {
      const int col = i * 256 + lane * 4;
      const float4 wv = *(const float4*)&p.attn_norm_w[col];
      uint2 o;
      o.x = pack2(v0[i].x * r0 * wv.x, v0[i].y * r0 * wv.y); o.y = pack2(v0[i].z * r0 * wv.z, v0[i].w * r0 * wv.w);
      *(uint2*)&p.actA[(size_t)row * DM + col] = o;
      o.x = pack2(v1[i].x * r1 * wv.x, v1[i].y * r1 * wv.y); o.y = pack2(v1[i].z * r1 * wv.z, v1[i].w * r1 * wv.w);
      *(uint2*)&p.actA[(size_t)(row + 1) * DM + col] = o;
    }
    uint2 o; o.x = pack2(pv0.x, pv0.y); o.y = pack2(pv0.z, pv0.w);
    *(uint2*)&p.pb[(size_t)row * 256 + lane * 4] = o;
    o.x = pack2(pv1.x, pv1.y); o.y = pack2(pv1.z, pv1.w);
    *(uint2*)&p.pb[(size_t)(row + 1) * 256 + lane * 4] = o;
  }
}

__device__ void phase_rmsnorm(const float* src, const float* w, u16* dstb, float* dstf) {
  const int wave = threadIdx.x >> 6;
  for (int rb = blockIdx.x; rb < NTOK / 4; rb += gridDim.x) rmsnorm_row(src, w, dstb, dstf, rb * 4 + wave);
}

__device__ void phase_final(const P& p) {
  const int wave = threadIdx.x >> 6, lane = threadIdx.x & 63;
  for (int rb = blockIdx.x; rb < NTOK / 4; rb += gridDim.x) {
    const int row = rb * 4 + wave;
    const float r = rsqrtf(p.rss[2 * NTOK + row] * (1.f / DM) + EPSV);
#pragma unroll
    for (int i = 0; i < 4; i++) {
      const int col = i * 256 + lane * 4;
      float hv[4];
      unpack4(*(const uint2*)&p.hb[(size_t)row * DM + col], hv);
      const float4 wv = *(const float4*)&p.final_norm_w[col];
      *(float4*)&p.h[(size_t)row * DM + col] = make_float4(hv[0] * r * wv.x, hv[1] * r * wv.y, hv[2] * r * wv.z, hv[3] * r * wv.w);
    }
  }
}

#define GK 64
struct GemmSmem { u16 a[2][128 * GK]; u16 b[2][128 * GK]; };

template <bool SWAP>
__device__ __forceinline__ void gemm_tile(const u16* __restrict__ A, int lda, const u16* __restrict__ Bt, int ldb,
                                          int K, int m0, int n0, GemmSmem& s, f32x4 (&acc)[4][4]) {
  int tid = threadIdx.x;
  asm volatile("" : "+v"(tid));
  const int lane = tid & 63, wave = tid >> 6;
  const int wr = wave >> 1, wc = wave & 1;
  const int l15 = lane & 15, g = lane >> 4;
  const int nk = K / GK;
  const int drow = 8 * wave + (lane >> 3);
  const int dchunk = (lane & 7) ^ ((4 * (wave & 1) + (lane >> 4)) & 7);
  const u16* Ap = A + (size_t)(m0 + drow) * lda + dchunk * 8;
  const u16* Bp = Bt + (size_t)(n0 + drow) * ldb + dchunk * 8;
  const size_t sa = (size_t)32 * lda, sb = (size_t)32 * ldb;
#define G_DMA(bufi, koff) do { \
    _Pragma("unroll") for (int _i = 0; _i < 4; _i++) { \
      __builtin_amdgcn_global_load_lds((const unsigned*)(Ap + _i * sa + (koff)), (unsigned*)&s.a[bufi][(32 * _i + 8 * wave) * GK], 16, 0, 0); \
      __builtin_amdgcn_global_load_lds((const unsigned*)(Bp + _i * sb + (koff)), (unsigned*)&s.b[bufi][(32 * _i + 8 * wave) * GK], 16, 0, 0); \
    } } while (0)
  const int fo0 = l15 * GK + ((g ^ (l15 >> 1)) * 8);
  const int fo1 = l15 * GK + (((4 + g) ^ (l15 >> 1)) * 8);
  G_DMA(0, 0);
  asm volatile("s_waitcnt vmcnt(0)" ::: "memory");
  __builtin_amdgcn_s_barrier();
  asm volatile("" ::: "memory");
  for (int kt = 0; kt < nk; kt++) {
    const int buf = kt & 1;
    if (kt + 1 < nk) { if (buf) G_DMA(0, (kt + 1) * GK); else G_DMA(1, (kt + 1) * GK); }
    const u16* sa_ = &s.a[buf][(wr * 64) * GK];
    const u16* sb_ = &s.b[buf][(wc * 64) * GK];
#pragma unroll
    for (int ks = 0; ks < 2; ks++) {
      const int fo = ks ? fo1 : fo0;
      bf16x8 af[4], bfr[4];
#pragma unroll
      for (int mi = 0; mi < 4; mi++) af[mi] = *(const bf16x8*)&sa_[mi * 16 * GK + fo];
#pragma unroll
      for (int ni = 0; ni < 4; ni++) bfr[ni] = *(const bf16x8*)&sb_[ni * 16 * GK + fo];
#pragma unroll
      for (int mi = 0; mi < 4; mi++)
#pragma unroll
        for (int ni = 0; ni < 4; ni++) acc[mi][ni] = SWAP ? mfma16(bfr[ni], af[mi], acc[mi][ni]) : mfma16(af[mi], bfr[ni], acc[mi][ni]);
    }
    asm volatile("s_waitcnt vmcnt(0) lgkmcnt(0)" ::: "memory");
    __builtin_amdgcn_s_barrier();
    asm volatile("" ::: "memory");
  }
}


#define G2K 32
struct Gemm2Smem { u16 a[3][256 * G2K]; u16 b[3][128 * G2K]; };

template <bool SWAP>
__device__ __forceinline__ void gemm256(const u16* __restrict__ A, int lda, const u16* __restrict__ Bt, int ldb,
                                        int K, int m0, int n0, Gemm2Smem& s, f32x4 (&acc)[8][4]) {
  int tid = threadIdx.x;
  asm volatile("" : "+v"(tid));
  const int lane = tid & 63, wave = tid >> 6;
  const int wr = wave >> 1, wc = wave & 1;
  const int l15 = lane & 15, g = lane >> 4;
  const int nk = K / G2K;
  const int drow = 16 * wave + (lane >> 2);
  const int dchunk = (lane & 3) ^ g;
  const u16* Ap = A + (size_t)(m0 + drow) * lda + dchunk * 8;
  const u16* Bp = Bt + (size_t)(n0 + drow) * ldb + dchunk * 8;
  const size_t sa = (size_t)64 * lda, sb = (size_t)64 * ldb;
  u16* const sa0 = &s.a[0][0] + (16 * wave) * G2K;
  u16* const sb0 = &s.b[0][0] + (16 * wave) * G2K;
#define G2_DMA(st, koff) do { \
    u16* _da = sa0 + (st) * (256 * G2K); u16* _db = sb0 + (st) * (128 * G2K); \
    _Pragma("unroll") for (int _i = 0; _i < 4; _i++) \
      __builtin_amdgcn_global_load_lds((const unsigned*)(Ap + _i * sa + (koff)), (unsigned*)(_da + 64 * _i * G2K), 16, 0, 0); \
    _Pragma("unroll") for (int _i = 0; _i < 2; _i++) \
      __builtin_amdgcn_global_load_lds((const unsigned*)(Bp + _i * sb + (koff)), (unsigned*)(_db + 64 * _i * G2K), 16, 0, 0); \
  } while (0)
  const int fo = l15 * G2K + ((g ^ ((l15 >> 2) & 3)) * 8);
  asm volatile("s_waitcnt lgkmcnt(0)" ::: "memory");
  __builtin_amdgcn_s_barrier();
  asm volatile("" ::: "memory");
#pragma unroll 1
  for (int j = 0; j < 2; j++) G2_DMA(j, j * G2K);
  int st = 0;
  for (int kt = 0; kt < nk; kt++) {
    if (kt + 1 < nk) asm volatile("s_waitcnt vmcnt(6)" ::: "memory");
    else asm volatile("s_waitcnt vmcnt(0)" ::: "memory");
    __builtin_amdgcn_s_barrier();
    asm volatile("" ::: "memory");
    if (kt + 2 < nk) {
      const int st2 = (st >= 1) ? st - 1 : 2;
      G2_DMA(st2, (kt + 2) * G2K);
    }
    const u16* sa_ = &s.a[0][0] + st * (256 * G2K) + (wr * 128) * G2K + fo;
    const u16* sb_ = &s.b[0][0] + st * (128 * G2K) + (wc * 64) * G2K + fo;
    bf16x8 af[8], bfr[4];
#pragma unroll
    for (int mi = 0; mi < 8; mi++) af[mi] = *(const bf16x8*)&sa_[mi * 16 * G2K];
#pragma unroll
    for (int ni = 0; ni < 4; ni++) bfr[ni] = *(const bf16x8*)&sb_[ni * 16 * G2K];
#pragma unroll
    for (int mi = 0; mi < 8; mi++)
#pragma unroll
      for (int ni = 0; ni < 4; ni++) acc[mi][ni] = SWAP ? mfma16(bfr[ni], af[mi], acc[mi][ni]) : mfma16(af[mi], bfr[ni], acc[mi][ni]);
    st = (st == 2) ? 0 : st + 1;
  }
}
#define ZERO_ACC8(acc) _Pragma("unroll") for (int _i = 0; _i < 8; _i++) _Pragma("unroll") for (int _j = 0; _j < 4; _j++) acc[_i][_j] = (f32x4){0.f, 0.f, 0.f, 0.f};

#define ZERO_ACC(acc) _Pragma("unroll") for (int _i = 0; _i < 4; _i++) _Pragma("unroll") for (int _j = 0; _j < 4; _j++) acc[_i][_j] = (f32x4){0.f, 0.f, 0.f, 0.f};

template <int NMI>
__device__ __forceinline__ void row_sumsq_add(f32x4 (&sq)[NMI][4], float* rss, int row0, int l15, int g) {
#pragma unroll
  for (int mi = 0; mi < NMI; mi++) {
    float v = 0.f;
#pragma unroll
    for (int ni = 0; ni < 4; ni++) v += (sq[mi][ni][0] + sq[mi][ni][1]) + (sq[mi][ni][2] + sq[mi][ni][3]);
    v += __shfl_xor(v, 16);
    v += __shfl_xor(v, 32);
    if (g == 0) atomicAdd(&rss[row0 + mi * 16 + l15], v);
  }
}

__device__ void phase_inproj(const P& p, unsigned char* smem) {
  Gemm2Smem& s = *(Gemm2Smem*)smem;
  const int lane = threadIdx.x & 63, wave = threadIdx.x >> 6, wr = wave >> 1, wc = wave & 1, l15 = lane & 15, g = lane >> 4;
  const int ntiles = 64 * 29;
  for (int tl = blockIdx.x; tl < ntiles; tl += gridDim.x) {
    const int mt = tl & 63, nt = tl >> 6;
    const int m0 = mt * 256, n0 = nt * 128;
    f32x4 acc[8][4];
    ZERO_ACC8(acc);
    if (nt >= 24 && nt < 28) {
      gemm256<false>(p.actA, DM, p.wt_in, DM, DM, m0, n0, s, acc);
#pragma unroll
      for (int mi = 0; mi < 8; mi++)
#pragma unroll
        for (int ni = 0; ni < 4; ni++) {
          const int rowb = m0 + wr * 128 + mi * 16 + g * 4;
          const int col = n0 + wc * 64 + ni * 16 + l15;
          const int cc = col - 3072, hh = cc >> 6, d = cc & 63;
          const int b = rowb >> 11, sq = rowb & 2047;
          uint2 o; o.x = pack2(acc[mi][ni][0], acc[mi][ni][1]); o.y = pack2(acc[mi][ni][2], acc[mi][ni][3]);
          *(uint2*)&p.vt[((size_t)((b * 8 + hh) * 64 + d)) * SEQ + sq] = o;
        }
    } else {
      gemm256<true>(p.actA, DM, p.wt_in, DM, DM, m0, n0, s, acc);
#pragma unroll
      for (int mi = 0; mi < 8; mi++)
#pragma unroll
        for (int ni = 0; ni < 4; ni++) {
          const int row = m0 + wr * 128 + mi * 16 + l15;
          const int col = n0 + wc * 64 + ni * 16 + g * 4;
          if (nt < 24) {
            uint2 o; o.x = pack2(acc[mi][ni][0], acc[mi][ni][1]); o.y = pack2(acc[mi][ni][2], acc[mi][ni][3]);
            *(uint2*)&p.proj[(size_t)row * PROJW + col] = o;
          } else if (col < 3600) {
            *(float4*)&p.gates[(size_t)row * 16 + (col - 3584)] = make_float4(acc[mi][ni][0], acc[mi][ni][1], acc[mi][ni][2], acc[mi][ni][3]);
          }
        }
    }
  }
}

__device__ void phase_outproj(const P& p, unsigned char* smem) {
  Gemm2Smem& s = *(Gemm2Smem*)smem;
  const int lane = threadIdx.x & 63, wave = threadIdx.x >> 6, wr = wave >> 1, wc = wave & 1, l15 = lane & 15, g = lane >> 4;
  for (int tl = blockIdx.x; tl < 64 * 8; tl += gridDim.x) {
    const int mt = tl & 63, nt = tl >> 6;
    const int m0 = mt * 256, n0 = nt * 128;
    f32x4 acc[8][4];
    ZERO_ACC8(acc);
    gemm256<true>(p.actA, DM, p.wt_out, DM, DM, m0, n0, s, acc);
#pragma unroll
    for (int mi = 0; mi < 8; mi++)
#pragma unroll
      for (int ni = 0; ni < 4; ni++) {
        const size_t idx = (size_t)(m0 + wr * 128 + mi * 16 + l15) * DM + n0 + wc * 64 + ni * 16 + g * 4;
        const float4 xv = *(const float4*)&p.x[idx];
        const float h0 = xv.x + acc[mi][ni][0], h1 = xv.y + acc[mi][ni][1], h2 = xv.z + acc[mi][ni][2], h3 = xv.w + acc[mi][ni][3];
        uint2 o; o.x = pack2(h0, h1); o.y = pack2(h2, h3);
        *(uint2*)&p.hb[idx] = o;
        acc[mi][ni] = (f32x4){h0 * h0, h1 * h1, h2 * h2, h3 * h3};
      }
    row_sumsq_add(acc, p.rss, m0 + wr * 128, l15, g);
  }
}

__device__ void phase_gateup(const P& p, unsigned char* smem) {
  Gemm2Smem& s = *(Gemm2Smem*)smem;
  u16* act = p.proj;
  const int lane = threadIdx.x & 63, wave = threadIdx.x >> 6, wr = wave >> 1, wc = wave & 1, l15 = lane & 15, g = lane >> 4;
  for (int tl = blockIdx.x; tl < 64 * 44; tl += gridDim.x) {
    const int mt = tl & 63, nt = tl >> 6;
    const int m0 = mt * 256, n0 = nt * 128;
    f32x4 acc[8][4];
    ZERO_ACC8(acc);
    gemm256<true>(p.hb, DM, p.wt_gu, DM, DM, m0, n0, s, acc);
#pragma unroll
    for (int mi = 0; mi < 8; mi++) {
      const int row = m0 + wr * 128 + mi * 16 + l15;
      const float rs = rsqrtf(p.rss[row] * (1.f / DM) + EPSV);
#pragma unroll
      for (int ni = 0; ni < 2; ni++) {
        const int col = 64 * nt + 32 * wc + 16 * ni + g * 4;
        float v[4];
#pragma unroll
        for (int r = 0; r < 4; r++) v[r] = siluf(acc[mi][ni][r] * rs) * (acc[mi][ni + 2][r] * rs);
        uint2 o; o.x = pack2(v[0], v[1]); o.y = pack2(v[2], v[3]);
        *(uint2*)&act[(size_t)row * DFF + col] = o;
      }
    }
  }
}

__device__ void phase_down(const P& p, unsigned char* smem) {
  Gemm2Smem& s = *(Gemm2Smem*)smem;
  const u16* act = p.proj;
  const int lane = threadIdx.x & 63, wave = threadIdx.x >> 6, wr = wave >> 1, wc = wave & 1, l15 = lane & 15, g = lane >> 4;
  for (int tl = blockIdx.x; tl < 64 * 8; tl += gridDim.x) {
    const int mt = tl & 63, nt = tl >> 6;
    const int m0 = mt * 256, n0 = nt * 128;
    f32x4 acc[8][4];
    ZERO_ACC8(acc);
    gemm256<true>(act, DFF, p.wt_down, DFF, DFF, m0, n0, s, acc);
#pragma unroll
    for (int mi = 0; mi < 8; mi++)
#pragma unroll
      for (int ni = 0; ni < 4; ni++) {
        const size_t idx = (size_t)(m0 + wr * 128 + mi * 16 + l15) * DM + n0 + wc * 64 + ni * 16 + g * 4;
        float hp[4];
        unpack4(*(const uint2*)&p.hb[idx], hp);
        const float h0 = hp[0] + acc[mi][ni][0], h1 = hp[1] + acc[mi][ni][1], h2 = hp[2] + acc[mi][ni][2], h3 = hp[3] + acc[mi][ni][3];
        uint2 o; o.x = pack2(h0, h1); o.y = pack2(h2, h3);
        *(uint2*)&p.actA[idx] = o;
        acc[mi][ni] = (f32x4){h0 * h0, h1 * h1, h2 * h2, h3 * h3};
      }
    row_sumsq_add(acc, p.rss + NTOK, m0 + wr * 128, l15, g);
  }
}

__device__ void phase_ple(const P& p, unsigned char* smem) {
  GemmSmem& s = *(GemmSmem*)smem;
  const int lane = threadIdx.x & 63, wave = threadIdx.x >> 6, wr = wave >> 1, wc = wave & 1, l15 = lane & 15, g = lane >> 4;
  for (int tl = blockIdx.x; tl < 128 * 8; tl += gridDim.x) {
    const int mt = tl & 127, nt = tl >> 7;
    const int m0 = mt * 128, n0 = nt * 128;
    f32x4 acc[4][4], acc2[4][4];
    ZERO_ACC(acc);
    gemm_tile<true>(p.actA, DM, p.wt_pg, DM, DM, m0, n0, s, acc);
#pragma unroll
    for (int mi = 0; mi < 4; mi++) {
      const float rs = rsqrtf(p.rss[NTOK + m0 + wr * 64 + mi * 16 + l15] * (1.f / DM) + EPSV);
#pragma unroll
      for (int ni = 0; ni < 4; ni++)
#pragma unroll
        for (int r = 0; r < 4; r++) acc[mi][ni][r] = sigmoidf_(acc[mi][ni][r] * rs);
    }
    ZERO_ACC(acc2);
    gemm_tile<true>(p.pb, 256, p.wt_pp, 256, 256, m0, n0, s, acc2);
#pragma unroll
    for (int mi = 0; mi < 4; mi++)
#pragma unroll
      for (int ni = 0; ni < 4; ni++) {
        const size_t idx = (size_t)(m0 + wr * 64 + mi * 16 + l15) * DM + n0 + wc * 64 + ni * 16 + g * 4;
        float hp[4];
        unpack4(*(const uint2*)&p.actA[idx], hp);
        const float h0 = hp[0] + acc[mi][ni][0] * acc2[mi][ni][0], h1 = hp[1] + acc[mi][ni][1] * acc2[mi][ni][1];
        const float h2 = hp[2] + acc[mi][ni][2] * acc2[mi][ni][2], h3 = hp[3] + acc[mi][ni][3] * acc2[mi][ni][3];
        { uint2 o; o.x = pack2(h0, h1); o.y = pack2(h2, h3); *(uint2*)&p.hb[idx] = o; }
        acc2[mi][ni] = (f32x4){h0 * h0, h1 * h1, h2 * h2, h3 * h3};
      }
    row_sumsq_add(acc2, p.rss + 2 * NTOK, m0 + wr * 64, l15, g);
  }
}

#define QLD 136
#define KLD 72
struct GdnSmem {
  u16 qb[64 * QLD];
  u16 kn[64 * QLD];
  u16 vb[64 * QLD];
  float Am[64 * 64];
  float gc[64], beta[64], be[64];
};
static_assert(offsetof(GdnSmem, kn) == 17408 && offsetof(GdnSmem, vb) == 34816 && offsetof(GdnSmem, Am) == 52224, "layout");


__device__ void gdn_unit(const P& p, int unit, GdnSmem& s) {
  int tid = threadIdx.x;
  asm volatile("" : "+v"(tid));
  int lane = tid & 63, wave = tid >> 6;
  int l15 = lane & 15, g = lane >> 4;
#define GDN_REFRESH() do { tid = threadIdx.x; asm volatile("" : "+v"(tid) :: "memory"); lane = tid & 63; wave = tid >> 6; l15 = lane & 15; g = lane >> 4; } while (0)
  const int bh = unit >> 5, n = unit & 31;
  const int b = bh >> 2, h = bh & 3;
  const int tb = b * SEQ;
  const int s0 = n * 64;
  u16* const qk_s = s.qb;
  u16* const WU = s.kn;
  u16* const kdT = (u16*)((unsigned char*)s.kn + 32768);
  __syncthreads();
  if (wave == 0) {
    const int t = tb + s0 + lane;
    const float ga = p.gates[(size_t)t * 16 + h], gb = p.gates[(size_t)t * 16 + 4 + h];
    const float xx = ga + p.dt_bias[h];
    const float sp = (xx > 20.f) ? xx : log1pf(__expf(xx));
    float gg = -__expf(p.a_log[h]) * sp;
#pragma unroll
    for (int off = 1; off < 64; off <<= 1) {
      float nb = __shfl_up(gg, off);
      if (lane >= off) gg += nb;
    }
    const float bt = sigmoidf_(gb);
    s.gc[lane] = gg;
    s.beta[lane] = bt;
    s.be[lane] = bt * __expf(gg);
  }
  {
    const int ch = tid & 15, rg = tid >> 4;
#pragma unroll 1
    for (int mat = 0; mat < 3; mat++) {
      const int col0 = mat * 512 + h * 128 + ch * 8;
      float cw[4][8];
#pragma unroll
      for (int k = 0; k < 4; k++) {
        const float4 w0 = *(const float4*)&p.conv_w[k * 1536 + col0];
        const float4 w1 = *(const float4*)&p.conv_w[k * 1536 + col0 + 4];
        cw[k][0] = w0.x; cw[k][1] = w0.y; cw[k][2] = w0.z; cw[k][3] = w0.w;
        cw[k][4] = w1.x; cw[k][5] = w1.y; cw[k][6] = w1.z; cw[k][7] = w1.w;
      }
      uint4 xr[7];
#pragma unroll
      for (int j = 0; j < 7; j++) {
        const int sp = s0 + 4 * rg + j - 3;
        xr[j] = (sp >= 0) ? *(const uint4*)&p.proj[(size_t)(tb + sp) * PROJW + col0] : make_uint4(0u, 0u, 0u, 0u);
      }
      float xf[7][8];
#pragma unroll
      for (int j = 0; j < 7; j++) unpack8(xr[j], xf[j]);
      u16* dst = (mat == 0) ? s.qb : ((mat == 1) ? s.kn : s.vb);
#pragma unroll
      for (int r = 0; r < 4; r++) {
        float val[8];
        float ss = 0.f;
#pragma unroll
        for (int c = 0; c < 8; c++) {
          const float cv = cw[0][c] * xf[r][c] + cw[1][c] * xf[r + 1][c] + cw[2][c] * xf[r + 2][c] + cw[3][c] * xf[r + 3][c];
          val[c] = siluf(cv);
          ss += val[c] * val[c];
        }
        float rs = 1.f;
        if (mat < 2) {
#pragma unroll
          for (int off = 1; off < 16; off <<= 1) ss += __shfl_xor(ss, off);
          rs = rsqrtf(ss + EPSV) * ((mat == 0) ? 0.08838834764831845f : 1.f);
        }
        uint4 o;
        o.x = pack2(val[0] * rs, val[1] * rs); o.y = pack2(val[2] * rs, val[3] * rs);
        o.z = pack2(val[4] * rs, val[5] * rs); o.w = pack2(val[6] * rs, val[7] * rs);
        *(uint4*)&dst[(4 * rg + r) * QLD + ch * 8] = o;
      }
    }
  }
  __syncthreads();
  GDN_REFRESH();
  u16* const gQ = p.gQ + (size_t)unit * 8192;
  {
#pragma unroll
    for (int it = 0; it < 4; it++) {
      const int idx = tid + 256 * it;
      const int i = idx >> 4, d8 = (idx & 15) * 8;
      const float e = __expf(s.gc[i]);
      float f[8];
      unpack8(*(const uint4*)&s.qb[i * QLD + d8], f);
      uint4 o;
      o.x = pack2(f[0] * e, f[1] * e); o.y = pack2(f[2] * e, f[3] * e);
      o.z = pack2(f[4] * e, f[5] * e); o.w = pack2(f[6] * e, f[7] * e);
      *(uint4*)&gQ[i * 128 + d8] = o;
    }
  }
  f32x4 cqk[4];
  {
    bf16x8 aq[4], ak[4];
#pragma unroll
    for (int ks = 0; ks < 4; ks++) {
      aq[ks] = *(const bf16x8*)&s.qb[(wave * 16 + l15) * QLD + ks * 32 + g * 8];
      ak[ks] = *(const bf16x8*)&s.kn[(wave * 16 + l15) * QLD + ks * 32 + g * 8];
    }
#pragma unroll
    for (int ni = 0; ni < 4; ni++) {
      f32x4 ckk = {0.f, 0.f, 0.f, 0.f};
      cqk[ni] = (f32x4){0.f, 0.f, 0.f, 0.f};
      if (ni <= wave) {
#pragma unroll
        for (int ks = 0; ks < 4; ks++) {
          bf16x8 bk = *(const bf16x8*)&s.kn[(ni * 16 + l15) * QLD + ks * 32 + g * 8];
          ckk = mfma16(ak[ks], bk, ckk);
          cqk[ni] = mfma16(aq[ks], bk, cqk[ni]);
        }
      }
      const int j = ni * 16 + l15;
      const float gcj = s.gc[j];
#pragma unroll
      for (int r = 0; r < 4; r++) {
        const int i = wave * 16 + g * 4 + r;
        const float dec = (i >= j) ? __expf(s.gc[i] - gcj) : 0.f;
        s.Am[i * 64 + j] = (i > j) ? ckk[r] * s.beta[i] * dec : 0.f;
        cqk[ni][r] = (i >= j) ? cqk[ni][r] * dec : 0.f;
      }
    }
  }
  __syncthreads();
  GDN_REFRESH();
#pragma unroll
  for (int ni = 0; ni < 4; ni++)
#pragma unroll
    for (int r = 0; r < 4; r++) qk_s[(wave * 16 + g * 4 + r) * KLD + ni * 16 + l15] = f2bf(cqk[ni][r]);
  float xs[64];
#ifdef NO_SOLVE
  for (int i = 0; i < 64; i++) xs[i] = s.Am[i*64+tid%64];
#else
  {
    const int c = tid;
    const u16* src = (c < 128) ? &s.vb[c] : &s.kn[c - 128];
    const float* sc = (c < 128) ? s.beta : s.be;
#pragma unroll
    for (int i = 0; i < 64; i++) {
      float a0 = bf2f(src[i * QLD]) * sc[i], a1 = 0.f, a2 = 0.f, a3 = 0.f;
#pragma unroll
      for (int j4 = 0; j4 < (i + 3) / 4; j4++) {
        const float4 av = *(const float4*)&s.Am[i * 64 + j4 * 4];
        if (j4 * 4 + 0 < i) a0 -= av.x * xs[j4 * 4 + 0];
        if (j4 * 4 + 1 < i) a1 -= av.y * xs[j4 * 4 + 1];
        if (j4 * 4 + 2 < i) a2 -= av.z * xs[j4 * 4 + 2];
        if (j4 * 4 + 3 < i) a3 -= av.w * xs[j4 * 4 + 3];
      }
      xs[i] = (a0 + a1) + (a2 + a3);
      asm volatile("" : "+v"(xs[i]) :: "memory");
    }
  }
#endif
  const float glast = s.gc[63];
  __syncthreads();
  GDN_REFRESH();
  {
    const int d = tid & 127, half = tid >> 7;
#pragma unroll
    for (int q = 0; q < 4; q++) {
      unsigned ow[4];
#pragma unroll
      for (int e2 = 0; e2 < 4; e2++) {
        const int c0 = half * 32 + q * 8 + e2 * 2;
        const float v0 = bf2f(s.kn[c0 * QLD + d]) * __expf(glast - s.gc[c0]);
        const float v1 = bf2f(s.kn[(c0 + 1) * QLD + d]) * __expf(glast - s.gc[c0 + 1]);
        ow[e2] = pack2(v0, v1);
      }
      *(uint4*)&kdT[d * KLD + half * 32 + q * 8] = make_uint4(ow[0], ow[1], ow[2], ow[3]);
    }
    if (tid == 0) p.gdl[unit] = __expf(glast);
  }
  __syncthreads();
  GDN_REFRESH();
  if (tid >= 128) {
#pragma unroll
    for (int q = 0; q < 8; q++)
      *(uint4*)&WU[(tid - 128) * KLD + q * 8] = make_uint4(pack2(xs[q * 8], xs[q * 8 + 1]), pack2(xs[q * 8 + 2], xs[q * 8 + 3]),
                                                            pack2(xs[q * 8 + 4], xs[q * 8 + 5]), pack2(xs[q * 8 + 6], xs[q * 8 + 7]));
  }
  __syncthreads();
  GDN_REFRESH();
  {
    u16* const gM = p.gM + (size_t)unit * 16384;
    bf16x8 aw[2][2];
#pragma unroll
    for (int mm = 0; mm < 2; mm++)
#pragma unroll
      for (int ks = 0; ks < 2; ks++) aw[mm][ks] = *(const bf16x8*)&WU[((2 * wave + mm) * 16 + l15) * KLD + ks * 32 + g * 8];
#pragma unroll
    for (int nn = 0; nn < 8; nn++) {
      const bf16x8 b0 = *(const bf16x8*)&kdT[(nn * 16 + l15) * KLD + g * 8];
      const bf16x8 b1 = *(const bf16x8*)&kdT[(nn * 16 + l15) * KLD + 32 + g * 8];
#pragma unroll
      for (int mm = 0; mm < 2; mm++) {
        f32x4 acc = {0.f, 0.f, 0.f, 0.f};
        acc = mfma16(aw[mm][0], b0, acc);
        acc = mfma16(aw[mm][1], b1, acc);
        uint2 o; o.x = pack2(-acc[0], -acc[1]); o.y = pack2(-acc[2], -acc[3]);
        *(uint2*)&gM[(nn * 16 + l15) * 128 + (2 * wave + mm) * 16 + 4 * g] = o;
      }
    }
#pragma unroll
    for (int nn = 0; nn < 4; nn++) {
      const bf16x8 b0 = *(const bf16x8*)&qk_s[(nn * 16 + l15) * KLD + g * 8];
      const bf16x8 b1 = *(const bf16x8*)&qk_s[(nn * 16 + l15) * KLD + 32 + g * 8];
#pragma unroll
      for (int mm = 0; mm < 2; mm++) {
        f32x4 acc = {0.f, 0.f, 0.f, 0.f};
        acc = mfma16(aw[mm][0], b0, acc);
        acc = mfma16(aw[mm][1], b1, acc);
        u16* qp = &gQ[(nn * 16 + l15) * 128 + (2 * wave + mm) * 16 + 4 * g];
        float qv[4];
        unpack4(*(const uint2*)qp, qv);
        uint2 o; o.x = pack2(qv[0] - acc[0], qv[1] - acc[1]); o.y = pack2(qv[2] - acc[2], qv[3] - acc[3]);
        *(uint2*)qp = o;
      }
    }
  }
  __syncthreads();
  GDN_REFRESH();
  if (tid < 128) {
#pragma unroll
    for (int q = 0; q < 8; q++)
      *(uint4*)&WU[tid * KLD + q * 8] = make_uint4(pack2(xs[q * 8], xs[q * 8 + 1]), pack2(xs[q * 8 + 2], xs[q * 8 + 3]),
                                                    pack2(xs[q * 8 + 4], xs[q * 8 + 5]), pack2(xs[q * 8 + 6], xs[q * 8 + 7]));
  }
  __syncthreads();
  GDN_REFRESH();
  {
    u16* const gC = p.gC + (size_t)unit * 16384;
    u16* const gO = p.gO + (size_t)unit * 8192;
    bf16x8 akd[2][2], aqk[2];
#pragma unroll
    for (int mm = 0; mm < 2; mm++)
#pragma unroll
      for (int ks = 0; ks < 2; ks++) akd[mm][ks] = *(const bf16x8*)&kdT[((2 * wave + mm) * 16 + l15) * KLD + ks * 32 + g * 8];
#pragma unroll
    for (int ks = 0; ks < 2; ks++) aqk[ks] = *(const bf16x8*)&qk_s[(wave * 16 + l15) * KLD + ks * 32 + g * 8];
#pragma unroll
    for (int nn = 0; nn < 8; nn++) {
      const bf16x8 b0 = *(const bf16x8*)&WU[(nn * 16 + l15) * KLD + g * 8];
      const bf16x8 b1 = *(const bf16x8*)&WU[(nn * 16 + l15) * KLD + 32 + g * 8];
#pragma unroll
      for (int mm = 0; mm < 2; mm++) {
        f32x4 acc = {0.f, 0.f, 0.f, 0.f};
        acc = mfma16(akd[mm][0], b0, acc);
        acc = mfma16(akd[mm][1], b1, acc);
        uint2 o; o.x = pack2(acc[0], acc[1]); o.y = pack2(acc[2], acc[3]);
        *(uint2*)&gC[(nn * 16 + l15) * 128 + (2 * wave + mm) * 16 + 4 * g] = o;
      }
      {
        f32x4 acc = {0.f, 0.f, 0.f, 0.f};
        acc = mfma16(aqk[0], b0, acc);
        acc = mfma16(aqk[1], b1, acc);
        uint2 o; o.x = pack2(acc[0], acc[1]); o.y = pack2(acc[2], acc[3]);
        *(uint2*)&gO[(nn * 16 + l15) * 64 + wave * 16 + 4 * g] = o;
      }
    }
  }
}

__device__ void fox_cumsum_unit(const P& p, int bhf, float* red) {
  const int tid = threadIdx.x, lane = tid & 63, wave = tid >> 6;
  const int b = bhf >> 3, hf = bhf & 7;
  const float bias = p.fox_f_bias[hf];
  float v[8];
  float run = 0.f;
#pragma unroll
  for (int i = 0; i < 8; i++) {
    const int t = b * SEQ + tid * 8 + i;
    const float xx = p.gates[(size_t)t * 16 + 8 + hf] + bias;
    const float ls = fminf(xx, 0.f) - log1pf(__expf(-fabsf(xx)));
    run += ls;
    v[i] = run;
  }
  float tot = run;
#pragma unroll
  for (int off = 1; off < 64; off <<= 1) {
    float nb = __shfl_up(tot, off);
    if (lane >= off) tot += nb;
  }
  __syncthreads();
  if (lane == 63) red[wave] = tot;
  __syncthreads();
  float base = tot - run;
  for (int w = 0; w < wave; w++) base += red[w];
#pragma unroll
  for (int i = 0; i < 8; i++) p.cf[(size_t)bhf * SEQ + tid * 8 + i] = v[i] + base;
}

__device__ void phase_gdnprep(const P& p, unsigned char* smem) {
  GdnSmem& s = *(GdnSmem*)smem;
  for (int u = blockIdx.x; u < 1024 + 64; u += gridDim.x) {
    if (u < 1024) gdn_unit(p, u, s);
    else { __syncthreads(); fox_cumsum_unit(p, u - 1024, (float*)smem); }
  }
}

#define SLD 136
#define NSCAN 128
struct ScanSmem { u16 st[2][32 * SLD]; };
struct ScanSet { bf16x8 mf[2][4]; uint2 ci[2][2]; float dl; };

__device__ __forceinline__ void scan_load(const P& p, int unit, int eq, int w, int l15, int g, ScanSet& z) {
  int la = (32 * w + l15) * 128 + 8 * g, lc = (32 * eq + l15) * 128 + 32 * w + 4 * g;
  asm volatile("" : "+v"(la), "+v"(lc));
  const u16* gM = p.gM + (size_t)unit * 16384;
  const u16* gC = p.gC + (size_t)unit * 16384;
#pragma unroll
  for (int md = 0; md < 2; md++)
#pragma unroll
    for (int ks = 0; ks < 4; ks++) z.mf[md][ks] = *(const bf16x8*)&gM[la + md * 16 * 128 + ks * 32];
#pragma unroll
  for (int md = 0; md < 2; md++)
#pragma unroll
    for (int ne = 0; ne < 2; ne++) z.ci[md][ne] = *(const uint2*)&gC[lc + ne * 16 * 128 + md * 16];
  z.dl = p.gdl[unit];
}

__device__ __forceinline__ unsigned scan_touch(const P& p, int unit, int lane) {
  unsigned v = 0u;
  if (lane < 16) {
    const u16* base = (lane < 8) ? (p.gM + (size_t)unit * 16384) : (p.gC + (size_t)unit * 16384);
    v = *(const unsigned*)(base + (lane & 7) * 2048);
  }
  return v;
}

__device__ __forceinline__ void scan_step(const P& p, int unit, int n, int eq, int w, int l15, int g, ScanSmem& s,
                                          f32x4 (&st)[2][2], const ScanSet& z) {
  const u16* Sb = s.st[n & 1];
  u16* Sn = s.st[(n & 1) ^ 1];
#pragma unroll
  for (int md = 0; md < 2; md++)
#pragma unroll
    for (int ne = 0; ne < 2; ne++) {
      float c[4];
      unpack4(z.ci[md][ne], c);
      st[md][ne][0] = st[md][ne][0] * z.dl + c[0];
      st[md][ne][1] = st[md][ne][1] * z.dl + c[1];
      st[md][ne][2] = st[md][ne][2] * z.dl + c[2];
      st[md][ne][3] = st[md][ne][3] * z.dl + c[3];
    }
  if (n > 0) {
    int lb = l15 * SLD + 8 * g;
    asm volatile("" : "+v"(lb));
#pragma unroll
    for (int ne = 0; ne < 2; ne++) {
#pragma unroll
      for (int ks = 0; ks < 4; ks++) {
        const bf16x8 bs = *(const bf16x8*)&Sb[lb + 16 * ne * SLD + ks * 32];
        st[0][ne] = mfma16(z.mf[0][ks], bs, st[0][ne]);
        st[1][ne] = mfma16(z.mf[1][ks], bs, st[1][ne]);
      }
    }
  }
  if (n + 1 < 32) {
    u16* gS = p.gS + (size_t)(unit + 1) * 16384;
    int lsl = l15 * SLD + 32 * w + 4 * g, lsg = (32 * eq + l15) * 128 + 32 * w + 4 * g;
    asm volatile("" : "+v"(lsl), "+v"(lsg));
#pragma unroll
    for (int md = 0; md < 2; md++)
#pragma unroll
      for (int ne = 0; ne < 2; ne++) {
        uint2 o; o.x = pack2(st[md][ne][0], st[md][ne][1]); o.y = pack2(st[md][ne][2], st[md][ne][3]);
        *(uint2*)&Sn[lsl + 16 * ne * SLD + 16 * md] = o;
        *(uint2*)&gS[lsg + 16 * ne * 128 + 16 * md] = o;
      }
  }
  asm volatile("s_waitcnt lgkmcnt(0)" ::: "memory");
  __builtin_amdgcn_s_barrier();
  asm volatile("" ::: "memory");
}

__device__ void scan_unit(const P& p, int item, ScanSmem& s) {
  int tid = threadIdx.x;
  asm volatile("" : "+v"(tid));
  const int lane = tid & 63, w = tid >> 6;
  const int l15 = lane & 15, g = lane >> 4;
  const int bh = item >> 2, eq = item & 3;
  const int u0 = bh * 32;
  f32x4 st[2][2];
#pragma unroll
  for (int md = 0; md < 2; md++)
#pragma unroll
    for (int ne = 0; ne < 2; ne++) st[md][ne] = (f32x4){0.f, 0.f, 0.f, 0.f};
  ScanSet z0, z1, z2, z3;
  scan_load(p, u0 + 0, eq, w, l15, g, z0);
  scan_load(p, u0 + 1, eq, w, l15, g, z1);
  scan_load(p, u0 + 2, eq, w, l15, g, z2);
  unsigned tacc = 0u, tprev = 0u;
  __builtin_amdgcn_s_setprio(3);
#pragma unroll 1
  for (int n = 0; n < 32; n += 4) {
    tacc += tprev;
    tprev = 0u;
    if (n + 8 < 32) {
      tprev = scan_touch(p, u0 + n + 8, lane) + scan_touch(p, u0 + n + 9, lane) + scan_touch(p, u0 + n + 10, lane) +
              scan_touch(p, u0 + n + 11, lane);
    }
    scan_load(p, u0 + n + 3, eq, w, l15, g, z3);
    scan_step(p, u0 + n, n, eq, w, l15, g, s, st, z0);
    if (n + 4 < 32) scan_load(p, u0 + n + 4, eq, w, l15, g, z0);
    scan_step(p, u0 + n + 1, n + 1, eq, w, l15, g, s, st, z1);
    if (n + 4 < 32) scan_load(p, u0 + n + 5, eq, w, l15, g, z1);
    scan_step(p, u0 + n + 2, n + 2, eq, w, l15, g, s, st, z2);
    if (n + 4 < 32) scan_load(p, u0 + n + 6, eq, w, l15, g, z2);
    scan_step(p, u0 + n + 3, n + 3, eq, w, l15, g, s, st, z3);
  }
  __builtin_amdgcn_s_setprio(0);
  asm volatile("" :: "v"(tacc));
}

#define OLD 136
struct GoutSmem { float ssq[4][64]; u16 ob[64 * OLD]; };

__device__ void gout_unit(const P& p, int unit, GoutSmem& s) {
  const int tid = threadIdx.x, lane = tid & 63, w = tid >> 6;
  const int l15 = lane & 15, g = lane >> 4;
  const int bh = unit >> 5, n = unit & 31;
  const int b = bh >> 2, h = bh & 3;
  const u16* gQ = p.gQ + (size_t)unit * 8192;
  const u16* gO = p.gO + (size_t)unit * 8192;
  const u16* gS = p.gS + (size_t)unit * 16384;
  f32x4 o[4][2];
#pragma unroll
  for (int mc = 0; mc < 4; mc++)
#pragma unroll
    for (int ne = 0; ne < 2; ne++) {
      float c[4];
      unpack4(*(const uint2*)&gO[(32 * w + 16 * ne + l15) * 64 + 16 * mc + 4 * g], c);
      o[mc][ne] = (f32x4){c[0], c[1], c[2], c[3]};
    }
  if (n > 0) {
    bf16x8 bs[2][4];
#pragma unroll
    for (int ne = 0; ne < 2; ne++)
#pragma unroll
      for (int ks = 0; ks < 4; ks++) bs[ne][ks] = *(const bf16x8*)&gS[(32 * w + 16 * ne + l15) * 128 + ks * 32 + 8 * g];
#pragma unroll
    for (int mc = 0; mc < 4; mc++) {
#pragma unroll
      for (int ks = 0; ks < 4; ks++) {
        const bf16x8 aq = *(const bf16x8*)&gQ[(16 * mc + l15) * 128 + ks * 32 + 8 * g];
        o[mc][0] = mfma16(aq, bs[0][ks], o[mc][0]);
        o[mc][1] = mfma16(aq, bs[1][ks], o[mc][1]);
      }
    }
  }
  const float gnw0 = p.gdn_norm_w[32 * w + l15], gnw1 = p.gdn_norm_w[32 * w + 16 + l15];
  __syncthreads();
#pragma unroll
  for (int mc = 0; mc < 4; mc++)
#pragma unroll
    for (int r = 0; r < 4; r++) {
      float sq = o[mc][0][r] * o[mc][0][r] + o[mc][1][r] * o[mc][1][r];
#pragma unroll
      for (int off = 1; off < 16; off <<= 1) sq += __shfl_xor(sq, off);
      if (l15 == 0) s.ssq[w][16 * mc + 4 * g + r] = sq;
    }
  __syncthreads();
#pragma unroll
  for (int mc = 0; mc < 4; mc++)
#pragma unroll
    for (int r = 0; r < 4; r++) {
      const int c = 16 * mc + 4 * g + r;
      const float tot = s.ssq[0][c] + s.ssq[1][c] + s.ssq[2][c] + s.ssq[3][c];
      const float rs = rsqrtf(tot * (1.f / 128.f) + EPSV);
      s.ob[c * OLD + 32 * w + l15] = f2bf(o[mc][0][r] * rs * gnw0);
      s.ob[c * OLD + 32 * w + 16 + l15] = f2bf(o[mc][1][r] * rs * gnw1);
    }
  __syncthreads();
  {
    const int t0 = b * SEQ + n * 64;
    const int c0 = tid >> 4, ch = tid & 15;
    const u16* zp = p.proj + (size_t)(t0 + c0) * PROJW + 1536 + h * 128 + ch * 8;
    u16* op = p.actA + (size_t)(t0 + c0) * DM + h * 128 + ch * 8;
#pragma unroll
    for (int i = 0; i < 4; i++) {
      float ov[8], zv[8];
      unpack8(*(const uint4*)&s.ob[(c0 + 16 * i) * OLD + ch * 8], ov);
      unpack8(*(const uint4*)(zp + (size_t)i * 16 * PROJW), zv);
      uint4 r;
      r.x = pack2(ov[0] * siluf(zv[0]), ov[1] * siluf(zv[1])); r.y = pack2(ov[2] * siluf(zv[2]), ov[3] * siluf(zv[3]));
      r.z = pack2(ov[4] * siluf(zv[4]), ov[5] * siluf(zv[5])); r.w = pack2(ov[6] * siluf(zv[6]), ov[7] * siluf(zv[7]));
      *(uint4*)(op + (size_t)i * 16 * DM) = r;
    }
  }
}

__device__ void phase_gout(const P& p, unsigned char* smem) {
  GoutSmem& s = *(GoutSmem*)smem;
  for (int u = blockIdx.x; u < 1024; u += gridDim.x) gout_unit(p, u, s);
}

#define LOG2E 1.4426950408889634f
#define ANST 4
struct AttnSmem { u16 k[ANST][64 * 64 + 128]; u16 v[ANST][64 * 64]; };

__device__ void attn_unit(const P& p, int item, AttnSmem& s) {
  int tid = threadIdx.x;
  asm volatile("" : "+v"(tid));
  const int lane = tid & 63, w = tid >> 6;
  const int l15 = lane & 15, g = lane >> 4;
  const int qb = 15 - (item >> 6), bhf = item & 63;
  const int b = bhf >> 3, hf = bhf & 7;
  const int q0 = qb * 128 + 32 * w;
  const u16* qbase = p.proj + (size_t)(b * SEQ) * PROJW + 2048 + hf * 64;
  const u16* kbase = p.proj + (size_t)(b * SEQ) * PROJW + 2560 + hf * 64;
  const u16* vbase = p.vt + (size_t)bhf * 64 * SEQ;
  const float* cfb = p.cf + (size_t)bhf * SEQ;
  bf16x8 qf[2][2];
#pragma unroll
  for (int mi = 0; mi < 2; mi++)
#pragma unroll
    for (int ks = 0; ks < 2; ks++) qf[mi][ks] = *(const bf16x8*)&qbase[(size_t)(q0 + 16 * mi + l15) * PROJW + ks * 32 + g * 8];
  float cq[2], m[2], lsum[2];
  f32x4 O[2][4];
#pragma unroll
  for (int mi = 0; mi < 2; mi++) {
    cq[mi] = cfb[q0 + 16 * mi + l15]; m[mi] = -1e30f; lsum[mi] = 0.f;
#pragma unroll
    for (int nd = 0; nd < 4; nd++) O[mi][nd] = (f32x4){0.f, 0.f, 0.f, 0.f};
  }
  asm volatile("" :: "v"(cq[0]), "v"(cq[1]), "v"(qf[0][0]), "v"(qf[0][1]), "v"(qf[1][0]), "v"(qf[1][1]));
  const int ntile = (q0 + 32 + 63) >> 6;
  const int ntile_blk = 2 * qb + 2;
  const int drow = 8 * w + (lane >> 3);
  const int dchunk = (lane & 7) ^ ((4 * (w & 1) + (lane >> 4)) & 7);
  const u16* kg = kbase + (size_t)drow * PROJW + dchunk * 8;
  const u16* vg = vbase + (size_t)drow * SEQ + dchunk * 8;
  const float* cg_ = cfb + lane;
  u16* const skw = &s.k[0][0] + (8 * w) * 64;
  u16* const svw = &s.v[0][0] + (8 * w) * 64;
#define A_DMA(st, kk0) do { \
    u16* _dk = skw + (st) * (64 * 64 + 128); u16* _dv = svw + (st) * (64 * 64); \
    __builtin_amdgcn_global_load_lds((const unsigned*)(kg + (size_t)(kk0) * PROJW), (unsigned*)(_dk), 16, 0, 0); \
    __builtin_amdgcn_global_load_lds((const unsigned*)(kg + (size_t)((kk0) + 32) * PROJW), (unsigned*)(_dk + 32 * 64), 16, 0, 0); \
    __builtin_amdgcn_global_load_lds((const unsigned*)(vg + (kk0)), (unsigned*)(_dv), 16, 0, 0); \
    __builtin_amdgcn_global_load_lds((const unsigned*)(vg + (size_t)32 * SEQ + (kk0)), (unsigned*)(_dv + 32 * 64), 16, 0, 0); \
    __builtin_amdgcn_global_load_lds((const unsigned*)(cg_ + (kk0)), (unsigned*)(&s.k[0][0] + (st) * (64 * 64 + 128) + 64 * 64), 4, 0, 0); \
  } while (0)
  {
    const int npro = (ntile_blk > 2) ? 3 : 2;
#pragma unroll 1
    for (int j = 0; j < npro; j++) A_DMA(j, j * 64);
  }
  int ko[4][2];
#pragma unroll
  for (int t = 0; t < 4; t++) {
    const int row = 32 * (t >> 1) + 8 * (l15 >> 2) + 4 * (t & 1) + (l15 & 3);
    const int sw = (row >> 1) & 7;
    ko[t][0] = row * 64 + ((g ^ sw) * 8);
    ko[t][1] = row * 64 + (((4 + g) ^ sw) * 8);
  }
  const int swz = l15 >> 1;
  int vo[2];
  vo[0] = l15 * 64 + ((g ^ swz) * 8);
  vo[1] = l15 * 64 + (((4 + g) ^ swz) * 8);
#pragma unroll 1
  for (int kt = 0; kt < ntile_blk; kt++) {
    const int k0 = kt * 64, st = kt & 3;
    const int rem = ntile_blk - 1 - kt;
    if (rem >= 2) asm volatile("s_waitcnt vmcnt(10)" ::: "memory");
    else if (rem == 1) asm volatile("s_waitcnt vmcnt(5)" ::: "memory");
    else asm volatile("s_waitcnt vmcnt(0)" ::: "memory");
    asm volatile("s_waitcnt lgkmcnt(0)" ::: "memory");
    __builtin_amdgcn_s_barrier();
    asm volatile("" ::: "memory");
    if (kt + 3 < ntile_blk) { const int st3 = (kt + 3) & 3; A_DMA(st3, k0 + 192); }
    if (kt < ntile) {
      const u16* Ks = s.k[st];
      const u16* Vs = s.v[st];
      f32x4 ST[2][4];
#pragma unroll
      for (int t = 0; t < 4; t++) {
        const bf16x8 kf0 = *(const bf16x8*)&Ks[ko[t][0]];
        const bf16x8 kf1 = *(const bf16x8*)&Ks[ko[t][1]];
#pragma unroll
        for (int mi = 0; mi < 2; mi++) {
          f32x4 acc = {0.f, 0.f, 0.f, 0.f};
          acc = mfma16(kf0, qf[mi][0], acc);
          acc = mfma16(kf1, qf[mi][1], acc);
          ST[mi][t] = acc;
        }
      }
      f32x4 ck[4];
      {
        const unsigned cka = (unsigned)(size_t)(&Ks[64 * 64]) + 32u * g;
        asm volatile("ds_read_b128 %0, %4\n\tds_read_b128 %1, %4 offset:16\n\tds_read_b128 %2, %4 offset:128\n\t"
                     "ds_read_b128 %3, %4 offset:144\n\ts_waitcnt lgkmcnt(0)"
                     : "=&v"(ck[0]), "=&v"(ck[1]), "=&v"(ck[2]), "=&v"(ck[3]) : "v"(cka) : "memory");
      }
      const bool diag = (kt == ntile - 1);
      bf16x8 pf[2][2];
#pragma unroll
      for (int mi = 0; mi < 2; mi++) {
        const int qpos = q0 + 16 * mi + l15;
        float mx = -1e30f;
#pragma unroll
        for (int t = 0; t < 4; t++) {
          const float ckv[4] = {ck[t][0], ck[t][1], ck[t][2], ck[t][3]};
#pragma unroll
          for (int r = 0; r < 4; r++) {
            float lg = ST[mi][t][r] * (0.125f * LOG2E) + (cq[mi] - ckv[r]) * LOG2E;
            if (diag && (k0 + 32 * (t >> 1) + 8 * g + 4 * (t & 1) + r > qpos)) lg = -1e30f;
            ST[mi][t][r] = lg;
            mx = fmaxf(mx, lg);
          }
        }
        mx = fmaxf(mx, __shfl_xor(mx, 16));
        mx = fmaxf(mx, __shfl_xor(mx, 32));
        const float mn = fmaxf(m[mi], mx);
        const float alpha = __builtin_amdgcn_exp2f(m[mi] - mn);
        m[mi] = mn;
        float ps = 0.f;
#pragma unroll
        for (int t = 0; t < 4; t++)
#pragma unroll
          for (int r = 0; r < 4; r++) {
            const float pe = __builtin_amdgcn_exp2f(ST[mi][t][r] - mn);
            ST[mi][t][r] = pe;
            ps += pe;
          }
        lsum[mi] = lsum[mi] * alpha + ps;
#pragma unroll
        for (int kk = 0; kk < 2; kk++) {
          uint4 pk;
          pk.x = pack2(ST[mi][2 * kk][0], ST[mi][2 * kk][1]); pk.y = pack2(ST[mi][2 * kk][2], ST[mi][2 * kk][3]);
          pk.z = pack2(ST[mi][2 * kk + 1][0], ST[mi][2 * kk + 1][1]); pk.w = pack2(ST[mi][2 * kk + 1][2], ST[mi][2 * kk + 1][3]);
          pf[mi][kk] = __builtin_bit_cast(bf16x8, pk);
        }
#pragma unroll
        for (int r = 0; r < 4; r++) {
          const float ar = __shfl(alpha, 4 * g + r);
#pragma unroll
          for (int nd = 0; nd < 4; nd++) O[mi][nd][r] *= ar;
        }
      }
#pragma unroll
      for (int nd = 0; nd < 4; nd++)
#pragma unroll
        for (int kk = 0; kk < 2; kk++) {
          const bf16x8 vf = *(const bf16x8*)&Vs[16 * nd * 64 + vo[kk]];
          O[0][nd] = mfma16(pf[0][kk], vf, O[0][nd]);
          O[1][nd] = mfma16(pf[1][kk], vf, O[1][nd]);
        }
    }
  }
#pragma unroll
  for (int mi = 0; mi < 2; mi++) {
    float l = lsum[mi];
    l += __shfl_xor(l, 16);
    l += __shfl_xor(l, 32);
    const float inv = 1.f / l;
#pragma unroll
    for (int r = 0; r < 4; r++) {
      const float ir = __shfl(inv, 4 * g + r);
      const int t = b * SEQ + q0 + 16 * mi + 4 * g + r;
#pragma unroll
      for (int nd = 0; nd < 4; nd++) p.actA[(size_t)t * DM + 512 + hf * 64 + 16 * nd + l15] = f2bf(O[mi][nd][r] * ir);
    }
  }
}

__device__ void deferred_transpose(const P& p, int it, float* tile) {
  const int n1 = 16 * 16, n2 = n1 + 16 * 88, n3 = n2 + 44 * 16, n4 = n3 + 16 * 16;
  if (it < n1) { transpose_item(p.w_out, 1024, p.wt_out, 1024, it % 16, it / 16, 1, tile); }
  else if (it < n2) { int j = it - n1; transpose_item(p.w_gate_up, 2 * DFF, p.wt_gu, 1024, j % 16, j / 16, 2, tile, p.ffn_norm_w); }
  else if (it < n3) { int j = it - n2; transpose_item(p.w_down, 1024, p.wt_down, DFF, j % 44, j / 44, 1, tile); }
  else if (it < n4) { int j = it - n3; transpose_item(p.w_ple_gate, 1024, p.wt_pg, 1024, j % 16, j / 16, 1, tile, p.ple_norm_w); }
  else { int j = it - n4; transpose_item(p.w_ple_proj, 1024, p.wt_pp, 256, j % 4, j / 4, 1, tile); }
}
#define N_DEFER (16 * 16 + 16 * 88 + 44 * 16 + 16 * 16 + 4 * 16)

__device__ void phase_mixer(const P& p, unsigned char* smem, int rr) {
  volatile int* s_item_p = (volatile int*)(smem + SMEM_MAIN + 16);
  for (;;) {
    __syncthreads();
    if (threadIdx.x == 0) *s_item_p = (int)atomicAdd(&p.counters[rr], 1u);
    __syncthreads();
    const int item = *s_item_p;
    if (item >= NSCAN + 1024 + N_DEFER) break;
    if (item < NSCAN) { scan_unit(p, item, *(ScanSmem*)smem); }
    else if (item < NSCAN + 1024) { attn_unit(p, item - NSCAN, *(AttnSmem*)smem); }
    else { deferred_transpose(p, item - NSCAN - 1024, (float*)smem); }
  }
}

#define XB_TMO      128
#define XB_XCNT(j)  (256  + 64 * (j))
#define XB_XSUB(j)  (1280 + 64 * (j))
#define XB_XGEN(j)  (2304 + 64 * (j))
#define XB_TOP      3328
#define XB_TOPGEN   3392
#define XCD_BAR_WORDS 3456
#define XB_SPIN_CAP (1u << 20)
#define LAS __attribute__((address_space(3)))
__device__ __forceinline__ unsigned xb_ld(unsigned* p) { return __hip_atomic_load(p, __ATOMIC_RELAXED, __HIP_MEMORY_SCOPE_AGENT); }
__device__ __forceinline__ unsigned xb_add(unsigned* p, unsigned v) { return __hip_atomic_fetch_add(p, v, __ATOMIC_RELAXED, __HIP_MEMORY_SCOPE_AGENT); }
__device__ __forceinline__ unsigned xb_xcc_id() { return (unsigned)__builtin_amdgcn_s_getreg((3 << 11) | 20) & 0xFu; }
#define XB_SPIN(cond, bar) do { unsigned _sp = 0; while (cond) { __builtin_amdgcn_s_sleep(1); \
    if ((++_sp & 255u) == 0u) { if (xb_ld(&(bar)[XB_TMO])) break; if (_sp > XB_SPIN_CAP) { atomicAdd(&(bar)[XB_TMO], 1u); break; } } } } while (0)
struct XcdBarrier { unsigned* bar; unsigned x; volatile LAS unsigned* st; };
__device__ __forceinline__ XcdBarrier xcd_barrier_post(unsigned* bar, volatile LAS unsigned* st) {
  XcdBarrier b; b.bar = bar; b.x = xb_xcc_id(); b.st = st;
  if (threadIdx.x == 0) (void)xb_add(&bar[XB_XCNT(b.x)], 1u);
  return b;
}
__device__ __forceinline__ void xcd_barrier_complete(unsigned* bar, unsigned x, unsigned& nloc, unsigned& nx) {
  const unsigned G = gridDim.x * gridDim.y * gridDim.z;
  unsigned sum, cnt, mine, sp = 0u;
  for (;;) {
    sum = 0u; cnt = 0u; mine = 0u;
#pragma unroll
    for (unsigned j = 0; j < 16; ++j) { const unsigned c = xb_ld(&bar[XB_XCNT(j)]); sum += c; cnt += (c > 0u) ? 1u : 0u; mine = (j == x) ? c : mine; }
    if (sum == G) break;
    __builtin_amdgcn_s_sleep(1);
    if ((++sp & 255u) == 0u) { if (xb_ld(&bar[XB_TMO])) break; if (sp > XB_SPIN_CAP) { atomicAdd(&bar[XB_TMO], 1u); break; } }
  }
  nloc = mine > 0u ? mine : 1u; nx = cnt > 0u ? cnt : 1u;
}
__device__ __forceinline__ void xcd_barrier(const XcdBarrier& b) {
  asm volatile("s_waitcnt vmcnt(0)" ::: "memory");
  __syncthreads();
  if (threadIdx.x == 0) {
    unsigned* bar = b.bar;
    __builtin_amdgcn_s_waitcnt(0);
    unsigned nloc = b.st[0], nx = b.st[1];
    if (nloc == 0u) { xcd_barrier_complete(bar, b.x, nloc, nx); b.st[0] = nloc; b.st[1] = nx; }
    const unsigned old = xb_add(&bar[XB_XSUB(b.x)], 1u);
    const unsigned gen = old / nloc;
    if (old + 1u == (gen + 1u) * nloc) {
      __builtin_amdgcn_fence(__ATOMIC_RELEASE, "agent");
      asm volatile("s_waitcnt vmcnt(0)" ::: "memory");
      const unsigned og = xb_add(&bar[XB_TOP], 1u);
      const unsigned tg = og / nx;
      if (og + 1u == (tg + 1u) * nx) xb_add(&bar[XB_TOPGEN], 1u);
      else XB_SPIN(xb_ld(&bar[XB_TOPGEN]) == tg, bar);
      __builtin_amdgcn_fence(__ATOMIC_ACQUIRE, "agent");
      xb_add(&bar[XB_XGEN(b.x)], 1u);
      asm volatile("s_waitcnt vmcnt(0)" ::: "memory");
    } else {
      XB_SPIN(xb_ld(&bar[XB_XGEN(b.x)]) == gen, bar);
      __builtin_amdgcn_fence(__ATOMIC_ACQUIRE, "agent");
      asm volatile("s_waitcnt vmcnt(0)" ::: "memory");
    }
  }
  __syncthreads();
}

__global__ void __launch_bounds__(256, 2) mega(P p, int lo, int hi) {
  __shared__ __attribute__((aligned(16))) unsigned char smem[SMEM_MAIN + 32];
  cg::grid_group grid = cg::this_grid();
  uint4* xbw = (uint4*)(smem + SMEM_MAIN);
  if (threadIdx.x == 0) *xbw = make_uint4(0u, 0u, 0u, 0u);
  __syncthreads();
  XcdBarrier xb = xcd_barrier_post(p.bar, (volatile LAS unsigned*)xbw);
  if (hi < 0) grid.sync();
#define SEAM(k) if (lo <= k && k + 1 < hi) xcd_barrier(xb);
#if !defined(ONLY) || ONLY == 0
  if (lo <= 0 && 0 < hi) phase_prep(p, smem);
#endif
  SEAM(0)
#if !defined(ONLY) || ONLY == 1
  if (lo <= 1 && 1 < hi) phase_inproj(p, smem);
#endif
  SEAM(1)
#if !defined(ONLY) || ONLY == 2
  if (lo <= 2 && 2 < hi) phase_gdnprep(p, smem);
#endif
  SEAM(2)
#if !defined(ONLY) || ONLY == 3
  if (lo <= 3 && 3 < hi) phase_mixer(p, smem, 0);
#endif
  SEAM(3)
#if !defined(ONLY) || ONLY == 4
  if (lo <= 4 && 4 < hi) phase_gout(p, smem);
#endif
  SEAM(4)
#if !defined(ONLY) || ONLY == 5
  if (lo <= 5 && 5 < hi) phase_outproj(p, smem);
#endif
  SEAM(5)
#if !defined(ONLY) || ONLY == 6
  if (lo <= 6 && 6 < hi) phase_gateup(p, smem);
#endif
  SEAM(6)
#if !defined(ONLY) || ONLY == 7
  if (lo <= 7 && 7 < hi) phase_down(p, smem);
#endif
  SEAM(7)
#if !defined(ONLY) || ONLY == 8
  if (lo <= 8 && 8 < hi) phase_ple(p, smem);
#endif
  SEAM(8)
  if (lo <= 9 && 9 < hi) phase_final(p);
}

static_assert(sizeof(GemmSmem) <= SMEM_MAIN && sizeof(Gemm2Smem) <= SMEM_MAIN && sizeof(GdnSmem) <= SMEM_MAIN && sizeof(ScanSmem) <= SMEM_MAIN &&
              sizeof(GoutSmem) <= SMEM_MAIN && sizeof(AttnSmem) <= SMEM_MAIN && 64 * 65 * 4 <= SMEM_MAIN, "smem");

extern "C" void kernel_launch(void* const* d_in, const int* in_sizes, int n_in, void* d_out, int out_size,
                              void* d_ws, size_t ws_size, hipStream_t stream) {
  static int grid_blocks = 0;
  if (!grid_blocks) {
    int dev = 0, cus = 0, per_cu = 0;
    hipGetDevice(&dev);
    hipDeviceGetAttribute(&cus, hipDeviceAttributeMultiprocessorCount, dev);
    hipOccupancyMaxActiveBlocksPerMultiprocessor(&per_cu, mega, 256, 0);
    if (per_cu > 2) per_cu = 2;
    if (per_cu < 1) per_cu = 1;
    grid_blocks = cus * per_cu;
  }
  P p{};
  const float* const* in = (const float* const*)d_in;
  p.x = in[0]; p.p = in[1]; p.attn_norm_w = in[2]; p.w_in = in[3]; p.conv_w = in[4]; p.a_log = in[5];
  p.dt_bias = in[6]; p.gdn_norm_w = in[7]; p.fox_f_bias = in[8]; p.w_out = in[9]; p.ffn_norm_w = in[10];
  p.w_gate_up = in[11]; p.w_down = in[12]; p.ple_norm_w = in[13]; p.w_ple_gate = in[14]; p.w_ple_proj = in[15];
  p.final_norm_w = in[16];
  p.h = (float*)d_out;
  unsigned char* ws = (unsigned char*)d_ws;
  size_t off = 0;
  auto take = [&](size_t bytes) { unsigned char* r = ws + off; off += (bytes + 255) & ~(size_t)255; return r; };
  p.counters = (unsigned*)take(256);
  p.bar = (unsigned*)take(XCD_BAR_WORDS * 4);
  p.wt_in = (u16*)take((size_t)NIN_PAD * 1024 * 2);
  p.wt_out = (u16*)take((size_t)1024 * 1024 * 2);
  p.wt_gu = (u16*)take((size_t)2 * DFF * 1024 * 2);
  p.wt_down = (u16*)take((size_t)1024 * DFF * 2);
  p.wt_pg = (u16*)take((size_t)1024 * 1024 * 2);
  p.wt_pp = (u16*)take((size_t)1024 * 256 * 2);
  p.actA = (u16*)take((size_t)NTOK * 1024 * 2);
  p.pb = (u16*)take((size_t)NTOK * 256 * 2);
  p.proj = (u16*)take((size_t)NTOK * PROJW * 2);
  p.vt = (u16*)take((size_t)64 * 64 * SEQ * 2);
  p.gates = (float*)take((size_t)NTOK * 16 * 4);
  p.cf = (float*)take((size_t)64 * SEQ * 4);
  p.gM = (u16*)take((size_t)1024 * 16384 * 2);
  p.gC = (u16*)take((size_t)1024 * 16384 * 2);
  p.gdl = (float*)take(1024 * 4);
  p.rss = (float*)take((size_t)3 * NTOK * 4);
  p.hb = p.gM;
  if (off > ws_size) fprintf(stderr, "workspace too small: need %zu have %zu\n", off, ws_size);
  u16* ob = (u16*)d_out;
  p.gS = ob;
  p.gQ = ob + (size_t)1024 * 16384;
  p.gO = ob + (size_t)1024 * 16384 + (size_t)1024 * 8192;
  hipMemsetAsync(p.bar, 0, XCD_BAR_WORDS * 4, stream);
  int lo = 0, hi = NPHASE;
  void* args[] = {&p, &lo, &hi};
  hipError_t e = hipLaunchCooperativeKernel((void*)mega, dim3(grid_blocks), dim3(256), args, 0, stream);
  if (e != hipSuccess) fprintf(stderr, "cooperative launch failed: %s (grid %d)\n", hipGetErrorString(e), grid_blocks);
}
```

```cpp
#include <hip/hip_runtime.h>
#include <hip/hip_cooperative_groups.h>
#include <cstdio>
#include <cstdint>
namespace cg = cooperative_groups;

typedef unsigned short u16;
typedef __attribute__((ext_vector_type(8))) short bf16x8;
typedef __attribute__((ext_vector_type(4))) float f32x4;

#define NTOK 16384
#define SEQ 2048
#define DM 1024
#define DFF 2816
#define PROJW 3072
#define NIN_PAD 3712
#define EPSV 1e-6f
#define NPHASE 10
#define SMEM_MAIN 73728

struct P {
  const float *x, *p, *attn_norm_w, *w_in, *conv_w, *a_log, *dt_bias, *gdn_norm_w, *fox_f_bias, *w_out,
      *ffn_norm_w, *w_gate_up, *w_down, *ple_norm_w, *w_ple_gate, *w_ple_proj, *final_norm_w;
  float* h;
  u16 *wt_in, *wt_out, *wt_gu, *wt_down, *wt_pg, *wt_pp;
  u16 *actA;
  u16 *pb;
  u16 *proj;
  u16 *vt;
  float *gates;
  float *cf;
  u16 *gM, *gC;
  u16 *gQ, *gO;
  u16 *gS;
  float *gdl;
  unsigned *counters;
  unsigned *bar;
  u16 *hb;
  float *rss;
};

typedef __attribute__((ext_vector_type(2))) float f32x2_t;
typedef __attribute__((ext_vector_type(2))) __bf16 bf16x2_t;
__device__ __forceinline__ u16 f2bf(float f) { return __builtin_bit_cast(u16, (__bf16)f); }
__device__ __forceinline__ float bf2f(u16 h) { return __uint_as_float(((unsigned)h) << 16); }
__device__ __forceinline__ unsigned pack2(float a, float b) {
  f32x2_t f = {a, b};
  return __builtin_bit_cast(unsigned, __builtin_convertvector(f, bf16x2_t));
}
__device__ __forceinline__ float siluf(float v) { return v / (1.f + __expf(-v)); }
__device__ __forceinline__ float sigmoidf_(float v) { return 1.f / (1.f + __expf(-v)); }
__device__ __forceinline__ f32x4 mfma16(bf16x8 a, bf16x8 b, f32x4 c) {
  return __builtin_amdgcn_mfma_f32_16x16x32_bf16(a, b, c, 0, 0, 0);
}
#define LDS_FENCE() asm volatile("s_waitcnt lgkmcnt(0)" ::: "memory")

__device__ __forceinline__ void unpack8(const uint4& v, float (&f)[8]) {
  f[0] = bf2f((u16)(v.x & 0xffffu)); f[1] = bf2f((u16)(v.x >> 16));
  f[2] = bf2f((u16)(v.y & 0xffffu)); f[3] = bf2f((u16)(v.y >> 16));
  f[4] = bf2f((u16)(v.z & 0xffffu)); f[5] = bf2f((u16)(v.z >> 16));
  f[6] = bf2f((u16)(v.w & 0xffffu)); f[7] = bf2f((u16)(v.w >> 16));
}
__device__ __forceinline__ void unpack4(const uint2& v, float (&f)[4]) {
  f[0] = bf2f((u16)(v.x & 0xffffu)); f[1] = bf2f((u16)(v.x >> 16));
  f[2] = bf2f((u16)(v.y & 0xffffu)); f[3] = bf2f((u16)(v.y >> 16));
}


__device__ __forceinline__ int colmap(int kind, int nn) {
  if (kind == 0) {
    if (nn < 2048) return nn;
    if (nn < 3584) return nn + 8;
    if (nn < 3588) return 2048 + (nn - 3584);
    if (nn < 3592) return 2052 + (nn - 3588);
    if (nn < 3600) return nn;
    return -1;
  } else if (kind == 2) {
    int i = nn >> 7, wc = (nn >> 6) & 1, u = (nn >> 5) & 1, j = nn & 31;
    return u * DFF + 64 * i + 32 * wc + j;
  }
  return nn;
}

__device__ void transpose_item(const float* __restrict__ src, int ldsrc, u16* __restrict__ dst, int K,
                               int kt, int nt, int kind, float* tile, const float* __restrict__ kscale = nullptr) {
  int tid = threadIdx.x;
  asm volatile("" : "+v"(tid));
  const int c = tid & 63, r0 = tid >> 6;
  const int ncol = colmap(kind, nt * 64 + c);
  float tv[16];
#pragma unroll
  for (int i = 0; i < 16; i++) {
    int r = r0 + 4 * i;
    tv[i] = (ncol >= 0) ? src[(size_t)(kt * 64 + r) * ldsrc + ncol] : 0.f;
  }
  if (kscale) {
#pragma unroll
    for (int i = 0; i < 16; i++) tv[i] *= kscale[kt * 64 + r0 + 4 * i];
  }
#pragma unroll
  for (int i = 0; i < 16; i++) tile[(r0 + 4 * i) * 65 + c] = tv[i];
  __syncthreads();
#pragma unroll 8
  for (int i = 0; i < 16; i++) {
    int rn = r0 + 4 * i;
    dst[(size_t)(nt * 64 + rn) * K + kt * 64 + c] = f2bf(tile[c * 65 + rn]);
  }
  __syncthreads();
}

__device__ __forceinline__ void rmsnorm_row(const float* src, const float* __restrict__ w,
                                            u16* dstb, float* dstf, int row) {
  const int lane = threadIdx.x & 63;
  float4 v[4];
  float ss = 0.f;
#pragma unroll
  for (int i = 0; i < 4; i++) {
    v[i] = *(const float4*)&src[(size_t)row * DM + i * 256 + lane * 4];
    ss += v[i].x * v[i].x + v[i].y * v[i].y + v[i].z * v[i].z + v[i].w * v[i].w;
  }
#pragma unroll
  for (int off = 32; off >= 1; off >>= 1) ss += __shfl_xor(ss, off);
  const float r = rsqrtf(ss * (1.f / DM) + EPSV);
#pragma unroll
  for (int i = 0; i < 4; i++) {
    const int col = i * 256 + lane * 4;
    float4 wv = *(const float4*)&w[col];
    float y0 = v[i].x * r * wv.x, y1 = v[i].y * r * wv.y, y2 = v[i].z * r * wv.z, y3 = v[i].w * r * wv.w;
    if (dstb) {
      uint2 o; o.x = pack2(y0, y1); o.y = pack2(y2, y3);
      *(uint2*)&dstb[(size_t)row * DM + col] = o;
    } else {
      *(float4*)&dstf[(size_t)row * DM + col] = make_float4(y0, y1, y2, y3);
    }
  }
}

__device__ void phase_prep(const P& p, unsigned char* smem) {
  float* tile = (float*)smem;
  if (blockIdx.x == 0 && threadIdx.x < 16) p.counters[threadIdx.x] = 0u;
  for (int i = blockIdx.x * 256 + threadIdx.x; i < 3 * NTOK; i += gridDim.x * 256) p.rss[i] = 0.f;
  for (int it = blockIdx.x; it < 16 * 58; it += gridDim.x) transpose_item(p.w_in, 3600, p.wt_in, 1024, it % 16, it / 16, 0, tile);
  const int wave = threadIdx.x >> 6, lane = threadIdx.x & 63;
  for (int rb = blockIdx.x; rb < NTOK / 8; rb += gridDim.x) {
    const int row = rb * 8 + wave * 2;
    float4 v0[4], v1[4];
#pragma unroll
    for (int i = 0; i < 4; i++) {
      v0[i] = *(const float4*)&p.x[(size_t)row * DM + i * 256 + lane * 4];
      v1[i] = *(const float4*)&p.x[(size_t)(row + 1) * DM + i * 256 + lane * 4];
    }
    const float4 pv0 = *(const float4*)&p.p[(size_t)row * 256 + lane * 4];
    const float4 pv1 = *(const float4*)&p.p[(size_t)(row + 1) * 256 + lane * 4];
    float s0 = 0.f, s1 = 0.f;
#pragma unroll
    for (int i = 0; i < 4; i++) {
      s0 += v0[i].x * v0[i].x + v0[i].y * v0[i].y + v0[i].z * v0[i].z + v0[i].w * v0[i].w;
      s1 += v1[i].x * v1[i].x + v1[i].y * v1[i].y + v1[i].z * v1[i].z + v1[i].w * v1[i].w;
    }
#pragma unroll
    for (int off = 32; off >= 1; off >>= 1) { s0 += __shfl_xor(s0, off); s1 += __shfl_xor(s1, off); }
    const float r0 = rsqrtf(s0 * (1.f / DM) + EPSV), r1 = rsqrtf(s1 * (1.f / DM) + EPSV);
#pragma unroll
    for (int i = 0; i < 4; i++) {
      const int col = i * 256 + lane * 4;
      const float4 wv = *(const float4*)&p.attn_norm_w[col];
      uint2 o;
      o.x = pack2(v0[i].x * r0 * wv.x, v0[i].y * r0 * wv.y); o.y = pack2(v0[i].z * r0 * wv.z, v0[i].w * r0 * wv.w);
      *(uint2*)&p.actA[(size_t)row * DM + col] = o;
      o.x = pack2(v1[i].x * r1 * wv.x, v1[i].y * r1 * wv.y); o.y = pack2(v1[i].z * r1 * wv.z, v1[i].w * r1 * wv.w);
      *(uint2*)&p.actA[(size_t)(row + 1) * DM + col] = o;
    }
    uint2 o; o.x = pack2(pv0.x, pv0.y); o.y = pack2(pv0.z, pv0.w);
    *(uint2*)&p.pb[(size_t)row * 256 + lane * 4] = o;
    o.x = pack2(pv1.x, pv1.y); o.y = pack2(pv1.z, pv1.w);
    *(uint2*)&p.pb[(size_t)(row + 1) * 256 + lane * 4] = o;
  }
}

__device__ void phase_rmsnorm(const float* src, const float* w, u16* dstb, float* dstf) {
  const int wave = threadIdx.x >> 6;
  for (int rb = blockIdx.x; rb < NTOK / 4; rb += gridDim.x) rmsnorm_row(src, w, dstb, dstf, rb * 4 + wave);
}

__device__ void phase_final(const P& p) {
  const int wave = threadIdx.x >> 6, lane = threadIdx.x & 63;
  for (int rb = blockIdx.x; rb < NTOK / 4; rb += gridDim.x) {
    const int row = rb * 4 + wave;
    const float r = rsqrtf(p.rss[2 * NTOK + row] * (1.f / DM) + EPSV);
#pragma unroll
    for (int i = 0; i < 4; i++) {
      const int col = i * 256 + lane * 4;
      float4 v = *(const float4*)&p.h[(size_t)row * DM + col];
      const float4 wv = *(const float4*)&p.final_norm_w[col];
      f32x4 o = {v.x * r * wv.x, v.y * r * wv.y, v.z * r * wv.z, v.w * r * wv.w};
      __builtin_nontemporal_store(o, (f32x4*)&p.h[(size_t)row * DM + col]);
    }
  }
}

#define GK 64
struct GemmSmem { u16 a[2][128 * GK]; u16 b[2][128 * GK]; };

template <bool SWAP>
__device__ __forceinline__ void gemm_tile(const u16* __restrict__ A, int lda, const u16* __restrict__ Bt, int ldb,
                                          int K, int m0, int n0, GemmSmem& s, f32x4 (&acc)[4][4]) {
  int tid = threadIdx.x;
  asm volatile("" : "+v"(tid));
  const int lane = tid & 63, wave = tid >> 6;
  const int wr = wave >> 1, wc = wave & 1;
  const int l15 = lane & 15, g = lane >> 4;
  const int nk = K / GK;
  const int drow = 8 * wave + (lane >> 3);
  const int dchunk = (lane & 7) ^ ((4 * (wave & 1) + (lane >> 4)) & 7);
  const u16* Ap = A + (size_t)(m0 + drow) * lda + dchunk * 8;
  const u16* Bp = Bt + (size_t)(n0 + drow) * ldb + dchunk * 8;
  const size_t sa = (size_t)32 * lda, sb = (size_t)32 * ldb;
#define G_DMA(bufi, koff) do { \
    _Pragma("unroll") for (int _i = 0; _i < 4; _i++) { \
      __builtin_amdgcn_global_load_lds((const unsigned*)(Ap + _i * sa + (koff)), (unsigned*)&s.a[bufi][(32 * _i + 8 * wave) * GK], 16, 0, 0); \
      __builtin_amdgcn_global_load_lds((const unsigned*)(Bp + _i * sb + (koff)), (unsigned*)&s.b[bufi][(32 * _i + 8 * wave) * GK], 16, 0, 0); \
    } } while (0)
  const int fo0 = l15 * GK + ((g ^ (l15 >> 1)) * 8);
  const int fo1 = l15 * GK + (((4 + g) ^ (l15 >> 1)) * 8);
  G_DMA(0, 0);
  asm volatile("s_waitcnt vmcnt(0)" ::: "memory");
  __builtin_amdgcn_s_barrier();
  asm volatile("" ::: "memory");
  for (int kt = 0; kt < nk; kt++) {
    const int buf = kt & 1;
    if (kt + 1 < nk) { if (buf) G_DMA(0, (kt + 1) * GK); else G_DMA(1, (kt + 1) * GK); }
    const u16* sa_ = &s.a[buf][(wr * 64) * GK];
    const u16* sb_ = &s.b[buf][(wc * 64) * GK];
#pragma unroll
    for (int ks = 0; ks < 2; ks++) {
      const int fo = ks ? fo1 : fo0;
      bf16x8 af[4], bfr[4];
#pragma unroll
      for (int mi = 0; mi < 4; mi++) af[mi] = *(const bf16x8*)&sa_[mi * 16 * GK + fo];
#pragma unroll
      for (int ni = 0; ni < 4; ni++) bfr[ni] = *(const bf16x8*)&sb_[ni * 16 * GK + fo];
#pragma unroll
      for (int mi = 0; mi < 4; mi++)
#pragma unroll
        for (int ni = 0; ni < 4; ni++) acc[mi][ni] = SWAP ? mfma16(bfr[ni], af[mi], acc[mi][ni]) : mfma16(af[mi], bfr[ni], acc[mi][ni]);
    }
    asm volatile("s_waitcnt vmcnt(0) lgkmcnt(0)" ::: "memory");
    __builtin_amdgcn_s_barrier();
    asm volatile("" ::: "memory");
  }
}


#define G2K 32
struct Gemm2Smem { u16 a[3][256 * G2K]; u16 b[3][128 * G2K]; };

template <bool SWAP>
__device__ __forceinline__ void gemm256(const u16* __restrict__ A, int lda, const u16* __restrict__ Bt, int ldb,
                                        int K, int m0, int n0, Gemm2Smem& s, f32x4 (&acc)[8][4]) {
  int tid = threadIdx.x;
  asm volatile("" : "+v"(tid));
  const int lane = tid & 63, wave = tid >> 6;
  const int wr = wave >> 1, wc = wave & 1;
  const int l15 = lane & 15, g = lane >> 4;
  const int nk = K / G2K;
  const int drow = 16 * wave + (lane >> 2);
  const int dchunk = (lane & 3) ^ g;
  const u16* Ap = A + (size_t)(m0 + drow) * lda + dchunk * 8;
  const u16* Bp = Bt + (size_t)(n0 + drow) * ldb + dchunk * 8;
  const size_t sa = (size_t)64 * lda, sb = (size_t)64 * ldb;
  u16* const sa0 = &s.a[0][0] + (16 * wave) * G2K;
  u16* const sb0 = &s.b[0][0] + (16 * wave) * G2K;
#define G2_DMA(st, koff) do { \
    u16* _da = sa0 + (st) * (256 * G2K); u16* _db = sb0 + (st) * (128 * G2K); \
    _Pragma("unroll") for (int _i = 0; _i < 4; _i++) \
      __builtin_amdgcn_global_load_lds((const unsigned*)(Ap + _i * sa + (koff)), (unsigned*)(_da + 64 * _i * G2K), 16, 0, 0); \
    _Pragma("unroll") for (int _i = 0; _i < 2; _i++) \
      __builtin_amdgcn_global_load_lds((const unsigned*)(Bp + _i * sb + (koff)), (unsigned*)(_db + 64 * _i * G2K), 16, 0, 0); \
  } while (0)
  const int fo = l15 * G2K + ((g ^ ((l15 >> 2) & 3)) * 8);
  asm volatile("s_waitcnt lgkmcnt(0)" ::: "memory");
  __builtin_amdgcn_s_barrier();
  asm volatile("" ::: "memory");
#pragma unroll 1
  for (int j = 0; j < 2; j++) G2_DMA(j, j * G2K);
  int st = 0;
  for (int kt = 0; kt < nk; kt++) {
    if (kt + 1 < nk) asm volatile("s_waitcnt vmcnt(6)" ::: "memory");
    else asm volatile("s_waitcnt vmcnt(0)" ::: "memory");
    __builtin_amdgcn_s_barrier();
    asm volatile("" ::: "memory");
    if (kt + 2 < nk) {
      const int st2 = (st >= 1) ? st - 1 : 2;
      G2_DMA(st2, (kt + 2) * G2K);
    }
    const u16* sa_ = &s.a[0][0] + st * (256 * G2K) + (wr * 128) * G2K + fo;
    const u16* sb_ = &s.b[0][0] + st * (128 * G2K) + (wc * 64) * G2K + fo;
    bf16x8 af[8], bfr[4];
#pragma unroll
    for (int mi = 0; mi < 8; mi++) af[mi] = *(const bf16x8*)&sa_[mi * 16 * G2K];
#pragma unroll
    for (int ni = 0; ni < 4; ni++) bfr[ni] = *(const bf16x8*)&sb_[ni * 16 * G2K];
#pragma unroll
    for (int mi = 0; mi < 8; mi++)
#pragma unroll
      for (int ni = 0; ni < 4; ni++) acc[mi][ni] = SWAP ? mfma16(bfr[ni], af[mi], acc[mi][ni]) : mfma16(af[mi], bfr[ni], acc[mi][ni]);
    st = (st == 2) ? 0 : st + 1;
  }
}
#define ZERO_ACC8(acc) _Pragma("unroll") for (int _i = 0; _i < 8; _i++) _Pragma("unroll") for (int _j = 0; _j < 4; _j++) acc[_i][_j] = (f32x4){0.f, 0.f, 0.f, 0.f};

#define ZERO_ACC(acc) _Pragma("unroll") for (int _i = 0; _i < 4; _i++) _Pragma("unroll") for (int _j = 0; _j < 4; _j++) acc[_i][_j] = (f32x4){0.f, 0.f, 0.f, 0.f};

template <int NMI>
__device__ __forceinline__ void row_sumsq_add(f32x4 (&sq)[NMI][4], float* rss, int row0, int l15, int g) {
#pragma unroll
  for (int mi = 0; mi < NMI; mi++) {
    float v = 0.f;
#pragma unroll
    for (int ni = 0; ni < 4; ni++) v += (sq[mi][ni][0] + sq[mi][ni][1]) + (sq[mi][ni][2] + sq[mi][ni][3]);
    v += __shfl_xor(v, 16);
    v += __shfl_xor(v, 32);
    if (g == 0) atomicAdd(&rss[row0 + mi * 16 + l15], v);
  }
}

__device__ void phase_inproj(const P& p, unsigned char* smem) {
  Gemm2Smem& s = *(Gemm2Smem*)smem;
  const int lane = threadIdx.x & 63, wave = threadIdx.x >> 6, wr = wave >> 1, wc = wave & 1, l15 = lane & 15, g = lane >> 4;
  const int ntiles = 64 * 29;
  for (int tl = blockIdx.x; tl < ntiles; tl += gridDim.x) {
    const int mt = tl & 63, nt = tl >> 6;
    const int m0 = mt * 256, n0 = nt * 128;
    f32x4 acc[8][4];
    ZERO_ACC8(acc);
    if (nt >= 24 && nt < 28) {
      gemm256<false>(p.actA, DM, p.wt_in, DM, DM, m0, n0, s, acc);
#pragma unroll
      for (int mi = 0; mi < 8; mi++)
#pragma unroll
        for (int ni = 0; ni < 4; ni++) {
          const int rowb = m0 + wr * 128 + mi * 16 + g * 4;
          const int col = n0 + wc * 64 + ni * 16 + l15;
          const int cc = col - 3072, hh = cc >> 6, d = cc & 63;
          const int b = rowb >> 11, sq = rowb & 2047;
          uint2 o; o.x = pack2(acc[mi][ni][0], acc[mi][ni][1]); o.y = pack2(acc[mi][ni][2], acc[mi][ni][3]);
          *(uint2*)&p.vt[((size_t)((b * 8 + hh) * 64 + d)) * SEQ + sq] = o;
        }
    } else {
      gemm256<true>(p.actA, DM, p.wt_in, DM, DM, m0, n0, s, acc);
#pragma unroll
      for (int mi = 0; mi < 8; mi++)
#pragma unroll
        for (int ni = 0; ni < 4; ni++) {
          const int row = m0 + wr * 128 + mi * 16 + l15;
          const int col = n0 + wc * 64 + ni * 16 + g * 4;
          if (nt < 24) {
            uint2 o; o.x = pack2(acc[mi][ni][0], acc[mi][ni][1]); o.y = pack2(acc[mi][ni][2], acc[mi][ni][3]);
            *(uint2*)&p.proj[(size_t)row * PROJW + col] = o;
          } else if (col < 3600) {
            *(float4*)&p.gates[(size_t)row * 16 + (col - 3584)] = make_float4(acc[mi][ni][0], acc[mi][ni][1], acc[mi][ni][2], acc[mi][ni][3]);
          }
        }
    }
  }
}

__device__ void phase_outproj(const P& p, unsigned char* smem) {
  Gemm2Smem& s = *(Gemm2Smem*)smem;
  const int lane = threadIdx.x & 63, wave = threadIdx.x >> 6, wr = wave >> 1, wc = wave & 1, l15 = lane & 15, g = lane >> 4;
  for (int tl = blockIdx.x; tl < 64 * 8; tl += gridDim.x) {
    const int mt = tl & 63, nt = tl >> 6;
    const int m0 = mt * 256, n0 = nt * 128;
    f32x4 acc[8][4];
    ZERO_ACC8(acc);
    gemm256<true>(p.actA, DM, p.wt_out, DM, DM, m0, n0, s, acc);
#pragma unroll
    for (int mi = 0; mi < 8; mi++)
#pragma unroll
      for (int ni = 0; ni < 4; ni++) {
        const size_t idx = (size_t)(m0 + wr * 128 + mi * 16 + l15) * DM + n0 + wc * 64 + ni * 16 + g * 4;
        const f32x4 xv4 = __builtin_nontemporal_load((const f32x4*)&p.x[idx]);
        const float4 xv = make_float4(xv4[0], xv4[1], xv4[2], xv4[3]);
        const float h0 = xv.x + acc[mi][ni][0], h1 = xv.y + acc[mi][ni][1], h2 = xv.z + acc[mi][ni][2], h3 = xv.w + acc[mi][ni][3];
        uint2 o; o.x = pack2(h0, h1); o.y = pack2(h2, h3);
        *(uint2*)&p.hb[idx] = o;
        acc[mi][ni] = (f32x4){h0 * h0, h1 * h1, h2 * h2, h3 * h3};
      }
    row_sumsq_add(acc, p.rss, m0 + wr * 128, l15, g);
  }
}

__device__ void phase_gateup(const P& p, unsigned char* smem) {
  Gemm2Smem& s = *(Gemm2Smem*)smem;
  u16* act = p.proj;
  const int lane = threadIdx.x & 63, wave = threadIdx.x >> 6, wr = wave >> 1, wc = wave & 1, l15 = lane & 15, g = lane >> 4;
  for (int tl = blockIdx.x; tl < 64 * 44; tl += gridDim.x) {
    const int mt = tl & 63, nt = tl >> 6;
    const int m0 = mt * 256, n0 = nt * 128;
    f32x4 acc[8][4];
    ZERO_ACC8(acc);
    gemm256<true>(p.hb, DM, p.wt_gu, DM, DM, m0, n0, s, acc);
#pragma unroll
    for (int mi = 0; mi < 8; mi++) {
      const int row = m0 + wr * 128 + mi * 16 + l15;
      const float rs = rsqrtf(p.rss[row] * (1.f / DM) + EPSV);
#pragma unroll
      for (int ni = 0; ni < 2; ni++) {
        const int col = 64 * nt + 32 * wc + 16 * ni + g * 4;
        float v[4];
#pragma unroll
        for (int r = 0; r < 4; r++) v[r] = siluf(acc[mi][ni][r] * rs) * (acc[mi][ni + 2][r] * rs);
        uint2 o; o.x = pack2(v[0], v[1]); o.y = pack2(v[2], v[3]);
        *(uint2*)&act[(size_t)row * DFF + col] = o;
      }
    }
  }
}

__device__ void phase_down(const P& p, unsigned char* smem) {
  Gemm2Smem& s = *(Gemm2Smem*)smem;
  const u16* act = p.proj;
  const int lane = threadIdx.x & 63, wave = threadIdx.x >> 6, wr = wave >> 1, wc = wave & 1, l15 = lane & 15, g = lane >> 4;
  for (int tl = blockIdx.x; tl < 64 * 8; tl += gridDim.x) {
    const int mt = tl & 63, nt = tl >> 6;
    const int m0 = mt * 256, n0 = nt * 128;
    f32x4 acc[8][4];
    ZERO_ACC8(acc);
    gemm256<true>(act, DFF, p.wt_down, DFF, DFF, m0, n0, s, acc);
#pragma unroll
    for (int mi = 0; mi < 8; mi++)
#pragma unroll
      for (int ni = 0; ni < 4; ni++) {
        const size_t idx = (size_t)(m0 + wr * 128 + mi * 16 + l15) * DM + n0 + wc * 64 + ni * 16 + g * 4;
        float hp[4];
        unpack4(*(const uint2*)&p.hb[idx], hp);
        const float h0 = hp[0] + acc[mi][ni][0], h1 = hp[1] + acc[mi][ni][1], h2 = hp[2] + acc[mi][ni][2], h3 = hp[3] + acc[mi][ni][3];
        uint2 o; o.x = pack2(h0, h1); o.y = pack2(h2, h3);
        *(uint2*)&p.actA[idx] = o;
        acc[mi][ni] = (f32x4){h0 * h0, h1 * h1, h2 * h2, h3 * h3};
      }
    row_sumsq_add(acc, p.rss + NTOK, m0 + wr * 128, l15, g);
  }
}

__device__ void phase_ple(const P& p, unsigned char* smem) {
  GemmSmem& s = *(GemmSmem*)smem;
  const int lane = threadIdx.x & 63, wave = threadIdx.x >> 6, wr = wave >> 1, wc = wave & 1, l15 = lane & 15, g = lane >> 4;
  for (int tl = blockIdx.x; tl < 128 * 8; tl += gridDim.x) {
    const int mt = tl & 127, nt = tl >> 7;
    const int m0 = mt * 128, n0 = nt * 128;
    f32x4 acc[4][4], acc2[4][4];
    ZERO_ACC(acc);
    gemm_tile<true>(p.actA, DM, p.wt_pg, DM, DM, m0, n0, s, acc);
#pragma unroll
    for (int mi = 0; mi < 4; mi++) {
      const float rs = rsqrtf(p.rss[NTOK + m0 + wr * 64 + mi * 16 + l15] * (1.f / DM) + EPSV);
#pragma unroll
      for (int ni = 0; ni < 4; ni++)
#pragma unroll
        for (int r = 0; r < 4; r++) acc[mi][ni][r] = sigmoidf_(acc[mi][ni][r] * rs);
    }
    ZERO_ACC(acc2);
    gemm_tile<true>(p.pb, 256, p.wt_pp, 256, 256, m0, n0, s, acc2);
#pragma unroll
    for (int mi = 0; mi < 4; mi++)
#pragma unroll
      for (int ni = 0; ni < 4; ni++) {
        const size_t idx = (size_t)(m0 + wr * 64 + mi * 16 + l15) * DM + n0 + wc * 64 + ni * 16 + g * 4;
        float hp[4];
        unpack4(*(const uint2*)&p.actA[idx], hp);
        const float h0 = hp[0] + acc[mi][ni][0] * acc2[mi][ni][0], h1 = hp[1] + acc[mi][ni][1] * acc2[mi][ni][1];
        const float h2 = hp[2] + acc[mi][ni][2] * acc2[mi][ni][2], h3 = hp[3] + acc[mi][ni][3] * acc2[mi][ni][3];
        *(float4*)&p.h[idx] = make_float4(h0, h1, h2, h3);
        acc2[mi][ni] = (f32x4){h0 * h0, h1 * h1, h2 * h2, h3 * h3};
      }
    row_sumsq_add(acc2, p.rss + 2 * NTOK, m0 + wr * 64, l15, g);
  }
}

#define QLD 136
#define KLD 72
struct GdnSmem {
  u16 qb[64 * QLD];
  u16 kn[64 * QLD];
  u16 vb[64 * QLD];
  float Am[64 * 64];
  float gc[64], beta[64], be[64];
};
static_assert(offsetof(GdnSmem, kn) == 17408 && offsetof(GdnSmem, vb) == 34816 && offsetof(GdnSmem, Am) == 52224, "layout");


__device__ void gdn_unit(const P& p, int unit, GdnSmem& s) {
  int tid = threadIdx.x;
  asm volatile("" : "+v"(tid));
  int lane = tid & 63, wave = tid >> 6;
  int l15 = lane & 15, g = lane >> 4;
#define GDN_REFRESH() do { tid = threadIdx.x; asm volatile("" : "+v"(tid) :: "memory"); lane = tid & 63; wave = tid >> 6; l15 = lane & 15; g = lane >> 4; } while (0)
  const int bh = unit >> 5, n = unit & 31;
  const int b = bh >> 2, h = bh & 3;
  const int tb = b * SEQ;
  const int s0 = n * 64;
  u16* const qk_s = s.qb;
  u16* const WU = s.kn;
  u16* const kdT = (u16*)((unsigned char*)s.kn + 32768);
  __syncthreads();
  if (wave == 0) {
    const int t = tb + s0 + lane;
    const float ga = p.gates[(size_t)t * 16 + h], gb = p.gates[(size_t)t * 16 + 4 + h];
    const float xx = ga + p.dt_bias[h];
    const float sp = (xx > 20.f) ? xx : log1pf(__expf(xx));
    float gg = -__expf(p.a_log[h]) * sp;
#pragma unroll
    for (int off = 1; off < 64; off <<= 1) {
      float nb = __shfl_up(gg, off);
      if (lane >= off) gg += nb;
    }
    const float bt = sigmoidf_(gb);
    s.gc[lane] = gg;
    s.beta[lane] = bt;
    s.be[lane] = bt * __expf(gg);
  }
  {
    const int ch = tid & 15, rg = tid >> 4;
#pragma unroll 1
    for (int mat = 0; mat < 3; mat++) {
      const int col0 = mat * 512 + h * 128 + ch * 8;
      float cw[4][8];
#pragma unroll
      for (int k = 0; k < 4; k++) {
        const float4 w0 = *(const float4*)&p.conv_w[k * 1536 + col0];
        const float4 w1 = *(const float4*)&p.conv_w[k * 1536 + col0 + 4];
        cw[k][0] = w0.x; cw[k][1] = w0.y; cw[k][2] = w0.z; cw[k][3] = w0.w;
        cw[k][4] = w1.x; cw[k][5] = w1.y; cw[k][6] = w1.z; cw[k][7] = w1.w;
      }
      uint4 xr[7];
#pragma unroll
      for (int j = 0; j < 7; j++) {
        const int sp = s0 + 4 * rg + j - 3;
        xr[j] = (sp >= 0) ? *(const uint4*)&p.proj[(size_t)(tb + sp) * PROJW + col0] : make_uint4(0u, 0u, 0u, 0u);
      }
      float xf[7][8];
#pragma unroll
      for (int j = 0; j < 7; j++) unpack8(xr[j], xf[j]);
      u16* dst = (mat == 0) ? s.qb : ((mat == 1) ? s.kn : s.vb);
#pragma unroll
      for (int r = 0; r < 4; r++) {
        float val[8];
        float ss = 0.f;
#pragma unroll
        for (int c = 0; c < 8; c++) {
          const float cv = cw[0][c] * xf[r][c] + cw[1][c] * xf[r + 1][c] + cw[2][c] * xf[r + 2][c] + cw[3][c] * xf[r + 3][c];
          val[c] = siluf(cv);
          ss += val[c] * val[c];
        }
        float rs = 1.f;
        if (mat < 2) {
#pragma unroll
          for (int off = 1; off < 16; off <<= 1) ss += __shfl_xor(ss, off);
          rs = rsqrtf(ss + EPSV) * ((mat == 0) ? 0.08838834764831845f : 1.f);
        }
        uint4 o;
        o.x = pack2(val[0] * rs, val[1] * rs); o.y = pack2(val[2] * rs, val[3] * rs);
        o.z = pack2(val[4] * rs, val[5] * rs); o.w = pack2(val[6] * rs, val[7] * rs);
        *(uint4*)&dst[(4 * rg + r) * QLD + ch * 8] = o;
      }
    }
  }
  __syncthreads();
  GDN_REFRESH();
  u16* const gQ = p.gQ + (size_t)unit * 8192;
  {
#pragma unroll
    for (int it = 0; it < 4; it++) {
      const int idx = tid + 256 * it;
      const int i = idx >> 4, d8 = (idx & 15) * 8;
      const float e = __expf(s.gc[i]);
      float f[8];
      unpack8(*(const uint4*)&s.qb[i * QLD + d8], f);
      uint4 o;
      o.x = pack2(f[0] * e, f[1] * e); o.y = pack2(f[2] * e, f[3] * e);
      o.z = pack2(f[4] * e, f[5] * e); o.w = pack2(f[6] * e, f[7] * e);
      *(uint4*)&gQ[i * 128 + d8] = o;
    }
  }
  f32x4 cqk[4];
  {
    bf16x8 aq[4], ak[4];
#pragma unroll
    for (int ks = 0; ks < 4; ks++) {
      aq[ks] = *(const bf16x8*)&s.qb[(wave * 16 + l15) * QLD + ks * 32 + g * 8];
      ak[ks] = *(const bf16x8*)&s.kn[(wave * 16 + l15) * QLD + ks * 32 + g * 8];
    }
#pragma unroll
    for (int ni = 0; ni < 4; ni++) {
      f32x4 ckk = {0.f, 0.f, 0.f, 0.f};
      cqk[ni] = (f32x4){0.f, 0.f, 0.f, 0.f};
      if (ni <= wave) {
#pragma unroll
        for (int ks = 0; ks < 4; ks++) {
          bf16x8 bk = *(const bf16x8*)&s.kn[(ni * 16 + l15) * QLD + ks * 32 + g * 8];
          ckk = mfma16(ak[ks], bk, ckk);
          cqk[ni] = mfma16(aq[ks], bk, cqk[ni]);
        }
      }
      const int j = ni * 16 + l15;
      const float gcj = s.gc[j];
#pragma unroll
      for (int r = 0; r < 4; r++) {
        const int i = wave * 16 + g * 4 + r;
        const float dec = (i >= j) ? __expf(s.gc[i] - gcj) : 0.f;
        s.Am[i * 64 + j] = (i > j) ? ckk[r] * s.beta[i] * dec : 0.f;
        cqk[ni][r] = (i >= j) ? cqk[ni][r] * dec : 0.f;
      }
    }
  }
  __syncthreads();
  GDN_REFRESH();
#pragma unroll
  for (int ni = 0; ni < 4; ni++)
#pragma unroll
    for (int r = 0; r < 4; r++) qk_s[(wave * 16 + g * 4 + r) * KLD + ni * 16 + l15] = f2bf(cqk[ni][r]);
  float xs[64];
#ifdef NO_SOLVE
  for (int i = 0; i < 64; i++) xs[i] = s.Am[i*64+tid%64];
#else
  {
    const int c = tid;
    const u16* src = (c < 128) ? &s.vb[c] : &s.kn[c - 128];
    const float* sc = (c < 128) ? s.beta : s.be;
#pragma unroll
    for (int i = 0; i < 64; i++) {
      float a0 = bf2f(src[i * QLD]) * sc[i], a1 = 0.f, a2 = 0.f, a3 = 0.f;
#pragma unroll
      for (int j4 = 0; j4 < (i + 3) / 4; j4++) {
        const float4 av = *(const float4*)&s.Am[i * 64 + j4 * 4];
        if (j4 * 4 + 0 < i) a0 -= av.x * xs[j4 * 4 + 0];
        if (j4 * 4 + 1 < i) a1 -= av.y * xs[j4 * 4 + 1];
        if (j4 * 4 + 2 < i) a2 -= av.z * xs[j4 * 4 + 2];
        if (j4 * 4 + 3 < i) a3 -= av.w * xs[j4 * 4 + 3];
      }
      xs[i] = (a0 + a1) + (a2 + a3);
      asm volatile("" : "+v"(xs[i]) :: "memory");
    }
  }
#endif
  const float glast = s.gc[63];
  __syncthreads();
  GDN_REFRESH();
  {
    const int d = tid & 127, half = tid >> 7;
#pragma unroll
    for (int q = 0; q < 4; q++) {
      unsigned ow[4];
#pragma unroll
      for (int e2 = 0; e2 < 4; e2++) {
        const int c0 = half * 32 + q * 8 + e2 * 2;
        const float v0 = bf2f(s.kn[c0 * QLD + d]) * __expf(glast - s.gc[c0]);
        const float v1 = bf2f(s.kn[(c0 + 1) * QLD + d]) * __expf(glast - s.gc[c0 + 1]);
        ow[e2] = pack2(v0, v1);
      }
      *(uint4*)&kdT[d * KLD + half * 32 + q * 8] = make_uint4(ow[0], ow[1], ow[2], ow[3]);
    }
    if (tid == 0) p.gdl[unit] = __expf(glast);
  }
  __syncthreads();
  GDN_REFRESH();
  if (tid >= 128) {
#pragma unroll
    for (int q = 0; q < 8; q++)
      *(uint4*)&WU[(tid - 128) * KLD + q * 8] = make_uint4(pack2(xs[q * 8], xs[q * 8 + 1]), pack2(xs[q * 8 + 2], xs[q * 8 + 3]),
                                                            pack2(xs[q * 8 + 4], xs[q * 8 + 5]), pack2(xs[q * 8 + 6], xs[q * 8 + 7]));
  }
  __syncthreads();
  GDN_REFRESH();
  {
    u16* const gM = p.gM + (size_t)unit * 16384;
    bf16x8 aw[2][2];
#pragma unroll
    for (int mm = 0; mm < 2; mm++)
#pragma unroll
      for (int ks = 0; ks < 2; ks++) aw[mm][ks] = *(const bf16x8*)&WU[((2 * wave + mm) * 16 + l15) * KLD + ks * 32 + g * 8];
#pragma unroll
    for (int nn = 0; nn < 8; nn++) {
      const bf16x8 b0 = *(const bf16x8*)&kdT[(nn * 16 + l15) * KLD + g * 8];
      const bf16x8 b1 = *(const bf16x8*)&kdT[(nn * 16 + l15) * KLD + 32 + g * 8];
#pragma unroll
      for (int mm = 0; mm < 2; mm++) {
        f32x4 acc = {0.f, 0.f, 0.f, 0.f};
        acc = mfma16(aw[mm][0], b0, acc);
        acc = mfma16(aw[mm][1], b1, acc);
        uint2 o; o.x = pack2(-acc[0], -acc[1]); o.y = pack2(-acc[2], -acc[3]);
        *(uint2*)&gM[(nn * 16 + l15) * 128 + (2 * wave + mm) * 16 + 4 * g] = o;
      }
    }
#pragma unroll
    for (int nn = 0; nn < 4; nn++) {
      const bf16x8 b0 = *(const bf16x8*)&qk_s[(nn * 16 + l15) * KLD + g * 8];
      const bf16x8 b1 = *(const bf16x8*)&qk_s[(nn * 16 + l15) * KLD + 32 + g * 8];
#pragma unroll
      for (int mm = 0; mm < 2; mm++) {
        f32x4 acc = {0.f, 0.f, 0.f, 0.f};
        acc = mfma16(aw[mm][0], b0, acc);
        acc = mfma16(aw[mm][1], b1, acc);
        u16* qp = &gQ[(nn * 16 + l15) * 128 + (2 * wave + mm) * 16 + 4 * g];
        float qv[4];
        unpack4(*(const uint2*)qp, qv);
        uint2 o; o.x = pack2(qv[0] - acc[0], qv[1] - acc[1]); o.y = pack2(qv[2] - acc[2], qv[3] - acc[3]);
        *(uint2*)qp = o;
      }
    }
  }
  __syncthreads();
  GDN_REFRESH();
  if (tid < 128) {
#pragma unroll
    for (int q = 0; q < 8; q++)
      *(uint4*)&WU[tid * KLD + q * 8] = make_uint4(pack2(xs[q * 8], xs[q * 8 + 1]), pack2(xs[q * 8 + 2], xs[q * 8 + 3]),
                                                    pack2(xs[q * 8 + 4], xs[q * 8 + 5]), pack2(xs[q * 8 + 6], xs[q * 8 + 7]));
  }
  __syncthreads();
  GDN_REFRESH();
  {
    u16* const gC = p.gC + (size_t)unit * 16384;
    u16* const gO = p.gO + (size_t)unit * 8192;
    bf16x8 akd[2][2], aqk[2];
#pragma unroll
    for (int mm = 0; mm < 2; mm++)
#pragma unroll
      for (int ks = 0; ks < 2; ks++) akd[mm][ks] = *(const bf16x8*)&kdT[((2 * wave + mm) * 16 + l15) * KLD + ks * 32 + g * 8];
#pragma unroll
    for (int ks = 0; ks < 2; ks++) aqk[ks] = *(const bf16x8*)&qk_s[(wave * 16 + l15) * KLD + ks * 32 + g * 8];
#pragma unroll
    for (int nn = 0; nn < 8; nn++) {
      const bf16x8 b0 = *(const bf16x8*)&WU[(nn * 16 + l15) * KLD + g * 8];
      const bf16x8 b1 = *(const bf16x8*)&WU[(nn * 16 + l15) * KLD + 32 + g * 8];
#pragma unroll
      for (int mm = 0; mm < 2; mm++) {
        f32x4 acc = {0.f, 0.f, 0.f, 0.f};
        acc = mfma16(akd[mm][0], b0, acc);
        acc = mfma16(akd[mm][1], b1, acc);
        uint2 o; o.x = pack2(acc[0], acc[1]); o.y = pack2(acc[2], acc[3]);
        *(uint2*)&gC[(nn * 16 + l15) * 128 + (2 * wave + mm) * 16 + 4 * g] = o;
      }
      {
        f32x4 acc = {0.f, 0.f, 0.f, 0.f};
        acc = mfma16(aqk[0], b0, acc);
        acc = mfma16(aqk[1], b1, acc);
        uint2 o; o.x = pack2(acc[0], acc[1]); o.y = pack2(acc[2], acc[3]);
        *(uint2*)&gO[(nn * 16 + l15) * 64 + wave * 16 + 4 * g] = o;
      }
    }
  }
}

__device__ void fox_cumsum_unit(const P& p, int bhf, float* red) {
  const int tid = threadIdx.x, lane = tid & 63, wave = tid >> 6;
  const int b = bhf >> 3, hf = bhf & 7;
  const float bias = p.fox_f_bias[hf];
  float v[8];
  float run = 0.f;
#pragma unroll
  for (int i = 0; i < 8; i++) {
    const int t = b * SEQ + tid * 8 + i;
    const float xx = p.gates[(size_t)t * 16 + 8 + hf] + bias;
    const float ls = fminf(xx, 0.f) - log1pf(__expf(-fabsf(xx)));
    run += ls;
    v[i] = run;
  }
  float tot = run;
#pragma unroll
  for (int off = 1; off < 64; off <<= 1) {
    float nb = __shfl_up(tot, off);
    if (lane >= off) tot += nb;
  }
  __syncthreads();
  if (lane == 63) red[wave] = tot;
  __syncthreads();
  float base = tot - run;
  for (int w = 0; w < wave; w++) base += red[w];
#pragma unroll
  for (int i = 0; i < 8; i++) p.cf[(size_t)bhf * SEQ + tid * 8 + i] = v[i] + base;
}

__device__ void phase_gdnprep(const P& p, unsigned char* smem) {
  GdnSmem& s = *(GdnSmem*)smem;
  for (int u = blockIdx.x; u < 1024 + 64; u += gridDim.x) {
    if (u < 1024) gdn_unit(p, u, s);
    else { __syncthreads(); fox_cumsum_unit(p, u - 1024, (float*)smem); }
  }
}

#define SLD 136
#define NSCAN 128
struct ScanSmem { u16 st[2][32 * SLD]; };
struct ScanSet { bf16x8 mf[2][4]; uint2 ci[2][2]; float dl; };

__device__ __forceinline__ void scan_load(const P& p, int unit, int eq, int w, int l15, int g, ScanSet& z) {
  int la = (32 * w + l15) * 128 + 8 * g, lc = (32 * eq + l15) * 128 + 32 * w + 4 * g;
  asm volatile("" : "+v"(la), "+v"(lc));
  const u16* gM = p.gM + (size_t)unit * 16384;
  const u16* gC = p.gC + (size_t)unit * 16384;
#pragma unroll
  for (int md = 0; md < 2; md++)
#pragma unroll
    for (int ks = 0; ks < 4; ks++) z.mf[md][ks] = *(const bf16x8*)&gM[la + md * 16 * 128 + ks * 32];
#pragma unroll
  for (int md = 0; md < 2; md++)
#pragma unroll
    for (int ne = 0; ne < 2; ne++) z.ci[md][ne] = *(const uint2*)&gC[lc + ne * 16 * 128 + md * 16];
  z.dl = p.gdl[unit];
}

__device__ __forceinline__ unsigned scan_touch(const P& p, int unit, int lane) {
  unsigned v = 0u;
  if (lane < 16) {
    const u16* base = (lane < 8) ? (p.gM + (size_t)unit * 16384) : (p.gC + (size_t)unit * 16384);
    v = *(const unsigned*)(base + (lane & 7) * 2048);
  }
  return v;
}

__device__ __forceinline__ void scan_step(const P& p, int unit, int n, int eq, int w, int l15, int g, ScanSmem& s,
                                          f32x4 (&st)[2][2], const ScanSet& z) {
  const u16* Sb = s.st[n & 1];
  u16* Sn = s.st[(n & 1) ^ 1];
#pragma unroll
  for (int md = 0; md < 2; md++)
#pragma unroll
    for (int ne = 0; ne < 2; ne++) {
      float c[4];
      unpack4(z.ci[md][ne], c);
      st[md][ne][0] = st[md][ne][0] * z.dl + c[0];
      st[md][ne][1] = st[md][ne][1] * z.dl + c[1];
      st[md][ne][2] = st[md][ne][2] * z.dl + c[2];
      st[md][ne][3] = st[md][ne][3] * z.dl + c[3];
    }
  if (n > 0) {
    int lb = l15 * SLD + 8 * g;
    asm volatile("" : "+v"(lb));
#pragma unroll
    for (int ne = 0; ne < 2; ne++) {
#pragma unroll
      for (int ks = 0; ks < 4; ks++) {
        const bf16x8 bs = *(const bf16x8*)&Sb[lb + 16 * ne * SLD + ks * 32];
        st[0][ne] = mfma16(z.mf[0][ks], bs, st[0][ne]);
        st[1][ne] = mfma16(z.mf[1][ks], bs, st[1][ne]);
      }
    }
  }
  if (n + 1 < 32) {
    u16* gS = p.gS + (size_t)(unit + 1) * 16384;
    int lsl = l15 * SLD + 32 * w + 4 * g, lsg = (32 * eq + l15) * 128 + 32 * w + 4 * g;
    asm volatile("" : "+v"(lsl), "+v"(lsg));
#pragma unroll
    for (int md = 0; md < 2; md++)
#pragma unroll
      for (int ne = 0; ne < 2; ne++) {
        uint2 o; o.x = pack2(st[md][ne][0], st[md][ne][1]); o.y = pack2(st[md][ne][2], st[md][ne][3]);
        *(uint2*)&Sn[lsl + 16 * ne * SLD + 16 * md] = o;
        *(uint2*)&gS[lsg + 16 * ne * 128 + 16 * md] = o;
      }
  }
  asm volatile("s_waitcnt lgkmcnt(0)" ::: "memory");
  __builtin_amdgcn_s_barrier();
  asm volatile("" ::: "memory");
}

__device__ void scan_unit(const P& p, int item, ScanSmem& s) {
  int tid = threadIdx.x;
  asm volatile("" : "+v"(tid));
  const int lane = tid & 63, w = tid >> 6;
  const int l15 = lane & 15, g = lane >> 4;
  const int bh = item >> 2, eq = item & 3;
  const int u0 = bh * 32;
  f32x4 st[2][2];
#pragma unroll
  for (int md = 0; md < 2; md++)
#pragma unroll
    for (int ne = 0; ne < 2; ne++) st[md][ne] = (f32x4){0.f, 0.f, 0.f, 0.f};
  ScanSet z0, z1, z2, z3;
  scan_load(p, u0 + 0, eq, w, l15, g, z0);
  scan_load(p, u0 + 1, eq, w, l15, g, z1);
  scan_load(p, u0 + 2, eq, w, l15, g, z2);
  unsigned tacc = 0u, tprev = 0u;
  __builtin_amdgcn_s_setprio(3);
#pragma unroll 1
  for (int n = 0; n < 32; n += 4) {
    tacc += tprev;
    tprev = 0u;
    if (n + 8 < 32) {
      tprev = scan_touch(p, u0 + n + 8, lane) + scan_touch(p, u0 + n + 9, lane) + scan_touch(p, u0 + n + 10, lane) +
              scan_touch(p, u0 + n + 11, lane);
    }
    scan_load(p, u0 + n + 3, eq, w, l15, g, z3);
    scan_step(p, u0 + n, n, eq, w, l15, g, s, st, z0);
    if (n + 4 < 32) scan_load(p, u0 + n + 4, eq, w, l15, g, z0);
    scan_step(p, u0 + n + 1, n + 1, eq, w, l15, g, s, st, z1);
    if (n + 4 < 32) scan_load(p, u0 + n + 5, eq, w, l15, g, z1);
    scan_step(p, u0 + n + 2, n + 2, eq, w, l15, g, s, st, z2);
    if (n + 4 < 32) scan_load(p, u0 + n + 6, eq, w, l15, g, z2);
    scan_step(p, u0 + n + 3, n + 3, eq, w, l15, g, s, st, z3);
  }
  __builtin_amdgcn_s_setprio(0);
  asm volatile("" :: "v"(tacc));
}

#define OLD 136
struct GoutSmem { float ssq[4][64]; u16 ob[64 * OLD]; };

__device__ void gout_unit(const P& p, int unit, GoutSmem& s) {
  const int tid = threadIdx.x, lane = tid & 63, w = tid >> 6;
  const int l15 = lane & 15, g = lane >> 4;
  const int bh = unit >> 5, n = unit & 31;
  const int b = bh >> 2, h = bh & 3;
  const u16* gQ = p.gQ + (size_t)unit * 8192;
  const u16* gO = p.gO + (size_t)unit * 8192;
  const u16* gS = p.gS + (size_t)unit * 16384;
  f32x4 o[4][2];
#pragma unroll
  for (int mc = 0; mc < 4; mc++)
#pragma unroll
    for (int ne = 0; ne < 2; ne++) {
      float c[4];
      unpack4(*(const uint2*)&gO[(32 * w + 16 * ne + l15) * 64 + 16 * mc + 4 * g], c);
      o[mc][ne] = (f32x4){c[0], c[1], c[2], c[3]};
    }
  if (n > 0) {
    bf16x8 bs[2][4];
#pragma unroll
    for (int ne = 0; ne < 2; ne++)
#pragma unroll
      for (int ks = 0; ks < 4; ks++) bs[ne][ks] = *(const bf16x8*)&gS[(32 * w + 16 * ne + l15) * 128 + ks * 32 + 8 * g];
#pragma unroll
    for (int mc = 0; mc < 4; mc++) {
#pragma unroll
      for (int ks = 0; ks < 4; ks++) {
        const bf16x8 aq = *(const bf16x8*)&gQ[(16 * mc + l15) * 128 + ks * 32 + 8 * g];
        o[mc][0] = mfma16(aq, bs[0][ks], o[mc][0]);
        o[mc][1] = mfma16(aq, bs[1][ks], o[mc][1]);
      }
    }
  }
  const float gnw0 = p.gdn_norm_w[32 * w + l15], gnw1 = p.gdn_norm_w[32 * w + 16 + l15];
  __syncthreads();
#pragma unroll
  for (int mc = 0; mc < 4; mc++)
#pragma unroll
    for (int r = 0; r < 4; r++) {
      float sq = o[mc][0][r] * o[mc][0][r] + o[mc][1][r] * o[mc][1][r];
#pragma unroll
      for (int off = 1; off < 16; off <<= 1) sq += __shfl_xor(sq, off);
      if (l15 == 0) s.ssq[w][16 * mc + 4 * g + r] = sq;
    }
  __syncthreads();
#pragma unroll
  for (int mc = 0; mc < 4; mc++)
#pragma unroll
    for (int r = 0; r < 4; r++) {
      const int c = 16 * mc + 4 * g + r;
      const float tot = s.ssq[0][c] + s.ssq[1][c] + s.ssq[2][c] + s.ssq[3][c];
      const float rs = rsqrtf(tot * (1.f / 128.f) + EPSV);
      s.ob[c * OLD + 32 * w + l15] = f2bf(o[mc][0][r] * rs * gnw0);
      s.ob[c * OLD + 32 * w + 16 + l15] = f2bf(o[mc][1][r] * rs * gnw1);
    }
  __syncthreads();
  {
    const int t0 = b * SEQ + n * 64;
    const int c0 = tid >> 4, ch = tid & 15;
    const u16* zp = p.proj + (size_t)(t0 + c0) * PROJW + 1536 + h * 128 + ch * 8;
    u16* op = p.actA + (size_t)(t0 + c0) * DM + h * 128 + ch * 8;
#pragma unroll
    for (int i = 0; i < 4; i++) {
      float ov[8], zv[8];
      unpack8(*(const uint4*)&s.ob[(c0 + 16 * i) * OLD + ch * 8], ov);
      unpack8(*(const uint4*)(zp + (size_t)i * 16 * PROJW), zv);
      uint4 r;
      r.x = pack2(ov[0] * siluf(zv[0]), ov[1] * siluf(zv[1])); r.y = pack2(ov[2] * siluf(zv[2]), ov[3] * siluf(zv[3]));
      r.z = pack2(ov[4] * siluf(zv[4]), ov[5] * siluf(zv[5])); r.w = pack2(ov[6] * siluf(zv[6]), ov[7] * siluf(zv[7]));
      *(uint4*)(op + (size_t)i * 16 * DM) = r;
    }
  }
}

__device__ void phase_gout(const P& p, unsigned char* smem) {
  GoutSmem& s = *(GoutSmem*)smem;
  for (int u = blockIdx.x; u < 1024; u += gridDim.x) gout_unit(p, u, s);
}

#define LOG2E 1.4426950408889634f
#define ANST 4
struct AttnSmem { u16 k[ANST][64 * 64 + 128]; u16 v[ANST][64 * 64]; };

__device__ void attn_unit(const P& p, int item, AttnSmem& s) {
  int tid = threadIdx.x;
  asm volatile("" : "+v"(tid));
  const int lane = tid & 63, w = tid >> 6;
  const int l15 = lane & 15, g = lane >> 4;
  const int qb = 15 - (item >> 6), bhf = item & 63;
  const int b = bhf >> 3, hf = bhf & 7;
  const int q0 = qb * 128 + 32 * w;
  const u16* qbase = p.proj + (size_t)(b * SEQ) * PROJW + 2048 + hf * 64;
  const u16* kbase = p.proj + (size_t)(b * SEQ) * PROJW + 2560 + hf * 64;
  const u16* vbase = p.vt + (size_t)bhf * 64 * SEQ;
  const float* cfb = p.cf + (size_t)bhf * SEQ;
  bf16x8 qf[2][2];
#pragma unroll
  for (int mi = 0; mi < 2; mi++)
#pragma unroll
    for (int ks = 0; ks < 2; ks++) qf[mi][ks] = *(const bf16x8*)&qbase[(size_t)(q0 + 16 * mi + l15) * PROJW + ks * 32 + g * 8];
  float cq[2], m[2], lsum[2];
  f32x4 O[2][4];
#pragma unroll
  for (int mi = 0; mi < 2; mi++) {
    cq[mi] = cfb[q0 + 16 * mi + l15]; m[mi] = -1e30f; lsum[mi] = 0.f;
#pragma unroll
    for (int nd = 0; nd < 4; nd++) O[mi][nd] = (f32x4){0.f, 0.f, 0.f, 0.f};
  }
  asm volatile("" :: "v"(cq[0]), "v"(cq[1]), "v"(qf[0][0]), "v"(qf[0][1]), "v"(qf[1][0]), "v"(qf[1][1]));
  const int ntile = (q0 + 32 + 63) >> 6;
  const int ntile_blk = 2 * qb + 2;
  const int drow = 8 * w + (lane >> 3);
  const int dchunk = (lane & 7) ^ ((4 * (w & 1) + (lane >> 4)) & 7);
  const u16* kg = kbase + (size_t)drow * PROJW + dchunk * 8;
  const u16* vg = vbase + (size_t)drow * SEQ + dchunk * 8;
  const float* cg_ = cfb + lane;
  u16* const skw = &s.k[0][0] + (8 * w) * 64;
  u16* const svw = &s.v[0][0] + (8 * w) * 64;
#define A_DMA(st, kk0) do { \
    u16* _dk = skw + (st) * (64 * 64 + 128); u16* _dv = svw + (st) * (64 * 64); \
    __builtin_amdgcn_global_load_lds((const unsigned*)(kg + (size_t)(kk0) * PROJW), (unsigned*)(_dk), 16, 0, 0); \
    __builtin_amdgcn_global_load_lds((const unsigned*)(kg + (size_t)((kk0) + 32) * PROJW), (unsigned*)(_dk + 32 * 64), 16, 0, 0); \
    __builtin_amdgcn_global_load_lds((const unsigned*)(vg + (kk0)), (unsigned*)(_dv), 16, 0, 0); \
    __builtin_amdgcn_global_load_lds((const unsigned*)(vg + (size_t)32 * SEQ + (kk0)), (unsigned*)(_dv + 32 * 64), 16, 0, 0); \
    __builtin_amdgcn_global_load_lds((const unsigned*)(cg_ + (kk0)), (unsigned*)(&s.k[0][0] + (st) * (64 * 64 + 128) + 64 * 64), 4, 0, 0); \
  } while (0)
  {
    const int npro = (ntile_blk > 2) ? 3 : 2;
#pragma unroll 1
    for (int j = 0; j < npro; j++) A_DMA(j, j * 64);
  }
  int ko[4][2];
#pragma unroll
  for (int t = 0; t < 4; t++) {
    const int row = 32 * (t >> 1) + 8 * (l15 >> 2) + 4 * (t & 1) + (l15 & 3);
    const int sw = (row >> 1) & 7;
    ko[t][0] = row * 64 + ((g ^ sw) * 8);
    ko[t][1] = row * 64 + (((4 + g) ^ sw) * 8);
  }
  const int swz = l15 >> 1;
  int vo[2];
  vo[0] = l15 * 64 + ((g ^ swz) * 8);
  vo[1] = l15 * 64 + (((4 + g) ^ swz) * 8);
#pragma unroll 1
  for (int kt = 0; kt < ntile_blk; kt++) {
    const int k0 = kt * 64, st = kt & 3;
    const int rem = ntile_blk - 1 - kt;
    if (rem >= 2) asm volatile("s_waitcnt vmcnt(10)" ::: "memory");
    else if (rem == 1) asm volatile("s_waitcnt vmcnt(5)" ::: "memory");
    else asm volatile("s_waitcnt vmcnt(0)" ::: "memory");
    asm volatile("s_waitcnt lgkmcnt(0)" ::: "memory");
    __builtin_amdgcn_s_barrier();
    asm volatile("" ::: "memory");
    if (kt + 3 < ntile_blk) { const int st3 = (kt + 3) & 3; A_DMA(st3, k0 + 192); }
    if (kt < ntile) {
      const u16* Ks = s.k[st];
      const u16* Vs = s.v[st];
      f32x4 ST[2][4];
#pragma unroll
      for (int t = 0; t < 4; t++) {
        const bf16x8 kf0 = *(const bf16x8*)&Ks[ko[t][0]];
        const bf16x8 kf1 = *(const bf16x8*)&Ks[ko[t][1]];
#pragma unroll
        for (int mi = 0; mi < 2; mi++) {
          f32x4 acc = {0.f, 0.f, 0.f, 0.f};
          acc = mfma16(kf0, qf[mi][0], acc);
          acc = mfma16(kf1, qf[mi][1], acc);
          ST[mi][t] = acc;
        }
      }
      f32x4 ck[4];
      {
        const unsigned cka = (unsigned)(size_t)(&Ks[64 * 64]) + 32u * g;
        asm volatile("ds_read_b128 %0, %4\n\tds_read_b128 %1, %4 offset:16\n\tds_read_b128 %2, %4 offset:128\n\t"
                     "ds_read_b128 %3, %4 offset:144\n\ts_waitcnt lgkmcnt(0)"
                     : "=&v"(ck[0]), "=&v"(ck[1]), "=&v"(ck[2]), "=&v"(ck[3]) : "v"(cka) : "memory");
      }
      const bool diag = (kt == ntile - 1);
      bf16x8 pf[2][2];
#pragma unroll
      for (int mi = 0; mi < 2; mi++) {
        const int qpos = q0 + 16 * mi + l15;
        float mx = -1e30f;
#pragma unroll
        for (int t = 0; t < 4; t++) {
          const float ckv[4] = {ck[t][0], ck[t][1], ck[t][2], ck[t][3]};
#pragma unroll
          for (int r = 0; r < 4; r++) {
            float lg = ST[mi][t][r] * (0.125f * LOG2E) + (cq[mi] - ckv[r]) * LOG2E;
            if (diag && (k0 + 32 * (t >> 1) + 8 * g + 4 * (t & 1) + r > qpos)) lg = -1e30f;
            ST[mi][t][r] = lg;
            mx = fmaxf(mx, lg);
          }
        }
        mx = fmaxf(mx, __shfl_xor(mx, 16));
        mx = fmaxf(mx, __shfl_xor(mx, 32));
        const float mn = fmaxf(m[mi], mx);
        const float alpha = __builtin_amdgcn_exp2f(m[mi] - mn);
        m[mi] = mn;
        float ps = 0.f;
#pragma unroll
        for (int t = 0; t < 4; t++)
#pragma unroll
          for (int r = 0; r < 4; r++) {
            const float pe = __builtin_amdgcn_exp2f(ST[mi][t][r] - mn);
            ST[mi][t][r] = pe;
            ps += pe;
          }
        lsum[mi] = lsum[mi] * alpha + ps;
#pragma unroll
        for (int kk = 0; kk < 2; kk++) {
          uint4 pk;
          pk.x = pack2(ST[mi][2 * kk][0], ST[mi][2 * kk][1]); pk.y = pack2(ST[mi][2 * kk][2], ST[mi][2 * kk][3]);
          pk.z = pack2(ST[mi][2 * kk + 1][0], ST[mi][2 * kk + 1][1]); pk.w = pack2(ST[mi][2 * kk + 1][2], ST[mi][2 * kk + 1][3]);
          pf[mi][kk] = __builtin_bit_cast(bf16x8, pk);
        }
#pragma unroll
        for (int r = 0; r < 4; r++) {
          const float ar = __shfl(alpha, 4 * g + r);
#pragma unroll
          for (int nd = 0; nd < 4; nd++) O[mi][nd][r] *= ar;
        }
      }
#pragma unroll
      for (int nd = 0; nd < 4; nd++)
#pragma unroll
        for (int kk = 0; kk < 2; kk++) {
          const bf16x8 vf = *(const bf16x8*)&Vs[16 * nd * 64 + vo[kk]];
          O[0][nd] = mfma16(pf[0][kk], vf, O[0][nd]);
          O[1][nd] = mfma16(pf[1][kk], vf, O[1][nd]);
        }
    }
  }
#pragma unroll
  for (int mi = 0; mi < 2; mi++) {
    float l = lsum[mi];
    l += __shfl_xor(l, 16);
    l += __shfl_xor(l, 32);
    const float inv = 1.f / l;
#pragma unroll
    for (int r = 0; r < 4; r++) {
      const float ir = __shfl(inv, 4 * g + r);
      const int t = b * SEQ + q0 + 16 * mi + 4 * g + r;
#pragma unroll
      for (int nd = 0; nd < 4; nd++) p.actA[(size_t)t * DM + 512 + hf * 64 + 16 * nd + l15] = f2bf(O[mi][nd][r] * ir);
    }
  }
}

__device__ void deferred_transpose(const P& p, int it, float* tile) {
  const int n1 = 16 * 16, n2 = n1 + 16 * 88, n3 = n2 + 44 * 16, n4 = n3 + 16 * 16;
  if (it < n1) { transpose_item(p.w_out, 1024, p.wt_out, 1024, it % 16, it / 16, 1, tile); }
  else if (it < n2) { int j = it - n1; transpose_item(p.w_gate_up, 2 * DFF, p.wt_gu, 1024, j % 16, j / 16, 2, tile, p.ffn_norm_w); }
  else if (it < n3) { int j = it - n2; transpose_item(p.w_down, 1024, p.wt_down, DFF, j % 44, j / 44, 1, tile); }
  else if (it < n4) { int j = it - n3; transpose_item(p.w_ple_gate, 1024, p.wt_pg, 1024, j % 16, j / 16, 1, tile, p.ple_norm_w); }
  else { int j = it - n4; transpose_item(p.w_ple_proj, 1024, p.wt_pp, 256, j % 4, j / 4, 1, tile); }
}
#define N_DEFER (16 * 16 + 16 * 88 + 44 * 16 + 16 * 16 + 4 * 16)

__device__ void phase_mixer(const P& p, unsigned char* smem, int rr) {
  volatile int* s_item_p = (volatile int*)(smem + SMEM_MAIN + 16);
  for (;;) {
    __syncthreads();
    if (threadIdx.x == 0) *s_item_p = (int)atomicAdd(&p.counters[rr], 1u);
    __syncthreads();
    const int item = *s_item_p;
    if (item >= NSCAN + 1024 + N_DEFER) break;
    if (item < NSCAN) { scan_unit(p, item, *(ScanSmem*)smem); }
    else if (item < NSCAN + 1024) { attn_unit(p, item - NSCAN, *(AttnSmem*)smem); }
    else { deferred_transpose(p, item - NSCAN - 1024, (float*)smem); }
  }
}

#define XB_TMO      128
#define XB_XCNT(j)  (256  + 64 * (j))
#define XB_XSUB(j)  (1280 + 64 * (j))
#define XB_XGEN(j)  (2304 + 64 * (j))
#define XB_TOP      3328
#define XB_TOPGEN   3392
#define XCD_BAR_WORDS 3456
#define XB_SPIN_CAP (1u << 20)
#define LAS __attribute__((address_space(3)))
__device__ __forceinline__ unsigned xb_ld(unsigned* p) { return __hip_atomic_load(p, __ATOMIC_RELAXED, __HIP_MEMORY_SCOPE_AGENT); }
__device__ __forceinline__ unsigned xb_add(unsigned* p, unsigned v) { return __hip_atomic_fetch_add(p, v, __ATOMIC_RELAXED, __HIP_MEMORY_SCOPE_AGENT); }
__device__ __forceinline__ unsigned xb_xcc_id() { return (unsigned)__builtin_amdgcn_s_getreg((3 << 11) | 20) & 0xFu; }
#define XB_SPIN(cond, bar) do { unsigned _sp = 0; while (cond) { __builtin_amdgcn_s_sleep(1); \
    if ((++_sp & 255u) == 0u) { if (xb_ld(&(bar)[XB_TMO])) break; if (_sp > XB_SPIN_CAP) { atomicAdd(&(bar)[XB_TMO], 1u); break; } } } } while (0)
struct XcdBarrier { unsigned* bar; unsigned x; volatile LAS unsigned* st; };
__device__ __forceinline__ XcdBarrier xcd_barrier_post(unsigned* bar, volatile LAS unsigned* st) {
  XcdBarrier b; b.bar = bar; b.x = xb_xcc_id(); b.st = st;
  if (threadIdx.x == 0) (void)xb_add(&bar[XB_XCNT(b.x)], 1u);
  return b;
}
__device__ __forceinline__ void xcd_barrier_complete(unsigned* bar, unsigned x, unsigned& nloc, unsigned& nx) {
  const unsigned G = gridDim.x * gridDim.y * gridDim.z;
  unsigned sum, cnt, mine, sp = 0u;
  for (;;) {
    sum = 0u; cnt = 0u; mine = 0u;
#pragma unroll
    for (unsigned j = 0; j < 16; ++j) { const unsigned c = xb_ld(&bar[XB_XCNT(j)]); sum += c; cnt += (c > 0u) ? 1u : 0u; mine = (j == x) ? c : mine; }
    if (sum == G) break;
    __builtin_amdgcn_s_sleep(1);
    if ((++sp & 255u) == 0u) { if (xb_ld(&bar[XB_TMO])) break; if (sp > XB_SPIN_CAP) { atomicAdd(&bar[XB_TMO], 1u); break; } }
  }
  nloc = mine > 0u ? mine : 1u; nx = cnt > 0u ? cnt : 1u;
}
__device__ __forceinline__ void xcd_barrier(const XcdBarrier& b) {
  asm volatile("s_waitcnt vmcnt(0)" ::: "memory");
  __syncthreads();
  if (threadIdx.x == 0) {
    unsigned* bar = b.bar;
    __builtin_amdgcn_s_waitcnt(0);
    unsigned nloc = b.st[0], nx = b.st[1];
    if (nloc == 0u) { xcd_barrier_complete(bar, b.x, nloc, nx); b.st[0] = nloc; b.st[1] = nx; }
    const unsigned old = xb_add(&bar[XB_XSUB(b.x)], 1u);
    const unsigned gen = old / nloc;
    if (old + 1u == (gen + 1u) * nloc) {
      __builtin_amdgcn_fence(__ATOMIC_RELEASE, "agent");
      asm volatile("s_waitcnt vmcnt(0)" ::: "memory");
      const unsigned og = xb_add(&bar[XB_TOP], 1u);
      const unsigned tg = og / nx;
      if (og + 1u == (tg + 1u) * nx) xb_add(&bar[XB_TOPGEN], 1u);
      else XB_SPIN(xb_ld(&bar[XB_TOPGEN]) == tg, bar);
      __builtin_amdgcn_fence(__ATOMIC_ACQUIRE, "agent");
      xb_add(&bar[XB_XGEN(b.x)], 1u);
      asm volatile("s_waitcnt vmcnt(0)" ::: "memory");
    } else {
      XB_SPIN(xb_ld(&bar[XB_XGEN(b.x)]) == gen, bar);
      __builtin_amdgcn_fence(__ATOMIC_ACQUIRE, "agent");
      asm volatile("s_waitcnt vmcnt(0)" ::: "memory");
    }
  }
  __syncthreads();
}

__global__ void __launch_bounds__(256, 2) mega(P p, int lo, int hi) {
  __shared__ __attribute__((aligned(16))) unsigned char smem[SMEM_MAIN + 32];
  cg::grid_group grid = cg::this_grid();
  uint4* xbw = (uint4*)(smem + SMEM_MAIN);
  if (threadIdx.x == 0) *xbw = make_uint4(0u, 0u, 0u, 0u);
  __syncthreads();
  XcdBarrier xb = xcd_barrier_post(p.bar, (volatile LAS unsigned*)xbw);
  if (hi < 0) grid.sync();
#define SEAM(k) if (lo <= k && k + 1 < hi) xcd_barrier(xb);
#if !defined(ONLY) || ONLY == 0
  if (lo <= 0 && 0 < hi) phase_prep(p, smem);
#endif
  SEAM(0)
#if !defined(ONLY) || ONLY == 1
  if (lo <= 1 && 1 < hi) phase_inproj(p, smem);
#endif
  SEAM(1)
#if !defined(ONLY) || ONLY == 2
  if (lo <= 2 && 2 < hi) phase_gdnprep(p, smem);
#endif
  SEAM(2)
#if !defined(ONLY) || ONLY == 3
  if (lo <= 3 && 3 < hi) phase_mixer(p, smem, 0);
#endif
  SEAM(3)
#if !defined(ONLY) || ONLY == 4
  if (lo <= 4 && 4 < hi) phase_gout(p, smem);
#endif
  SEAM(4)
#if !defined(ONLY) || ONLY == 5
  if (lo <= 5 && 5 < hi) phase_outproj(p, smem);
#endif
  SEAM(5)
#if !defined(ONLY) || ONLY == 6
  if (lo <= 6 && 6 < hi) phase_gateup(p, smem);
#endif
  SEAM(6)
#if !defined(ONLY) || ONLY == 7
  if (lo <= 7 && 7 < hi) phase_down(p, smem);
#endif
  SEAM(7)
#if !defined(ONLY) || ONLY == 8
  if (lo <= 8 && 8 < hi) phase_ple(p, smem);
#endif
  SEAM(8)
  if (lo <= 9 && 9 < hi) phase_final(p);
}

static_assert(sizeof(GemmSmem) <= SMEM_MAIN && sizeof(Gemm2Smem) <= SMEM_MAIN && sizeof(GdnSmem) <= SMEM_MAIN && sizeof(ScanSmem) <= SMEM_MAIN &&
              sizeof(GoutSmem) <= SMEM_MAIN && sizeof(AttnSmem) <= SMEM_MAIN && 64 * 65 * 4 <= SMEM_MAIN, "smem");

extern "C" void kernel_launch(void* const* d_in, const int* in_sizes, int n_in, void* d_out, int out_size,
                              void* d_ws, size_t ws_size, hipStream_t stream) {
  static int grid_blocks = 0;
  if (!grid_blocks) {
    int dev = 0, cus = 0, per_cu = 0;
    hipGetDevice(&dev);
    hipDeviceGetAttribute(&cus, hipDeviceAttributeMultiprocessorCount, dev);
    hipOccupancyMaxActiveBlocksPerMultiprocessor(&per_cu, mega, 256, 0);
    if (per_cu > 2) per_cu = 2;
    if (per_cu < 1) per_cu = 1;
    grid_blocks = cus * per_cu;
  }
  P p{};
  const float* const* in = (const float* const*)d_in;
  p.x = in[0]; p.p = in[1]; p.attn_norm_w = in[2]; p.w_in = in[3]; p.conv_w = in[4]; p.a_log = in[5];
  p.dt_bias = in[6]; p.gdn_norm_w = in[7]; p.fox_f_bias = in[8]; p.w_out = in[9]; p.ffn_norm_w = in[10];
  p.w_gate_up = in[11]; p.w_down = in[12]; p.ple_norm_w = in[13]; p.w_ple_gate = in[14]; p.w_ple_proj = in[15];
  p.final_norm_w = in[16];
  p.h = (float*)d_out;
  unsigned char* ws = (unsigned char*)d_ws;
  size_t off = 0;
  auto take = [&](size_t bytes) { unsigned char* r = ws + off; off += (bytes + 255) & ~(size_t)255; return r; };
  p.counters = (unsigned*)take(256);
  p.bar = (unsigned*)take(XCD_BAR_WORDS * 4);
  p.wt_in = (u16*)take((size_t)NIN_PAD * 1024 * 2);
  p.wt_out = (u16*)take((size_t)1024 * 1024 * 2);
  p.wt_gu = (u16*)take((size_t)2 * DFF * 1024 * 2);
  p.wt_down = (u16*)take((size_t)1024 * DFF * 2);
  p.wt_pg = (u16*)take((size_t)1024 * 1024 * 2);
  p.wt_pp = (u16*)take((size_t)1024 * 256 * 2);
  p.actA = (u16*)take((size_t)NTOK * 1024 * 2);
  p.pb = (u16*)take((size_t)NTOK * 256 * 2);
  p.proj = (u16*)take((size_t)NTOK * PROJW * 2);
  p.vt = (u16*)take((size_t)64 * 64 * SEQ * 2);
  p.gates = (float*)take((size_t)NTOK * 16 * 4);
  p.cf = (float*)take((size_t)64 * SEQ * 4);
  p.gM = (u16*)take((size_t)1024 * 16384 * 2);
  p.gC = (u16*)take((size_t)1024 * 16384 * 2);
  p.gdl = (float*)take(1024 * 4);
  p.rss = (float*)take((size_t)3 * NTOK * 4);
  p.hb = p.gM;
  if (off > ws_size) fprintf(stderr, "workspace too small: need %zu have %zu\n", off, ws_size);
  u16* ob = (u16*)d_out;
  p.gS = ob;
  p.gQ = ob + (size_t)1024 * 16384;
  p.gO = ob + (size_t)1024 * 16384 + (size_t)1024 * 8192;
  hipMemsetAsync(p.bar, 0, XCD_BAR_WORDS * 4, stream);
  int lo = 0, hi = NPHASE;
  void* args[] = {&p, &lo, &hi};
  hipError_t e = hipLaunchCooperativeKernel((void*)mega, dim3(grid_blocks), dim3(256), args, 0, stream);
  if (e != hipSuccess) fprintf(stderr, "cooperative launch failed: %s (grid %d)\n", hipGetErrorString(e), grid_blocks);
}
```

```cpp
#include <hip/hip_runtime.h>
#include <hip/hip_cooperative_groups.h>
#include <cstdio>
#include <cstdint>
namespace cg = cooperative_groups;

typedef unsigned short u16;
typedef __attribute__((ext_vector_type(8))) short bf16x8;
typedef __attribute__((ext_vector_type(4))) float f32x4;

#define NTOK 16384
#define SEQ 2048
#define DM 1024
#define DFF 2816
#define PROJW 3072
#define NIN_PAD 3712
#define EPSV 1e-6f
#define NPHASE 10
#define SMEM_MAIN 73728

struct P {
  const float *x, *p, *attn_norm_w, *w_in, *conv_w, *a_log, *dt_bias, *gdn_norm_w, *fox_f_bias, *w_out,
      *ffn_norm_w, *w_gate_up, *w_down, *ple_norm_w, *w_ple_gate, *w_ple_proj, *final_norm_w;
  float* h;
  u16 *wt_in, *wt_out, *wt_gu, *wt_down, *wt_pg, *wt_pp;
  u16 *actA;
  u16 *pb;
  u16 *proj;
  u16 *vt;
  float *gates;
  float *cf;
  u16 *gM, *gC;
  u16 *gQ, *gO;
  u16 *gS;
  float *gdl;
  unsigned *counters;
  unsigned *bar;
  u16 *hb;
  float *rss;
};

typedef __attribute__((ext_vector_type(2))) float f32x2_t;
typedef __attribute__((ext_vector_type(2))) __bf16 bf16x2_t;
__device__ __forceinline__ u16 f2bf(float f) { return __builtin_bit_cast(u16, (__bf16)f); }
__device__ __forceinline__ float bf2f(u16 h) { return __uint_as_float(((unsigned)h) << 16); }
__device__ __forceinline__ unsigned pack2(float a, float b) {
  f32x2_t f = {a, b};
  return __builtin_bit_cast(unsigned, __builtin_convertvector(f, bf16x2_t));
}
__device__ __forceinline__ float siluf(float v) { return v / (1.f + __expf(-v)); }
__device__ __forceinline__ float sigmoidf_(float v) { return 1.f / (1.f + __expf(-v)); }
__device__ __forceinline__ f32x4 mfma16(bf16x8 a, bf16x8 b, f32x4 c) {
  return __builtin_amdgcn_mfma_f32_16x16x32_bf16(a, b, c, 0, 0, 0);
}
#define LDS_FENCE() asm volatile("s_waitcnt lgkmcnt(0)" ::: "memory")

__device__ __forceinline__ void unpack8(const uint4& v, float (&f)[8]) {
  f[0] = bf2f((u16)(v.x & 0xffffu)); f[1] = bf2f((u16)(v.x >> 16));
  f[2] = bf2f((u16)(v.y & 0xffffu)); f[3] = bf2f((u16)(v.y >> 16));
  f[4] = bf2f((u16)(v.z & 0xffffu)); f[5] = bf2f((u16)(v.z >> 16));
  f[6] = bf2f((u16)(v.w & 0xffffu)); f[7] = bf2f((u16)(v.w >> 16));
}
__device__ __forceinline__ void unpack4(const uint2& v, float (&f)[4]) {
  f[0] = bf2f((u16)(v.x & 0xffffu)); f[1] = bf2f((u16)(v.x >> 16));
  f[2] = bf2f((u16)(v.y & 0xffffu)); f[3] = bf2f((u16)(v.y >> 16));
}


__device__ __forceinline__ int colmap(int kind, int nn) {
  if (kind == 0) {
    if (nn < 2048) return nn;
    if (nn < 3584) return nn + 8;
    if (nn < 3588) return 2048 + (nn - 3584);
    if (nn < 3592) return 2052 + (nn - 3588);
    if (nn < 3600) return nn;
    return -1;
  } else if (kind == 2) {
    int i = nn >> 7, wc = (nn >> 6) & 1, u = (nn >> 5) & 1, j = nn & 31;
    return u * DFF + 64 * i + 32 * wc + j;
  }
  return nn;
}

__device__ void transpose_item(const float* __restrict__ src, int ldsrc, u16* __restrict__ dst, int K,
                               int kt, int nt, int kind, float* tile, const float* __restrict__ kscale = nullptr) {
  int tid = threadIdx.x;
  asm volatile("" : "+v"(tid));
  const int c = tid & 63, r0 = tid >> 6;
  const int ncol = colmap(kind, nt * 64 + c);
  float tv[16];
#pragma unroll
  for (int i = 0; i < 16; i++) {
    int r = r0 + 4 * i;
    tv[i] = (ncol >= 0) ? __builtin_nontemporal_load(&src[(size_t)(kt * 64 + r) * ldsrc + ncol]) : 0.f;
  }
  if (kscale) {
#pragma unroll
    for (int i = 0; i < 16; i++) tv[i] *= kscale[kt * 64 + r0 + 4 * i];
  }
#pragma unroll
  for (int i = 0; i < 16; i++) tile[(r0 + 4 * i) * 65 + c] = tv[i];
  __syncthreads();
#pragma unroll 8
  for (int i = 0; i < 16; i++) {
    int rn = r0 + 4 * i;
    dst[(size_t)(nt * 64 + rn) * K + kt * 64 + c] = f2bf(tile[c * 65 + rn]);
  }
  __syncthreads();
}

__device__ __forceinline__ void rmsnorm_row(const float* src, const float* __restrict__ w,
                                            u16* dstb, float* dstf, int row) {
  const int lane = threadIdx.x & 63;
  float4 v[4];
  float ss = 0.f;
#pragma unroll
  for (int i = 0; i < 4; i++) {
    v[i] = *(const float4*)&src[(size_t)row * DM + i * 256 + lane * 4];
    ss += v[i].x * v[i].x + v[i].y * v[i].y + v[i].z * v[i].z + v[i].w * v[i].w;
  }
#pragma unroll
  for (int off = 32; off >= 1; off >>= 1) ss += __shfl_xor(ss, off);
  const float r = rsqrtf(ss * (1.f / DM) + EPSV);
#pragma unroll
  for (int i = 0; i < 4; i++) {
    const int col = i * 256 + lane * 4;
    float4 wv = *(const float4*)&w[col];
    float y0 = v[i].x * r * wv.x, y1 = v[i].y * r * wv.y, y2 = v[i].z * r * wv.z, y3 = v[i].w * r * wv.w;
    if (dstb) {
      uint2 o; o.x = pack2(y0, y1); o.y = pack2(y2, y3);
      *(uint2*)&dstb[(size_t)row * DM + col] = o;
    } else {
      *(float4*)&dstf[(size_t)row * DM + col] = make_float4(y0, y1, y2, y3);
    }
  }
}

__device__ void phase_prep(const P& p, unsigned char* smem) {
  float* tile = (float*)smem;
  if (blockIdx.x == 0 && threadIdx.x < 16) p.counters[threadIdx.x] = 0u;
  for (int i = blockIdx.x * 256 + threadIdx.x; i < 3 * NTOK; i += gridDim.x * 256) p.rss[i] = 0.f;
  for (int it = blockIdx.x; it < 16 * 58; it += gridDim.x) transpose_item(p.w_in, 3600, p.wt_in, 1024, it % 16, it / 16, 0, tile);
  const int wave = threadIdx.x >> 6, lane = threadIdx.x & 63;
  for (int rb = blockIdx.x; rb < NTOK / 8; rb += gridDim.x) {
    const int row = rb * 8 + wave * 2;
    float4 v0[4], v1[4];
#pragma unroll
    for (int i = 0; i < 4; i++) {
      { const f32x4 t0 = __builtin_nontemporal_load((const f32x4*)&p.x[(size_t)row * DM + i * 256 + lane * 4]);
        const f32x4 t1 = __builtin_nontemporal_load((const f32x4*)&p.x[(size_t)(row + 1) * DM + i * 256 + lane * 4]);
        v0[i] = make_float4(t0[0], t0[1], t0[2], t0[3]); v1[i] = make_float4(t1[0], t1[1], t1[2], t1[3]); }
    }
    const float4 pv0 = *(const float4*)&p.p[(size_t)row * 256 + lane * 4];
    const float4 pv1 = *(const float4*)&p.p[(size_t)(row + 1) * 256 + lane * 4];
    float s0 = 0.f, s1 = 0.f;
#pragma unroll
    for (int i = 0; i < 4; i++) {
      s0 += v0[i].x * v0[i].x + v0[i].y * v0[i].y + v0[i].z * v0[i].z + v0[i].w * v0[i].w;
      s1 += v1[i].x * v1[i].x + v1[i].y * v1[i].y + v1[i].z * v1[i].z + v1[i].w * v1[i].w;
    }
#pragma unroll
    for (int off = 32; off >= 1; off >>= 1) { s0 += __shfl_xor(s0, off); s1 += __shfl_xor(s1, off); }
    const float r0 = rsqrtf(s0 * (1.f / DM) + EPSV), r1 = rsqrtf(s1 * (1.f / DM) + EPSV);
#pragma unroll
    for (int i = 0; i < 4; i++) {
      const int col = i * 256 + lane * 4;
      const float4 wv = *(const float4*)&p.attn_norm_w[col];
      uint2 o;
      o.x = pack2(v0[i].x * r0 * wv.x, v0[i].y * r0 * wv.y); o.y = pack2(v0[i].z * r0 * wv.z, v0[i].w * r0 * wv.w);
      *(uint2*)&p.actA[(size_t)row * DM + col] = o;
      o.x = pack2(v1[i].x * r1 * wv.x, v1[i].y * r1 * wv.y); o.y = pack2(v1[i].z * r1 * wv.z, v1[i].w * r1 * wv.w);
      *(uint2*)&p.actA[(size_t)(row + 1) * DM + col] = o;
    }
    uint2 o; o.x = pack2(pv0.x, pv0.y); o.y = pack2(pv0.z, pv0.w);
    *(uint2*)&p.pb[(size_t)row * 256 + lane * 4] = o;
    o.x = pack2(pv1.x, pv1.y); o.y = pack2(pv1.z, pv1.w);
    *(uint2*)&p.pb[(size_t)(row + 1) * 256 + lane * 4] = o;
  }
}

__device__ void phase_rmsnorm(const float* src, const float* w, u16* dstb, float* dstf) {
  const int wave = threadIdx.x >> 6;
  for (int rb = blockIdx.x; rb < NTOK / 4; rb += gridDim.x) rmsnorm_row(src, w, dstb, dstf, rb * 4 + wave);
}

__device__ void phase_final(const P& p) {
  const int wave = threadIdx.x >> 6, lane = threadIdx.x & 63;
  for (int rb = blockIdx.x; rb < NTOK / 4; rb += gridDim.x) {
    const int row = rb * 4 + wave;
    const float r = rsqrtf(p.rss[2 * NTOK + row] * (1.f / DM) + EPSV);
#pragma unroll
    for (int i = 0; i < 4; i++) {
      const int col = i * 256 + lane * 4;
      float4 v = *(const float4*)&p.h[(size_t)row * DM + col];
      const float4 wv = *(const float4*)&p.final_norm_w[col];
      f32x4 o = {v.x * r * wv.x, v.y * r * wv.y, v.z * r * wv.z, v.w * r * wv.w};
      __builtin_nontemporal_store(o, (f32x4*)&p.h[(size_t)row * DM + col]);
    }
  }
}

#define GK 64
struct GemmSmem { u16 a[2][128 * GK]; u16 b[2][128 * GK]; };

template <bool SWAP>
__device__ __forceinline__ void gemm_tile(const u16* __restrict__ A, int lda, const u16* __restrict__ Bt, int ldb,
                                          int K, int m0, int n0, GemmSmem& s, f32x4 (&acc)[4][4]) {
  int tid = threadIdx.x;
  asm volatile("" : "+v"(tid));
  const int lane = tid & 63, wave = tid >> 6;
  const int wr = wave >> 1, wc = wave & 1;
  const int l15 = lane & 15, g = lane >> 4;
  const int nk = K / GK;
  const int drow = 8 * wave + (lane >> 3);
  const int dchunk = (lane & 7) ^ ((4 * (wave & 1) + (lane >> 4)) & 7);
  const u16* Ap = A + (size_t)(m0 + drow) * lda + dchunk * 8;
  const u16* Bp = Bt + (size_t)(n0 + drow) * ldb + dchunk * 8;
  const size_t sa = (size_t)32 * lda, sb = (size_t)32 * ldb;
#define G_DMA(bufi, koff) do { \
    _Pragma("unroll") for (int _i = 0; _i < 4; _i++) { \
      __builtin_amdgcn_global_load_lds((const unsigned*)(Ap + _i * sa + (koff)), (unsigned*)&s.a[bufi][(32 * _i + 8 * wave) * GK], 16, 0, 0); \
      __builtin_amdgcn_global_load_lds((const unsigned*)(Bp + _i * sb + (koff)), (unsigned*)&s.b[bufi][(32 * _i + 8 * wave) * GK], 16, 0, 0); \
    } } while (0)
  const int fo0 = l15 * GK + ((g ^ (l15 >> 1)) * 8);
  const int fo1 = l15 * GK + (((4 + g) ^ (l15 >> 1)) * 8);
  G_DMA(0, 0);
  asm volatile("s_waitcnt vmcnt(0)" ::: "memory");
  __builtin_amdgcn_s_barrier();
  asm volatile("" ::: "memory");
  for (int kt = 0; kt < nk; kt++) {
    const int buf = kt & 1;
    if (kt + 1 < nk) { if (buf) G_DMA(0, (kt + 1) * GK); else G_DMA(1, (kt + 1) * GK); }
    const u16* sa_ = &s.a[buf][(wr * 64) * GK];
    const u16* sb_ = &s.b[buf][(wc * 64) * GK];
#pragma unroll
    for (int ks = 0; ks < 2; ks++) {
      const int fo = ks ? fo1 : fo0;
      bf16x8 af[4], bfr[4];
#pragma unroll
      for (int mi = 0; mi < 4; mi++) af[mi] = *(const bf16x8*)&sa_[mi * 16 * GK + fo];
#pragma unroll
      for (int ni = 0; ni < 4; ni++) bfr[ni] = *(const bf16x8*)&sb_[ni * 16 * GK + fo];
#pragma unroll
      for (int mi = 0; mi < 4; mi++)
#pragma unroll
        for (int ni = 0; ni < 4; ni++) acc[mi][ni] = SWAP ? mfma16(bfr[ni], af[mi], acc[mi][ni]) : mfma16(af[mi], bfr[ni], acc[mi][ni]);
    }
    asm volatile("s_waitcnt vmcnt(0) lgkmcnt(0)" ::: "memory");
    __builtin_amdgcn_s_barrier();
    asm volatile("" ::: "memory");
  }
}


#define G2K 32
struct Gemm2Smem { u16 a[3][256 * G2K]; u16 b[3][128 * G2K]; };

template <bool SWAP>
__device__ __forceinline__ void gemm256(const u16* __restrict__ A, int lda, const u16* __restrict__ Bt, int ldb,
                                        int K, int m0, int n0, Gemm2Smem& s, f32x4 (&acc)[8][4]) {
  int tid = threadIdx.x;
  asm volatile("" : "+v"(tid));
  const int lane = tid & 63, wave = tid >> 6;
  const int wr = wave >> 1, wc = wave & 1;
  const int l15 = lane & 15, g = lane >> 4;
  const int nk = K / G2K;
  const int drow = 16 * wave + (lane >> 2);
  const int dchunk = (lane & 3) ^ g;
  const u16* Ap = A + (size_t)(m0 + drow) * lda + dchunk * 8;
  const u16* Bp = Bt + (size_t)(n0 + drow) * ldb + dchunk * 8;
  const size_t sa = (size_t)64 * lda, sb = (size_t)64 * ldb;
  u16* const sa0 = &s.a[0][0] + (16 * wave) * G2K;
  u16* const sb0 = &s.b[0][0] + (16 * wave) * G2K;
#define G2_DMA(st, koff) do { \
    u16* _da = sa0 + (st) * (256 * G2K); u16* _db = sb0 + (st) * (128 * G2K); \
    _Pragma("unroll") for (int _i = 0; _i < 4; _i++) \
      __builtin_amdgcn_global_load_lds((const unsigned*)(Ap + _i * sa + (koff)), (unsigned*)(_da + 64 * _i * G2K), 16, 0, 0); \
    _Pragma("unroll") for (int _i = 0; _i < 2; _i++) \
      __builtin_amdgcn_global_load_lds((const unsigned*)(Bp + _i * sb + (koff)), (unsigned*)(_db + 64 * _i * G2K), 16, 0, 0); \
  } while (0)
  const int fo = l15 * G2K + ((g ^ ((l15 >> 2) & 3)) * 8);
  asm volatile("s_waitcnt lgkmcnt(0)" ::: "memory");
  __builtin_amdgcn_s_barrier();
  asm volatile("" ::: "memory");
#pragma unroll 1
  for (int j = 0; j < 2; j++) G2_DMA(j, j * G2K);
  int st = 0;
  for (int kt = 0; kt < nk; kt++) {
    if (kt + 1 < nk) asm volatile("s_waitcnt vmcnt(6)" ::: "memory");
    else asm volatile("s_waitcnt vmcnt(0)" ::: "memory");
    __builtin_amdgcn_s_barrier();
    asm volatile("" ::: "memory");
    if (kt + 2 < nk) {
      const int st2 = (st >= 1) ? st - 1 : 2;
      G2_DMA(st2, (kt + 2) * G2K);
    }
    const u16* sa_ = &s.a[0][0] + st * (256 * G2K) + (wr * 128) * G2K + fo;
    const u16* sb_ = &s.b[0][0] + st * (128 * G2K) + (wc * 64) * G2K + fo;
    bf16x8 af[8], bfr[4];
#pragma unroll
    for (int mi = 0; mi < 8; mi++) af[mi] = *(const bf16x8*)&sa_[mi * 16 * G2K];
#pragma unroll
    for (int ni = 0; ni < 4; ni++) bfr[ni] = *(const bf16x8*)&sb_[ni * 16 * G2K];
#pragma unroll
    for (int mi = 0; mi < 8; mi++)
#pragma unroll
      for (int ni = 0; ni < 4; ni++) acc[mi][ni] = SWAP ? mfma16(bfr[ni], af[mi], acc[mi][ni]) : mfma16(af[mi], bfr[ni], acc[mi][ni]);
    st = (st == 2) ? 0 : st + 1;
  }
}
#define ZERO_ACC8(acc) _Pragma("unroll") for (int _i = 0; _i < 8; _i++) _Pragma("unroll") for (int _j = 0; _j < 4; _j++) acc[_i][_j] = (f32x4){0.f, 0.f, 0.f, 0.f};

#define ZERO_ACC(acc) _Pragma("unroll") for (int _i = 0; _i < 4; _i++) _Pragma("unroll") for (int _j = 0; _j < 4; _j++) acc[_i][_j] = (f32x4){0.f, 0.f, 0.f, 0.f};

template <int NMI>
__device__ __forceinline__ void row_sumsq_add(f32x4 (&sq)[NMI][4], float* rss, int row0, int l15, int g) {
#pragma unroll
  for (int mi = 0; mi < NMI; mi++) {
    float v = 0.f;
#pragma unroll
    for (int ni = 0; ni < 4; ni++) v += (sq[mi][ni][0] + sq[mi][ni][1]) + (sq[mi][ni][2] + sq[mi][ni][3]);
    v += __shfl_xor(v, 16);
    v += __shfl_xor(v, 32);
    if (g == 0) atomicAdd(&rss[row0 + mi * 16 + l15], v);
  }
}

__device__ void phase_inproj(const P& p, unsigned char* smem) {
  Gemm2Smem& s = *(Gemm2Smem*)smem;
  const int lane = threadIdx.x & 63, wave = threadIdx.x >> 6, wr = wave >> 1, wc = wave & 1, l15 = lane & 15, g = lane >> 4;
  const int ntiles = 64 * 29;
  for (int tl = blockIdx.x; tl < ntiles; tl += gridDim.x) {
    const int mt = tl & 63, nt = tl >> 6;
    const int m0 = mt * 256, n0 = nt * 128;
    f32x4 acc[8][4];
    ZERO_ACC8(acc);
    if (nt >= 24 && nt < 28) {
      gemm256<false>(p.actA, DM, p.wt_in, DM, DM, m0, n0, s, acc);
#pragma unroll
      for (int mi = 0; mi < 8; mi++)
#pragma unroll
        for (int ni = 0; ni < 4; ni++) {
          const int rowb = m0 + wr * 128 + mi * 16 + g * 4;
          const int col = n0 + wc * 64 + ni * 16 + l15;
          const int cc = col - 3072, hh = cc >> 6, d = cc & 63;
          const int b = rowb >> 11, sq = rowb & 2047;
          uint2 o; o.x = pack2(acc[mi][ni][0], acc[mi][ni][1]); o.y = pack2(acc[mi][ni][2], acc[mi][ni][3]);
          *(uint2*)&p.vt[((size_t)((b * 8 + hh) * 64 + d)) * SEQ + sq] = o;
        }
    } else {
      gemm256<true>(p.actA, DM, p.wt_in, DM, DM, m0, n0, s, acc);
#pragma unroll
      for (int mi = 0; mi < 8; mi++)
#pragma unroll
        for (int ni = 0; ni < 4; ni++) {
          const int row = m0 + wr * 128 + mi * 16 + l15;
          const int col = n0 + wc * 64 + ni * 16 + g * 4;
          if (nt < 24) {
            uint2 o; o.x = pack2(acc[mi][ni][0], acc[mi][ni][1]); o.y = pack2(acc[mi][ni][2], acc[mi][ni][3]);
            *(uint2*)&p.proj[(size_t)row * PROJW + col] = o;
          } else if (col < 3600) {
            *(float4*)&p.gates[(size_t)row * 16 + (col - 3584)] = make_float4(acc[mi][ni][0], acc[mi][ni][1], acc[mi][ni][2], acc[mi][ni][3]);
          }
        }
    }
  }
}

__device__ void phase_outproj(const P& p, unsigned char* smem) {
  Gemm2Smem& s = *(Gemm2Smem*)smem;
  const int lane = threadIdx.x & 63, wave = threadIdx.x >> 6, wr = wave >> 1, wc = wave & 1, l15 = lane & 15, g = lane >> 4;
  for (int tl = blockIdx.x; tl < 64 * 8; tl += gridDim.x) {
    const int mt = tl & 63, nt = tl >> 6;
    const int m0 = mt * 256, n0 = nt * 128;
    f32x4 acc[8][4];
    ZERO_ACC8(acc);
    gemm256<true>(p.actA, DM, p.wt_out, DM, DM, m0, n0, s, acc);
#pragma unroll
    for (int mi = 0; mi < 8; mi++)
#pragma unroll
      for (int ni = 0; ni < 4; ni++) {
        const size_t idx = (size_t)(m0 + wr * 128 + mi * 16 + l15) * DM + n0 + wc * 64 + ni * 16 + g * 4;
        const f32x4 xv4 = __builtin_nontemporal_load((const f32x4*)&p.x[idx]);
        const float4 xv = make_float4(xv4[0], xv4[1], xv4[2], xv4[3]);
        const float h0 = xv.x + acc[mi][ni][0], h1 = xv.y + acc[mi][ni][1], h2 = xv.z + acc[mi][ni][2], h3 = xv.w + acc[mi][ni][3];
        uint2 o; o.x = pack2(h0, h1); o.y = pack2(h2, h3);
        *(uint2*)&p.hb[idx] = o;
        acc[mi][ni] = (f32x4){h0 * h0, h1 * h1, h2 * h2, h3 * h3};
      }
    row_sumsq_add(acc, p.rss, m0 + wr * 128, l15, g);
  }
}

__device__ void phase_gateup(const P& p, unsigned char* smem) {
  Gemm2Smem& s = *(Gemm2Smem*)smem;
  u16* act = p.proj;
  const int lane = threadIdx.x & 63, wave = threadIdx.x >> 6, wr = wave >> 1, wc = wave & 1, l15 = lane & 15, g = lane >> 4;
  for (int tl = blockIdx.x; tl < 64 * 44; tl += gridDim.x) {
    const int mt = tl & 63, nt = tl >> 6;
    const int m0 = mt * 256, n0 = nt * 128;
    f32x4 acc[8][4];
    ZERO_ACC8(acc);
    gemm256<true>(p.hb, DM, p.wt_gu, DM, DM, m0, n0, s, acc);
#pragma unroll
    for (int mi = 0; mi < 8; mi++) {
      const int row = m0 + wr * 128 + mi * 16 + l15;
      const float rs = rsqrtf(p.rss[row] * (1.f / DM) + EPSV);
#pragma unroll
      for (int ni = 0; ni < 2; ni++) {
        const int col = 64 * nt + 32 * wc + 16 * ni + g * 4;
        float v[4];
#pragma unroll
        for (int r = 0; r < 4; r++) v[r] = siluf(acc[mi][ni][r] * rs) * (acc[mi][ni + 2][r] * rs);
        uint2 o; o.x = pack2(v[0], v[1]); o.y = pack2(v[2], v[3]);
        *(uint2*)&act[(size_t)row * DFF + col] = o;
      }
    }
  }
}

__device__ void phase_down(const P& p, unsigned char* smem) {
  Gemm2Smem& s = *(Gemm2Smem*)smem;
  const u16* act = p.proj;
  const int lane = threadIdx.x & 63, wave = threadIdx.x >> 6, wr = wave >> 1, wc = wave & 1, l15 = lane & 15, g = lane >> 4;
  for (int tl = blockIdx.x; tl < 64 * 8; tl += gridDim.x) {
    const int mt = tl & 63, nt = tl >> 6;
    const int m0 = mt * 256, n0 = nt * 128;
    f32x4 acc[8][4];
    ZERO_ACC8(acc);
    gemm256<true>(act, DFF, p.wt_down, DFF, DFF, m0, n0, s, acc);
#pragma unroll
    for (int mi = 0; mi < 8; mi++)
#pragma unroll
      for (int ni = 0; ni < 4; ni++) {
        const size_t idx = (size_t)(m0 + wr * 128 + mi * 16 + l15) * DM + n0 + wc * 64 + ni * 16 + g * 4;
        float hp[4];
        unpack4(*(const uint2*)&p.hb[idx], hp);
        const float h0 = hp[0] + acc[mi][ni][0], h1 = hp[1] + acc[mi][ni][1], h2 = hp[2] + acc[mi][ni][2], h3 = hp[3] + acc[mi][ni][3];
        uint2 o; o.x = pack2(h0, h1); o.y = pack2(h2, h3);
        *(uint2*)&p.actA[idx] = o;
        acc[mi][ni] = (f32x4){h0 * h0, h1 * h1, h2 * h2, h3 * h3};
      }
    row_sumsq_add(acc, p.rss + NTOK, m0 + wr * 128, l15, g);
  }
}

__device__ void phase_ple(const P& p, unsigned char* smem) {
  GemmSmem& s = *(GemmSmem*)smem;
  const int lane = threadIdx.x & 63, wave = threadIdx.x >> 6, wr = wave >> 1, wc = wave & 1, l15 = lane & 15, g = lane >> 4;
  for (int tl = blockIdx.x; tl < 128 * 8; tl += gridDim.x) {
    const int mt = tl & 127, nt = tl >> 7;
    const int m0 = mt * 128, n0 = nt * 128;
    f32x4 acc[4][4], acc2[4][4];
    ZERO_ACC(acc);
    gemm_tile<true>(p.actA, DM, p.wt_pg, DM, DM, m0, n0, s, acc);
#pragma unroll
    for (int mi = 0; mi < 4; mi++) {
      const float rs = rsqrtf(p.rss[NTOK + m0 + wr * 64 + mi * 16 + l15] * (1.f / DM) + EPSV);
#pragma unroll
      for (int ni = 0; ni < 4; ni++)
#pragma unroll
        for (int r = 0; r < 4; r++) acc[mi][ni][r] = sigmoidf_(acc[mi][ni][r] * rs);
    }
    ZERO_ACC(acc2);
    gemm_tile<true>(p.pb, 256, p.wt_pp, 256, 256, m0, n0, s, acc2);
#pragma unroll
    for (int mi = 0; mi < 4; mi++)
#pragma unroll
      for (int ni = 0; ni < 4; ni++) {
        const size_t idx = (size_t)(m0 + wr * 64 + mi * 16 + l15) * DM + n0 + wc * 64 + ni * 16 + g * 4;
        float hp[4];
        unpack4(*(const uint2*)&p.actA[idx], hp);
        const float h0 = hp[0] + acc[mi][ni][0] * acc2[mi][ni][0], h1 = hp[1] + acc[mi][ni][1] * acc2[mi][ni][1];
        const float h2 = hp[2] + acc[mi][ni][2] * acc2[mi][ni][2], h3 = hp[3] + acc[mi][ni][3] * acc2[mi][ni][3];
        *(float4*)&p.h[idx] = make_float4(h0, h1, h2, h3);
        acc2[mi][ni] = (f32x4){h0 * h0, h1 * h1, h2 * h2, h3 * h3};
      }
    row_sumsq_add(acc2, p.rss + 2 * NTOK, m0 + wr * 64, l15, g);
  }
}

#define QLD 136
#define KLD 72
struct GdnSmem {
  u16 qb[64 * QLD];
  u16 kn[64 * QLD];
  u16 vb[64 * QLD];
  float Am[64 * 64];
  float gc[64], beta[64], be[64];
};
static_assert(offsetof(GdnSmem, kn) == 17408 && offsetof(GdnSmem, vb) == 34816 && offsetof(GdnSmem, Am) == 52224, "layout");


__device__ void gdn_unit(const P& p, int unit, GdnSmem& s) {
  int tid = threadIdx.x;
  asm volatile("" : "+v"(tid));
  int lane = tid & 63, wave = tid >> 6;
  int l15 = lane & 15, g = lane >> 4;
#define GDN_REFRESH() do { tid = threadIdx.x; asm volatile("" : "+v"(tid) :: "memory"); lane = tid & 63; wave = tid >> 6; l15 = lane & 15; g = lane >> 4; } while (0)
  const int bh = unit >> 5, n = unit & 31;
  const int b = bh >> 2, h = bh & 3;
  const int tb = b * SEQ;
  const int s0 = n * 64;
  u16* const qk_s = s.qb;
  u16* const WU = s.kn;
  u16* const kdT = (u16*)((unsigned char*)s.kn + 32768);
  __syncthreads();
  if (wave == 0) {
    const int t = tb + s0 + lane;
    const float ga = p.gates[(size_t)t * 16 + h], gb = p.gates[(size_t)t * 16 + 4 + h];
    const float xx = ga + p.dt_bias[h];
    const float sp = (xx > 20.f) ? xx : log1pf(__expf(xx));
    float gg = -__expf(p.a_log[h]) * sp;
#pragma unroll
    for (int off = 1; off < 64; off <<= 1) {
      float nb = __shfl_up(gg, off);
      if (lane >= off) gg += nb;
    }
    const float bt = sigmoidf_(gb);
    s.gc[lane] = gg;
    s.beta[lane] = bt;
    s.be[lane] = bt * __expf(gg);
  }
  {
    const int ch = tid & 15, rg = tid >> 4;
#pragma unroll 1
    for (int mat = 0; mat < 3; mat++) {
      const int col0 = mat * 512 + h * 128 + ch * 8;
      float cw[4][8];
#pragma unroll
      for (int k = 0; k < 4; k++) {
        const float4 w0 = *(const float4*)&p.conv_w[k * 1536 + col0];
        const float4 w1 = *(const float4*)&p.conv_w[k * 1536 + col0 + 4];
        cw[k][0] = w0.x; cw[k][1] = w0.y; cw[k][2] = w0.z; cw[k][3] = w0.w;
        cw[k][4] = w1.x; cw[k][5] = w1.y; cw[k][6] = w1.z; cw[k][7] = w1.w;
      }
      uint4 xr[7];
#pragma unroll
      for (int j = 0; j < 7; j++) {
        const int sp = s0 + 4 * rg + j - 3;
        xr[j] = (sp >= 0) ? *(const uint4*)&p.proj[(size_t)(tb + sp) * PROJW + col0] : make_uint4(0u, 0u, 0u, 0u);
      }
      float xf[7][8];
#pragma unroll
      for (int j = 0; j < 7; j++) unpack8(xr[j], xf[j]);
      u16* dst = (mat == 0) ? s.qb : ((mat == 1) ? s.kn : s.vb);
#pragma unroll
      for (int r = 0; r < 4; r++) {
        float val[8];
        float ss = 0.f;
#pragma unroll
        for (int c = 0; c < 8; c++) {
          const float cv = cw[0][c] * xf[r][c] + cw[1][c] * xf[r + 1][c] + cw[2][c] * xf[r + 2][c] + cw[3][c] * xf[r + 3][c];
          val[c] = siluf(cv);
          ss += val[c] * val[c];
        }
        float rs = 1.f;
        if (mat < 2) {
#pragma unroll
          for (int off = 1; off < 16; off <<= 1) ss += __shfl_xor(ss, off);
          rs = rsqrtf(ss + EPSV) * ((mat == 0) ? 0.08838834764831845f : 1.f);
        }
        uint4 o;
        o.x = pack2(val[0] * rs, val[1] * rs); o.y = pack2(val[2] * rs, val[3] * rs);
        o.z = pack2(val[4] * rs, val[5] * rs); o.w = pack2(val[6] * rs, val[7] * rs);
        *(uint4*)&dst[(4 * rg + r) * QLD + ch * 8] = o;
      }
    }
  }
  __syncthreads();
  GDN_REFRESH();
  u16* const gQ = p.gQ + (size_t)unit * 8192;
  {
#pragma unroll
    for (int it = 0; it < 4; it++) {
      const int idx = tid + 256 * it;
      const int i = idx >> 4, d8 = (idx & 15) * 8;
      const float e = __expf(s.gc[i]);
      float f[8];
      unpack8(*(const uint4*)&s.qb[i * QLD + d8], f);
      uint4 o;
      o.x = pack2(f[0] * e, f[1] * e); o.y = pack2(f[2] * e, f[3] * e);
      o.z = pack2(f[4] * e, f[5] * e); o.w = pack2(f[6] * e, f[7] * e);
      *(uint4*)&gQ[i * 128 + d8] = o;
    }
  }
  f32x4 cqk[4];
  {
    bf16x8 aq[4], ak[4];
#pragma unroll
    for (int ks = 0; ks < 4; ks++) {
      aq[ks] = *(const bf16x8*)&s.qb[(wave * 16 + l15) * QLD + ks * 32 + g * 8];
      ak[ks] = *(const bf16x8*)&s.kn[(wave * 16 + l15) * QLD + ks * 32 + g * 8];
    }
#pragma unroll
    for (int ni = 0; ni < 4; ni++) {
      f32x4 ckk = {0.f, 0.f, 0.f, 0.f};
      cqk[ni] = (f32x4){0.f, 0.f, 0.f, 0.f};
      if (ni <= wave) {
#pragma unroll
        for (int ks = 0; ks < 4; ks++) {
          bf16x8 bk = *(const bf16x8*)&s.kn[(ni * 16 + l15) * QLD + ks * 32 + g * 8];
          ckk = mfma16(ak[ks], bk, ckk);
          cqk[ni] = mfma16(aq[ks], bk, cqk[ni]);
        }
      }
      const int j = ni * 16 + l15;
      const float gcj = s.gc[j];
#pragma unroll
      for (int r = 0; r < 4; r++) {
        const int i = wave * 16 + g * 4 + r;
        const float dec = (i >= j) ? __expf(s.gc[i] - gcj) : 0.f;
        s.Am[i * 64 + j] = (i > j) ? ckk[r] * s.beta[i] * dec : 0.f;
        cqk[ni][r] = (i >= j) ? cqk[ni][r] * dec : 0.f;
      }
    }
  }
  __syncthreads();
  GDN_REFRESH();
#pragma unroll
  for (int ni = 0; ni < 4; ni++)
#pragma unroll
    for (int r = 0; r < 4; r++) qk_s[(wave * 16 + g * 4 + r) * KLD + ni * 16 + l15] = f2bf(cqk[ni][r]);
  float xs[64];
#ifdef NO_SOLVE
  for (int i = 0; i < 64; i++) xs[i] = s.Am[i*64+tid%64];
#else
  {
    const int c = tid;
    const u16* src = (c < 128) ? &s.vb[c] : &s.kn[c - 128];
    const float* sc = (c < 128) ? s.beta : s.be;
#pragma unroll
    for (int i = 0; i < 64; i++) {
      float a0 = bf2f(src[i * QLD]) * sc[i], a1 = 0.f, a2 = 0.f, a3 = 0.f;
#pragma unroll
      for (int j4 = 0; j4 < (i + 3) / 4; j4++) {
        const float4 av = *(const float4*)&s.Am[i * 64 + j4 * 4];
        if (j4 * 4 + 0 < i) a0 -= av.x * xs[j4 * 4 + 0];
        if (j4 * 4 + 1 < i) a1 -= av.y * xs[j4 * 4 + 1];
        if (j4 * 4 + 2 < i) a2 -= av.z * xs[j4 * 4 + 2];
        if (j4 * 4 + 3 < i) a3 -= av.w * xs[j4 * 4 + 3];
      }
      xs[i] = (a0 + a1) + (a2 + a3);
      asm volatile("" : "+v"(xs[i]) :: "memory");
    }
  }
#endif
  const float glast = s.gc[63];
  __syncthreads();
  GDN_REFRESH();
  {
    const int d = tid & 127, half = tid >> 7;
#pragma unroll
    for (int q = 0; q < 4; q++) {
      unsigned ow[4];
#pragma unroll
      for (int e2 = 0; e2 < 4; e2++) {
        const int c0 = half * 32 + q * 8 + e2 * 2;
        const float v0 = bf2f(s.kn[c0 * QLD + d]) * __expf(glast - s.gc[c0]);
        const float v1 = bf2f(s.kn[(c0 + 1) * QLD + d]) * __expf(glast - s.gc[c0 + 1]);
        ow[e2] = pack2(v0, v1);
      }
      *(uint4*)&kdT[d * KLD + half * 32 + q * 8] = make_uint4(ow[0], ow[1], ow[2], ow[3]);
    }
    if (tid == 0) p.gdl[unit] = __expf(glast);
  }
  __syncthreads();
  GDN_REFRESH();
  if (tid >= 128) {
#pragma unroll
    for (int q = 0; q < 8; q++)
      *(uint4*)&WU[(tid - 128) * KLD + q * 8] = make_uint4(pack2(xs[q * 8], xs[q * 8 + 1]), pack2(xs[q * 8 + 2], xs[q * 8 + 3]),
                                                            pack2(xs[q * 8 + 4], xs[q * 8 + 5]), pack2(xs[q * 8 + 6], xs[q * 8 + 7]));
  }
  __syncthreads();
  GDN_REFRESH();
  {
    u16* const gM = p.gM + (size_t)unit * 16384;
    bf16x8 aw[2][2];
#pragma unroll
    for (int mm = 0; mm < 2; mm++)
#pragma unroll
      for (int ks = 0; ks < 2; ks++) aw[mm][ks] = *(const bf16x8*)&WU[((2 * wave + mm) * 16 + l15) * KLD + ks * 32 + g * 8];
#pragma unroll
    for (int nn = 0; nn < 8; nn++) {
      const bf16x8 b0 = *(const bf16x8*)&kdT[(nn * 16 + l15) * KLD + g * 8];
      const bf16x8 b1 = *(const bf16x8*)&kdT[(nn * 16 + l15) * KLD + 32 + g * 8];
#pragma unroll
      for (int mm = 0; mm < 2; mm++) {
        f32x4 acc = {0.f, 0.f, 0.f, 0.f};
        acc = mfma16(aw[mm][0], b0, acc);
        acc = mfma16(aw[mm][1], b1, acc);
        uint2 o; o.x = pack2(-acc[0], -acc[1]); o.y = pack2(-acc[2], -acc[3]);
        *(uint2*)&gM[(nn * 16 + l15) * 128 + (2 * wave + mm) * 16 + 4 * g] = o;
      }
    }
#pragma unroll
    for (int nn = 0; nn < 4; nn++) {
      const bf16x8 b0 = *(const bf16x8*)&qk_s[(nn * 16 + l15) * KLD + g * 8];
      const bf16x8 b1 = *(const bf16x8*)&qk_s[(nn * 16 + l15) * KLD + 32 + g * 8];
#pragma unroll
      for (int mm = 0; mm < 2; mm++) {
        f32x4 acc = {0.f, 0.f, 0.f, 0.f};
        acc = mfma16(aw[mm][0], b0, acc);
        acc = mfma16(aw[mm][1], b1, acc);
        u16* qp = &gQ[(nn * 16 + l15) * 128 + (2 * wave + mm) * 16 + 4 * g];
        float qv[4];
        unpack4(*(const uint2*)qp, qv);
        uint2 o; o.x = pack2(qv[0] - acc[0], qv[1] - acc[1]); o.y = pack2(qv[2] - acc[2], qv[3] - acc[3]);
        *(uint2*)qp = o;
      }
    }
  }
  __syncthreads();
  GDN_REFRESH();
  if (tid < 128) {
#pragma unroll
    for (int q = 0; q < 8; q++)
      *(uint4*)&WU[tid * KLD + q * 8] = make_uint4(pack2(xs[q * 8], xs[q * 8 + 1]), pack2(xs[q * 8 + 2], xs[q * 8 + 3]),
                                                    pack2(xs[q * 8 + 4], xs[q * 8 + 5]), pack2(xs[q * 8 + 6], xs[q * 8 + 7]));
  }
  __syncthreads();
  GDN_REFRESH();
  {
    u16* const gC = p.gC + (size_t)unit * 16384;
    u16* const gO = p.gO + (size_t)unit * 8192;
    bf16x8 akd[2][2], aqk[2];
#pragma unroll
    for (int mm = 0; mm < 2; mm++)
#pragma unroll
      for (int ks = 0; ks < 2; ks++) akd[mm][ks] = *(const bf16x8*)&kdT[((2 * wave + mm) * 16 + l15) * KLD + ks * 32 + g * 8];
#pragma unroll
    for (int ks = 0; ks < 2; ks++) aqk[ks] = *(const bf16x8*)&qk_s[(wave * 16 + l15) * KLD + ks * 32 + g * 8];
#pragma unroll
    for (int nn = 0; nn < 8; nn++) {
      const bf16x8 b0 = *(const bf16x8*)&WU[(nn * 16 + l15) * KLD + g * 8];
      const bf16x8 b1 = *(const bf16x8*)&WU[(nn * 16 + l15) * KLD + 32 + g * 8];
#pragma unroll
      for (int mm = 0; mm < 2; mm++) {
        f32x4 acc = {0.f, 0.f, 0.f, 0.f};
        acc = mfma16(akd[mm][0], b0, acc);
        acc = mfma16(akd[mm][1], b1, acc);
        uint2 o; o.x = pack2(acc[0], acc[1]); o.y = pack2(acc[2], acc[3]);
        *(uint2*)&gC[(nn * 16 + l15) * 128 + (2 * wave + mm) * 16 + 4 * g] = o;
      }
      {
        f32x4 acc = {0.f, 0.f, 0.f, 0.f};
        acc = mfma16(aqk[0], b0, acc);
        acc = mfma16(aqk[1], b1, acc);
        uint2 o; o.x = pack2(acc[0], acc[1]); o.y = pack2(acc[2], acc[3]);
        *(uint2*)&gO[(nn * 16 + l15) * 64 + wave * 16 + 4 * g] = o;
      }
    }
  }
}

__device__ void fox_cumsum_unit(const P& p, int bhf, float* red) {
  const int tid = threadIdx.x, lane = tid & 63, wave = tid >> 6;
  const int b = bhf >> 3, hf = bhf & 7;
  const float bias = p.fox_f_bias[hf];
  float v[8];
  float run = 0.f;
#pragma unroll
  for (int i = 0; i < 8; i++) {
    const int t = b * SEQ + tid * 8 + i;
    const float xx = p.gates[(size_t)t * 16 + 8 + hf] + bias;
    const float ls = fminf(xx, 0.f) - log1pf(__expf(-fabsf(xx)));
    run += ls;
    v[i] = run;
  }
  float tot = run;
#pragma unroll
  for (int off = 1; off < 64; off <<= 1) {
    float nb = __shfl_up(tot, off);
    if (lane >= off) tot += nb;
  }
  __syncthreads();
  if (lane == 63) red[wave] = tot;
  __syncthreads();
  float base = tot - run;
  for (int w = 0; w < wave; w++) base += red[w];
#pragma unroll
  for (int i = 0; i < 8; i++) p.cf[(size_t)bhf * SEQ + tid * 8 + i] = v[i] + base;
}

__device__ void phase_gdnprep(const P& p, unsigned char* smem) {
  GdnSmem& s = *(GdnSmem*)smem;
  for (int u = blockIdx.x; u < 1024 + 64; u += gridDim.x) {
    if (u < 1024) gdn_unit(p, u, s);
    else { __syncthreads(); fox_cumsum_unit(p, u - 1024, (float*)smem); }
  }
}

#define SLD 136
#define NSCAN 128
struct ScanSmem { u16 st[2][32 * SLD]; };
struct ScanSet { bf16x8 mf[2][4]; uint2 ci[2][2]; float dl; };

__device__ __forceinline__ void scan_load(const P& p, int unit, int eq, int w, int l15, int g, ScanSet& z) {
  int la = (32 * w + l15) * 128 + 8 * g, lc = (32 * eq + l15) * 128 + 32 * w + 4 * g;
  asm volatile("" : "+v"(la), "+v"(lc));
  const u16* gM = p.gM + (size_t)unit * 16384;
  const u16* gC = p.gC + (size_t)unit * 16384;
#pragma unroll
  for (int md = 0; md < 2; md++)
#pragma unroll
    for (int ks = 0; ks < 4; ks++) z.mf[md][ks] = *(const bf16x8*)&gM[la + md * 16 * 128 + ks * 32];
#pragma unroll
  for (int md = 0; md < 2; md++)
#pragma unroll
    for (int ne = 0; ne < 2; ne++) z.ci[md][ne] = *(const uint2*)&gC[lc + ne * 16 * 128 + md * 16];
  z.dl = p.gdl[unit];
}

__device__ __forceinline__ unsigned scan_touch(const P& p, int unit, int lane) {
  unsigned v = 0u;
  if (lane < 16) {
    const u16* base = (lane < 8) ? (p.gM + (size_t)unit * 16384) : (p.gC + (size_t)unit * 16384);
    v = *(const unsigned*)(base + (lane & 7) * 2048);
  }
  return v;
}

__device__ __forceinline__ void scan_step(const P& p, int unit, int n, int eq, int w, int l15, int g, ScanSmem& s,
                                          f32x4 (&st)[2][2], const ScanSet& z) {
  const u16* Sb = s.st[n & 1];
  u16* Sn = s.st[(n & 1) ^ 1];
#pragma unroll
  for (int md = 0; md < 2; md++)
#pragma unroll
    for (int ne = 0; ne < 2; ne++) {
      float c[4];
      unpack4(z.ci[md][ne], c);
      st[md][ne][0] = st[md][ne][0] * z.dl + c[0];
      st[md][ne][1] = st[md][ne][1] * z.dl + c[1];
      st[md][ne][2] = st[md][ne][2] * z.dl + c[2];
      st[md][ne][3] = st[md][ne][3] * z.dl + c[3];
    }
  if (n > 0) {
    int lb = l15 * SLD + 8 * g;
    asm volatile("" : "+v"(lb));
#pragma unroll
    for (int ne = 0; ne < 2; ne++) {
#pragma unroll
      for (int ks = 0; ks < 4; ks++) {
        const bf16x8 bs = *(const bf16x8*)&Sb[lb + 16 * ne * SLD + ks * 32];
        st[0][ne] = mfma16(z.mf[0][ks], bs, st[0][ne]);
        st[1][ne] = mfma16(z.mf[1][ks], bs, st[1][ne]);
      }
    }
  }
  if (n + 1 < 32) {
    u16* gS = p.gS + (size_t)(unit + 1) * 16384;
    int lsl = l15 * SLD + 32 * w + 4 * g, lsg = (32 * eq + l15) * 128 + 32 * w + 4 * g;
    asm volatile("" : "+v"(lsl), "+v"(lsg));
#pragma unroll
    for (int md = 0; md < 2; md++)
#pragma unroll
      for (int ne = 0; ne < 2; ne++) {
        uint2 o; o.x = pack2(st[md][ne][0], st[md][ne][1]); o.y = pack2(st[md][ne][2], st[md][ne][3]);
        *(uint2*)&Sn[lsl + 16 * ne * SLD + 16 * md] = o;
        *(uint2*)&gS[lsg + 16 * ne * 128 + 16 * md] = o;
      }
  }
  asm volatile("s_waitcnt lgkmcnt(0)" ::: "memory");
  __builtin_amdgcn_s_barrier();
  asm volatile("" ::: "memory");
}

__device__ void scan_unit(const P& p, int item, ScanSmem& s) {
  int tid = threadIdx.x;
  asm volatile("" : "+v"(tid));
  const int lane = tid & 63, w = tid >> 6;
  const int l15 = lane & 15, g = lane >> 4;
  const int bh = item >> 2, eq = item & 3;
  const int u0 = bh * 32;
  f32x4 st[2][2];
#pragma unroll
  for (int md = 0; md < 2; md++)
#pragma unroll
    for (int ne = 0; ne < 2; ne++) st[md][ne] = (f32x4){0.f, 0.f, 0.f, 0.f};
  ScanSet z0, z1, z2, z3;
  scan_load(p, u0 + 0, eq, w, l15, g, z0);
  scan_load(p, u0 + 1, eq, w, l15, g, z1);
  scan_load(p, u0 + 2, eq, w, l15, g, z2);
  unsigned tacc = 0u, tprev = 0u;
  __builtin_amdgcn_s_setprio(3);
#pragma unroll 1
  for (int n = 0; n < 32; n += 4) {
    tacc += tprev;
    tprev = 0u;
    if (n + 8 < 32) {
      tprev = scan_touch(p, u0 + n + 8, lane) + scan_touch(p, u0 + n + 9, lane) + scan_touch(p, u0 + n + 10, lane) +
              scan_touch(p, u0 + n + 11, lane);
    }
    scan_load(p, u0 + n + 3, eq, w, l15, g, z3);
    scan_step(p, u0 + n, n, eq, w, l15, g, s, st, z0);
    if (n + 4 < 32) scan_load(p, u0 + n + 4, eq, w, l15, g, z0);
    scan_step(p, u0 + n + 1, n + 1, eq, w, l15, g, s, st, z1);
    if (n + 4 < 32) scan_load(p, u0 + n + 5, eq, w, l15, g, z1);
    scan_step(p, u0 + n + 2, n + 2, eq, w, l15, g, s, st, z2);
    if (n + 4 < 32) scan_load(p, u0 + n + 6, eq, w, l15, g, z2);
    scan_step(p, u0 + n + 3, n + 3, eq, w, l15, g, s, st, z3);
  }
  __builtin_amdgcn_s_setprio(0);
  asm volatile("" :: "v"(tacc));
}

#define OLD 136
struct GoutSmem { float ssq[4][64]; u16 ob[64 * OLD]; };

__device__ void gout_unit(const P& p, int unit, GoutSmem& s) {
  const int tid = threadIdx.x, lane = tid & 63, w = tid >> 6;
  const int l15 = lane & 15, g = lane >> 4;
  const int bh = unit >> 5, n = unit & 31;
  const int b = bh >> 2, h = bh & 3;
  const u16* gQ = p.gQ + (size_t)unit * 8192;
  const u16* gO = p.gO + (size_t)unit * 8192;
  const u16* gS = p.gS + (size_t)unit * 16384;
  f32x4 o[4][2];
#pragma unroll
  for (int mc = 0; mc < 4; mc++)
#pragma unroll
    for (int ne = 0; ne < 2; ne++) {
      float c[4];
      unpack4(*(const uint2*)&gO[(32 * w + 16 * ne + l15) * 64 + 16 * mc + 4 * g], c);
      o[mc][ne] = (f32x4){c[0], c[1], c[2], c[3]};
    }
  if (n > 0) {
    bf16x8 bs[2][4];
#pragma unroll
    for (int ne = 0; ne < 2; ne++)
#pragma unroll
      for (int ks = 0; ks < 4; ks++) bs[ne][ks] = *(const bf16x8*)&gS[(32 * w + 16 * ne + l15) * 128 + ks * 32 + 8 * g];
#pragma unroll
    for (int mc = 0; mc < 4; mc++) {
#pragma unroll
      for (int ks = 0; ks < 4; ks++) {
        const bf16x8 aq = *(const bf16x8*)&gQ[(16 * mc + l15) * 128 + ks * 32 + 8 * g];
        o[mc][0] = mfma16(aq, bs[0][ks], o[mc][0]);
        o[mc][1] = mfma16(aq, bs[1][ks], o[mc][1]);
      }
    }
  }
  const float gnw0 = p.gdn_norm_w[32 * w + l15], gnw1 = p.gdn_norm_w[32 * w + 16 + l15];
  __syncthreads();
#pragma unroll
  for (int mc = 0; mc < 4; mc++)
#pragma unroll
    for (int r = 0; r < 4; r++) {
      float sq = o[mc][0][r] * o[mc][0][r] + o[mc][1][r] * o[mc][1][r];
#pragma unroll
      for (int off = 1; off < 16; off <<= 1) sq += __shfl_xor(sq, off);
      if (l15 == 0) s.ssq[w][16 * mc + 4 * g + r] = sq;
    }
  __syncthreads();
#pragma unroll
  for (int mc = 0; mc < 4; mc++)
#pragma unroll
    for (int r = 0; r < 4; r++) {
      const int c = 16 * mc + 4 * g + r;
      const float tot = s.ssq[0][c] + s.ssq[1][c] + s.ssq[2][c] + s.ssq[3][c];
      const float rs = rsqrtf(tot * (1.f / 128.f) + EPSV);
      s.ob[c * OLD + 32 * w + l15] = f2bf(o[mc][0][r] * rs * gnw0);
      s.ob[c * OLD + 32 * w + 16 + l15] = f2bf(o[mc][1][r] * rs * gnw1);
    }
  __syncthreads();
  {
    const int t0 = b * SEQ + n * 64;
    const int c0 = tid >> 4, ch = tid & 15;
    const u16* zp = p.proj + (size_t)(t0 + c0) * PROJW + 1536 + h * 128 + ch * 8;
    u16* op = p.actA + (size_t)(t0 + c0) * DM + h * 128 + ch * 8;
#pragma unroll
    for (int i = 0; i < 4; i++) {
      float ov[8], zv[8];
      unpack8(*(const uint4*)&s.ob[(c0 + 16 * i) * OLD + ch * 8], ov);
      unpack8(*(const uint4*)(zp + (size_t)i * 16 * PROJW), zv);
      uint4 r;
      r.x = pack2(ov[0] * siluf(zv[0]), ov[1] * siluf(zv[1])); r.y = pack2(ov[2] * siluf(zv[2]), ov[3] * siluf(zv[3]));
      r.z = pack2(ov[4] * siluf(zv[4]), ov[5] * siluf(zv[5])); r.w = pack2(ov[6] * siluf(zv[6]), ov[7] * siluf(zv[7]));
      *(uint4*)(op + (size_t)i * 16 * DM) = r;
    }
  }
}

__device__ void phase_gout(const P& p, unsigned char* smem) {
  GoutSmem& s = *(GoutSmem*)smem;
  for (int u = blockIdx.x; u < 1024; u += gridDim.x) gout_unit(p, u, s);
}

#define LOG2E 1.4426950408889634f
#define ANST 4
struct AttnSmem { u16 k[ANST][64 * 64 + 128]; u16 v[ANST][64 * 64]; };

__device__ void attn_unit(const P& p, int item, AttnSmem& s) {
  int tid = threadIdx.x;
  asm volatile("" : "+v"(tid));
  const int lane = tid & 63, w = tid >> 6;
  const int l15 = lane & 15, g = lane >> 4;
  const int qb = 15 - (item >> 6), bhf = item & 63;
  const int b = bhf >> 3, hf = bhf & 7;
  const int q0 = qb * 128 + 32 * w;
  const u16* qbase = p.proj + (size_t)(b * SEQ) * PROJW + 2048 + hf * 64;
  const u16* kbase = p.proj + (size_t)(b * SEQ) * PROJW + 2560 + hf * 64;
  const u16* vbase = p.vt + (size_t)bhf * 64 * SEQ;
  const float* cfb = p.cf + (size_t)bhf * SEQ;
  bf16x8 qf[2][2];
#pragma unroll
  for (int mi = 0; mi < 2; mi++)
#pragma unroll
    for (int ks = 0; ks < 2; ks++) qf[mi][ks] = *(const bf16x8*)&qbase[(size_t)(q0 + 16 * mi + l15) * PROJW + ks * 32 + g * 8];
  float cq[2], m[2], lsum[2];
  f32x4 O[2][4];
#pragma unroll
  for (int mi = 0; mi < 2; mi++) {
    cq[mi] = cfb[q0 + 16 * mi + l15]; m[mi] = -1e30f; lsum[mi] = 0.f;
#pragma unroll
    for (int nd = 0; nd < 4; nd++) O[mi][nd] = (f32x4){0.f, 0.f, 0.f, 0.f};
  }
  asm volatile("" :: "v"(cq[0]), "v"(cq[1]), "v"(qf[0][0]), "v"(qf[0][1]), "v"(qf[1][0]), "v"(qf[1][1]));
  const int ntile = (q0 + 32 + 63) >> 6;
  const int ntile_blk = 2 * qb + 2;
  const int drow = 8 * w + (lane >> 3);
  const int dchunk = (lane & 7) ^ ((4 * (w & 1) + (lane >> 4)) & 7);
  const u16* kg = kbase + (size_t)drow * PROJW + dchunk * 8;
  const u16* vg = vbase + (size_t)drow * SEQ + dchunk * 8;
  const float* cg_ = cfb + lane;
  u16* const skw = &s.k[0][0] + (8 * w) * 64;
  u16* const svw = &s.v[0][0] + (8 * w) * 64;
#define A_DMA(st, kk0) do { \
    u16* _dk = skw + (st) * (64 * 64 + 128); u16* _dv = svw + (st) * (64 * 64); \
    __builtin_amdgcn_global_load_lds((const unsigned*)(kg + (size_t)(kk0) * PROJW), (unsigned*)(_dk), 16, 0, 0); \
    __builtin_amdgcn_global_load_lds((const unsigned*)(kg + (size_t)((kk0) + 32) * PROJW), (unsigned*)(_dk + 32 * 64), 16, 0, 0); \
    __builtin_amdgcn_global_load_lds((const unsigned*)(vg + (kk0)), (unsigned*)(_dv), 16, 0, 0); \
    __builtin_amdgcn_global_load_lds((const unsigned*)(vg + (size_t)32 * SEQ + (kk0)), (unsigned*)(_dv + 32 * 64), 16, 0, 0); \
    __builtin_amdgcn_global_load_lds((const unsigned*)(cg_ + (kk0)), (unsigned*)(&s.k[0][0] + (st) * (64 * 64 + 128) + 64 * 64), 4, 0, 0); \
  } while (0)
  {
    const int npro = (ntile_blk > 2) ? 3 : 2;
#pragma unroll 1
    for (int j = 0; j < npro; j++) A_DMA(j, j * 64);
  }
  int ko[4][2];
#pragma unroll
  for (int t = 0; t < 4; t++) {
    const int row = 32 * (t >> 1) + 8 * (l15 >> 2) + 4 * (t & 1) + (l15 & 3);
    const int sw = (row >> 1) & 7;
    ko[t][0] = row * 64 + ((g ^ sw) * 8);
    ko[t][1] = row * 64 + (((4 + g) ^ sw) * 8);
  }
  const int swz = l15 >> 1;
  int vo[2];
  vo[0] = l15 * 64 + ((g ^ swz) * 8);
  vo[1] = l15 * 64 + (((4 + g) ^ swz) * 8);
#pragma unroll 1
  for (int kt = 0; kt < ntile_blk; kt++) {
    const int k0 = kt * 64, st = kt & 3;
    const int rem = ntile_blk - 1 - kt;
    if (rem >= 2) asm volatile("s_waitcnt vmcnt(10)" ::: "memory");
    else if (rem == 1) asm volatile("s_waitcnt vmcnt(5)" ::: "memory");
    else asm volatile("s_waitcnt vmcnt(0)" ::: "memory");
    asm volatile("s_waitcnt lgkmcnt(0)" ::: "memory");
    __builtin_amdgcn_s_barrier();
    asm volatile("" ::: "memory");
    if (kt + 3 < ntile_blk) { const int st3 = (kt + 3) & 3; A_DMA(st3, k0 + 192); }
    if (kt < ntile) {
      const u16* Ks = s.k[st];
      const u16* Vs = s.v[st];
      f32x4 ST[2][4];
#pragma unroll
      for (int t = 0; t < 4; t++) {
        const bf16x8 kf0 = *(const bf16x8*)&Ks[ko[t][0]];
        const bf16x8 kf1 = *(const bf16x8*)&Ks[ko[t][1]];
#pragma unroll
        for (int mi = 0; mi < 2; mi++) {
          f32x4 acc = {0.f, 0.f, 0.f, 0.f};
          acc = mfma16(kf0, qf[mi][0], acc);
          acc = mfma16(kf1, qf[mi][1], acc);
          ST[mi][t] = acc;
        }
      }
      f32x4 ck[4];
      {
        const unsigned cka = (unsigned)(size_t)(&Ks[64 * 64]) + 32u * g;
        asm volatile("ds_read_b128 %0, %4\n\tds_read_b128 %1, %4 offset:16\n\tds_read_b128 %2, %4 offset:128\n\t"
                     "ds_read_b128 %3, %4 offset:144\n\ts_waitcnt lgkmcnt(0)"
                     : "=&v"(ck[0]), "=&v"(ck[1]), "=&v"(ck[2]), "=&v"(ck[3]) : "v"(cka) : "memory");
      }
      const bool diag = (kt == ntile - 1);
      bf16x8 pf[2][2];
#pragma unroll
      for (int mi = 0; mi < 2; mi++) {
        const int qpos = q0 + 16 * mi + l15;
        float mx = -1e30f;
#pragma unroll
        for (int t = 0; t < 4; t++) {
          const float ckv[4] = {ck[t][0], ck[t][1], ck[t][2], ck[t][3]};
#pragma unroll
          for (int r = 0; r < 4; r++) {
            float lg = ST[mi][t][r] * (0.125f * LOG2E) + (cq[mi] - ckv[r]) * LOG2E;
            if (diag && (k0 + 32 * (t >> 1) + 8 * g + 4 * (t & 1) + r > qpos)) lg = -1e30f;
            ST[mi][t][r] = lg;
            mx = fmaxf(mx, lg);
          }
        }
        mx = fmaxf(mx, __shfl_xor(mx, 16));
        mx = fmaxf(mx, __shfl_xor(mx, 32));
        const float mn = fmaxf(m[mi], mx);
        const float alpha = __builtin_amdgcn_exp2f(m[mi] - mn);
        m[mi] = mn;
        float ps = 0.f;
#pragma unroll
        for (int t = 0; t < 4; t++)
#pragma unroll
          for (int r = 0; r < 4; r++) {
            const float pe = __builtin_amdgcn_exp2f(ST[mi][t][r] - mn);
            ST[mi][t][r] = pe;
            ps += pe;
          }
        lsum[mi] = lsum[mi] * alpha + ps;
#pragma unroll
        for (int kk = 0; kk < 2; kk++) {
          uint4 pk;
          pk.x = pack2(ST[mi][2 * kk][0], ST[mi][2 * kk][1]); pk.y = pack2(ST[mi][2 * kk][2], ST[mi][2 * kk][3]);
          pk.z = pack2(ST[mi][2 * kk + 1][0], ST[mi][2 * kk + 1][1]); pk.w = pack2(ST[mi][2 * kk + 1][2], ST[mi][2 * kk + 1][3]);
          pf[mi][kk] = __builtin_bit_cast(bf16x8, pk);
        }
#pragma unroll
        for (int r = 0; r < 4; r++) {
          const float ar = __shfl(alpha, 4 * g + r);
#pragma unroll
          for (int nd = 0; nd < 4; nd++) O[mi][nd][r] *= ar;
        }
      }
#pragma unroll
      for (int nd = 0; nd < 4; nd++)
#pragma unroll
        for (int kk = 0; kk < 2; kk++) {
          const bf16x8 vf = *(const bf16x8*)&Vs[16 * nd * 64 + vo[kk]];
          O[0][nd] = mfma16(pf[0][kk], vf, O[0][nd]);
          O[1][nd] = mfma16(pf[1][kk], vf, O[1][nd]);
        }
    }
  }
#pragma unroll
  for (int mi = 0; mi < 2; mi++) {
    float l = lsum[mi];
    l += __shfl_xor(l, 16);
    l += __shfl_xor(l, 32);
    const float inv = 1.f / l;
#pragma unroll
    for (int r = 0; r < 4; r++) {
      const float ir = __shfl(inv, 4 * g + r);
      const int t = b * SEQ + q0 + 16 * mi + 4 * g + r;
#pragma unroll
      for (int nd = 0; nd < 4; nd++) p.actA[(size_t)t * DM + 512 + hf * 64 + 16 * nd + l15] = f2bf(O[mi][nd][r] * ir);
    }
  }
}

__device__ void deferred_transpose(const P& p, int it, float* tile) {
  const int n1 = 16 * 16, n2 = n1 + 16 * 88, n3 = n2 + 44 * 16, n4 = n3 + 16 * 16;
  if (it < n1) { transpose_item(p.w_out, 1024, p.wt_out, 1024, it % 16, it / 16, 1, tile); }
  else if (it < n2) { int j = it - n1; transpose_item(p.w_gate_up, 2 * DFF, p.wt_gu, 1024, j % 16, j / 16, 2, tile, p.ffn_norm_w); }
  else if (it < n3) { int j = it - n2; transpose_item(p.w_down, 1024, p.wt_down, DFF, j % 44, j / 44, 1, tile); }
  else if (it < n4) { int j = it - n3; transpose_item(p.w_ple_gate, 1024, p.wt_pg, 1024, j % 16, j / 16, 1, tile, p.ple_norm_w); }
  else { int j = it - n4; transpose_item(p.w_ple_proj, 1024, p.wt_pp, 256, j % 4, j / 4, 1, tile); }
}
#define N_DEFER (16 * 16 + 16 * 88 + 44 * 16 + 16 * 16 + 4 * 16)

__device__ void phase_mixer(const P& p, unsigned char* smem, int rr) {
  volatile int* s_item_p = (volatile int*)(smem + SMEM_MAIN + 16);
  for (;;) {
    __syncthreads();
    if (threadIdx.x == 0) *s_item_p = (int)atomicAdd(&p.counters[rr], 1u);
    __syncthreads();
    const int item = *s_item_p;
    if (item >= NSCAN + 1024 + N_DEFER) break;
    if (item < NSCAN) { scan_unit(p, item, *(ScanSmem*)smem); }
    else if (item < NSCAN + 1024) { attn_unit(p, item - NSCAN, *(AttnSmem*)smem); }
    else { deferred_transpose(p, item - NSCAN - 1024, (float*)smem); }
  }
}

#define XB_TMO      128
#define XB_XCNT(j)  (256  + 64 * (j))
#define XB_XSUB(j)  (1280 + 64 * (j))
#define XB_XGEN(j)  (2304 + 64 * (j))
#define XB_TOP      3328
#define XB_TOPGEN   3392
#define XCD_BAR_WORDS 3456
#define XB_SPIN_CAP (1u << 20)
#define LAS __attribute__((address_space(3)))
__device__ __forceinline__ unsigned xb_ld(unsigned* p) { return __hip_atomic_load(p, __ATOMIC_RELAXED, __HIP_MEMORY_SCOPE_AGENT); }
__device__ __forceinline__ unsigned xb_add(unsigned* p, unsigned v) { return __hip_atomic_fetch_add(p, v, __ATOMIC_RELAXED, __HIP_MEMORY_SCOPE_AGENT); }
__device__ __forceinline__ unsigned xb_xcc_id() { return (unsigned)__builtin_amdgcn_s_getreg((3 << 11) | 20) & 0xFu; }
#define XB_SPIN(cond, bar) do { unsigned _sp = 0; while (cond) { __builtin_amdgcn_s_sleep(1); \
    if ((++_sp & 255u) == 0u) { if (xb_ld(&(bar)[XB_TMO])) break; if (_sp > XB_SPIN_CAP) { atomicAdd(&(bar)[XB_TMO], 1u); break; } } } } while (0)
struct XcdBarrier { unsigned* bar; unsigned x; volatile LAS unsigned* st; };
__device__ __forceinline__ XcdBarrier xcd_barrier_post(unsigned* bar, volatile LAS unsigned* st) {
  XcdBarrier b; b.bar = bar; b.x = xb_xcc_id(); b.st = st;
  if (threadIdx.x == 0) (void)xb_add(&bar[XB_XCNT(b.x)], 1u);
  return b;
}
__device__ __forceinline__ void xcd_barrier_complete(unsigned* bar, unsigned x, unsigned& nloc, unsigned& nx) {
  const unsigned G = gridDim.x * gridDim.y * gridDim.z;
  unsigned sum, cnt, mine, sp = 0u;
  for (;;) {
    sum = 0u; cnt = 0u; mine = 0u;
#pragma unroll
    for (unsigned j = 0; j < 16; ++j) { const unsigned c = xb_ld(&bar[XB_XCNT(j)]); sum += c; cnt += (c > 0u) ? 1u : 0u; mine = (j == x) ? c : mine; }
    if (sum == G) break;
    __builtin_amdgcn_s_sleep(1);
    if ((++sp & 255u) == 0u) { if (xb_ld(&bar[XB_TMO])) break; if (sp > XB_SPIN_CAP) { atomicAdd(&bar[XB_TMO], 1u); break; } }
  }
  nloc = mine > 0u ? mine : 1u; nx = cnt > 0u ? cnt : 1u;
}
__device__ __forceinline__ void xcd_barrier(const XcdBarrier& b) {
  asm volatile("s_waitcnt vmcnt(0)" ::: "memory");
  __syncthreads();
  if (threadIdx.x == 0) {
    unsigned* bar = b.bar;
    __builtin_amdgcn_s_waitcnt(0);
    unsigned nloc = b.st[0], nx = b.st[1];
    if (nloc == 0u) { xcd_barrier_complete(bar, b.x, nloc, nx); b.st[0] = nloc; b.st[1] = nx; }
    const unsigned old = xb_add(&bar[XB_XSUB(b.x)], 1u);
    const unsigned gen = old / nloc;
    if (old + 1u == (gen + 1u) * nloc) {
      __builtin_amdgcn_fence(__ATOMIC_RELEASE, "agent");
      asm volatile("s_waitcnt vmcnt(0)" ::: "memory");
      const unsigned og = xb_add(&bar[XB_TOP], 1u);
      const unsigned tg = og / nx;
      if (og + 1u == (tg + 1u) * nx) xb_add(&bar[XB_TOPGEN], 1u);
      else XB_SPIN(xb_ld(&bar[XB_TOPGEN]) == tg, bar);
      __builtin_amdgcn_fence(__ATOMIC_ACQUIRE, "agent");
      xb_add(&bar[XB_XGEN(b.x)], 1u);
      asm volatile("s_waitcnt vmcnt(0)" ::: "memory");
    } else {
      XB_SPIN(xb_ld(&bar[XB_XGEN(b.x)]) == gen, bar);
      __builtin_amdgcn_fence(__ATOMIC_ACQUIRE, "agent");
      asm volatile("s_waitcnt vmcnt(0)" ::: "memory");
    }
  }
  __syncthreads();
}

__global__ void __launch_bounds__(256, 2) mega(P p, int lo, int hi) {
  __shared__ __attribute__((aligned(16))) unsigned char smem[SMEM_MAIN + 32];
  cg::grid_group grid = cg::this_grid();
  uint4* xbw = (uint4*)(smem + SMEM_MAIN);
  if (threadIdx.x == 0) *xbw = make_uint4(0u, 0u, 0u, 0u);
  __syncthreads();
  XcdBarrier xb = xcd_barrier_post(p.bar, (volatile LAS unsigned*)xbw);
  if (hi < 0) grid.sync();
#define SEAM(k) if (lo <= k && k + 1 < hi) xcd_barrier(xb);
#if !defined(ONLY) || ONLY == 0
  if (lo <= 0 && 0 < hi) phase_prep(p, smem);
#endif
  SEAM(0)
#if !defined(ONLY) || ONLY == 1
  if (lo <= 1 && 1 < hi) phase_inproj(p, smem);
#endif
  SEAM(1)
#if !defined(ONLY) || ONLY == 2
  if (lo <= 2 && 2 < hi) phase_gdnprep(p, smem);
#endif
  SEAM(2)
#if !defined(ONLY) || ONLY == 3
  if (lo <= 3 && 3 < hi) phase_mixer(p, smem, 0);
#endif
  SEAM(3)
#if !defined(ONLY) || ONLY == 4
  if (lo <= 4 && 4 < hi) phase_gout(p, smem);
#endif
  SEAM(4)
#if !defined(ONLY) || ONLY == 5
  if (lo <= 5 && 5 < hi) phase_outproj(p, smem);
#endif
  SEAM(5)
#if !defined(ONLY) || ONLY == 6
  if (lo <= 6 && 6 < hi) phase_gateup(p, smem);
#endif
  SEAM(6)
#if !defined(ONLY) || ONLY == 7
  if (lo <= 7 && 7 < hi) phase_down(p, smem);
#endif
  SEAM(7)
#if !defined(ONLY) || ONLY == 8
  if (lo <= 8 && 8 < hi) phase_ple(p, smem);
#endif
  SEAM(8)
  if (lo <= 9 && 9 < hi) phase_final(p);
}

static_assert(sizeof(GemmSmem) <= SMEM_MAIN && sizeof(Gemm2Smem) <= SMEM_MAIN && sizeof(GdnSmem) <= SMEM_MAIN && sizeof(ScanSmem) <= SMEM_MAIN &&
              sizeof(GoutSmem) <= SMEM_MAIN && sizeof(AttnSmem) <= SMEM_MAIN && 64 * 65 * 4 <= SMEM_MAIN, "smem");

extern "C" void kernel_launch(void* const* d_in, const int* in_sizes, int n_in, void* d_out, int out_size,
                              void* d_ws, size_t ws_size, hipStream_t stream) {
  static int grid_blocks = 0;
  if (!grid_blocks) {
    int dev = 0, cus = 0, per_cu = 0;
    hipGetDevice(&dev);
    hipDeviceGetAttribute(&cus, hipDeviceAttributeMultiprocessorCount, dev);
    hipOccupancyMaxActiveBlocksPerMultiprocessor(&per_cu, mega, 256, 0);
    if (per_cu > 2) per_cu = 2;
    if (per_cu < 1) per_cu = 1;
    grid_blocks = cus * per_cu;
  }
  P p{};
  const float* const* in = (const float* const*)d_in;
  p.x = in[0]; p.p = in[1]; p.attn_norm_w = in[2]; p.w_in = in[3]; p.conv_w = in[4]; p.a_log = in[5];
  p.dt_bias = in[6]; p.gdn_norm_w = in[7]; p.fox_f_bias = in[8]; p.w_out = in[9]; p.ffn_norm_w = in[10];
  p.w_gate_up = in[11]; p.w_down = in[12]; p.ple_norm_w = in[13]; p.w_ple_gate = in[14]; p.w_ple_proj = in[15];
  p.final_norm_w = in[16];
  p.h = (float*)d_out;
  unsigned char* ws = (unsigned char*)d_ws;
  size_t off = 0;
  auto take = [&](size_t bytes) { unsigned char* r = ws + off; off += (bytes + 255) & ~(size_t)255; return r; };
  p.counters = (unsigned*)take(256);
  p.bar = (unsigned*)take(XCD_BAR_WORDS * 4);
  p.wt_in = (u16*)take((size_t)NIN_PAD * 1024 * 2);
  p.wt_out = (u16*)take((size_t)1024 * 1024 * 2);
  p.wt_gu = (u16*)take((size_t)2 * DFF * 1024 * 2);
  p.wt_down = (u16*)take((size_t)1024 * DFF * 2);
  p.wt_pg = (u16*)take((size_t)1024 * 1024 * 2);
  p.wt_pp = (u16*)take((size_t)1024 * 256 * 2);
  p.actA = (u16*)take((size_t)NTOK * 1024 * 2);
  p.pb = (u16*)take((size_t)NTOK * 256 * 2);
  p.proj = (u16*)take((size_t)NTOK * PROJW * 2);
  p.vt = (u16*)take((size_t)64 * 64 * SEQ * 2);
  p.gates = (float*)take((size_t)NTOK * 16 * 4);
  p.cf = (float*)take((size_t)64 * SEQ * 4);
  p.gM = (u16*)take((size_t)1024 * 16384 * 2);
  p.gC = (u16*)take((size_t)1024 * 16384 * 2);
  p.gdl = (float*)take(1024 * 4);
  p.rss = (float*)take((size_t)3 * NTOK * 4);
  p.hb = p.gM;
  if (off > ws_size) fprintf(stderr, "workspace too small: need %zu have %zu\n", off, ws_size);
  u16* ob = (u16*)d_out;
  p.gS = ob;
  p.gQ = ob + (size_t)1024 * 16384;
  p.gO = ob + (size_t)1024 * 16384 + (size_t)1024 * 8192;
  hipMemsetAsync(p.bar, 0, XCD_BAR_WORDS * 4, stream);
  int lo = 0, hi = NPHASE;
  void* args[] = {&p, &lo, &hi};
  hipError_t e = hipLaunchCooperativeKernel((void*)mega, dim3(grid_blocks), dim3(256), args, 0, stream);
  if (e != hipSuccess) fprintf(stderr, "cooperative launch failed: %s (grid %d)\n", hipGetErrorString(e), grid_blocks);
}
```

```cpp
#include <hip/hip_runtime.h>
#include <hip/hip_cooperative_groups.h>
#include <cstdio>
#include <cstdint>
namespace cg = cooperative_groups;

typedef unsigned short u16;
typedef __attribute__((ext_vector_type(8))) short bf16x8;
typedef __attribute__((ext_vector_type(4))) float f32x4;

#define NTOK 16384
#define SEQ 2048
#define DM 1024
#define DFF 2816
#define PROJW 3072
#define NIN_PAD 3712
#define EPSV 1e-6f
#define NPHASE 10
#define SMEM_MAIN 73728

struct P {
  const float *x, *p, *attn_norm_w, *w_in, *conv_w, *a_log, *dt_bias, *gdn_norm_w, *fox_f_bias, *w_out,
      *ffn_norm_w, *w_gate_up, *w_down, *ple_norm_w, *w_ple_gate, *w_ple_proj, *final_norm_w;
  float* h;
  u16 *wt_in, *wt_out, *wt_gu, *wt_down, *wt_pg, *wt_pp;
  u16 *actA;
  u16 *pb;
  u16 *proj;
  u16 *vt;
  float *gates;
  float *cf;
  u16 *gM, *gC;
  u16 *gQ, *gO;
  u16 *gS;
  float *gdl;
  unsigned *counters;
  unsigned *bar;
  u16 *hb;
  float *rss;
};

typedef __attribute__((ext_vector_type(2))) float f32x2_t;
typedef __attribute__((ext_vector_type(2))) __bf16 bf16x2_t;
__device__ __forceinline__ u16 f2bf(float f) { return __builtin_bit_cast(u16, (__bf16)f); }
__device__ __forceinline__ float bf2f(u16 h) { return __uint_as_float(((unsigned)h) << 16); }
__device__ __forceinline__ unsigned pack2(float a, float b) {
  f32x2_t f = {a, b};
  return __builtin_bit_cast(unsigned, __builtin_convertvector(f, bf16x2_t));
}
__device__ __forceinline__ float siluf(float v) { return v / (1.f + __expf(-v)); }
__device__ __forceinline__ float sigmoidf_(float v) { return 1.f / (1.f + __expf(-v)); }
__device__ __forceinline__ f32x4 mfma16(bf16x8 a, bf16x8 b, f32x4 c) {
  return __builtin_amdgcn_mfma_f32_16x16x32_bf16(a, b, c, 0, 0, 0);
}
#define LDS_FENCE() asm volatile("s_waitcnt lgkmcnt(0)" ::: "memory")

__device__ __forceinline__ void unpack8(const uint4& v, float (&f)[8]) {
  f[0] = bf2f((u16)(v.x & 0xffffu)); f[1] = bf2f((u16)(v.x >> 16));
  f[2] = bf2f((u16)(v.y & 0xffffu)); f[3] = bf2f((u16)(v.y >> 16));
  f[4] = bf2f((u16)(v.z & 0xffffu)); f[5] = bf2f((u16)(v.z >> 16));
  f[6] = bf2f((u16)(v.w & 0xffffu)); f[7] = bf2f((u16)(v.w >> 16));
}
__device__ __forceinline__ void unpack4(const uint2& v, float (&f)[4]) {
  f[0] = bf2f((u16)(v.x & 0xffffu)); f[1] = bf2f((u16)(v.x >> 16));
  f[2] = bf2f((u16)(v.y & 0xffffu)); f[3] = bf2f((u16)(v.y >> 16));
}


__device__ __forceinline__ int colmap(int kind, int nn) {
  if (kind == 0) {
    if (nn < 2048) return nn;
    if (nn < 3584) return nn + 8;
    if (nn < 3588) return 2048 + (nn - 3584);
    if (nn < 3592) return 2052 + (nn - 3588);
    if (nn < 3600) return nn;
    return -1;
  } else if (kind == 2) {
    int i = nn >> 7, wc = (nn >> 6) & 1, u = (nn >> 5) & 1, j = nn & 31;
    return u * DFF + 64 * i + 32 * wc + j;
  }
  return nn;
}

__device__ void transpose_item(const float* __restrict__ src, int ldsrc, u16* __restrict__ dst, int K,
                               int kt, int nt, int kind, float* tile, const float* __restrict__ kscale = nullptr) {
  int tid = threadIdx.x;
  asm volatile("" : "+v"(tid));
  const int c = tid & 63, r0 = tid >> 6;
  const int ncol = colmap(kind, nt * 64 + c);
  float tv[16];
#pragma unroll
  for (int i = 0; i < 16; i++) {
    int r = r0 + 4 * i;
    tv[i] = (ncol >= 0) ? __builtin_nontemporal_load(&src[(size_t)(kt * 64 + r) * ldsrc + ncol]) : 0.f;
  }
  if (kscale) {
#pragma unroll
    for (int i = 0; i < 16; i++) tv[i] *= kscale[kt * 64 + r0 + 4 * i];
  }
#pragma unroll
  for (int i = 0; i < 16; i++) tile[(r0 + 4 * i) * 65 + c] = tv[i];
  __syncthreads();
#pragma unroll 8
  for (int i = 0; i < 16; i++) {
    int rn = r0 + 4 * i;
    dst[(size_t)(nt * 64 + rn) * K + kt * 64 + c] = f2bf(tile[c * 65 + rn]);
  }
  __syncthreads();
}

__device__ __forceinline__ void rmsnorm_row(const float* src, const float* __restrict__ w,
                                            u16* dstb, float* dstf, int row) {
  const int lane = threadIdx.x & 63;
  float4 v[4];
  float ss = 0.f;
#pragma unroll
  for (int i = 0; i < 4; i++) {
    v[i] = *(const float4*)&src[(size_t)row * DM + i * 256 + lane * 4];
    ss += v[i].x * v[i].x + v[i].y * v[i].y + v[i].z * v[i].z + v[i].w * v[i].w;
  }
#pragma unroll
  for (int off = 32; off >= 1; off >>= 1) ss += __shfl_xor(ss, off);
  const float r = rsqrtf(ss * (1.f / DM) + EPSV);
#pragma unroll
  for (int i = 0; i < 4; i++) {
    const int col = i * 256 + lane * 4;
    float4 wv = *(const float4*)&w[col];
    float y0 = v[i].x * r * wv.x, y1 = v[i].y * r * wv.y, y2 = v[i].z * r * wv.z, y3 = v[i].w * r * wv.w;
    if (dstb) {
      uint2 o; o.x = pack2(y0, y1); o.y = pack2(y2, y3);
      *(uint2*)&dstb[(size_t)row * DM + col] = o;
    } else {
      *(float4*)&dstf[(size_t)row * DM + col] = make_float4(y0, y1, y2, y3);
    }
  }
}

__device__ void phase_prep(const P& p, unsigned char* smem) {
  float* tile = (float*)smem;
  if (blockIdx.x == 0 && threadIdx.x < 16) p.counters[threadIdx.x] = 0u;
  for (int i = blockIdx.x * 256 + threadIdx.x; i < 3 * NTOK; i += gridDim.x * 256) p.rss[i] = 0.f;
  for (int it = blockIdx.x; it < 16 * 58; it += gridDim.x) transpose_item(p.w_in, 3600, p.wt_in, 1024, it % 16, it / 16, 0, tile);
  const int wave = threadIdx.x >> 6, lane = threadIdx.x & 63;
  for (int rb = blockIdx.x; rb < NTOK / 8; rb += gridDim.x) {
    const int row = rb * 8 + wave * 2;
    float4 v0[4], v1[4];
#pragma unroll
    for (int i = 0; i < 4; i++) {
      { const f32x4 t0 = __builtin_nontemporal_load((const f32x4*)&p.x[(size_t)row * DM + i * 256 + lane * 4]);
        const f32x4 t1 = __builtin_nontemporal_load((const f32x4*)&p.x[(size_t)(row + 1) * DM + i * 256 + lane * 4]);
        v0[i] = make_float4(t0[0], t0[1], t0[2], t0[3]); v1[i] = make_float4(t1[0], t1[1], t1[2], t1[3]); }
    }
    const float4 pv0 = *(const float4*)&p.p[(size_t)row * 256 + lane * 4];
    const float4 pv1 = *(const float4*)&p.p[(size_t)(row + 1) * 256 + lane * 4];
    float s0 = 0.f, s1 = 0.f;
#pragma unroll
    for (int i = 0; i < 4; i++) {
      s0 += v0[i].x * v0[i].x + v0[i].y * v0[i].y + v0[i].z * v0[i].z + v0[i].w * v0[i].w;
      s1 += v1[i].x * v1[i].x + v1[i].y * v1[i].y + v1[i].z * v1[i].z + v1[i].w * v1[i].w;
    }
#pragma unroll
    for (int off = 32; off >= 1; off >>= 1) { s0 += __shfl_xor(s0, off); s1 += __shfl_xor(s1, off); }
    const float r0 = rsqrtf(s0 * (1.f / DM) + EPSV), r1 = rsqrtf(s1 * (1.f / DM) + EPSV);
#pragma unroll
    for (int i = 0; i < 4; i++) {
      const int col = i * 256 + lane * 4;
      const float4 wv = *(const float4*)&p.attn_norm_w[col];
      uint2 o;
      o.x = pack2(v0[i].x * r0 * wv.x, v0[i].y * r0 * wv.y); o.y = pack2(v0[i].z * r0 * wv.z, v0[i].w * r0 * wv.w);
      *(uint2*)&p.actA[(size_t)row * DM + col] = o;
      o.x = pack2(v1[i].x * r1 * wv.x, v1[i].y * r1 * wv.y); o.y = pack2(v1[i].z * r1 * wv.z, v1[i].w * r1 * wv.w);
      *(uint2*)&p.actA[(size_t)(row + 1) * DM + col] = o;
    }
    uint2 o; o.x = pack2(pv0.x, pv0.y); o.y = pack2(pv0.z, pv0.w);
    *(uint2*)&p.pb[(size_t)row * 256 + lane * 4] = o;
    o.x = pack2(pv1.x, pv1.y); o.y = pack2(pv1.z, pv1.w);
    *(uint2*)&p.pb[(size_t)(row + 1) * 256 + lane * 4] = o;
  }
}

__device__ void phase_rmsnorm(const float* src, const float* w, u16* dstb, float* dstf) {
  const int wave = threadIdx.x >> 6;
  for (int rb = blockIdx.x; rb < NTOK / 4; rb += gridDim.x) rmsnorm_row(src, w, dstb, dstf, rb * 4 + wave);
}

__device__ void phase_final(const P& p) {
  const int wave = threadIdx.x >> 6, lane = threadIdx.x & 63;
  for (int rb = blockIdx.x; rb < NTOK / 4; rb += gridDim.x) {
    const int row = rb * 4 + wave;
    const float r = rsqrtf(p.rss[2 * NTOK + row] * (1.f / DM) + EPSV);
#pragma unroll
    for (int i = 0; i < 4; i++) {
      const int col = i * 256 + lane * 4;
      float4 v = *(const float4*)&p.h[(size_t)row * DM + col];
      const float4 wv = *(const float4*)&p.final_norm_w[col];
      f32x4 o = {v.x * r * wv.x, v.y * r * wv.y, v.z * r * wv.z, v.w * r * wv.w};
      __builtin_nontemporal_store(o, (f32x4*)&p.h[(size_t)row * DM + col]);
    }
  }
}

#define GK 64
struct GemmSmem { u16 a[2][128 * GK]; u16 b[2][128 * GK]; };

template <bool SWAP>
__device__ __forceinline__ void gemm_tile(const u16* __restrict__ A, int lda, const u16* __restrict__ Bt, int ldb,
                                          int K, int m0, int n0, GemmSmem& s, f32x4 (&acc)[4][4]) {
  int tid = threadIdx.x;
  asm volatile("" : "+v"(tid));
  const int lane = tid & 63, wave = tid >> 6;
  const int wr = wave >> 1, wc = wave & 1;
  const int l15 = lane & 15, g = lane >> 4;
  const int nk = K / GK;
  const int drow = 8 * wave + (lane >> 3);
  const int dchunk = (lane & 7) ^ ((4 * (wave & 1) + (lane >> 4)) & 7);
  const u16* Ap = A + (size_t)(m0 + drow) * lda + dchunk * 8;
  const u16* Bp = Bt + (size_t)(n0 + drow) * ldb + dchunk * 8;
  const size_t sa = (size_t)32 * lda, sb = (size_t)32 * ldb;
#define G_DMA(bufi, koff) do { \
    _Pragma("unroll") for (int _i = 0; _i < 4; _i++) { \
      __builtin_amdgcn_global_load_lds((const unsigned*)(Ap + _i * sa + (koff)), (unsigned*)&s.a[bufi][(32 * _i + 8 * wave) * GK], 16, 0, 0); \
      __builtin_amdgcn_global_load_lds((const unsigned*)(Bp + _i * sb + (koff)), (unsigned*)&s.b[bufi][(32 * _i + 8 * wave) * GK], 16, 0, 0); \
    } } while (0)
  const int fo0 = l15 * GK + ((g ^ (l15 >> 1)) * 8);
  const int fo1 = l15 * GK + (((4 + g) ^ (l15 >> 1)) * 8);
  G_DMA(0, 0);
  asm volatile("s_waitcnt vmcnt(0)" ::: "memory");
  __builtin_amdgcn_s_barrier();
  asm volatile("" ::: "memory");
  for (int kt = 0; kt < nk; kt++) {
    const int buf = kt & 1;
    if (kt + 1 < nk) { if (buf) G_DMA(0, (kt + 1) * GK); else G_DMA(1, (kt + 1) * GK); }
    const u16* sa_ = &s.a[buf][(wr * 64) * GK];
    const u16* sb_ = &s.b[buf][(wc * 64) * GK];
#pragma unroll
    for (int ks = 0; ks < 2; ks++) {
      const int fo = ks ? fo1 : fo0;
      bf16x8 af[4], bfr[4];
#pragma unroll
      for (int mi = 0; mi < 4; mi++) af[mi] = *(const bf16x8*)&sa_[mi * 16 * GK + fo];
#pragma unroll
      for (int ni = 0; ni < 4; ni++) bfr[ni] = *(const bf16x8*)&sb_[ni * 16 * GK + fo];
#pragma unroll
      for (int mi = 0; mi < 4; mi++)
#pragma unroll
        for (int ni = 0; ni < 4; ni++) acc[mi][ni] = SWAP ? mfma16(bfr[ni], af[mi], acc[mi][ni]) : mfma16(af[mi], bfr[ni], acc[mi][ni]);
    }
    asm volatile("s_waitcnt vmcnt(0) lgkmcnt(0)" ::: "memory");
    __builtin_amdgcn_s_barrier();
    asm volatile("" ::: "memory");
  }
}


#define G2K 32
struct Gemm2Smem { u16 a[3][256 * G2K]; u16 b[3][128 * G2K]; };

template <bool SWAP>
__device__ __forceinline__ void gemm256(const u16* __restrict__ A, int lda, const u16* __restrict__ Bt, int ldb,
                                        int K, int m0, int n0, Gemm2Smem& s, f32x4 (&acc)[8][4]) {
  int tid = threadIdx.x;
  asm volatile("" : "+v"(tid));
  const int lane = tid & 63, wave = tid >> 6;
  const int wr = wave >> 1, wc = wave & 1;
  const int l15 = lane & 15, g = lane >> 4;
  const int nk = K / G2K;
  const int drow = 16 * wave + (lane >> 2);
  const int dchunk = (lane & 3) ^ g;
  const u16* Ap = A + (size_t)(m0 + drow) * lda + dchunk * 8;
  const u16* Bp = Bt + (size_t)(n0 + drow) * ldb + dchunk * 8;
  const size_t sa = (size_t)64 * lda, sb = (size_t)64 * ldb;
  u16* const sa0 = &s.a[0][0] + (16 * wave) * G2K;
  u16* const sb0 = &s.b[0][0] + (16 * wave) * G2K;
#define G2_DMA(st, koff) do { \
    u16* _da = sa0 + (st) * (256 * G2K); u16* _db = sb0 + (st) * (128 * G2K); \
    _Pragma("unroll") for (int _i = 0; _i < 4; _i++) \
      __builtin_amdgcn_global_load_lds((const unsigned*)(Ap + _i * sa + (koff)), (unsigned*)(_da + 64 * _i * G2K), 16, 0, 0); \
    _Pragma("unroll") for (int _i = 0; _i < 2; _i++) \
      __builtin_amdgcn_global_load_lds((const unsigned*)(Bp + _i * sb + (koff)), (unsigned*)(_db + 64 * _i * G2K), 16, 0, 0); \
  } while (0)
  const int fo = l15 * G2K + ((g ^ ((l15 >> 2) & 3)) * 8);
  asm volatile("s_waitcnt lgkmcnt(0)" ::: "memory");
  __builtin_amdgcn_s_barrier();
  asm volatile("" ::: "memory");
#pragma unroll 1
  for (int j = 0; j < 2; j++) G2_DMA(j, j * G2K);
  int st = 0;
  for (int kt = 0; kt < nk; kt++) {
    if (kt + 1 < nk) asm volatile("s_waitcnt vmcnt(6)" ::: "memory");
    else asm volatile("s_waitcnt vmcnt(0)" ::: "memory");
    __builtin_amdgcn_s_barrier();
    asm volatile("" ::: "memory");
    if (kt + 2 < nk) {
      const int st2 = (st >= 1) ? st - 1 : 2;
      G2_DMA(st2, (kt + 2) * G2K);
    }
    const u16* sa_ = &s.a[0][0] + st * (256 * G2K) + (wr * 128) * G2K + fo;
    const u16* sb_ = &s.b[0][0] + st * (128 * G2K) + (wc * 64) * G2K + fo;
    bf16x8 af[8], bfr[4];
#pragma unroll
    for (int mi = 0; mi < 8; mi++) af[mi] = *(const bf16x8*)&sa_[mi * 16 * G2K];
#pragma unroll
    for (int ni = 0; ni < 4; ni++) bfr[ni] = *(const bf16x8*)&sb_[ni * 16 * G2K];
#pragma unroll
    for (int mi = 0; mi < 8; mi++)
#pragma unroll
      for (int ni = 0; ni < 4; ni++) acc[mi][ni] = SWAP ? mfma16(bfr[ni], af[mi], acc[mi][ni]) : mfma16(af[mi], bfr[ni], acc[mi][ni]);
    st = (st == 2) ? 0 : st + 1;
  }
}
#define ZERO_ACC8(acc) _Pragma("unroll") for (int _i = 0; _i < 8; _i++) _Pragma("unroll") for (int _j = 0; _j < 4; _j++) acc[_i][_j] = (f32x4){0.f, 0.f, 0.f, 0.f};

#define ZERO_ACC(acc) _Pragma("unroll") for (int _i = 0; _i < 4; _i++) _Pragma("unroll") for (int _j = 0; _j < 4; _j++) acc[_i][_j] = (f32x4){0.f, 0.f, 0.f, 0.f};

template <int NMI>
__device__ __forceinline__ void row_sumsq_add(f32x4 (&sq)[NMI][4], float* rss, int row0, int l15, int g) {
#pragma unroll
  for (int mi = 0; mi < NMI; mi++) {
    float v = 0.f;
#pragma unroll
    for (int ni = 0; ni < 4; ni++) v += (sq[mi][ni][0] + sq[mi][ni][1]) + (sq[mi][ni][2] + sq[mi][ni][3]);
    v += __shfl_xor(v, 16);
    v += __shfl_xor(v, 32);
    if (g == 0) atomicAdd(&rss[row0 + mi * 16 + l15], v);
  }
}

__device__ void phase_inproj(const P& p, unsigned char* smem) {
  Gemm2Smem& s = *(Gemm2Smem*)smem;
  const int lane = threadIdx.x & 63, wave = threadIdx.x >> 6, wr = wave >> 1, wc = wave & 1, l15 = lane & 15, g = lane >> 4;
  const int ntiles = 64 * 29;
  for (int tl = blockIdx.x; tl < ntiles; tl += gridDim.x) {
    const int mt = tl & 63, nt = tl >> 6;
    const int m0 = mt * 256, n0 = nt * 128;
    f32x4 acc[8][4];
    ZERO_ACC8(acc);
    if (nt >= 24 && nt < 28) {
      gemm256<false>(p.actA, DM, p.wt_in, DM, DM, m0, n0, s, acc);
#pragma unroll
      for (int mi = 0; mi < 8; mi++)
#pragma unroll
        for (int ni = 0; ni < 4; ni++) {
          const int rowb = m0 + wr * 128 + mi * 16 + g * 4;
          const int col = n0 + wc * 64 + ni * 16 + l15;
          const int cc = col - 3072, hh = cc >> 6, d = cc & 63;
          const int b = rowb >> 11, sq = rowb & 2047;
          uint2 o; o.x = pack2(acc[mi][ni][0], acc[mi][ni][1]); o.y = pack2(acc[mi][ni][2], acc[mi][ni][3]);
          *(uint2*)&p.vt[((size_t)((b * 8 + hh) * 64 + d)) * SEQ + sq] = o;
        }
    } else {
      gemm256<true>(p.actA, DM, p.wt_in, DM, DM, m0, n0, s, acc);
#pragma unroll
      for (int mi = 0; mi < 8; mi++)
#pragma unroll
        for (int ni = 0; ni < 4; ni++) {
          const int row = m0 + wr * 128 + mi * 16 + l15;
          const int col = n0 + wc * 64 + ni * 16 + g * 4;
          if (nt < 24) {
            uint2 o; o.x = pack2(acc[mi][ni][0], acc[mi][ni][1]); o.y = pack2(acc[mi][ni][2], acc[mi][ni][3]);
            *(uint2*)&p.proj[(size_t)row * PROJW + col] = o;
          } else if (col < 3600) {
            *(float4*)&p.gates[(size_t)row * 16 + (col - 3584)] = make_float4(acc[mi][ni][0], acc[mi][ni][1], acc[mi][ni][2], acc[mi][ni][3]);
          }
        }
    }
  }
}

__device__ void phase_outproj(const P& p, unsigned char* smem) {
  Gemm2Smem& s = *(Gemm2Smem*)smem;
  const int lane = threadIdx.x & 63, wave = threadIdx.x >> 6, wr = wave >> 1, wc = wave & 1, l15 = lane & 15, g = lane >> 4;
  for (int tl = blockIdx.x; tl < 64 * 8; tl += gridDim.x) {
    const int mt = tl & 63, nt = tl >> 6;
    const int m0 = mt * 256, n0 = nt * 128;
    f32x4 acc[8][4];
    ZERO_ACC8(acc);
    gemm256<true>(p.actA, DM, p.wt_out, DM, DM, m0, n0, s, acc);
#pragma unroll
    for (int mi = 0; mi < 8; mi++)
#pragma unroll
      for (int ni = 0; ni < 4; ni++) {
        const size_t idx = (size_t)(m0 + wr * 128 + mi * 16 + l15) * DM + n0 + wc * 64 + ni * 16 + g * 4;
        const f32x4 xv4 = __builtin_nontemporal_load((const f32x4*)&p.x[idx]);
        const float4 xv = make_float4(xv4[0], xv4[1], xv4[2], xv4[3]);
        const float h0 = xv.x + acc[mi][ni][0], h1 = xv.y + acc[mi][ni][1], h2 = xv.z + acc[mi][ni][2], h3 = xv.w + acc[mi][ni][3];
        uint2 o; o.x = pack2(h0, h1); o.y = pack2(h2, h3);
        *(uint2*)&p.hb[idx] = o;
        acc[mi][ni] = (f32x4){h0 * h0, h1 * h1, h2 * h2, h3 * h3};
      }
    row_sumsq_add(acc, p.rss, m0 + wr * 128, l15, g);
  }
}

__device__ void phase_gateup(const P& p, unsigned char* smem) {
  Gemm2Smem& s = *(Gemm2Smem*)smem;
  u16* act = p.proj;
  const int lane = threadIdx.x & 63, wave = threadIdx.x >> 6, wr = wave >> 1, wc = wave & 1, l15 = lane & 15, g = lane >> 4;
  for (int tl = blockIdx.x; tl < 64 * 44; tl += gridDim.x) {
    const int mt = tl & 63, nt = tl >> 6;
    const int m0 = mt * 256, n0 = nt * 128;
    f32x4 acc[8][4];
    ZERO_ACC8(acc);
    gemm256<true>(p.hb, DM, p.wt_gu, DM, DM, m0, n0, s, acc);
#pragma unroll
    for (int mi = 0; mi < 8; mi++) {
      const int row = m0 + wr * 128 + mi * 16 + l15;
      const float rs = rsqrtf(p.rss[row] * (1.f / DM) + EPSV);
#pragma unroll
      for (int ni = 0; ni < 2; ni++) {
        const int col = 64 * nt + 32 * wc + 16 * ni + g * 4;
        float v[4];
#pragma unroll
        for (int r = 0; r < 4; r++) v[r] = siluf(acc[mi][ni][r] * rs) * (acc[mi][ni + 2][r] * rs);
        uint2 o; o.x = pack2(v[0], v[1]); o.y = pack2(v[2], v[3]);
        *(uint2*)&act[(size_t)row * DFF + col] = o;
      }
    }
  }
}

__device__ void phase_down(const P& p, unsigned char* smem) {
  Gemm2Smem& s = *(Gemm2Smem*)smem;
  const u16* act = p.proj;
  const int lane = threadIdx.x & 63, wave = threadIdx.x >> 6, wr = wave >> 1, wc = wave & 1, l15 = lane & 15, g = lane >> 4;
  for (int tl = blockIdx.x; tl < 64 * 8; tl += gridDim.x) {
    const int mt = tl & 63, nt = tl >> 6;
    const int m0 = mt * 256, n0 = nt * 128;
    f32x4 acc[8][4];
    ZERO_ACC8(acc);
    gemm256<true>(act, DFF, p.wt_down, DFF, DFF, m0, n0, s, acc);
#pragma unroll
    for (int mi = 0; mi < 8; mi++)
#pragma unroll
      for (int ni = 0; ni < 4; ni++) {
        const size_t idx = (size_t)(m0 + wr * 128 + mi * 16 + l15) * DM + n0 + wc * 64 + ni * 16 + g * 4;
        float hp[4];
        unpack4(*(const uint2*)&p.hb[idx], hp);
        const float h0 = hp[0] + acc[mi][ni][0], h1 = hp[1] + acc[mi][ni][1], h2 = hp[2] + acc[mi][ni][2], h3 = hp[3] + acc[mi][ni][3];
        uint2 o; o.x = pack2(h0, h1); o.y = pack2(h2, h3);
        *(uint2*)&p.actA[idx] = o;
        acc[mi][ni] = (f32x4){h0 * h0, h1 * h1, h2 * h2, h3 * h3};
      }
    row_sumsq_add(acc, p.rss + NTOK, m0 + wr * 128, l15, g);
  }
}

__device__ void phase_ple(const P& p, unsigned char* smem) {
  GemmSmem& s = *(GemmSmem*)smem;
  const int lane = threadIdx.x & 63, wave = threadIdx.x >> 6, wr = wave >> 1, wc = wave & 1, l15 = lane & 15, g = lane >> 4;
  for (int tl = blockIdx.x; tl < 128 * 8; tl += gridDim.x) {
    const int mt = tl & 127, nt = tl >> 7;
    const int m0 = mt * 128, n0 = nt * 128;
    f32x4 acc[4][4], acc2[4][4];
    ZERO_ACC(acc);
    gemm_tile<true>(p.actA, DM, p.wt_pg, DM, DM, m0, n0, s, acc);
#pragma unroll
    for (int mi = 0; mi < 4; mi++) {
      const float rs = rsqrtf(p.rss[NTOK + m0 + wr * 64 + mi * 16 + l15] * (1.f / DM) + EPSV);
#pragma unroll
      for (int ni = 0; ni < 4; ni++)
#pragma unroll
        for (int r = 0; r < 4; r++) acc[mi][ni][r] = sigmoidf_(acc[mi][ni][r] * rs);
    }
    ZERO_ACC(acc2);
    gemm_tile<true>(p.pb, 256, p.wt_pp, 256, 256, m0, n0, s, acc2);
#pragma unroll
    for (int mi = 0; mi < 4; mi++)
#pragma unroll
      for (int ni = 0; ni < 4; ni++) {
        const size_t idx = (size_t)(m0 + wr * 64 + mi * 16 + l15) * DM + n0 + wc * 64 + ni * 16 + g * 4;
        float hp[4];
        unpack4(*(const uint2*)&p.actA[idx], hp);
        const float h0 = hp[0] + acc[mi][ni][0] * acc2[mi][ni][0], h1 = hp[1] + acc[mi][ni][1] * acc2[mi][ni][1];
        const float h2 = hp[2] + acc[mi][ni][2] * acc2[mi][ni][2], h3 = hp[3] + acc[mi][ni][3] * acc2[mi][ni][3];
        *(float4*)&p.h[idx] = make_float4(h0, h1, h2, h3);
        acc2[mi][ni] = (f32x4){h0 * h0, h1 * h1, h2 * h2, h3 * h3};
      }
    row_sumsq_add(acc2, p.rss + 2 * NTOK, m0 + wr * 64, l15, g);
  }
}

#define QLD 136
#define KLD 72
struct GdnSmem {
  u16 qb[64 * QLD];
  u16 kn[64 * QLD];
  u16 vb[64 * QLD];
  float Am[64 * 64];
  float gc[64], beta[64], be[64];
};
static_assert(offsetof(GdnSmem, kn) == 17408 && offsetof(GdnSmem, vb) == 34816 && offsetof(GdnSmem, Am) == 52224, "layout");


__device__ void gdn_unit(const P& p, int unit, GdnSmem& s) {
  int tid = threadIdx.x;
  asm volatile("" : "+v"(tid));
  int lane = tid & 63, wave = tid >> 6;
  int l15 = lane & 15, g = lane >> 4;
#define GDN_REFRESH() do { tid = threadIdx.x; asm volatile("" : "+v"(tid) :: "memory"); lane = tid & 63; wave = tid >> 6; l15 = lane & 15; g = lane >> 4; } while (0)
  const int bh = unit >> 5, n = unit & 31;
  const int b = bh >> 2, h = bh & 3;
  const int tb = b * SEQ;
  const int s0 = n * 64;
  u16* const qk_s = s.qb;
  u16* const WU = s.kn;
  u16* const kdT = (u16*)((unsigned char*)s.kn + 32768);
  __syncthreads();
  if (wave == 0) {
    const int t = tb + s0 + lane;
    const float ga = p.gates[(size_t)t * 16 + h], gb = p.gates[(size_t)t * 16 + 4 + h];
    const float xx = ga + p.dt_bias[h];
    const float sp = (xx > 20.f) ? xx : log1pf(__expf(xx));
    float gg = -__expf(p.a_log[h]) * sp;
#pragma unroll
    for (int off = 1; off < 64; off <<= 1) {
      float nb = __shfl_up(gg, off);
      if (lane >= off) gg += nb;
    }
    const float bt = sigmoidf_(gb);
    s.gc[lane] = gg;
    s.beta[lane] = bt;
    s.be[lane] = bt * __expf(gg);
  }
  {
    const int ch = tid & 15, rg = tid >> 4;
#pragma unroll 1
    for (int mat = 0; mat < 3; mat++) {
      const int col0 = mat * 512 + h * 128 + ch * 8;
      float cw[4][8];
#pragma unroll
      for (int k = 0; k < 4; k++) {
        const float4 w0 = *(const float4*)&p.conv_w[k * 1536 + col0];
        const float4 w1 = *(const float4*)&p.conv_w[k * 1536 + col0 + 4];
        cw[k][0] = w0.x; cw[k][1] = w0.y; cw[k][2] = w0.z; cw[k][3] = w0.w;
        cw[k][4] = w1.x; cw[k][5] = w1.y; cw[k][6] = w1.z; cw[k][7] = w1.w;
      }
      uint4 xr[7];
#pragma unroll
      for (int j = 0; j < 7; j++) {
        const int sp = s0 + 4 * rg + j - 3;
        if (sp >= 0) {
          typedef __attribute__((ext_vector_type(4))) unsigned u32x4_t;
          const u32x4_t t = __builtin_nontemporal_load((const u32x4_t*)&p.proj[(size_t)(tb + sp) * PROJW + col0]);
          xr[j] = make_uint4(t[0], t[1], t[2], t[3]);
        } else xr[j] = make_uint4(0u, 0u, 0u, 0u);
      }
      float xf[7][8];
#pragma unroll
      for (int j = 0; j < 7; j++) unpack8(xr[j], xf[j]);
      u16* dst = (mat == 0) ? s.qb : ((mat == 1) ? s.kn : s.vb);
#pragma unroll
      for (int r = 0; r < 4; r++) {
        float val[8];
        float ss = 0.f;
#pragma unroll
        for (int c = 0; c < 8; c++) {
          const float cv = cw[0][c] * xf[r][c] + cw[1][c] * xf[r + 1][c] + cw[2][c] * xf[r + 2][c] + cw[3][c] * xf[r + 3][c];
          val[c] = siluf(cv);
          ss += val[c] * val[c];
        }
        float rs = 1.f;
        if (mat < 2) {
#pragma unroll
          for (int off = 1; off < 16; off <<= 1) ss += __shfl_xor(ss, off);
          rs = rsqrtf(ss + EPSV) * ((mat == 0) ? 0.08838834764831845f : 1.f);
        }
        uint4 o;
        o.x = pack2(val[0] * rs, val[1] * rs); o.y = pack2(val[2] * rs, val[3] * rs);
        o.z = pack2(val[4] * rs, val[5] * rs); o.w = pack2(val[6] * rs, val[7] * rs);
        *(uint4*)&dst[(4 * rg + r) * QLD + ch * 8] = o;
      }
    }
  }
  __syncthreads();
  GDN_REFRESH();
  u16* const gQ = p.gQ + (size_t)unit * 8192;
  {
#pragma unroll
    for (int it = 0; it < 4; it++) {
      const int idx = tid + 256 * it;
      const int i = idx >> 4, d8 = (idx & 15) * 8;
      const float e = __expf(s.gc[i]);
      float f[8];
      unpack8(*(const uint4*)&s.qb[i * QLD + d8], f);
      uint4 o;
      o.x = pack2(f[0] * e, f[1] * e); o.y = pack2(f[2] * e, f[3] * e);
      o.z = pack2(f[4] * e, f[5] * e); o.w = pack2(f[6] * e, f[7] * e);
      *(uint4*)&gQ[i * 128 + d8] = o;
    }
  }
  f32x4 cqk[4];
  {
    bf16x8 aq[4], ak[4];
#pragma unroll
    for (int ks = 0; ks < 4; ks++) {
      aq[ks] = *(const bf16x8*)&s.qb[(wave * 16 + l15) * QLD + ks * 32 + g * 8];
      ak[ks] = *(const bf16x8*)&s.kn[(wave * 16 + l15) * QLD + ks * 32 + g * 8];
    }
#pragma unroll
    for (int ni = 0; ni < 4; ni++) {
      f32x4 ckk = {0.f, 0.f, 0.f, 0.f};
      cqk[ni] = (f32x4){0.f, 0.f, 0.f, 0.f};
      if (ni <= wave) {
#pragma unroll
        for (int ks = 0; ks < 4; ks++) {
          bf16x8 bk = *(const bf16x8*)&s.kn[(ni * 16 + l15) * QLD + ks * 32 + g * 8];
          ckk = mfma16(ak[ks], bk, ckk);
          cqk[ni] = mfma16(aq[ks], bk, cqk[ni]);
        }
      }
      const int j = ni * 16 + l15;
      const float gcj = s.gc[j];
#pragma unroll
      for (int r = 0; r < 4; r++) {
        const int i = wave * 16 + g * 4 + r;
        const float dec = (i >= j) ? __expf(s.gc[i] - gcj) : 0.f;
        s.Am[i * 64 + j] = (i > j) ? ckk[r] * s.beta[i] * dec : 0.f;
        cqk[ni][r] = (i >= j) ? cqk[ni][r] * dec : 0.f;
      }
    }
  }
  __syncthreads();
  GDN_REFRESH();
#pragma unroll
  for (int ni = 0; ni < 4; ni++)
#pragma unroll
    for (int r = 0; r < 4; r++) qk_s[(wave * 16 + g * 4 + r) * KLD + ni * 16 + l15] = f2bf(cqk[ni][r]);
  float xs[64];
#ifdef NO_SOLVE
  for (int i = 0; i < 64; i++) xs[i] = s.Am[i*64+tid%64];
#else
  {
    const int c = tid;
    const u16* src = (c < 128) ? &s.vb[c] : &s.kn[c - 128];
    const float* sc = (c < 128) ? s.beta : s.be;
#pragma unroll
    for (int i = 0; i < 64; i++) {
      float a0 = bf2f(src[i * QLD]) * sc[i], a1 = 0.f, a2 = 0.f, a3 = 0.f;
#pragma unroll
      for (int j4 = 0; j4 < (i + 3) / 4; j4++) {
        const float4 av = *(const float4*)&s.Am[i * 64 + j4 * 4];
        if (j4 * 4 + 0 < i) a0 -= av.x * xs[j4 * 4 + 0];
        if (j4 * 4 + 1 < i) a1 -= av.y * xs[j4 * 4 + 1];
        if (j4 * 4 + 2 < i) a2 -= av.z * xs[j4 * 4 + 2];
        if (j4 * 4 + 3 < i) a3 -= av.w * xs[j4 * 4 + 3];
      }
      xs[i] = (a0 + a1) + (a2 + a3);
      asm volatile("" : "+v"(xs[i]) :: "memory");
    }
  }
#endif
  const float glast = s.gc[63];
  __syncthreads();
  GDN_REFRESH();
  {
    const int d = tid & 127, half = tid >> 7;
#pragma unroll
    for (int q = 0; q < 4; q++) {
      unsigned ow[4];
#pragma unroll
      for (int e2 = 0; e2 < 4; e2++) {
        const int c0 = half * 32 + q * 8 + e2 * 2;
        const float v0 = bf2f(s.kn[c0 * QLD + d]) * __expf(glast - s.gc[c0]);
        const float v1 = bf2f(s.kn[(c0 + 1) * QLD + d]) * __expf(glast - s.gc[c0 + 1]);
        ow[e2] = pack2(v0, v1);
      }
      *(uint4*)&kdT[d * KLD + half * 32 + q * 8] = make_uint4(ow[0], ow[1], ow[2], ow[3]);
    }
    if (tid == 0) p.gdl[unit] = __expf(glast);
  }
  __syncthreads();
  GDN_REFRESH();
  if (tid >= 128) {
#pragma unroll
    for (int q = 0; q < 8; q++)
      *(uint4*)&WU[(tid - 128) * KLD + q * 8] = make_uint4(pack2(xs[q * 8], xs[q * 8 + 1]), pack2(xs[q * 8 + 2], xs[q * 8 + 3]),
                                                            pack2(xs[q * 8 + 4], xs[q * 8 + 5]), pack2(xs[q * 8 + 6], xs[q * 8 + 7]));
  }
  __syncthreads();
  GDN_REFRESH();
  {
    u16* const gM = p.gM + (size_t)unit * 16384;
    bf16x8 aw[2][2];
#pragma unroll
    for (int mm = 0; mm < 2; mm++)
#pragma unroll
      for (int ks = 0; ks < 2; ks++) aw[mm][ks] = *(const bf16x8*)&WU[((2 * wave + mm) * 16 + l15) * KLD + ks * 32 + g * 8];
#pragma unroll
    for (int nn = 0; nn < 8; nn++) {
      const bf16x8 b0 = *(const bf16x8*)&kdT[(nn * 16 + l15) * KLD + g * 8];
      const bf16x8 b1 = *(const bf16x8*)&kdT[(nn * 16 + l15) * KLD + 32 + g * 8];
#pragma unroll
      for (int mm = 0; mm < 2; mm++) {
        f32x4 acc = {0.f, 0.f, 0.f, 0.f};
        acc = mfma16(aw[mm][0], b0, acc);
        acc = mfma16(aw[mm][1], b1, acc);
        uint2 o; o.x = pack2(-acc[0], -acc[1]); o.y = pack2(-acc[2], -acc[3]);
        *(uint2*)&gM[(nn * 16 + l15) * 128 + (2 * wave + mm) * 16 + 4 * g] = o;
      }
    }
#pragma unroll
    for (int nn = 0; nn < 4; nn++) {
      const bf16x8 b0 = *(const bf16x8*)&qk_s[(nn * 16 + l15) * KLD + g * 8];
      const bf16x8 b1 = *(const bf16x8*)&qk_s[(nn * 16 + l15) * KLD + 32 + g * 8];
#pragma unroll
      for (int mm = 0; mm < 2; mm++) {
        f32x4 acc = {0.f, 0.f, 0.f, 0.f};
        acc = mfma16(aw[mm][0], b0, acc);
        acc = mfma16(aw[mm][1], b1, acc);
        u16* qp = &gQ[(nn * 16 + l15) * 128 + (2 * wave + mm) * 16 + 4 * g];
        float qv[4];
        unpack4(*(const uint2*)qp, qv);
        uint2 o; o.x = pack2(qv[0] - acc[0], qv[1] - acc[1]); o.y = pack2(qv[2] - acc[2], qv[3] - acc[3]);
        *(uint2*)qp = o;
      }
    }
  }
  __syncthreads();
  GDN_REFRESH();
  if (tid < 128) {
#pragma unroll
    for (int q = 0; q < 8; q++)
      *(uint4*)&WU[tid * KLD + q * 8] = make_uint4(pack2(xs[q * 8], xs[q * 8 + 1]), pack2(xs[q * 8 + 2], xs[q * 8 + 3]),
                                                    pack2(xs[q * 8 + 4], xs[q * 8 + 5]), pack2(xs[q * 8 + 6], xs[q * 8 + 7]));
  }
  __syncthreads();
  GDN_REFRESH();
  {
    u16* const gC = p.gC + (size_t)unit * 16384;
    u16* const gO = p.gO + (size_t)unit * 8192;
    bf16x8 akd[2][2], aqk[2];
#pragma unroll
    for (int mm = 0; mm < 2; mm++)
#pragma unroll
      for (int ks = 0; ks < 2; ks++) akd[mm][ks] = *(const bf16x8*)&kdT[((2 * wave + mm) * 16 + l15) * KLD + ks * 32 + g * 8];
#pragma unroll
    for (int ks = 0; ks < 2; ks++) aqk[ks] = *(const bf16x8*)&qk_s[(wave * 16 + l15) * KLD + ks * 32 + g * 8];
#pragma unroll
    for (int nn = 0; nn < 8; nn++) {
      const bf16x8 b0 = *(const bf16x8*)&WU[(nn * 16 + l15) * KLD + g * 8];
      const bf16x8 b1 = *(const bf16x8*)&WU[(nn * 16 + l15) * KLD + 32 + g * 8];
#pragma unroll
      for (int mm = 0; mm < 2; mm++) {
        f32x4 acc = {0.f, 0.f, 0.f, 0.f};
        acc = mfma16(akd[mm][0], b0, acc);
        acc = mfma16(akd[mm][1], b1, acc);
        uint2 o; o.x = pack2(acc[0], acc[1]); o.y = pack2(acc[2], acc[3]);
        *(uint2*)&gC[(nn * 16 + l15) * 128 + (2 * wave + mm) * 16 + 4 * g] = o;
      }
      {
        f32x4 acc = {0.f, 0.f, 0.f, 0.f};
        acc = mfma16(aqk[0], b0, acc);
        acc = mfma16(aqk[1], b1, acc);
        uint2 o; o.x = pack2(acc[0], acc[1]); o.y = pack2(acc[2], acc[3]);
        *(uint2*)&gO[(nn * 16 + l15) * 64 + wave * 16 + 4 * g] = o;
      }
    }
  }
}

__device__ void fox_cumsum_unit(const P& p, int bhf, float* red) {
  const int tid = threadIdx.x, lane = tid & 63, wave = tid >> 6;
  const int b = bhf >> 3, hf = bhf & 7;
  const float bias = p.fox_f_bias[hf];
  float v[8];
  float run = 0.f;
#pragma unroll
  for (int i = 0; i < 8; i++) {
    const int t = b * SEQ + tid * 8 + i;
    const float xx = p.gates[(size_t)t * 16 + 8 + hf] + bias;
    const float ls = fminf(xx, 0.f) - log1pf(__expf(-fabsf(xx)));
    run += ls;
    v[i] = run;
  }
  float tot = run;
#pragma unroll
  for (int off = 1; off < 64; off <<= 1) {
    float nb = __shfl_up(tot, off);
    if (lane >= off) tot += nb;
  }
  __syncthreads();
  if (lane == 63) red[wave] = tot;
  __syncthreads();
  float base = tot - run;
  for (int w = 0; w < wave; w++) base += red[w];
#pragma unroll
  for (int i = 0; i < 8; i++) p.cf[(size_t)bhf * SEQ + tid * 8 + i] = v[i] + base;
}

__device__ void phase_gdnprep(const P& p, unsigned char* smem) {
  GdnSmem& s = *(GdnSmem*)smem;
  for (int u = blockIdx.x; u < 1024 + 64; u += gridDim.x) {
    if (u < 1024) gdn_unit(p, u, s);
    else { __syncthreads(); fox_cumsum_unit(p, u - 1024, (float*)smem); }
  }
}

#define SLD 136
#define NSCAN 128
struct ScanSmem { u16 st[2][32 * SLD]; };
struct ScanSet { bf16x8 mf[2][4]; uint2 ci[2][2]; float dl; };

__device__ __forceinline__ void scan_load(const P& p, int unit, int eq, int w, int l15, int g, ScanSet& z) {
  int la = (32 * w + l15) * 128 + 8 * g, lc = (32 * eq + l15) * 128 + 32 * w + 4 * g;
  asm volatile("" : "+v"(la), "+v"(lc));
  const u16* gM = p.gM + (size_t)unit * 16384;
  const u16* gC = p.gC + (size_t)unit * 16384;
#pragma unroll
  for (int md = 0; md < 2; md++)
#pragma unroll
    for (int ks = 0; ks < 4; ks++) z.mf[md][ks] = *(const bf16x8*)&gM[la + md * 16 * 128 + ks * 32];
#pragma unroll
  for (int md = 0; md < 2; md++)
#pragma unroll
    for (int ne = 0; ne < 2; ne++) z.ci[md][ne] = *(const uint2*)&gC[lc + ne * 16 * 128 + md * 16];
  z.dl = p.gdl[unit];
}

__device__ __forceinline__ unsigned scan_touch(const P& p, int unit, int lane) {
  unsigned v = 0u;
  if (lane < 16) {
    const u16* base = (lane < 8) ? (p.gM + (size_t)unit * 16384) : (p.gC + (size_t)unit * 16384);
    v = *(const unsigned*)(base + (lane & 7) * 2048);
  }
  return v;
}

__device__ __forceinline__ void scan_step(const P& p, int unit, int n, int eq, int w, int l15, int g, ScanSmem& s,
                                          f32x4 (&st)[2][2], const ScanSet& z) {
  const u16* Sb = s.st[n & 1];
  u16* Sn = s.st[(n & 1) ^ 1];
#pragma unroll
  for (int md = 0; md < 2; md++)
#pragma unroll
    for (int ne = 0; ne < 2; ne++) {
      float c[4];
      unpack4(z.ci[md][ne], c);
      st[md][ne][0] = st[md][ne][0] * z.dl + c[0];
      st[md][ne][1] = st[md][ne][1] * z.dl + c[1];
      st[md][ne][2] = st[md][ne][2] * z.dl + c[2];
      st[md][ne][3] = st[md][ne][3] * z.dl + c[3];
    }
  if (n > 0) {
    int lb = l15 * SLD + 8 * g;
    asm volatile("" : "+v"(lb));
#pragma unroll
    for (int ne = 0; ne < 2; ne++) {
#pragma unroll
      for (int ks = 0; ks < 4; ks++) {
        const bf16x8 bs = *(const bf16x8*)&Sb[lb + 16 * ne * SLD + ks * 32];
        st[0][ne] = mfma16(z.mf[0][ks], bs, st[0][ne]);
        st[1][ne] = mfma16(z.mf[1][ks], bs, st[1][ne]);
      }
    }
  }
  if (n + 1 < 32) {
    u16* gS = p.gS + (size_t)(unit + 1) * 16384;
    int lsl = l15 * SLD + 32 * w + 4 * g, lsg = (32 * eq + l15) * 128 + 32 * w + 4 * g;
    asm volatile("" : "+v"(lsl), "+v"(lsg));
#pragma unroll
    for (int md = 0; md < 2; md++)
#pragma unroll
      for (int ne = 0; ne < 2; ne++) {
        uint2 o; o.x = pack2(st[md][ne][0], st[md][ne][1]); o.y = pack2(st[md][ne][2], st[md][ne][3]);
        *(uint2*)&Sn[lsl + 16 * ne * SLD + 16 * md] = o;
        *(uint2*)&gS[lsg + 16 * ne * 128 + 16 * md] = o;
      }
  }
  asm volatile("s_waitcnt lgkmcnt(0)" ::: "memory");
  __builtin_amdgcn_s_barrier();
  asm volatile("" ::: "memory");
}

__device__ void scan_unit(const P& p, int item, ScanSmem& s) {
  int tid = threadIdx.x;
  asm volatile("" : "+v"(tid));
  const int lane = tid & 63, w = tid >> 6;
  const int l15 = lane & 15, g = lane >> 4;
  const int bh = item >> 2, eq = item & 3;
  const int u0 = bh * 32;
  f32x4 st[2][2];
#pragma unroll
  for (int md = 0; md < 2; md++)
#pragma unroll
    for (int ne = 0; ne < 2; ne++) st[md][ne] = (f32x4){0.f, 0.f, 0.f, 0.f};
  ScanSet z0, z1, z2, z3;
  scan_load(p, u0 + 0, eq, w, l15, g, z0);
  scan_load(p, u0 + 1, eq, w, l15, g, z1);
  scan_load(p, u0 + 2, eq, w, l15, g, z2);
  unsigned tacc = 0u, tprev = 0u;
  __builtin_amdgcn_s_setprio(3);
#pragma unroll 1
  for (int n = 0; n < 32; n += 4) {
    tacc += tprev;
    tprev = 0u;
    if (n + 8 < 32) {
      tprev = scan_touch(p, u0 + n + 8, lane) + scan_touch(p, u0 + n + 9, lane) + scan_touch(p, u0 + n + 10, lane) +
              scan_touch(p, u0 + n + 11, lane);
    }
    scan_load(p, u0 + n + 3, eq, w, l15, g, z3);
    scan_step(p, u0 + n, n, eq, w, l15, g, s, st, z0);
    if (n + 4 < 32) scan_load(p, u0 + n + 4, eq, w, l15, g, z0);
    scan_step(p, u0 + n + 1, n + 1, eq, w, l15, g, s, st, z1);
    if (n + 4 < 32) scan_load(p, u0 + n + 5, eq, w, l15, g, z1);
    scan_step(p, u0 + n + 2, n + 2, eq, w, l15, g, s, st, z2);
    if (n + 4 < 32) scan_load(p, u0 + n + 6, eq, w, l15, g, z2);
    scan_step(p, u0 + n + 3, n + 3, eq, w, l15, g, s, st, z3);
  }
  __builtin_amdgcn_s_setprio(0);
  asm volatile("" :: "v"(tacc));
}

#define OLD 136
struct GoutSmem { float ssq[4][64]; u16 ob[64 * OLD]; };

__device__ void gout_unit(const P& p, int unit, GoutSmem& s) {
  const int tid = threadIdx.x, lane = tid & 63, w = tid >> 6;
  const int l15 = lane & 15, g = lane >> 4;
  const int bh = unit >> 5, n = unit & 31;
  const int b = bh >> 2, h = bh & 3;
  const u16* gQ = p.gQ + (size_t)unit * 8192;
  const u16* gO = p.gO + (size_t)unit * 8192;
  const u16* gS = p.gS + (size_t)unit * 16384;
  f32x4 o[4][2];
#pragma unroll
  for (int mc = 0; mc < 4; mc++)
#pragma unroll
    for (int ne = 0; ne < 2; ne++) {
      float c[4];
      unpack4(*(const uint2*)&gO[(32 * w + 16 * ne + l15) * 64 + 16 * mc + 4 * g], c);
      o[mc][ne] = (f32x4){c[0], c[1], c[2], c[3]};
    }
  if (n > 0) {
    bf16x8 bs[2][4];
#pragma unroll
    for (int ne = 0; ne < 2; ne++)
#pragma unroll
      for (int ks = 0; ks < 4; ks++) bs[ne][ks] = *(const bf16x8*)&gS[(32 * w + 16 * ne + l15) * 128 + ks * 32 + 8 * g];
#pragma unroll
    for (int mc = 0; mc < 4; mc++) {
#pragma unroll
      for (int ks = 0; ks < 4; ks++) {
        const bf16x8 aq = *(const bf16x8*)&gQ[(16 * mc + l15) * 128 + ks * 32 + 8 * g];
        o[mc][0] = mfma16(aq, bs[0][ks], o[mc][0]);
        o[mc][1] = mfma16(aq, bs[1][ks], o[mc][1]);
      }
    }
  }
  const float gnw0 = p.gdn_norm_w[32 * w + l15], gnw1 = p.gdn_norm_w[32 * w + 16 + l15];
  __syncthreads();
#pragma unroll
  for (int mc = 0; mc < 4; mc++)
#pragma unroll
    for (int r = 0; r < 4; r++) {
      float sq = o[mc][0][r] * o[mc][0][r] + o[mc][1][r] * o[mc][1][r];
#pragma unroll
      for (int off = 1; off < 16; off <<= 1) sq += __shfl_xor(sq, off);
      if (l15 == 0) s.ssq[w][16 * mc + 4 * g + r] = sq;
    }
  __syncthreads();
#pragma unroll
  for (int mc = 0; mc < 4; mc++)
#pragma unroll
    for (int r = 0; r < 4; r++) {
      const int c = 16 * mc + 4 * g + r;
      const float tot = s.ssq[0][c] + s.ssq[1][c] + s.ssq[2][c] + s.ssq[3][c];
      const float rs = rsqrtf(tot * (1.f / 128.f) + EPSV);
      s.ob[c * OLD + 32 * w + l15] = f2bf(o[mc][0][r] * rs * gnw0);
      s.ob[c * OLD + 32 * w + 16 + l15] = f2bf(o[mc][1][r] * rs * gnw1);
    }
  __syncthreads();
  {
    const int t0 = b * SEQ + n * 64;
    const int c0 = tid >> 4, ch = tid & 15;
    const u16* zp = p.proj + (size_t)(t0 + c0) * PROJW + 1536 + h * 128 + ch * 8;
    u16* op = p.actA + (size_t)(t0 + c0) * DM + h * 128 + ch * 8;
#pragma unroll
    for (int i = 0; i < 4; i++) {
      float ov[8], zv[8];
      unpack8(*(const uint4*)&s.ob[(c0 + 16 * i) * OLD + ch * 8], ov);
      unpack8(*(const uint4*)(zp + (size_t)i * 16 * PROJW), zv);
      uint4 r;
      r.x = pack2(ov[0] * siluf(zv[0]), ov[1] * siluf(zv[1])); r.y = pack2(ov[2] * siluf(zv[2]), ov[3] * siluf(zv[3]));
      r.z = pack2(ov[4] * siluf(zv[4]), ov[5] * siluf(zv[5])); r.w = pack2(ov[6] * siluf(zv[6]), ov[7] * siluf(zv[7]));
      *(uint4*)(op + (size_t)i * 16 * DM) = r;
    }
  }
}

__device__ void phase_gout(const P& p, unsigned char* smem) {
  GoutSmem& s = *(GoutSmem*)smem;
  for (int u = blockIdx.x; u < 1024; u += gridDim.x) gout_unit(p, u, s);
}

#define LOG2E 1.4426950408889634f
#define ANST 4
struct AttnSmem { u16 k[ANST][64 * 64 + 128]; u16 v[ANST][64 * 64]; };

__device__ void attn_unit(const P& p, int item, AttnSmem& s) {
  int tid = threadIdx.x;
  asm volatile("" : "+v"(tid));
  const int lane = tid & 63, w = tid >> 6;
  const int l15 = lane & 15, g = lane >> 4;
  const int qb = 15 - (item >> 6), bhf = item & 63;
  const int b = bhf >> 3, hf = bhf & 7;
  const int q0 = qb * 128 + 32 * w;
  const u16* qbase = p.proj + (size_t)(b * SEQ) * PROJW + 2048 + hf * 64;
  const u16* kbase = p.proj + (size_t)(b * SEQ) * PROJW + 2560 + hf * 64;
  const u16* vbase = p.vt + (size_t)bhf * 64 * SEQ;
  const float* cfb = p.cf + (size_t)bhf * SEQ;
  bf16x8 qf[2][2];
#pragma unroll
  for (int mi = 0; mi < 2; mi++)
#pragma unroll
    for (int ks = 0; ks < 2; ks++) qf[mi][ks] = *(const bf16x8*)&qbase[(size_t)(q0 + 16 * mi + l15) * PROJW + ks * 32 + g * 8];
  float cq[2], m[2], lsum[2];
  f32x4 O[2][4];
#pragma unroll
  for (int mi = 0; mi < 2; mi++) {
    cq[mi] = cfb[q0 + 16 * mi + l15]; m[mi] = -1e30f; lsum[mi] = 0.f;
#pragma unroll
    for (int nd = 0; nd < 4; nd++) O[mi][nd] = (f32x4){0.f, 0.f, 0.f, 0.f};
  }
  asm volatile("" :: "v"(cq[0]), "v"(cq[1]), "v"(qf[0][0]), "v"(qf[0][1]), "v"(qf[1][0]), "v"(qf[1][1]));
  const int ntile = (q0 + 32 + 63) >> 6;
  const int ntile_blk = 2 * qb + 2;
  const int drow = 8 * w + (lane >> 3);
  const int dchunk = (lane & 7) ^ ((4 * (w & 1) + (lane >> 4)) & 7);
  const u16* kg = kbase + (size_t)drow * PROJW + dchunk * 8;
  const u16* vg = vbase + (size_t)drow * SEQ + dchunk * 8;
  const float* cg_ = cfb + lane;
  u16* const skw = &s.k[0][0] + (8 * w) * 64;
  u16* const svw = &s.v[0][0] + (8 * w) * 64;
#define A_DMA(st, kk0) do { \
    u16* _dk = skw + (st) * (64 * 64 + 128); u16* _dv = svw + (st) * (64 * 64); \
    __builtin_amdgcn_global_load_lds((const unsigned*)(kg + (size_t)(kk0) * PROJW), (unsigned*)(_dk), 16, 0, 0); \
    __builtin_amdgcn_global_load_lds((const unsigned*)(kg + (size_t)((kk0) + 32) * PROJW), (unsigned*)(_dk + 32 * 64), 16, 0, 0); \
    __builtin_amdgcn_global_load_lds((const unsigned*)(vg + (kk0)), (unsigned*)(_dv), 16, 0, 0); \
    __builtin_amdgcn_global_load_lds((const unsigned*)(vg + (size_t)32 * SEQ + (kk0)), (unsigned*)(_dv + 32 * 64), 16, 0, 0); \
    __builtin_amdgcn_global_load_lds((const unsigned*)(cg_ + (kk0)), (unsigned*)(&s.k[0][0] + (st) * (64 * 64 + 128) + 64 * 64), 4, 0, 0); \
  } while (0)
  {
    const int npro = (ntile_blk > 2) ? 3 : 2;
#pragma unroll 1
    for (int j = 0; j < npro; j++) A_DMA(j, j * 64);
  }
  int ko[4][2];
#pragma unroll
  for (int t = 0; t < 4; t++) {
    const int row = 32 * (t >> 1) + 8 * (l15 >> 2) + 4 * (t & 1) + (l15 & 3);
    const int sw = (row >> 1) & 7;
    ko[t][0] = row * 64 + ((g ^ sw) * 8);
    ko[t][1] = row * 64 + (((4 + g) ^ sw) * 8);
  }
  const int swz = l15 >> 1;
  int vo[2];
  vo[0] = l15 * 64 + ((g ^ swz) * 8);
  vo[1] = l15 * 64 + (((4 + g) ^ swz) * 8);
#pragma unroll 1
  for (int kt = 0; kt < ntile_blk; kt++) {
    const int k0 = kt * 64, st = kt & 3;
    const int rem = ntile_blk - 1 - kt;
    if (rem >= 2) asm volatile("s_waitcnt vmcnt(10)" ::: "memory");
    else if (rem == 1) asm volatile("s_waitcnt vmcnt(5)" ::: "memory");
    else asm volatile("s_waitcnt vmcnt(0)" ::: "memory");
    asm volatile("s_waitcnt lgkmcnt(0)" ::: "memory");
    __builtin_amdgcn_s_barrier();
    asm volatile("" ::: "memory");
    if (kt + 3 < ntile_blk) { const int st3 = (kt + 3) & 3; A_DMA(st3, k0 + 192); }
    if (kt < ntile) {
      const u16* Ks = s.k[st];
      const u16* Vs = s.v[st];
      f32x4 ST[2][4];
#pragma unroll
      for (int t = 0; t < 4; t++) {
        const bf16x8 kf0 = *(const bf16x8*)&Ks[ko[t][0]];
        const bf16x8 kf1 = *(const bf16x8*)&Ks[ko[t][1]];
#pragma unroll
        for (int mi = 0; mi < 2; mi++) {
          f32x4 acc = {0.f, 0.f, 0.f, 0.f};
          acc = mfma16(kf0, qf[mi][0], acc);
          acc = mfma16(kf1, qf[mi][1], acc);
          ST[mi][t] = acc;
        }
      }
      f32x4 ck[4];
      {
        const unsigned cka = (unsigned)(size_t)(&Ks[64 * 64]) + 32u * g;
        asm volatile("ds_read_b128 %0, %4\n\tds_read_b128 %1, %4 offset:16\n\tds_read_b128 %2, %4 offset:128\n\t"
                     "ds_read_b128 %3, %4 offset:144\n\ts_waitcnt lgkmcnt(0)"
                     : "=&v"(ck[0]), "=&v"(ck[1]), "=&v"(ck[2]), "=&v"(ck[3]) : "v"(cka) : "memory");
      }
      const bool diag = (kt == ntile - 1);
      bf16x8 pf[2][2];
#pragma unroll
      for (int mi = 0; mi < 2; mi++) {
        const int qpos = q0 + 16 * mi + l15;
        float mx = -1e30f;
#pragma unroll
        for (int t = 0; t < 4; t++) {
          const float ckv[4] = {ck[t][0], ck[t][1], ck[t][2], ck[t][3]};
#pragma unroll
          for (int r = 0; r < 4; r++) {
            float lg = ST[mi][t][r] * (0.125f * LOG2E) + (cq[mi] - ckv[r]) * LOG2E;
            if (diag && (k0 + 32 * (t >> 1) + 8 * g + 4 * (t & 1) + r > qpos)) lg = -1e30f;
            ST[mi][t][r] = lg;
            mx = fmaxf(mx, lg);
          }
        }
        mx = fmaxf(mx, __shfl_xor(mx, 16));
        mx = fmaxf(mx, __shfl_xor(mx, 32));
        const float mn = fmaxf(m[mi], mx);
        const float alpha = __builtin_amdgcn_exp2f(m[mi] - mn);
        m[mi] = mn;
        float ps = 0.f;
#pragma unroll
        for (int t = 0; t < 4; t++)
#pragma unroll
          for (int r = 0; r < 4; r++) {
            const float pe = __builtin_amdgcn_exp2f(ST[mi][t][r] - mn);
            ST[mi][t][r] = pe;
            ps += pe;
          }
        lsum[mi] = lsum[mi] * alpha + ps;
#pragma unroll
        for (int kk = 0; kk < 2; kk++) {
          uint4 pk;
          pk.x = pack2(ST[mi][2 * kk][0], ST[mi][2 * kk][1]); pk.y = pack2(ST[mi][2 * kk][2], ST[mi][2 * kk][3]);
          pk.z = pack2(ST[mi][2 * kk + 1][0], ST[mi][2 * kk + 1][1]); pk.w = pack2(ST[mi][2 * kk + 1][2], ST[mi][2 * kk + 1][3]);
          pf[mi][kk] = __builtin_bit_cast(bf16x8, pk);
        }
#pragma unroll
        for (int r = 0; r < 4; r++) {
          const float ar = __shfl(alpha, 4 * g + r);
#pragma unroll
          for (int nd = 0; nd < 4; nd++) O[mi][nd][r] *= ar;
        }
      }
#pragma unroll
      for (int nd = 0; nd < 4; nd++)
#pragma unroll
        for (int kk = 0; kk < 2; kk++) {
          const bf16x8 vf = *(const bf16x8*)&Vs[16 * nd * 64 + vo[kk]];
          O[0][nd] = mfma16(pf[0][kk], vf, O[0][nd]);
          O[1][nd] = mfma16(pf[1][kk], vf, O[1][nd]);
        }
    }
  }
#pragma unroll
  for (int mi = 0; mi < 2; mi++) {
    float l = lsum[mi];
    l += __shfl_xor(l, 16);
    l += __shfl_xor(l, 32);
    const float inv = 1.f / l;
#pragma unroll
    for (int r = 0; r < 4; r++) {
      const float ir = __shfl(inv, 4 * g + r);
      const int t = b * SEQ + q0 + 16 * mi + 4 * g + r;
#pragma unroll
      for (int nd = 0; nd < 4; nd++) p.actA[(size_t)t * DM + 512 + hf * 64 + 16 * nd + l15] = f2bf(O[mi][nd][r] * ir);
    }
  }
}

__device__ void deferred_transpose(const P& p, int it, float* tile) {
  const int n1 = 16 * 16, n2 = n1 + 16 * 88, n3 = n2 + 44 * 16, n4 = n3 + 16 * 16;
  if (it < n1) { transpose_item(p.w_out, 1024, p.wt_out, 1024, it % 16, it / 16, 1, tile); }
  else if (it < n2) { int j = it - n1; transpose_item(p.w_gate_up, 2 * DFF, p.wt_gu, 1024, j % 16, j / 16, 2, tile, p.ffn_norm_w); }
  else if (it < n3) { int j = it - n2; transpose_item(p.w_down, 1024, p.wt_down, DFF, j % 44, j / 44, 1, tile); }
  else if (it < n4) { int j = it - n3; transpose_item(p.w_ple_gate, 1024, p.wt_pg, 1024, j % 16, j / 16, 1, tile, p.ple_norm_w); }
  else { int j = it - n4; transpose_item(p.w_ple_proj, 1024, p.wt_pp, 256, j % 4, j / 4, 1, tile); }
}
#define N_DEFER (16 * 16 + 16 * 88 + 44 * 16 + 16 * 16 + 4 * 16)

__device__ void phase_mixer(const P& p, unsigned char* smem, int rr) {
  volatile int* s_item_p = (volatile int*)(smem + SMEM_MAIN + 16);
  for (;;) {
    __syncthreads();
    if (threadIdx.x == 0) *s_item_p = (int)atomicAdd(&p.counters[rr], 1u);
    __syncthreads();
    const int item = *s_item_p;
    if (item >= NSCAN + 1024 + N_DEFER) break;
    if (item < NSCAN) { scan_unit(p, item, *(ScanSmem*)smem); }
    else if (item < NSCAN + 1024) { attn_unit(p, item - NSCAN, *(AttnSmem*)smem); }
    else { deferred_transpose(p, item - NSCAN - 1024, (float*)smem); }
  }
}

#define XB_TMO      128
#define XB_XCNT(j)  (256  + 64 * (j))
#define XB_XSUB(j)  (1280 + 64 * (j))
#define XB_XGEN(j)  (2304 + 64 * (j))
#define XB_TOP      3328
#define XB_TOPGEN   3392
#define XCD_BAR_WORDS 3456
#define XB_SPIN_CAP (1u << 20)
#define LAS __attribute__((address_space(3)))
__device__ __forceinline__ unsigned xb_ld(unsigned* p) { return __hip_atomic_load(p, __ATOMIC_RELAXED, __HIP_MEMORY_SCOPE_AGENT); }
__device__ __forceinline__ unsigned xb_add(unsigned* p, unsigned v) { return __hip_atomic_fetch_add(p, v, __ATOMIC_RELAXED, __HIP_MEMORY_SCOPE_AGENT); }
__device__ __forceinline__ unsigned xb_xcc_id() { return (unsigned)__builtin_amdgcn_s_getreg((3 << 11) | 20) & 0xFu; }
#define XB_SPIN(cond, bar) do { unsigned _sp = 0; while (cond) { __builtin_amdgcn_s_sleep(1); \
    if ((++_sp & 255u) == 0u) { if (xb_ld(&(bar)[XB_TMO])) break; if (_sp > XB_SPIN_CAP) { atomicAdd(&(bar)[XB_TMO], 1u); break; } } } } while (0)
struct XcdBarrier { unsigned* bar; unsigned x; volatile LAS unsigned* st; };
__device__ __forceinline__ XcdBarrier xcd_barrier_post(unsigned* bar, volatile LAS unsigned* st) {
  XcdBarrier b; b.bar = bar; b.x = xb_xcc_id(); b.st = st;
  if (threadIdx.x == 0) (void)xb_add(&bar[XB_XCNT(b.x)], 1u);
  return b;
}
__device__ __forceinline__ void xcd_barrier_complete(unsigned* bar, unsigned x, unsigned& nloc, unsigned& nx) {
  const unsigned G = gridDim.x * gridDim.y * gridDim.z;
  unsigned sum, cnt, mine, sp = 0u;
  for (;;) {
    sum = 0u; cnt = 0u; mine = 0u;
#pragma unroll
    for (unsigned j = 0; j < 16; ++j) { const unsigned c = xb_ld(&bar[XB_XCNT(j)]); sum += c; cnt += (c > 0u) ? 1u : 0u; mine = (j == x) ? c : mine; }
    if (sum == G) break;
    __builtin_amdgcn_s_sleep(1);
    if ((++sp & 255u) == 0u) { if (xb_ld(&bar[XB_TMO])) break; if (sp > XB_SPIN_CAP) { atomicAdd(&bar[XB_TMO], 1u); break; } }
  }
  nloc = mine > 0u ? mine : 1u; nx = cnt > 0u ? cnt : 1u;
}
__device__ __forceinline__ void xcd_barrier(const XcdBarrier& b) {
  asm volatile("s_waitcnt vmcnt(0)" ::: "memory");
  __syncthreads();
  if (threadIdx.x == 0) {
    unsigned* bar = b.bar;
    __builtin_amdgcn_s_waitcnt(0);
    unsigned nloc = b.st[0], nx = b.st[1];
    if (nloc == 0u) { xcd_barrier_complete(bar, b.x, nloc, nx); b.st[0] = nloc; b.st[1] = nx; }
    const unsigned old = xb_add(&bar[XB_XSUB(b.x)], 1u);
    const unsigned gen = old / nloc;
    if (old + 1u == (gen + 1u) * nloc) {
      __builtin_amdgcn_fence(__ATOMIC_RELEASE, "agent");
      asm volatile("s_waitcnt vmcnt(0)" ::: "memory");
      const unsigned og = xb_add(&bar[XB_TOP], 1u);
      const unsigned tg = og / nx;
      if (og + 1u == (tg + 1u) * nx) xb_add(&bar[XB_TOPGEN], 1u);
      else XB_SPIN(xb_ld(&bar[XB_TOPGEN]) == tg, bar);
      __builtin_amdgcn_fence(__ATOMIC_ACQUIRE, "agent");
      xb_add(&bar[XB_XGEN(b.x)], 1u);
      asm volatile("s_waitcnt vmcnt(0)" ::: "memory");
    } else {
      XB_SPIN(xb_ld(&bar[XB_XGEN(b.x)]) == gen, bar);
      __builtin_amdgcn_fence(__ATOMIC_ACQUIRE, "agent");
      asm volatile("s_waitcnt vmcnt(0)" ::: "memory");
    }
  }
  __syncthreads();
}

__global__ void __launch_bounds__(256, 2) mega(P p, int lo, int hi) {
  __shared__ __attribute__((aligned(16))) unsigned char smem[SMEM_MAIN + 32];
  cg::grid_group grid = cg::this_grid();
  uint4* xbw = (uint4*)(smem + SMEM_MAIN);
  if (threadIdx.x == 0) *xbw = make_uint4(0u, 0u, 0u, 0u);
  __syncthreads();
  XcdBarrier xb = xcd_barrier_post(p.bar, (volatile LAS unsigned*)xbw);
  if (hi < 0) grid.sync();
#define SEAM(k) if (lo <= k && k + 1 < hi) xcd_barrier(xb);
#if !defined(ONLY) || ONLY == 0
  if (lo <= 0 && 0 < hi) phase_prep(p, smem);
#endif
  SEAM(0)
#if !defined(ONLY) || ONLY == 1
  if (lo <= 1 && 1 < hi) phase_inproj(p, smem);
#endif
  SEAM(1)
#if !defined(ONLY) || ONLY == 2
  if (lo <= 2 && 2 < hi) phase_gdnprep(p, smem);
#endif
  SEAM(2)
#if !defined(ONLY) || ONLY == 3
  if (lo <= 3 && 3 < hi) phase_mixer(p, smem, 0);
#endif
  SEAM(3)
#if !defined(ONLY) || ONLY == 4
  if (lo <= 4 && 4 < hi) phase_gout(p, smem);
#endif
  SEAM(4)
#if !defined(ONLY) || ONLY == 5
  if (lo <= 5 && 5 < hi) phase_outproj(p, smem);
#endif
  SEAM(5)
#if !defined(ONLY) || ONLY == 6
  if (lo <= 6 && 6 < hi) phase_gateup(p, smem);
#endif
  SEAM(6)
#if !defined(ONLY) || ONLY == 7
  if (lo <= 7 && 7 < hi) phase_down(p, smem);
#endif
  SEAM(7)
#if !defined(ONLY) || ONLY == 8
  if (lo <= 8 && 8 < hi) phase_ple(p, smem);
#endif
  SEAM(8)
  if (lo <= 9 && 9 < hi) phase_final(p);
}

static_assert(sizeof(GemmSmem) <= SMEM_MAIN && sizeof(Gemm2Smem) <= SMEM_MAIN && sizeof(GdnSmem) <= SMEM_MAIN && sizeof(ScanSmem) <= SMEM_MAIN &&
              sizeof(GoutSmem) <= SMEM_MAIN && sizeof(AttnSmem) <= SMEM_MAIN && 64 * 65 * 4 <= SMEM_MAIN, "smem");

extern "C" void kernel_launch(void* const* d_in, const int* in_sizes, int n_in, void* d_out, int out_size,
                              void* d_ws, size_t ws_size, hipStream_t stream) {
  static int grid_blocks = 0;
  if (!grid_blocks) {
    int dev = 0, cus = 0, per_cu = 0;
    hipGetDevice(&dev);
    hipDeviceGetAttribute(&cus, hipDeviceAttributeMultiprocessorCount, dev);
    hipOccupancyMaxActiveBlocksPerMultiprocessor(&per_cu, mega, 256, 0);
    if (per_cu > 2) per_cu = 2;
    if (per_cu < 1) per_cu = 1;
    grid_blocks = cus * per_cu;
  }
  P p{};
  const float* const* in = (const float* const*)d_in;
  p.x = in[0]; p.p = in[1]; p.attn_norm_w = in[2]; p.w_in = in[3]; p.conv_w = in[4]; p.a_log = in[5];
  p.dt_bias = in[6]; p.gdn_norm_w = in[7]; p.fox_f_bias = in[8]; p.w_out = in[9]; p.ffn_norm_w = in[10];
  p.w_gate_up = in[11]; p.w_down = in[12]; p.ple_norm_w = in[13]; p.w_ple_gate = in[14]; p.w_ple_proj = in[15];
  p.final_norm_w = in[16];
  p.h = (float*)d_out;
  unsigned char* ws = (unsigned char*)d_ws;
  size_t off = 0;
  auto take = [&](size_t bytes) { unsigned char* r = ws + off; off += (bytes + 255) & ~(size_t)255; return r; };
  p.counters = (unsigned*)take(256);
  p.bar = (unsigned*)take(XCD_BAR_WORDS * 4);
  p.wt_in = (u16*)take((size_t)NIN_PAD * 1024 * 2);
  p.wt_out = (u16*)take((size_t)1024 * 1024 * 2);
  p.wt_gu = (u16*)take((size_t)2 * DFF * 1024 * 2);
  p.wt_down = (u16*)take((size_t)1024 * DFF * 2);
  p.wt_pg = (u16*)take((size_t)1024 * 1024 * 2);
  p.wt_pp = (u16*)take((size_t)1024 * 256 * 2);
  p.actA = (u16*)take((size_t)NTOK * 1024 * 2);
  p.pb = (u16*)take((size_t)NTOK * 256 * 2);
  p.proj = (u16*)take((size_t)NTOK * PROJW * 2);
  p.vt = (u16*)take((size_t)64 * 64 * SEQ * 2);
  p.gates = (float*)take((size_t)NTOK * 16 * 4);
  p.cf = (float*)take((size_t)64 * SEQ * 4);
  p.gM = (u16*)take((size_t)1024 * 16384 * 2);
  p.gC = (u16*)take((size_t)1024 * 16384 * 2);
  p.gdl = (float*)take(1024 * 4);
  p.rss = (float*)take((size_t)3 * NTOK * 4);
  p.hb = p.gM;
  if (off > ws_size) fprintf(stderr, "workspace too small: need %zu have %zu\n", off, ws_size);
  u16* ob = (u16*)d_out;
  p.gS = ob;
  p.gQ = ob + (size_t)1024 * 16384;
  p.gO = ob + (size_t)1024 * 16384 + (size_t)1024 * 8192;
  hipMemsetAsync(p.bar, 0, XCD_BAR_WORDS * 4, stream);
  int lo = 0, hi = NPHASE;
  void* args[] = {&p, &lo, &hi};
  hipError_t e = hipLaunchCooperativeKernel((void*)mega, dim3(grid_blocks), dim3(256), args, 0, stream);
  if (e != hipSuccess) fprintf(stderr, "cooperative launch failed: %s (grid %d)\n", hipGetErrorString(e), grid_blocks);
}
```

```cpp
#include <hip/hip_runtime.h>
#include <hip/hip_cooperative_groups.h>
#include <cstdio>
#include <cstdint>
namespace cg = cooperative_groups;

typedef unsigned short u16;
typedef __attribute__((ext_vector_type(8))) short bf16x8;
typedef __attribute__((ext_vector_type(4))) float f32x4;

#define NTOK 16384
#define SEQ 2048
#define DM 1024
#define DFF 2816
#define PROJW 3072
#define NIN_PAD 3712
#define EPSV 1e-6f
#define NPHASE 10
#define SMEM_MAIN 73728

struct P {
  const float *x, *p, *attn_norm_w, *w_in, *conv_w, *a_log, *dt_bias, *gdn_norm_w, *fox_f_bias, *w_out,
      *ffn_norm_w, *w_gate_up, *w_down, *ple_norm_w, *w_ple_gate, *w_ple_proj, *final_norm_w;
  float* h;
  u16 *wt_in, *wt_out, *wt_gu, *wt_down, *wt_pg, *wt_pp;
  u16 *actA;
  u16 *pb;
  u16 *proj;
  u16 *vt;
  float *gates;
  float *cf;
  u16 *gM, *gC;
  u16 *gQ, *gO;
  u16 *gS;
  float *gdl;
  unsigned *counters;
  unsigned *bar;
  u16 *hb;
  float *rss;
};

typedef __attribute__((ext_vector_type(2))) float f32x2_t;
typedef __attribute__((ext_vector_type(2))) __bf16 bf16x2_t;
__device__ __forceinline__ u16 f2bf(float f) { return __builtin_bit_cast(u16, (__bf16)f); }
__device__ __forceinline__ float bf2f(u16 h) { return __uint_as_float(((unsigned)h) << 16); }
__device__ __forceinline__ unsigned pack2(float a, float b) {
  f32x2_t f = {a, b};
  return __builtin_bit_cast(unsigned, __builtin_convertvector(f, bf16x2_t));
}
__device__ __forceinline__ float siluf(float v) { return v / (1.f + __expf(-v)); }
__device__ __forceinline__ float sigmoidf_(float v) { return 1.f / (1.f + __expf(-v)); }
__device__ __forceinline__ f32x4 mfma16(bf16x8 a, bf16x8 b, f32x4 c) {
  return __builtin_amdgcn_mfma_f32_16x16x32_bf16(a, b, c, 0, 0, 0);
}
#define LDS_FENCE() asm volatile("s_waitcnt lgkmcnt(0)" ::: "memory")

__device__ __forceinline__ void unpack8(const uint4& v, float (&f)[8]) {
  f[0] = bf2f((u16)(v.x & 0xffffu)); f[1] = bf2f((u16)(v.x >> 16));
  f[2] = bf2f((u16)(v.y & 0xffffu)); f[3] = bf2f((u16)(v.y >> 16));
  f[4] = bf2f((u16)(v.z & 0xffffu)); f[5] = bf2f((u16)(v.z >> 16));
  f[6] = bf2f((u16)(v.w & 0xffffu)); f[7] = bf2f((u16)(v.w >> 16));
}
__device__ __forceinline__ void unpack4(const uint2& v, float (&f)[4]) {
  f[0] = bf2f((u16)(v.x & 0xffffu)); f[1] = bf2f((u16)(v.x >> 16));
  f[2] = bf2f((u16)(v.y & 0xffffu)); f[3] = bf2f((u16)(v.y >> 16));
}


__device__ __forceinline__ int colmap(int kind, int nn) {
  if (kind == 0) {
    if (nn < 2048) return nn;
    if (nn < 3584) return nn + 8;
    if (nn < 3588) return 2048 + (nn - 3584);
    if (nn < 3592) return 2052 + (nn - 3588);
    if (nn < 3600) return nn;
    return -1;
  } else if (kind == 2) {
    int i = nn >> 7, wc = (nn >> 6) & 1, u = (nn >> 5) & 1, j = nn & 31;
    return u * DFF + 64 * i + 32 * wc + j;
  }
  return nn;
}

__device__ void transpose_item(const float* __restrict__ src, int ldsrc, u16* __restrict__ dst, int K,
                               int kt, int nt, int kind, float* tile, const float* __restrict__ kscale = nullptr) {
  int tid = threadIdx.x;
  asm volatile("" : "+v"(tid));
  const int c = tid & 63, r0 = tid >> 6;
  const int ncol = colmap(kind, nt * 64 + c);
  float tv[16];
#pragma unroll
  for (int i = 0; i < 16; i++) {
    int r = r0 + 4 * i;
    tv[i] = (ncol >= 0) ? __builtin_nontemporal_load(&src[(size_t)(kt * 64 + r) * ldsrc + ncol]) : 0.f;
  }
  if (kscale) {
#pragma unroll
    for (int i = 0; i < 16; i++) tv[i] *= kscale[kt * 64 + r0 + 4 * i];
  }
#pragma unroll
  for (int i = 0; i < 16; i++) tile[(r0 + 4 * i) * 65 + c] = tv[i];
  __syncthreads();
#pragma unroll 8
  for (int i = 0; i < 16; i++) {
    int rn = r0 + 4 * i;
    dst[(size_t)(nt * 64 + rn) * K + kt * 64 + c] = f2bf(tile[c * 65 + rn]);
  }
  __syncthreads();
}

__device__ __forceinline__ void rmsnorm_row(const float* src, const float* __restrict__ w,
                                            u16* dstb, float* dstf, int row) {
  const int lane = threadIdx.x & 63;
  float4 v[4];
  float ss = 0.f;
#pragma unroll
  for (int i = 0; i < 4; i++) {
    v[i] = *(const float4*)&src[(size_t)row * DM + i * 256 + lane * 4];
    ss += v[i].x * v[i].x + v[i].y * v[i].y + v[i].z * v[i].z + v[i].w * v[i].w;
  }
#pragma unroll
  for (int off = 32; off >= 1; off >>= 1) ss += __shfl_xor(ss, off);
  const float r = rsqrtf(ss * (1.f / DM) + EPSV);
#pragma unroll
  for (int i = 0; i < 4; i++) {
    const int col = i * 256 + lane * 4;
    float4 wv = *(const float4*)&w[col];
    float y0 = v[i].x * r * wv.x, y1 = v[i].y * r * wv.y, y2 = v[i].z * r * wv.z, y3 = v[i].w * r * wv.w;
    if (dstb) {
      uint2 o; o.x = pack2(y0, y1); o.y = pack2(y2, y3);
      *(uint2*)&dstb[(size_t)row * DM + col] = o;
    } else {
      *(float4*)&dstf[(size_t)row * DM + col] = make_float4(y0, y1, y2, y3);
    }
  }
}

__device__ void phase_prep(const P& p, unsigned char* smem) {
  float* tile = (float*)smem;
  if (blockIdx.x == 0 && threadIdx.x < 16) p.counters[threadIdx.x] = 0u;
  for (int i = blockIdx.x * 256 + threadIdx.x; i < 3 * NTOK; i += gridDim.x * 256) p.rss[i] = 0.f;
  for (int it = blockIdx.x; it < 16 * 58; it += gridDim.x) transpose_item(p.w_in, 3600, p.wt_in, 1024, it % 16, it / 16, 0, tile);
  const int wave = threadIdx.x >> 6, lane = threadIdx.x & 63;
  for (int rb = blockIdx.x; rb < NTOK / 8; rb += gridDim.x) {
    const int row = rb * 8 + wave * 2;
    float4 v0[4], v1[4];
#pragma unroll
    for (int i = 0; i < 4; i++) {
      { const f32x4 t0 = __builtin_nontemporal_load((const f32x4*)&p.x[(size_t)row * DM + i * 256 + lane * 4]);
        const f32x4 t1 = __builtin_nontemporal_load((const f32x4*)&p.x[(size_t)(row + 1) * DM + i * 256 + lane * 4]);
        v0[i] = make_float4(t0[0], t0[1], t0[2], t0[3]); v1[i] = make_float4(t1[0], t1[1], t1[2], t1[3]); }
    }
    const float4 pv0 = *(const float4*)&p.p[(size_t)row * 256 + lane * 4];
    const float4 pv1 = *(const float4*)&p.p[(size_t)(row + 1) * 256 + lane * 4];
    float s0 = 0.f, s1 = 0.f;
#pragma unroll
    for (int i = 0; i < 4; i++) {
      s0 += v0[i].x * v0[i].x + v0[i].y * v0[i].y + v0[i].z * v0[i].z + v0[i].w * v0[i].w;
      s1 += v1[i].x * v1[i].x + v1[i].y * v1[i].y + v1[i].z * v1[i].z + v1[i].w * v1[i].w;
    }
#pragma unroll
    for (int off = 32; off >= 1; off >>= 1) { s0 += __shfl_xor(s0, off); s1 += __shfl_xor(s1, off); }
    const float r0 = rsqrtf(s0 * (1.f / DM) + EPSV), r1 = rsqrtf(s1 * (1.f / DM) + EPSV);
#pragma unroll
    for (int i = 0; i < 4; i++) {
      const int col = i * 256 + lane * 4;
      const float4 wv = *(const float4*)&p.attn_norm_w[col];
      uint2 o;
      o.x = pack2(v0[i].x * r0 * wv.x, v0[i].y * r0 * wv.y); o.y = pack2(v0[i].z * r0 * wv.z, v0[i].w * r0 * wv.w);
      *(uint2*)&p.actA[(size_t)row * DM + col] = o;
      o.x = pack2(v1[i].x * r1 * wv.x, v1[i].y * r1 * wv.y); o.y = pack2(v1[i].z * r1 * wv.z, v1[i].w * r1 * wv.w);
      *(uint2*)&p.actA[(size_t)(row + 1) * DM + col] = o;
    }
    uint2 o; o.x = pack2(pv0.x, pv0.y); o.y = pack2(pv0.z, pv0.w);
    *(uint2*)&p.pb[(size_t)row * 256 + lane * 4] = o;
    o.x = pack2(pv1.x, pv1.y); o.y = pack2(pv1.z, pv1.w);
    *(uint2*)&p.pb[(size_t)(row + 1) * 256 + lane * 4] = o;
  }
}

__device__ void phase_rmsnorm(const float* src, const float* w, u16* dstb, float* dstf) {
  const int wave = threadIdx.x >> 6;
  for (int rb = blockIdx.x; rb < NTOK / 4; rb += gridDim.x) rmsnorm_row(src, w, dstb, dstf, rb * 4 + wave);
}

__device__ void phase_final(const P& p) {
  const int wave = threadIdx.x >> 6, lane = threadIdx.x & 63;
  for (int rb = blockIdx.x; rb < NTOK / 4; rb += gridDim.x) {
    const int row = rb * 4 + wave;
    const float r = rsqrtf(p.rss[2 * NTOK + row] * (1.f / DM) + EPSV);
#pragma unroll
    for (int i = 0; i < 4; i++) {
      const int col = i * 256 + lane * 4;
      float4 v = *(const float4*)&p.h[(size_t)row * DM + col];
      const float4 wv = *(const float4*)&p.final_norm_w[col];
      f32x4 o = {v.x * r * wv.x, v.y * r * wv.y, v.z * r * wv.z, v.w * r * wv.w};
      __builtin_nontemporal_store(o, (f32x4*)&p.h[(size_t)row * DM + col]);
    }
  }
}

#define GK 64
struct GemmSmem { u16 a[2][128 * GK]; u16 b[2][128 * GK]; };

template <bool SWAP>
__device__ __forceinline__ void gemm_tile(const u16* __restrict__ A, int lda, const u16* __restrict__ Bt, int ldb,
                                          int K, int m0, int n0, GemmSmem& s, f32x4 (&acc)[4][4]) {
  int tid = threadIdx.x;
  asm volatile("" : "+v"(tid));
  const int lane = tid & 63, wave = tid >> 6;
  const int wr = wave >> 1, wc = wave & 1;
  const int l15 = lane & 15, g = lane >> 4;
  const int nk = K / GK;
  const int drow = 8 * wave + (lane >> 3);
  const int dchunk = (lane & 7) ^ ((4 * (wave & 1) + (lane >> 4)) & 7);
  const u16* Ap = A + (size_t)(m0 + drow) * lda + dchunk * 8;
  const u16* Bp = Bt + (size_t)(n0 + drow) * ldb + dchunk * 8;
  const size_t sa = (size_t)32 * lda, sb = (size_t)32 * ldb;
#define G_DMA(bufi, koff) do { \
    _Pragma("unroll") for (int _i = 0; _i < 4; _i++) { \
      __builtin_amdgcn_global_load_lds((const unsigned*)(Ap + _i * sa + (koff)), (unsigned*)&s.a[bufi][(32 * _i + 8 * wave) * GK], 16, 0, 0); \
      __builtin_amdgcn_global_load_lds((const unsigned*)(Bp + _i * sb + (koff)), (unsigned*)&s.b[bufi][(32 * _i + 8 * wave) * GK], 16, 0, 0); \
    } } while (0)
  const int fo0 = l15 * GK + ((g ^ (l15 >> 1)) * 8);
  const int fo1 = l15 * GK + (((4 + g) ^ (l15 >> 1)) * 8);
  G_DMA(0, 0);
  asm volatile("s_waitcnt vmcnt(0)" ::: "memory");
  __builtin_amdgcn_s_barrier();
  asm volatile("" ::: "memory");
  for (int kt = 0; kt < nk; kt++) {
    const int buf = kt & 1;
    if (kt + 1 < nk) { if (buf) G_DMA(0, (kt + 1) * GK); else G_DMA(1, (kt + 1) * GK); }
    const u16* sa_ = &s.a[buf][(wr * 64) * GK];
    const u16* sb_ = &s.b[buf][(wc * 64) * GK];
#pragma unroll
    for (int ks = 0; ks < 2; ks++) {
      const int fo = ks ? fo1 : fo0;
      bf16x8 af[4], bfr[4];
#pragma unroll
      for (int mi = 0; mi < 4; mi++) af[mi] = *(const bf16x8*)&sa_[mi * 16 * GK + fo];
#pragma unroll
      for (int ni = 0; ni < 4; ni++) bfr[ni] = *(const bf16x8*)&sb_[ni * 16 * GK + fo];
#pragma unroll
      for (int mi = 0; mi < 4; mi++)
#pragma unroll
        for (int ni = 0; ni < 4; ni++) acc[mi][ni] = SWAP ? mfma16(bfr[ni], af[mi], acc[mi][ni]) : mfma16(af[mi], bfr[ni], acc[mi][ni]);
    }
    asm volatile("s_waitcnt vmcnt(0) lgkmcnt(0)" ::: "memory");
    __builtin_amdgcn_s_barrier();
    asm volatile("" ::: "memory");
  }
}


#define G2K 32
struct Gemm2Smem { u16 a[3][256 * G2K]; u16 b[3][128 * G2K]; };

template <bool SWAP>
__device__ __forceinline__ void gemm256(const u16* __restrict__ A, int lda, const u16* __restrict__ Bt, int ldb,
                                        int K, int m0, int n0, Gemm2Smem& s, f32x4 (&acc)[8][4]) {
  int tid = threadIdx.x;
  asm volatile("" : "+v"(tid));
  const int lane = tid & 63, wave = tid >> 6;
  const int wr = wave >> 1, wc = wave & 1;
  const int l15 = lane & 15, g = lane >> 4;
  const int nk = K / G2K;
  const int drow = 16 * wave + (lane >> 2);
  const int dchunk = (lane & 3) ^ g;
  const u16* Ap = A + (size_t)(m0 + drow) * lda + dchunk * 8;
  const u16* Bp = Bt + (size_t)(n0 + drow) * ldb + dchunk * 8;
  const size_t sa = (size_t)64 * lda, sb = (size_t)64 * ldb;
  u16* const sa0 = &s.a[0][0] + (16 * wave) * G2K;
  u16* const sb0 = &s.b[0][0] + (16 * wave) * G2K;
#define G2_DMA(st, koff) do { \
    u16* _da = sa0 + (st) * (256 * G2K); u16* _db = sb0 + (st) * (128 * G2K); \
    _Pragma("unroll") for (int _i = 0; _i < 4; _i++) \
      __builtin_amdgcn_global_load_lds((const unsigned*)(Ap + _i * sa + (koff)), (unsigned*)(_da + 64 * _i * G2K), 16, 0, 0); \
    _Pragma("unroll") for (int _i = 0; _i < 2; _i++) \
      __builtin_amdgcn_global_load_lds((const unsigned*)(Bp + _i * sb + (koff)), (unsigned*)(_db + 64 * _i * G2K), 16, 0, 0); \
  } while (0)
  const int fo = l15 * G2K + ((g ^ ((l15 >> 2) & 3)) * 8);
  asm volatile("s_waitcnt lgkmcnt(0)" ::: "memory");
  __builtin_amdgcn_s_barrier();
  asm volatile("" ::: "memory");
#pragma unroll 1
  for (int j = 0; j < 2; j++) G2_DMA(j, j * G2K);
  int st = 0;
  for (int kt = 0; kt < nk; kt++) {
    if (kt + 1 < nk) asm volatile("s_waitcnt vmcnt(6)" ::: "memory");
    else asm volatile("s_waitcnt vmcnt(0)" ::: "memory");
    __builtin_amdgcn_s_barrier();
    asm volatile("" ::: "memory");
    if (kt + 2 < nk) {
      const int st2 = (st >= 1) ? st - 1 : 2;
      G2_DMA(st2, (kt + 2) * G2K);
    }
    const u16* sa_ = &s.a[0][0] + st * (256 * G2K) + (wr * 128) * G2K + fo;
    const u16* sb_ = &s.b[0][0] + st * (128 * G2K) + (wc * 64) * G2K + fo;
    bf16x8 af[8], bfr[4];
#pragma unroll
    for (int mi = 0; mi < 8; mi++) af[mi] = *(const bf16x8*)&sa_[mi * 16 * G2K];
#pragma unroll
    for (int ni = 0; ni < 4; ni++) bfr[ni] = *(const bf16x8*)&sb_[ni * 16 * G2K];
#pragma unroll
    for (int mi = 0; mi < 8; mi++)
#pragma unroll
      for (int ni = 0; ni < 4; ni++) acc[mi][ni] = SWAP ? mfma16(bfr[ni], af[mi], acc[mi][ni]) : mfma16(af[mi], bfr[ni], acc[mi][ni]);
    st = (st == 2) ? 0 : st + 1;
  }
}
#define ZERO_ACC8(acc) _Pragma("unroll") for (int _i = 0; _i < 8; _i++) _Pragma("unroll") for (int _j = 0; _j < 4; _j++) acc[_i][_j] = (f32x4){0.f, 0.f, 0.f, 0.f};

#define ZERO_ACC(acc) _Pragma("unroll") for (int _i = 0; _i < 4; _i++) _Pragma("unroll") for (int _j = 0; _j < 4; _j++) acc[_i][_j] = (f32x4){0.f, 0.f, 0.f, 0.f};

template <int NMI>
__device__ __forceinline__ void row_sumsq_add(f32x4 (&sq)[NMI][4], float* rss, int row0, int l15, int g) {
#pragma unroll
  for (int mi = 0; mi < NMI; mi++) {
    float v = 0.f;
#pragma unroll
    for (int ni = 0; ni < 4; ni++) v += (sq[mi][ni][0] + sq[mi][ni][1]) + (sq[mi][ni][2] + sq[mi][ni][3]);
    v += __shfl_xor(v, 16);
    v += __shfl_xor(v, 32);
    if (g == 0) atomicAdd(&rss[row0 + mi * 16 + l15], v);
  }
}

__device__ void phase_inproj(const P& p, unsigned char* smem) {
  Gemm2Smem& s = *(Gemm2Smem*)smem;
  const int lane = threadIdx.x & 63, wave = threadIdx.x >> 6, wr = wave >> 1, wc = wave & 1, l15 = lane & 15, g = lane >> 4;
  const int ntiles = 64 * 29;
  for (int tl = blockIdx.x; tl < ntiles; tl += gridDim.x) {
    const int mt = tl & 63, nt = tl >> 6;
    const int m0 = mt * 256, n0 = nt * 128;
    f32x4 acc[8][4];
    ZERO_ACC8(acc);
    if (nt >= 24 && nt < 28) {
      gemm256<false>(p.actA, DM, p.wt_in, DM, DM, m0, n0, s, acc);
#pragma unroll
      for (int mi = 0; mi < 8; mi++)
#pragma unroll
        for (int ni = 0; ni < 4; ni++) {
          const int rowb = m0 + wr * 128 + mi * 16 + g * 4;
          const int col = n0 + wc * 64 + ni * 16 + l15;
          const int cc = col - 3072, hh = cc >> 6, d = cc & 63;
          const int b = rowb >> 11, sq = rowb & 2047;
          uint2 o; o.x = pack2(acc[mi][ni][0], acc[mi][ni][1]); o.y = pack2(acc[mi][ni][2], acc[mi][ni][3]);
          *(uint2*)&p.vt[((size_t)((b * 8 + hh) * 64 + d)) * SEQ + sq] = o;
        }
    } else {
      gemm256<true>(p.actA, DM, p.wt_in, DM, DM, m0, n0, s, acc);
#pragma unroll
      for (int mi = 0; mi < 8; mi++)
#pragma unroll
        for (int ni = 0; ni < 4; ni++) {
          const int row = m0 + wr * 128 + mi * 16 + l15;
          const int col = n0 + wc * 64 + ni * 16 + g * 4;
          if (nt < 24) {
            uint2 o; o.x = pack2(acc[mi][ni][0], acc[mi][ni][1]); o.y = pack2(acc[mi][ni][2], acc[mi][ni][3]);
            *(uint2*)&p.proj[(size_t)row * PROJW + col] = o;
          } else if (col < 3600) {
            *(float4*)&p.gates[(size_t)row * 16 + (col - 3584)] = make_float4(acc[mi][ni][0], acc[mi][ni][1], acc[mi][ni][2], acc[mi][ni][3]);
          }
        }
    }
  }
}

__device__ void phase_outproj(const P& p, unsigned char* smem) {
  GemmSmem& s = *(GemmSmem*)smem;
  const int lane = threadIdx.x & 63, wave = threadIdx.x >> 6, wr = wave >> 1, wc = wave & 1, l15 = lane & 15, g = lane >> 4;
  for (int tl = blockIdx.x; tl < 128 * 8; tl += gridDim.x) {
    const int mt = tl & 127, nt = tl >> 7;
    const int m0 = mt * 128, n0 = nt * 128;
    f32x4 acc[4][4];
    ZERO_ACC(acc);
    gemm_tile<true>(p.actA, DM, p.wt_out, DM, DM, m0, n0, s, acc);
#pragma unroll
    for (int mi = 0; mi < 4; mi++)
#pragma unroll
      for (int ni = 0; ni < 4; ni++) {
        const size_t idx = (size_t)(m0 + wr * 64 + mi * 16 + l15) * DM + n0 + wc * 64 + ni * 16 + g * 4;
        const f32x4 xv4 = __builtin_nontemporal_load((const f32x4*)&p.x[idx]);
        const float4 xv = make_float4(xv4[0], xv4[1], xv4[2], xv4[3]);
        const float h0 = xv.x + acc[mi][ni][0], h1 = xv.y + acc[mi][ni][1], h2 = xv.z + acc[mi][ni][2], h3 = xv.w + acc[mi][ni][3];
        uint2 o; o.x = pack2(h0, h1); o.y = pack2(h2, h3);
        *(uint2*)&p.hb[idx] = o;
        acc[mi][ni] = (f32x4){h0 * h0, h1 * h1, h2 * h2, h3 * h3};
      }
    row_sumsq_add(acc, p.rss, m0 + wr * 64, l15, g);
  }
}

__device__ void phase_gateup(const P& p, unsigned char* smem) {
  Gemm2Smem& s = *(Gemm2Smem*)smem;
  u16* act = p.proj;
  const int lane = threadIdx.x & 63, wave = threadIdx.x >> 6, wr = wave >> 1, wc = wave & 1, l15 = lane & 15, g = lane >> 4;
  for (int tl = blockIdx.x; tl < 64 * 44; tl += gridDim.x) {
    const int mt = tl & 63, nt = tl >> 6;
    const int m0 = mt * 256, n0 = nt * 128;
    f32x4 acc[8][4];
    ZERO_ACC8(acc);
    gemm256<true>(p.hb, DM, p.wt_gu, DM, DM, m0, n0, s, acc);
#pragma unroll
    for (int mi = 0; mi < 8; mi++) {
      const int row = m0 + wr * 128 + mi * 16 + l15;
      const float rs = rsqrtf(p.rss[row] * (1.f / DM) + EPSV);
#pragma unroll
      for (int ni = 0; ni < 2; ni++) {
        const int col = 64 * nt + 32 * wc + 16 * ni + g * 4;
        float v[4];
#pragma unroll
        for (int r = 0; r < 4; r++) v[r] = siluf(acc[mi][ni][r] * rs) * (acc[mi][ni + 2][r] * rs);
        uint2 o; o.x = pack2(v[0], v[1]); o.y = pack2(v[2], v[3]);
        *(uint2*)&act[(size_t)row * DFF + col] = o;
      }
    }
  }
}

__device__ void phase_down(const P& p, unsigned char* smem) {
  GemmSmem& s = *(GemmSmem*)smem;
  const u16* act = p.proj;
  const int lane = threadIdx.x & 63, wave = threadIdx.x >> 6, wr = wave >> 1, wc = wave & 1, l15 = lane & 15, g = lane >> 4;
  for (int tl = blockIdx.x; tl < 128 * 8; tl += gridDim.x) {
    const int mt = tl & 127, nt = tl >> 7;
    const int m0 = mt * 128, n0 = nt * 128;
    f32x4 acc[4][4];
    ZERO_ACC(acc);
    gemm_tile<true>(act, DFF, p.wt_down, DFF, DFF, m0, n0, s, acc);
#pragma unroll
    for (int mi = 0; mi < 4; mi++)
#pragma unroll
      for (int ni = 0; ni < 4; ni++) {
        const size_t idx = (size_t)(m0 + wr * 64 + mi * 16 + l15) * DM + n0 + wc * 64 + ni * 16 + g * 4;
        float hp[4];
        unpack4(*(const uint2*)&p.hb[idx], hp);
        const float h0 = hp[0] + acc[mi][ni][0], h1 = hp[1] + acc[mi][ni][1], h2 = hp[2] + acc[mi][ni][2], h3 = hp[3] + acc[mi][ni][3];
        uint2 o; o.x = pack2(h0, h1); o.y = pack2(h2, h3);
        *(uint2*)&p.actA[idx] = o;
        acc[mi][ni] = (f32x4){h0 * h0, h1 * h1, h2 * h2, h3 * h3};
      }
    row_sumsq_add(acc, p.rss + NTOK, m0 + wr * 64, l15, g);
  }
}

__device__ void phase_ple(const P& p, unsigned char* smem) {
  GemmSmem& s = *(GemmSmem*)smem;
  const int lane = threadIdx.x & 63, wave = threadIdx.x >> 6, wr = wave >> 1, wc = wave & 1, l15 = lane & 15, g = lane >> 4;
  for (int tl = blockIdx.x; tl < 128 * 8; tl += gridDim.x) {
    const int mt = tl & 127, nt = tl >> 7;
    const int m0 = mt * 128, n0 = nt * 128;
    f32x4 acc[4][4], acc2[4][4];
    ZERO_ACC(acc);
    gemm_tile<true>(p.actA, DM, p.wt_pg, DM, DM, m0, n0, s, acc);
#pragma unroll
    for (int mi = 0; mi < 4; mi++) {
      const float rs = rsqrtf(p.rss[NTOK + m0 + wr * 64 + mi * 16 + l15] * (1.f / DM) + EPSV);
#pragma unroll
      for (int ni = 0; ni < 4; ni++)
#pragma unroll
        for (int r = 0; r < 4; r++) acc[mi][ni][r] = sigmoidf_(acc[mi][ni][r] * rs);
    }
    ZERO_ACC(acc2);
    gemm_tile<true>(p.pb, 256, p.wt_pp, 256, 256, m0, n0, s, acc2);
#pragma unroll
    for (int mi = 0; mi < 4; mi++)
#pragma unroll
      for (int ni = 0; ni < 4; ni++) {
        const size_t idx = (size_t)(m0 + wr * 64 + mi * 16 + l15) * DM + n0 + wc * 64 + ni * 16 + g * 4;
        float hp[4];
        unpack4(*(const uint2*)&p.actA[idx], hp);
        const float h0 = hp[0] + acc[mi][ni][0] * acc2[mi][ni][0], h1 = hp[1] + acc[mi][ni][1] * acc2[mi][ni][1];
        const float h2 = hp[2] + acc[mi][ni][2] * acc2[mi][ni][2], h3 = hp[3] + acc[mi][ni][3] * acc2[mi][ni][3];
        *(float4*)&p.h[idx] = make_float4(h0, h1, h2, h3);
        acc2[mi][ni] = (f32x4){h0 * h0, h1 * h1, h2 * h2, h3 * h3};
      }
    row_sumsq_add(acc2, p.rss + 2 * NTOK, m0 + wr * 64, l15, g);
  }
}

#define QLD 136
#define KLD 72
struct GdnSmem {
  u16 qb[64 * QLD];
  u16 kn[64 * QLD];
  u16 vb[64 * QLD];
  float Am[64 * 64];
  float gc[64], beta[64], be[64];
};
static_assert(offsetof(GdnSmem, kn) == 17408 && offsetof(GdnSmem, vb) == 34816 && offsetof(GdnSmem, Am) == 52224, "layout");


__device__ void gdn_unit(const P& p, int unit, GdnSmem& s) {
  int tid = threadIdx.x;
  asm volatile("" : "+v"(tid));
  int lane = tid & 63, wave = tid >> 6;
  int l15 = lane & 15, g = lane >> 4;
#define GDN_REFRESH() do { tid = threadIdx.x; asm volatile("" : "+v"(tid) :: "memory"); lane = tid & 63; wave = tid >> 6; l15 = lane & 15; g = lane >> 4; } while (0)
  const int bh = unit >> 5, n = unit & 31;
  const int b = bh >> 2, h = bh & 3;
  const int tb = b * SEQ;
  const int s0 = n * 64;
  u16* const qk_s = s.qb;
  u16* const WU = s.kn;
  u16* const kdT = (u16*)((unsigned char*)s.kn + 32768);
  __syncthreads();
  if (wave == 0) {
    const int t = tb + s0 + lane;
    const float ga = p.gates[(size_t)t * 16 + h], gb = p.gates[(size_t)t * 16 + 4 + h];
    const float xx = ga + p.dt_bias[h];
    const float sp = (xx > 20.f) ? xx : log1pf(__expf(xx));
    float gg = -__expf(p.a_log[h]) * sp;
#pragma unroll
    for (int off = 1; off < 64; off <<= 1) {
      float nb = __shfl_up(gg, off);
      if (lane >= off) gg += nb;
    }
    const float bt = sigmoidf_(gb);
    s.gc[lane] = gg;
    s.beta[lane] = bt;
    s.be[lane] = bt * __expf(gg);
  }
  {
    const int ch = tid & 15, rg = tid >> 4;
#pragma unroll 1
    for (int mat = 0; mat < 3; mat++) {
      const int col0 = mat * 512 + h * 128 + ch * 8;
      float cw[4][8];
#pragma unroll
      for (int k = 0; k < 4; k++) {
        const float4 w0 = *(const float4*)&p.conv_w[k * 1536 + col0];
        const float4 w1 = *(const float4*)&p.conv_w[k * 1536 + col0 + 4];
        cw[k][0] = w0.x; cw[k][1] = w0.y; cw[k][2] = w0.z; cw[k][3] = w0.w;
        cw[k][4] = w1.x; cw[k][5] = w1.y; cw[k][6] = w1.z; cw[k][7] = w1.w;
      }
      uint4 xr[7];
#pragma unroll
      for (int j = 0; j < 7; j++) {
        const int sp = s0 + 4 * rg + j - 3;
        if (sp >= 0) {
          typedef __attribute__((ext_vector_type(4))) unsigned u32x4_t;
          const u32x4_t t = __builtin_nontemporal_load((const u32x4_t*)&p.proj[(size_t)(tb + sp) * PROJW + col0]);
          xr[j] = make_uint4(t[0], t[1], t[2], t[3]);
        } else xr[j] = make_uint4(0u, 0u, 0u, 0u);
      }
      float xf[7][8];
#pragma unroll
      for (int j = 0; j < 7; j++) unpack8(xr[j], xf[j]);
      u16* dst = (mat == 0) ? s.qb : ((mat == 1) ? s.kn : s.vb);
#pragma unroll
      for (int r = 0; r < 4; r++) {
        float val[8];
        float ss = 0.f;
#pragma unroll
        for (int c = 0; c < 8; c++) {
          const float cv = cw[0][c] * xf[r][c] + cw[1][c] * xf[r + 1][c] + cw[2][c] * xf[r + 2][c] + cw[3][c] * xf[r + 3][c];
          val[c] = siluf(cv);
          ss += val[c] * val[c];
        }
        float rs = 1.f;
        if (mat < 2) {
#pragma unroll
          for (int off = 1; off < 16; off <<= 1) ss += __shfl_xor(ss, off);
          rs = rsqrtf(ss + EPSV) * ((mat == 0) ? 0.08838834764831845f : 1.f);
        }
        uint4 o;
        o.x = pack2(val[0] * rs, val[1] * rs); o.y = pack2(val[2] * rs, val[3] * rs);
        o.z = pack2(val[4] * rs, val[5] * rs); o.w = pack2(val[6] * rs, val[7] * rs);
        *(uint4*)&dst[(4 * rg + r) * QLD + ch * 8] = o;
      }
    }
  }
  __syncthreads();
  GDN_REFRESH();
  u16* const gQ = p.gQ + (size_t)unit * 8192;
  {
#pragma unroll
    for (int it = 0; it < 4; it++) {
      const int idx = tid + 256 * it;
      const int i = idx >> 4, d8 = (idx & 15) * 8;
      const float e = __expf(s.gc[i]);
      float f[8];
      unpack8(*(const uint4*)&s.qb[i * QLD + d8], f);
      uint4 o;
      o.x = pack2(f[0] * e, f[1] * e); o.y = pack2(f[2] * e, f[3] * e);
      o.z = pack2(f[4] * e, f[5] * e); o.w = pack2(f[6] * e, f[7] * e);
      *(uint4*)&gQ[i * 128 + d8] = o;
    }
  }
  f32x4 cqk[4];
  {
    bf16x8 aq[4], ak[4];
#pragma unroll
    for (int ks = 0; ks < 4; ks++) {
      aq[ks] = *(const bf16x8*)&s.qb[(wave * 16 + l15) * QLD + ks * 32 + g * 8];
      ak[ks] = *(const bf16x8*)&s.kn[(wave * 16 + l15) * QLD + ks * 32 + g * 8];
    }
#pragma unroll
    for (int ni = 0; ni < 4; ni++) {
      f32x4 ckk = {0.f, 0.f, 0.f, 0.f};
      cqk[ni] = (f32x4){0.f, 0.f, 0.f, 0.f};
      if (ni <= wave) {
#pragma unroll
        for (int ks = 0; ks < 4; ks++) {
          bf16x8 bk = *(const bf16x8*)&s.kn[(ni * 16 + l15) * QLD + ks * 32 + g * 8];
          ckk = mfma16(ak[ks], bk, ckk);
          cqk[ni] = mfma16(aq[ks], bk, cqk[ni]);
        }
      }
      const int j = ni * 16 + l15;
      const float gcj = s.gc[j];
#pragma unroll
      for (int r = 0; r < 4; r++) {
        const int i = wave * 16 + g * 4 + r;
        const float dec = (i >= j) ? __expf(s.gc[i] - gcj) : 0.f;
        s.Am[i * 64 + j] = (i > j) ? ckk[r] * s.beta[i] * dec : 0.f;
        cqk[ni][r] = (i >= j) ? cqk[ni][r] * dec : 0.f;
      }
    }
  }
  __syncthreads();
  GDN_REFRESH();
#pragma unroll
  for (int ni = 0; ni < 4; ni++)
#pragma unroll
    for (int r = 0; r < 4; r++) qk_s[(wave * 16 + g * 4 + r) * KLD + ni * 16 + l15] = f2bf(cqk[ni][r]);
  float xs[64];
#ifdef NO_SOLVE
  for (int i = 0; i < 64; i++) xs[i] = s.Am[i*64+tid%64];
#else
  {
    const int c = tid;
    const u16* src = (c < 128) ? &s.vb[c] : &s.kn[c - 128];
    const float* sc = (c < 128) ? s.beta : s.be;
#pragma unroll
    for (int i = 0; i < 64; i++) {
      float a0 = bf2f(src[i * QLD]) * sc[i], a1 = 0.f, a2 = 0.f, a3 = 0.f;
#pragma unroll
      for (int j4 = 0; j4 < (i + 3) / 4; j4++) {
        const float4 av = *(const float4*)&s.Am[i * 64 + j4 * 4];
        if (j4 * 4 + 0 < i) a0 -= av.x * xs[j4 * 4 + 0];
        if (j4 * 4 + 1 < i) a1 -= av.y * xs[j4 * 4 + 1];
        if (j4 * 4 + 2 < i) a2 -= av.z * xs[j4 * 4 + 2];
        if (j4 * 4 + 3 < i) a3 -= av.w * xs[j4 * 4 + 3];
      }
      xs[i] = (a0 + a1) + (a2 + a3);
      asm volatile("" : "+v"(xs[i]) :: "memory");
    }
  }
#endif
  const float glast = s.gc[63];
  __syncthreads();
  GDN_REFRESH();
  {
    const int d = tid & 127, half = tid >> 7;
#pragma unroll
    for (int q = 0; q < 4; q++) {
      unsigned ow[4];
#pragma unroll
      for (int e2 = 0; e2 < 4; e2++) {
        const int c0 = half * 32 + q * 8 + e2 * 2;
        const float v0 = bf2f(s.kn[c0 * QLD + d]) * __expf(glast - s.gc[c0]);
        const float v1 = bf2f(s.kn[(c0 + 1) * QLD + d]) * __expf(glast - s.gc[c0 + 1]);
        ow[e2] = pack2(v0, v1);
      }
      *(uint4*)&kdT[d * KLD + half * 32 + q * 8] = make_uint4(ow[0], ow[1], ow[2], ow[3]);
    }
    if (tid == 0) p.gdl[unit] = __expf(glast);
  }
  __syncthreads();
  GDN_REFRESH();
  if (tid >= 128) {
#pragma unroll
    for (int q = 0; q < 8; q++)
      *(uint4*)&WU[(tid - 128) * KLD + q * 8] = make_uint4(pack2(xs[q * 8], xs[q * 8 + 1]), pack2(xs[q * 8 + 2], xs[q * 8 + 3]),
                                                            pack2(xs[q * 8 + 4], xs[q * 8 + 5]), pack2(xs[q * 8 + 6], xs[q * 8 + 7]));
  }
  __syncthreads();
  GDN_REFRESH();
  {
    u16* const gM = p.gM + (size_t)unit * 16384;
    bf16x8 aw[2][2];
#pragma unroll
    for (int mm = 0; mm < 2; mm++)
#pragma unroll
      for (int ks = 0; ks < 2; ks++) aw[mm][ks] = *(const bf16x8*)&WU[((2 * wave + mm) * 16 + l15) * KLD + ks * 32 + g * 8];
#pragma unroll
    for (int nn = 0; nn < 8; nn++) {
      const bf16x8 b0 = *(const bf16x8*)&kdT[(nn * 16 + l15) * KLD + g * 8];
      const bf16x8 b1 = *(const bf16x8*)&kdT[(nn * 16 + l15) * KLD + 32 + g * 8];
#pragma unroll
      for (int mm = 0; mm < 2; mm++) {
        f32x4 acc = {0.f, 0.f, 0.f, 0.f};
        acc = mfma16(aw[mm][0], b0, acc);
        acc = mfma16(aw[mm][1], b1, acc);
        uint2 o; o.x = pack2(-acc[0], -acc[1]); o.y = pack2(-acc[2], -acc[3]);
        *(uint2*)&gM[(nn * 16 + l15) * 128 + (2 * wave + mm) * 16 + 4 * g] = o;
      }
    }
#pragma unroll
    for (int nn = 0; nn < 4; nn++) {
      const bf16x8 b0 = *(const bf16x8*)&qk_s[(nn * 16 + l15) * KLD + g * 8];
      const bf16x8 b1 = *(const bf16x8*)&qk_s[(nn * 16 + l15) * KLD + 32 + g * 8];
#pragma unroll
      for (int mm = 0; mm < 2; mm++) {
        f32x4 acc = {0.f, 0.f, 0.f, 0.f};
        acc = mfma16(aw[mm][0], b0, acc);
        acc = mfma16(aw[mm][1], b1, acc);
        u16* qp = &gQ[(nn * 16 + l15) * 128 + (2 * wave + mm) * 16 + 4 * g];
        float qv[4];
        unpack4(*(const uint2*)qp, qv);
        uint2 o; o.x = pack2(qv[0] - acc[0], qv[1] - acc[1]); o.y = pack2(qv[2] - acc[2], qv[3] - acc[3]);
        *(uint2*)qp = o;
      }
    }
  }
  __syncthreads();
  GDN_REFRESH();
  if (tid < 128) {
#pragma unroll
    for (int q = 0; q < 8; q++)
      *(uint4*)&WU[tid * KLD + q * 8] = make_uint4(pack2(xs[q * 8], xs[q * 8 + 1]), pack2(xs[q * 8 + 2], xs[q * 8 + 3]),
                                                    pack2(xs[q * 8 + 4], xs[q * 8 + 5]), pack2(xs[q * 8 + 6], xs[q * 8 + 7]));
  }
  __syncthreads();
  GDN_REFRESH();
  {
    u16* const gC = p.gC + (size_t)unit * 16384;
    u16* const gO = p.gO + (size_t)unit * 8192;
    bf16x8 akd[2][2], aqk[2];
#pragma unroll
    for (int mm = 0; mm < 2; mm++)
#pragma unroll
      for (int ks = 0; ks < 2; ks++) akd[mm][ks] = *(const bf16x8*)&kdT[((2 * wave + mm) * 16 + l15) * KLD + ks * 32 + g * 8];
#pragma unroll
    for (int ks = 0; ks < 2; ks++) aqk[ks] = *(const bf16x8*)&qk_s[(wave * 16 + l15) * KLD + ks * 32 + g * 8];
#pragma unroll
    for (int nn = 0; nn < 8; nn++) {
      const bf16x8 b0 = *(const bf16x8*)&WU[(nn * 16 + l15) * KLD + g * 8];
      const bf16x8 b1 = *(const bf16x8*)&WU[(nn * 16 + l15) * KLD + 32 + g * 8];
#pragma unroll
      for (int mm = 0; mm < 2; mm++) {
        f32x4 acc = {0.f, 0.f, 0.f, 0.f};
        acc = mfma16(akd[mm][0], b0, acc);
        acc = mfma16(akd[mm][1], b1, acc);
        uint2 o; o.x = pack2(acc[0], acc[1]); o.y = pack2(acc[2], acc[3]);
        *(uint2*)&gC[(nn * 16 + l15) * 128 + (2 * wave + mm) * 16 + 4 * g] = o;
      }
      {
        f32x4 acc = {0.f, 0.f, 0.f, 0.f};
        acc = mfma16(aqk[0], b0, acc);
        acc = mfma16(aqk[1], b1, acc);
        uint2 o; o.x = pack2(acc[0], acc[1]); o.y = pack2(acc[2], acc[3]);
        *(uint2*)&gO[(nn * 16 + l15) * 64 + wave * 16 + 4 * g] = o;
      }
    }
  }
}

__device__ void fox_cumsum_unit(const P& p, int bhf, float* red) {
  const int tid = threadIdx.x, lane = tid & 63, wave = tid >> 6;
  const int b = bhf >> 3, hf = bhf & 7;
  const float bias = p.fox_f_bias[hf];
  float v[8];
  float run = 0.f;
#pragma unroll
  for (int i = 0; i < 8; i++) {
    const int t = b * SEQ + tid * 8 + i;
    const float xx = p.gates[(size_t)t * 16 + 8 + hf] + bias;
    const float ls = fminf(xx, 0.f) - log1pf(__expf(-fabsf(xx)));
    run += ls;
    v[i] = run;
  }
  float tot = run;
#pragma unroll
  for (int off = 1; off < 64; off <<= 1) {
    float nb = __shfl_up(tot, off);
    if (lane >= off) tot += nb;
  }
  __syncthreads();
  if (lane == 63) red[wave] = tot;
  __syncthreads();
  float base = tot - run;
  for (int w = 0; w < wave; w++) base += red[w];
#pragma unroll
  for (int i = 0; i < 8; i++) p.cf[(size_t)bhf * SEQ + tid * 8 + i] = v[i] + base;
}

__device__ void phase_gdnprep(const P& p, unsigned char* smem) {
  GdnSmem& s = *(GdnSmem*)smem;
  for (int u = blockIdx.x; u < 1024 + 64; u += gridDim.x) {
    if (u < 1024) gdn_unit(p, u, s);
    else { __syncthreads(); fox_cumsum_unit(p, u - 1024, (float*)smem); }
  }
}

#define SLD 136
#define NSCAN 128
struct ScanSmem { u16 st[2][32 * SLD]; };
struct ScanSet { bf16x8 mf[2][4]; uint2 ci[2][2]; float dl; };

__device__ __forceinline__ void scan_load(const P& p, int unit, int eq, int w, int l15, int g, ScanSet& z) {
  int la = (32 * w + l15) * 128 + 8 * g, lc = (32 * eq + l15) * 128 + 32 * w + 4 * g;
  asm volatile("" : "+v"(la), "+v"(lc));
  const u16* gM = p.gM + (size_t)unit * 16384;
  const u16* gC = p.gC + (size_t)unit * 16384;
#pragma unroll
  for (int md = 0; md < 2; md++)
#pragma unroll
    for (int ks = 0; ks < 4; ks++) z.mf[md][ks] = *(const bf16x8*)&gM[la + md * 16 * 128 + ks * 32];
#pragma unroll
  for (int md = 0; md < 2; md++)
#pragma unroll
    for (int ne = 0; ne < 2; ne++) z.ci[md][ne] = *(const uint2*)&gC[lc + ne * 16 * 128 + md * 16];
  z.dl = p.gdl[unit];
}

__device__ __forceinline__ unsigned scan_touch(const P& p, int unit, int lane) {
  unsigned v = 0u;
  if (lane < 16) {
    const u16* base = (lane < 8) ? (p.gM + (size_t)unit * 16384) : (p.gC + (size_t)unit * 16384);
    v = *(const unsigned*)(base + (lane & 7) * 2048);
  }
  return v;
}

__device__ __forceinline__ void scan_step(const P& p, int unit, int n, int eq, int w, int l15, int g, ScanSmem& s,
                                          f32x4 (&st)[2][2], const ScanSet& z) {
  const u16* Sb = s.st[n & 1];
  u16* Sn = s.st[(n & 1) ^ 1];
#pragma unroll
  for (int md = 0; md < 2; md++)
#pragma unroll
    for (int ne = 0; ne < 2; ne++) {
      float c[4];
      unpack4(z.ci[md][ne], c);
      st[md][ne][0] = st[md][ne][0] * z.dl + c[0];
      st[md][ne][1] = st[md][ne][1] * z.dl + c[1];
      st[md][ne][2] = st[md][ne][2] * z.dl + c[2];
      st[md][ne][3] = st[md][ne][3] * z.dl + c[3];
    }
  if (n > 0) {
    int lb = l15 * SLD + 8 * g;
    asm volatile("" : "+v"(lb));
#pragma unroll
    for (int ne = 0; ne < 2; ne++) {
#pragma unroll
      for (int ks = 0; ks < 4; ks++) {
        const bf16x8 bs = *(const bf16x8*)&Sb[lb + 16 * ne * SLD + ks * 32];
        st[0][ne] = mfma16(z.mf[0][ks], bs, st[0][ne]);
        st[1][ne] = mfma16(z.mf[1][ks], bs, st[1][ne]);
      }
    }
  }
  if (n + 1 < 32) {
    u16* gS = p.gS + (size_t)(unit + 1) * 16384;
    int lsl = l15 * SLD + 32 * w + 4 * g, lsg = (32 * eq + l15) * 128 + 32 * w + 4 * g;
    asm volatile("" : "+v"(lsl), "+v"(lsg));
#pragma unroll
    for (int md = 0; md < 2; md++)
#pragma unroll
      for (int ne = 0; ne < 2; ne++) {
        uint2 o; o.x = pack2(st[md][ne][0], st[md][ne][1]); o.y = pack2(st[md][ne][2], st[md][ne][3]);
        *(uint2*)&Sn[lsl + 16 * ne * SLD + 16 * md] = o;
        *(uint2*)&gS[lsg + 16 * ne * 128 + 16 * md] = o;
      }
  }
  asm volatile("s_waitcnt lgkmcnt(0)" ::: "memory");
  __builtin_amdgcn_s_barrier();
  asm volatile("" ::: "memory");
}

__device__ void scan_unit(const P& p, int item, ScanSmem& s) {
  int tid = threadIdx.x;
  asm volatile("" : "+v"(tid));
  const int lane = tid & 63, w = tid >> 6;
  const int l15 = lane & 15, g = lane >> 4;
  const int bh = item >> 2, eq = item & 3;
  const int u0 = bh * 32;
  f32x4 st[2][2];
#pragma unroll
  for (int md = 0; md < 2; md++)
#pragma unroll
    for (int ne = 0; ne < 2; ne++) st[md][ne] = (f32x4){0.f, 0.f, 0.f, 0.f};
  ScanSet z0, z1, z2, z3;
  scan_load(p, u0 + 0, eq, w, l15, g, z0);
  scan_load(p, u0 + 1, eq, w, l15, g, z1);
  scan_load(p, u0 + 2, eq, w, l15, g, z2);
  unsigned tacc = 0u, tprev = 0u;
  __builtin_amdgcn_s_setprio(3);
#pragma unroll 1
  for (int n = 0; n < 32; n += 4) {
    tacc += tprev;
    tprev = 0u;
    if (n + 8 < 32) {
      tprev = scan_touch(p, u0 + n + 8, lane) + scan_touch(p, u0 + n + 9, lane) + scan_touch(p, u0 + n + 10, lane) +
              scan_touch(p, u0 + n + 11, lane);
    }
    scan_load(p, u0 + n + 3, eq, w, l15, g, z3);
    scan_step(p, u0 + n, n, eq, w, l15, g, s, st, z0);
    if (n + 4 < 32) scan_load(p, u0 + n + 4, eq, w, l15, g, z0);
    scan_step(p, u0 + n + 1, n + 1, eq, w, l15, g, s, st, z1);
    if (n + 4 < 32) scan_load(p, u0 + n + 5, eq, w, l15, g, z1);
    scan_step(p, u0 + n + 2, n + 2, eq, w, l15, g, s, st, z2);
    if (n + 4 < 32) scan_load(p, u0 + n + 6, eq, w, l15, g, z2);
    scan_step(p, u0 + n + 3, n + 3, eq, w, l15, g, s, st, z3);
  }
  __builtin_amdgcn_s_setprio(0);
  asm volatile("" :: "v"(tacc));
}

#define OLD 136
struct GoutSmem { float ssq[4][64]; u16 ob[64 * OLD]; };

__device__ void gout_unit(const P& p, int unit, GoutSmem& s) {
  const int tid = threadIdx.x, lane = tid & 63, w = tid >> 6;
  const int l15 = lane & 15, g = lane >> 4;
  const int bh = unit >> 5, n = unit & 31;
  const int b = bh >> 2, h = bh & 3;
  const u16* gQ = p.gQ + (size_t)unit * 8192;
  const u16* gO = p.gO + (size_t)unit * 8192;
  const u16* gS = p.gS + (size_t)unit * 16384;
  f32x4 o[4][2];
#pragma unroll
  for (int mc = 0; mc < 4; mc++)
#pragma unroll
    for (int ne = 0; ne < 2; ne++) {
      float c[4];
      unpack4(*(const uint2*)&gO[(32 * w + 16 * ne + l15) * 64 + 16 * mc + 4 * g], c);
      o[mc][ne] = (f32x4){c[0], c[1], c[2], c[3]};
    }
  if (n > 0) {
    bf16x8 bs[2][4];
#pragma unroll
    for (int ne = 0; ne < 2; ne++)
#pragma unroll
      for (int ks = 0; ks < 4; ks++) bs[ne][ks] = *(const bf16x8*)&gS[(32 * w + 16 * ne + l15) * 128 + ks * 32 + 8 * g];
#pragma unroll
    for (int mc = 0; mc < 4; mc++) {
#pragma unroll
      for (int ks = 0; ks < 4; ks++) {
        const bf16x8 aq = *(const bf16x8*)&gQ[(16 * mc + l15) * 128 + ks * 32 + 8 * g];
        o[mc][0] = mfma16(aq, bs[0][ks], o[mc][0]);
        o[mc][1] = mfma16(aq, bs[1][ks], o[mc][1]);
      }
    }
  }
  const float gnw0 = p.gdn_norm_w[32 * w + l15], gnw1 = p.gdn_norm_w[32 * w + 16 + l15];
  __syncthreads();
#pragma unroll
  for (int mc = 0; mc < 4; mc++)
#pragma unroll
    for (int r = 0; r < 4; r++) {
      float sq = o[mc][0][r] * o[mc][0][r] + o[mc][1][r] * o[mc][1][r];
#pragma unroll
      for (int off = 1; off < 16; off <<= 1) sq += __shfl_xor(sq, off);
      if (l15 == 0) s.ssq[w][16 * mc + 4 * g + r] = sq;
    }
  __syncthreads();
#pragma unroll
  for (int mc = 0; mc < 4; mc++)
#pragma unroll
    for (int r = 0; r < 4; r++) {
      const int c = 16 * mc + 4 * g + r;
      const float tot = s.ssq[0][c] + s.ssq[1][c] + s.ssq[2][c] + s.ssq[3][c];
      const float rs = rsqrtf(tot * (1.f / 128.f) + EPSV);
      s.ob[c * OLD + 32 * w + l15] = f2bf(o[mc][0][r] * rs * gnw0);
      s.ob[c * OLD + 32 * w + 16 + l15] = f2bf(o[mc][1][r] * rs * gnw1);
    }
  __syncthreads();
  {
    const int t0 = b * SEQ + n * 64;
    const int c0 = tid >> 4, ch = tid & 15;
    const u16* zp = p.proj + (size_t)(t0 + c0) * PROJW + 1536 + h * 128 + ch * 8;
    u16* op = p.actA + (size_t)(t0 + c0) * DM + h * 128 + ch * 8;
#pragma unroll
    for (int i = 0; i < 4; i++) {
      float ov[8], zv[8];
      unpack8(*(const uint4*)&s.ob[(c0 + 16 * i) * OLD + ch * 8], ov);
      unpack8(*(const uint4*)(zp + (size_t)i * 16 * PROJW), zv);
      uint4 r;
      r.x = pack2(ov[0] * siluf(zv[0]), ov[1] * siluf(zv[1])); r.y = pack2(ov[2] * siluf(zv[2]), ov[3] * siluf(zv[3]));
      r.z = pack2(ov[4] * siluf(zv[4]), ov[5] * siluf(zv[5])); r.w = pack2(ov[6] * siluf(zv[6]), ov[7] * siluf(zv[7]));
      *(uint4*)(op + (size_t)i * 16 * DM) = r;
    }
  }
}

__device__ void phase_gout(const P& p, unsigned char* smem) {
  GoutSmem& s = *(GoutSmem*)smem;
  for (int u = blockIdx.x; u < 1024; u += gridDim.x) gout_unit(p, u, s);
}

#define LOG2E 1.4426950408889634f
#define ANST 4
struct AttnSmem { u16 k[ANST][64 * 64 + 128]; u16 v[ANST][64 * 64]; };

__device__ void attn_unit(const P& p, int item, AttnSmem& s) {
  int tid = threadIdx.x;
  asm volatile("" : "+v"(tid));
  const int lane = tid & 63, w = tid >> 6;
  const int l15 = lane & 15, g = lane >> 4;
  const int qb = 15 - (item >> 6), bhf = item & 63;
  const int b = bhf >> 3, hf = bhf & 7;
  const int q0 = qb * 128 + 32 * w;
  const u16* qbase = p.proj + (size_t)(b * SEQ) * PROJW + 2048 + hf * 64;
  const u16* kbase = p.proj + (size_t)(b * SEQ) * PROJW + 2560 + hf * 64;
  const u16* vbase = p.vt + (size_t)bhf * 64 * SEQ;
  const float* cfb = p.cf + (size_t)bhf * SEQ;
  bf16x8 qf[2][2];
#pragma unroll
  for (int mi = 0; mi < 2; mi++)
#pragma unroll
    for (int ks = 0; ks < 2; ks++) qf[mi][ks] = *(const bf16x8*)&qbase[(size_t)(q0 + 16 * mi + l15) * PROJW + ks * 32 + g * 8];
  float cq[2], m[2], lsum[2];
  f32x4 O[2][4];
#pragma unroll
  for (int mi = 0; mi < 2; mi++) {
    cq[mi] = cfb[q0 + 16 * mi + l15]; m[mi] = -1e30f; lsum[mi] = 0.f;
#pragma unroll
    for (int nd = 0; nd < 4; nd++) O[mi][nd] = (f32x4){0.f, 0.f, 0.f, 0.f};
  }
  asm volatile("" :: "v"(cq[0]), "v"(cq[1]), "v"(qf[0][0]), "v"(qf[0][1]), "v"(qf[1][0]), "v"(qf[1][1]));
  const int ntile = (q0 + 32 + 63) >> 6;
  const int ntile_blk = 2 * qb + 2;
  const int drow = 8 * w + (lane >> 3);
  const int dchunk = (lane & 7) ^ ((4 * (w & 1) + (lane >> 4)) & 7);
  const u16* kg = kbase + (size_t)drow * PROJW + dchunk * 8;
  const u16* vg = vbase + (size_t)drow * SEQ + dchunk * 8;
  const float* cg_ = cfb + lane;
  u16* const skw = &s.k[0][0] + (8 * w) * 64;
  u16* const svw = &s.v[0][0] + (8 * w) * 64;
#define A_DMA(st, kk0) do { \
    u16* _dk = skw + (st) * (64 * 64 + 128); u16* _dv = svw + (st) * (64 * 64); \
    __builtin_amdgcn_global_load_lds((const unsigned*)(kg + (size_t)(kk0) * PROJW), (unsigned*)(_dk), 16, 0, 0); \
    __builtin_amdgcn_global_load_lds((const unsigned*)(kg + (size_t)((kk0) + 32) * PROJW), (unsigned*)(_dk + 32 * 64), 16, 0, 0); \
    __builtin_amdgcn_global_load_lds((const unsigned*)(vg + (kk0)), (unsigned*)(_dv), 16, 0, 0); \
    __builtin_amdgcn_global_load_lds((const unsigned*)(vg + (size_t)32 * SEQ + (kk0)), (unsigned*)(_dv + 32 * 64), 16, 0, 0); \
    __builtin_amdgcn_global_load_lds((const unsigned*)(cg_ + (kk0)), (unsigned*)(&s.k[0][0] + (st) * (64 * 64 + 128) + 64 * 64), 4, 0, 0); \
  } while (0)
  {
    const int npro = (ntile_blk > 2) ? 3 : 2;
#pragma unroll 1
    for (int j = 0; j < npro; j++) A_DMA(j, j * 64);
  }
  int ko[4][2];
#pragma unroll
  for (int t = 0; t < 4; t++) {
    const int row = 32 * (t >> 1) + 8 * (l15 >> 2) + 4 * (t & 1) + (l15 & 3);
    const int sw = (row >> 1) & 7;
    ko[t][0] = row * 64 + ((g ^ sw) * 8);
    ko[t][1] = row * 64 + (((4 + g) ^ sw) * 8);
  }
  const int swz = l15 >> 1;
  int vo[2];
  vo[0] = l15 * 64 + ((g ^ swz) * 8);
  vo[1] = l15 * 64 + (((4 + g) ^ swz) * 8);
#pragma unroll 1
  for (int kt = 0; kt < ntile_blk; kt++) {
    const int k0 = kt * 64, st = kt & 3;
    const int rem = ntile_blk - 1 - kt;
    if (rem >= 2) asm volatile("s_waitcnt vmcnt(10)" ::: "memory");
    else if (rem == 1) asm volatile("s_waitcnt vmcnt(5)" ::: "memory");
    else asm volatile("s_waitcnt vmcnt(0)" ::: "memory");
    asm volatile("s_waitcnt lgkmcnt(0)" ::: "memory");
    __builtin_amdgcn_s_barrier();
    asm volatile("" ::: "memory");
    if (kt + 3 < ntile_blk) { const int st3 = (kt + 3) & 3; A_DMA(st3, k0 + 192); }
    if (kt < ntile) {
      const u16* Ks = s.k[st];
      const u16* Vs = s.v[st];
      f32x4 ST[2][4];
#pragma unroll
      for (int t = 0; t < 4; t++) {
        const bf16x8 kf0 = *(const bf16x8*)&Ks[ko[t][0]];
        const bf16x8 kf1 = *(const bf16x8*)&Ks[ko[t][1]];
#pragma unroll
        for (int mi = 0; mi < 2; mi++) {
          f32x4 acc = {0.f, 0.f, 0.f, 0.f};
          acc = mfma16(kf0, qf[mi][0], acc);
          acc = mfma16(kf1, qf[mi][1], acc);
          ST[mi][t] = acc;
        }
      }
      f32x4 ck[4];
      {
        const unsigned cka = (unsigned)(size_t)(&Ks[64 * 64]) + 32u * g;
        asm volatile("ds_read_b128 %0, %4\n\tds_read_b128 %1, %4 offset:16\n\tds_read_b128 %2, %4 offset:128\n\t"
                     "ds_read_b128 %3, %4 offset:144\n\ts_waitcnt lgkmcnt(0)"
                     : "=&v"(ck[0]), "=&v"(ck[1]), "=&v"(ck[2]), "=&v"(ck[3]) : "v"(cka) : "memory");
      }
      const bool diag = (kt == ntile - 1);
      bf16x8 pf[2][2];
#pragma unroll
      for (int mi = 0; mi < 2; mi++) {
        const int qpos = q0 + 16 * mi + l15;
        float mx = -1e30f;
#pragma unroll
        for (int t = 0; t < 4; t++) {
          const float ckv[4] = {ck[t][0], ck[t][1], ck[t][2], ck[t][3]};
#pragma unroll
          for (int r = 0; r < 4; r++) {
            float lg = ST[mi][t][r] * (0.125f * LOG2E) + (cq[mi] - ckv[r]) * LOG2E;
            if (diag && (k0 + 32 * (t >> 1) + 8 * g + 4 * (t & 1) + r > qpos)) lg = -1e30f;
            ST[mi][t][r] = lg;
            mx = fmaxf(mx, lg);
          }
        }
        mx = fmaxf(mx, __shfl_xor(mx, 16));
        mx = fmaxf(mx, __shfl_xor(mx, 32));
        const float mn = fmaxf(m[mi], mx);
        const float alpha = __builtin_amdgcn_exp2f(m[mi] - mn);
        m[mi] = mn;
        float ps = 0.f;
#pragma unroll
        for (int t = 0; t < 4; t++)
#pragma unroll
          for (int r = 0; r < 4; r++) {
            const float pe = __builtin_amdgcn_exp2f(ST[mi][t][r] - mn);
            ST[mi][t][r] = pe;
            ps += pe;
          }
        lsum[mi] = lsum[mi] * alpha + ps;
#pragma unroll
        for (int kk = 0; kk < 2; kk++) {
          uint4 pk;
          pk.x = pack2(ST[mi][2 * kk][0], ST[mi][2 * kk][1]); pk.y = pack2(ST[mi][2 * kk][2], ST[mi][2 * kk][3]);
          pk.z = pack2(ST[mi][2 * kk + 1][0], ST[mi][2 * kk + 1][1]); pk.w = pack2(ST[mi][2 * kk + 1][2], ST[mi][2 * kk + 1][3]);
          pf[mi][kk] = __builtin_bit_cast(bf16x8, pk);
        }
#pragma unroll
        for (int r = 0; r < 4; r++) {
          const float ar = __shfl(alpha, 4 * g + r);
#pragma unroll
          for (int nd = 0; nd < 4; nd++) O[mi][nd][r] *= ar;
        }
      }
#pragma unroll
      for (int nd = 0; nd < 4; nd++)
#pragma unroll
        for (int kk = 0; kk < 2; kk++) {
          const bf16x8 vf = *(const bf16x8*)&Vs[16 * nd * 64 + vo[kk]];
          O[0][nd] = mfma16(pf[0][kk], vf, O[0][nd]);
          O[1][nd] = mfma16(pf[1][kk], vf, O[1][nd]);
        }
    }
  }
#pragma unroll
  for (int mi = 0; mi < 2; mi++) {
    float l = lsum[mi];
    l += __shfl_xor(l, 16);
    l += __shfl_xor(l, 32);
    const float inv = 1.f / l;
#pragma unroll
    for (int r = 0; r < 4; r++) {
      const float ir = __shfl(inv, 4 * g + r);
      const int t = b * SEQ + q0 + 16 * mi + 4 * g + r;
#pragma unroll
      for (int nd = 0; nd < 4; nd++) p.actA[(size_t)t * DM + 512 + hf * 64 + 16 * nd + l15] = f2bf(O[mi][nd][r] * ir);
    }
  }
}

__device__ void deferred_transpose(const P& p, int it, float* tile) {
  const int n1 = 16 * 16, n2 = n1 + 16 * 88, n3 = n2 + 44 * 16, n4 = n3 + 16 * 16;
  if (it < n1) { transpose_item(p.w_out, 1024, p.wt_out, 1024, it % 16, it / 16, 1, tile); }
  else if (it < n2) { int j = it - n1; transpose_item(p.w_gate_up, 2 * DFF, p.wt_gu, 1024, j % 16, j / 16, 2, tile, p.ffn_norm_w); }
  else if (it < n3) { int j = it - n2; transpose_item(p.w_down, 1024, p.wt_down, DFF, j % 44, j / 44, 1, tile); }
  else if (it < n4) { int j = it - n3; transpose_item(p.w_ple_gate, 1024, p.wt_pg, 1024, j % 16, j / 16, 1, tile, p.ple_norm_w); }
  else { int j = it - n4; transpose_item(p.w_ple_proj, 1024, p.wt_pp, 256, j % 4, j / 4, 1, tile); }
}
#define N_DEFER (16 * 16 + 16 * 88 + 44 * 16 + 16 * 16 + 4 * 16)

__device__ void phase_mixer(const P& p, unsigned char* smem, int rr) {
  volatile int* s_item_p = (volatile int*)(smem + SMEM_MAIN + 16);
  for (;;) {
    __syncthreads();
    if (threadIdx.x == 0) *s_item_p = (int)atomicAdd(&p.counters[rr], 1u);
    __syncthreads();
    const int item = *s_item_p;
    if (item >= NSCAN + 1024 + N_DEFER) break;
    if (item < NSCAN) { scan_unit(p, item, *(ScanSmem*)smem); }
    else if (item < NSCAN + 1024) { attn_unit(p, item - NSCAN, *(AttnSmem*)smem); }
    else { deferred_transpose(p, item - NSCAN - 1024, (float*)smem); }
  }
}

#define XB_TMO      128
#define XB_XCNT(j)  (256  + 64 * (j))
#define XB_XSUB(j)  (1280 + 64 * (j))
#define XB_XGEN(j)  (2304 + 64 * (j))
#define XB_TOP      3328
#define XB_TOPGEN   3392
#define XCD_BAR_WORDS 3456
#define XB_SPIN_CAP (1u << 20)
#define LAS __attribute__((address_space(3)))
__device__ __forceinline__ unsigned xb_ld(unsigned* p) { return __hip_atomic_load(p, __ATOMIC_RELAXED, __HIP_MEMORY_SCOPE_AGENT); }
__device__ __forceinline__ unsigned xb_add(unsigned* p, unsigned v) { return __hip_atomic_fetch_add(p, v, __ATOMIC_RELAXED, __HIP_MEMORY_SCOPE_AGENT); }
__device__ __forceinline__ unsigned xb_xcc_id() { return (unsigned)__builtin_amdgcn_s_getreg((3 << 11) | 20) & 0xFu; }
#define XB_SPIN(cond, bar) do { unsigned _sp = 0; while (cond) { __builtin_amdgcn_s_sleep(1); \
    if ((++_sp & 255u) == 0u) { if (xb_ld(&(bar)[XB_TMO])) break; if (_sp > XB_SPIN_CAP) { atomicAdd(&(bar)[XB_TMO], 1u); break; } } } } while (0)
struct XcdBarrier { unsigned* bar; unsigned x; volatile LAS unsigned* st; };
__device__ __forceinline__ XcdBarrier xcd_barrier_post(unsigned* bar, volatile LAS unsigned* st) {
  XcdBarrier b; b.bar = bar; b.x = xb_xcc_id(); b.st = st;
  if (threadIdx.x == 0) (void)xb_add(&bar[XB_XCNT(b.x)], 1u);
  return b;
}
__device__ __forceinline__ void xcd_barrier_complete(unsigned* bar, unsigned x, unsigned& nloc, unsigned& nx) {
  const unsigned G = gridDim.x * gridDim.y * gridDim.z;
  unsigned sum, cnt, mine, sp = 0u;
  for (;;) {
    sum = 0u; cnt = 0u; mine = 0u;
#pragma unroll
    for (unsigned j = 0; j < 16; ++j) { const unsigned c = xb_ld(&bar[XB_XCNT(j)]); sum += c; cnt += (c > 0u) ? 1u : 0u; mine = (j == x) ? c : mine; }
    if (sum == G) break;
    __builtin_amdgcn_s_sleep(1);
    if ((++sp & 255u) == 0u) { if (xb_ld(&bar[XB_TMO])) break; if (sp > XB_SPIN_CAP) { atomicAdd(&bar[XB_TMO], 1u); break; } }
  }
  nloc = mine > 0u ? mine : 1u; nx = cnt > 0u ? cnt : 1u;
}
__device__ __forceinline__ void xcd_barrier(const XcdBarrier& b) {
  asm volatile("s_waitcnt vmcnt(0)" ::: "memory");
  __syncthreads();
  if (threadIdx.x == 0) {
    unsigned* bar = b.bar;
    __builtin_amdgcn_s_waitcnt(0);
    unsigned nloc = b.st[0], nx = b.st[1];
    if (nloc == 0u) { xcd_barrier_complete(bar, b.x, nloc, nx); b.st[0] = nloc; b.st[1] = nx; }
    const unsigned old = xb_add(&bar[XB_XSUB(b.x)], 1u);
    const unsigned gen = old / nloc;
    if (old + 1u == (gen + 1u) * nloc) {
      __builtin_amdgcn_fence(__ATOMIC_RELEASE, "agent");
      asm volatile("s_waitcnt vmcnt(0)" ::: "memory");
      const unsigned og = xb_add(&bar[XB_TOP], 1u);
      const unsigned tg = og / nx;
      if (og + 1u == (tg + 1u) * nx) xb_add(&bar[XB_TOPGEN], 1u);
      else XB_SPIN(xb_ld(&bar[XB_TOPGEN]) == tg, bar);
      __builtin_amdgcn_fence(__ATOMIC_ACQUIRE, "agent");
      xb_add(&bar[XB_XGEN(b.x)], 1u);
      asm volatile("s_waitcnt vmcnt(0)" ::: "memory");
    } else {
      XB_SPIN(xb_ld(&bar[XB_XGEN(b.x)]) == gen, bar);
      __builtin_amdgcn_fence(__ATOMIC_ACQUIRE, "agent");
      asm volatile("s_waitcnt vmcnt(0)" ::: "memory");
    }
  }
  __syncthreads();
}

__global__ void __launch_bounds__(256, 2) mega(P p, int lo, int hi) {
  __shared__ __attribute__((aligned(16))) unsigned char smem[SMEM_MAIN + 32];
  cg::grid_group grid = cg::this_grid();
  uint4* xbw = (uint4*)(smem + SMEM_MAIN);
  if (threadIdx.x == 0) *xbw = make_uint4(0u, 0u, 0u, 0u);
  __syncthreads();
  XcdBarrier xb = xcd_barrier_post(p.bar, (volatile LAS unsigned*)xbw);
  if (hi < 0) grid.sync();
#define SEAM(k) if (lo <= k && k + 1 < hi) xcd_barrier(xb);
#if !defined(ONLY) || ONLY == 0
  if (lo <= 0 && 0 < hi) phase_prep(p, smem);
#endif
  SEAM(0)
#if !defined(ONLY) || ONLY == 1
  if (lo <= 1 && 1 < hi) phase_inproj(p, smem);
#endif
  SEAM(1)
#if !defined(ONLY) || ONLY == 2
  if (lo <= 2 && 2 < hi) phase_gdnprep(p, smem);
#endif
  SEAM(2)
#if !defined(ONLY) || ONLY == 3
  if (lo <= 3 && 3 < hi) phase_mixer(p, smem, 0);
#endif
  SEAM(3)
#if !defined(ONLY) || ONLY == 4
  if (lo <= 4 && 4 < hi) phase_gout(p, smem);
#endif
  SEAM(4)
#if !defined(ONLY) || ONLY == 5
  if (lo <= 5 && 5 < hi) phase_outproj(p, smem);
#endif
  SEAM(5)
#if !defined(ONLY) || ONLY == 6
  if (lo <= 6 && 6 < hi) phase_gateup(p, smem);
#endif
  SEAM(6)
#if !defined(ONLY) || ONLY == 7
  if (lo <= 7 && 7 < hi) phase_down(p, smem);
#endif
  SEAM(7)
#if !defined(ONLY) || ONLY == 8
  if (lo <= 8 && 8 < hi) phase_ple(p, smem);
#endif
  SEAM(8)
  if (lo <= 9 && 9 < hi) phase_final(p);
}

static_assert(sizeof(GemmSmem) <= SMEM_MAIN && sizeof(Gemm2Smem) <= SMEM_MAIN && sizeof(GdnSmem) <= SMEM_MAIN && sizeof(ScanSmem) <= SMEM_MAIN &&
              sizeof(GoutSmem) <= SMEM_MAIN && sizeof(AttnSmem) <= SMEM_MAIN && 64 * 65 * 4 <= SMEM_MAIN, "smem");

extern "C" void kernel_launch(void* const* d_in, const int* in_sizes, int n_in, void* d_out, int out_size,
                              void* d_ws, size_t ws_size, hipStream_t stream) {
  static int grid_blocks = 0;
  if (!grid_blocks) {
    int dev = 0, cus = 0, per_cu = 0;
    hipGetDevice(&dev);
    hipDeviceGetAttribute(&cus, hipDeviceAttributeMultiprocessorCount, dev);
    hipOccupancyMaxActiveBlocksPerMultiprocessor(&per_cu, mega, 256, 0);
    if (per_cu > 2) per_cu = 2;
    if (per_cu < 1) per_cu = 1;
    grid_blocks = cus * per_cu;
  }
  P p{};
  const float* const* in = (const float* const*)d_in;
  p.x = in[0]; p.p = in[1]; p.attn_norm_w = in[2]; p.w_in = in[3]; p.conv_w = in[4]; p.a_log = in[5];
  p.dt_bias = in[6]; p.gdn_norm_w = in[7]; p.fox_f_bias = in[8]; p.w_out = in[9]; p.ffn_norm_w = in[10];
  p.w_gate_up = in[11]; p.w_down = in[12]; p.ple_norm_w = in[13]; p.w_ple_gate = in[14]; p.w_ple_proj = in[15];
  p.final_norm_w = in[16];
  p.h = (float*)d_out;
  unsigned char* ws = (unsigned char*)d_ws;
  size_t off = 0;
  auto take = [&](size_t bytes) { unsigned char* r = ws + off; off += (bytes + 255) & ~(size_t)255; return r; };
  p.counters = (unsigned*)take(256);
  p.bar = (unsigned*)take(XCD_BAR_WORDS * 4);
  p.wt_in = (u16*)take((size_t)NIN_PAD * 1024 * 2);
  p.wt_out = (u16*)take((size_t)1024 * 1024 * 2);
  p.wt_gu = (u16*)take((size_t)2 * DFF * 1024 * 2);
  p.wt_down = (u16*)take((size_t)1024 * DFF * 2);
  p.wt_pg = (u16*)take((size_t)1024 * 1024 * 2);
  p.wt_pp = (u16*)take((size_t)1024 * 256 * 2);
  p.actA = (u16*)take((size_t)NTOK * 1024 * 2);
  p.pb = (u16*)take((size_t)NTOK * 256 * 2);
  p.proj = (u16*)take((size_t)NTOK * PROJW * 2);
  p.vt = (u16*)take((size_t)64 * 64 * SEQ * 2);
  p.gates = (float*)take((size_t)NTOK * 16 * 4);
  p.cf = (float*)take((size_t)64 * SEQ * 4);
  p.gM = (u16*)take((size_t)1024 * 16384 * 2);
  p.gC = (u16*)take((size_t)1024 * 16384 * 2);
  p.gdl = (float*)take(1024 * 4);
  p.rss = (float*)take((size_t)3 * NTOK * 4);
  p.hb = p.gM;
  if (off > ws_size) fprintf(stderr, "workspace too small: need %zu have %zu\n", off, ws_size);
  u16* ob = (u16*)d_out;
  p.gS = ob;
  p.gQ = ob + (size_t)1024 * 16384;
  p.gO = ob + (size_t)1024 * 16384 + (size_t)1024 * 8192;
  hipMemsetAsync(p.bar, 0, XCD_BAR_WORDS * 4, stream);
  int lo = 0, hi = NPHASE;
  void* args[] = {&p, &lo, &hi};
  hipError_t e = hipLaunchCooperativeKernel((void*)mega, dim3(grid_blocks), dim3(256), args, 0, stream);
  if (e != hipSuccess) fprintf(stderr, "cooperative launch failed: %s (grid %d)\n", hipGetErrorString(e), grid_blocks);
}
```

```cpp
#include <hip/hip_runtime.h>
#include <hip/hip_cooperative_groups.h>
#include <cstdio>
#include <cstdint>
namespace cg = cooperative_groups;

typedef unsigned short u16;
typedef __attribute__((ext_vector_type(8))) short bf16x8;
typedef __attribute__((ext_vector_type(4))) float f32x4;

#define NTOK 16384
#define SEQ 2048
#define DM 1024
#define DFF 2816
#define PROJW 3072
#define NIN_PAD 3712
#define EPSV 1e-6f
#define NPHASE 10
#define SMEM_MAIN 73728

struct P {
  const float *x, *p, *attn_norm_w, *w_in, *conv_w, *a_log, *dt_bias, *gdn_norm_w, *fox_f_bias, *w_out,
      *ffn_norm_w, *w_gate_up, *w_down, *ple_norm_w, *w_ple_gate, *w_ple_proj, *final_norm_w;
  float* h;
  u16 *wt_in, *wt_out, *wt_gu, *wt_down, *wt_pg, *wt_pp;
  u16 *actA;
  u16 *pb;
  u16 *proj;
  u16 *vt;
  float *gates;
  float *cf;
  u16 *gM, *gC;
  u16 *gQ, *gO;
  u16 *gS;
  float *gdl;
  unsigned *counters;
  unsigned *bar;
  u16 *hb;
  float *rss;
};

typedef __attribute__((ext_vector_type(2))) float f32x2_t;
typedef __attribute__((ext_vector_type(2))) __bf16 bf16x2_t;
__device__ __forceinline__ u16 f2bf(float f) { return __builtin_bit_cast(u16, (__bf16)f); }
__device__ __forceinline__ float bf2f(u16 h) { return __uint_as_float(((unsigned)h) << 16); }
__device__ __forceinline__ unsigned pack2(float a, float b) {
  f32x2_t f = {a, b};
  return __builtin_bit_cast(unsigned, __builtin_convertvector(f, bf16x2_t));
}
__device__ __forceinline__ float siluf(float v) { return v / (1.f + __expf(-v)); }
__device__ __forceinline__ float sigmoidf_(float v) { return 1.f / (1.f + __expf(-v)); }
__device__ __forceinline__ f32x4 mfma16(bf16x8 a, bf16x8 b, f32x4 c) {
  return __builtin_amdgcn_mfma_f32_16x16x32_bf16(a, b, c, 0, 0, 0);
}
#define LDS_FENCE() asm volatile("s_waitcnt lgkmcnt(0)" ::: "memory")

__device__ __forceinline__ void unpack8(const uint4& v, float (&f)[8]) {
  f[0] = bf2f((u16)(v.x & 0xffffu)); f[1] = bf2f((u16)(v.x >> 16));
  f[2] = bf2f((u16)(v.y & 0xffffu)); f[3] = bf2f((u16)(v.y >> 16));
  f[4] = bf2f((u16)(v.z & 0xffffu)); f[5] = bf2f((u16)(v.z >> 16));
  f[6] = bf2f((u16)(v.w & 0xffffu)); f[7] = bf2f((u16)(v.w >> 16));
}
__device__ __forceinline__ void unpack4(const uint2& v, float (&f)[4]) {
  f[0] = bf2f((u16)(v.x & 0xffffu)); f[1] = bf2f((u16)(v.x >> 16));
  f[2] = bf2f((u16)(v.y & 0xffffu)); f[3] = bf2f((u16)(v.y >> 16));
}


__device__ __forceinline__ int colmap(int kind, int nn) {
  if (kind == 0) {
    if (nn < 2048) return nn;
    if (nn < 3584) return nn + 8;
    if (nn < 3588) return 2048 + (nn - 3584);
    if (nn < 3592) return 2052 + (nn - 3588);
    if (nn < 3600) return nn;
    return -1;
  } else if (kind == 2) {
    int i = nn >> 7, wc = (nn >> 6) & 1, u = (nn >> 5) & 1, j = nn & 31;
    return u * DFF + 64 * i + 32 * wc + j;
  }
  return nn;
}

__device__ void transpose_item(const float* __restrict__ src, int ldsrc, u16* __restrict__ dst, int K,
                               int kt, int nt, int kind, float* tile, const float* __restrict__ kscale = nullptr) {
  int tid = threadIdx.x;
  asm volatile("" : "+v"(tid));
  const int c = tid & 63, r0 = tid >> 6;
  const int ncol = colmap(kind, nt * 64 + c);
  float tv[16];
#pragma unroll
  for (int i = 0; i < 16; i++) {
    int r = r0 + 4 * i;
    tv[i] = (ncol >= 0) ? __builtin_nontemporal_load(&src[(size_t)(kt * 64 + r) * ldsrc + ncol]) : 0.f;
  }
  if (kscale) {
#pragma unroll
    for (int i = 0; i < 16; i++) tv[i] *= kscale[kt * 64 + r0 + 4 * i];
  }
#pragma unroll
  for (int i = 0; i < 16; i++) tile[(r0 + 4 * i) * 65 + c] = tv[i];
  __syncthreads();
#pragma unroll 8
  for (int i = 0; i < 16; i++) {
    int rn = r0 + 4 * i;
    dst[(size_t)(nt * 64 + rn) * K + kt * 64 + c] = f2bf(tile[c * 65 + rn]);
  }
  __syncthreads();
}

__device__ __forceinline__ void rmsnorm_row(const float* src, const float* __restrict__ w,
                                            u16* dstb, float* dstf, int row) {
  const int lane = threadIdx.x & 63;
  float4 v[4];
  float ss = 0.f;
#pragma unroll
  for (int i = 0; i < 4; i++) {
    v[i] = *(const float4*)&src[(size_t)row * DM + i * 256 + lane * 4];
    ss += v[i].x * v[i].x + v[i].y * v[i].y + v[i].z * v[i].z + v[i].w * v[i].w;
  }
#pragma unroll
  for (int off = 32; off >= 1; off >>= 1) ss += __shfl_xor(ss, off);
  const float r = rsqrtf(ss * (1.f / DM) + EPSV);
#pragma unroll
  for (int i = 0; i < 4; i++) {
    const int col = i * 256 + lane * 4;
    float4 wv = *(const float4*)&w[col];
    float y0 = v[i].x * r * wv.x, y1 = v[i].y * r * wv.y, y2 = v[i].z * r * wv.z, y3 = v[i].w * r * wv.w;
    if (dstb) {
      uint2 o; o.x = pack2(y0, y1); o.y = pack2(y2, y3);
      *(uint2*)&dstb[(size_t)row * DM + col] = o;
    } else {
      *(float4*)&dstf[(size_t)row * DM + col] = make_float4(y0, y1, y2, y3);
    }
  }
}

__device__ void phase_prep(const P& p, unsigned char* smem) {
  float* tile = (float*)smem;
  if (blockIdx.x == 0 && threadIdx.x < 16) p.counters[threadIdx.x] = 0u;
  for (int i = blockIdx.x * 256 + threadIdx.x; i < 3 * NTOK; i += gridDim.x * 256) p.rss[i] = 0.f;
  for (int it = blockIdx.x; it < 16 * 58; it += gridDim.x) transpose_item(p.w_in, 3600, p.wt_in, 1024, it % 16, it / 16, 0, tile);
  const int wave = threadIdx.x >> 6, lane = threadIdx.x & 63;
  for (int rb = blockIdx.x; rb < NTOK / 8; rb += gridDim.x) {
    const int row = rb * 8 + wave * 2;
    float4 v0[4], v1[4];
#pragma unroll
    for (int i = 0; i < 4; i++) {
      { const f32x4 t0 = __builtin_nontemporal_load((const f32x4*)&p.x[(size_t)row * DM + i * 256 + lane * 4]);
        const f32x4 t1 = __builtin_nontemporal_load((const f32x4*)&p.x[(size_t)(row + 1) * DM + i * 256 + lane * 4]);
        v0[i] = make_float4(t0[0], t0[1], t0[2], t0[3]); v1[i] = make_float4(t1[0], t1[1], t1[2], t1[3]); }
    }
    const float4 pv0 = *(const float4*)&p.p[(size_t)row * 256 + lane * 4];
    const float4 pv1 = *(const float4*)&p.p[(size_t)(row + 1) * 256 + lane * 4];
    float s0 = 0.f, s1 = 0.f;
#pragma unroll
    for (int i = 0; i < 4; i++) {
      s0 += v0[i].x * v0[i].x + v0[i].y * v0[i].y + v0[i].z * v0[i].z + v0[i].w * v0[i].w;
      s1 += v1[i].x * v1[i].x + v1[i].y * v1[i].y + v1[i].z * v1[i].z + v1[i].w * v1[i].w;
    }
#pragma unroll
    for (int off = 32; off >= 1; off >>= 1) { s0 += __shfl_xor(s0, off); s1 += __shfl_xor(s1, off); }
    const float r0 = rsqrtf(s0 * (1.f / DM) + EPSV), r1 = rsqrtf(s1 * (1.f / DM) + EPSV);
#pragma unroll
    for (int i = 0; i < 4; i++) {
      const int col = i * 256 + lane * 4;
      const float4 wv = *(const float4*)&p.attn_norm_w[col];
      uint2 o;
      o.x = pack2(v0[i].x * r0 * wv.x, v0[i].y * r0 * wv.y); o.y = pack2(v0[i].z * r0 * wv.z, v0[i].w * r0 * wv.w);
      *(uint2*)&p.actA[(size_t)row * DM + col] = o;
      o.x = pack2(v1[i].x * r1 * wv.x, v1[i].y * r1 * wv.y); o.y = pack2(v1[i].z * r1 * wv.z, v1[i].w * r1 * wv.w);
      *(uint2*)&p.actA[(size_t)(row + 1) * DM + col] = o;
    }
    uint2 o; o.x = pack2(pv0.x, pv0.y); o.y = pack2(pv0.z, pv0.w);
    *(uint2*)&p.pb[(size_t)row * 256 + lane * 4] = o;
    o.x = pack2(pv1.x, pv1.y); o.y = pack2(pv1.z, pv1.w);
    *(uint2*)&p.pb[(size_t)(row + 1) * 256 + lane * 4] = o;
  }
}

__device__ void phase_rmsnorm(const float* src, const float* w, u16* dstb, float* dstf) {
  const int wave = threadIdx.x >> 6;
  for (int rb = blockIdx.x; rb < NTOK / 4; rb += gridDim.x) rmsnorm_row(src, w, dstb, dstf, rb * 4 + wave);
}

__device__ void phase_final(const P& p) {
  const int wave = threadIdx.x >> 6, lane = threadIdx.x & 63;
  for (int rb = blockIdx.x; rb < NTOK / 4; rb += gridDim.x) {
    const int row = rb * 4 + wave;
    const float r = rsqrtf(p.rss[2 * NTOK + row] * (1.f / DM) + EPSV);
#pragma unroll
    for (int i = 0; i < 4; i++) {
      const int col = i * 256 + lane * 4;
      float4 v = *(const float4*)&p.h[(size_t)row * DM + col];
      const float4 wv = *(const float4*)&p.final_norm_w[col];
      f32x4 o = {v.x * r * wv.x, v.y * r * wv.y, v.z * r * wv.z, v.w * r * wv.w};
      __builtin_nontemporal_store(o, (f32x4*)&p.h[(size_t)row * DM + col]);
    }
  }
}

#define GK 64
struct GemmSmem { u16 a[2][128 * GK]; u16 b[2][128 * GK]; };

template <bool SWAP>
__device__ __forceinline__ void gemm_tile(const u16* __restrict__ A, int lda, const u16* __restrict__ Bt, int ldb,
                                          int K, int m0, int n0, GemmSmem& s, f32x4 (&acc)[4][4]) {
  int tid = threadIdx.x;
  asm volatile("" : "+v"(tid));
  const int lane = tid & 63, wave = tid >> 6;
  const int wr = wave >> 1, wc = wave & 1;
  const int l15 = lane & 15, g = lane >> 4;
  const int nk = K / GK;
  const int drow = 8 * wave + (lane >> 3);
  const int dchunk = (lane & 7) ^ ((4 * (wave & 1) + (lane >> 4)) & 7);
  const u16* Ap = A + (size_t)(m0 + drow) * lda + dchunk * 8;
  const u16* Bp = Bt + (size_t)(n0 + drow) * ldb + dchunk * 8;
  const size_t sa = (size_t)32 * lda, sb = (size_t)32 * ldb;
#define G_DMA(bufi, koff) do { \
    _Pragma("unroll") for (int _i = 0; _i < 4; _i++) { \
      __builtin_amdgcn_global_load_lds((const unsigned*)(Ap + _i * sa + (koff)), (unsigned*)&s.a[bufi][(32 * _i + 8 * wave) * GK], 16, 0, 0); \
      __builtin_amdgcn_global_load_lds((const unsigned*)(Bp + _i * sb + (koff)), (unsigned*)&s.b[bufi][(32 * _i + 8 * wave) * GK], 16, 0, 0); \
    } } while (0)
  const int fo0 = l15 * GK + ((g ^ (l15 >> 1)) * 8);
  const int fo1 = l15 * GK + (((4 + g) ^ (l15 >> 1)) * 8);
  G_DMA(0, 0);
  asm volatile("s_waitcnt vmcnt(0)" ::: "memory");
  __builtin_amdgcn_s_barrier();
  asm volatile("" ::: "memory");
  for (int kt = 0; kt < nk; kt++) {
    const int buf = kt & 1;
    if (kt + 1 < nk) { if (buf) G_DMA(0, (kt + 1) * GK); else G_DMA(1, (kt + 1) * GK); }
    const u16* sa_ = &s.a[buf][(wr * 64) * GK];
    const u16* sb_ = &s.b[buf][(wc * 64) * GK];
#pragma unroll
    for (int ks = 0; ks < 2; ks++) {
      const int fo = ks ? fo1 : fo0;
      bf16x8 af[4], bfr[4];
#pragma unroll
      for (int mi = 0; mi < 4; mi++) af[mi] = *(const bf16x8*)&sa_[mi * 16 * GK + fo];
#pragma unroll
      for (int ni = 0; ni < 4; ni++) bfr[ni] = *(const bf16x8*)&sb_[ni * 16 * GK + fo];
#pragma unroll
      for (int mi = 0; mi < 4; mi++)
#pragma unroll
        for (int ni = 0; ni < 4; ni++) acc[mi][ni] = SWAP ? mfma16(bfr[ni], af[mi], acc[mi][ni]) : mfma16(af[mi], bfr[ni], acc[mi][ni]);
    }
    asm volatile("s_waitcnt vmcnt(0) lgkmcnt(0)" ::: "memory");
    __builtin_amdgcn_s_barrier();
    asm volatile("" ::: "memory");
  }
}


#define G2K 32
struct Gemm2Smem { u16 a[3][256 * G2K]; u16 b[3][128 * G2K]; };

template <bool SWAP>
__device__ __forceinline__ void gemm256(const u16* __restrict__ A, int lda, const u16* __restrict__ Bt, int ldb,
                                        int K, int m0, int n0, Gemm2Smem& s, f32x4 (&acc)[8][4]) {
  int tid = threadIdx.x;
  asm volatile("" : "+v"(tid));
  const int lane = tid & 63, wave = tid >> 6;
  const int wr = wave >> 1, wc = wave & 1;
  const int l15 = lane & 15, g = lane >> 4;
  const int nk = K / G2K;
  const int drow = 16 * wave + (lane >> 2);
  const int dchunk = (lane & 3) ^ g;
  const u16* Ap = A + (size_t)(m0 + drow) * lda + dchunk * 8;
  const u16* Bp = Bt + (size_t)(n0 + drow) * ldb + dchunk * 8;
  const size_t sa = (size_t)64 * lda, sb = (size_t)64 * ldb;
  u16* const sa0 = &s.a[0][0] + (16 * wave) * G2K;
  u16* const sb0 = &s.b[0][0] + (16 * wave) * G2K;
#define G2_DMA(st, koff) do { \
    u16* _da = sa0 + (st) * (256 * G2K); u16* _db = sb0 + (st) * (128 * G2K); \
    _Pragma("unroll") for (int _i = 0; _i < 4; _i++) \
      __builtin_amdgcn_global_load_lds((const unsigned*)(Ap + _i * sa + (koff)), (unsigned*)(_da + 64 * _i * G2K), 16, 0, 0); \
    _Pragma("unroll") for (int _i = 0; _i < 2; _i++) \
      __builtin_amdgcn_global_load_lds((const unsigned*)(Bp + _i * sb + (koff)), (unsigned*)(_db + 64 * _i * G2K), 16, 0, 0); \
  } while (0)
  const int fo = l15 * G2K + ((g ^ ((l15 >> 2) & 3)) * 8);
  asm volatile("s_waitcnt lgkmcnt(0)" ::: "memory");
  __builtin_amdgcn_s_barrier();
  asm volatile("" ::: "memory");
#pragma unroll 1
  for (int j = 0; j < 2; j++) G2_DMA(j, j * G2K);
  int st = 0;
  for (int kt = 0; kt < nk; kt++) {
    if (kt + 1 < nk) asm volatile("s_waitcnt vmcnt(6)" ::: "memory");
    else asm volatile("s_waitcnt vmcnt(0)" ::: "memory");
    __builtin_amdgcn_s_barrier();
    asm volatile("" ::: "memory");
    if (kt + 2 < nk) {
      const int st2 = (st >= 1) ? st - 1 : 2;
      G2_DMA(st2, (kt + 2) * G2K);
    }
    const u16* sa_ = &s.a[0][0] + st * (256 * G2K) + (wr * 128) * G2K + fo;
    const u16* sb_ = &s.b[0][0] + st * (128 * G2K) + (wc * 64) * G2K + fo;
    bf16x8 af[8], bfr[4];
#pragma unroll
    for (int mi = 0; mi < 8; mi++) af[mi] = *(const bf16x8*)&sa_[mi * 16 * G2K];
#pragma unroll
    for (int ni = 0; ni < 4; ni++) bfr[ni] = *(const bf16x8*)&sb_[ni * 16 * G2K];
#pragma unroll
    for (int mi = 0; mi < 8; mi++)
#pragma unroll
      for (int ni = 0; ni < 4; ni++) acc[mi][ni] = SWAP ? mfma16(bfr[ni], af[mi], acc[mi][ni]) : mfma16(af[mi], bfr[ni], acc[mi][ni]);
    st = (st == 2) ? 0 : st + 1;
  }
}
#define ZERO_ACC8(acc) _Pragma("unroll") for (int _i = 0; _i < 8; _i++) _Pragma("unroll") for (int _j = 0; _j < 4; _j++) acc[_i][_j] = (f32x4){0.f, 0.f, 0.f, 0.f};

#define ZERO_ACC(acc) _Pragma("unroll") for (int _i = 0; _i < 4; _i++) _Pragma("unroll") for (int _j = 0; _j < 4; _j++) acc[_i][_j] = (f32x4){0.f, 0.f, 0.f, 0.f};

template <int NMI>
__device__ __forceinline__ void row_sumsq_add(f32x4 (&sq)[NMI][4], float* rss, int row0, int l15, int g) {
#pragma unroll
  for (int mi = 0; mi < NMI; mi++) {
    float v = 0.f;
#pragma unroll
    for (int ni = 0; ni < 4; ni++) v += (sq[mi][ni][0] + sq[mi][ni][1]) + (sq[mi][ni][2] + sq[mi][ni][3]);
    v += __shfl_xor(v, 16);
    v += __shfl_xor(v, 32);
    if (g == 0) atomicAdd(&rss[row0 + mi * 16 + l15], v);
  }
}

__device__ void deferred_transpose(const P& p, int it, float* tile);
#define N_DEFER (16 * 16 + 16 * 88 + 44 * 16 + 16 * 16 + 4 * 16)
#define DEFER_A 960
#define DEFER_B 1664

__device__ void phase_inproj(const P& p, unsigned char* smem) {
  Gemm2Smem& s = *(Gemm2Smem*)smem;
  const int lane = threadIdx.x & 63, wave = threadIdx.x >> 6, wr = wave >> 1, wc = wave & 1, l15 = lane & 15, g = lane >> 4;
  const int ntiles = 64 * 29;
  for (int tl = blockIdx.x; tl < ntiles; tl += gridDim.x) {
    const int mt = tl & 63, nt = tl >> 6;
    const int m0 = mt * 256, n0 = nt * 128;
    f32x4 acc[8][4];
    ZERO_ACC8(acc);
    if (nt >= 24 && nt < 28) {
      gemm256<false>(p.actA, DM, p.wt_in, DM, DM, m0, n0, s, acc);
#pragma unroll
      for (int mi = 0; mi < 8; mi++)
#pragma unroll
        for (int ni = 0; ni < 4; ni++) {
          const int rowb = m0 + wr * 128 + mi * 16 + g * 4;
          const int col = n0 + wc * 64 + ni * 16 + l15;
          const int cc = col - 3072, hh = cc >> 6, d = cc & 63;
          const int b = rowb >> 11, sq = rowb & 2047;
          uint2 o; o.x = pack2(acc[mi][ni][0], acc[mi][ni][1]); o.y = pack2(acc[mi][ni][2], acc[mi][ni][3]);
          *(uint2*)&p.vt[((size_t)((b * 8 + hh) * 64 + d)) * SEQ + sq] = o;
        }
    } else {
      gemm256<true>(p.actA, DM, p.wt_in, DM, DM, m0, n0, s, acc);
#pragma unroll
      for (int mi = 0; mi < 8; mi++)
#pragma unroll
        for (int ni = 0; ni < 4; ni++) {
          const int row = m0 + wr * 128 + mi * 16 + l15;
          const int col = n0 + wc * 64 + ni * 16 + g * 4;
          if (nt < 24) {
            uint2 o; o.x = pack2(acc[mi][ni][0], acc[mi][ni][1]); o.y = pack2(acc[mi][ni][2], acc[mi][ni][3]);
            *(uint2*)&p.proj[(size_t)row * PROJW + col] = o;
          } else if (col < 3600) {
            *(float4*)&p.gates[(size_t)row * 16 + (col - 3584)] = make_float4(acc[mi][ni][0], acc[mi][ni][1], acc[mi][ni][2], acc[mi][ni][3]);
          }
        }
    }
  }
  if (gridDim.x == 512 && blockIdx.x >= 320) {
    __syncthreads();
    for (int it = (int)blockIdx.x - 320; it < DEFER_A; it += 192) deferred_transpose(p, it, (float*)smem);
  }
}

__device__ void phase_outproj(const P& p, unsigned char* smem) {
  GemmSmem& s = *(GemmSmem*)smem;
  const int lane = threadIdx.x & 63, wave = threadIdx.x >> 6, wr = wave >> 1, wc = wave & 1, l15 = lane & 15, g = lane >> 4;
  for (int tl = blockIdx.x; tl < 128 * 8; tl += gridDim.x) {
    const int mt = tl & 127, nt = tl >> 7;
    const int m0 = mt * 128, n0 = nt * 128;
    f32x4 acc[4][4];
    ZERO_ACC(acc);
    gemm_tile<true>(p.actA, DM, p.wt_out, DM, DM, m0, n0, s, acc);
#pragma unroll
    for (int mi = 0; mi < 4; mi++)
#pragma unroll
      for (int ni = 0; ni < 4; ni++) {
        const size_t idx = (size_t)(m0 + wr * 64 + mi * 16 + l15) * DM + n0 + wc * 64 + ni * 16 + g * 4;
        const f32x4 xv4 = __builtin_nontemporal_load((const f32x4*)&p.x[idx]);
        const float4 xv = make_float4(xv4[0], xv4[1], xv4[2], xv4[3]);
        const float h0 = xv.x + acc[mi][ni][0], h1 = xv.y + acc[mi][ni][1], h2 = xv.z + acc[mi][ni][2], h3 = xv.w + acc[mi][ni][3];
        uint2 o; o.x = pack2(h0, h1); o.y = pack2(h2, h3);
        *(uint2*)&p.hb[idx] = o;
        acc[mi][ni] = (f32x4){h0 * h0, h1 * h1, h2 * h2, h3 * h3};
      }
    row_sumsq_add(acc, p.rss, m0 + wr * 64, l15, g);
  }
}

__device__ void phase_gateup(const P& p, unsigned char* smem) {
  Gemm2Smem& s = *(Gemm2Smem*)smem;
  u16* act = p.proj;
  const int lane = threadIdx.x & 63, wave = threadIdx.x >> 6, wr = wave >> 1, wc = wave & 1, l15 = lane & 15, g = lane >> 4;
  for (int tl = blockIdx.x; tl < 64 * 44; tl += gridDim.x) {
    const int mt = tl & 63, nt = tl >> 6;
    const int m0 = mt * 256, n0 = nt * 128;
    f32x4 acc[8][4];
    ZERO_ACC8(acc);
    gemm256<true>(p.hb, DM, p.wt_gu, DM, DM, m0, n0, s, acc);
#pragma unroll
    for (int mi = 0; mi < 8; mi++) {
      const int row = m0 + wr * 128 + mi * 16 + l15;
      const float rs = rsqrtf(p.rss[row] * (1.f / DM) + EPSV);
#pragma unroll
      for (int ni = 0; ni < 2; ni++) {
        const int col = 64 * nt + 32 * wc + 16 * ni + g * 4;
        float v[4];
#pragma unroll
        for (int r = 0; r < 4; r++) v[r] = siluf(acc[mi][ni][r] * rs) * (acc[mi][ni + 2][r] * rs);
        uint2 o; o.x = pack2(v[0], v[1]); o.y = pack2(v[2], v[3]);
        *(uint2*)&act[(size_t)row * DFF + col] = o;
      }
    }
  }
  if (gridDim.x == 512 && blockIdx.x >= 256) {
    __syncthreads();
    for (int it = DEFER_B + (int)blockIdx.x - 256; it < N_DEFER; it += 256) deferred_transpose(p, it, (float*)smem);
  }
}

__device__ void phase_down(const P& p, unsigned char* smem) {
  GemmSmem& s = *(GemmSmem*)smem;
  const u16* act = p.proj;
  const int lane = threadIdx.x & 63, wave = threadIdx.x >> 6, wr = wave >> 1, wc = wave & 1, l15 = lane & 15, g = lane >> 4;
  for (int tl = blockIdx.x; tl < 128 * 8; tl += gridDim.x) {
    const int mt = tl & 127, nt = tl >> 7;
    const int m0 = mt * 128, n0 = nt * 128;
    f32x4 acc[4][4];
    ZERO_ACC(acc);
    gemm_tile<true>(act, DFF, p.wt_down, DFF, DFF, m0, n0, s, acc);
#pragma unroll
    for (int mi = 0; mi < 4; mi++)
#pragma unroll
      for (int ni = 0; ni < 4; ni++) {
        const size_t idx = (size_t)(m0 + wr * 64 + mi * 16 + l15) * DM + n0 + wc * 64 + ni * 16 + g * 4;
        float hp[4];
        unpack4(*(const uint2*)&p.hb[idx], hp);
        const float h0 = hp[0] + acc[mi][ni][0], h1 = hp[1] + acc[mi][ni][1], h2 = hp[2] + acc[mi][ni][2], h3 = hp[3] + acc[mi][ni][3];
        uint2 o; o.x = pack2(h0, h1); o.y = pack2(h2, h3);
        *(uint2*)&p.actA[idx] = o;
        acc[mi][ni] = (f32x4){h0 * h0, h1 * h1, h2 * h2, h3 * h3};
      }
    row_sumsq_add(acc, p.rss + NTOK, m0 + wr * 64, l15, g);
  }
}

__device__ void phase_ple(const P& p, unsigned char* smem) {
  GemmSmem& s = *(GemmSmem*)smem;
  const int lane = threadIdx.x & 63, wave = threadIdx.x >> 6, wr = wave >> 1, wc = wave & 1, l15 = lane & 15, g = lane >> 4;
  for (int tl = blockIdx.x; tl < 128 * 8; tl += gridDim.x) {
    const int mt = tl & 127, nt = tl >> 7;
    const int m0 = mt * 128, n0 = nt * 128;
    f32x4 acc[4][4], acc2[4][4];
    ZERO_ACC(acc);
    gemm_tile<true>(p.actA, DM, p.wt_pg, DM, DM, m0, n0, s, acc);
#pragma unroll
    for (int mi = 0; mi < 4; mi++) {
      const float rs = rsqrtf(p.rss[NTOK + m0 + wr * 64 + mi * 16 + l15] * (1.f / DM) + EPSV);
#pragma unroll
      for (int ni = 0; ni < 4; ni++)
#pragma unroll
        for (int r = 0; r < 4; r++) acc[mi][ni][r] = sigmoidf_(acc[mi][ni][r] * rs);
    }
    ZERO_ACC(acc2);
    gemm_tile<true>(p.pb, 256, p.wt_pp, 256, 256, m0, n0, s, acc2);
#pragma unroll
    for (int mi = 0; mi < 4; mi++)
#pragma unroll
      for (int ni = 0; ni < 4; ni++) {
        const size_t idx = (size_t)(m0 + wr * 64 + mi * 16 + l15) * DM + n0 + wc * 64 + ni * 16 + g * 4;
        float hp[4];
        unpack4(*(const uint2*)&p.actA[idx], hp);
        const float h0 = hp[0] + acc[mi][ni][0] * acc2[mi][ni][0], h1 = hp[1] + acc[mi][ni][1] * acc2[mi][ni][1];
        const float h2 = hp[2] + acc[mi][ni][2] * acc2[mi][ni][2], h3 = hp[3] + acc[mi][ni][3] * acc2[mi][ni][3];
        *(float4*)&p.h[idx] = make_float4(h0, h1, h2, h3);
        acc2[mi][ni] = (f32x4){h0 * h0, h1 * h1, h2 * h2, h3 * h3};
      }
    row_sumsq_add(acc2, p.rss + 2 * NTOK, m0 + wr * 64, l15, g);
  }
}

#define QLD 136
#define KLD 72
struct GdnSmem {
  u16 qb[64 * QLD];
  u16 kn[64 * QLD];
  u16 vb[64 * QLD];
  float Am[64 * 64];
  float gc[64], beta[64], be[64];
};
static_assert(offsetof(GdnSmem, kn) == 17408 && offsetof(GdnSmem, vb) == 34816 && offsetof(GdnSmem, Am) == 52224, "layout");


__device__ void gdn_unit(const P& p, int unit, GdnSmem& s) {
  int tid = threadIdx.x;
  asm volatile("" : "+v"(tid));
  int lane = tid & 63, wave = tid >> 6;
  int l15 = lane & 15, g = lane >> 4;
#define GDN_REFRESH() do { tid = threadIdx.x; asm volatile("" : "+v"(tid) :: "memory"); lane = tid & 63; wave = tid >> 6; l15 = lane & 15; g = lane >> 4; } while (0)
  const int bh = unit >> 5, n = unit & 31;
  const int b = bh >> 2, h = bh & 3;
  const int tb = b * SEQ;
  const int s0 = n * 64;
  u16* const qk_s = s.qb;
  u16* const WU = s.kn;
  u16* const kdT = (u16*)((unsigned char*)s.kn + 32768);
  __syncthreads();
  if (wave == 0) {
    const int t = tb + s0 + lane;
    const float ga = p.gates[(size_t)t * 16 + h], gb = p.gates[(size_t)t * 16 + 4 + h];
    const float xx = ga + p.dt_bias[h];
    const float sp = (xx > 20.f) ? xx : log1pf(__expf(xx));
    float gg = -__expf(p.a_log[h]) * sp;
#pragma unroll
    for (int off = 1; off < 64; off <<= 1) {
      float nb = __shfl_up(gg, off);
      if (lane >= off) gg += nb;
    }
    const float bt = sigmoidf_(gb);
    s.gc[lane] = gg;
    s.beta[lane] = bt;
    s.be[lane] = bt * __expf(gg);
  }
  {
    const int ch = tid & 15, rg = tid >> 4;
#pragma unroll 1
    for (int mat = 0; mat < 3; mat++) {
      const int col0 = mat * 512 + h * 128 + ch * 8;
      float cw[4][8];
#pragma unroll
      for (int k = 0; k < 4; k++) {
        const float4 w0 = *(const float4*)&p.conv_w[k * 1536 + col0];
        const float4 w1 = *(const float4*)&p.conv_w[k * 1536 + col0 + 4];
        cw[k][0] = w0.x; cw[k][1] = w0.y; cw[k][2] = w0.z; cw[k][3] = w0.w;
        cw[k][4] = w1.x; cw[k][5] = w1.y; cw[k][6] = w1.z; cw[k][7] = w1.w;
      }
      uint4 xr[7];
#pragma unroll
      for (int j = 0; j < 7; j++) {
        const int sp = s0 + 4 * rg + j - 3;
        if (sp >= 0) {
          typedef __attribute__((ext_vector_type(4))) unsigned u32x4_t;
          const u32x4_t t = __builtin_nontemporal_load((const u32x4_t*)&p.proj[(size_t)(tb + sp) * PROJW + col0]);
          xr[j] = make_uint4(t[0], t[1], t[2], t[3]);
        } else xr[j] = make_uint4(0u, 0u, 0u, 0u);
      }
      float xf[7][8];
#pragma unroll
      for (int j = 0; j < 7; j++) unpack8(xr[j], xf[j]);
      u16* dst = (mat == 0) ? s.qb : ((mat == 1) ? s.kn : s.vb);
#pragma unroll
      for (int r = 0; r < 4; r++) {
        float val[8];
        float ss = 0.f;
#pragma unroll
        for (int c = 0; c < 8; c++) {
          const float cv = cw[0][c] * xf[r][c] + cw[1][c] * xf[r + 1][c] + cw[2][c] * xf[r + 2][c] + cw[3][c] * xf[r + 3][c];
          val[c] = siluf(cv);
          ss += val[c] * val[c];
        }
        float rs = 1.f;
        if (mat < 2) {
#pragma unroll
          for (int off = 1; off < 16; off <<= 1) ss += __shfl_xor(ss, off);
          rs = rsqrtf(ss + EPSV) * ((mat == 0) ? 0.08838834764831845f : 1.f);
        }
        uint4 o;
        o.x = pack2(val[0] * rs, val[1] * rs); o.y = pack2(val[2] * rs, val[3] * rs);
        o.z = pack2(val[4] * rs, val[5] * rs); o.w = pack2(val[6] * rs, val[7] * rs);
        *(uint4*)&dst[(4 * rg + r) * QLD + ch * 8] = o;
      }
    }
  }
  __syncthreads();
  GDN_REFRESH();
  u16* const gQ = p.gQ + (size_t)unit * 8192;
  {
#pragma unroll
    for (int it = 0; it < 4; it++) {
      const int idx = tid + 256 * it;
      const int i = idx >> 4, d8 = (idx & 15) * 8;
      const float e = __expf(s.gc[i]);
      float f[8];
      unpack8(*(const uint4*)&s.qb[i * QLD + d8], f);
      uint4 o;
      o.x = pack2(f[0] * e, f[1] * e); o.y = pack2(f[2] * e, f[3] * e);
      o.z = pack2(f[4] * e, f[5] * e); o.w = pack2(f[6] * e, f[7] * e);
      *(uint4*)&gQ[i * 128 + d8] = o;
    }
  }
  f32x4 cqk[4];
  {
    bf16x8 aq[4], ak[4];
#pragma unroll
    for (int ks = 0; ks < 4; ks++) {
      aq[ks] = *(const bf16x8*)&s.qb[(wave * 16 + l15) * QLD + ks * 32 + g * 8];
      ak[ks] = *(const bf16x8*)&s.kn[(wave * 16 + l15) * QLD + ks * 32 + g * 8];
    }
#pragma unroll
    for (int ni = 0; ni < 4; ni++) {
      f32x4 ckk = {0.f, 0.f, 0.f, 0.f};
      cqk[ni] = (f32x4){0.f, 0.f, 0.f, 0.f};
      if (ni <= wave) {
#pragma unroll
        for (int ks = 0; ks < 4; ks++) {
          bf16x8 bk = *(const bf16x8*)&s.kn[(ni * 16 + l15) * QLD + ks * 32 + g * 8];
          ckk = mfma16(ak[ks], bk, ckk);
          cqk[ni] = mfma16(aq[ks], bk, cqk[ni]);
        }
      }
      const int j = ni * 16 + l15;
      const float gcj = s.gc[j];
#pragma unroll
      for (int r = 0; r < 4; r++) {
        const int i = wave * 16 + g * 4 + r;
        const float dec = (i >= j) ? __expf(s.gc[i] - gcj) : 0.f;
        s.Am[i * 64 + j] = (i > j) ? ckk[r] * s.beta[i] * dec : 0.f;
        cqk[ni][r] = (i >= j) ? cqk[ni][r] * dec : 0.f;
      }
    }
  }
  __syncthreads();
  GDN_REFRESH();
#pragma unroll
  for (int ni = 0; ni < 4; ni++)
#pragma unroll
    for (int r = 0; r < 4; r++) qk_s[(wave * 16 + g * 4 + r) * KLD + ni * 16 + l15] = f2bf(cqk[ni][r]);
  float xs[64];
#ifdef NO_SOLVE
  for (int i = 0; i < 64; i++) xs[i] = s.Am[i*64+tid%64];
#else
  {
    const int c = tid;
    const u16* src = (c < 128) ? &s.vb[c] : &s.kn[c - 128];
    const float* sc = (c < 128) ? s.beta : s.be;
#pragma unroll
    for (int i = 0; i < 64; i++) {
      float a0 = bf2f(src[i * QLD]) * sc[i], a1 = 0.f, a2 = 0.f, a3 = 0.f;
#pragma unroll
      for (int j4 = 0; j4 < (i + 3) / 4; j4++) {
        const float4 av = *(const float4*)&s.Am[i * 64 + j4 * 4];
        if (j4 * 4 + 0 < i) a0 -= av.x * xs[j4 * 4 + 0];
        if (j4 * 4 + 1 < i) a1 -= av.y * xs[j4 * 4 + 1];
        if (j4 * 4 + 2 < i) a2 -= av.z * xs[j4 * 4 + 2];
        if (j4 * 4 + 3 < i) a3 -= av.w * xs[j4 * 4 + 3];
      }
      xs[i] = (a0 + a1) + (a2 + a3);
      asm volatile("" : "+v"(xs[i]) :: "memory");
    }
  }
#endif
  const float glast = s.gc[63];
  __syncthreads();
  GDN_REFRESH();
  {
    const int d = tid & 127, half = tid >> 7;
#pragma unroll
    for (int q = 0; q < 4; q++) {
      unsigned ow[4];
#pragma unroll
      for (int e2 = 0; e2 < 4; e2++) {
        const int c0 = half * 32 + q * 8 + e2 * 2;
        const float v0 = bf2f(s.kn[c0 * QLD + d]) * __expf(glast - s.gc[c0]);
        const float v1 = bf2f(s.kn[(c0 + 1) * QLD + d]) * __expf(glast - s.gc[c0 + 1]);
        ow[e2] = pack2(v0, v1);
      }
      *(uint4*)&kdT[d * KLD + half * 32 + q * 8] = make_uint4(ow[0], ow[1], ow[2], ow[3]);
    }
    if (tid == 0) p.gdl[unit] = __expf(glast);
  }
  __syncthreads();
  GDN_REFRESH();
  if (tid >= 128) {
#pragma unroll
    for (int q = 0; q < 8; q++)
      *(uint4*)&WU[(tid - 128) * KLD + q * 8] = make_uint4(pack2(xs[q * 8], xs[q * 8 + 1]), pack2(xs[q * 8 + 2], xs[q * 8 + 3]),
                                                            pack2(xs[q * 8 + 4], xs[q * 8 + 5]), pack2(xs[q * 8 + 6], xs[q * 8 + 7]));
  }
  __syncthreads();
  GDN_REFRESH();
  {
    u16* const gM = p.gM + (size_t)unit * 16384;
    bf16x8 aw[2][2];
#pragma unroll
    for (int mm = 0; mm < 2; mm++)
#pragma unroll
      for (int ks = 0; ks < 2; ks++) aw[mm][ks] = *(const bf16x8*)&WU[((2 * wave + mm) * 16 + l15) * KLD + ks * 32 + g * 8];
#pragma unroll
    for (int nn = 0; nn < 8; nn++) {
      const bf16x8 b0 = *(const bf16x8*)&kdT[(nn * 16 + l15) * KLD + g * 8];
      const bf16x8 b1 = *(const bf16x8*)&kdT[(nn * 16 + l15) * KLD + 32 + g * 8];
#pragma unroll
      for (int mm = 0; mm < 2; mm++) {
        f32x4 acc = {0.f, 0.f, 0.f, 0.f};
        acc = mfma16(aw[mm][0], b0, acc);
        acc = mfma16(aw[mm][1], b1, acc);
        uint2 o; o.x = pack2(-acc[0], -acc[1]); o.y = pack2(-acc[2], -acc[3]);
        *(uint2*)&gM[(nn * 16 + l15) * 128 + (2 * wave + mm) * 16 + 4 * g] = o;
      }
    }
#pragma unroll
    for (int nn = 0; nn < 4; nn++) {
      const bf16x8 b0 = *(const bf16x8*)&qk_s[(nn * 16 + l15) * KLD + g * 8];
      const bf16x8 b1 = *(const bf16x8*)&qk_s[(nn * 16 + l15) * KLD + 32 + g * 8];
#pragma unroll
      for (int mm = 0; mm < 2; mm++) {
        f32x4 acc = {0.f, 0.f, 0.f, 0.f};
        acc = mfma16(aw[mm][0], b0, acc);
        acc = mfma16(aw[mm][1], b1, acc);
        u16* qp = &gQ[(nn * 16 + l15) * 128 + (2 * wave + mm) * 16 + 4 * g];
        float qv[4];
        unpack4(*(const uint2*)qp, qv);
        uint2 o; o.x = pack2(qv[0] - acc[0], qv[1] - acc[1]); o.y = pack2(qv[2] - acc[2], qv[3] - acc[3]);
        *(uint2*)qp = o;
      }
    }
  }
  __syncthreads();
  GDN_REFRESH();
  if (tid < 128) {
#pragma unroll
    for (int q = 0; q < 8; q++)
      *(uint4*)&WU[tid * KLD + q * 8] = make_uint4(pack2(xs[q * 8], xs[q * 8 + 1]), pack2(xs[q * 8 + 2], xs[q * 8 + 3]),
                                                    pack2(xs[q * 8 + 4], xs[q * 8 + 5]), pack2(xs[q * 8 + 6], xs[q * 8 + 7]));
  }
  __syncthreads();
  GDN_REFRESH();
  {
    u16* const gC = p.gC + (size_t)unit * 16384;
    u16* const gO = p.gO + (size_t)unit * 8192;
    bf16x8 akd[2][2], aqk[2];
#pragma unroll
    for (int mm = 0; mm < 2; mm++)
#pragma unroll
      for (int ks = 0; ks < 2; ks++) akd[mm][ks] = *(const bf16x8*)&kdT[((2 * wave + mm) * 16 + l15) * KLD + ks * 32 + g * 8];
#pragma unroll
    for (int ks = 0; ks < 2; ks++) aqk[ks] = *(const bf16x8*)&qk_s[(wave * 16 + l15) * KLD + ks * 32 + g * 8];
#pragma unroll
    for (int nn = 0; nn < 8; nn++) {
      const bf16x8 b0 = *(const bf16x8*)&WU[(nn * 16 + l15) * KLD + g * 8];
      const bf16x8 b1 = *(const bf16x8*)&WU[(nn * 16 + l15) * KLD + 32 + g * 8];
#pragma unroll
      for (int mm = 0; mm < 2; mm++) {
        f32x4 acc = {0.f, 0.f, 0.f, 0.f};
        acc = mfma16(akd[mm][0], b0, acc);
        acc = mfma16(akd[mm][1], b1, acc);
        uint2 o; o.x = pack2(acc[0], acc[1]); o.y = pack2(acc[2], acc[3]);
        *(uint2*)&gC[(nn * 16 + l15) * 128 + (2 * wave + mm) * 16 + 4 * g] = o;
      }
      {
        f32x4 acc = {0.f, 0.f, 0.f, 0.f};
        acc = mfma16(aqk[0], b0, acc);
        acc = mfma16(aqk[1], b1, acc);
        uint2 o; o.x = pack2(acc[0], acc[1]); o.y = pack2(acc[2], acc[3]);
        *(uint2*)&gO[(nn * 16 + l15) * 64 + wave * 16 + 4 * g] = o;
      }
    }
  }
}

__device__ void fox_cumsum_unit(const P& p, int bhf, float* red) {
  const int tid = threadIdx.x, lane = tid & 63, wave = tid >> 6;
  const int b = bhf >> 3, hf = bhf & 7;
  const float bias = p.fox_f_bias[hf];
  float v[8];
  float run = 0.f;
#pragma unroll
  for (int i = 0; i < 8; i++) {
    const int t = b * SEQ + tid * 8 + i;
    const float xx = p.gates[(size_t)t * 16 + 8 + hf] + bias;
    const float ls = fminf(xx, 0.f) - log1pf(__expf(-fabsf(xx)));
    run += ls;
    v[i] = run;
  }
  float tot = run;
#pragma unroll
  for (int off = 1; off < 64; off <<= 1) {
    float nb = __shfl_up(tot, off);
    if (lane >= off) tot += nb;
  }
  __syncthreads();
  if (lane == 63) red[wave] = tot;
  __syncthreads();
  float base = tot - run;
  for (int w = 0; w < wave; w++) base += red[w];
#pragma unroll
  for (int i = 0; i < 8; i++) p.cf[(size_t)bhf * SEQ + tid * 8 + i] = v[i] + base;
}

__device__ void phase_gdnprep(const P& p, unsigned char* smem) {
  GdnSmem& s = *(GdnSmem*)smem;
  for (int u = blockIdx.x; u < 1024 + 64; u += gridDim.x) {
    if (u < 1024) gdn_unit(p, u, s);
    else { __syncthreads(); fox_cumsum_unit(p, u - 1024, (float*)smem); }
  }
}

#define SLD 136
#define NSCAN 128
struct ScanSmem { u16 st[2][32 * SLD]; };
struct ScanSet { bf16x8 mf[2][4]; uint2 ci[2][2]; float dl; };

__device__ __forceinline__ void scan_load(const P& p, int unit, int eq, int w, int l15, int g, ScanSet& z) {
  int la = (32 * w + l15) * 128 + 8 * g, lc = (32 * eq + l15) * 128 + 32 * w + 4 * g;
  asm volatile("" : "+v"(la), "+v"(lc));
  const u16* gM = p.gM + (size_t)unit * 16384;
  const u16* gC = p.gC + (size_t)unit * 16384;
#pragma unroll
  for (int md = 0; md < 2; md++)
#pragma unroll
    for (int ks = 0; ks < 4; ks++) z.mf[md][ks] = *(const bf16x8*)&gM[la + md * 16 * 128 + ks * 32];
#pragma unroll
  for (int md = 0; md < 2; md++)
#pragma unroll
    for (int ne = 0; ne < 2; ne++) z.ci[md][ne] = *(const uint2*)&gC[lc + ne * 16 * 128 + md * 16];
  z.dl = p.gdl[unit];
}

__device__ __forceinline__ unsigned scan_touch(const P& p, int unit, int lane) {
  unsigned v = 0u;
  if (lane < 16) {
    const u16* base = (lane < 8) ? (p.gM + (size_t)unit * 16384) : (p.gC + (size_t)unit * 16384);
    v = *(const unsigned*)(base + (lane & 7) * 2048);
  }
  return v;
}

__device__ __forceinline__ void scan_step(const P& p, int unit, int n, int eq, int w, int l15, int g, ScanSmem& s,
                                          f32x4 (&st)[2][2], const ScanSet& z) {
  const u16* Sb = s.st[n & 1];
  u16* Sn = s.st[(n & 1) ^ 1];
#pragma unroll
  for (int md = 0; md < 2; md++)
#pragma unroll
    for (int ne = 0; ne < 2; ne++) {
      float c[4];
      unpack4(z.ci[md][ne], c);
      st[md][ne][0] = st[md][ne][0] * z.dl + c[0];
      st[md][ne][1] = st[md][ne][1] * z.dl + c[1];
      st[md][ne][2] = st[md][ne][2] * z.dl + c[2];
      st[md][ne][3] = st[md][ne][3] * z.dl + c[3];
    }
  if (n > 0) {
    int lb = l15 * SLD + 8 * g;
    asm volatile("" : "+v"(lb));
#pragma unroll
    for (int ne = 0; ne < 2; ne++) {
#pragma unroll
      for (int ks = 0; ks < 4; ks++) {
        const bf16x8 bs = *(const bf16x8*)&Sb[lb + 16 * ne * SLD + ks * 32];
        st[0][ne] = mfma16(z.mf[0][ks], bs, st[0][ne]);
        st[1][ne] = mfma16(z.mf[1][ks], bs, st[1][ne]);
      }
    }
  }
  if (n + 1 < 32) {
    u16* gS = p.gS + (size_t)(unit + 1) * 16384;
    int lsl = l15 * SLD + 32 * w + 4 * g, lsg = (32 * eq + l15) * 128 + 32 * w + 4 * g;
    asm volatile("" : "+v"(lsl), "+v"(lsg));
#pragma unroll
    for (int md = 0; md < 2; md++)
#pragma unroll
      for (int ne = 0; ne < 2; ne++) {
        uint2 o; o.x = pack2(st[md][ne][0], st[md][ne][1]); o.y = pack2(st[md][ne][2], st[md][ne][3]);
        *(uint2*)&Sn[lsl + 16 * ne * SLD + 16 * md] = o;
        *(uint2*)&gS[lsg + 16 * ne * 128 + 16 * md] = o;
      }
  }
  asm volatile("s_waitcnt lgkmcnt(0)" ::: "memory");
  __builtin_amdgcn_s_barrier();
  asm volatile("" ::: "memory");
}

__device__ void scan_unit(const P& p, int item, ScanSmem& s) {
  int tid = threadIdx.x;
  asm volatile("" : "+v"(tid));
  const int lane = tid & 63, w = tid >> 6;
  const int l15 = lane & 15, g = lane >> 4;
  const int bh = item >> 2, eq = item & 3;
  const int u0 = bh * 32;
  f32x4 st[2][2];
#pragma unroll
  for (int md = 0; md < 2; md++)
#pragma unroll
    for (int ne = 0; ne < 2; ne++) st[md][ne] = (f32x4){0.f, 0.f, 0.f, 0.f};
  ScanSet z0, z1, z2, z3;
  scan_load(p, u0 + 0, eq, w, l15, g, z0);
  scan_load(p, u0 + 1, eq, w, l15, g, z1);
  scan_load(p, u0 + 2, eq, w, l15, g, z2);
  unsigned tacc = 0u, tprev = 0u;
  __builtin_amdgcn_s_setprio(3);
#pragma unroll 1
  for (int n = 0; n < 32; n += 4) {
    tacc += tprev;
    tprev = 0u;
    if (n + 8 < 32) {
      tprev = scan_touch(p, u0 + n + 8, lane) + scan_touch(p, u0 + n + 9, lane) + scan_touch(p, u0 + n + 10, lane) +
              scan_touch(p, u0 + n + 11, lane);
    }
    scan_load(p, u0 + n + 3, eq, w, l15, g, z3);
    scan_step(p, u0 + n, n, eq, w, l15, g, s, st, z0);
    if (n + 4 < 32) scan_load(p, u0 + n + 4, eq, w, l15, g, z0);
    scan_step(p, u0 + n + 1, n + 1, eq, w, l15, g, s, st, z1);
    if (n + 4 < 32) scan_load(p, u0 + n + 5, eq, w, l15, g, z1);
    scan_step(p, u0 + n + 2, n + 2, eq, w, l15, g, s, st, z2);
    if (n + 4 < 32) scan_load(p, u0 + n + 6, eq, w, l15, g, z2);
    scan_step(p, u0 + n + 3, n + 3, eq, w, l15, g, s, st, z3);
  }
  __builtin_amdgcn_s_setprio(0);
  asm volatile("" :: "v"(tacc));
}

#define OLD 136
struct GoutSmem { float ssq[4][64]; u16 ob[64 * OLD]; };

__device__ void gout_unit(const P& p, int unit, GoutSmem& s) {
  const int tid = threadIdx.x, lane = tid & 63, w = tid >> 6;
  const int l15 = lane & 15, g = lane >> 4;
  const int bh = unit >> 5, n = unit & 31;
  const int b = bh >> 2, h = bh & 3;
  const u16* gQ = p.gQ + (size_t)unit * 8192;
  const u16* gO = p.gO + (size_t)unit * 8192;
  const u16* gS = p.gS + (size_t)unit * 16384;
  f32x4 o[4][2];
#pragma unroll
  for (int mc = 0; mc < 4; mc++)
#pragma unroll
    for (int ne = 0; ne < 2; ne++) {
      float c[4];
      unpack4(*(const uint2*)&gO[(32 * w + 16 * ne + l15) * 64 + 16 * mc + 4 * g], c);
      o[mc][ne] = (f32x4){c[0], c[1], c[2], c[3]};
    }
  if (n > 0) {
    bf16x8 bs[2][4];
#pragma unroll
    for (int ne = 0; ne < 2; ne++)
#pragma unroll
      for (int ks = 0; ks < 4; ks++) bs[ne][ks] = *(const bf16x8*)&gS[(32 * w + 16 * ne + l15) * 128 + ks * 32 + 8 * g];
#pragma unroll
    for (int mc = 0; mc < 4; mc++) {
#pragma unroll
      for (int ks = 0; ks < 4; ks++) {
        const bf16x8 aq = *(const bf16x8*)&gQ[(16 * mc + l15) * 128 + ks * 32 + 8 * g];
        o[mc][0] = mfma16(aq, bs[0][ks], o[mc][0]);
        o[mc][1] = mfma16(aq, bs[1][ks], o[mc][1]);
      }
    }
  }
  const float gnw0 = p.gdn_norm_w[32 * w + l15], gnw1 = p.gdn_norm_w[32 * w + 16 + l15];
  __syncthreads();
#pragma unroll
  for (int mc = 0; mc < 4; mc++)
#pragma unroll
    for (int r = 0; r < 4; r++) {
      float sq = o[mc][0][r] * o[mc][0][r] + o[mc][1][r] * o[mc][1][r];
#pragma unroll
      for (int off = 1; off < 16; off <<= 1) sq += __shfl_xor(sq, off);
      if (l15 == 0) s.ssq[w][16 * mc + 4 * g + r] = sq;
    }
  __syncthreads();
#pragma unroll
  for (int mc = 0; mc < 4; mc++)
#pragma unroll
    for (int r = 0; r < 4; r++) {
      const int c = 16 * mc + 4 * g + r;
      const float tot = s.ssq[0][c] + s.ssq[1][c] + s.ssq[2][c] + s.ssq[3][c];
      const float rs = rsqrtf(tot * (1.f / 128.f) + EPSV);
      s.ob[c * OLD + 32 * w + l15] = f2bf(o[mc][0][r] * rs * gnw0);
      s.ob[c * OLD + 32 * w + 16 + l15] = f2bf(o[mc][1][r] * rs * gnw1);
    }
  __syncthreads();
  {
    const int t0 = b * SEQ + n * 64;
    const int c0 = tid >> 4, ch = tid & 15;
    const u16* zp = p.proj + (size_t)(t0 + c0) * PROJW + 1536 + h * 128 + ch * 8;
    u16* op = p.actA + (size_t)(t0 + c0) * DM + h * 128 + ch * 8;
#pragma unroll
    for (int i = 0; i < 4; i++) {
      float ov[8], zv[8];
      unpack8(*(const uint4*)&s.ob[(c0 + 16 * i) * OLD + ch * 8], ov);
      unpack8(*(const uint4*)(zp + (size_t)i * 16 * PROJW), zv);
      uint4 r;
      r.x = pack2(ov[0] * siluf(zv[0]), ov[1] * siluf(zv[1])); r.y = pack2(ov[2] * siluf(zv[2]), ov[3] * siluf(zv[3]));
      r.z = pack2(ov[4] * siluf(zv[4]), ov[5] * siluf(zv[5])); r.w = pack2(ov[6] * siluf(zv[6]), ov[7] * siluf(zv[7]));
      *(uint4*)(op + (size_t)i * 16 * DM) = r;
    }
  }
}

__device__ void phase_gout(const P& p, unsigned char* smem) {
  GoutSmem& s = *(GoutSmem*)smem;
  for (int u = blockIdx.x; u < 1024; u += gridDim.x) gout_unit(p, u, s);
}

#define LOG2E 1.4426950408889634f
#define ANST 4
struct AttnSmem { u16 k[ANST][64 * 64 + 128]; u16 v[ANST][64 * 64]; };

__device__ void attn_unit(const P& p, int item, AttnSmem& s) {
  int tid = threadIdx.x;
  asm volatile("" : "+v"(tid));
  const int lane = tid & 63, w = tid >> 6;
  const int l15 = lane & 15, g = lane >> 4;
  const int qb = 15 - (item >> 6), bhf = item & 63;
  const int b = bhf >> 3, hf = bhf & 7;
  const int q0 = qb * 128 + 32 * w;
  const u16* qbase = p.proj + (size_t)(b * SEQ) * PROJW + 2048 + hf * 64;
  const u16* kbase = p.proj + (size_t)(b * SEQ) * PROJW + 2560 + hf * 64;
  const u16* vbase = p.vt + (size_t)bhf * 64 * SEQ;
  const float* cfb = p.cf + (size_t)bhf * SEQ;
  bf16x8 qf[2][2];
#pragma unroll
  for (int mi = 0; mi < 2; mi++)
#pragma unroll
    for (int ks = 0; ks < 2; ks++) qf[mi][ks] = *(const bf16x8*)&qbase[(size_t)(q0 + 16 * mi + l15) * PROJW + ks * 32 + g * 8];
  float cq[2], m[2], lsum[2];
  f32x4 O[2][4];
#pragma unroll
  for (int mi = 0; mi < 2; mi++) {
    cq[mi] = cfb[q0 + 16 * mi + l15]; m[mi] = -1e30f; lsum[mi] = 0.f;
#pragma unroll
    for (int nd = 0; nd < 4; nd++) O[mi][nd] = (f32x4){0.f, 0.f, 0.f, 0.f};
  }
  asm volatile("" :: "v"(cq[0]), "v"(cq[1]), "v"(qf[0][0]), "v"(qf[0][1]), "v"(qf[1][0]), "v"(qf[1][1]));
  const int ntile = (q0 + 32 + 63) >> 6;
  const int ntile_blk = 2 * qb + 2;
  const int drow = 8 * w + (lane >> 3);
  const int dchunk = (lane & 7) ^ ((4 * (w & 1) + (lane >> 4)) & 7);
  const u16* kg = kbase + (size_t)drow * PROJW + dchunk * 8;
  const u16* vg = vbase + (size_t)drow * SEQ + dchunk * 8;
  const float* cg_ = cfb + lane;
  u16* const skw = &s.k[0][0] + (8 * w) * 64;
  u16* const svw = &s.v[0][0] + (8 * w) * 64;
#define A_DMA(st, kk0) do { \
    u16* _dk = skw + (st) * (64 * 64 + 128); u16* _dv = svw + (st) * (64 * 64); \
    __builtin_amdgcn_global_load_lds((const unsigned*)(kg + (size_t)(kk0) * PROJW), (unsigned*)(_dk), 16, 0, 0); \
    __builtin_amdgcn_global_load_lds((const unsigned*)(kg + (size_t)((kk0) + 32) * PROJW), (unsigned*)(_dk + 32 * 64), 16, 0, 0); \
    __builtin_amdgcn_global_load_lds((const unsigned*)(vg + (kk0)), (unsigned*)(_dv), 16, 0, 0); \
    __builtin_amdgcn_global_load_lds((const unsigned*)(vg + (size_t)32 * SEQ + (kk0)), (unsigned*)(_dv + 32 * 64), 16, 0, 0); \
    __builtin_amdgcn_global_load_lds((const unsigned*)(cg_ + (kk0)), (unsigned*)(&s.k[0][0] + (st) * (64 * 64 + 128) + 64 * 64), 4, 0, 0); \
  } while (0)
  {
    const int npro = (ntile_blk > 2) ? 3 : 2;
#pragma unroll 1
    for (int j = 0; j < npro; j++) A_DMA(j, j * 64);
  }
  int ko[4][2];
#pragma unroll
  for (int t = 0; t < 4; t++) {
    const int row = 32 * (t >> 1) + 8 * (l15 >> 2) + 4 * (t & 1) + (l15 & 3);
    const int sw = (row >> 1) & 7;
    ko[t][0] = row * 64 + ((g ^ sw) * 8);
    ko[t][1] = row * 64 + (((4 + g) ^ sw) * 8);
  }
  const int swz = l15 >> 1;
  int vo[2];
  vo[0] = l15 * 64 + ((g ^ swz) * 8);
  vo[1] = l15 * 64 + (((4 + g) ^ swz) * 8);
#pragma unroll 1
  for (int kt = 0; kt < ntile_blk; kt++) {
    const int k0 = kt * 64, st = kt & 3;
    const int rem = ntile_blk - 1 - kt;
    if (rem >= 2) asm volatile("s_waitcnt vmcnt(10)" ::: "memory");
    else if (rem == 1) asm volatile("s_waitcnt vmcnt(5)" ::: "memory");
    else asm volatile("s_waitcnt vmcnt(0)" ::: "memory");
    asm volatile("s_waitcnt lgkmcnt(0)" ::: "memory");
    __builtin_amdgcn_s_barrier();
    asm volatile("" ::: "memory");
    if (kt + 3 < ntile_blk) { const int st3 = (kt + 3) & 3; A_DMA(st3, k0 + 192); }
    if (kt < ntile) {
      const u16* Ks = s.k[st];
      const u16* Vs = s.v[st];
      f32x4 ST[2][4];
#pragma unroll
      for (int t = 0; t < 4; t++) {
        const bf16x8 kf0 = *(const bf16x8*)&Ks[ko[t][0]];
        const bf16x8 kf1 = *(const bf16x8*)&Ks[ko[t][1]];
#pragma unroll
        for (int mi = 0; mi < 2; mi++) {
          f32x4 acc = {0.f, 0.f, 0.f, 0.f};
          acc = mfma16(kf0, qf[mi][0], acc);
          acc = mfma16(kf1, qf[mi][1], acc);
          ST[mi][t] = acc;
        }
      }
      f32x4 ck[4];
      {
        const unsigned cka = (unsigned)(size_t)(&Ks[64 * 64]) + 32u * g;
        asm volatile("ds_read_b128 %0, %4\n\tds_read_b128 %1, %4 offset:16\n\tds_read_b128 %2, %4 offset:128\n\t"
                     "ds_read_b128 %3, %4 offset:144\n\ts_waitcnt lgkmcnt(0)"
                     : "=&v"(ck[0]), "=&v"(ck[1]), "=&v"(ck[2]), "=&v"(ck[3]) : "v"(cka) : "memory");
      }
      const bool diag = (kt == ntile - 1);
      bf16x8 pf[2][2];
#pragma unroll
      for (int mi = 0; mi < 2; mi++) {
        const int qpos = q0 + 16 * mi + l15;
        float mx = -1e30f;
#pragma unroll
        for (int t = 0; t < 4; t++) {
          const float ckv[4] = {ck[t][0], ck[t][1], ck[t][2], ck[t][3]};
#pragma unroll
          for (int r = 0; r < 4; r++) {
            float lg = ST[mi][t][r] * (0.125f * LOG2E) + (cq[mi] - ckv[r]) * LOG2E;
            if (diag && (k0 + 32 * (t >> 1) + 8 * g + 4 * (t & 1) + r > qpos)) lg = -1e30f;
            ST[mi][t][r] = lg;
            mx = fmaxf(mx, lg);
          }
        }
        mx = fmaxf(mx, __shfl_xor(mx, 16));
        mx = fmaxf(mx, __shfl_xor(mx, 32));
        const float mn = fmaxf(m[mi], mx);
        const float alpha = __builtin_amdgcn_exp2f(m[mi] - mn);
        m[mi] = mn;
        float ps = 0.f;
#pragma unroll
        for (int t = 0; t < 4; t++)
#pragma unroll
          for (int r = 0; r < 4; r++) {
            const float pe = __builtin_amdgcn_exp2f(ST[mi][t][r] - mn);
            ST[mi][t][r] = pe;
            ps += pe;
          }
        lsum[mi] = lsum[mi] * alpha + ps;
#pragma unroll
        for (int kk = 0; kk < 2; kk++) {
          uint4 pk;
          pk.x = pack2(ST[mi][2 * kk][0], ST[mi][2 * kk][1]); pk.y = pack2(ST[mi][2 * kk][2], ST[mi][2 * kk][3]);
          pk.z = pack2(ST[mi][2 * kk + 1][0], ST[mi][2 * kk + 1][1]); pk.w = pack2(ST[mi][2 * kk + 1][2], ST[mi][2 * kk + 1][3]);
          pf[mi][kk] = __builtin_bit_cast(bf16x8, pk);
        }
#pragma unroll
        for (int r = 0; r < 4; r++) {
          const float ar = __shfl(alpha, 4 * g + r);
#pragma unroll
          for (int nd = 0; nd < 4; nd++) O[mi][nd][r] *= ar;
        }
      }
#pragma unroll
      for (int nd = 0; nd < 4; nd++)
#pragma unroll
        for (int kk = 0; kk < 2; kk++) {
          const bf16x8 vf = *(const bf16x8*)&Vs[16 * nd * 64 + vo[kk]];
          O[0][nd] = mfma16(pf[0][kk], vf, O[0][nd]);
          O[1][nd] = mfma16(pf[1][kk], vf, O[1][nd]);
        }
    }
  }
#pragma unroll
  for (int mi = 0; mi < 2; mi++) {
    float l = lsum[mi];
    l += __shfl_xor(l, 16);
    l += __shfl_xor(l, 32);
    const float inv = 1.f / l;
#pragma unroll
    for (int r = 0; r < 4; r++) {
      const float ir = __shfl(inv, 4 * g + r);
      const int t = b * SEQ + q0 + 16 * mi + 4 * g + r;
#pragma unroll
      for (int nd = 0; nd < 4; nd++) p.actA[(size_t)t * DM + 512 + hf * 64 + 16 * nd + l15] = f2bf(O[mi][nd][r] * ir);
    }
  }
}

__device__ void deferred_transpose(const P& p, int it, float* tile) {
  const int n1 = 16 * 16, n2 = n1 + 16 * 88, n3 = n2 + 44 * 16, n4 = n3 + 16 * 16;
  if (it < n1) { transpose_item(p.w_out, 1024, p.wt_out, 1024, it % 16, it / 16, 1, tile); }
  else if (it < n2) { int j = it - n1; transpose_item(p.w_gate_up, 2 * DFF, p.wt_gu, 1024, j % 16, j / 16, 2, tile, p.ffn_norm_w); }
  else if (it < n3) { int j = it - n2; transpose_item(p.w_down, 1024, p.wt_down, DFF, j % 44, j / 44, 1, tile); }
  else if (it < n4) { int j = it - n3; transpose_item(p.w_ple_gate, 1024, p.wt_pg, 1024, j % 16, j / 16, 1, tile, p.ple_norm_w); }
  else { int j = it - n4; transpose_item(p.w_ple_proj, 1024, p.wt_pp, 256, j % 4, j / 4, 1, tile); }
}

__device__ void phase_mixer(const P& p, unsigned char* smem, int rr) {
  volatile int* s_item_p = (volatile int*)(smem + SMEM_MAIN + 16);
  for (;;) {
    __syncthreads();
    if (threadIdx.x == 0) *s_item_p = (int)atomicAdd(&p.counters[rr], 1u);
    __syncthreads();
    const int item = *s_item_p;
    const int d0 = (gridDim.x == 512) ? DEFER_A : 0, d1 = (gridDim.x == 512) ? DEFER_B : N_DEFER;
    if (item >= NSCAN + 1024 + (d1 - d0)) break;
    if (item < NSCAN) { scan_unit(p, item, *(ScanSmem*)smem); }
    else if (item < NSCAN + 1024) { attn_unit(p, item - NSCAN, *(AttnSmem*)smem); }
    else { deferred_transpose(p, d0 + item - NSCAN - 1024, (float*)smem); }
  }
}

#define XB_TMO      128
#define XB_XCNT(j)  (256  + 64 * (j))
#define XB_XSUB(j)  (1280 + 64 * (j))
#define XB_XGEN(j)  (2304 + 64 * (j))
#define XB_TOP      3328
#define XB_TOPGEN   3392
#define XCD_BAR_WORDS 3456
#define XB_SPIN_CAP (1u << 20)
#define LAS __attribute__((address_space(3)))
__device__ __forceinline__ unsigned xb_ld(unsigned* p) { return __hip_atomic_load(p, __ATOMIC_RELAXED, __HIP_MEMORY_SCOPE_AGENT); }
__device__ __forceinline__ unsigned xb_add(unsigned* p, unsigned v) { return __hip_atomic_fetch_add(p, v, __ATOMIC_RELAXED, __HIP_MEMORY_SCOPE_AGENT); }
__device__ __forceinline__ unsigned xb_xcc_id() { return (unsigned)__builtin_amdgcn_s_getreg((3 << 11) | 20) & 0xFu; }
#define XB_SPIN(cond, bar) do { unsigned _sp = 0; while (cond) { __builtin_amdgcn_s_sleep(1); \
    if ((++_sp & 255u) == 0u) { if (xb_ld(&(bar)[XB_TMO])) break; if (_sp > XB_SPIN_CAP) { atomicAdd(&(bar)[XB_TMO], 1u); break; } } } } while (0)
struct XcdBarrier { unsigned* bar; unsigned x; volatile LAS unsigned* st; };
__device__ __forceinline__ XcdBarrier xcd_barrier_post(unsigned* bar, volatile LAS unsigned* st) {
  XcdBarrier b; b.bar = bar; b.x = xb_xcc_id(); b.st = st;
  if (threadIdx.x == 0) (void)xb_add(&bar[XB_XCNT(b.x)], 1u);
  return b;
}
__device__ __forceinline__ void xcd_barrier_complete(unsigned* bar, unsigned x, unsigned& nloc, unsigned& nx) {
  const unsigned G = gridDim.x * gridDim.y * gridDim.z;
  unsigned sum, cnt, mine, sp = 0u;
  for (;;) {
    sum = 0u; cnt = 0u; mine = 0u;
#pragma unroll
    for (unsigned j = 0; j < 16; ++j) { const unsigned c = xb_ld(&bar[XB_XCNT(j)]); sum += c; cnt += (c > 0u) ? 1u : 0u; mine = (j == x) ? c : mine; }
    if (sum == G) break;
    __builtin_amdgcn_s_sleep(1);
    if ((++sp & 255u) == 0u) { if (xb_ld(&bar[XB_TMO])) break; if (sp > XB_SPIN_CAP) { atomicAdd(&bar[XB_TMO], 1u); break; } }
  }
  nloc = mine > 0u ? mine : 1u; nx = cnt > 0u ? cnt : 1u;
}
__device__ __forceinline__ void xcd_barrier(const XcdBarrier& b) {
  asm volatile("s_waitcnt vmcnt(0)" ::: "memory");
  __syncthreads();
  if (threadIdx.x == 0) {
    unsigned* bar = b.bar;
    __builtin_amdgcn_s_waitcnt(0);
    unsigned nloc = b.st[0], nx = b.st[1];
    if (nloc == 0u) { xcd_barrier_complete(bar, b.x, nloc, nx); b.st[0] = nloc; b.st[1] = nx; }
    const unsigned old = xb_add(&bar[XB_XSUB(b.x)], 1u);
    const unsigned gen = old / nloc;
    if (old + 1u == (gen + 1u) * nloc) {
      __builtin_amdgcn_fence(__ATOMIC_RELEASE, "agent");
      asm volatile("s_waitcnt vmcnt(0)" ::: "memory");
      const unsigned og = xb_add(&bar[XB_TOP], 1u);
      const unsigned tg = og / nx;
      if (og + 1u == (tg + 1u) * nx) xb_add(&bar[XB_TOPGEN], 1u);
      else XB_SPIN(xb_ld(&bar[XB_TOPGEN]) == tg, bar);
      __builtin_amdgcn_fence(__ATOMIC_ACQUIRE, "agent");
      xb_add(&bar[XB_XGEN(b.x)], 1u);
      asm volatile("s_waitcnt vmcnt(0)" ::: "memory");
    } else {
      XB_SPIN(xb_ld(&bar[XB_XGEN(b.x)]) == gen, bar);
      __builtin_amdgcn_fence(__ATOMIC_ACQUIRE, "agent");
      asm volatile("s_waitcnt vmcnt(0)" ::: "memory");
    }
  }
  __syncthreads();
}

__global__ void __launch_bounds__(256, 2) mega(P p, int lo, int hi) {
  __shared__ __attribute__((aligned(16))) unsigned char smem[SMEM_MAIN + 32];
  cg::grid_group grid = cg::this_grid();
  uint4* xbw = (uint4*)(smem + SMEM_MAIN);
  if (threadIdx.x == 0) *xbw = make_uint4(0u, 0u, 0u, 0u);
  __syncthreads();
  XcdBarrier xb = xcd_barrier_post(p.bar, (volatile LAS unsigned*)xbw);
  if (hi < 0) grid.sync();
#define SEAM(k) if (lo <= k && k + 1 < hi) xcd_barrier(xb);
#if !defined(ONLY) || ONLY == 0
  if (lo <= 0 && 0 < hi) phase_prep(p, smem);
#endif
  SEAM(0)
#if !defined(ONLY) || ONLY == 1
  if (lo <= 1 && 1 < hi) phase_inproj(p, smem);
#endif
  SEAM(1)
#if !defined(ONLY) || ONLY == 2
  if (lo <= 2 && 2 < hi) phase_gdnprep(p, smem);
#endif
  SEAM(2)
#if !defined(ONLY) || ONLY == 3
  if (lo <= 3 && 3 < hi) phase_mixer(p, smem, 0);
#endif
  SEAM(3)
#if !defined(ONLY) || ONLY == 4
  if (lo <= 4 && 4 < hi) phase_gout(p, smem);
#endif
  SEAM(4)
#if !defined(ONLY) || ONLY == 5
  if (lo <= 5 && 5 < hi) phase_outproj(p, smem);
#endif
  SEAM(5)
#if !defined(ONLY) || ONLY == 6
  if (lo <= 6 && 6 < hi) phase_gateup(p, smem);
#endif
  SEAM(6)
#if !defined(ONLY) || ONLY == 7
  if (lo <= 7 && 7 < hi) phase_down(p, smem);
#endif
  SEAM(7)
#if !defined(ONLY) || ONLY == 8
  if (lo <= 8 && 8 < hi) phase_ple(p, smem);
#endif
  SEAM(8)
  if (lo <= 9 && 9 < hi) phase_final(p);
}

static_assert(sizeof(GemmSmem) <= SMEM_MAIN && sizeof(Gemm2Smem) <= SMEM_MAIN && sizeof(GdnSmem) <= SMEM_MAIN && sizeof(ScanSmem) <= SMEM_MAIN &&
              sizeof(GoutSmem) <= SMEM_MAIN && sizeof(AttnSmem) <= SMEM_MAIN && 64 * 65 * 4 <= SMEM_MAIN, "smem");

extern "C" void kernel_launch(void* const* d_in, const int* in_sizes, int n_in, void* d_out, int out_size,
                              void* d_ws, size_t ws_size, hipStream_t stream) {
  static int grid_blocks = 0;
  if (!grid_blocks) {
    int dev = 0, cus = 0, per_cu = 0;
    hipGetDevice(&dev);
    hipDeviceGetAttribute(&cus, hipDeviceAttributeMultiprocessorCount, dev);
    hipOccupancyMaxActiveBlocksPerMultiprocessor(&per_cu, mega, 256, 0);
    if (per_cu > 2) per_cu = 2;
    if (per_cu < 1) per_cu = 1;
    grid_blocks = cus * per_cu;
  }
  P p{};
  const float* const* in = (const float* const*)d_in;
  p.x = in[0]; p.p = in[1]; p.attn_norm_w = in[2]; p.w_in = in[3]; p.conv_w = in[4]; p.a_log = in[5];
  p.dt_bias = in[6]; p.gdn_norm_w = in[7]; p.fox_f_bias = in[8]; p.w_out = in[9]; p.ffn_norm_w = in[10];
  p.w_gate_up = in[11]; p.w_down = in[12]; p.ple_norm_w = in[13]; p.w_ple_gate = in[14]; p.w_ple_proj = in[15];
  p.final_norm_w = in[16];
  p.h = (float*)d_out;
  unsigned char* ws = (unsigned char*)d_ws;
  size_t off = 0;
  auto take = [&](size_t bytes) { unsigned char* r = ws + off; off += (bytes + 255) & ~(size_t)255; return r; };
  p.counters = (unsigned*)take(256);
  p.bar = (unsigned*)take(XCD_BAR_WORDS * 4);
  p.wt_in = (u16*)take((size_t)NIN_PAD * 1024 * 2);
  p.wt_out = (u16*)take((size_t)1024 * 1024 * 2);
  p.wt_gu = (u16*)take((size_t)2 * DFF * 1024 * 2);
  p.wt_down = (u16*)take((size_t)1024 * DFF * 2);
  p.wt_pg = (u16*)take((size_t)1024 * 1024 * 2);
  p.wt_pp = (u16*)take((size_t)1024 * 256 * 2);
  p.actA = (u16*)take((size_t)NTOK * 1024 * 2);
  p.pb = (u16*)take((size_t)NTOK * 256 * 2);
  p.proj = (u16*)take((size_t)NTOK * PROJW * 2);
  p.vt = (u16*)take((size_t)64 * 64 * SEQ * 2);
  p.gates = (float*)take((size_t)NTOK * 16 * 4);
  p.cf = (float*)take((size_t)64 * SEQ * 4);
  p.gM = (u16*)take((size_t)1024 * 16384 * 2);
  p.gC = (u16*)take((size_t)1024 * 16384 * 2);
  p.gdl = (float*)take(1024 * 4);
  p.rss = (float*)take((size_t)3 * NTOK * 4);
  p.hb = p.gM;
  if (off > ws_size) fprintf(stderr, "workspace too small: need %zu have %zu\n", off, ws_size);
  u16* ob = (u16*)d_out;
  p.gS = ob;
  p.gQ = ob + (size_t)1024 * 16384;
  p.gO = ob + (size_t)1024 * 16384 + (size_t)1024 * 8192;
  hipMemsetAsync(p.bar, 0, XCD_BAR_WORDS * 4, stream);
  int lo = 0, hi = NPHASE;
  void* args[] = {&p, &lo, &hi};
  hipError_t e = hipLaunchCooperativeKernel((void*)mega, dim3(grid_blocks), dim3(256), args, 0, stream);
  if (e != hipSuccess) fprintf(stderr, "cooperative launch failed: %s (grid %d)\n", hipGetErrorString(e), grid_blocks);
}
```

```cpp
#include <hip/hip_runtime.h>
#include <hip/hip_cooperative_groups.h>
#include <cstdio>
#include <cstdint>
namespace cg = cooperative_groups;

typedef unsigned short u16;
typedef __attribute__((ext_vector_type(8))) short bf16x8;
typedef __attribute__((ext_vector_type(4))) float f32x4;

#define NTOK 16384
#define SEQ 2048
#define DM 1024
#define DFF 2816
#define PROJW 3072
#define NIN_PAD 3712
#define EPSV 1e-6f
#define NPHASE 10
#define SMEM_MAIN 73728

struct P {
  const float *x, *p, *attn_norm_w, *w_in, *conv_w, *a_log, *dt_bias, *gdn_norm_w, *fox_f_bias, *w_out,
      *ffn_norm_w, *w_gate_up, *w_down, *ple_norm_w, *w_ple_gate, *w_ple_proj, *final_norm_w;
  float* h;
  u16 *wt_in, *wt_out, *wt_gu, *wt_down, *wt_pg, *wt_pp;
  u16 *actA;
  u16 *pb;
  u16 *proj;
  u16 *vt;
  float *gates;
  float *cf;
  u16 *gM, *gC;
  u16 *gQ, *gO;
  u16 *gS;
  float *gdl;
  unsigned *counters;
  unsigned *bar;
  u16 *hb;
  float *rss;
};

typedef __attribute__((ext_vector_type(2))) float f32x2_t;
typedef __attribute__((ext_vector_type(2))) __bf16 bf16x2_t;
__device__ __forceinline__ u16 f2bf(float f) { return __builtin_bit_cast(u16, (__bf16)f); }
__device__ __forceinline__ float bf2f(u16 h) { return __uint_as_float(((unsigned)h) << 16); }
__device__ __forceinline__ unsigned pack2(float a, float b) {
  f32x2_t f = {a, b};
  return __builtin_bit_cast(unsigned, __builtin_convertvector(f, bf16x2_t));
}
__device__ __forceinline__ float siluf(float v) { return v / (1.f + __expf(-v)); }
__device__ __forceinline__ float sigmoidf_(float v) { return 1.f / (1.f + __expf(-v)); }
__device__ __forceinline__ f32x4 mfma16(bf16x8 a, bf16x8 b, f32x4 c) {
  return __builtin_amdgcn_mfma_f32_16x16x32_bf16(a, b, c, 0, 0, 0);
}
#define LDS_FENCE() asm volatile("s_waitcnt lgkmcnt(0)" ::: "memory")

__device__ __forceinline__ void unpack8(const uint4& v, float (&f)[8]) {
  f[0] = bf2f((u16)(v.x & 0xffffu)); f[1] = bf2f((u16)(v.x >> 16));
  f[2] = bf2f((u16)(v.y & 0xffffu)); f[3] = bf2f((u16)(v.y >> 16));
  f[4] = bf2f((u16)(v.z & 0xffffu)); f[5] = bf2f((u16)(v.z >> 16));
  f[6] = bf2f((u16)(v.w & 0xffffu)); f[7] = bf2f((u16)(v.w >> 16));
}
__device__ __forceinline__ void unpack4(const uint2& v, float (&f)[4]) {
  f[0] = bf2f((u16)(v.x & 0xffffu)); f[1] = bf2f((u16)(v.x >> 16));
  f[2] = bf2f((u16)(v.y & 0xffffu)); f[3] = bf2f((u16)(v.y >> 16));
}


__device__ __forceinline__ int colmap(int kind, int nn) {
  if (kind == 0) {
    if (nn < 2048) return nn;
    if (nn < 3584) return nn + 8;
    if (nn < 3588) return 2048 + (nn - 3584);
    if (nn < 3592) return 2052 + (nn - 3588);
    if (nn < 3600) return nn;
    return -1;
  } else if (kind == 2) {
    int i = nn >> 7, wc = (nn >> 6) & 1, u = (nn >> 5) & 1, j = nn & 31;
    return u * DFF + 64 * i + 32 * wc + j;
  }
  return nn;
}

__device__ void transpose_item(const float* __restrict__ src, int ldsrc, u16* __restrict__ dst, int K,
                               int kt, int nt, int kind, float* tile, const float* __restrict__ kscale = nullptr) {
  int tid = threadIdx.x;
  asm volatile("" : "+v"(tid));
  const int c = tid & 63, r0 = tid >> 6;
  const int ncol = colmap(kind, nt * 64 + c);
  float tv[16];
#pragma unroll
  for (int i = 0; i < 16; i++) {
    int r = r0 + 4 * i;
    tv[i] = (ncol >= 0) ? __builtin_nontemporal_load(&src[(size_t)(kt * 64 + r) * ldsrc + ncol]) : 0.f;
  }
  if (kscale) {
#pragma unroll
    for (int i = 0; i < 16; i++) tv[i] *= kscale[kt * 64 + r0 + 4 * i];
  }
#pragma unroll
  for (int i = 0; i < 16; i++) tile[(r0 + 4 * i) * 65 + c] = tv[i];
  __syncthreads();
#pragma unroll 8
  for (int i = 0; i < 16; i++) {
    int rn = r0 + 4 * i;
    dst[(size_t)(nt * 64 + rn) * K + kt * 64 + c] = f2bf(tile[c * 65 + rn]);
  }
  __syncthreads();
}

__device__ __forceinline__ void rmsnorm_row(const float* src, const float* __restrict__ w,
                                            u16* dstb, float* dstf, int row) {
  const int lane = threadIdx.x & 63;
  float4 v[4];
  float ss = 0.f;
#pragma unroll
  for (int i = 0; i < 4; i++) {
    v[i] = *(const float4*)&src[(size_t)row * DM + i * 256 + lane * 4];
    ss += v[i].x * v[i].x + v[i].y * v[i].y + v[i].z * v[i].z + v[i].w * v[i].w;
  }
#pragma unroll
  for (int off = 32; off >= 1; off >>= 1) ss += __shfl_xor(ss, off);
  const float r = rsqrtf(ss * (1.f / DM) + EPSV);
#pragma unroll
  for (int i = 0; i < 4; i++) {
    const int col = i * 256 + lane * 4;
    float4 wv = *(const float4*)&w[col];
    float y0 = v[i].x * r * wv.x, y1 = v[i].y * r * wv.y, y2 = v[i].z * r * wv.z, y3 = v[i].w * r * wv.w;
    if (dstb) {
      uint2 o; o.x = pack2(y0, y1); o.y = pack2(y2, y3);
      *(uint2*)&dstb[(size_t)row * DM + col] = o;
    } else {
      *(float4*)&dstf[(size_t)row * DM + col] = make_float4(y0, y1, y2, y3);
    }
  }
}

__device__ void phase_prep(const P& p, unsigned char* smem) {
  float* tile = (float*)smem;
  if (blockIdx.x == 0 && threadIdx.x < 16) p.counters[threadIdx.x] = 0u;
  for (int i = blockIdx.x * 256 + threadIdx.x; i < 3 * NTOK; i += gridDim.x * 256) p.rss[i] = 0.f;
  for (int it = blockIdx.x; it < 16 * 58; it += gridDim.x) transpose_item(p.w_in, 3600, p.wt_in, 1024, it % 16, it / 16, 0, tile);
  const int wave = threadIdx.x >> 6, lane = threadIdx.x & 63;
  for (int rb = blockIdx.x; rb < NTOK / 8; rb += gridDim.x) {
    const int row = rb * 8 + wave * 2;
    float4 v0[4], v1[4];
#pragma unroll
    for (int i = 0; i < 4; i++) {
      { const f32x4 t0 = __builtin_nontemporal_load((const f32x4*)&p.x[(size_t)row * DM + i * 256 + lane * 4]);
        const f32x4 t1 = __builtin_nontemporal_load((const f32x4*)&p.x[(size_t)(row + 1) * DM + i * 256 + lane * 4]);
        v0[i] = make_float4(t0[0], t0[1], t0[2], t0[3]); v1[i] = make_float4(t1[0], t1[1], t1[2], t1[3]); }
    }
    const float4 pv0 = *(const float4*)&p.p[(size_t)row * 256 + lane * 4];
    const float4 pv1 = *(const float4*)&p.p[(size_t)(row + 1) * 256 + lane * 4];
    float s0 = 0.f, s1 = 0.f;
#pragma unroll
    for (int i = 0; i < 4; i++) {
      s0 += v0[i].x * v0[i].x + v0[i].y * v0[i].y + v0[i].z * v0[i].z + v0[i].w * v0[i].w;
      s1 += v1[i].x * v1[i].x + v1[i].y * v1[i].y + v1[i].z * v1[i].z + v1[i].w * v1[i].w;
    }
#pragma unroll
    for (int off = 32; off >= 1; off >>= 1) { s0 += __shfl_xor(s0, off); s1 += __shfl_xor(s1, off); }
    const float r0 = rsqrtf(s0 * (1.f / DM) + EPSV), r1 = rsqrtf(s1 * (1.f / DM) + EPSV);
#pragma unroll
    for (int i = 0; i < 4; i++) {
      const int col = i * 256 + lane * 4;
      const float4 wv = *(const float4*)&p.attn_norm_w[col];
      uint2 o;
      o.x = pack2(v0[i].x * r0 * wv.x, v0[i].y * r0 * wv.y); o.y = pack2(v0[i].z * r0 * wv.z, v0[i].w * r0 * wv.w);
      *(uint2*)&p.actA[(size_t)row * DM + col] = o;
      o.x = pack2(v1[i].x * r1 * wv.x, v1[i].y * r1 * wv.y); o.y = pack2(v1[i].z * r1 * wv.z, v1[i].w * r1 * wv.w);
      *(uint2*)&p.actA[(size_t)(row + 1) * DM + col] = o;
    }
    uint2 o; o.x = pack2(pv0.x, pv0.y); o.y = pack2(pv0.z, pv0.w);
    *(uint2*)&p.pb[(size_t)row * 256 + lane * 4] = o;
    o.x = pack2(pv1.x, pv1.y); o.y = pack2(pv1.z, pv1.w);
    *(uint2*)&p.pb[(size_t)(row + 1) * 256 + lane * 4] = o;
  }
}

__device__ void phase_rmsnorm(const float* src, const float* w, u16* dstb, float* dstf) {
  const int wave = threadIdx.x >> 6;
  for (int rb = blockIdx.x; rb < NTOK / 4; rb += gridDim.x) rmsnorm_row(src, w, dstb, dstf, rb * 4 + wave);
}

__device__ void phase_final(const P& p) {
  const int wave = threadIdx.x >> 6, lane = threadIdx.x & 63;
  for (int rb = blockIdx.x; rb < NTOK / 4; rb += gridDim.x) {
    const int row = rb * 4 + wave;
    const float r = rsqrtf(p.rss[2 * NTOK + row] * (1.f / DM) + EPSV);
#pragma unroll
    for (int i = 0; i < 4; i++) {
      const int col = i * 256 + lane * 4;
      float hv[4];
      unpack4(*(const uint2*)&p.hb[(size_t)row * DM + col], hv);
      const float4 wv = *(const float4*)&p.final_norm_w[col];
      f32x4 o = {hv[0] * r * wv.x, hv[1] * r * wv.y, hv[2] * r * wv.z, hv[3] * r * wv.w};
      __builtin_nontemporal_store(o, (f32x4*)&p.h[(size_t)row * DM + col]);
    }
  }
}

#define GK 64
struct GemmSmem { u16 a[2][128 * GK]; u16 b[2][128 * GK]; };

template <bool SWAP>
__device__ __forceinline__ void gemm_tile(const u16* __restrict__ A, int lda, const u16* __restrict__ Bt, int ldb,
                                          int K, int m0, int n0, GemmSmem& s, f32x4 (&acc)[4][4]) {
  int tid = threadIdx.x;
  asm volatile("" : "+v"(tid));
  const int lane = tid & 63, wave = tid >> 6;
  const int wr = wave >> 1, wc = wave & 1;
  const int l15 = lane & 15, g = lane >> 4;
  const int nk = K / GK;
  const int drow = 8 * wave + (lane >> 3);
  const int dchunk = (lane & 7) ^ ((4 * (wave & 1) + (lane >> 4)) & 7);
  const u16* Ap = A + (size_t)(m0 + drow) * lda + dchunk * 8;
  const u16* Bp = Bt + (size_t)(n0 + drow) * ldb + dchunk * 8;
  const size_t sa = (size_t)32 * lda, sb = (size_t)32 * ldb;
#define G_DMA(bufi, koff) do { \
    _Pragma("unroll") for (int _i = 0; _i < 4; _i++) { \
      __builtin_amdgcn_global_load_lds((const unsigned*)(Ap + _i * sa + (koff)), (unsigned*)&s.a[bufi][(32 * _i + 8 * wave) * GK], 16, 0, 0); \
      __builtin_amdgcn_global_load_lds((const unsigned*)(Bp + _i * sb + (koff)), (unsigned*)&s.b[bufi][(32 * _i + 8 * wave) * GK], 16, 0, 0); \
    } } while (0)
  const int fo0 = l15 * GK + ((g ^ (l15 >> 1)) * 8);
  const int fo1 = l15 * GK + (((4 + g) ^ (l15 >> 1)) * 8);
  G_DMA(0, 0);
  asm volatile("s_waitcnt vmcnt(0)" ::: "memory");
  __builtin_amdgcn_s_barrier();
  asm volatile("" ::: "memory");
  for (int kt = 0; kt < nk; kt++) {
    const int buf = kt & 1;
    if (kt + 1 < nk) { if (buf) G_DMA(0, (kt + 1) * GK); else G_DMA(1, (kt + 1) * GK); }
    const u16* sa_ = &s.a[buf][(wr * 64) * GK];
    const u16* sb_ = &s.b[buf][(wc * 64) * GK];
#pragma unroll
    for (int ks = 0; ks < 2; ks++) {
      const int fo = ks ? fo1 : fo0;
      bf16x8 af[4], bfr[4];
#pragma unroll
      for (int mi = 0; mi < 4; mi++) af[mi] = *(const bf16x8*)&sa_[mi * 16 * GK + fo];
#pragma unroll
      for (int ni = 0; ni < 4; ni++) bfr[ni] = *(const bf16x8*)&sb_[ni * 16 * GK + fo];
#pragma unroll
      for (int mi = 0; mi < 4; mi++)
#pragma unroll
        for (int ni = 0; ni < 4; ni++) acc[mi][ni] = SWAP ? mfma16(bfr[ni], af[mi], acc[mi][ni]) : mfma16(af[mi], bfr[ni], acc[mi][ni]);
    }
    asm volatile("s_waitcnt vmcnt(0) lgkmcnt(0)" ::: "memory");
    __builtin_amdgcn_s_barrier();
    asm volatile("" ::: "memory");
  }
}


#define G2K 32
struct Gemm2Smem { u16 a[3][256 * G2K]; u16 b[3][128 * G2K]; };

template <bool SWAP>
__device__ __forceinline__ void gemm256(const u16* __restrict__ A, int lda, const u16* __restrict__ Bt, int ldb,
                                        int K, int m0, int n0, Gemm2Smem& s, f32x4 (&acc)[8][4]) {
  int tid = threadIdx.x;
  asm volatile("" : "+v"(tid));
  const int lane = tid & 63, wave = tid >> 6;
  const int wr = wave >> 1, wc = wave & 1;
  const int l15 = lane & 15, g = lane >> 4;
  const int nk = K / G2K;
  const int drow = 16 * wave + (lane >> 2);
  const int dchunk = (lane & 3) ^ g;
  const u16* Ap = A + (size_t)(m0 + drow) * lda + dchunk * 8;
  const u16* Bp = Bt + (size_t)(n0 + drow) * ldb + dchunk * 8;
  const size_t sa = (size_t)64 * lda, sb = (size_t)64 * ldb;
  u16* const sa0 = &s.a[0][0] + (16 * wave) * G2K;
  u16* const sb0 = &s.b[0][0] + (16 * wave) * G2K;
#define G2_DMA(st, koff) do { \
    u16* _da = sa0 + (st) * (256 * G2K); u16* _db = sb0 + (st) * (128 * G2K); \
    _Pragma("unroll") for (int _i = 0; _i < 4; _i++) \
      __builtin_amdgcn_global_load_lds((const unsigned*)(Ap + _i * sa + (koff)), (unsigned*)(_da + 64 * _i * G2K), 16, 0, 0); \
    _Pragma("unroll") for (int _i = 0; _i < 2; _i++) \
      __builtin_amdgcn_global_load_lds((const unsigned*)(Bp + _i * sb + (koff)), (unsigned*)(_db + 64 * _i * G2K), 16, 0, 0); \
  } while (0)
  const int fo = l15 * G2K + ((g ^ ((l15 >> 2) & 3)) * 8);
  asm volatile("s_waitcnt lgkmcnt(0)" ::: "memory");
  __builtin_amdgcn_s_barrier();
  asm volatile("" ::: "memory");
#pragma unroll 1
  for (int j = 0; j < 2; j++) G2_DMA(j, j * G2K);
  int st = 0;
  for (int kt = 0; kt < nk; kt++) {
    if (kt + 1 < nk) asm volatile("s_waitcnt vmcnt(6)" ::: "memory");
    else asm volatile("s_waitcnt vmcnt(0)" ::: "memory");
    __builtin_amdgcn_s_barrier();
    asm volatile("" ::: "memory");
    if (kt + 2 < nk) {
      const int st2 = (st >= 1) ? st - 1 : 2;
      G2_DMA(st2, (kt + 2) * G2K);
    }
    const u16* sa_ = &s.a[0][0] + st * (256 * G2K) + (wr * 128) * G2K + fo;
    const u16* sb_ = &s.b[0][0] + st * (128 * G2K) + (wc * 64) * G2K + fo;
    bf16x8 af[8], bfr[4];
#pragma unroll
    for (int mi = 0; mi < 8; mi++) af[mi] = *(const bf16x8*)&sa_[mi * 16 * G2K];
#pragma unroll
    for (int ni = 0; ni < 4; ni++) bfr[ni] = *(const bf16x8*)&sb_[ni * 16 * G2K];
#pragma unroll
    for (int mi = 0; mi < 8; mi++)
#pragma unroll
      for (int ni = 0; ni < 4; ni++) acc[mi][ni] = SWAP ? mfma16(bfr[ni], af[mi], acc[mi][ni]) : mfma16(af[mi], bfr[ni], acc[mi][ni]);
    st = (st == 2) ? 0 : st + 1;
  }
}
#define ZERO_ACC8(acc) _Pragma("unroll") for (int _i = 0; _i < 8; _i++) _Pragma("unroll") for (int _j = 0; _j < 4; _j++) acc[_i][_j] = (f32x4){0.f, 0.f, 0.f, 0.f};

#define ZERO_ACC(acc) _Pragma("unroll") for (int _i = 0; _i < 4; _i++) _Pragma("unroll") for (int _j = 0; _j < 4; _j++) acc[_i][_j] = (f32x4){0.f, 0.f, 0.f, 0.f};

template <int NMI>
__device__ __forceinline__ void row_sumsq_add(f32x4 (&sq)[NMI][4], float* rss, int row0, int l15, int g) {
#pragma unroll
  for (int mi = 0; mi < NMI; mi++) {
    float v = 0.f;
#pragma unroll
    for (int ni = 0; ni < 4; ni++) v += (sq[mi][ni][0] + sq[mi][ni][1]) + (sq[mi][ni][2] + sq[mi][ni][3]);
    v += __shfl_xor(v, 16);
    v += __shfl_xor(v, 32);
    if (g == 0) atomicAdd(&rss[row0 + mi * 16 + l15], v);
  }
}

__device__ void deferred_transpose(const P& p, int it, float* tile);
#define N_DEFER (16 * 16 + 16 * 88 + 44 * 16 + 16 * 16 + 4 * 16)
#define DEFER_A 960
#define DEFER_B 1664

__device__ void phase_inproj(const P& p, unsigned char* smem) {
  Gemm2Smem& s = *(Gemm2Smem*)smem;
  const int lane = threadIdx.x & 63, wave = threadIdx.x >> 6, wr = wave >> 1, wc = wave & 1, l15 = lane & 15, g = lane >> 4;
  const int ntiles = 64 * 29;
  for (int tl = blockIdx.x; tl < ntiles; tl += gridDim.x) {
    const int mt = tl & 63, nt = tl >> 6;
    const int m0 = mt * 256, n0 = nt * 128;
    f32x4 acc[8][4];
    ZERO_ACC8(acc);
    if (nt >= 24 && nt < 28) {
      gemm256<false>(p.actA, DM, p.wt_in, DM, DM, m0, n0, s, acc);
#pragma unroll
      for (int mi = 0; mi < 8; mi++)
#pragma unroll
        for (int ni = 0; ni < 4; ni++) {
          const int rowb = m0 + wr * 128 + mi * 16 + g * 4;
          const int col = n0 + wc * 64 + ni * 16 + l15;
          const int cc = col - 3072, hh = cc >> 6, d = cc & 63;
          const int b = rowb >> 11, sq = rowb & 2047;
          uint2 o; o.x = pack2(acc[mi][ni][0], acc[mi][ni][1]); o.y = pack2(acc[mi][ni][2], acc[mi][ni][3]);
          *(uint2*)&p.vt[((size_t)((b * 8 + hh) * 64 + d)) * SEQ + sq] = o;
        }
    } else {
      gemm256<true>(p.actA, DM, p.wt_in, DM, DM, m0, n0, s, acc);
#pragma unroll
      for (int mi = 0; mi < 8; mi++)
#pragma unroll
        for (int ni = 0; ni < 4; ni++) {
          const int row = m0 + wr * 128 + mi * 16 + l15;
          const int col = n0 + wc * 64 + ni * 16 + g * 4;
          if (nt < 24) {
            uint2 o; o.x = pack2(acc[mi][ni][0], acc[mi][ni][1]); o.y = pack2(acc[mi][ni][2], acc[mi][ni][3]);
            *(uint2*)&p.proj[(size_t)row * PROJW + col] = o;
          } else if (col < 3600) {
            *(float4*)&p.gates[(size_t)row * 16 + (col - 3584)] = make_float4(acc[mi][ni][0], acc[mi][ni][1], acc[mi][ni][2], acc[mi][ni][3]);
          }
        }
    }
  }
  if (gridDim.x == 512 && blockIdx.x >= 320) {
    __syncthreads();
    for (int it = (int)blockIdx.x - 320; it < DEFER_A; it += 192) deferred_transpose(p, it, (float*)smem);
  }
}

__device__ void phase_outproj(const P& p, unsigned char* smem) {
  GemmSmem& s = *(GemmSmem*)smem;
  const int lane = threadIdx.x & 63, wave = threadIdx.x >> 6, wr = wave >> 1, wc = wave & 1, l15 = lane & 15, g = lane >> 4;
  for (int tl = blockIdx.x; tl < 128 * 8; tl += gridDim.x) {
    const int mt = tl & 127, nt = tl >> 7;
    const int m0 = mt * 128, n0 = nt * 128;
    f32x4 acc[4][4];
    ZERO_ACC(acc);
    gemm_tile<true>(p.actA, DM, p.wt_out, DM, DM, m0, n0, s, acc);
#pragma unroll
    for (int mi = 0; mi < 4; mi++)
#pragma unroll
      for (int ni = 0; ni < 4; ni++) {
        const size_t idx = (size_t)(m0 + wr * 64 + mi * 16 + l15) * DM + n0 + wc * 64 + ni * 16 + g * 4;
        const f32x4 xv4 = __builtin_nontemporal_load((const f32x4*)&p.x[idx]);
        const float4 xv = make_float4(xv4[0], xv4[1], xv4[2], xv4[3]);
        const float h0 = xv.x + acc[mi][ni][0], h1 = xv.y + acc[mi][ni][1], h2 = xv.z + acc[mi][ni][2], h3 = xv.w + acc[mi][ni][3];
        uint2 o; o.x = pack2(h0, h1); o.y = pack2(h2, h3);
        *(uint2*)&p.hb[idx] = o;
        acc[mi][ni] = (f32x4){h0 * h0, h1 * h1, h2 * h2, h3 * h3};
      }
    row_sumsq_add(acc, p.rss, m0 + wr * 64, l15, g);
  }
}

__device__ void phase_gateup(const P& p, unsigned char* smem) {
  Gemm2Smem& s = *(Gemm2Smem*)smem;
  u16* act = p.proj;
  const int lane = threadIdx.x & 63, wave = threadIdx.x >> 6, wr = wave >> 1, wc = wave & 1, l15 = lane & 15, g = lane >> 4;
  for (int tl = blockIdx.x; tl < 64 * 44; tl += gridDim.x) {
    const int mt = tl & 63, nt = tl >> 6;
    const int m0 = mt * 256, n0 = nt * 128;
    f32x4 acc[8][4];
    ZERO_ACC8(acc);
    gemm256<true>(p.hb, DM, p.wt_gu, DM, DM, m0, n0, s, acc);
#pragma unroll
    for (int mi = 0; mi < 8; mi++) {
      const int row = m0 + wr * 128 + mi * 16 + l15;
      const float rs = rsqrtf(p.rss[row] * (1.f / DM) + EPSV);
#pragma unroll
      for (int ni = 0; ni < 2; ni++) {
        const int col = 64 * nt + 32 * wc + 16 * ni + g * 4;
        float v[4];
#pragma unroll
        for (int r = 0; r < 4; r++) v[r] = siluf(acc[mi][ni][r] * rs) * (acc[mi][ni + 2][r] * rs);
        uint2 o; o.x = pack2(v[0], v[1]); o.y = pack2(v[2], v[3]);
        *(uint2*)&act[(size_t)row * DFF + col] = o;
      }
    }
  }
  if (gridDim.x == 512 && blockIdx.x >= 256) {
    __syncthreads();
    for (int it = DEFER_B + (int)blockIdx.x - 256; it < N_DEFER; it += 256) deferred_transpose(p, it, (float*)smem);
  }
}

__device__ void phase_down(const P& p, unsigned char* smem) {
  GemmSmem& s = *(GemmSmem*)smem;
  const u16* act = p.proj;
  const int lane = threadIdx.x & 63, wave = threadIdx.x >> 6, wr = wave >> 1, wc = wave & 1, l15 = lane & 15, g = lane >> 4;
  for (int tl = blockIdx.x; tl < 128 * 8; tl += gridDim.x) {
    const int mt = tl & 127, nt = tl >> 7;
    const int m0 = mt * 128, n0 = nt * 128;
    f32x4 acc[4][4];
    ZERO_ACC(acc);
    gemm_tile<true>(act, DFF, p.wt_down, DFF, DFF, m0, n0, s, acc);
#pragma unroll
    for (int mi = 0; mi < 4; mi++)
#pragma unroll
      for (int ni = 0; ni < 4; ni++) {
        const size_t idx = (size_t)(m0 + wr * 64 + mi * 16 + l15) * DM + n0 + wc * 64 + ni * 16 + g * 4;
        float hp[4];
        unpack4(*(const uint2*)&p.hb[idx], hp);
        const float h0 = hp[0] + acc[mi][ni][0], h1 = hp[1] + acc[mi][ni][1], h2 = hp[2] + acc[mi][ni][2], h3 = hp[3] + acc[mi][ni][3];
        uint2 o; o.x = pack2(h0, h1); o.y = pack2(h2, h3);
        *(uint2*)&p.actA[idx] = o;
        acc[mi][ni] = (f32x4){h0 * h0, h1 * h1, h2 * h2, h3 * h3};
      }
    row_sumsq_add(acc, p.rss + NTOK, m0 + wr * 64, l15, g);
  }
}

__device__ void phase_ple(const P& p, unsigned char* smem) {
  GemmSmem& s = *(GemmSmem*)smem;
  const int lane = threadIdx.x & 63, wave = threadIdx.x >> 6, wr = wave >> 1, wc = wave & 1, l15 = lane & 15, g = lane >> 4;
  for (int tl = blockIdx.x; tl < 128 * 8; tl += gridDim.x) {
    const int mt = tl & 127, nt = tl >> 7;
    const int m0 = mt * 128, n0 = nt * 128;
    f32x4 acc[4][4], acc2[4][4];
    ZERO_ACC(acc);
    gemm_tile<true>(p.actA, DM, p.wt_pg, DM, DM, m0, n0, s, acc);
#pragma unroll
    for (int mi = 0; mi < 4; mi++) {
      const float rs = rsqrtf(p.rss[NTOK + m0 + wr * 64 + mi * 16 + l15] * (1.f / DM) + EPSV);
#pragma unroll
      for (int ni = 0; ni < 4; ni++)
#pragma unroll
        for (int r = 0; r < 4; r++) acc[mi][ni][r] = sigmoidf_(acc[mi][ni][r] * rs);
    }
    ZERO_ACC(acc2);
    gemm_tile<true>(p.pb, 256, p.wt_pp, 256, 256, m0, n0, s, acc2);
#pragma unroll
    for (int mi = 0; mi < 4; mi++)
#pragma unroll
      for (int ni = 0; ni < 4; ni++) {
        const size_t idx = (size_t)(m0 + wr * 64 + mi * 16 + l15) * DM + n0 + wc * 64 + ni * 16 + g * 4;
        float hp[4];
        unpack4(*(const uint2*)&p.actA[idx], hp);
        const float h0 = hp[0] + acc[mi][ni][0] * acc2[mi][ni][0], h1 = hp[1] + acc[mi][ni][1] * acc2[mi][ni][1];
        const float h2 = hp[2] + acc[mi][ni][2] * acc2[mi][ni][2], h3 = hp[3] + acc[mi][ni][3] * acc2[mi][ni][3];
        { uint2 o; o.x = pack2(h0, h1); o.y = pack2(h2, h3); *(uint2*)&p.hb[idx] = o; }
        acc2[mi][ni] = (f32x4){h0 * h0, h1 * h1, h2 * h2, h3 * h3};
      }
    row_sumsq_add(acc2, p.rss + 2 * NTOK, m0 + wr * 64, l15, g);
  }
}

#define QLD 136
#define KLD 72
struct GdnSmem {
  u16 qb[64 * QLD];
  u16 kn[64 * QLD];
  u16 vb[64 * QLD];
  float Am[64 * 64];
  float gc[64], beta[64], be[64];
};
static_assert(offsetof(GdnSmem, kn) == 17408 && offsetof(GdnSmem, vb) == 34816 && offsetof(GdnSmem, Am) == 52224, "layout");


__device__ void gdn_unit(const P& p, int unit, GdnSmem& s) {
  int tid = threadIdx.x;
  asm volatile("" : "+v"(tid));
  int lane = tid & 63, wave = tid >> 6;
  int l15 = lane & 15, g = lane >> 4;
#define GDN_REFRESH() do { tid = threadIdx.x; asm volatile("" : "+v"(tid) :: "memory"); lane = tid & 63; wave = tid >> 6; l15 = lane & 15; g = lane >> 4; } while (0)
  const int bh = unit >> 5, n = unit & 31;
  const int b = bh >> 2, h = bh & 3;
  const int tb = b * SEQ;
  const int s0 = n * 64;
  u16* const qk_s = s.qb;
  u16* const WU = s.kn;
  u16* const kdT = (u16*)((unsigned char*)s.kn + 32768);
  __syncthreads();
  if (wave == 0) {
    const int t = tb + s0 + lane;
    const float ga = p.gates[(size_t)t * 16 + h], gb = p.gates[(size_t)t * 16 + 4 + h];
    const float xx = ga + p.dt_bias[h];
    const float sp = (xx > 20.f) ? xx : log1pf(__expf(xx));
    float gg = -__expf(p.a_log[h]) * sp;
#pragma unroll
    for (int off = 1; off < 64; off <<= 1) {
      float nb = __shfl_up(gg, off);
      if (lane >= off) gg += nb;
    }
    const float bt = sigmoidf_(gb);
    s.gc[lane] = gg;
    s.beta[lane] = bt;
    s.be[lane] = bt * __expf(gg);
  }
  {
    const int ch = tid & 15, rg = tid >> 4;
#pragma unroll 1
    for (int mat = 0; mat < 3; mat++) {
      const int col0 = mat * 512 + h * 128 + ch * 8;
      float cw[4][8];
#pragma unroll
      for (int k = 0; k < 4; k++) {
        const float4 w0 = *(const float4*)&p.conv_w[k * 1536 + col0];
        const float4 w1 = *(const float4*)&p.conv_w[k * 1536 + col0 + 4];
        cw[k][0] = w0.x; cw[k][1] = w0.y; cw[k][2] = w0.z; cw[k][3] = w0.w;
        cw[k][4] = w1.x; cw[k][5] = w1.y; cw[k][6] = w1.z; cw[k][7] = w1.w;
      }
      uint4 xr[7];
#pragma unroll
      for (int j = 0; j < 7; j++) {
        const int sp = s0 + 4 * rg + j - 3;
        if (sp >= 0) {
          typedef __attribute__((ext_vector_type(4))) unsigned u32x4_t;
          const u32x4_t t = __builtin_nontemporal_load((const u32x4_t*)&p.proj[(size_t)(tb + sp) * PROJW + col0]);
          xr[j] = make_uint4(t[0], t[1], t[2], t[3]);
        } else xr[j] = make_uint4(0u, 0u, 0u, 0u);
      }
      float xf[7][8];
#pragma unroll
      for (int j = 0; j < 7; j++) unpack8(xr[j], xf[j]);
      u16* dst = (mat == 0) ? s.qb : ((mat == 1) ? s.kn : s.vb);
#pragma unroll
      for (int r = 0; r < 4; r++) {
        float val[8];
        float ss = 0.f;
#pragma unroll
        for (int c = 0; c < 8; c++) {
          const float cv = cw[0][c] * xf[r][c] + cw[1][c] * xf[r + 1][c] + cw[2][c] * xf[r + 2][c] + cw[3][c] * xf[r + 3][c];
          val[c] = siluf(cv);
          ss += val[c] * val[c];
        }
        float rs = 1.f;
        if (mat < 2) {
#pragma unroll
          for (int off = 1; off < 16; off <<= 1) ss += __shfl_xor(ss, off);
          rs = rsqrtf(ss + EPSV) * ((mat == 0) ? 0.08838834764831845f : 1.f);
        }
        uint4 o;
        o.x = pack2(val[0] * rs, val[1] * rs); o.y = pack2(val[2] * rs, val[3] * rs);
        o.z = pack2(val[4] * rs, val[5] * rs); o.w = pack2(val[6] * rs, val[7] * rs);
        *(uint4*)&dst[(4 * rg + r) * QLD + ch * 8] = o;
      }
    }
  }
  __syncthreads();
  GDN_REFRESH();
  u16* const gQ = p.gQ + (size_t)unit * 8192;
  {
#pragma unroll
    for (int it = 0; it < 4; it++) {
      const int idx = tid + 256 * it;
      const int i = idx >> 4, d8 = (idx & 15) * 8;
      const float e = __expf(s.gc[i]);
      float f[8];
      unpack8(*(const uint4*)&s.qb[i * QLD + d8], f);
      uint4 o;
      o.x = pack2(f[0] * e, f[1] * e); o.y = pack2(f[2] * e, f[3] * e);
      o.z = pack2(f[4] * e, f[5] * e); o.w = pack2(f[6] * e, f[7] * e);
      *(uint4*)&gQ[i * 128 + d8] = o;
    }
  }
  f32x4 cqk[4];
  {
    bf16x8 aq[4], ak[4];
#pragma unroll
    for (int ks = 0; ks < 4; ks++) {
      aq[ks] = *(const bf16x8*)&s.qb[(wave * 16 + l15) * QLD + ks * 32 + g * 8];
      ak[ks] = *(const bf16x8*)&s.kn[(wave * 16 + l15) * QLD + ks * 32 + g * 8];
    }
#pragma unroll
    for (int ni = 0; ni < 4; ni++) {
      f32x4 ckk = {0.f, 0.f, 0.f, 0.f};
      cqk[ni] = (f32x4){0.f, 0.f, 0.f, 0.f};
      if (ni <= wave) {
#pragma unroll
        for (int ks = 0; ks < 4; ks++) {
          bf16x8 bk = *(const bf16x8*)&s.kn[(ni * 16 + l15) * QLD + ks * 32 + g * 8];
          ckk = mfma16(ak[ks], bk, ckk);
          cqk[ni] = mfma16(aq[ks], bk, cqk[ni]);
        }
      }
      const int j = ni * 16 + l15;
      const float gcj = s.gc[j];
#pragma unroll
      for (int r = 0; r < 4; r++) {
        const int i = wave * 16 + g * 4 + r;
        const float dec = (i >= j) ? __expf(s.gc[i] - gcj) : 0.f;
        s.Am[i * 64 + j] = (i > j) ? ckk[r] * s.beta[i] * dec : 0.f;
        cqk[ni][r] = (i >= j) ? cqk[ni][r] * dec : 0.f;
      }
    }
  }
  __syncthreads();
  GDN_REFRESH();
#pragma unroll
  for (int ni = 0; ni < 4; ni++)
#pragma unroll
    for (int r = 0; r < 4; r++) qk_s[(wave * 16 + g * 4 + r) * KLD + ni * 16 + l15] = f2bf(cqk[ni][r]);
  float xs[64];
#ifdef NO_SOLVE
  for (int i = 0; i < 64; i++) xs[i] = s.Am[i*64+tid%64];
#else
  {
    const int c = tid;
    const u16* src = (c < 128) ? &s.vb[c] : &s.kn[c - 128];
    const float* sc = (c < 128) ? s.beta : s.be;
#pragma unroll
    for (int i = 0; i < 64; i++) {
      float a0 = bf2f(src[i * QLD]) * sc[i], a1 = 0.f, a2 = 0.f, a3 = 0.f;
#pragma unroll
      for (int j4 = 0; j4 < (i + 3) / 4; j4++) {
        const float4 av = *(const float4*)&s.Am[i * 64 + j4 * 4];
        if (j4 * 4 + 0 < i) a0 -= av.x * xs[j4 * 4 + 0];
        if (j4 * 4 + 1 < i) a1 -= av.y * xs[j4 * 4 + 1];
        if (j4 * 4 + 2 < i) a2 -= av.z * xs[j4 * 4 + 2];
        if (j4 * 4 + 3 < i) a3 -= av.w * xs[j4 * 4 + 3];
      }
      xs[i] = (a0 + a1) + (a2 + a3);
      asm volatile("" : "+v"(xs[i]) :: "memory");
    }
  }
#endif
  const float glast = s.gc[63];
  __syncthreads();
  GDN_REFRESH();
  {
    const int d = tid & 127, half = tid >> 7;
#pragma unroll
    for (int q = 0; q < 4; q++) {
      unsigned ow[4];
#pragma unroll
      for (int e2 = 0; e2 < 4; e2++) {
        const int c0 = half * 32 + q * 8 + e2 * 2;
        const float v0 = bf2f(s.kn[c0 * QLD + d]) * __expf(glast - s.gc[c0]);
        const float v1 = bf2f(s.kn[(c0 + 1) * QLD + d]) * __expf(glast - s.gc[c0 + 1]);
        ow[e2] = pack2(v0, v1);
      }
      *(uint4*)&kdT[d * KLD + half * 32 + q * 8] = make_uint4(ow[0], ow[1], ow[2], ow[3]);
    }
    if (tid == 0) p.gdl[unit] = __expf(glast);
  }
  __syncthreads();
  GDN_REFRESH();
  if (tid >= 128) {
#pragma unroll
    for (int q = 0; q < 8; q++)
      *(uint4*)&WU[(tid - 128) * KLD + q * 8] = make_uint4(pack2(xs[q * 8], xs[q * 8 + 1]), pack2(xs[q * 8 + 2], xs[q * 8 + 3]),
                                                            pack2(xs[q * 8 + 4], xs[q * 8 + 5]), pack2(xs[q * 8 + 6], xs[q * 8 + 7]));
  }
  __syncthreads();
  GDN_REFRESH();
  {
    u16* const gM = p.gM + (size_t)unit * 16384;
    bf16x8 aw[2][2];
#pragma unroll
    for (int mm = 0; mm < 2; mm++)
#pragma unroll
      for (int ks = 0; ks < 2; ks++) aw[mm][ks] = *(const bf16x8*)&WU[((2 * wave + mm) * 16 + l15) * KLD + ks * 32 + g * 8];
#pragma unroll
    for (int nn = 0; nn < 8; nn++) {
      const bf16x8 b0 = *(const bf16x8*)&kdT[(nn * 16 + l15) * KLD + g * 8];
      const bf16x8 b1 = *(const bf16x8*)&kdT[(nn * 16 + l15) * KLD + 32 + g * 8];
#pragma unroll
      for (int mm = 0; mm < 2; mm++) {
        f32x4 acc = {0.f, 0.f, 0.f, 0.f};
        acc = mfma16(aw[mm][0], b0, acc);
        acc = mfma16(aw[mm][1], b1, acc);
        uint2 o; o.x = pack2(-acc[0], -acc[1]); o.y = pack2(-acc[2], -acc[3]);
        *(uint2*)&gM[(nn * 16 + l15) * 128 + (2 * wave + mm) * 16 + 4 * g] = o;
      }
    }
#pragma unroll
    for (int nn = 0; nn < 4; nn++) {
      const bf16x8 b0 = *(const bf16x8*)&qk_s[(nn * 16 + l15) * KLD + g * 8];
      const bf16x8 b1 = *(const bf16x8*)&qk_s[(nn * 16 + l15) * KLD + 32 + g * 8];
#pragma unroll
      for (int mm = 0; mm < 2; mm++) {
        f32x4 acc = {0.f, 0.f, 0.f, 0.f};
        acc = mfma16(aw[mm][0], b0, acc);
        acc = mfma16(aw[mm][1], b1, acc);
        u16* qp = &gQ[(nn * 16 + l15) * 128 + (2 * wave + mm) * 16 + 4 * g];
        float qv[4];
        unpack4(*(const uint2*)qp, qv);
        uint2 o; o.x = pack2(qv[0] - acc[0], qv[1] - acc[1]); o.y = pack2(qv[2] - acc[2], qv[3] - acc[3]);
        *(uint2*)qp = o;
      }
    }
  }
  __syncthreads();
  GDN_REFRESH();
  if (tid < 128) {
#pragma unroll
    for (int q = 0; q < 8; q++)
      *(uint4*)&WU[tid * KLD + q * 8] = make_uint4(pack2(xs[q * 8], xs[q * 8 + 1]), pack2(xs[q * 8 + 2], xs[q * 8 + 3]),
                                                    pack2(xs[q * 8 + 4], xs[q * 8 + 5]), pack2(xs[q * 8 + 6], xs[q * 8 + 7]));
  }
  __syncthreads();
  GDN_REFRESH();
  {
    u16* const gC = p.gC + (size_t)unit * 16384;
    u16* const gO = p.gO + (size_t)unit * 8192;
    bf16x8 akd[2][2], aqk[2];
#pragma unroll
    for (int mm = 0; mm < 2; mm++)
#pragma unroll
      for (int ks = 0; ks < 2; ks++) akd[mm][ks] = *(const bf16x8*)&kdT[((2 * wave + mm) * 16 + l15) * KLD + ks * 32 + g * 8];
#pragma unroll
    for (int ks = 0; ks < 2; ks++) aqk[ks] = *(const bf16x8*)&qk_s[(wave * 16 + l15) * KLD + ks * 32 + g * 8];
#pragma unroll
    for (int nn = 0; nn < 8; nn++) {
      const bf16x8 b0 = *(const bf16x8*)&WU[(nn * 16 + l15) * KLD + g * 8];
      const bf16x8 b1 = *(const bf16x8*)&WU[(nn * 16 + l15) * KLD + 32 + g * 8];
#pragma unroll
      for (int mm = 0; mm < 2; mm++) {
        f32x4 acc = {0.f, 0.f, 0.f, 0.f};
        acc = mfma16(akd[mm][0], b0, acc);
        acc = mfma16(akd[mm][1], b1, acc);
        uint2 o; o.x = pack2(acc[0], acc[1]); o.y = pack2(acc[2], acc[3]);
        *(uint2*)&gC[(nn * 16 + l15) * 128 + (2 * wave + mm) * 16 + 4 * g] = o;
      }
      {
        f32x4 acc = {0.f, 0.f, 0.f, 0.f};
        acc = mfma16(aqk[0], b0, acc);
        acc = mfma16(aqk[1], b1, acc);
        uint2 o; o.x = pack2(acc[0], acc[1]); o.y = pack2(acc[2], acc[3]);
        *(uint2*)&gO[(nn * 16 + l15) * 64 + wave * 16 + 4 * g] = o;
      }
    }
  }
}

__device__ void fox_cumsum_unit(const P& p, int bhf, float* red) {
  const int tid = threadIdx.x, lane = tid & 63, wave = tid >> 6;
  const int b = bhf >> 3, hf = bhf & 7;
  const float bias = p.fox_f_bias[hf];
  float v[8];
  float run = 0.f;
#pragma unroll
  for (int i = 0; i < 8; i++) {
    const int t = b * SEQ + tid * 8 + i;
    const float xx = p.gates[(size_t)t * 16 + 8 + hf] + bias;
    const float ls = fminf(xx, 0.f) - log1pf(__expf(-fabsf(xx)));
    run += ls;
    v[i] = run;
  }
  float tot = run;
#pragma unroll
  for (int off = 1; off < 64; off <<= 1) {
    float nb = __shfl_up(tot, off);
    if (lane >= off) tot += nb;
  }
  __syncthreads();
  if (lane == 63) red[wave] = tot;
  __syncthreads();
  float base = tot - run;
  for (int w = 0; w < wave; w++) base += red[w];
#pragma unroll
  for (int i = 0; i < 8; i++) p.cf[(size_t)bhf * SEQ + tid * 8 + i] = v[i] + base;
}

__device__ void phase_gdnprep(const P& p, unsigned char* smem) {
  GdnSmem& s = *(GdnSmem*)smem;
  for (int u = blockIdx.x; u < 1024 + 64; u += gridDim.x) {
    if (u < 1024) gdn_unit(p, u, s);
    else { __syncthreads(); fox_cumsum_unit(p, u - 1024, (float*)smem); }
  }
}

#define SLD 136
#define NSCAN 128
struct ScanSmem { u16 st[2][32 * SLD]; };
struct ScanSet { bf16x8 mf[2][4]; uint2 ci[2][2]; float dl; };

__device__ __forceinline__ void scan_load(const P& p, int unit, int eq, int w, int l15, int g, ScanSet& z) {
  int la = (32 * w + l15) * 128 + 8 * g, lc = (32 * eq + l15) * 128 + 32 * w + 4 * g;
  asm volatile("" : "+v"(la), "+v"(lc));
  const u16* gM = p.gM + (size_t)unit * 16384;
  const u16* gC = p.gC + (size_t)unit * 16384;
#pragma unroll
  for (int md = 0; md < 2; md++)
#pragma unroll
    for (int ks = 0; ks < 4; ks++) z.mf[md][ks] = *(const bf16x8*)&gM[la + md * 16 * 128 + ks * 32];
#pragma unroll
  for (int md = 0; md < 2; md++)
#pragma unroll
    for (int ne = 0; ne < 2; ne++) z.ci[md][ne] = *(const uint2*)&gC[lc + ne * 16 * 128 + md * 16];
  z.dl = p.gdl[unit];
}

__device__ __forceinline__ unsigned scan_touch(const P& p, int unit, int lane) {
  unsigned v = 0u;
  if (lane < 16) {
    const u16* base = (lane < 8) ? (p.gM + (size_t)unit * 16384) : (p.gC + (size_t)unit * 16384);
    v = *(const unsigned*)(base + (lane & 7) * 2048);
  }
  return v;
}

__device__ __forceinline__ void scan_step(const P& p, int unit, int n, int eq, int w, int l15, int g, ScanSmem& s,
                                          f32x4 (&st)[2][2], const ScanSet& z) {
  const u16* Sb = s.st[n & 1];
  u16* Sn = s.st[(n & 1) ^ 1];
#pragma unroll
  for (int md = 0; md < 2; md++)
#pragma unroll
    for (int ne = 0; ne < 2; ne++) {
      float c[4];
      unpack4(z.ci[md][ne], c);
      st[md][ne][0] = st[md][ne][0] * z.dl + c[0];
      st[md][ne][1] = st[md][ne][1] * z.dl + c[1];
      st[md][ne][2] = st[md][ne][2] * z.dl + c[2];
      st[md][ne][3] = st[md][ne][3] * z.dl + c[3];
    }
  if (n > 0) {
    int lb = l15 * SLD + 8 * g;
    asm volatile("" : "+v"(lb));
#pragma unroll
    for (int ne = 0; ne < 2; ne++) {
#pragma unroll
      for (int ks = 0; ks < 4; ks++) {
        const bf16x8 bs = *(const bf16x8*)&Sb[lb + 16 * ne * SLD + ks * 32];
        st[0][ne] = mfma16(z.mf[0][ks], bs, st[0][ne]);
        st[1][ne] = mfma16(z.mf[1][ks], bs, st[1][ne]);
      }
    }
  }
  if (n + 1 < 32) {
    u16* gS = p.gS + (size_t)(unit + 1) * 16384;
    int lsl = l15 * SLD + 32 * w + 4 * g, lsg = (32 * eq + l15) * 128 + 32 * w + 4 * g;
    asm volatile("" : "+v"(lsl), "+v"(lsg));
#pragma unroll
    for (int md = 0; md < 2; md++)
#pragma unroll
      for (int ne = 0; ne < 2; ne++) {
        uint2 o; o.x = pack2(st[md][ne][0], st[md][ne][1]); o.y = pack2(st[md][ne][2], st[md][ne][3]);
        *(uint2*)&Sn[lsl + 16 * ne * SLD + 16 * md] = o;
        *(uint2*)&gS[lsg + 16 * ne * 128 + 16 * md] = o;
      }
  }
  asm volatile("s_waitcnt lgkmcnt(0)" ::: "memory");
  __builtin_amdgcn_s_barrier();
  asm volatile("" ::: "memory");
}

__device__ void scan_unit(const P& p, int item, ScanSmem& s) {
  int tid = threadIdx.x;
  asm volatile("" : "+v"(tid));
  const int lane = tid & 63, w = tid >> 6;
  const int l15 = lane & 15, g = lane >> 4;
  const int bh = item >> 2, eq = item & 3;
  const int u0 = bh * 32;
  f32x4 st[2][2];
#pragma unroll
  for (int md = 0; md < 2; md++)
#pragma unroll
    for (int ne = 0; ne < 2; ne++) st[md][ne] = (f32x4){0.f, 0.f, 0.f, 0.f};
  ScanSet z0, z1, z2, z3;
  scan_load(p, u0 + 0, eq, w, l15, g, z0);
  scan_load(p, u0 + 1, eq, w, l15, g, z1);
  scan_load(p, u0 + 2, eq, w, l15, g, z2);
  unsigned tacc = 0u, tprev = 0u;
  __builtin_amdgcn_s_setprio(3);
#pragma unroll 1
  for (int n = 0; n < 32; n += 4) {
    tacc += tprev;
    tprev = 0u;
    if (n + 8 < 32) {
      tprev = scan_touch(p, u0 + n + 8, lane) + scan_touch(p, u0 + n + 9, lane) + scan_touch(p, u0 + n + 10, lane) +
              scan_touch(p, u0 + n + 11, lane);
    }
    scan_load(p, u0 + n + 3, eq, w, l15, g, z3);
    scan_step(p, u0 + n, n, eq, w, l15, g, s, st, z0);
    if (n + 4 < 32) scan_load(p, u0 + n + 4, eq, w, l15, g, z0);
    scan_step(p, u0 + n + 1, n + 1, eq, w, l15, g, s, st, z1);
    if (n + 4 < 32) scan_load(p, u0 + n + 5, eq, w, l15, g, z1);
    scan_step(p, u0 + n + 2, n + 2, eq, w, l15, g, s, st, z2);
    if (n + 4 < 32) scan_load(p, u0 + n + 6, eq, w, l15, g, z2);
    scan_step(p, u0 + n + 3, n + 3, eq, w, l15, g, s, st, z3);
  }
  __builtin_amdgcn_s_setprio(0);
  asm volatile("" :: "v"(tacc));
}

#define OLD 136
struct GoutSmem { float ssq[4][64]; u16 ob[64 * OLD]; };

__device__ void gout_unit(const P& p, int unit, GoutSmem& s) {
  const int tid = threadIdx.x, lane = tid & 63, w = tid >> 6;
  const int l15 = lane & 15, g = lane >> 4;
  const int bh = unit >> 5, n = unit & 31;
  const int b = bh >> 2, h = bh & 3;
  const u16* gQ = p.gQ + (size_t)unit * 8192;
  const u16* gO = p.gO + (size_t)unit * 8192;
  const u16* gS = p.gS + (size_t)unit * 16384;
  f32x4 o[4][2];
#pragma unroll
  for (int mc = 0; mc < 4; mc++)
#pragma unroll
    for (int ne = 0; ne < 2; ne++) {
      float c[4];
      unpack4(*(const uint2*)&gO[(32 * w + 16 * ne + l15) * 64 + 16 * mc + 4 * g], c);
      o[mc][ne] = (f32x4){c[0], c[1], c[2], c[3]};
    }
  if (n > 0) {
    bf16x8 bs[2][4];
#pragma unroll
    for (int ne = 0; ne < 2; ne++)
#pragma unroll
      for (int ks = 0; ks < 4; ks++) bs[ne][ks] = *(const bf16x8*)&gS[(32 * w + 16 * ne + l15) * 128 + ks * 32 + 8 * g];
#pragma unroll
    for (int mc = 0; mc < 4; mc++) {
#pragma unroll
      for (int ks = 0; ks < 4; ks++) {
        const bf16x8 aq = *(const bf16x8*)&gQ[(16 * mc + l15) * 128 + ks * 32 + 8 * g];
        o[mc][0] = mfma16(aq, bs[0][ks], o[mc][0]);
        o[mc][1] = mfma16(aq, bs[1][ks], o[mc][1]);
      }
    }
  }
  const float gnw0 = p.gdn_norm_w[32 * w + l15], gnw1 = p.gdn_norm_w[32 * w + 16 + l15];
  __syncthreads();
#pragma unroll
  for (int mc = 0; mc < 4; mc++)
#pragma unroll
    for (int r = 0; r < 4; r++) {
      float sq = o[mc][0][r] * o[mc][0][r] + o[mc][1][r] * o[mc][1][r];
#pragma unroll
      for (int off = 1; off < 16; off <<= 1) sq += __shfl_xor(sq, off);
      if (l15 == 0) s.ssq[w][16 * mc + 4 * g + r] = sq;
    }
  __syncthreads();
#pragma unroll
  for (int mc = 0; mc < 4; mc++)
#pragma unroll
    for (int r = 0; r < 4; r++) {
      const int c = 16 * mc + 4 * g + r;
      const float tot = s.ssq[0][c] + s.ssq[1][c] + s.ssq[2][c] + s.ssq[3][c];
      const float rs = rsqrtf(tot * (1.f / 128.f) + EPSV);
      s.ob[c * OLD + 32 * w + l15] = f2bf(o[mc][0][r] * rs * gnw0);
      s.ob[c * OLD + 32 * w + 16 + l15] = f2bf(o[mc][1][r] * rs * gnw1);
    }
  __syncthreads();
  {
    const int t0 = b * SEQ + n * 64;
    const int c0 = tid >> 4, ch = tid & 15;
    const u16* zp = p.proj + (size_t)(t0 + c0) * PROJW + 1536 + h * 128 + ch * 8;
    u16* op = p.actA + (size_t)(t0 + c0) * DM + h * 128 + ch * 8;
#pragma unroll
    for (int i = 0; i < 4; i++) {
      float ov[8], zv[8];
      unpack8(*(const uint4*)&s.ob[(c0 + 16 * i) * OLD + ch * 8], ov);
      unpack8(*(const uint4*)(zp + (size_t)i * 16 * PROJW), zv);
      uint4 r;
      r.x = pack2(ov[0] * siluf(zv[0]), ov[1] * siluf(zv[1])); r.y = pack2(ov[2] * siluf(zv[2]), ov[3] * siluf(zv[3]));
      r.z = pack2(ov[4] * siluf(zv[4]), ov[5] * siluf(zv[5])); r.w = pack2(ov[6] * siluf(zv[6]), ov[7] * siluf(zv[7]));
      *(uint4*)(op + (size_t)i * 16 * DM) = r;
    }
  }
}

__device__ void phase_gout(const P& p, unsigned char* smem) {
  GoutSmem& s = *(GoutSmem*)smem;
  for (int u = blockIdx.x; u < 1024; u += gridDim.x) gout_unit(p, u, s);
}

#define LOG2E 1.4426950408889634f
#define ANST 4
struct AttnSmem { u16 k[ANST][64 * 64 + 128]; u16 v[ANST][64 * 64]; };

__device__ void attn_unit(const P& p, int item, AttnSmem& s) {
  int tid = threadIdx.x;
  asm volatile("" : "+v"(tid));
  const int lane = tid & 63, w = tid >> 6;
  const int l15 = lane & 15, g = lane >> 4;
  const int qb = 15 - (item >> 6), bhf = item & 63;
  const int b = bhf >> 3, hf = bhf & 7;
  const int q0 = qb * 128 + 32 * w;
  const u16* qbase = p.proj + (size_t)(b * SEQ) * PROJW + 2048 + hf * 64;
  const u16* kbase = p.proj + (size_t)(b * SEQ) * PROJW + 2560 + hf * 64;
  const u16* vbase = p.vt + (size_t)bhf * 64 * SEQ;
  const float* cfb = p.cf + (size_t)bhf * SEQ;
  bf16x8 qf[2][2];
#pragma unroll
  for (int mi = 0; mi < 2; mi++)
#pragma unroll
    for (int ks = 0; ks < 2; ks++) qf[mi][ks] = *(const bf16x8*)&qbase[(size_t)(q0 + 16 * mi + l15) * PROJW + ks * 32 + g * 8];
  float cq[2], m[2], lsum[2];
  f32x4 O[2][4];
#pragma unroll
  for (int mi = 0; mi < 2; mi++) {
    cq[mi] = cfb[q0 + 16 * mi + l15]; m[mi] = -1e30f; lsum[mi] = 0.f;
#pragma unroll
    for (int nd = 0; nd < 4; nd++) O[mi][nd] = (f32x4){0.f, 0.f, 0.f, 0.f};
  }
  asm volatile("" :: "v"(cq[0]), "v"(cq[1]), "v"(qf[0][0]), "v"(qf[0][1]), "v"(qf[1][0]), "v"(qf[1][1]));
  const int ntile = (q0 + 32 + 63) >> 6;
  const int ntile_blk = 2 * qb + 2;
  const int drow = 8 * w + (lane >> 3);
  const int dchunk = (lane & 7) ^ ((4 * (w & 1) + (lane >> 4)) & 7);
  const u16* kg = kbase + (size_t)drow * PROJW + dchunk * 8;
  const u16* vg = vbase + (size_t)drow * SEQ + dchunk * 8;
  const float* cg_ = cfb + lane;
  u16* const skw = &s.k[0][0] + (8 * w) * 64;
  u16* const svw = &s.v[0][0] + (8 * w) * 64;
#define A_DMA(st, kk0) do { \
    u16* _dk = skw + (st) * (64 * 64 + 128); u16* _dv = svw + (st) * (64 * 64); \
    __builtin_amdgcn_global_load_lds((const unsigned*)(kg + (size_t)(kk0) * PROJW), (unsigned*)(_dk), 16, 0, 0); \
    __builtin_amdgcn_global_load_lds((const unsigned*)(kg + (size_t)((kk0) + 32) * PROJW), (unsigned*)(_dk + 32 * 64), 16, 0, 0); \
    __builtin_amdgcn_global_load_lds((const unsigned*)(vg + (kk0)), (unsigned*)(_dv), 16, 0, 0); \
    __builtin_amdgcn_global_load_lds((const unsigned*)(vg + (size_t)32 * SEQ + (kk0)), (unsigned*)(_dv + 32 * 64), 16, 0, 0); \
    __builtin_amdgcn_global_load_lds((const unsigned*)(cg_ + (kk0)), (unsigned*)(&s.k[0][0] + (st) * (64 * 64 + 128) + 64 * 64), 4, 0, 0); \
  } while (0)
  {
    const int npro = (ntile_blk > 2) ? 3 : 2;
#pragma unroll 1
    for (int j = 0; j < npro; j++) A_DMA(j, j * 64);
  }
  int ko[4][2];
#pragma unroll
  for (int t = 0; t < 4; t++) {
    const int row = 32 * (t >> 1) + 8 * (l15 >> 2) + 4 * (t & 1) + (l15 & 3);
    const int sw = (row >> 1) & 7;
    ko[t][0] = row * 64 + ((g ^ sw) * 8);
    ko[t][1] = row * 64 + (((4 + g) ^ sw) * 8);
  }
  const int swz = l15 >> 1;
  int vo[2];
  vo[0] = l15 * 64 + ((g ^ swz) * 8);
  vo[1] = l15 * 64 + (((4 + g) ^ swz) * 8);
#pragma unroll 1
  for (int kt = 0; kt < ntile_blk; kt++) {
    const int k0 = kt * 64, st = kt & 3;
    const int rem = ntile_blk - 1 - kt;
    if (rem >= 2) asm volatile("s_waitcnt vmcnt(10)" ::: "memory");
    else if (rem == 1) asm volatile("s_waitcnt vmcnt(5)" ::: "memory");
    else asm volatile("s_waitcnt vmcnt(0)" ::: "memory");
    asm volatile("s_waitcnt lgkmcnt(0)" ::: "memory");
    __builtin_amdgcn_s_barrier();
    asm volatile("" ::: "memory");
    if (kt + 3 < ntile_blk) { const int st3 = (kt + 3) & 3; A_DMA(st3, k0 + 192); }
    if (kt < ntile) {
      const u16* Ks = s.k[st];
      const u16* Vs = s.v[st];
      f32x4 ST[2][4];
#pragma unroll
      for (int t = 0; t < 4; t++) {
        const bf16x8 kf0 = *(const bf16x8*)&Ks[ko[t][0]];
        const bf16x8 kf1 = *(const bf16x8*)&Ks[ko[t][1]];
#pragma unroll
        for (int mi = 0; mi < 2; mi++) {
          f32x4 acc = {0.f, 0.f, 0.f, 0.f};
          acc = mfma16(kf0, qf[mi][0], acc);
          acc = mfma16(kf1, qf[mi][1], acc);
          ST[mi][t] = acc;
        }
      }
      f32x4 ck[4];
      {
        const unsigned cka = (unsigned)(size_t)(&Ks[64 * 64]) + 32u * g;
        asm volatile("ds_read_b128 %0, %4\n\tds_read_b128 %1, %4 offset:16\n\tds_read_b128 %2, %4 offset:128\n\t"
                     "ds_read_b128 %3, %4 offset:144\n\ts_waitcnt lgkmcnt(0)"
                     : "=&v"(ck[0]), "=&v"(ck[1]), "=&v"(ck[2]), "=&v"(ck[3]) : "v"(cka) : "memory");
      }
      const bool diag = (kt == ntile - 1);
      bf16x8 pf[2][2];
#pragma unroll
      for (int mi = 0; mi < 2; mi++) {
        const int qpos = q0 + 16 * mi + l15;
        float mx = -1e30f;
#pragma unroll
        for (int t = 0; t < 4; t++) {
          const float ckv[4] = {ck[t][0], ck[t][1], ck[t][2], ck[t][3]};
#pragma unroll
          for (int r = 0; r < 4; r++) {
            float lg = ST[mi][t][r] * (0.125f * LOG2E) + (cq[mi] - ckv[r]) * LOG2E;
            if (diag && (k0 + 32 * (t >> 1) + 8 * g + 4 * (t & 1) + r > qpos)) lg = -1e30f;
            ST[mi][t][r] = lg;
            mx = fmaxf(mx, lg);
          }
        }
        mx = fmaxf(mx, __shfl_xor(mx, 16));
        mx = fmaxf(mx, __shfl_xor(mx, 32));
        const float mn = fmaxf(m[mi], mx);
        const float alpha = __builtin_amdgcn_exp2f(m[mi] - mn);
        m[mi] = mn;
        float ps = 0.f;
#pragma unroll
        for (int t = 0; t < 4; t++)
#pragma unroll
          for (int r = 0; r < 4; r++) {
            const float pe = __builtin_amdgcn_exp2f(ST[mi][t][r] - mn);
            ST[mi][t][r] = pe;
            ps += pe;
          }
        lsum[mi] = lsum[mi] * alpha + ps;
#pragma unroll
        for (int kk = 0; kk < 2; kk++) {
          uint4 pk;
          pk.x = pack2(ST[mi][2 * kk][0], ST[mi][2 * kk][1]); pk.y = pack2(ST[mi][2 * kk][2], ST[mi][2 * kk][3]);
          pk.z = pack2(ST[mi][2 * kk + 1][0], ST[mi][2 * kk + 1][1]); pk.w = pack2(ST[mi][2 * kk + 1][2], ST[mi][2 * kk + 1][3]);
          pf[mi][kk] = __builtin_bit_cast(bf16x8, pk);
        }
#pragma unroll
        for (int r = 0; r < 4; r++) {
          const float ar = __shfl(alpha, 4 * g + r);
#pragma unroll
          for (int nd = 0; nd < 4; nd++) O[mi][nd][r] *= ar;
        }
      }
#pragma unroll
      for (int nd = 0; nd < 4; nd++)
#pragma unroll
        for (int kk = 0; kk < 2; kk++) {
          const bf16x8 vf = *(const bf16x8*)&Vs[16 * nd * 64 + vo[kk]];
          O[0][nd] = mfma16(pf[0][kk], vf, O[0][nd]);
          O[1][nd] = mfma16(pf[1][kk], vf, O[1][nd]);
        }
    }
  }
#pragma unroll
  for (int mi = 0; mi < 2; mi++) {
    float l = lsum[mi];
    l += __shfl_xor(l, 16);
    l += __shfl_xor(l, 32);
    const float inv = 1.f / l;
#pragma unroll
    for (int r = 0; r < 4; r++) {
      const float ir = __shfl(inv, 4 * g + r);
      const int t = b * SEQ + q0 + 16 * mi + 4 * g + r;
#pragma unroll
      for (int nd = 0; nd < 4; nd++) p.actA[(size_t)t * DM + 512 + hf * 64 + 16 * nd + l15] = f2bf(O[mi][nd][r] * ir);
    }
  }
}

__device__ void deferred_transpose(const P& p, int it, float* tile) {
  const int n1 = 16 * 16, n2 = n1 + 16 * 88, n3 = n2 + 44 * 16, n4 = n3 + 16 * 16;
  if (it < n1) { transpose_item(p.w_out, 1024, p.wt_out, 1024, it % 16, it / 16, 1, tile); }
  else if (it < n2) { int j = it - n1; transpose_item(p.w_gate_up, 2 * DFF, p.wt_gu, 1024, j % 16, j / 16, 2, tile, p.ffn_norm_w); }
  else if (it < n3) { int j = it - n2; transpose_item(p.w_down, 1024, p.wt_down, DFF, j % 44, j / 44, 1, tile); }
  else if (it < n4) { int j = it - n3; transpose_item(p.w_ple_gate, 1024, p.wt_pg, 1024, j % 16, j / 16, 1, tile, p.ple_norm_w); }
  else { int j = it - n4; transpose_item(p.w_ple_proj, 1024, p.wt_pp, 256, j % 4, j / 4, 1, tile); }
}

__device__ void phase_mixer(const P& p, unsigned char* smem, int rr) {
  volatile int* s_item_p = (volatile int*)(smem + SMEM_MAIN + 16);
  for (;;) {
    __syncthreads();
    if (threadIdx.x == 0) *s_item_p = (int)atomicAdd(&p.counters[rr], 1u);
    __syncthreads();
    const int item = *s_item_p;
    const int d0 = (gridDim.x == 512) ? DEFER_A : 0, d1 = (gridDim.x == 512) ? DEFER_B : N_DEFER;
    if (item >= NSCAN + 1024 + (d1 - d0)) break;
    if (item < NSCAN) { scan_unit(p, item, *(ScanSmem*)smem); }
    else if (item < NSCAN + 1024) { attn_unit(p, item - NSCAN, *(AttnSmem*)smem); }
    else { deferred_transpose(p, d0 + item - NSCAN - 1024, (float*)smem); }
  }
}

#define XB_TMO      128
#define XB_XCNT(j)  (256  + 64 * (j))
#define XB_XSUB(j)  (1280 + 64 * (j))
#define XB_XGEN(j)  (2304 + 64 * (j))
#define XB_TOP      3328
#define XB_TOPGEN   3392
#define XCD_BAR_WORDS 3456
#define XB_SPIN_CAP (1u << 20)
#define LAS __attribute__((address_space(3)))
__device__ __forceinline__ unsigned xb_ld(unsigned* p) { return __hip_atomic_load(p, __ATOMIC_RELAXED, __HIP_MEMORY_SCOPE_AGENT); }
__device__ __forceinline__ unsigned xb_add(unsigned* p, unsigned v) { return __hip_atomic_fetch_add(p, v, __ATOMIC_RELAXED, __HIP_MEMORY_SCOPE_AGENT); }
__device__ __forceinline__ unsigned xb_xcc_id() { return (unsigned)__builtin_amdgcn_s_getreg((3 << 11) | 20) & 0xFu; }
#define XB_SPIN(cond, bar) do { unsigned _sp = 0; while (cond) { __builtin_amdgcn_s_sleep(1); \
    if ((++_sp & 255u) == 0u) { if (xb_ld(&(bar)[XB_TMO])) break; if (_sp > XB_SPIN_CAP) { atomicAdd(&(bar)[XB_TMO], 1u); break; } } } } while (0)
struct XcdBarrier { unsigned* bar; unsigned x; volatile LAS unsigned* st; };
__device__ __forceinline__ XcdBarrier xcd_barrier_post(unsigned* bar, volatile LAS unsigned* st) {
  XcdBarrier b; b.bar = bar; b.x = xb_xcc_id(); b.st = st;
  if (threadIdx.x == 0) (void)xb_add(&bar[XB_XCNT(b.x)], 1u);
  return b;
}
__device__ __forceinline__ void xcd_barrier_complete(unsigned* bar, unsigned x, unsigned& nloc, unsigned& nx) {
  const unsigned G = gridDim.x * gridDim.y * gridDim.z;
  unsigned sum, cnt, mine, sp = 0u;
  for (;;) {
    sum = 0u; cnt = 0u; mine = 0u;
#pragma unroll
    for (unsigned j = 0; j < 16; ++j) { const unsigned c = xb_ld(&bar[XB_XCNT(j)]); sum += c; cnt += (c > 0u) ? 1u : 0u; mine = (j == x) ? c : mine; }
    if (sum == G) break;
    __builtin_amdgcn_s_sleep(1);
    if ((++sp & 255u) == 0u) { if (xb_ld(&bar[XB_TMO])) break; if (sp > XB_SPIN_CAP) { atomicAdd(&bar[XB_TMO], 1u); break; } }
  }
  nloc = mine > 0u ? mine : 1u; nx = cnt > 0u ? cnt : 1u;
}
__device__ __forceinline__ void xcd_barrier(const XcdBarrier& b) {
  asm volatile("s_waitcnt vmcnt(0)" ::: "memory");
  __syncthreads();
  if (threadIdx.x == 0) {
    unsigned* bar = b.bar;
    __builtin_amdgcn_s_waitcnt(0);
    unsigned nloc = b.st[0], nx = b.st[1];
    if (nloc == 0u) { xcd_barrier_complete(bar, b.x, nloc, nx); b.st[0] = nloc; b.st[1] = nx; }
    const unsigned old = xb_add(&bar[XB_XSUB(b.x)], 1u);
    const unsigned gen = old / nloc;
    if (old + 1u == (gen + 1u) * nloc) {
      __builtin_amdgcn_fence(__ATOMIC_RELEASE, "agent");
      asm volatile("s_waitcnt vmcnt(0)" ::: "memory");
      const unsigned og = xb_add(&bar[XB_TOP], 1u);
      const unsigned tg = og / nx;
      if (og + 1u == (tg + 1u) * nx) xb_add(&bar[XB_TOPGEN], 1u);
      else XB_SPIN(xb_ld(&bar[XB_TOPGEN]) == tg, bar);
      __builtin_amdgcn_fence(__ATOMIC_ACQUIRE, "agent");
      xb_add(&bar[XB_XGEN(b.x)], 1u);
      asm volatile("s_waitcnt vmcnt(0)" ::: "memory");
    } else {
      XB_SPIN(xb_ld(&bar[XB_XGEN(b.x)]) == gen, bar);
      __builtin_amdgcn_fence(__ATOMIC_ACQUIRE, "agent");
      asm volatile("s_waitcnt vmcnt(0)" ::: "memory");
    }
  }
  __syncthreads();
}

__global__ void __launch_bounds__(256, 2) mega(P p, int lo, int hi) {
  __shared__ __attribute__((aligned(16))) unsigned char smem[SMEM_MAIN + 32];
  cg::grid_group grid = cg::this_grid();
  uint4* xbw = (uint4*)(smem + SMEM_MAIN);
  if (threadIdx.x == 0) *xbw = make_uint4(0u, 0u, 0u, 0u);
  __syncthreads();
  XcdBarrier xb = xcd_barrier_post(p.bar, (volatile LAS unsigned*)xbw);
  if (hi < 0) grid.sync();
#define SEAM(k) if (lo <= k && k + 1 < hi) xcd_barrier(xb);
#if !defined(ONLY) || ONLY == 0
  if (lo <= 0 && 0 < hi) phase_prep(p, smem);
#endif
  SEAM(0)
#if !defined(ONLY) || ONLY == 1
  if (lo <= 1 && 1 < hi) phase_inproj(p, smem);
#endif
  SEAM(1)
#if !defined(ONLY) || ONLY == 2
  if (lo <= 2 && 2 < hi) phase_gdnprep(p, smem);
#endif
  SEAM(2)
#if !defined(ONLY) || ONLY == 3
  if (lo <= 3 && 3 < hi) phase_mixer(p, smem, 0);
#endif
  SEAM(3)
#if !defined(ONLY) || ONLY == 4
  if (lo <= 4 && 4 < hi) phase_gout(p, smem);
#endif
  SEAM(4)
#if !defined(ONLY) || ONLY == 5
  if (lo <= 5 && 5 < hi) phase_outproj(p, smem);
#endif
  SEAM(5)
#if !defined(ONLY) || ONLY == 6
  if (lo <= 6 && 6 < hi) phase_gateup(p, smem);
#endif
  SEAM(6)
#if !defined(ONLY) || ONLY == 7
  if (lo <= 7 && 7 < hi) phase_down(p, smem);
#endif
  SEAM(7)
#if !defined(ONLY) || ONLY == 8
  if (lo <= 8 && 8 < hi) phase_ple(p, smem);
#endif
  SEAM(8)
  if (lo <= 9 && 9 < hi) phase_final(p);
}

static_assert(sizeof(GemmSmem) <= SMEM_MAIN && sizeof(Gemm2Smem) <= SMEM_MAIN && sizeof(GdnSmem) <= SMEM_MAIN && sizeof(ScanSmem) <= SMEM_MAIN &&
              sizeof(GoutSmem) <= SMEM_MAIN && sizeof(AttnSmem) <= SMEM_MAIN && 64 * 65 * 4 <= SMEM_MAIN, "smem");

extern "C" void kernel_launch(void* const* d_in, const int* in_sizes, int n_in, void* d_out, int out_size,
                              void* d_ws, size_t ws_size, hipStream_t stream) {
  static int grid_blocks = 0;
  if (!grid_blocks) {
    int dev = 0, cus = 0, per_cu = 0;
    hipGetDevice(&dev);
    hipDeviceGetAttribute(&cus, hipDeviceAttributeMultiprocessorCount, dev);
    hipOccupancyMaxActiveBlocksPerMultiprocessor(&per_cu, mega, 256, 0);
    if (per_cu > 2) per_cu = 2;
    if (per_cu < 1) per_cu = 1;
    grid_blocks = cus * per_cu;
  }
  P p{};
  const float* const* in = (const float* const*)d_in;
  p.x = in[0]; p.p = in[1]; p.attn_norm_w = in[2]; p.w_in = in[3]; p.conv_w = in[4]; p.a_log = in[5];
  p.dt_bias = in[6]; p.gdn_norm_w = in[7]; p.fox_f_bias = in[8]; p.w_out = in[9]; p.ffn_norm_w = in[10];
  p.w_gate_up = in[11]; p.w_down = in[12]; p.ple_norm_w = in[13]; p.w_ple_gate = in[14]; p.w_ple_proj = in[15];
  p.final_norm_w = in[16];
  p.h = (float*)d_out;
  unsigned char* ws = (unsigned char*)d_ws;
  size_t off = 0;
  auto take = [&](size_t bytes) { unsigned char* r = ws + off; off += (bytes + 255) & ~(size_t)255; return r; };
  p.counters = (unsigned*)take(256);
  p.bar = (unsigned*)take(XCD_BAR_WORDS * 4);
  p.wt_in = (u16*)take((size_t)NIN_PAD * 1024 * 2);
  p.wt_out = (u16*)take((size_t)1024 * 1024 * 2);
  p.wt_gu = (u16*)take((size_t)2 * DFF * 1024 * 2);
  p.wt_down = (u16*)take((size_t)1024 * DFF * 2);
  p.wt_pg = (u16*)take((size_t)1024 * 1024 * 2);
  p.wt_pp = (u16*)take((size_t)1024 * 256 * 2);
  p.actA = (u16*)take((size_t)NTOK * 1024 * 2);
  p.pb = (u16*)take((size_t)NTOK * 256 * 2);
  p.proj = (u16*)take((size_t)NTOK * PROJW * 2);
  p.vt = (u16*)take((size_t)64 * 64 * SEQ * 2);
  p.gates = (float*)take((size_t)NTOK * 16 * 4);
  p.cf = (float*)take((size_t)64 * SEQ * 4);
  p.gM = (u16*)take((size_t)1024 * 16384 * 2);
  p.gC = (u16*)take((size_t)1024 * 16384 * 2);
  p.gdl = (float*)take(1024 * 4);
  p.rss = (float*)take((size_t)3 * NTOK * 4);
  p.hb = p.gM;
  if (off > ws_size) fprintf(stderr, "workspace too small: need %zu have %zu\n", off, ws_size);
  u16* ob = (u16*)d_out;
  p.gS = ob;
  p.gQ = ob + (size_t)1024 * 16384;
  p.gO = ob + (size_t)1024 * 16384 + (size_t)1024 * 8192;
  hipMemsetAsync(p.bar, 0, XCD_BAR_WORDS * 4, stream);
  int lo = 0, hi = NPHASE;
  void* args[] = {&p, &lo, &hi};
  hipError_t e = hipLaunchCooperativeKernel((void*)mega, dim3(grid_blocks), dim3(256), args, 0, stream);
  if (e != hipSuccess) fprintf(stderr, "cooperative launch failed: %s (grid %d)\n", hipGetErrorString(e), grid_blocks);
}
```

```cpp
#include <hip/hip_runtime.h>
#include <hip/hip_cooperative_groups.h>
#include <cstdio>
#include <cstdint>
namespace cg = cooperative_groups;

typedef unsigned short u16;
typedef __attribute__((ext_vector_type(8))) short bf16x8;
typedef __attribute__((ext_vector_type(4))) float f32x4;

#define NTOK 16384
#define SEQ 2048
#define DM 1024
#define DFF 2816
#define PROJW 3072
#define NIN_PAD 3712
#define EPSV 1e-6f
#define NPHASE 10
#define SMEM_MAIN 73728

struct P {
  const float *x, *p, *attn_norm_w, *w_in, *conv_w, *a_log, *dt_bias, *gdn_norm_w, *fox_f_bias, *w_out,
      *ffn_norm_w, *w_gate_up, *w_down, *ple_norm_w, *w_ple_gate, *w_ple_proj, *final_norm_w;
  float* h;
  u16 *wt_in, *wt_out, *wt_gu, *wt_down, *wt_pg, *wt_pp;
  u16 *actA;
  u16 *pb;
  u16 *proj;
  u16 *vt;
  float *gates;
  float *cf;
  u16 *gM, *gC;
  u16 *gQ, *gO;
  u16 *gS;
  float *gdl;
  unsigned *counters;
  unsigned *bar;
  u16 *hb;
  float *rss;
};

typedef __attribute__((ext_vector_type(2))) float f32x2_t;
typedef __attribute__((ext_vector_type(2))) __bf16 bf16x2_t;
__device__ __forceinline__ u16 f2bf(float f) { return __builtin_bit_cast(u16, (__bf16)f); }
__device__ __forceinline__ float bf2f(u16 h) { return __uint_as_float(((unsigned)h) << 16); }
__device__ __forceinline__ unsigned pack2(float a, float b) {
  f32x2_t f = {a, b};
  return __builtin_bit_cast(unsigned, __builtin_convertvector(f, bf16x2_t));
}
__device__ __forceinline__ float siluf(float v) { return v / (1.f + __expf(-v)); }
__device__ __forceinline__ float sigmoidf_(float v) { return 1.f / (1.f + __expf(-v)); }
__device__ __forceinline__ f32x4 mfma16(bf16x8 a, bf16x8 b, f32x4 c) {
  return __builtin_amdgcn_mfma_f32_16x16x32_bf16(a, b, c, 0, 0, 0);
}
#define LDS_FENCE() asm volatile("s_waitcnt lgkmcnt(0)" ::: "memory")

__device__ __forceinline__ void unpack8(const uint4& v, float (&f)[8]) {
  f[0] = bf2f((u16)(v.x & 0xffffu)); f[1] = bf2f((u16)(v.x >> 16));
  f[2] = bf2f((u16)(v.y & 0xffffu)); f[3] = bf2f((u16)(v.y >> 16));
  f[4] = bf2f((u16)(v.z & 0xffffu)); f[5] = bf2f((u16)(v.z >> 16));
  f[6] = bf2f((u16)(v.w & 0xffffu)); f[7] = bf2f((u16)(v.w >> 16));
}
__device__ __forceinline__ void unpack4(const uint2& v, float (&f)[4]) {
  f[0] = bf2f((u16)(v.x & 0xffffu)); f[1] = bf2f((u16)(v.x >> 16));
  f[2] = bf2f((u16)(v.y & 0xffffu)); f[3] = bf2f((u16)(v.y >> 16));
}


__device__ __forceinline__ int colmap(int kind, int nn) {
  if (kind == 0) {
    if (nn < 2048) return nn;
    if (nn < 3584) return nn + 8;
    if (nn < 3588) return 2048 + (nn - 3584);
    if (nn < 3592) return 2052 + (nn - 3588);
    if (nn < 3600) return nn;
    return -1;
  } else if (kind == 2) {
    int i = nn >> 7, wc = (nn >> 6) & 1, u = (nn >> 5) & 1, j = nn & 31;
    return u * DFF + 64 * i + 32 * wc + j;
  }
  return nn;
}

__device__ void transpose_item(const float* __restrict__ src, int ldsrc, u16* __restrict__ dst, int K,
                               int kt, int nt, int kind, float* tile, const float* __restrict__ kscale = nullptr) {
  int tid = threadIdx.x;
  asm volatile("" : "+v"(tid));
  const int c = tid & 63, r0 = tid >> 6;
  const int ncol = colmap(kind, nt * 64 + c);
  float tv[16];
#pragma unroll
  for (int i = 0; i < 16; i++) {
    int r = r0 + 4 * i;
    tv[i] = (ncol >= 0) ? __builtin_nontemporal_load(&src[(size_t)(kt * 64 + r) * ldsrc + ncol]) : 0.f;
  }
  if (kscale) {
#pragma unroll
    for (int i = 0; i < 16; i++) tv[i] *= kscale[kt * 64 + r0 + 4 * i];
  }
#pragma unroll
  for (int i = 0; i < 16; i++) tile[(r0 + 4 * i) * 65 + c] = tv[i];
  __syncthreads();
#pragma unroll 8
  for (int i = 0; i < 16; i++) {
    int rn = r0 + 4 * i;
    dst[(size_t)(nt * 64 + rn) * K + kt * 64 + c] = f2bf(tile[c * 65 + rn]);
  }
  __syncthreads();
}

__device__ __forceinline__ void rmsnorm_row(const float* src, const float* __restrict__ w,
                                            u16* dstb, float* dstf, int row) {
  const int lane = threadIdx.x & 63;
  float4 v[4];
  float ss = 0.f;
#pragma unroll
  for (int i = 0; i < 4; i++) {
    v[i] = *(const float4*)&src[(size_t)row * DM + i * 256 + lane * 4];
    ss += v[i].x * v[i].x + v[i].y * v[i].y + v[i].z * v[i].z + v[i].w * v[i].w;
  }
#pragma unroll
  for (int off = 32; off >= 1; off >>= 1) ss += __shfl_xor(ss, off);
  const float r = rsqrtf(ss * (1.f / DM) + EPSV);
#pragma unroll
  for (int i = 0; i < 4; i++) {
    const int col = i * 256 + lane * 4;
    float4 wv = *(const float4*)&w[col];
    float y0 = v[i].x * r * wv.x, y1 = v[i].y * r * wv.y, y2 = v[i].z * r * wv.z, y3 = v[i].w * r * wv.w;
    if (dstb) {
      uint2 o; o.x = pack2(y0, y1); o.y = pack2(y2, y3);
      *(uint2*)&dstb[(size_t)row * DM + col] = o;
    } else {
      *(float4*)&dstf[(size_t)row * DM + col] = make_float4(y0, y1, y2, y3);
    }
  }
}

__device__ void phase_prep(const P& p, unsigned char* smem) {
  float* tile = (float*)smem;
  if (blockIdx.x == 0 && threadIdx.x < 16) p.counters[threadIdx.x] = 0u;
  for (int i = blockIdx.x * 256 + threadIdx.x; i < 3 * NTOK; i += gridDim.x * 256) p.rss[i] = 0.f;
  for (int it = blockIdx.x; it < 16 * 58; it += gridDim.x) transpose_item(p.w_in, 3600, p.wt_in, 1024, it % 16, it / 16, 0, tile);
  const int wave = threadIdx.x >> 6, lane = threadIdx.x & 63;
  for (int rb = blockIdx.x; rb < NTOK / 8; rb += gridDim.x) {
    const int row = rb * 8 + wave * 2;
    float4 v0[4], v1[4];
#pragma unroll
    for (int i = 0; i < 4; i++) {
      { const f32x4 t0 = __builtin_nontemporal_load((const f32x4*)&p.x[(size_t)row * DM + i * 256 + lane * 4]);
        const f32x4 t1 = __builtin_nontemporal_load((const f32x4*)&p.x[(size_t)(row + 1) * DM + i * 256 + lane * 4]);
        v0[i] = make_float4(t0[0], t0[1], t0[2], t0[3]); v1[i] = make_float4(t1[0], t1[1], t1[2], t1[3]); }
    }
    const float4 pv0 = *(const float4*)&p.p[(size_t)row * 256 + lane * 4];
    const float4 pv1 = *(const float4*)&p.p[(size_t)(row + 1) * 256 + lane * 4];
    float s0 = 0.f, s1 = 0.f;
#pragma unroll
    for (int i = 0; i < 4; i++) {
      s0 += v0[i].x * v0[i].x + v0[i].y * v0[i].y + v0[i].z * v0[i].z + v0[i].w * v0[i].w;
      s1 += v1[i].x * v1[i].x + v1[i].y * v1[i].y + v1[i].z * v1[i].z + v1[i].w * v1[i].w;
    }
#pragma unroll
    for (int off = 32; off >= 1; off >>= 1) { s0 += __shfl_xor(s0, off); s1 += __shfl_xor(s1, off); }
    const float r0 = rsqrtf(s0 * (1.f / DM) + EPSV), r1 = rsqrtf(s1 * (1.f / DM) + EPSV);
#pragma unroll
    for (int i = 0; i < 4; i++) {
      const int col = i * 256 + lane * 4;
      const float4 wv = *(const float4*)&p.attn_norm_w[col];
      uint2 o;
      o.x = pack2(v0[i].x * r0 * wv.x, v0[i].y * r0 * wv.y); o.y = pack2(v0[i].z * r0 * wv.z, v0[i].w * r0 * wv.w);
      *(uint2*)&p.actA[(size_t)row * DM + col] = o;
      o.x = pack2(v1[i].x * r1 * wv.x, v1[i].y * r1 * wv.y); o.y = pack2(v1[i].z * r1 * wv.z, v1[i].w * r1 * wv.w);
      *(uint2*)&p.actA[(size_t)(row + 1) * DM + col] = o;
    }
    uint2 o; o.x = pack2(pv0.x, pv0.y); o.y = pack2(pv0.z, pv0.w);
    *(uint2*)&p.pb[(size_t)row * 256 + lane * 4] = o;
    o.x = pack2(pv1.x, pv1.y); o.y = pack2(pv1.z, pv1.w);
    *(uint2*)&p.pb[(size_t)(row + 1) * 256 + lane * 4] = o;
  }
}

__device__ void phase_rmsnorm(const float* src, const float* w, u16* dstb, float* dstf) {
  const int wave = threadIdx.x >> 6;
  for (int rb = blockIdx.x; rb < NTOK / 4; rb += gridDim.x) rmsnorm_row(src, w, dstb, dstf, rb * 4 + wave);
}

__device__ void phase_final(const P& p) {
  const int wave = threadIdx.x >> 6, lane = threadIdx.x & 63;
  float4 wv[4];
#pragma unroll
  for (int i = 0; i < 4; i++) wv[i] = *(const float4*)&p.final_norm_w[i * 256 + lane * 4];
  for (int rb = blockIdx.x; rb < NTOK / 16; rb += gridDim.x) {
    const int row0 = rb * 16 + wave * 4;
    uint2 raw[4][4];
    float rs[4];
#pragma unroll
    for (int q = 0; q < 4; q++) {
      rs[q] = p.rss[2 * NTOK + row0 + q];
#pragma unroll
      for (int i = 0; i < 4; i++) raw[q][i] = *(const uint2*)&p.hb[(size_t)(row0 + q) * DM + i * 256 + lane * 4];
    }
#pragma unroll
    for (int q = 0; q < 4; q++) {
      const float r = rsqrtf(rs[q] * (1.f / DM) + EPSV);
#pragma unroll
      for (int i = 0; i < 4; i++) {
        float hv[4];
        unpack4(raw[q][i], hv);
        f32x4 o = {hv[0] * r * wv[i].x, hv[1] * r * wv[i].y, hv[2] * r * wv[i].z, hv[3] * r * wv[i].w};
        __builtin_nontemporal_store(o, (f32x4*)&p.h[(size_t)(row0 + q) * DM + i * 256 + lane * 4]);
      }
    }
  }
}

#define GK 64
struct GemmSmem { u16 a[2][128 * GK]; u16 b[2][128 * GK]; };

template <bool SWAP>
__device__ __forceinline__ void gemm_tile(const u16* __restrict__ A, int lda, const u16* __restrict__ Bt, int ldb,
                                          int K, int m0, int n0, GemmSmem& s, f32x4 (&acc)[4][4]) {
  int tid = threadIdx.x;
  asm volatile("" : "+v"(tid));
  const int lane = tid & 63, wave = tid >> 6;
  const int wr = wave >> 1, wc = wave & 1;
  const int l15 = lane & 15, g = lane >> 4;
  const int nk = K / GK;
  const int drow = 8 * wave + (lane >> 3);
  const int dchunk = (lane & 7) ^ ((4 * (wave & 1) + (lane >> 4)) & 7);
  const u16* Ap = A + (size_t)(m0 + drow) * lda + dchunk * 8;
  const u16* Bp = Bt + (size_t)(n0 + drow) * ldb + dchunk * 8;
  const size_t sa = (size_t)32 * lda, sb = (size_t)32 * ldb;
#define G_DMA(bufi, koff) do { \
    _Pragma("unroll") for (int _i = 0; _i < 4; _i++) { \
      __builtin_amdgcn_global_load_lds((const unsigned*)(Ap + _i * sa + (koff)), (unsigned*)&s.a[bufi][(32 * _i + 8 * wave) * GK], 16, 0, 0); \
      __builtin_amdgcn_global_load_lds((const unsigned*)(Bp + _i * sb + (koff)), (unsigned*)&s.b[bufi][(32 * _i + 8 * wave) * GK], 16, 0, 0); \
    } } while (0)
  const int fo0 = l15 * GK + ((g ^ (l15 >> 1)) * 8);
  const int fo1 = l15 * GK + (((4 + g) ^ (l15 >> 1)) * 8);
  G_DMA(0, 0);
  asm volatile("s_waitcnt vmcnt(0)" ::: "memory");
  __builtin_amdgcn_s_barrier();
  asm volatile("" ::: "memory");
  for (int kt = 0; kt < nk; kt++) {
    const int buf = kt & 1;
    if (kt + 1 < nk) { if (buf) G_DMA(0, (kt + 1) * GK); else G_DMA(1, (kt + 1) * GK); }
    const u16* sa_ = &s.a[buf][(wr * 64) * GK];
    const u16* sb_ = &s.b[buf][(wc * 64) * GK];
#pragma unroll
    for (int ks = 0; ks < 2; ks++) {
      const int fo = ks ? fo1 : fo0;
      bf16x8 af[4], bfr[4];
#pragma unroll
      for (int mi = 0; mi < 4; mi++) af[mi] = *(const bf16x8*)&sa_[mi * 16 * GK + fo];
#pragma unroll
      for (int ni = 0; ni < 4; ni++) bfr[ni] = *(const bf16x8*)&sb_[ni * 16 * GK + fo];
#pragma unroll
      for (int mi = 0; mi < 4; mi++)
#pragma unroll
        for (int ni = 0; ni < 4; ni++) acc[mi][ni] = SWAP ? mfma16(bfr[ni], af[mi], acc[mi][ni]) : mfma16(af[mi], bfr[ni], acc[mi][ni]);
    }
    asm volatile("s_waitcnt vmcnt(0) lgkmcnt(0)" ::: "memory");
    __builtin_amdgcn_s_barrier();
    asm volatile("" ::: "memory");
  }
}


#define G2K 32
struct Gemm2Smem { u16 a[3][256 * G2K]; u16 b[3][128 * G2K]; };

template <bool SWAP>
__device__ __forceinline__ void gemm256(const u16* __restrict__ A, int lda, const u16* __restrict__ Bt, int ldb,
                                        int K, int m0, int n0, Gemm2Smem& s, f32x4 (&acc)[8][4]) {
  int tid = threadIdx.x;
  asm volatile("" : "+v"(tid));
  const int lane = tid & 63, wave = tid >> 6;
  const int wr = wave >> 1, wc = wave & 1;
  const int l15 = lane & 15, g = lane >> 4;
  const int nk = K / G2K;
  const int drow = 16 * wave + (lane >> 2);
  const int dchunk = (lane & 3) ^ g;
  const u16* Ap = A + (size_t)(m0 + drow) * lda + dchunk * 8;
  const u16* Bp = Bt + (size_t)(n0 + drow) * ldb + dchunk * 8;
  const size_t sa = (size_t)64 * lda, sb = (size_t)64 * ldb;
  u16* const sa0 = &s.a[0][0] + (16 * wave) * G2K;
  u16* const sb0 = &s.b[0][0] + (16 * wave) * G2K;
#define G2_DMA(st, koff) do { \
    u16* _da = sa0 + (st) * (256 * G2K); u16* _db = sb0 + (st) * (128 * G2K); \
    _Pragma("unroll") for (int _i = 0; _i < 4; _i++) \
      __builtin_amdgcn_global_load_lds((const unsigned*)(Ap + _i * sa + (koff)), (unsigned*)(_da + 64 * _i * G2K), 16, 0, 0); \
    _Pragma("unroll") for (int _i = 0; _i < 2; _i++) \
      __builtin_amdgcn_global_load_lds((const unsigned*)(Bp + _i * sb + (koff)), (unsigned*)(_db + 64 * _i * G2K), 16, 0, 0); \
  } while (0)
  const int fo = l15 * G2K + ((g ^ ((l15 >> 2) & 3)) * 8);
  asm volatile("s_waitcnt lgkmcnt(0)" ::: "memory");
  __builtin_amdgcn_s_barrier();
  asm volatile("" ::: "memory");
#pragma unroll 1
  for (int j = 0; j < 2; j++) G2_DMA(j, j * G2K);
  int st = 0;
  for (int kt = 0; kt < nk; kt++) {
    if (kt + 1 < nk) asm volatile("s_waitcnt vmcnt(6)" ::: "memory");
    else asm volatile("s_waitcnt vmcnt(0)" ::: "memory");
    __builtin_amdgcn_s_barrier();
    asm volatile("" ::: "memory");
    if (kt + 2 < nk) {
      const int st2 = (st >= 1) ? st - 1 : 2;
      G2_DMA(st2, (kt + 2) * G2K);
    }
    const u16* sa_ = &s.a[0][0] + st * (256 * G2K) + (wr * 128) * G2K + fo;
    const u16* sb_ = &s.b[0][0] + st * (128 * G2K) + (wc * 64) * G2K + fo;
    bf16x8 af[8], bfr[4];
#pragma unroll
    for (int mi = 0; mi < 8; mi++) af[mi] = *(const bf16x8*)&sa_[mi * 16 * G2K];
#pragma unroll
    for (int ni = 0; ni < 4; ni++) bfr[ni] = *(const bf16x8*)&sb_[ni * 16 * G2K];
#pragma unroll
    for (int mi = 0; mi < 8; mi++)
#pragma unroll
      for (int ni = 0; ni < 4; ni++) acc[mi][ni] = SWAP ? mfma16(bfr[ni], af[mi], acc[mi][ni]) : mfma16(af[mi], bfr[ni], acc[mi][ni]);
    st = (st == 2) ? 0 : st + 1;
  }
}
#define ZERO_ACC8(acc) _Pragma("unroll") for (int _i = 0; _i < 8; _i++) _Pragma("unroll") for (int _j = 0; _j < 4; _j++) acc[_i][_j] = (f32x4){0.f, 0.f, 0.f, 0.f};

#define ZERO_ACC(acc) _Pragma("unroll") for (int _i = 0; _i < 4; _i++) _Pragma("unroll") for (int _j = 0; _j < 4; _j++) acc[_i][_j] = (f32x4){0.f, 0.f, 0.f, 0.f};

template <int NMI>
__device__ __forceinline__ void row_sumsq_add(f32x4 (&sq)[NMI][4], float* rss, int row0, int l15, int g) {
#pragma unroll
  for (int mi = 0; mi < NMI; mi++) {
    float v = 0.f;
#pragma unroll
    for (int ni = 0; ni < 4; ni++) v += (sq[mi][ni][0] + sq[mi][ni][1]) + (sq[mi][ni][2] + sq[mi][ni][3]);
    v += __shfl_xor(v, 16);
    v += __shfl_xor(v, 32);
    if (g == 0) atomicAdd(&rss[row0 + mi * 16 + l15], v);
  }
}

__device__ void deferred_transpose(const P& p, int it, float* tile);
#define N_DEFER (16 * 16 + 16 * 88 + 44 * 16 + 16 * 16 + 4 * 16)
#define DEFER_A 960
#define DEFER_B 1664

__device__ void phase_inproj(const P& p, unsigned char* smem) {
  Gemm2Smem& s = *(Gemm2Smem*)smem;
  const int lane = threadIdx.x & 63, wave = threadIdx.x >> 6, wr = wave >> 1, wc = wave & 1, l15 = lane & 15, g = lane >> 4;
  const int ntiles = 64 * 29;
  for (int tl = blockIdx.x; tl < ntiles; tl += gridDim.x) {
    const int mt = tl & 63, nt = tl >> 6;
    const int m0 = mt * 256, n0 = nt * 128;
    f32x4 acc[8][4];
    ZERO_ACC8(acc);
    if (nt >= 24 && nt < 28) {
      gemm256<false>(p.actA, DM, p.wt_in, DM, DM, m0, n0, s, acc);
#pragma unroll
      for (int mi = 0; mi < 8; mi++)
#pragma unroll
        for (int ni = 0; ni < 4; ni++) {
          const int rowb = m0 + wr * 128 + mi * 16 + g * 4;
          const int col = n0 + wc * 64 + ni * 16 + l15;
          const int cc = col - 3072, hh = cc >> 6, d = cc & 63;
          const int b = rowb >> 11, sq = rowb & 2047;
          uint2 o; o.x = pack2(acc[mi][ni][0], acc[mi][ni][1]); o.y = pack2(acc[mi][ni][2], acc[mi][ni][3]);
          *(uint2*)&p.vt[((size_t)((b * 8 + hh) * 64 + d)) * SEQ + sq] = o;
        }
    } else {
      gemm256<true>(p.actA, DM, p.wt_in, DM, DM, m0, n0, s, acc);
#pragma unroll
      for (int mi = 0; mi < 8; mi++)
#pragma unroll
        for (int ni = 0; ni < 4; ni++) {
          const int row = m0 + wr * 128 + mi * 16 + l15;
          const int col = n0 + wc * 64 + ni * 16 + g * 4;
          if (nt < 24) {
            uint2 o; o.x = pack2(acc[mi][ni][0], acc[mi][ni][1]); o.y = pack2(acc[mi][ni][2], acc[mi][ni][3]);
            *(uint2*)&p.proj[(size_t)row * PROJW + col] = o;
          } else if (col < 3600) {
            *(float4*)&p.gates[(size_t)row * 16 + (col - 3584)] = make_float4(acc[mi][ni][0], acc[mi][ni][1], acc[mi][ni][2], acc[mi][ni][3]);
          }
        }
    }
  }
  if (gridDim.x == 512 && blockIdx.x >= 320) {
    __syncthreads();
    for (int it = (int)blockIdx.x - 320; it < DEFER_A; it += 192) deferred_transpose(p, it, (float*)smem);
  }
}

__device__ void phase_outproj(const P& p, unsigned char* smem) {
  GemmSmem& s = *(GemmSmem*)smem;
  const int lane = threadIdx.x & 63, wave = threadIdx.x >> 6, wr = wave >> 1, wc = wave & 1, l15 = lane & 15, g = lane >> 4;
  for (int tl = blockIdx.x; tl < 128 * 8; tl += gridDim.x) {
    const int mt = tl & 127, nt = tl >> 7;
    const int m0 = mt * 128, n0 = nt * 128;
    f32x4 acc[4][4];
    ZERO_ACC(acc);
    gemm_tile<true>(p.actA, DM, p.wt_out, DM, DM, m0, n0, s, acc);
#pragma unroll
    for (int mi = 0; mi < 4; mi++)
#pragma unroll
      for (int ni = 0; ni < 4; ni++) {
        const size_t idx = (size_t)(m0 + wr * 64 + mi * 16 + l15) * DM + n0 + wc * 64 + ni * 16 + g * 4;
        const f32x4 xv4 = __builtin_nontemporal_load((const f32x4*)&p.x[idx]);
        const float4 xv = make_float4(xv4[0], xv4[1], xv4[2], xv4[3]);
        const float h0 = xv.x + acc[mi][ni][0], h1 = xv.y + acc[mi][ni][1], h2 = xv.z + acc[mi][ni][2], h3 = xv.w + acc[mi][ni][3];
        uint2 o; o.x = pack2(h0, h1); o.y = pack2(h2, h3);
        *(uint2*)&p.hb[idx] = o;
        acc[mi][ni] = (f32x4){h0 * h0, h1 * h1, h2 * h2, h3 * h3};
      }
    row_sumsq_add(acc, p.rss, m0 + wr * 64, l15, g);
  }
}

__device__ void phase_gateup(const P& p, unsigned char* smem) {
  Gemm2Smem& s = *(Gemm2Smem*)smem;
  u16* act = p.proj;
  const int lane = threadIdx.x & 63, wave = threadIdx.x >> 6, wr = wave >> 1, wc = wave & 1, l15 = lane & 15, g = lane >> 4;
  for (int tl = blockIdx.x; tl < 64 * 44; tl += gridDim.x) {
    const int mt = tl & 63, nt = tl >> 6;
    const int m0 = mt * 256, n0 = nt * 128;
    f32x4 acc[8][4];
    ZERO_ACC8(acc);
    gemm256<true>(p.hb, DM, p.wt_gu, DM, DM, m0, n0, s, acc);
#pragma unroll
    for (int mi = 0; mi < 8; mi++) {
      const int row = m0 + wr * 128 + mi * 16 + l15;
      const float rs = rsqrtf(p.rss[row] * (1.f / DM) + EPSV);
#pragma unroll
      for (int ni = 0; ni < 2; ni++) {
        const int col = 64 * nt + 32 * wc + 16 * ni + g * 4;
        float v[4];
#pragma unroll
        for (int r = 0; r < 4; r++) v[r] = siluf(acc[mi][ni][r] * rs) * (acc[mi][ni + 2][r] * rs);
        uint2 o; o.x = pack2(v[0], v[1]); o.y = pack2(v[2], v[3]);
        *(uint2*)&act[(size_t)row * DFF + col] = o;
      }
    }
  }
  if (gridDim.x == 512 && blockIdx.x >= 256) {
    __syncthreads();
    for (int it = DEFER_B + (int)blockIdx.x - 256; it < N_DEFER; it += 256) deferred_transpose(p, it, (float*)smem);
  }
}

__device__ void phase_down(const P& p, unsigned char* smem) {
  GemmSmem& s = *(GemmSmem*)smem;
  const u16* act = p.proj;
  const int lane = threadIdx.x & 63, wave = threadIdx.x >> 6, wr = wave >> 1, wc = wave & 1, l15 = lane & 15, g = lane >> 4;
  for (int tl = blockIdx.x; tl < 128 * 8; tl += gridDim.x) {
    const int mt = tl & 127, nt = tl >> 7;
    const int m0 = mt * 128, n0 = nt * 128;
    f32x4 acc[4][4];
    ZERO_ACC(acc);
    gemm_tile<true>(act, DFF, p.wt_down, DFF, DFF, m0, n0, s, acc);
#pragma unroll
    for (int mi = 0; mi < 4; mi++)
#pragma unroll
      for (int ni = 0; ni < 4; ni++) {
        const size_t idx = (size_t)(m0 + wr * 64 + mi * 16 + l15) * DM + n0 + wc * 64 + ni * 16 + g * 4;
        float hp[4];
        unpack4(*(const uint2*)&p.hb[idx], hp);
        const float h0 = hp[0] + acc[mi][ni][0], h1 = hp[1] + acc[mi][ni][1], h2 = hp[2] + acc[mi][ni][2], h3 = hp[3] + acc[mi][ni][3];
        uint2 o; o.x = pack2(h0, h1); o.y = pack2(h2, h3);
        *(uint2*)&p.actA[idx] = o;
        acc[mi][ni] = (f32x4){h0 * h0, h1 * h1, h2 * h2, h3 * h3};
      }
    row_sumsq_add(acc, p.rss + NTOK, m0 + wr * 64, l15, g);
  }
}

__device__ void phase_ple(const P& p, unsigned char* smem) {
  GemmSmem& s = *(GemmSmem*)smem;
  const int lane = threadIdx.x & 63, wave = threadIdx.x >> 6, wr = wave >> 1, wc = wave & 1, l15 = lane & 15, g = lane >> 4;
  for (int tl = blockIdx.x; tl < 128 * 8; tl += gridDim.x) {
    const int mt = tl & 127, nt = tl >> 7;
    const int m0 = mt * 128, n0 = nt * 128;
    f32x4 acc[4][4], acc2[4][4];
    ZERO_ACC(acc);
    gemm_tile<true>(p.actA, DM, p.wt_pg, DM, DM, m0, n0, s, acc);
#pragma unroll
    for (int mi = 0; mi < 4; mi++) {
      const float rs = rsqrtf(p.rss[NTOK + m0 + wr * 64 + mi * 16 + l15] * (1.f / DM) + EPSV);
#pragma unroll
      for (int ni = 0; ni < 4; ni++)
#pragma unroll
        for (int r = 0; r < 4; r++) acc[mi][ni][r] = sigmoidf_(acc[mi][ni][r] * rs);
    }
    ZERO_ACC(acc2);
    gemm_tile<true>(p.pb, 256, p.wt_pp, 256, 256, m0, n0, s, acc2);
#pragma unroll
    for (int mi = 0; mi < 4; mi++)
#pragma unroll
      for (int ni = 0; ni < 4; ni++) {
        const size_t idx = (size_t)(m0 + wr * 64 + mi * 16 + l15) * DM + n0 + wc * 64 + ni * 16 + g * 4;
        float hp[4];
        unpack4(*(const uint2*)&p.actA[idx], hp);
        const float h0 = hp[0] + acc[mi][ni][0] * acc2[mi][ni][0], h1 = hp[1] + acc[mi][ni][1] * acc2[mi][ni][1];
        const float h2 = hp[2] + acc[mi][ni][2] * acc2[mi][ni][2], h3 = hp[3] + acc[mi][ni][3] * acc2[mi][ni][3];
        { uint2 o; o.x = pack2(h0, h1); o.y = pack2(h2, h3); *(uint2*)&p.hb[idx] = o; }
        acc2[mi][ni] = (f32x4){h0 * h0, h1 * h1, h2 * h2, h3 * h3};
      }
    row_sumsq_add(acc2, p.rss + 2 * NTOK, m0 + wr * 64, l15, g);
  }
}

#define QLD 136
#define KLD 72
struct GdnSmem {
  u16 qb[64 * QLD];
  u16 kn[64 * QLD];
  u16 vb[64 * QLD];
  float Am[64 * 64];
  float gc[64], beta[64], be[64];
};
static_assert(offsetof(GdnSmem, kn) == 17408 && offsetof(GdnSmem, vb) == 34816 && offsetof(GdnSmem, Am) == 52224, "layout");


__device__ void gdn_unit(const P& p, int unit, GdnSmem& s) {
  int tid = threadIdx.x;
  asm volatile("" : "+v"(tid));
  int lane = tid & 63, wave = tid >> 6;
  int l15 = lane & 15, g = lane >> 4;
#define GDN_REFRESH() do { tid = threadIdx.x; asm volatile("" : "+v"(tid) :: "memory"); lane = tid & 63; wave = tid >> 6; l15 = lane & 15; g = lane >> 4; } while (0)
  const int bh = unit >> 5, n = unit & 31;
  const int b = bh >> 2, h = bh & 3;
  const int tb = b * SEQ;
  const int s0 = n * 64;
  u16* const qk_s = s.qb;
  u16* const WU = s.kn;
  u16* const kdT = (u16*)((unsigned char*)s.kn + 32768);
  __syncthreads();
  if (wave == 0) {
    const int t = tb + s0 + lane;
    const float ga = p.gates[(size_t)t * 16 + h], gb = p.gates[(size_t)t * 16 + 4 + h];
    const float xx = ga + p.dt_bias[h];
    const float sp = (xx > 20.f) ? xx : log1pf(__expf(xx));
    float gg = -__expf(p.a_log[h]) * sp;
#pragma unroll
    for (int off = 1; off < 64; off <<= 1) {
      float nb = __shfl_up(gg, off);
      if (lane >= off) gg += nb;
    }
    const float bt = sigmoidf_(gb);
    s.gc[lane] = gg;
    s.beta[lane] = bt;
    s.be[lane] = bt * __expf(gg);
  }
  {
    const int ch = tid & 15, rg = tid >> 4;
#pragma unroll 1
    for (int mat = 0; mat < 3; mat++) {
      const int col0 = mat * 512 + h * 128 + ch * 8;
      float cw[4][8];
#pragma unroll
      for (int k = 0; k < 4; k++) {
        const float4 w0 = *(const float4*)&p.conv_w[k * 1536 + col0];
        const float4 w1 = *(const float4*)&p.conv_w[k * 1536 + col0 + 4];
        cw[k][0] = w0.x; cw[k][1] = w0.y; cw[k][2] = w0.z; cw[k][3] = w0.w;
        cw[k][4] = w1.x; cw[k][5] = w1.y; cw[k][6] = w1.z; cw[k][7] = w1.w;
      }
      uint4 xr[7];
#pragma unroll
      for (int j = 0; j < 7; j++) {
        const int sp = s0 + 4 * rg + j - 3;
        if (sp >= 0) {
          typedef __attribute__((ext_vector_type(4))) unsigned u32x4_t;
          const u32x4_t t = __builtin_nontemporal_load((const u32x4_t*)&p.proj[(size_t)(tb + sp) * PROJW + col0]);
          xr[j] = make_uint4(t[0], t[1], t[2], t[3]);
        } else xr[j] = make_uint4(0u, 0u, 0u, 0u);
      }
      float xf[7][8];
#pragma unroll
      for (int j = 0; j < 7; j++) unpack8(xr[j], xf[j]);
      u16* dst = (mat == 0) ? s.qb : ((mat == 1) ? s.kn : s.vb);
#pragma unroll
      for (int r = 0; r < 4; r++) {
        float val[8];
        float ss = 0.f;
#pragma unroll
        for (int c = 0; c < 8; c++) {
          const float cv = cw[0][c] * xf[r][c] + cw[1][c] * xf[r + 1][c] + cw[2][c] * xf[r + 2][c] + cw[3][c] * xf[r + 3][c];
          val[c] = siluf(cv);
          ss += val[c] * val[c];
        }
        float rs = 1.f;
        if (mat < 2) {
#pragma unroll
          for (int off = 1; off < 16; off <<= 1) ss += __shfl_xor(ss, off);
          rs = rsqrtf(ss + EPSV) * ((mat == 0) ? 0.08838834764831845f : 1.f);
        }
        uint4 o;
        o.x = pack2(val[0] * rs, val[1] * rs); o.y = pack2(val[2] * rs, val[3] * rs);
        o.z = pack2(val[4] * rs, val[5] * rs); o.w = pack2(val[6] * rs, val[7] * rs);
        *(uint4*)&dst[(4 * rg + r) * QLD + ch * 8] = o;
      }
    }
  }
  __syncthreads();
  GDN_REFRESH();
  u16* const gQ = p.gQ + (size_t)unit * 8192;
  {
#pragma unroll
    for (int it = 0; it < 4; it++) {
      const int idx = tid + 256 * it;
      const int i = idx >> 4, d8 = (idx & 15) * 8;
      const float e = __expf(s.gc[i]);
      float f[8];
      unpack8(*(const uint4*)&s.qb[i * QLD + d8], f);
      uint4 o;
      o.x = pack2(f[0] * e, f[1] * e); o.y = pack2(f[2] * e, f[3] * e);
      o.z = pack2(f[4] * e, f[5] * e); o.w = pack2(f[6] * e, f[7] * e);
      *(uint4*)&gQ[i * 128 + d8] = o;
    }
  }
  f32x4 cqk[4];
  {
    bf16x8 aq[4], ak[4];
#pragma unroll
    for (int ks = 0; ks < 4; ks++) {
      aq[ks] = *(const bf16x8*)&s.qb[(wave * 16 + l15) * QLD + ks * 32 + g * 8];
      ak[ks] = *(const bf16x8*)&s.kn[(wave * 16 + l15) * QLD + ks * 32 + g * 8];
    }
#pragma unroll
    for (int ni = 0; ni < 4; ni++) {
      f32x4 ckk = {0.f, 0.f, 0.f, 0.f};
      cqk[ni] = (f32x4){0.f, 0.f, 0.f, 0.f};
      if (ni <= wave) {
#pragma unroll
        for (int ks = 0; ks < 4; ks++) {
          bf16x8 bk = *(const bf16x8*)&s.kn[(ni * 16 + l15) * QLD + ks * 32 + g * 8];
          ckk = mfma16(ak[ks], bk, ckk);
          cqk[ni] = mfma16(aq[ks], bk, cqk[ni]);
        }
      }
      const int j = ni * 16 + l15;
      const float gcj = s.gc[j];
#pragma unroll
      for (int r = 0; r < 4; r++) {
        const int i = wave * 16 + g * 4 + r;
        const float dec = (i >= j) ? __expf(s.gc[i] - gcj) : 0.f;
        s.Am[i * 64 + j] = (i > j) ? ckk[r] * s.beta[i] * dec : 0.f;
        cqk[ni][r] = (i >= j) ? cqk[ni][r] * dec : 0.f;
      }
    }
  }
  __syncthreads();
  GDN_REFRESH();
#pragma unroll
  for (int ni = 0; ni < 4; ni++)
#pragma unroll
    for (int r = 0; r < 4; r++) qk_s[(wave * 16 + g * 4 + r) * KLD + ni * 16 + l15] = f2bf(cqk[ni][r]);
  float xs[64];
#ifdef NO_SOLVE
  for (int i = 0; i < 64; i++) xs[i] = s.Am[i*64+tid%64];
#else
  {
    const int c = tid;
    const u16* src = (c < 128) ? &s.vb[c] : &s.kn[c - 128];
    const float* sc = (c < 128) ? s.beta : s.be;
#pragma unroll
    for (int i = 0; i < 64; i++) {
      float a0 = bf2f(src[i * QLD]) * sc[i], a1 = 0.f, a2 = 0.f, a3 = 0.f;
#pragma unroll
      for (int j4 = 0; j4 < (i + 3) / 4; j4++) {
        const float4 av = *(const float4*)&s.Am[i * 64 + j4 * 4];
        if (j4 * 4 + 0 < i) a0 -= av.x * xs[j4 * 4 + 0];
        if (j4 * 4 + 1 < i) a1 -= av.y * xs[j4 * 4 + 1];
        if (j4 * 4 + 2 < i) a2 -= av.z * xs[j4 * 4 + 2];
        if (j4 * 4 + 3 < i) a3 -= av.w * xs[j4 * 4 + 3];
      }
      xs[i] = (a0 + a1) + (a2 + a3);
      asm volatile("" : "+v"(xs[i]) :: "memory");
    }
  }
#endif
  const float glast = s.gc[63];
  __syncthreads();
  GDN_REFRESH();
  {
    const int d = tid & 127, half = tid >> 7;
#pragma unroll
    for (int q = 0; q < 4; q++) {
      unsigned ow[4];
#pragma unroll
      for (int e2 = 0; e2 < 4; e2++) {
        const int c0 = half * 32 + q * 8 + e2 * 2;
        const float v0 = bf2f(s.kn[c0 * QLD + d]) * __expf(glast - s.gc[c0]);
        const float v1 = bf2f(s.kn[(c0 + 1) * QLD + d]) * __expf(glast - s.gc[c0 + 1]);
        ow[e2] = pack2(v0, v1);
      }
      *(uint4*)&kdT[d * KLD + half * 32 + q * 8] = make_uint4(ow[0], ow[1], ow[2], ow[3]);
    }
    if (tid == 0) p.gdl[unit] = __expf(glast);
  }
  __syncthreads();
  GDN_REFRESH();
  if (tid >= 128) {
#pragma unroll
    for (int q = 0; q < 8; q++)
      *(uint4*)&WU[(tid - 128) * KLD + q * 8] = make_uint4(pack2(xs[q * 8], xs[q * 8 + 1]), pack2(xs[q * 8 + 2], xs[q * 8 + 3]),
                                                            pack2(xs[q * 8 + 4], xs[q * 8 + 5]), pack2(xs[q * 8 + 6], xs[q * 8 + 7]));
  }
  __syncthreads();
  GDN_REFRESH();
  {
    u16* const gM = p.gM + (size_t)unit * 16384;
    bf16x8 aw[2][2];
#pragma unroll
    for (int mm = 0; mm < 2; mm++)
#pragma unroll
      for (int ks = 0; ks < 2; ks++) aw[mm][ks] = *(const bf16x8*)&WU[((2 * wave + mm) * 16 + l15) * KLD + ks * 32 + g * 8];
#pragma unroll
    for (int nn = 0; nn < 8; nn++) {
      const bf16x8 b0 = *(const bf16x8*)&kdT[(nn * 16 + l15) * KLD + g * 8];
      const bf16x8 b1 = *(const bf16x8*)&kdT[(nn * 16 + l15) * KLD + 32 + g * 8];
#pragma unroll
      for (int mm = 0; mm < 2; mm++) {
        f32x4 acc = {0.f, 0.f, 0.f, 0.f};
        acc = mfma16(aw[mm][0], b0, acc);
        acc = mfma16(aw[mm][1], b1, acc);
        uint2 o; o.x = pack2(-acc[0], -acc[1]); o.y = pack2(-acc[2], -acc[3]);
        *(uint2*)&gM[(nn * 16 + l15) * 128 + (2 * wave + mm) * 16 + 4 * g] = o;
      }
    }
#pragma unroll
    for (int nn = 0; nn < 4; nn++) {
      const bf16x8 b0 = *(const bf16x8*)&qk_s[(nn * 16 + l15) * KLD + g * 8];
      const bf16x8 b1 = *(const bf16x8*)&qk_s[(nn * 16 + l15) * KLD + 32 + g * 8];
#pragma unroll
      for (int mm = 0; mm < 2; mm++) {
        f32x4 acc = {0.f, 0.f, 0.f, 0.f};
        acc = mfma16(aw[mm][0], b0, acc);
        acc = mfma16(aw[mm][1], b1, acc);
        u16* qp = &gQ[(nn * 16 + l15) * 128 + (2 * wave + mm) * 16 + 4 * g];
        float qv[4];
        unpack4(*(const uint2*)qp, qv);
        uint2 o; o.x = pack2(qv[0] - acc[0], qv[1] - acc[1]); o.y = pack2(qv[2] - acc[2], qv[3] - acc[3]);
        *(uint2*)qp = o;
      }
    }
  }
  __syncthreads();
  GDN_REFRESH();
  if (tid < 128) {
#pragma unroll
    for (int q = 0; q < 8; q++)
      *(uint4*)&WU[tid * KLD + q * 8] = make_uint4(pack2(xs[q * 8], xs[q * 8 + 1]), pack2(xs[q * 8 + 2], xs[q * 8 + 3]),
                                                    pack2(xs[q * 8 + 4], xs[q * 8 + 5]), pack2(xs[q * 8 + 6], xs[q * 8 + 7]));
  }
  __syncthreads();
  GDN_REFRESH();
  {
    u16* const gC = p.gC + (size_t)unit * 16384;
    u16* const gO = p.gO + (size_t)unit * 8192;
    bf16x8 akd[2][2], aqk[2];
#pragma unroll
    for (int mm = 0; mm < 2; mm++)
#pragma unroll
      for (int ks = 0; ks < 2; ks++) akd[mm][ks] = *(const bf16x8*)&kdT[((2 * wave + mm) * 16 + l15) * KLD + ks * 32 + g * 8];
#pragma unroll
    for (int ks = 0; ks < 2; ks++) aqk[ks] = *(const bf16x8*)&qk_s[(wave * 16 + l15) * KLD + ks * 32 + g * 8];
#pragma unroll
    for (int nn = 0; nn < 8; nn++) {
      const bf16x8 b0 = *(const bf16x8*)&WU[(nn * 16 + l15) * KLD + g * 8];
      const bf16x8 b1 = *(const bf16x8*)&WU[(nn * 16 + l15) * KLD + 32 + g * 8];
#pragma unroll
      for (int mm = 0; mm < 2; mm++) {
        f32x4 acc = {0.f, 0.f, 0.f, 0.f};
        acc = mfma16(akd[mm][0], b0, acc);
        acc = mfma16(akd[mm][1], b1, acc);
        uint2 o; o.x = pack2(acc[0], acc[1]); o.y = pack2(acc[2], acc[3]);
        *(uint2*)&gC[(nn * 16 + l15) * 128 + (2 * wave + mm) * 16 + 4 * g] = o;
      }
      {
        f32x4 acc = {0.f, 0.f, 0.f, 0.f};
        acc = mfma16(aqk[0], b0, acc);
        acc = mfma16(aqk[1], b1, acc);
        uint2 o; o.x = pack2(acc[0], acc[1]); o.y = pack2(acc[2], acc[3]);
        *(uint2*)&gO[(nn * 16 + l15) * 64 + wave * 16 + 4 * g] = o;
      }
    }
  }
}

__device__ void fox_cumsum_unit(const P& p, int bhf, float* red) {
  const int tid = threadIdx.x, lane = tid & 63, wave = tid >> 6;
  const int b = bhf >> 3, hf = bhf & 7;
  const float bias = p.fox_f_bias[hf];
  float v[8];
  float run = 0.f;
#pragma unroll
  for (int i = 0; i < 8; i++) {
    const int t = b * SEQ + tid * 8 + i;
    const float xx = p.gates[(size_t)t * 16 + 8 + hf] + bias;
    const float ls = fminf(xx, 0.f) - log1pf(__expf(-fabsf(xx)));
    run += ls;
    v[i] = run;
  }
  float tot = run;
#pragma unroll
  for (int off = 1; off < 64; off <<= 1) {
    float nb = __shfl_up(tot, off);
    if (lane >= off) tot += nb;
  }
  __syncthreads();
  if (lane == 63) red[wave] = tot;
  __syncthreads();
  float base = tot - run;
  for (int w = 0; w < wave; w++) base += red[w];
#pragma unroll
  for (int i = 0; i < 8; i++) p.cf[(size_t)bhf * SEQ + tid * 8 + i] = v[i] + base;
}

__device__ void phase_gdnprep(const P& p, unsigned char* smem) {
  GdnSmem& s = *(GdnSmem*)smem;
  for (int u = blockIdx.x; u < 1024 + 64; u += gridDim.x) {
    if (u < 1024) gdn_unit(p, u, s);
    else { __syncthreads(); fox_cumsum_unit(p, u - 1024, (float*)smem); }
  }
}

#define SLD 136
#define NSCAN 128
struct ScanSmem { u16 st[2][32 * SLD]; };
struct ScanSet { bf16x8 mf[2][4]; uint2 ci[2][2]; float dl; };

__device__ __forceinline__ void scan_load(const P& p, int unit, int eq, int w, int l15, int g, ScanSet& z) {
  int la = (32 * w + l15) * 128 + 8 * g, lc = (32 * eq + l15) * 128 + 32 * w + 4 * g;
  asm volatile("" : "+v"(la), "+v"(lc));
  const u16* gM = p.gM + (size_t)unit * 16384;
  const u16* gC = p.gC + (size_t)unit * 16384;
#pragma unroll
  for (int md = 0; md < 2; md++)
#pragma unroll
    for (int ks = 0; ks < 4; ks++) z.mf[md][ks] = *(const bf16x8*)&gM[la + md * 16 * 128 + ks * 32];
#pragma unroll
  for (int md = 0; md < 2; md++)
#pragma unroll
    for (int ne = 0; ne < 2; ne++) z.ci[md][ne] = *(const uint2*)&gC[lc + ne * 16 * 128 + md * 16];
  z.dl = p.gdl[unit];
}

__device__ __forceinline__ unsigned scan_touch(const P& p, int unit, int lane) {
  unsigned v = 0u;
  if (lane < 16) {
    const u16* base = (lane < 8) ? (p.gM + (size_t)unit * 16384) : (p.gC + (size_t)unit * 16384);
    v = *(const unsigned*)(base + (lane & 7) * 2048);
  }
  return v;
}

__device__ __forceinline__ void scan_step(const P& p, int unit, int n, int eq, int w, int l15, int g, ScanSmem& s,
                                          f32x4 (&st)[2][2], const ScanSet& z) {
  const u16* Sb = s.st[n & 1];
  u16* Sn = s.st[(n & 1) ^ 1];
#pragma unroll
  for (int md = 0; md < 2; md++)
#pragma unroll
    for (int ne = 0; ne < 2; ne++) {
      float c[4];
      unpack4(z.ci[md][ne], c);
      st[md][ne][0] = st[md][ne][0] * z.dl + c[0];
      st[md][ne][1] = st[md][ne][1] * z.dl + c[1];
      st[md][ne][2] = st[md][ne][2] * z.dl + c[2];
      st[md][ne][3] = st[md][ne][3] * z.dl + c[3];
    }
  if (n > 0) {
    int lb = l15 * SLD + 8 * g;
    asm volatile("" : "+v"(lb));
#pragma unroll
    for (int ne = 0; ne < 2; ne++) {
#pragma unroll
      for (int ks = 0; ks < 4; ks++) {
        const bf16x8 bs = *(const bf16x8*)&Sb[lb + 16 * ne * SLD + ks * 32];
        st[0][ne] = mfma16(z.mf[0][ks], bs, st[0][ne]);
        st[1][ne] = mfma16(z.mf[1][ks], bs, st[1][ne]);
      }
    }
  }
  if (n + 1 < 32) {
    u16* gS = p.gS + (size_t)(unit + 1) * 16384;
    int lsl = l15 * SLD + 32 * w + 4 * g, lsg = (32 * eq + l15) * 128 + 32 * w + 4 * g;
    asm volatile("" : "+v"(lsl), "+v"(lsg));
#pragma unroll
    for (int md = 0; md < 2; md++)
#pragma unroll
      for (int ne = 0; ne < 2; ne++) {
        uint2 o; o.x = pack2(st[md][ne][0], st[md][ne][1]); o.y = pack2(st[md][ne][2], st[md][ne][3]);
        *(uint2*)&Sn[lsl + 16 * ne * SLD + 16 * md] = o;
        *(uint2*)&gS[lsg + 16 * ne * 128 + 16 * md] = o;
      }
  }
  asm volatile("s_waitcnt lgkmcnt(0)" ::: "memory");
  __builtin_amdgcn_s_barrier();
  asm volatile("" ::: "memory");
}

__device__ void scan_unit(const P& p, int item, ScanSmem& s) {
  int tid = threadIdx.x;
  asm volatile("" : "+v"(tid));
  const int lane = tid & 63, w = tid >> 6;
  const int l15 = lane & 15, g = lane >> 4;
  const int bh = item >> 2, eq = item & 3;
  const int u0 = bh * 32;
  f32x4 st[2][2];
#pragma unroll
  for (int md = 0; md < 2; md++)
#pragma unroll
    for (int ne = 0; ne < 2; ne++) st[md][ne] = (f32x4){0.f, 0.f, 0.f, 0.f};
  ScanSet z0, z1, z2, z3;
  scan_load(p, u0 + 0, eq, w, l15, g, z0);
  scan_load(p, u0 + 1, eq, w, l15, g, z1);
  scan_load(p, u0 + 2, eq, w, l15, g, z2);
  unsigned tacc = 0u, tprev = 0u;
  __builtin_amdgcn_s_setprio(3);
#pragma unroll 1
  for (int n = 0; n < 32; n += 4) {
    tacc += tprev;
    tprev = 0u;
    if (n + 8 < 32) {
      tprev = scan_touch(p, u0 + n + 8, lane) + scan_touch(p, u0 + n + 9, lane) + scan_touch(p, u0 + n + 10, lane) +
              scan_touch(p, u0 + n + 11, lane);
    }
    scan_load(p, u0 + n + 3, eq, w, l15, g, z3);
    scan_step(p, u0 + n, n, eq, w, l15, g, s, st, z0);
    if (n + 4 < 32) scan_load(p, u0 + n + 4, eq, w, l15, g, z0);
    scan_step(p, u0 + n + 1, n + 1, eq, w, l15, g, s, st, z1);
    if (n + 4 < 32) scan_load(p, u0 + n + 5, eq, w, l15, g, z1);
    scan_step(p, u0 + n + 2, n + 2, eq, w, l15, g, s, st, z2);
    if (n + 4 < 32) scan_load(p, u0 + n + 6, eq, w, l15, g, z2);
    scan_step(p, u0 + n + 3, n + 3, eq, w, l15, g, s, st, z3);
  }
  __builtin_amdgcn_s_setprio(0);
  asm volatile("" :: "v"(tacc));
}

#define OLD 136
struct GoutSmem { float ssq[4][64]; u16 ob[64 * OLD]; };

__device__ void gout_unit(const P& p, int unit, GoutSmem& s) {
  const int tid = threadIdx.x, lane = tid & 63, w = tid >> 6;
  const int l15 = lane & 15, g = lane >> 4;
  const int bh = unit >> 5, n = unit & 31;
  const int b = bh >> 2, h = bh & 3;
  const u16* gQ = p.gQ + (size_t)unit * 8192;
  const u16* gO = p.gO + (size_t)unit * 8192;
  const u16* gS = p.gS + (size_t)unit * 16384;
  f32x4 o[4][2];
#pragma unroll
  for (int mc = 0; mc < 4; mc++)
#pragma unroll
    for (int ne = 0; ne < 2; ne++) {
      float c[4];
      unpack4(*(const uint2*)&gO[(32 * w + 16 * ne + l15) * 64 + 16 * mc + 4 * g], c);
      o[mc][ne] = (f32x4){c[0], c[1], c[2], c[3]};
    }
  if (n > 0) {
    bf16x8 bs[2][4];
#pragma unroll
    for (int ne = 0; ne < 2; ne++)
#pragma unroll
      for (int ks = 0; ks < 4; ks++) bs[ne][ks] = *(const bf16x8*)&gS[(32 * w + 16 * ne + l15) * 128 + ks * 32 + 8 * g];
#pragma unroll
    for (int mc = 0; mc < 4; mc++) {
#pragma unroll
      for (int ks = 0; ks < 4; ks++) {
        const bf16x8 aq = *(const bf16x8*)&gQ[(16 * mc + l15) * 128 + ks * 32 + 8 * g];
        o[mc][0] = mfma16(aq, bs[0][ks], o[mc][0]);
        o[mc][1] = mfma16(aq, bs[1][ks], o[mc][1]);
      }
    }
  }
  const float gnw0 = p.gdn_norm_w[32 * w + l15], gnw1 = p.gdn_norm_w[32 * w + 16 + l15];
  __syncthreads();
#pragma unroll
  for (int mc = 0; mc < 4; mc++)
#pragma unroll
    for (int r = 0; r < 4; r++) {
      float sq = o[mc][0][r] * o[mc][0][r] + o[mc][1][r] * o[mc][1][r];
#pragma unroll
      for (int off = 1; off < 16; off <<= 1) sq += __shfl_xor(sq, off);
      if (l15 == 0) s.ssq[w][16 * mc + 4 * g + r] = sq;
    }
  __syncthreads();
#pragma unroll
  for (int mc = 0; mc < 4; mc++)
#pragma unroll
    for (int r = 0; r < 4; r++) {
      const int c = 16 * mc + 4 * g + r;
      const float tot = s.ssq[0][c] + s.ssq[1][c] + s.ssq[2][c] + s.ssq[3][c];
      const float rs = rsqrtf(tot * (1.f / 128.f) + EPSV);
      s.ob[c * OLD + 32 * w + l15] = f2bf(o[mc][0][r] * rs * gnw0);
      s.ob[c * OLD + 32 * w + 16 + l15] = f2bf(o[mc][1][r] * rs * gnw1);
    }
  __syncthreads();
  {
    const int t0 = b * SEQ + n * 64;
    const int c0 = tid >> 4, ch = tid & 15;
    const u16* zp = p.proj + (size_t)(t0 + c0) * PROJW + 1536 + h * 128 + ch * 8;
    u16* op = p.actA + (size_t)(t0 + c0) * DM + h * 128 + ch * 8;
#pragma unroll
    for (int i = 0; i < 4; i++) {
      float ov[8], zv[8];
      unpack8(*(const uint4*)&s.ob[(c0 + 16 * i) * OLD + ch * 8], ov);
      unpack8(*(const uint4*)(zp + (size_t)i * 16 * PROJW), zv);
      uint4 r;
      r.x = pack2(ov[0] * siluf(zv[0]), ov[1] * siluf(zv[1])); r.y = pack2(ov[2] * siluf(zv[2]), ov[3] * siluf(zv[3]));
      r.z = pack2(ov[4] * siluf(zv[4]), ov[5] * siluf(zv[5])); r.w = pack2(ov[6] * siluf(zv[6]), ov[7] * siluf(zv[7]));
      *(uint4*)(op + (size_t)i * 16 * DM) = r;
    }
  }
}

__device__ void phase_gout(const P& p, unsigned char* smem) {
  GoutSmem& s = *(GoutSmem*)smem;
  for (int u = blockIdx.x; u < 1024; u += gridDim.x) gout_unit(p, u, s);
}

#define LOG2E 1.4426950408889634f
#define ANST 4
struct AttnSmem { u16 k[ANST][64 * 64 + 128]; u16 v[ANST][64 * 64]; };

__device__ void attn_unit(const P& p, int item, AttnSmem& s) {
  int tid = threadIdx.x;
  asm volatile("" : "+v"(tid));
  const int lane = tid & 63, w = tid >> 6;
  const int l15 = lane & 15, g = lane >> 4;
  const int qb = 15 - (item >> 6), bhf = item & 63;
  const int b = bhf >> 3, hf = bhf & 7;
  const int q0 = qb * 128 + 32 * w;
  const u16* qbase = p.proj + (size_t)(b * SEQ) * PROJW + 2048 + hf * 64;
  const u16* kbase = p.proj + (size_t)(b * SEQ) * PROJW + 2560 + hf * 64;
  const u16* vbase = p.vt + (size_t)bhf * 64 * SEQ;
  const float* cfb = p.cf + (size_t)bhf * SEQ;
  bf16x8 qf[2][2];
#pragma unroll
  for (int mi = 0; mi < 2; mi++)
#pragma unroll
    for (int ks = 0; ks < 2; ks++) qf[mi][ks] = *(const bf16x8*)&qbase[(size_t)(q0 + 16 * mi + l15) * PROJW + ks * 32 + g * 8];
  float cq[2], m[2], lsum[2];
  f32x4 O[2][4];
#pragma unroll
  for (int mi = 0; mi < 2; mi++) {
    cq[mi] = cfb[q0 + 16 * mi + l15]; m[mi] = -1e30f; lsum[mi] = 0.f;
#pragma unroll
    for (int nd = 0; nd < 4; nd++) O[mi][nd] = (f32x4){0.f, 0.f, 0.f, 0.f};
  }
  asm volatile("" :: "v"(cq[0]), "v"(cq[1]), "v"(qf[0][0]), "v"(qf[0][1]), "v"(qf[1][0]), "v"(qf[1][1]));
  const int ntile = (q0 + 32 + 63) >> 6;
  const int ntile_blk = 2 * qb + 2;
  const int drow = 8 * w + (lane >> 3);
  const int dchunk = (lane & 7) ^ ((4 * (w & 1) + (lane >> 4)) & 7);
  const u16* kg = kbase + (size_t)drow * PROJW + dchunk * 8;
  const u16* vg = vbase + (size_t)drow * SEQ + dchunk * 8;
  const float* cg_ = cfb + lane;
  u16* const skw = &s.k[0][0] + (8 * w) * 64;
  u16* const svw = &s.v[0][0] + (8 * w) * 64;
#define A_DMA(st, kk0) do { \
    u16* _dk = skw + (st) * (64 * 64 + 128); u16* _dv = svw + (st) * (64 * 64); \
    __builtin_amdgcn_global_load_lds((const unsigned*)(kg + (size_t)(kk0) * PROJW), (unsigned*)(_dk), 16, 0, 0); \
    __builtin_amdgcn_global_load_lds((const unsigned*)(kg + (size_t)((kk0) + 32) * PROJW), (unsigned*)(_dk + 32 * 64), 16, 0, 0); \
    __builtin_amdgcn_global_load_lds((const unsigned*)(vg + (kk0)), (unsigned*)(_dv), 16, 0, 0); \
    __builtin_amdgcn_global_load_lds((const unsigned*)(vg + (size_t)32 * SEQ + (kk0)), (unsigned*)(_dv + 32 * 64), 16, 0, 0); \
    __builtin_amdgcn_global_load_lds((const unsigned*)(cg_ + (kk0)), (unsigned*)(&s.k[0][0] + (st) * (64 * 64 + 128) + 64 * 64), 4, 0, 0); \
  } while (0)
  {
    const int npro = (ntile_blk > 2) ? 3 : 2;
#pragma unroll 1
    for (int j = 0; j < npro; j++) A_DMA(j, j * 64);
  }
  int ko[4][2];
#pragma unroll
  for (int t = 0; t < 4; t++) {
    const int row = 32 * (t >> 1) + 8 * (l15 >> 2) + 4 * (t & 1) + (l15 & 3);
    const int sw = (row >> 1) & 7;
    ko[t][0] = row * 64 + ((g ^ sw) * 8);
    ko[t][1] = row * 64 + (((4 + g) ^ sw) * 8);
  }
  const int swz = l15 >> 1;
  int vo[2];
  vo[0] = l15 * 64 + ((g ^ swz) * 8);
  vo[1] = l15 * 64 + (((4 + g) ^ swz) * 8);
#pragma unroll 1
  for (int kt = 0; kt < ntile_blk; kt++) {
    const int k0 = kt * 64, st = kt & 3;
    const int rem = ntile_blk - 1 - kt;
    if (rem >= 2) asm volatile("s_waitcnt vmcnt(10)" ::: "memory");
    else if (rem == 1) asm volatile("s_waitcnt vmcnt(5)" ::: "memory");
    else asm volatile("s_waitcnt vmcnt(0)" ::: "memory");
    asm volatile("s_waitcnt lgkmcnt(0)" ::: "memory");
    __builtin_amdgcn_s_barrier();
    asm volatile("" ::: "memory");
    if (kt + 3 < ntile_blk) { const int st3 = (kt + 3) & 3; A_DMA(st3, k0 + 192); }
    if (kt < ntile) {
      const u16* Ks = s.k[st];
      const u16* Vs = s.v[st];
      f32x4 ST[2][4];
#pragma unroll
      for (int t = 0; t < 4; t++) {
        const bf16x8 kf0 = *(const bf16x8*)&Ks[ko[t][0]];
        const bf16x8 kf1 = *(const bf16x8*)&Ks[ko[t][1]];
#pragma unroll
        for (int mi = 0; mi < 2; mi++) {
          f32x4 acc = {0.f, 0.f, 0.f, 0.f};
          acc = mfma16(kf0, qf[mi][0], acc);
          acc = mfma16(kf1, qf[mi][1], acc);
          ST[mi][t] = acc;
        }
      }
      f32x4 ck[4];
      {
        const unsigned cka = (unsigned)(size_t)(&Ks[64 * 64]) + 32u * g;
        asm volatile("ds_read_b128 %0, %4\n\tds_read_b128 %1, %4 offset:16\n\tds_read_b128 %2, %4 offset:128\n\t"
                     "ds_read_b128 %3, %4 offset:144\n\ts_waitcnt lgkmcnt(0)"
                     : "=&v"(ck[0]), "=&v"(ck[1]), "=&v"(ck[2]), "=&v"(ck[3]) : "v"(cka) : "memory");
      }
      const bool diag = (kt == ntile - 1);
      bf16x8 pf[2][2];
#pragma unroll
      for (int mi = 0; mi < 2; mi++) {
        const int qpos = q0 + 16 * mi + l15;
        float mx = -1e30f;
#pragma unroll
        for (int t = 0; t < 4; t++) {
          const float ckv[4] = {ck[t][0], ck[t][1], ck[t][2], ck[t][3]};
#pragma unroll
          for (int r = 0; r < 4; r++) {
            float lg = ST[mi][t][r] * (0.125f * LOG2E) + (cq[mi] - ckv[r]) * LOG2E;
            if (diag && (k0 + 32 * (t >> 1) + 8 * g + 4 * (t & 1) + r > qpos)) lg = -1e30f;
            ST[mi][t][r] = lg;
            mx = fmaxf(mx, lg);
          }
        }
        mx = fmaxf(mx, __shfl_xor(mx, 16));
        mx = fmaxf(mx, __shfl_xor(mx, 32));
        const float mn = fmaxf(m[mi], mx);
        const float alpha = __builtin_amdgcn_exp2f(m[mi] - mn);
        m[mi] = mn;
        float ps = 0.f;
#pragma unroll
        for (int t = 0; t < 4; t++)
#pragma unroll
          for (int r = 0; r < 4; r++) {
            const float pe = __builtin_amdgcn_exp2f(ST[mi][t][r] - mn);
            ST[mi][t][r] = pe;
            ps += pe;
          }
        lsum[mi] = lsum[mi] * alpha + ps;
#pragma unroll
        for (int kk = 0; kk < 2; kk++) {
          uint4 pk;
          pk.x = pack2(ST[mi][2 * kk][0], ST[mi][2 * kk][1]); pk.y = pack2(ST[mi][2 * kk][2], ST[mi][2 * kk][3]);
          pk.z = pack2(ST[mi][2 * kk + 1][0], ST[mi][2 * kk + 1][1]); pk.w = pack2(ST[mi][2 * kk + 1][2], ST[mi][2 * kk + 1][3]);
          pf[mi][kk] = __builtin_bit_cast(bf16x8, pk);
        }
#pragma unroll
        for (int r = 0; r < 4; r++) {
          const float ar = __shfl(alpha, 4 * g + r);
#pragma unroll
          for (int nd = 0; nd < 4; nd++) O[mi][nd][r] *= ar;
        }
      }
#pragma unroll
      for (int nd = 0; nd < 4; nd++)
#pragma unroll
        for (int kk = 0; kk < 2; kk++) {
          const bf16x8 vf = *(const bf16x8*)&Vs[16 * nd * 64 + vo[kk]];
          O[0][nd] = mfma16(pf[0][kk], vf, O[0][nd]);
          O[1][nd] = mfma16(pf[1][kk], vf, O[1][nd]);
        }
    }
  }
#pragma unroll
  for (int mi = 0; mi < 2; mi++) {
    float l = lsum[mi];
    l += __shfl_xor(l, 16);
    l += __shfl_xor(l, 32);
    const float inv = 1.f / l;
#pragma unroll
    for (int r = 0; r < 4; r++) {
      const float ir = __shfl(inv, 4 * g + r);
      const int t = b * SEQ + q0 + 16 * mi + 4 * g + r;
#pragma unroll
      for (int nd = 0; nd < 4; nd++) p.actA[(size_t)t * DM + 512 + hf * 64 + 16 * nd + l15] = f2bf(O[mi][nd][r] * ir);
    }
  }
}

__device__ void deferred_transpose(const P& p, int it, float* tile) {
  const int n1 = 16 * 16, n2 = n1 + 16 * 88, n3 = n2 + 44 * 16, n4 = n3 + 16 * 16;
  if (it < n1) { transpose_item(p.w_out, 1024, p.wt_out, 1024, it % 16, it / 16, 1, tile); }
  else if (it < n2) { int j = it - n1; transpose_item(p.w_gate_up, 2 * DFF, p.wt_gu, 1024, j % 16, j / 16, 2, tile, p.ffn_norm_w); }
  else if (it < n3) { int j = it - n2; transpose_item(p.w_down, 1024, p.wt_down, DFF, j % 44, j / 44, 1, tile); }
  else if (it < n4) { int j = it - n3; transpose_item(p.w_ple_gate, 1024, p.wt_pg, 1024, j % 16, j / 16, 1, tile, p.ple_norm_w); }
  else { int j = it - n4; transpose_item(p.w_ple_proj, 1024, p.wt_pp, 256, j % 4, j / 4, 1, tile); }
}

__device__ void phase_mixer(const P& p, unsigned char* smem, int rr) {
  volatile int* s_item_p = (volatile int*)(smem + SMEM_MAIN + 16);
  for (;;) {
    __syncthreads();
    if (threadIdx.x == 0) *s_item_p = (int)atomicAdd(&p.counters[rr], 1u);
    __syncthreads();
    const int item = *s_item_p;
    const int d0 = (gridDim.x == 512) ? DEFER_A : 0, d1 = (gridDim.x == 512) ? DEFER_B : N_DEFER;
    if (item >= NSCAN + 1024 + (d1 - d0)) break;
    if (item < NSCAN) { scan_unit(p, item, *(ScanSmem*)smem); }
    else if (item < NSCAN + 1024) { attn_unit(p, item - NSCAN, *(AttnSmem*)smem); }
    else { deferred_transpose(p, d0 + item - NSCAN - 1024, (float*)smem); }
  }
}

#define XB_TMO      128
#define XB_XCNT(j)  (256  + 64 * (j))
#define XB_XSUB(j)  (1280 + 64 * (j))
#define XB_XGEN(j)  (2304 + 64 * (j))
#define XB_TOP      3328
#define XB_TOPGEN   3392
#define XCD_BAR_WORDS 3456
#define XB_SPIN_CAP (1u << 20)
#define LAS __attribute__((address_space(3)))
__device__ __forceinline__ unsigned xb_ld(unsigned* p) { return __hip_atomic_load(p, __ATOMIC_RELAXED, __HIP_MEMORY_SCOPE_AGENT); }
__device__ __forceinline__ unsigned xb_add(unsigned* p, unsigned v) { return __hip_atomic_fetch_add(p, v, __ATOMIC_RELAXED, __HIP_MEMORY_SCOPE_AGENT); }
__device__ __forceinline__ unsigned xb_xcc_id() { return (unsigned)__builtin_amdgcn_s_getreg((3 << 11) | 20) & 0xFu; }
#define XB_SPIN(cond, bar) do { unsigned _sp = 0; while (cond) { __builtin_amdgcn_s_sleep(1); \
    if ((++_sp & 255u) == 0u) { if (xb_ld(&(bar)[XB_TMO])) break; if (_sp > XB_SPIN_CAP) { atomicAdd(&(bar)[XB_TMO], 1u); break; } } } } while (0)
struct XcdBarrier { unsigned* bar; unsigned x; volatile LAS unsigned* st; };
__device__ __forceinline__ XcdBarrier xcd_barrier_post(unsigned* bar, volatile LAS unsigned* st) {
  XcdBarrier b; b.bar = bar; b.x = xb_xcc_id(); b.st = st;
  if (threadIdx.x == 0) (void)xb_add(&bar[XB_XCNT(b.x)], 1u);
  return b;
}
__device__ __forceinline__ void xcd_barrier_complete(unsigned* bar, unsigned x, unsigned& nloc, unsigned& nx) {
  const unsigned G = gridDim.x * gridDim.y * gridDim.z;
  unsigned sum, cnt, mine, sp = 0u;
  for (;;) {
    sum = 0u; cnt = 0u; mine = 0u;
#pragma unroll
    for (unsigned j = 0; j < 16; ++j) { const unsigned c = xb_ld(&bar[XB_XCNT(j)]); sum += c; cnt += (c > 0u) ? 1u : 0u; mine = (j == x) ? c : mine; }
    if (sum == G) break;
    __builtin_amdgcn_s_sleep(1);
    if ((++sp & 255u) == 0u) { if (xb_ld(&bar[XB_TMO])) break; if (sp > XB_SPIN_CAP) { atomicAdd(&bar[XB_TMO], 1u); break; } }
  }
  nloc = mine > 0u ? mine : 1u; nx = cnt > 0u ? cnt : 1u;
}
__device__ __forceinline__ void xcd_barrier(const XcdBarrier& b) {
  asm volatile("s_waitcnt vmcnt(0)" ::: "memory");
  __syncthreads();
  if (threadIdx.x == 0) {
    unsigned* bar = b.bar;
    __builtin_amdgcn_s_waitcnt(0);
    unsigned nloc = b.st[0], nx = b.st[1];
    if (nloc == 0u) { xcd_barrier_complete(bar, b.x, nloc, nx); b.st[0] = nloc; b.st[1] = nx; }
    const unsigned old = xb_add(&bar[XB_XSUB(b.x)], 1u);
    const unsigned gen = old / nloc;
    if (old + 1u == (gen + 1u) * nloc) {
      __builtin_amdgcn_fence(__ATOMIC_RELEASE, "agent");
      asm volatile("s_waitcnt vmcnt(0)" ::: "memory");
      const unsigned og = xb_add(&bar[XB_TOP], 1u);
      const unsigned tg = og / nx;
      if (og + 1u == (tg + 1u) * nx) xb_add(&bar[XB_TOPGEN], 1u);
      else XB_SPIN(xb_ld(&bar[XB_TOPGEN]) == tg, bar);
      __builtin_amdgcn_fence(__ATOMIC_ACQUIRE, "agent");
      xb_add(&bar[XB_XGEN(b.x)], 1u);
      asm volatile("s_waitcnt vmcnt(0)" ::: "memory");
    } else {
      XB_SPIN(xb_ld(&bar[XB_XGEN(b.x)]) == gen, bar);
      __builtin_amdgcn_fence(__ATOMIC_ACQUIRE, "agent");
      asm volatile("s_waitcnt vmcnt(0)" ::: "memory");
    }
  }
  __syncthreads();
}

__global__ void __launch_bounds__(256, 2) mega(P p, int lo, int hi) {
  __shared__ __attribute__((aligned(16))) unsigned char smem[SMEM_MAIN + 32];
  cg::grid_group grid = cg::this_grid();
  uint4* xbw = (uint4*)(smem + SMEM_MAIN);
  if (threadIdx.x == 0) *xbw = make_uint4(0u, 0u, 0u, 0u);
  __syncthreads();
  XcdBarrier xb = xcd_barrier_post(p.bar, (volatile LAS unsigned*)xbw);
  if (hi < 0) grid.sync();
#define SEAM(k) if (lo <= k && k + 1 < hi) xcd_barrier(xb);
#if !defined(ONLY) || ONLY == 0
  if (lo <= 0 && 0 < hi) phase_prep(p, smem);
#endif
  SEAM(0)
#if !defined(ONLY) || ONLY == 1
  if (lo <= 1 && 1 < hi) phase_inproj(p, smem);
#endif
  SEAM(1)
#if !defined(ONLY) || ONLY == 2
  if (lo <= 2 && 2 < hi) phase_gdnprep(p, smem);
#endif
  SEAM(2)
#if !defined(ONLY) || ONLY == 3
  if (lo <= 3 && 3 < hi) phase_mixer(p, smem, 0);
#endif
  SEAM(3)
#if !defined(ONLY) || ONLY == 4
  if (lo <= 4 && 4 < hi) phase_gout(p, smem);
#endif
  SEAM(4)
#if !defined(ONLY) || ONLY == 5
  if (lo <= 5 && 5 < hi) phase_outproj(p, smem);
#endif
  SEAM(5)
#if !defined(ONLY) || ONLY == 6
  if (lo <= 6 && 6 < hi) phase_gateup(p, smem);
#endif
  SEAM(6)
#if !defined(ONLY) || ONLY == 7
  if (lo <= 7 && 7 < hi) phase_down(p, smem);
#endif
  SEAM(7)
#if !defined(ONLY) || ONLY == 8
  if (lo <= 8 && 8 < hi) phase_ple(p, smem);
#endif
  SEAM(8)
  if (lo <= 9 && 9 < hi) phase_final(p);
}

static_assert(sizeof(GemmSmem) <= SMEM_MAIN && sizeof(Gemm2Smem) <= SMEM_MAIN && sizeof(GdnSmem) <= SMEM_MAIN && sizeof(ScanSmem) <= SMEM_MAIN &&
              sizeof(GoutSmem) <= SMEM_MAIN && sizeof(AttnSmem) <= SMEM_MAIN && 64 * 65 * 4 <= SMEM_MAIN, "smem");

extern "C" void kernel_launch(void* const* d_in, const int* in_sizes, int n_in, void* d_out, int out_size,
                              void* d_ws, size_t ws_size, hipStream_t stream) {
  static int grid_blocks = 0;
  if (!grid_blocks) {
    int dev = 0, cus = 0, per_cu = 0;
    hipGetDevice(&dev);
    hipDeviceGetAttribute(&cus, hipDeviceAttributeMultiprocessorCount, dev);
    hipOccupancyMaxActiveBlocksPerMultiprocessor(&per_cu, mega, 256, 0);
    if (per_cu > 2) per_cu = 2;
    if (per_cu < 1) per_cu = 1;
    grid_blocks = cus * per_cu;
  }
  P p{};
  const float* const* in = (const float* const*)d_in;
  p.x = in[0]; p.p = in[1]; p.attn_norm_w = in[2]; p.w_in = in[3]; p.conv_w = in[4]; p.a_log = in[5];
  p.dt_bias = in[6]; p.gdn_norm_w = in[7]; p.fox_f_bias = in[8]; p.w_out = in[9]; p.ffn_norm_w = in[10];
  p.w_gate_up = in[11]; p.w_down = in[12]; p.ple_norm_w = in[13]; p.w_ple_gate = in[14]; p.w_ple_proj = in[15];
  p.final_norm_w = in[16];
  p.h = (float*)d_out;
  unsigned char* ws = (unsigned char*)d_ws;
  size_t off = 0;
  auto take = [&](size_t bytes) { unsigned char* r = ws + off; off += (bytes + 255) & ~(size_t)255; return r; };
  p.counters = (unsigned*)take(256);
  p.bar = (unsigned*)take(XCD_BAR_WORDS * 4);
  p.wt_in = (u16*)take((size_t)NIN_PAD * 1024 * 2);
  p.wt_out = (u16*)take((size_t)1024 * 1024 * 2);
  p.wt_gu = (u16*)take((size_t)2 * DFF * 1024 * 2);
  p.wt_down = (u16*)take((size_t)1024 * DFF * 2);
  p.wt_pg = (u16*)take((size_t)1024 * 1024 * 2);
  p.wt_pp = (u16*)take((size_t)1024 * 256 * 2);
  p.actA = (u16*)take((size_t)NTOK * 1024 * 2);
  p.pb = (u16*)take((size_t)NTOK * 256 * 2);
  p.proj = (u16*)take((size_t)NTOK * PROJW * 2);
  p.vt = (u16*)take((size_t)64 * 64 * SEQ * 2);
  p.gates = (float*)take((size_t)NTOK * 16 * 4);
  p.cf = (float*)take((size_t)64 * SEQ * 4);
  p.gM = (u16*)take((size_t)1024 * 16384 * 2);
  p.gC = (u16*)take((size_t)1024 * 16384 * 2);
  p.gdl = (float*)take(1024 * 4);
  p.rss = (float*)take((size_t)3 * NTOK * 4);
  p.hb = p.gM;
  if (off > ws_size) fprintf(stderr, "workspace too small: need %zu have %zu\n", off, ws_size);
  u16* ob = (u16*)d_out;
  p.gS = ob;
  p.gQ = ob + (size_t)1024 * 16384;
  p.gO = ob + (size_t)1024 * 16384 + (size_t)1024 * 8192;
  hipMemsetAsync(p.bar, 0, XCD_BAR_WORDS * 4, stream);
  int lo = 0, hi = NPHASE;
  void* args[] = {&p, &lo, &hi};
  hipError_t e = hipLaunchCooperativeKernel((void*)mega, dim3(grid_blocks), dim3(256), args, 0, stream);
  if (e != hipSuccess) fprintf(stderr, "cooperative launch failed: %s (grid %d)\n", hipGetErrorString(e), grid_blocks);
}
```
